# Optimizing an MI355X kernel written in HIP

```python
import jax, jax.numpy as jnp
from jax import lax
import numpy as np

D_MODEL = 1024
BATCH = 2
SEQ = 16384
DEPTH = 4

GRID_W = 64
CTX_LEN = 256
N_MIXERS = 2
POOL_WINDOWS = (2, 4, 8, 16)
N_POOL_GROUPS = 4
POOL_GROUP_DIM = D_MODEL // N_POOL_GROUPS
HEAD_DIM = 64
N_Q_HEADS = D_MODEL // HEAD_DIM
N_KV_HEADS = N_Q_HEADS // 4
Q_PER_KV = N_Q_HEADS // N_KV_HEADS
QKV_DIM = (N_Q_HEADS + 2 * N_KV_HEADS) * HEAD_DIM
WINDOW = 128
BLOCK_Q = 128
ROPE_THETA = 10000.0
N_EXPERTS = 16
EC_CAPACITY_FACTOR = 2
D_EXPERT = 2048
NORM_EPS = 1e-6
NEG_INF = -1e30

kernel_name = "hybrid_pool_swa_ecmoe_diffusion"


def rmsnorm(x, g):
    xf = x.astype(jnp.float32)
    y = xf * lax.rsqrt(jnp.mean(xf * xf, axis=-1, keepdims=True) + NORM_EPS)
    return (y * g.astype(jnp.float32)).astype(x.dtype)


def ada_params(cvec, w, b):
    m = jax.nn.silu(cvec) @ w + b
    return jnp.split(m, 6, axis=-1)


def modulate(h, shift, scale):
    return h * (1 + scale) + shift


def rope_2d(x):
    B, L, H, Dh = x.shape
    rows = L // GRID_W
    row = jnp.repeat(jnp.arange(rows), GRID_W).astype(jnp.float32)
    col = jnp.tile(jnp.arange(GRID_W), rows).astype(jnp.float32)
    n_freq = Dh // 4
    inv = ROPE_THETA ** (-jnp.arange(n_freq, dtype=jnp.float32) / n_freq)
    ang = jnp.concatenate([row[:, None] * inv, col[:, None] * inv], axis=-1)
    cos = jnp.cos(ang)[None, :, None, :]
    sin = jnp.sin(ang)[None, :, None, :]
    xp = x.astype(jnp.float32).reshape(B, L, H, Dh // 2, 2)
    x0, x1 = xp[..., 0], xp[..., 1]
    out = jnp.stack([x0 * cos - x1 * sin, x0 * sin + x1 * cos], axis=-1)
    return out.reshape(B, L, H, Dh).astype(x.dtype)


def pool_mix(h, w_pool, scale):
    B, L, D = h.shape
    hf = h.astype(jnp.float32)
    cs = jnp.concatenate([jnp.zeros((B, 1, D), jnp.float32), jnp.cumsum(hf, axis=1)], axis=1)
    t = jnp.arange(L)
    groups = []
    for g, w in enumerate(POOL_WINDOWS):
        half = w // 2
        lo = jnp.clip(t - half, 0, L)
        hi = jnp.clip(t + half, 0, L)
        sl = slice(g * POOL_GROUP_DIM, (g + 1) * POOL_GROUP_DIM)
        csg = cs[..., sl]
        mean = (csg[:, hi] - csg[:, lo]) / (hi - lo).astype(jnp.float32)[None, :, None]
        groups.append(mean - hf[..., sl])
    p = jnp.stack(groups, axis=2)
    y = jnp.einsum('blgc,gcd->blgd', p, w_pool.astype(jnp.float32)).reshape(B, L, D)
    return (y * scale.astype(jnp.float32)).astype(h.dtype)


def project_qkv(h, w_qkv, q_norm, k_norm):
    B, L, _ = h.shape
    proj = h @ w_qkv
    nq = N_Q_HEADS * HEAD_DIM
    nk = N_KV_HEADS * HEAD_DIM
    q = rmsnorm(proj[..., :nq].reshape(B, L, N_Q_HEADS, HEAD_DIM), q_norm)
    k = rmsnorm(proj[..., nq:nq + nk].reshape(B, L, N_KV_HEADS, HEAD_DIM), k_norm)
    v = proj[..., nq + nk:].reshape(B, L, N_KV_HEADS, HEAD_DIM)
    return q, k, v


def project_kv(h, w_qkv, k_norm):
    B, L, _ = h.shape
    nq = N_Q_HEADS * HEAD_DIM
    nk = N_KV_HEADS * HEAD_DIM
    proj = h @ w_qkv[:, nq:]
    k = rmsnorm(proj[..., :nk].reshape(B, L, N_KV_HEADS, HEAD_DIM), k_norm)
    v = proj[..., nk:].reshape(B, L, N_KV_HEADS, HEAD_DIM)
    return k, v


def attn_latent(q, k, v, kc, vc, sink):
    B, L, _, _ = q.shape
    Lc = kc.shape[1]
    nb = L // BLOCK_Q
    band = BLOCK_Q + 2 * WINDOW
    scale = HEAD_DIM ** -0.5
    kpad = jnp.pad(k, ((0, 0), (WINDOW, WINDOW), (0, 0), (0, 0)))
    vpad = jnp.pad(v, ((0, 0), (WINDOW, WINDOW), (0, 0), (0, 0)))
    sink_b = jnp.broadcast_to(sink.astype(jnp.float32).reshape(N_KV_HEADS, Q_PER_KV)[None, :, :, None, None],
                              (B, N_KV_HEADS, Q_PER_KV, BLOCK_Q, 1))

    def block(bi):
        start = bi * BLOCK_Q
        qb = lax.dynamic_slice_in_dim(q, start, BLOCK_Q, axis=1).reshape(B, BLOCK_Q, N_KV_HEADS, Q_PER_KV, HEAD_DIM)
        kb = lax.dynamic_slice_in_dim(kpad, start, band, axis=1)
        vb = lax.dynamic_slice_in_dim(vpad, start, band, axis=1)
        qi = start + jnp.arange(BLOCK_Q)
        kj = start - WINDOW + jnp.arange(band)
        mask = (kj[None, :] >= 0) & (kj[None, :] < L) & (jnp.abs(qi[:, None] - kj[None, :]) <= WINDOW)
        s_loc = jnp.einsum('bqkgd,bskd->bkgqs', qb, kb).astype(jnp.float32) * scale
        s_loc = jnp.where(mask[None, None, None], s_loc, NEG_INF)
        s_ctx = jnp.einsum('bqkgd,bskd->bkgqs', qb, kc).astype(jnp.float32) * scale
        p = jax.nn.softmax(jnp.concatenate([s_loc, s_ctx, sink_b], axis=-1), axis=-1).astype(v.dtype)
        o = (jnp.einsum('bkgqs,bskd->bqkgd', p[..., :band], vb)
             + jnp.einsum('bkgqs,bskd->bqkgd', p[..., band:band + Lc], vc))
        return o.reshape(B, BLOCK_Q, N_Q_HEADS * HEAD_DIM)

    out = lax.map(block, jnp.arange(nb))
    return jnp.transpose(out, (1, 0, 2, 3)).reshape(B, L, N_Q_HEADS * HEAD_DIM)


def attn_context(qc, kc, vc, sink):
    B, Lc, _, _ = qc.shape
    scale = HEAD_DIM ** -0.5
    qg = qc.reshape(B, Lc, N_KV_HEADS, Q_PER_KV, HEAD_DIM)
    s = jnp.einsum('bqkgd,bskd->bkgqs', qg, kc).astype(jnp.float32) * scale
    sink_b = jnp.broadcast_to(sink.astype(jnp.float32).reshape(N_KV_HEADS, Q_PER_KV)[None, :, :, None, None],
                              (B, N_KV_HEADS, Q_PER_KV, Lc, 1))
    p = jax.nn.softmax(jnp.concatenate([s, sink_b], axis=-1), axis=-1).astype(vc.dtype)
    o = jnp.einsum('bkgqs,bskd->bqkgd', p[..., :Lc], vc)
    return o.reshape(B, Lc, N_Q_HEADS * HEAD_DIM)


def ec_moe(h, w_router, w_gate, w_up, w_down):
    B, N, D = h.shape
    C = EC_CAPACITY_FACTOR * N // N_EXPERTS
    aff = jax.nn.softmax(jnp.einsum('bnd,de->bne', h, w_router).astype(jnp.float32), axis=-1)
    vals, idx = lax.top_k(jnp.swapaxes(aff, 1, 2), C)
    xs = jax.vmap(lambda hb, ib: hb[ib])(h, idx)
    a = jnp.einsum('becd,edf->becf', xs, w_gate)
    u = jnp.einsum('becd,edf->becf', xs, w_up)
    y = jnp.einsum('becf,efd->becd', jax.nn.silu(a) * u, w_down) * vals[..., None].astype(h.dtype)
    out = jax.vmap(lambda ib, yb: jnp.zeros((N, D), yb.dtype).at[ib.reshape(-1)].add(yb.reshape(-1, D)))(idx, y)
    return out


def setup_inputs(seed: int = 0) -> dict:
    key = jax.random.key(seed)
    ks = jax.random.split(key, 20)
    n_pool = (DEPTH + 1) // 2
    n_attn = DEPTH // 2
    D = D_MODEL
    nrm = jax.random.normal
    f32 = jnp.float32
    return {
        "x": nrm(ks[0], (BATCH, SEQ, D), f32),
        "c": nrm(ks[1], (BATCH, D), f32),
        "ctx": nrm(ks[2], (BATCH, CTX_LEN, D), f32),
        "c_ctx": nrm(ks[3], (D,), f32),
        "w_ada": nrm(ks[4], (DEPTH, D, 6 * D), f32) * (0.5 * D ** -0.5),
        "b_ada": nrm(ks[5], (DEPTH, 6 * D), f32) * 0.02,
        "norm1_g": 1.0 + 0.05 * nrm(ks[6], (DEPTH, D), f32),
        "norm2_g": 1.0 + 0.05 * nrm(ks[7], (DEPTH, D), f32),
        "pool_w": nrm(ks[8], (n_pool, N_POOL_GROUPS, POOL_GROUP_DIM, POOL_GROUP_DIM), f32) * POOL_GROUP_DIM ** -0.5,
        "pool_scale": 1.0 + 0.05 * nrm(ks[9], (n_pool, D), f32),
        "attn_w_qkv": nrm(ks[10], (n_attn, D, QKV_DIM), f32) * D ** -0.5,
        "attn_w_o": nrm(ks[11], (n_attn, N_Q_HEADS * HEAD_DIM, D), f32) * (N_Q_HEADS * HEAD_DIM) ** -0.5,
        "attn_q_norm": 1.0 + 0.05 * nrm(ks[12], (n_attn, HEAD_DIM), f32),
        "attn_k_norm": 1.0 + 0.05 * nrm(ks[13], (n_attn, HEAD_DIM), f32),
        "attn_sink": 0.5 * nrm(ks[14], (n_attn, N_Q_HEADS), f32),
        "router_w": nrm(ks[15], (DEPTH, D, N_EXPERTS), f32) * D ** -0.5,
        "exp_w_gate": nrm(ks[16], (DEPTH, N_EXPERTS, D, D_EXPERT), f32) * D ** -0.5,
        "exp_w_up": nrm(ks[17], (DEPTH, N_EXPERTS, D, D_EXPERT), f32) * D ** -0.5,
        "exp_w_down": nrm(ks[18], (DEPTH, N_EXPERTS, D_EXPERT, D), f32) * D_EXPERT ** -0.5,
    }


def reference(x, c, ctx, c_ctx, w_ada, b_ada, norm1_g, norm2_g, pool_w, pool_scale,
              attn_w_qkv, attn_w_o, attn_q_norm, attn_k_norm, attn_sink,
              router_w, exp_w_gate, exp_w_up, exp_w_down):
    for i in range(DEPTH):
        update_ctx = i < DEPTH - 1
        j = i // N_MIXERS
        is_pool = (i % N_MIXERS) == 0
        sh1, sc1, g1, sh2, sc2, g2 = [m[:, None, :] for m in ada_params(c, w_ada[i], b_ada[i])]
        csh1, csc1, cg1, csh2, csc2, cg2 = [m[None, None, :] for m in ada_params(c_ctx, w_ada[i], b_ada[i])]

        h = modulate(rmsnorm(x, norm1_g[i]), sh1, sc1)
        if is_pool:
            y = pool_mix(h, pool_w[j], pool_scale[j])
            if update_ctx:
                hc = modulate(rmsnorm(ctx, norm1_g[i]), csh1, csc1)
                yc = pool_mix(hc, pool_w[j], pool_scale[j])
        else:
            hc = modulate(rmsnorm(ctx, norm1_g[i]), csh1, csc1)
            q, k, v = project_qkv(h, attn_w_qkv[j], attn_q_norm[j], attn_k_norm[j])
            q = rope_2d(q)
            k = rope_2d(k)
            if update_ctx:
                qc, kc, vc = project_qkv(hc, attn_w_qkv[j], attn_q_norm[j], attn_k_norm[j])
                yc = attn_context(qc, kc, vc, attn_sink[j]) @ attn_w_o[j]
            else:
                kc, vc = project_kv(hc, attn_w_qkv[j], attn_k_norm[j])
            y = attn_latent(q, k, v, kc, vc, attn_sink[j]) @ attn_w_o[j]

        x = x + g1 * y
        h2 = modulate(rmsnorm(x, norm2_g[i]), sh2, sc2)
        x = x + g2 * ec_moe(h2, router_w[i], exp_w_gate[i], exp_w_up[i], exp_w_down[i])

        if update_ctx:
            ctx = ctx + cg1 * yc
            hc2 = modulate(rmsnorm(ctx, norm2_g[i]), csh2, csc2)
            ctx = ctx + cg2 * ec_moe(hc2, router_w[i], exp_w_gate[i], exp_w_up[i], exp_w_down[i])
    return x
```

```cpp
#include <hip/hip_runtime.h>
#include <stdint.h>
#include <stdio.h>

typedef _Float16 f16;
typedef _Float16 f16x4 __attribute__((ext_vector_type(4)));
typedef _Float16 f16x8 __attribute__((ext_vector_type(8)));
typedef float f32x4 __attribute__((ext_vector_type(4)));
typedef float f32x2 __attribute__((ext_vector_type(2)));

#define DM 1024
#define SEQ 16384
#define NLAT 32768
#define CTXL 256
#define NCTX 512
#define MROWS 33280
#define NEXP 16
#define DEXP 2048
#define SLOTS 4160
#define SLOTS_PAD 4352
#define QKVD 1536
#define NTHR 512

struct Params {
    const float *x, *c, *ctx, *c_ctx, *w_ada, *b_ada, *norm1_g, *norm2_g, *pool_w, *pool_scale, *w_qkv, *w_o, *q_norm, *k_norm, *sink, *router_w, *w_gate, *w_up, *w_down;
    float* out;
    unsigned* bar; float* mod; float* rope; float* X; f16* H; f16* Z; f16* Q; f16* Kb; f16* Vb; f16* O; float* aff; int* inv; int* rowidx; f16* act; f16* yslot; f16* Wgu; f16* Wd; f16* Wmix;
};

__device__ __forceinline__ float wave_sum(float v) {
#pragma unroll
    for (int o = 32; o; o >>= 1) v += __shfl_xor(v, o);
    return v;
}
__device__ __forceinline__ float silu_f(float v) { return v / (1.0f + __expf(-v)); }

__device__ __forceinline__ const float* modp(const Params& P, int l, int v, int j) { return P.mod + (size_t)((l * 3 + v) * 6 + j) * DM; }

__device__ void phase_ada(const Params& P, int bid, int nb, float* lds) {
    float* sc = lds; float* red = lds + 3 * DM;
    const int tid = threadIdx.x;
    for (int i = tid; i < 3 * DM; i += NTHR) { const int v = i >> 10, k = i & 1023; const float cv = v < 2 ? P.c[v * DM + k] : P.c_ctx[k]; sc[i] = silu_f(cv); }
    __syncthreads();
    for (int u = bid; u < 4 * 96; u += nb) {
        const int l = u / 96, ch = u % 96, col = ch * 64 + (tid & 63), ks = tid >> 6;
        const float* w = P.w_ada + (size_t)l * DM * 6 * DM + col;
        float s0 = 0.f, s1 = 0.f, s2 = 0.f;
        for (int k = ks * 128; k < ks * 128 + 128; ++k) { const float wv = w[(size_t)k * 6 * DM]; s0 += sc[k] * wv; s1 += sc[DM + k] * wv; s2 += sc[2 * DM + k] * wv; }
        red[(ks * 3 + 0) * 64 + (tid & 63)] = s0; red[(ks * 3 + 1) * 64 + (tid & 63)] = s1; red[(ks * 3 + 2) * 64 + (tid & 63)] = s2;
        __syncthreads();
        if (tid < 192) { const int v = tid >> 6, cc = tid & 63; float s = 0.f;
#pragma unroll
            for (int q = 0; q < 8; ++q) s += red[(q * 3 + v) * 64 + cc];
            const int colg = ch * 64 + cc; s += P.b_ada[l * 6 * DM + colg];
            const int j = colg >> 10, d = colg & 1023;
            P.mod[(size_t)((l * 3 + v) * 6 + j) * DM + d] = s; }
        __syncthreads();
    }
    for (int i = bid * NTHR + tid; i < 256 * 16; i += nb * NTHR) {
        const int p = i >> 4, f = i & 15;
        const float inv = powf(10000.0f, -(float)f / 16.0f);
        const float angf = (float)p * inv;
        double a = (double)angf;
        const double twopi = 6.283185307179586476925286766559;
        a -= twopi * rint(a / twopi);
        const double a2 = a * a;
        double cs = 1.0, sn = 1.0;
        double tc = 0.0, ts = 0.0;
        for (int n = 16; n >= 1; --n) { tc = (tc + 1.0) * (-a2 / (double)((2 * n - 1) * (2 * n))); ts = (ts + 1.0) * (-a2 / (double)((2 * n) * (2 * n + 1))); }
        cs = 1.0 + tc; sn = a * (1.0 + ts);
        P.rope[i * 2] = (float)cs; P.rope[i * 2 + 1] = (float)sn;
    }
}

template <bool FIRST, bool FINAL>
__device__ void phase_n1(const Params& P, int l, int bid, int nb) {
    const int wid = threadIdx.x >> 6, lane = threadIdx.x & 63;
    const int nrows = FINAL ? NLAT : MROWS;
    for (int r = bid * 8 + wid; r < nrows; r += nb * 8) {
        const int v = r < NLAT ? (r >> 14) : 2;
        f32x4 xv[4];
        if (FIRST) {
            const float* src = r < NLAT ? P.x + (size_t)r * DM : P.ctx + (size_t)(r - NLAT) * DM;
#pragma unroll
            for (int q = 0; q < 4; ++q) xv[q] = *(const f32x4*)(src + q * 256 + lane * 4);
        } else {
            const float* src = P.X + (size_t)r * DM;
#pragma unroll
            for (int q = 0; q < 4; ++q) xv[q] = *(const f32x4*)(src + q * 256 + lane * 4);
            f32x4 acc[4];
#pragma unroll
            for (int q = 0; q < 4; ++q) acc[q] = (f32x4){0.f, 0.f, 0.f, 0.f};
            const int sl = lane < 16 ? P.inv[(size_t)r * 16 + lane] : -1;
            const float af = lane < 16 ? P.aff[(size_t)r * 16 + lane] : 0.f;
            for (int e = 0; e < 16; ++e) {
                const int s = __shfl(sl, e);
                if (s >= 0) {
                    const float val = __shfl(af, e);
                    const f16* y = P.yslot + ((size_t)e * SLOTS_PAD + s) * DM;
#pragma unroll
                    for (int q = 0; q < 4; ++q) { const f16x4 yv = *(const f16x4*)(y + q * 256 + lane * 4);
                        acc[q] += val * (f32x4){(float)yv[0], (float)yv[1], (float)yv[2], (float)yv[3]}; }
                }
            }
            const float* g2 = modp(P, l - 1, v, 5);
#pragma unroll
            for (int q = 0; q < 4; ++q) xv[q] += *(const f32x4*)(g2 + q * 256 + lane * 4) * acc[q];
        }
        if (FINAL) {
            float* dst = P.out + (size_t)r * DM;
#pragma unroll
            for (int q = 0; q < 4; ++q) *(f32x4*)(dst + q * 256 + lane * 4) = xv[q];
            continue;
        }
        float* xd = P.X + (size_t)r * DM;
        float ss = 0.f;
#pragma unroll
        for (int q = 0; q < 4; ++q) { *(f32x4*)(xd + q * 256 + lane * 4) = xv[q]; ss += xv[q][0] * xv[q][0] + xv[q][1] * xv[q][1] + xv[q][2] * xv[q][2] + xv[q][3] * xv[q][3]; }
        ss = wave_sum(ss);
        const float rstd = rsqrtf(ss * (1.0f / DM) + 1e-6f);
        const float* g = P.norm1_g + l * DM; const float* sh = modp(P, l, v, 0); const float* scl = modp(P, l, v, 1);
        f16* hd = P.H + (size_t)r * DM;
#pragma unroll
        for (int q = 0; q < 4; ++q) {
            const int c0 = q * 256 + lane * 4;
            const f32x4 gv = *(const f32x4*)(g + c0), sv = *(const f32x4*)(sh + c0), cv = *(const f32x4*)(scl + c0);
            const f32x4 h = xv[q] * rstd * gv * (1.0f + cv) + sv;
            *(f16x4*)(hd + c0) = (f16x4){(f16)h[0], (f16)h[1], (f16)h[2], (f16)h[3]};
        }
    }
}

template <bool POOL>
__device__ void phase_n2(const Params& P, int l, int bid, int nb, float* lds) {
    const int tid = threadIdx.x, wid = tid >> 6, lane = tid & 63;
    const float* wr = P.router_w + (size_t)l * DM * NEXP;
    for (int i = tid; i < DM * NEXP; i += NTHR) { const int d = i >> 4, e = i & 15; lds[e * DM + d] = wr[i]; }
    __syncthreads();
    const int j = l >> 1;
    for (int r = bid * 8 + wid; r < MROWS; r += nb * 8) {
        int v, s0, L;
        if (r < NLAT) { v = r >> 14; s0 = v << 14; L = SEQ; } else { v = 2; s0 = NLAT + (((r - NLAT) >> 8) << 8); L = CTXL; }
        const int t = r - s0;
        f32x4 y[4];
#pragma unroll
        for (int q = 0; q < 4; ++q) {
            const int c0 = q * 256 + lane * 4;
            const f16x4 zc = *(const f16x4*)(P.Z + (size_t)r * DM + c0);
            const f32x4 zf = (f32x4){(float)zc[0], (float)zc[1], (float)zc[2], (float)zc[3]};
            if (POOL) {
                const int half = 1 << q;
                const int lo = max(t - half, 0), hi = min(t + half, L);
                f32x4 s = (f32x4){0.f, 0.f, 0.f, 0.f};
                for (int tt = lo; tt < hi; ++tt) { const f16x4 zz = *(const f16x4*)(P.Z + (size_t)(s0 + tt) * DM + c0); s += (f32x4){(float)zz[0], (float)zz[1], (float)zz[2], (float)zz[3]}; }
                const f32x4 ps = *(const f32x4*)(P.pool_scale + j * DM + c0);
                y[q] = (s * (1.0f / (float)(hi - lo)) - zf) * ps;
            } else y[q] = zf;
        }
        float* xd = P.X + (size_t)r * DM;
        const float* g1 = modp(P, l, v, 2);
        f32x4 xv[4]; float ss = 0.f;
#pragma unroll
        for (int q = 0; q < 4; ++q) {
            const int c0 = q * 256 + lane * 4;
            xv[q] = *(const f32x4*)(xd + c0) + *(const f32x4*)(g1 + c0) * y[q];
            *(f32x4*)(xd + c0) = xv[q];
            ss += xv[q][0] * xv[q][0] + xv[q][1] * xv[q][1] + xv[q][2] * xv[q][2] + xv[q][3] * xv[q][3];
        }
        ss = wave_sum(ss);
        const float rstd = rsqrtf(ss * (1.0f / DM) + 1e-6f);
        const float* g = P.norm2_g + l * DM; const float* sh = modp(P, l, v, 3); const float* scl = modp(P, l, v, 4);
        f16* hd = P.H + (size_t)r * DM;
        f32x4 h2[4];
#pragma unroll
        for (int q = 0; q < 4; ++q) {
            const int c0 = q * 256 + lane * 4;
            const f32x4 gv = *(const f32x4*)(g + c0), sv = *(const f32x4*)(sh + c0), cv = *(const f32x4*)(scl + c0);
            h2[q] = xv[q] * rstd * gv * (1.0f + cv) + sv;
            *(f16x4*)(hd + c0) = (f16x4){(f16)h2[q][0], (f16)h2[q][1], (f16)h2[q][2], (f16)h2[q][3]};
        }
        float mylg = 0.f;
#pragma unroll 2
        for (int e = 0; e < 16; ++e) {
            float s = 0.f;
#pragma unroll
            for (int q = 0; q < 4; ++q) { const f32x4 w = *(const f32x4*)(lds + e * DM + q * 256 + lane * 4); s += h2[q][0] * w[0] + h2[q][1] * w[1] + h2[q][2] * w[2] + h2[q][3] * w[3]; }
            s = wave_sum(s);
            mylg = (lane == e) ? s : mylg;
        }
        float mx = mylg;
        mx = fmaxf(mx, __shfl_xor(mx, 1)); mx = fmaxf(mx, __shfl_xor(mx, 2)); mx = fmaxf(mx, __shfl_xor(mx, 4)); mx = fmaxf(mx, __shfl_xor(mx, 8));
        const float pe = __expf(mylg - mx);
        float den = pe;
        den += __shfl_xor(den, 1); den += __shfl_xor(den, 2); den += __shfl_xor(den, 4); den += __shfl_xor(den, 8);
        if (lane < 16) P.aff[(size_t)r * 16 + lane] = pe / den;
    }
}

__device__ void phase_topk(const Params& P, int bid, int nb, unsigned* lds) {
    unsigned* hist = lds; unsigned* misc = lds + 256; unsigned* wsa = lds + 272; unsigned* wsb = lds + 288;
    const int tid = threadIdx.x, wid = tid >> 6, lane = tid & 63;
    for (int p = bid; p < 64; p += nb) {
        const int set = p >> 4, e = p & 15;
        const int n = set < 2 ? SEQ : CTXL, C = n >> 3;
        const int r0 = set < 2 ? set * SEQ : NLAT + (set - 2) * CTXL;
        const int slot0 = set < 2 ? set * 2048 : 4096 + (set - 2) * 32;
        unsigned key[32];
#pragma unroll
        for (int i = 0; i < 32; ++i) { const int idx = tid * 32 + i; key[i] = idx < n ? (__float_as_uint(P.aff[(size_t)(r0 + idx) * 16 + e]) + 1u) : 0u; }
        unsigned prefix = 0u, krem = (unsigned)C;
        for (int pass = 3; pass >= 0; --pass) {
            const int sh = pass * 8;
            if (tid < 256) hist[tid] = 0u;
            __syncthreads();
            const unsigned himask = pass == 3 ? 0u : (0xFFFFFFFFu << (sh + 8));
#pragma unroll
            for (int i = 0; i < 32; ++i) if ((key[i] & himask) == prefix && key[i] != 0u) atomicAdd(&hist[(key[i] >> sh) & 255u], 1u);
            __syncthreads();
            if (tid < 256) {
                unsigned gt = 0u;
                for (int b = tid + 1; b < 256; ++b) gt += hist[b];
                const unsigned hb = hist[tid];
                if (gt < krem && krem <= gt + hb) { misc[0] = (unsigned)tid; misc[1] = krem - gt; }
            }
            __syncthreads();
            prefix |= misc[0] << sh; krem = misc[1];
            __syncthreads();
        }
        const unsigned T = prefix;
        unsigned cg = 0u, ce = 0u;
#pragma unroll
        for (int i = 0; i < 32; ++i) { cg += key[i] > T ? 1u : 0u; ce += key[i] == T ? 1u : 0u; }
        unsigned ig = cg, ie = ce;
#pragma unroll
        for (int o = 1; o < 64; o <<= 1) { const unsigned a = __shfl_up(ig, o), b = __shfl_up(ie, o); if (lane >= o) { ig += a; ie += b; } }
        if (lane == 63) { wsa[wid] = ig; wsb[wid] = ie; }
        __syncthreads();
        unsigned bg = 0u, be = 0u;
        for (int w = 0; w < wid; ++w) { bg += wsa[w]; be += wsb[w]; }
        unsigned pg = bg + ig - cg, pe = be + ie - ce;
#pragma unroll
        for (int i = 0; i < 32; ++i) {
            const int idx = tid * 32 + i;
            if (idx < n) {
                bool sel = false; unsigned rank = 0u;
                if (key[i] > T) { sel = true; rank = pg + (pe < krem ? pe : krem); ++pg; }
                else if (key[i] == T) { if (pe < krem) { sel = true; rank = pg + pe; } ++pe; }
                if (sel) P.rowidx[e * SLOTS_PAD + slot0 + (int)rank] = r0 + idx;
                P.inv[(size_t)(r0 + idx) * 16 + e] = sel ? slot0 + (int)rank : -1;
            }
        }
        if (set == 3) for (int i = SLOTS + tid; i < SLOTS_PAD; i += NTHR) P.rowidx[e * SLOTS_PAD + i] = 0;
        __syncthreads();
    }
}

struct EpiZ { f16* Z; int coloff; __device__ __forceinline__ void elem(int row, int col, float a, float) const { Z[(size_t)row * DM + coloff + col] = (f16)a; } };
struct EpiQKV { f16 *Q, *K, *V; __device__ __forceinline__ void elem(int row, int col, float a, float) const {
        if (col < 1024) Q[(size_t)row * 1024 + col] = (f16)a; else if (col < 1280) K[(size_t)row * 256 + col - 1024] = (f16)a; else V[(size_t)row * 256 + col - 1280] = (f16)a; } };
struct EpiAct { f16* act; __device__ __forceinline__ void elem(int row, int col, float a, float b) const { act[(size_t)row * DEXP + col] = (f16)(silu_f(a) * b); } };
struct EpiY { f16* y; __device__ __forceinline__ void elem(int row, int col, float a, float) const { y[(size_t)row * DM + col] = (f16)a; } };

template <class Epi, bool DUAL>
__device__ void naive_tile(const f16* A, const int* rowidx, int lda, const float* B0, const float* B1, int ldb, int K, int row0, int col0, const Epi& epi, float* lds) {
    float* As = lds;
    float* Bs = lds + 16 * 132;
    float* Bs1 = Bs + 16 * 64;
    const int tid = threadIdx.x, tx = tid & 15, ty = tid >> 4;
    const int arow = tid >> 2, ak = (tid & 3) * 4, bk = tid >> 5, bn = (tid & 31) * 2;
    const int grow = rowidx ? rowidx[row0 + arow] : row0 + arow;
    const f16* ap = A + (size_t)grow * lda + ak;
    float acc0[4][4], acc1[4][4];
#pragma unroll
    for (int i = 0; i < 4; ++i)
#pragma unroll
        for (int jj = 0; jj < 4; ++jj) { acc0[i][jj] = 0.f; acc1[i][jj] = 0.f; }
    for (int k0 = 0; k0 < K; k0 += 16) {
        const f16x4 av = *(const f16x4*)(ap + k0);
#pragma unroll
        for (int i = 0; i < 4; ++i) As[(ak + i) * 132 + arow] = (float)av[i];
        const f32x2 bv = *(const f32x2*)(B0 + (size_t)(k0 + bk) * ldb + col0 + bn);
        Bs[bk * 64 + bn] = bv[0]; Bs[bk * 64 + bn + 1] = bv[1];
        if (DUAL) { const f32x2 bw = *(const f32x2*)(B1 + (size_t)(k0 + bk) * ldb + col0 + bn); Bs1[bk * 64 + bn] = bw[0]; Bs1[bk * 64 + bn + 1] = bw[1]; }
        __syncthreads();
#pragma unroll
        for (int kk = 0; kk < 16; ++kk) {
            const f32x4 a = *(const f32x4*)(As + kk * 132 + ty * 4);
            const f32x4 b = *(const f32x4*)(Bs + kk * 64 + tx * 4);
#pragma unroll
            for (int i = 0; i < 4; ++i)
#pragma unroll
                for (int jj = 0; jj < 4; ++jj) acc0[i][jj] += a[i] * b[jj];
            if (DUAL) { const f32x4 b1 = *(const f32x4*)(Bs1 + kk * 64 + tx * 4);
#pragma unroll
                for (int i = 0; i < 4; ++i)
#pragma unroll
                    for (int jj = 0; jj < 4; ++jj) acc1[i][jj] += a[i] * b1[jj]; }
        }
        __syncthreads();
    }
#pragma unroll
    for (int i = 0; i < 4; ++i)
#pragma unroll
        for (int jj = 0; jj < 4; ++jj) epi.elem(row0 + ty * 4 + i, col0 + tx * 4 + jj, acc0[i][jj], acc1[i][jj]);
}

__device__ void phase_poolgemm_naive(const Params& P, int l, int bid, int nb, float* lds) {
    const int j = l >> 1;
    for (int u = bid; u < 260 * 16; u += nb) {
        const int pm = u >> 4, g = (u >> 2) & 3, pn = u & 3;
        EpiZ epi{P.Z, g * 256};
        naive_tile<EpiZ, false>(P.H + g * 256, nullptr, DM, P.pool_w + (size_t)(j * 4 + g) * 256 * 256, nullptr, 256, 256, pm * 128, pn * 64, epi, lds);
    }
}
__device__ void phase_qkvgemm_naive(const Params& P, int l, int bid, int nb, float* lds) {
    const int j = l >> 1;
    for (int u = bid; u < 260 * 24; u += nb) {
        const int pm = u / 24, pn = u % 24;
        EpiQKV epi{P.Q, P.Kb, P.Vb};
        naive_tile<EpiQKV, false>(P.H, nullptr, DM, P.w_qkv + (size_t)j * DM * QKVD, nullptr, QKVD, DM, pm * 128, pn * 64, epi, lds);
    }
}
__device__ void phase_oproj_naive(const Params& P, int l, int bid, int nb, float* lds) {
    const int j = l >> 1;
    for (int u = bid; u < 260 * 16; u += nb) {
        const int pm = u >> 4, pn = u & 15;
        EpiZ epi{P.Z, 0};
        naive_tile<EpiZ, false>(P.O, nullptr, DM, P.w_o + (size_t)j * DM * DM, nullptr, DM, DM, pm * 128, pn * 64, epi, lds);
    }
}
__device__ void phase_gateup_naive(const Params& P, int l, int bid, int nb, float* lds) {
    for (int u = bid; u < 16 * 34 * 32; u += nb) {
        const int e = u / (34 * 32), rem = u % (34 * 32), pm = rem >> 5, pn = rem & 31;
        EpiAct epi{P.act + (size_t)e * SLOTS_PAD * DEXP};
        const size_t wo = ((size_t)l * NEXP + e) * DM * DEXP;
        naive_tile<EpiAct, true>(P.H, P.rowidx + e * SLOTS_PAD, DM, P.w_gate + wo, P.w_up + wo, DEXP, DM, pm * 128, pn * 64, epi, lds);
    }
}
__device__ void phase_down_naive(const Params& P, int l, int bid, int nb, float* lds) {
    for (int u = bid; u < 16 * 34 * 16; u += nb) {
        const int e = u / (34 * 16), rem = u % (34 * 16), pm = rem >> 4, pn = rem & 15;
        EpiY epi{P.yslot + (size_t)e * SLOTS_PAD * DM};
        const size_t wo = ((size_t)l * NEXP + e) * DEXP * DM;
        naive_tile<EpiY, false>(P.act + (size_t)e * SLOTS_PAD * DEXP, nullptr, DEXP, P.w_down + wo, nullptr, DM, DEXP, pm * 128, pn * 64, epi, lds);
    }
}

__device__ void phase_qkn(const Params& P, int l, int bid, int nb) {
    const int j = l >> 1, wid = threadIdx.x >> 6, lane = threadIdx.x & 63;
    const float* qn = P.q_norm + j * 64; const float* kn = P.k_norm + j * 64;
    for (int r = bid * 8 + wid; r < MROWS; r += nb * 8) {
        const bool lat = r < NLAT;
        const int t = r & (SEQ - 1), prow = t >> 6, pcol = t & 63;
        {
            f16* qp = P.Q + (size_t)r * 1024 + lane * 16;
            const f16x8 a = *(const f16x8*)qp, b = *(const f16x8*)(qp + 8);
            float v[16];
#pragma unroll
            for (int i = 0; i < 8; ++i) { v[i] = (float)a[i]; v[8 + i] = (float)b[i]; }
            float ss = 0.f;
#pragma unroll
            for (int i = 0; i < 16; ++i) ss += v[i] * v[i];
            ss += __shfl_xor(ss, 1); ss += __shfl_xor(ss, 2);
            const float rstd = rsqrtf(ss * (1.0f / 64.0f) + 1e-6f);
            const int e0 = (lane & 3) * 16;
#pragma unroll
            for (int i = 0; i < 16; ++i) v[i] = v[i] * rstd * qn[e0 + i];
            if (lat) {
                const int pos = (lane & 2) ? pcol : prow; const int f0 = (lane & 1) * 8;
                const float* tb = P.rope + (size_t)(pos * 16 + f0) * 2;
#pragma unroll
                for (int i = 0; i < 8; ++i) { const float cs = tb[2 * i], sn = tb[2 * i + 1]; const float x0 = v[2 * i], x1 = v[2 * i + 1]; v[2 * i] = x0 * cs - x1 * sn; v[2 * i + 1] = x0 * sn + x1 * cs; }
            }
            const float qs = 0.125f * 1.4426950408889634f;
            f16x8 oa, ob;
#pragma unroll
            for (int i = 0; i < 8; ++i) { oa[i] = (f16)(v[i] * qs); ob[i] = (f16)(v[8 + i] * qs); }
            *(f16x8*)qp = oa; *(f16x8*)(qp + 8) = ob;
        }
        {
            f16* kp = P.Kb + (size_t)r * 256 + lane * 4;
            const f16x4 a = *(const f16x4*)kp;
            float v[4] = {(float)a[0], (float)a[1], (float)a[2], (float)a[3]};
            float ss = v[0] * v[0] + v[1] * v[1] + v[2] * v[2] + v[3] * v[3];
            ss += __shfl_xor(ss, 1); ss += __shfl_xor(ss, 2); ss += __shfl_xor(ss, 4); ss += __shfl_xor(ss, 8);
            const float rstd = rsqrtf(ss * (1.0f / 64.0f) + 1e-6f);
            const int e0 = (lane & 15) * 4;
#pragma unroll
            for (int i = 0; i < 4; ++i) v[i] = v[i] * rstd * kn[e0 + i];
            if (lat) {
                const int pr = e0 >> 1;
                const int pos = pr >= 16 ? pcol : prow; const int f0 = pr & 15;
                const float* tb = P.rope + (size_t)(pos * 16 + f0) * 2;
#pragma unroll
                for (int i = 0; i < 2; ++i) { const float cs = tb[2 * i], sn = tb[2 * i + 1]; const float x0 = v[2 * i], x1 = v[2 * i + 1]; v[2 * i] = x0 * cs - x1 * sn; v[2 * i + 1] = x0 * sn + x1 * cs; }
            }
            *(f16x4*)kp = (f16x4){(f16)v[0], (f16)v[1], (f16)v[2], (f16)v[3]};
        }
    }
}

__device__ void phase_attn_naive(const Params& P, int l, int bid, int nb) {
    const int j = l >> 1;
    for (int idx = bid * NTHR + threadIdx.x; idx < MROWS * 16; idx += nb * NTHR) {
        const int h = idx / MROWS, r = idx % MROWS, kv = h >> 2;
        int b, s0, L, t; bool lat = r < NLAT;
        if (lat) { b = r >> 14; s0 = b << 14; L = SEQ; t = r - s0; } else { b = (r - NLAT) >> 8; s0 = NLAT + (b << 8); L = CTXL; t = r - s0; }
        float q[64], o[64];
        const f16* qp = P.Q + (size_t)r * 1024 + h * 64;
#pragma unroll
        for (int i = 0; i < 64; ++i) { q[i] = (float)qp[i]; o[i] = 0.f; }
        float m = P.sink[j * 16 + h] * 1.4426950408889634f, den = 1.0f;
        const int nloc = lat ? 257 : 0;
        const int cbase = NLAT + b * CTXL;
        for (int it = 0; it < nloc + CTXL; ++it) {
            int kr;
            if (it < nloc) { const int kj = t - 128 + it; if (kj < 0 || kj >= L) continue; kr = s0 + kj; } else kr = cbase + (it - nloc);
            const f16* kp = P.Kb + (size_t)kr * 256 + kv * 64;
            float s = 0.f;
#pragma unroll
            for (int i = 0; i < 64; ++i) s += q[i] * (float)kp[i];
            const float mn = fmaxf(m, s), corr = exp2f(m - mn), p = exp2f(s - mn);
            den = den * corr + p; m = mn;
            const f16* vp = P.Vb + (size_t)kr * 256 + kv * 64;
#pragma unroll
            for (int i = 0; i < 64; ++i) o[i] = o[i] * corr + p * (float)vp[i];
        }
        const float inv = 1.0f / den;
        f16* op = P.O + (size_t)r * 1024 + h * 64;
#pragma unroll
        for (int i = 0; i < 64; ++i) op[i] = (f16)(o[i] * inv);
    }
}

#define LAS __attribute__((address_space(3)))
namespace fg {
constexpr int BM = 256, BK = 64, HALF = 128, HTB = HALF * BK * 2, STAGE_BYTES = 8 * HTB;
__device__ __forceinline__ int lds_byte(int r, int c) { const int st = (r >> 4) * 2 + (c >> 5), rr = r & 15, cc = c & 31, ob = rr * 64 + cc * 2; return st * 1024 + (ob ^ (((ob >> 9) & 1) << 5)); }
__device__ __forceinline__ void stage_rc(int b, int& R, int& C) { const int st = b / 1024, sb = b % 1024, swz = sb ^ (((sb >> 9) & 1) << 5); R = (st >> 1) * 16 + swz / 64; C = (st & 1) * 32 + (swz % 64) / 2; }
__device__ __forceinline__ int perm32(int rho) { const int n = rho >> 4, i = rho & 15; return 8 * (i >> 2) + 4 * n + (i & 3); }
struct Unit { int e, pm, pn; };
__device__ __forceinline__ void xcd_order(int i, int& T) { const int c = blockIdx.x; T = i * (int)gridDim.x + c; }

template <class PR>
__device__ __forceinline__ void gemm_phase(LAS unsigned char* lds, const PR& S) {
    const int tid = threadIdx.x, wid = __builtin_amdgcn_readfirstlane(tid >> 6), lane = tid & 63, wr = wid >> 2, wc = wid & 3, fr = lane & 15, fq = lane >> 4;
    constexpr int K = PR::K, nt = K / BK;
    int Rr[2], Cc[2]; unsigned voffB[2];
#pragma unroll
    for (int i = 0; i < 2; ++i) { int R, C; stage_rc(tid * 16 + i * 8192, R, C); Rr[i] = R; Cc[i] = C; const int Rb = (R & ~31) + perm32(R & 31); voffB[i] = (unsigned)(Rb * PR::LDB + C) * 2u; }
    const size_t kstep = (size_t)(BK * 2);
    const size_t hB = S.hstepB();
    const unsigned ldsw = (unsigned)wid * 1024u;
    const int aoff = lds_byte(wr * 64 + fr, fq * 8), boff = lds_byte(wc * 32 + fr, fq * 8);
#define FG_SA(b, h) (((b) * 2 + (h)) * HTB)
#define FG_SB(b, h) ((4 + (b) * 2 + (h)) * HTB)
#define FG_STAGE(bufoff, gbase, voff) do { _Pragma("unroll") for (int _i = 0; _i < 2; ++_i) \
        __builtin_amdgcn_global_load_lds((const unsigned*)((const char*)(gbase) + (voff)[_i]), (LAS unsigned*)(lds + (bufoff) + ldsw + _i * 8192), 16, 0, 0); } while (0)
#define FG_LDA(dst, b, h) do { _Pragma("unroll") for (int m = 0; m < 4; ++m) _Pragma("unroll") for (int k = 0; k < 2; ++k) dst[m][k] = *(const LAS f16x8*)(lds + FG_SA(b, h) + aoff + m * 2048 + k * 1024); } while (0)
#define FG_LDB(dst, b, h) do { _Pragma("unroll") for (int n = 0; n < 2; ++n) _Pragma("unroll") for (int k = 0; k < 2; ++k) dst[n][k] = *(const LAS f16x8*)(lds + FG_SB(b, h) + boff + n * 2048 + k * 1024); } while (0)
#define FG_MMA(ai, bj, At, Bt) do { __builtin_amdgcn_s_setprio(1); _Pragma("unroll") for (int m = 0; m < 4; ++m) _Pragma("unroll") for (int n = 0; n < 2; ++n) _Pragma("unroll") for (int k = 0; k < 2; ++k) \
        acc[ai][bj][m][n] = __builtin_amdgcn_mfma_f32_16x16x32_f16(Bt[n][k], At[m][k], acc[ai][bj][m][n], 0, 0, 0); __builtin_amdgcn_s_setprio(0); } while (0)
#define FG_WAIT_V(n) asm volatile("s_waitcnt vmcnt(" #n ")" ::: "memory")
#define FG_WAIT_L(n) asm volatile("s_waitcnt lgkmcnt(" #n ")" ::: "memory")
#define FG_BAR __builtin_amdgcn_s_barrier()
#define FG_SCHED __builtin_amdgcn_sched_barrier(0)
    Unit cur, nxt; int ui = 0;
    if (!S.next(0, cur)) return;
    f32x4 acc[2][2][4][2];
#pragma unroll
    for (int a = 0; a < 2; ++a)
#pragma unroll
        for (int b = 0; b < 2; ++b)
#pragma unroll
            for (int m = 0; m < 4; ++m)
#pragma unroll
                for (int n = 0; n < 2; ++n) acc[a][b][m][n] = (f32x4){0.f, 0.f, 0.f, 0.f};
    f16x8 At[4][2], B0[2][2], B1[2][2];
    unsigned vA[2][2], vN[2][2];
    S.a_voff(cur, Rr, Cc, vA);
#pragma unroll
    for (int h = 0; h < 2; ++h)
#pragma unroll
        for (int i = 0; i < 2; ++i) { asm volatile("" : "+v"(vA[h][i])); vN[h][i] = vA[h][i]; }
    const char* cA = S.a_base(cur); const char* cB = S.b_base(cur);
    FG_STAGE(FG_SB(0, 0), cB, voffB); FG_STAGE(FG_SA(0, 0), cA, vA[0]); FG_STAGE(FG_SB(0, 1), cB + hB, voffB); FG_STAGE(FG_SA(0, 1), cA, vA[1]);
    if (wr == 1) FG_BAR;
    FG_WAIT_V(4); FG_BAR;
    FG_STAGE(FG_SB(1, 0), cB + kstep, voffB); FG_STAGE(FG_SA(1, 0), cA + kstep, vA[0]); FG_STAGE(FG_SB(1, 1), cB + hB + kstep, voffB);
    FG_WAIT_V(6); FG_BAR;
    for (;;) {
        const bool has_next = S.next(ui + 1, nxt);
        const char* nA = has_next ? S.a_base(nxt) : cA; const char* nB = has_next ? S.b_base(nxt) : cB;
        if (has_next) { S.a_voff(nxt, Rr, Cc, vN);
#pragma unroll
            for (int h = 0; h < 2; ++h)
#pragma unroll
                for (int i = 0; i < 2; ++i) asm volatile("" : "+v"(vN[h][i])); }
        for (int t = 0; t < nt; t += 2) {
            const bool last = (t == nt - 2);
            const char* a1 = cA + (size_t)(t + 1) * kstep;
            const char* a2 = last ? nA : cA + (size_t)(t + 2) * kstep; const char* b2 = last ? nB : cB + (size_t)(t + 2) * kstep;
            const char* a3 = a2 + kstep; const char* b3 = b2 + kstep;
            unsigned v2[2][2];
#pragma unroll
            for (int h = 0; h < 2; ++h)
#pragma unroll
                for (int i = 0; i < 2; ++i) v2[h][i] = last ? vN[h][i] : vA[h][i];
            FG_LDB(B0, 0, 0); FG_SCHED; FG_LDA(At, 0, 0); FG_STAGE(FG_SA(1, 1), a1, vA[1]);
            FG_WAIT_L(8); FG_BAR; FG_WAIT_L(0); FG_MMA(0, 0, At, B0); FG_BAR; FG_SCHED;
            FG_LDB(B1, 0, 1); FG_STAGE(FG_SB(0, 0), b2, voffB);
            FG_BAR; FG_WAIT_L(0); FG_MMA(0, 1, At, B1); FG_BAR;
            FG_LDA(At, 0, 1); FG_STAGE(FG_SA(0, 0), a2, v2[0]);
            FG_BAR; FG_WAIT_L(0); FG_MMA(1, 0, At, B0); FG_BAR; FG_SCHED;
            FG_STAGE(FG_SB(0, 1), b2 + hB, voffB);
            FG_WAIT_V(6); FG_BAR; FG_MMA(1, 1, At, B1); FG_BAR;
            FG_LDB(B0, 1, 0); FG_SCHED; FG_LDA(At, 1, 0); FG_STAGE(FG_SA(0, 1), a2, v2[1]);
            FG_WAIT_L(8); FG_BAR; FG_WAIT_L(0); FG_MMA(0, 0, At, B0); FG_BAR; FG_SCHED;
            FG_LDB(B1, 1, 1); FG_STAGE(FG_SB(1, 0), b3, voffB);
            FG_BAR; FG_WAIT_L(0); FG_MMA(0, 1, At, B1); FG_BAR;
            FG_LDA(At, 1, 1); FG_STAGE(FG_SA(1, 0), a3, v2[0]);
            FG_BAR; FG_WAIT_L(0); FG_MMA(1, 0, At, B0); FG_BAR; FG_SCHED;
            FG_STAGE(FG_SB(1, 1), b3 + hB, voffB);
            FG_WAIT_V(6); FG_BAR; FG_MMA(1, 1, At, B1); FG_BAR;
        }
        S.epi(acc, cur, wr, wc, fr, fq);
        if (!has_next) break;
#pragma unroll
        for (int a = 0; a < 2; ++a)
#pragma unroll
            for (int b = 0; b < 2; ++b)
#pragma unroll
                for (int m = 0; m < 4; ++m)
#pragma unroll
                    for (int n = 0; n < 2; ++n) acc[a][b][m][n] = (f32x4){0.f, 0.f, 0.f, 0.f};
        cur = nxt; cA = nA; cB = nB; ++ui;
#pragma unroll
        for (int h = 0; h < 2; ++h)
#pragma unroll
            for (int i = 0; i < 2; ++i) vA[h][i] = vN[h][i];
    }
    FG_WAIT_V(0);
    if (wr == 0) FG_BAR;
    FG_BAR;
#undef FG_SA
#undef FG_SB
#undef FG_STAGE
#undef FG_LDA
#undef FG_LDB
#undef FG_MMA
#undef FG_WAIT_V
#undef FG_WAIT_L
#undef FG_BAR
#undef FG_SCHED
}

__device__ __forceinline__ f16x8 pack8(const f32x4 a, const f32x4 b) { return (f16x8){(f16)a[0], (f16)a[1], (f16)a[2], (f16)a[3], (f16)b[0], (f16)b[1], (f16)b[2], (f16)b[3]}; }

template <int K_, int LDA_, int LDB_> struct PRBase {
    static constexpr int K = K_, LDA = LDA_, LDB = LDB_;
    __device__ __forceinline__ void plain_voff(const int (&R)[2], const int (&C)[2], unsigned (&v)[2][2]) const {
#pragma unroll
        for (int h = 0; h < 2; ++h)
#pragma unroll
            for (int i = 0; i < 2; ++i) v[h][i] = (unsigned)((h * HALF + R[i]) * LDA + C[i]) * 2u;
    }
};
struct PRGateUp : PRBase<1024, 1024, 1024> {
    const f16* H; const int* rowidx; const f16* W; f16* act; int nunits;
    __device__ __forceinline__ size_t hstepB() const { return (size_t)DEXP * DM * 2; }
    __device__ __forceinline__ bool next(int i, Unit& u) const { const int T = i * (int)gridDim.x + (int)blockIdx.x; if (T >= nunits) return false; u.e = T / 272; const int t = T % 272; u.pm = t >> 4; u.pn = t & 15; return true; }
    __device__ __forceinline__ const char* a_base(const Unit&) const { return (const char*)H; }
    __device__ __forceinline__ void a_voff(const Unit& u, const int (&R)[2], const int (&C)[2], unsigned (&v)[2][2]) const {
        const int* ri = rowidx + u.e * SLOTS_PAD + u.pm * BM;
#pragma unroll
        for (int h = 0; h < 2; ++h)
#pragma unroll
            for (int i = 0; i < 2; ++i) { const int g = ri[h * HALF + R[i]]; v[h][i] = (unsigned)(g * LDA + C[i]) * 2u; }
    }
    __device__ __forceinline__ const char* b_base(const Unit& u) const { return (const char*)(W + ((size_t)u.e * 2 * DEXP + (size_t)u.pn * HALF) * DM); }
    __device__ __forceinline__ void epi(const f32x4 (&acc)[2][2][4][2], const Unit& u, int wr, int wc, int fr, int fq) const {
        f16* base = act + ((size_t)u.e * SLOTS_PAD + (size_t)u.pm * BM + wr * 64 + fr) * DEXP + u.pn * HALF + wc * 32 + fq * 8;
#pragma unroll
        for (int ai = 0; ai < 2; ++ai)
#pragma unroll
            for (int m = 0; m < 4; ++m) {
                f32x4 o0, o1;
#pragma unroll
                for (int j = 0; j < 4; ++j) { o0[j] = silu_f(acc[ai][0][m][0][j]) * acc[ai][1][m][0][j]; o1[j] = silu_f(acc[ai][0][m][1][j]) * acc[ai][1][m][1][j]; }
                *(f16x8*)(base + (size_t)(ai * HALF + m * 16) * DEXP) = pack8(o0, o1);
            }
    }
};
struct PRDown : PRBase<2048, 2048, 2048> {
    const f16* act; const f16* W; f16* y; int nunits;
    __device__ __forceinline__ size_t hstepB() const { return (size_t)HALF * DEXP * 2; }
    __device__ __forceinline__ bool next(int i, Unit& u) const { const int T = i * (int)gridDim.x + (int)blockIdx.x; if (T >= nunits) return false; u.e = T / 68; const int t = T % 68; u.pm = t >> 2; u.pn = t & 3; return true; }
    __device__ __forceinline__ const char* a_base(const Unit& u) const { return (const char*)(act + ((size_t)u.e * SLOTS_PAD + (size_t)u.pm * BM) * DEXP); }
    __device__ __forceinline__ void a_voff(const Unit&, const int (&R)[2], const int (&C)[2], unsigned (&v)[2][2]) const { plain_voff(R, C, v); }
    __device__ __forceinline__ const char* b_base(const Unit& u) const { return (const char*)(W + ((size_t)u.e * DM + (size_t)u.pn * BM) * DEXP); }
    __device__ __forceinline__ void epi(const f32x4 (&acc)[2][2][4][2], const Unit& u, int wr, int wc, int fr, int fq) const {
        f16* base = y + ((size_t)u.e * SLOTS_PAD + (size_t)u.pm * BM + wr * 64 + fr) * DM + u.pn * BM + wc * 32 + fq * 8;
#pragma unroll
        for (int ai = 0; ai < 2; ++ai)
#pragma unroll
            for (int m = 0; m < 4; ++m)
#pragma unroll
                for (int bj = 0; bj < 2; ++bj) *(f16x8*)(base + (size_t)(ai * HALF + m * 16) * DM + bj * HALF) = pack8(acc[ai][bj][m][0], acc[ai][bj][m][1]);
    }
};
template <int K_> struct PRDense : PRBase<K_, 1024, K_> {
    const f16* A; const f16* W; f16* O0; f16* O1; f16* O2; int ncol; int mode;
    __device__ __forceinline__ size_t hstepB() const { return (size_t)HALF * K_ * 2; }
    __device__ __forceinline__ bool next(int i, Unit& u) const { const int T = i * (int)gridDim.x + (int)blockIdx.x; if (T >= 130 * ncol) return false; u.e = 0; u.pm = T / ncol; u.pn = T % ncol; return true; }
    __device__ __forceinline__ const char* a_base(const Unit& u) const { return (const char*)(A + (size_t)u.pm * BM * 1024 + (mode == 2 ? u.pn * 256 : 0)); }
    __device__ __forceinline__ void a_voff(const Unit&, const int (&R)[2], const int (&C)[2], unsigned (&v)[2][2]) const { this->plain_voff(R, C, v); }
    __device__ __forceinline__ const char* b_base(const Unit& u) const { return (const char*)(W + (size_t)u.pn * BM * K_); }
    __device__ __forceinline__ void epi(const f32x4 (&acc)[2][2][4][2], const Unit& u, int wr, int wc, int fr, int fq) const {
        f16* base; int ld;
        const int row = u.pm * BM + wr * 64 + fr, colw = wc * 32 + fq * 8;
        if (mode == 1) { if (u.pn < 4) { base = O0 + (size_t)row * 1024 + u.pn * BM + colw; ld = 1024; } else if (u.pn == 4) { base = O1 + (size_t)row * 256 + colw; ld = 256; } else { base = O2 + (size_t)row * 256 + colw; ld = 256; } }
        else { base = O0 + (size_t)row * 1024 + u.pn * BM + colw; ld = 1024; }
#pragma unroll
        for (int ai = 0; ai < 2; ++ai)
#pragma unroll
            for (int m = 0; m < 4; ++m)
#pragma unroll
                for (int bj = 0; bj < 2; ++bj) *(f16x8*)(base + (size_t)(ai * HALF + m * 16) * ld + bj * HALF) = pack8(acc[ai][bj][m][0], acc[ai][bj][m][1]);
    }
};
}

__device__ __forceinline__ void cvt_tile(const float* src, f16* dst, int K, int N, int k0, int n0, f16* tile  ) {
    const int tid = threadIdx.x;
#pragma unroll
    for (int p = 0; p < 2; ++p) { const int id = tid + p * NTHR, kr = id >> 4, c4 = (id & 15) * 4;
        const f32x4 v = *(const f32x4*)(src + (size_t)(k0 + kr) * N + n0 + c4);
        *(f16x4*)(tile + kr * 72 + c4) = (f16x4){(f16)v[0], (f16)v[1], (f16)v[2], (f16)v[3]}; }
    __syncthreads();
    { const int n = tid >> 3, kg = (tid & 7) * 8; f16x8 o;
#pragma unroll
      for (int i = 0; i < 8; ++i) o[i] = tile[(kg + i) * 72 + n];
      *(f16x8*)(dst + (size_t)(n0 + n) * K + k0 + kg) = o; }
    __syncthreads();
}
__device__ void phase_convert(const Params& P, int l, int bid, int nb, f16* tile) {
    const int j = l >> 1;
    const int nexp_tiles = NEXP * 3 * 512;
    int nmix;
    if ((l & 1) == 0) nmix = 64; else nmix = 640;
    for (int u = bid; u < nexp_tiles + nmix; u += nb) {
        if (u < nexp_tiles) {
            const int e = u / 1536, r = u % 1536, which = r / 512, t = r % 512;
            if (which < 2) { const float* src = (which == 0 ? P.w_gate : P.w_up) + ((size_t)l * NEXP + e) * DM * DEXP; f16* dst = P.Wgu + ((size_t)e * 2 + which) * DEXP * DM;
                cvt_tile(src, dst, DM, DEXP, (t >> 5) * 64, (t & 31) * 64, tile); }
            else { const float* src = P.w_down + ((size_t)l * NEXP + e) * DEXP * DM; f16* dst = P.Wd + (size_t)e * DM * DEXP;
                cvt_tile(src, dst, DEXP, DM, (t >> 4) * 64, (t & 15) * 64, tile); }
        } else {
            const int t = u - nexp_tiles;
            if ((l & 1) == 0) { const int g = t >> 4, tt = t & 15; cvt_tile(P.pool_w + (size_t)(j * 4 + g) * 65536, P.Wmix + (size_t)g * 65536, 256, 256, (tt >> 2) * 64, (tt & 3) * 64, tile); }
            else if (t < 384) cvt_tile(P.w_qkv + (size_t)j * DM * QKVD, P.Wmix, DM, QKVD, (t / 24) * 64, (t % 24) * 64, tile);
            else { const int tt = t - 384; cvt_tile(P.w_o + (size_t)j * DM * DM, P.Wmix + (size_t)QKVD * DM, DM, DM, (tt >> 4) * 64, (tt & 15) * 64, tile); }
        }
    }
}
__device__ void phase_gateup_fast(const Params& P, LAS unsigned char* lds) { fg::PRGateUp S; S.H = P.H; S.rowidx = P.rowidx; S.W = P.Wgu; S.act = P.act; S.nunits = 16 * 272; fg::gemm_phase(lds, S); }
__device__ void phase_down_fast(const Params& P, LAS unsigned char* lds) { fg::PRDown S; S.act = P.act; S.W = P.Wd; S.y = P.yslot; S.nunits = 16 * 68; fg::gemm_phase(lds, S); }
__device__ void phase_pool_fast(const Params& P, LAS unsigned char* lds) { fg::PRDense<256> S; S.A = P.H; S.W = P.Wmix; S.O0 = P.Z; S.O1 = nullptr; S.O2 = nullptr; S.ncol = 4; S.mode = 2; fg::gemm_phase(lds, S); }
__device__ void phase_qkv_fast(const Params& P, LAS unsigned char* lds) { fg::PRDense<1024> S; S.A = P.H; S.W = P.Wmix; S.O0 = P.Q; S.O1 = P.Kb; S.O2 = P.Vb; S.ncol = 6; S.mode = 1; fg::gemm_phase(lds, S); }
__device__ void phase_oproj_fast(const Params& P, LAS unsigned char* lds) { fg::PRDense<1024> S; S.A = P.O; S.W = P.Wmix + (size_t)QKVD * DM; S.O0 = P.Z; S.O1 = nullptr; S.O2 = nullptr; S.ncol = 4; S.mode = 0; fg::gemm_phase(lds, S); }

typedef float f32x16 __attribute__((ext_vector_type(16)));
#define AT_KB 9216
#define AT_VB 8704
__device__ void phase_attn_fast(const Params& P, int l, LAS unsigned char* lds, bool do_ctx) {
    const int j = l >> 1;
    const int tid = threadIdx.x, wid = tid >> 6, lane = tid & 63, l32 = lane & 31, hi = lane >> 5;
    const int g = wid >> 1, qoff = (wid & 1) * 64;
    const int nunits = do_ctx ? 1040 : 1024;
    for (int u = blockIdx.x; u < nunits; u += gridDim.x) {
        int b, qblk, kv, qrow0, t0, t1, s0;
        if (u < 1024) { b = u >> 9; qblk = (u >> 2) & 127; kv = u & 3; s0 = b * SEQ; qrow0 = s0 + qblk * 128; t0 = qblk == 0 ? 2 : 0; t1 = qblk == 127 ? 4 : 6; }
        else { const int uu = u - 1024; b = uu >> 3; qblk = (uu >> 2) & 1; kv = uu & 3; s0 = NLAT + b * CTXL; qrow0 = s0 + qblk * 128; t0 = 0; t1 = 0; }
        const int cb = NLAT + b * CTXL, nloc = t1 - t0, ntiles = nloc + 4;
        const int h = kv * 4 + g;
        f16x8 Qf[2][4];
#pragma unroll
        for (int qb = 0; qb < 2; ++qb)
#pragma unroll
            for (int ks = 0; ks < 4; ++ks) Qf[qb][ks] = *(const f16x8*)(P.Q + (size_t)(qrow0 + qoff + 32 * qb + l32) * 1024 + h * 64 + 16 * ks + 8 * hi);
        f32x16 OT[2][2];
#pragma unroll
        for (int db = 0; db < 2; ++db)
#pragma unroll
            for (int qb = 0; qb < 2; ++qb)
#pragma unroll
                for (int r = 0; r < 16; ++r) OT[db][qb][r] = 0.f;
        float mrun[2], lrun[2];
        { const float sk = P.sink[j * 16 + h] * 1.4426950408889634f; mrun[0] = sk; mrun[1] = sk; lrun[0] = hi == 0 ? 1.0f : 0.0f; lrun[1] = lrun[0]; }
        const int lkey = tid >> 3, lpc = tid & 7;
        f16x8 kreg, vreg;
        auto tile_row = [&](int it) -> int { return it < nloc ? (qrow0 - 128 + 64 * (t0 + it)) : (cb + 64 * (it - nloc)); };
        { const int kr = tile_row(0) + lkey; kreg = *(const f16x8*)(P.Kb + (size_t)kr * 256 + kv * 64 + lpc * 8); vreg = *(const f16x8*)(P.Vb + (size_t)kr * 256 + kv * 64 + lpc * 8); }
        __syncthreads();
        {
            LAS f16* Kl = (LAS f16*)(lds); LAS f16* Vl = (LAS f16*)(lds + 2 * AT_KB);
            *(LAS f16x8*)(Kl + lkey * 72 + lpc * 8) = kreg;
#pragma unroll
            for (int i = 0; i < 8; ++i) Vl[(lpc * 8 + i) * 68 + lkey] = vreg[i];
        }
        __syncthreads();
        for (int it = 0; it < ntiles; ++it) {
            const int buf = it & 1;
            if (it + 1 < ntiles) { const int kr = tile_row(it + 1) + lkey; kreg = *(const f16x8*)(P.Kb + (size_t)kr * 256 + kv * 64 + lpc * 8); vreg = *(const f16x8*)(P.Vb + (size_t)kr * 256 + kv * 64 + lpc * 8); }
            const LAS f16* Kl = (const LAS f16*)(lds + buf * AT_KB); const LAS f16* Vl = (const LAS f16*)(lds + 2 * AT_KB + buf * AT_VB);
            f32x16 S[2][2];
#pragma unroll
            for (int kb = 0; kb < 2; ++kb)
#pragma unroll
                for (int qb = 0; qb < 2; ++qb)
#pragma unroll
                    for (int r = 0; r < 16; ++r) S[kb][qb][r] = 0.f;
#pragma unroll
            for (int ks = 0; ks < 4; ++ks)
#pragma unroll
                for (int kb = 0; kb < 2; ++kb) {
                    const f16x8 kf = *(const LAS f16x8*)(Kl + (32 * kb + l32) * 72 + 16 * ks + 8 * hi);
#pragma unroll
                    for (int qb = 0; qb < 2; ++qb) S[kb][qb] = __builtin_amdgcn_mfma_f32_32x32x16_f16(kf, Qf[qb][ks], S[kb][qb], 0, 0, 0);
                }
            if (it < nloc) {
                const int kt = 64 * (t0 + it);
#pragma unroll
                for (int qb = 0; qb < 2; ++qb) {
                    const int qp = 128 + qoff + 32 * qb + l32;
#pragma unroll
                    for (int kb = 0; kb < 2; ++kb)
#pragma unroll
                        for (int r = 0; r < 16; ++r) { const int kp = kt + 32 * kb + 8 * (r >> 2) + 4 * hi + (r & 3); const int d = qp - kp; if (d > 128 || d < -128) S[kb][qb][r] = -INFINITY; }
                }
            }
            f16x8 Pf[2][4];
#pragma unroll
            for (int qb = 0; qb < 2; ++qb) {
                float mx = S[0][qb][0];
#pragma unroll
                for (int kb = 0; kb < 2; ++kb)
#pragma unroll
                    for (int r = 0; r < 16; ++r) mx = fmaxf(mx, S[kb][qb][r]);
                mx = fmaxf(mx, __shfl_xor(mx, 32));
                const float mn = fmaxf(mrun[qb], mx), corr = __builtin_amdgcn_exp2f(mrun[qb] - mn);
                mrun[qb] = mn;
                float ps = 0.f;
#pragma unroll
                for (int kb = 0; kb < 2; ++kb)
#pragma unroll
                    for (int r = 0; r < 16; ++r) { const float p = __builtin_amdgcn_exp2f(S[kb][qb][r] - mn); S[kb][qb][r] = p; ps += p; }
                lrun[qb] = lrun[qb] * corr + ps;
#pragma unroll
                for (int db = 0; db < 2; ++db)
#pragma unroll
                    for (int r = 0; r < 16; ++r) OT[db][qb][r] *= corr;
#pragma unroll
                for (int ks = 0; ks < 4; ++ks) { const int kb = ks >> 1, r0 = 8 * (ks & 1);
#pragma unroll
                    for (int e = 0; e < 8; ++e) Pf[qb][ks][e] = (f16)S[kb][qb][r0 + e]; }
            }
#pragma unroll
            for (int ks = 0; ks < 4; ++ks)
#pragma unroll
                for (int db = 0; db < 2; ++db) {
                    const LAS f16* vp = Vl + (32 * db + l32) * 68 + 16 * ks + 4 * hi;
                    const f16x4 v0 = *(const LAS f16x4*)vp, v1 = *(const LAS f16x4*)(vp + 8);
                    const f16x8 vf = (f16x8){v0[0], v0[1], v0[2], v0[3], v1[0], v1[1], v1[2], v1[3]};
#pragma unroll
                    for (int qb = 0; qb < 2; ++qb) OT[db][qb] = __builtin_amdgcn_mfma_f32_32x32x16_f16(vf, Pf[qb][ks], OT[db][qb], 0, 0, 0);
                }
            if (it + 1 < ntiles) {
                LAS f16* Kw = (LAS f16*)(lds + (buf ^ 1) * AT_KB); LAS f16* Vw = (LAS f16*)(lds + 2 * AT_KB + (buf ^ 1) * AT_VB);
                *(LAS f16x8*)(Kw + lkey * 72 + lpc * 8) = kreg;
#pragma unroll
                for (int i = 0; i < 8; ++i) Vw[(lpc * 8 + i) * 68 + lkey] = vreg[i];
            }
            __syncthreads();
        }
#pragma unroll
        for (int qb = 0; qb < 2; ++qb) {
            const float lt = lrun[qb] + __shfl_xor(lrun[qb], 32);
            const float inv = 1.0f / lt;
            f16* op = P.O + (size_t)(qrow0 + qoff + 32 * qb + l32) * 1024 + h * 64;
#pragma unroll
            for (int db = 0; db < 2; ++db)
#pragma unroll
                for (int i = 0; i < 4; ++i) {
                    const f16x4 o = (f16x4){(f16)(OT[db][qb][4 * i] * inv), (f16)(OT[db][qb][4 * i + 1] * inv), (f16)(OT[db][qb][4 * i + 2] * inv), (f16)(OT[db][qb][4 * i + 3] * inv)};
                    *(f16x4*)(op + 32 * db + 8 * i + 4 * hi) = o;
                }
        }
    }
}

enum { PH_ADA, PH_N1F, PH_N1, PH_FINAL, PH_N2P, PH_N2A, PH_TOPK, PH_POOLG, PH_QKVG, PH_QKN, PH_ATTN, PH_OPROJ, PH_GATEUP, PH_DOWN, PH_CVT, PH_GATEUP_F, PH_DOWN_F, PH_POOL_F, PH_QKV_F, PH_OPROJ_F, PH_ATTN_F };
template <int PH> __global__ __launch_bounds__(NTHR, 2) void k_ph(Params P, int l) {
    extern __shared__ __attribute__((aligned(16))) unsigned char shm[];
    const int bid = blockIdx.x, nb = gridDim.x;
    if (PH == PH_ADA) phase_ada(P, bid, nb, (float*)shm);
    if (PH == PH_N1F) phase_n1<true, false>(P, l, bid, nb);
    if (PH == PH_N1) phase_n1<false, false>(P, l, bid, nb);
    if (PH == PH_FINAL) phase_n1<false, true>(P, l, bid, nb);
    if (PH == PH_N2P) phase_n2<true>(P, l, bid, nb, (float*)shm);
    if (PH == PH_N2A) phase_n2<false>(P, l, bid, nb, (float*)shm);
    if (PH == PH_TOPK) phase_topk(P, bid, nb, (unsigned*)shm);
    if (PH == PH_POOLG) phase_poolgemm_naive(P, l, bid, nb, (float*)shm);
    if (PH == PH_QKVG) phase_qkvgemm_naive(P, l, bid, nb, (float*)shm);
    if (PH == PH_QKN) phase_qkn(P, l, bid, nb);
    if (PH == PH_ATTN) phase_attn_naive(P, l, bid, nb);
    if (PH == PH_OPROJ) phase_oproj_naive(P, l, bid, nb, (float*)shm);
    if (PH == PH_GATEUP) phase_gateup_naive(P, l, bid, nb, (float*)shm);
    if (PH == PH_DOWN) phase_down_naive(P, l, bid, nb, (float*)shm);
    if (PH == PH_CVT) phase_convert(P, l, bid, nb, (f16*)shm);
    if (PH == PH_GATEUP_F) phase_gateup_fast(P, (LAS unsigned char*)shm);
    if (PH == PH_DOWN_F) phase_down_fast(P, (LAS unsigned char*)shm);
    if (PH == PH_POOL_F) phase_pool_fast(P, (LAS unsigned char*)shm);
    if (PH == PH_QKV_F) phase_qkv_fast(P, (LAS unsigned char*)shm);
    if (PH == PH_OPROJ_F) phase_oproj_fast(P, (LAS unsigned char*)shm);
    if (PH == PH_ATTN_F) phase_attn_fast(P, l, (LAS unsigned char*)shm, true);
}

static inline size_t al256(size_t v) { return (v + 255) & ~(size_t)255; }

extern "C" void kernel_launch(void* const* d_in, const int* in_sizes, int n_in, void* d_out, int out_size, void* d_ws, size_t ws_size, hipStream_t stream) {
    Params P{};
    P.x = (const float*)d_in[0]; P.c = (const float*)d_in[1]; P.ctx = (const float*)d_in[2]; P.c_ctx = (const float*)d_in[3];
    P.w_ada = (const float*)d_in[4]; P.b_ada = (const float*)d_in[5]; P.norm1_g = (const float*)d_in[6]; P.norm2_g = (const float*)d_in[7];
    P.pool_w = (const float*)d_in[8]; P.pool_scale = (const float*)d_in[9]; P.w_qkv = (const float*)d_in[10]; P.w_o = (const float*)d_in[11];
    P.q_norm = (const float*)d_in[12]; P.k_norm = (const float*)d_in[13]; P.sink = (const float*)d_in[14]; P.router_w = (const float*)d_in[15];
    P.w_gate = (const float*)d_in[16]; P.w_up = (const float*)d_in[17]; P.w_down = (const float*)d_in[18];
    P.out = (float*)d_out;
    char* w = (char*)d_ws; size_t off = 0;
    auto take = [&](size_t bytes) { char* p = w + off; off = al256(off + bytes); return p; };
    P.bar = (unsigned*)take(16384);
    P.mod = (float*)take((size_t)4 * 3 * 6 * DM * 4);
    P.rope = (float*)take((size_t)256 * 16 * 2 * 4);
    P.X = (float*)take((size_t)MROWS * DM * 4);
    P.H = (f16*)take((size_t)MROWS * DM * 2);
    P.Z = (f16*)take((size_t)MROWS * DM * 2);
    P.Q = (f16*)take((size_t)MROWS * DM * 2);
    P.Kb = (f16*)take((size_t)MROWS * 256 * 2);
    P.Vb = (f16*)take((size_t)MROWS * 256 * 2);
    P.O = (f16*)take((size_t)MROWS * DM * 2);
    P.aff = (float*)take((size_t)MROWS * 16 * 4);
    P.inv = (int*)take((size_t)MROWS * 16 * 4);
    P.rowidx = (int*)take((size_t)NEXP * SLOTS_PAD * 4);
    P.act = (f16*)take((size_t)NEXP * SLOTS_PAD * DEXP * 2);
    P.yslot = (f16*)take((size_t)NEXP * SLOTS_PAD * DM * 2);
    P.Wgu = (f16*)take((size_t)NEXP * 2 * DEXP * DM * 2);
    P.Wd = (f16*)take((size_t)NEXP * DM * DEXP * 2);
    P.Wmix = (f16*)take((size_t)(QKVD + DM) * DM * 2);
    if (off > ws_size) { fprintf(stderr, "workspace too small: need %zu have %zu\n", off, ws_size); return; }
    const int G = 1024;
#ifndef FAST_MOE
#define FAST_MOE 1
#endif
#ifndef FAST_MIX
#define FAST_MIX 1
#endif
#define LAUNCH(PH, L, LDS) hipLaunchKernelGGL((k_ph<PH>), dim3(G), dim3(NTHR), (LDS), stream, P, (L))
#define LAUNCHF(PH, L) do { static bool attr_ = false; if (!attr_) { hipFuncSetAttribute((const void*)k_ph<PH>, hipFuncAttributeMaxDynamicSharedMemorySize, fg::STAGE_BYTES); attr_ = true; } \
        hipLaunchKernelGGL((k_ph<PH>), dim3(256), dim3(NTHR), fg::STAGE_BYTES, stream, P, (L)); } while (0)
    LAUNCH(PH_ADA, 0, 20480);
    for (int l = 0; l < 4; ++l) {
        if (FAST_MOE || FAST_MIX) LAUNCH(PH_CVT, l, 16384);
        if (l == 0) LAUNCH(PH_N1F, l, 0); else LAUNCH(PH_N1, l, 0);
        if ((l & 1) == 0) { if (FAST_MIX) LAUNCHF(PH_POOL_F, l); else LAUNCH(PH_POOLG, l, 16384); LAUNCH(PH_N2P, l, 65536); }
        else { if (FAST_MIX) LAUNCHF(PH_QKV_F, l); else LAUNCH(PH_QKVG, l, 16384); LAUNCH(PH_QKN, l, 0); hipLaunchKernelGGL((k_ph<PH_ATTN_F>), dim3(256), dim3(NTHR), 36864, stream, P, l);
               if (FAST_MIX) LAUNCHF(PH_OPROJ_F, l); else LAUNCH(PH_OPROJ, l, 16384); LAUNCH(PH_N2A, l, 65536); }
        LAUNCH(PH_TOPK, l, 2048);
        if (FAST_MOE) { LAUNCHF(PH_GATEUP_F, l); LAUNCHF(PH_DOWN_F, l); } else { LAUNCH(PH_GATEUP, l, 16384); LAUNCH(PH_DOWN, l, 16384); }
    }
    LAUNCH(PH_FINAL, 4, 0);
#undef LAUNCH
}
```

```cpp
#include <hip/hip_runtime.h>
#include <stdint.h>
#include <stdio.h>

typedef _Float16 f16;
typedef _Float16 f16x2 __attribute__((ext_vector_type(2)));
typedef _Float16 f16x4 __attribute__((ext_vector_type(4)));
typedef _Float16 f16x8 __attribute__((ext_vector_type(8)));
typedef float f32x4 __attribute__((ext_vector_type(4)));
typedef float f32x2 __attribute__((ext_vector_type(2)));

#define LAS __attribute__((address_space(3)))
#define DM 1024
#define SEQ 16384
#define NLAT 32768
#define CTXL 256
#define NCTX 512
#define MROWS 33280
#define NEXP 16
#define DEXP 2048
#define SLOTS 4160
#define SLOTS_PAD 4352
#define QKVD 1536
#define NTHR 512

constexpr size_t al256c(size_t v) { return (v + 255) & ~(size_t)255; }
constexpr size_t OFF_BAR = 0;
constexpr size_t OFF_MOD = al256c(OFF_BAR + 16384);
constexpr size_t OFF_ROPE = al256c(OFF_MOD + (size_t)4 * 3 * 6 * DM * 4);
constexpr size_t OFF_X = al256c(OFF_ROPE + (size_t)256 * 16 * 2 * 4);
constexpr size_t OFF_H = al256c(OFF_X + (size_t)MROWS * DM * 4);
constexpr size_t OFF_Z = al256c(OFF_H + (size_t)MROWS * DM * 2);
constexpr size_t OFF_Q = al256c(OFF_Z + (size_t)MROWS * DM * 2);
constexpr size_t OFF_KB = al256c(OFF_Q + (size_t)MROWS * DM * 2);
constexpr size_t OFF_VB = al256c(OFF_KB + (size_t)MROWS * 256 * 2);
constexpr size_t OFF_VT = al256c(OFF_VB + (size_t)MROWS * 256 * 2);
constexpr size_t OFF_O = al256c(OFF_VT + (size_t)MROWS * 256 * 2);
constexpr size_t OFF_AFF = al256c(OFF_O + (size_t)MROWS * DM * 2);
constexpr size_t OFF_INV = al256c(OFF_AFF + (size_t)MROWS * 16 * 4);
constexpr size_t OFF_ROWIDX = al256c(OFF_INV + (size_t)MROWS * 16 * 4);
constexpr size_t OFF_ACT = al256c(OFF_ROWIDX + (size_t)NEXP * SLOTS_PAD * 4);
constexpr size_t OFF_YSLOT = al256c(OFF_ACT + (size_t)NEXP * SLOTS_PAD * DEXP * 2);
constexpr size_t OFF_WGU = al256c(OFF_YSLOT + (size_t)NEXP * SLOTS_PAD * DM * 2);
constexpr size_t OFF_WD = al256c(OFF_WGU + (size_t)NEXP * 2 * DEXP * DM * 2);
constexpr size_t OFF_WMIX = al256c(OFF_WD + (size_t)NEXP * DM * DEXP * 2);
constexpr size_t OFF_WGU3 = al256c(OFF_WMIX + (size_t)(QKVD + DM) * DM * 2);
constexpr size_t OFF_WD3 = al256c(OFF_WGU3 + (size_t)NEXP * 2 * DEXP * DM * 2);
constexpr size_t OFF_DUMMY = al256c(OFF_WD3 + (size_t)NEXP * DM * DEXP * 2);
constexpr size_t WS_TOTAL = OFF_DUMMY;
struct Params {
    const float *x, *c, *ctx, *c_ctx, *w_ada, *b_ada, *norm1_g, *norm2_g, *pool_w, *pool_scale, *w_qkv, *w_o, *q_norm, *k_norm, *sink, *router_w, *w_gate, *w_up, *w_down;
    float* out; char* ws; int wv; int zoff;
#define WSF(name, type, off) __host__ __device__ __forceinline__ type* name() const { return (type*)(ws + zoff + (off)); }
    WSF(bar, unsigned, OFF_BAR) WSF(mod, float, OFF_MOD) WSF(rope, float, OFF_ROPE) WSF(X, f16, OFF_X) WSF(H, f16, OFF_H) WSF(Z, f16, OFF_Z) WSF(Q, f16, OFF_Q) WSF(Kb, f16, OFF_KB) WSF(Vb, f16, OFF_VB) WSF(Vt, f16, OFF_VT)
    WSF(O, f16, OFF_O) WSF(aff, float, OFF_AFF) WSF(inv, int, OFF_INV) WSF(rowidx, int, OFF_ROWIDX) WSF(act, f16, OFF_ACT) WSF(yslot, f16, OFF_YSLOT) WSF(Wgu, f16, OFF_WGU) WSF(Wd, f16, OFF_WD) WSF(Wmix, f16, OFF_WMIX)
#undef WSF
#define WSW(name, type, off) __host__ __device__ __forceinline__ type* name() const { return (type*)(ws + zoff + (off)); }
    WSW(Xw, f16, OFF_X) WSW(Ow, f16, OFF_O) WSW(Hw, f16, OFF_H) WSW(affw, float, OFF_AFF) WSW(Qw, f16, OFF_Q) WSW(Kw, f16, OFF_KB)
#undef WSW
};

template <int O> __device__ __forceinline__ float shx(float v, int lane) {
    if (O == 1) return __int_as_float(__builtin_amdgcn_update_dpp(0, __float_as_int(v), 0xB1, 0xF, 0xF, true));
    if (O == 2) return __int_as_float(__builtin_amdgcn_update_dpp(0, __float_as_int(v), 0x4E, 0xF, 0xF, true));
    if (O < 32) return __int_as_float(__builtin_amdgcn_ds_swizzle(__float_as_int(v), (O << 10) | 0x1f));
    return __int_as_float(__builtin_amdgcn_ds_bpermute((lane ^ O) << 2, __float_as_int(v)));
}
__device__ __forceinline__ float wave_sum(float v, int lane) {
    v += shx<1>(v, lane); v += shx<2>(v, lane); v += shx<4>(v, lane); v += shx<8>(v, lane); v += shx<16>(v, lane); v += shx<32>(v, lane);
    return v;
}
__device__ __forceinline__ unsigned shup(unsigned v, int o, int lane) { return (unsigned)__builtin_amdgcn_ds_bpermute((lane - o) << 2, (int)v); }
__device__ __forceinline__ int opaque_bid() { int b = blockIdx.x; asm volatile("" : "+s"(b)); return b; }
#define opaque_tid() opaque_tid_(P.wv)
__device__ __forceinline__ int opaque_tid_(int wv) { int ln; asm volatile("v_mbcnt_lo_u32_b32 %0, -1, 0\n\tv_mbcnt_hi_u32_b32 %0, -1, %0" : "=v"(ln)); return (wv << 6) | ln; }
__device__ __forceinline__ float silu_f(float v) { return v * __builtin_amdgcn_rcpf(1.0f + __expf(-v)); }

__device__ __forceinline__ const float* modp(const Params& P, int l, int v, int j) { return P.mod() + (size_t)((l * 3 + v) * 6 + j) * DM; }

__device__ __forceinline__ void phase_ada(const Params& P, int bid, int nb, float* lds) {
    float* sc = lds; float* red = lds + 3 * DM;
    const int tid = opaque_tid();
    for (int i = tid; i < 3 * DM; i += NTHR) { const int v = i >> 10, k = i & 1023; const float cv = v < 2 ? P.c[v * DM + k] : P.c_ctx[k]; sc[i] = silu_f(cv); }
    __syncthreads();
    for (int u = bid; u < 4 * 96; u += nb) {
        const int l = u / 96, ch = u % 96, col = ch * 64 + (tid & 63), ks = tid >> 6;
        const float* w = P.w_ada + (size_t)l * DM * 6 * DM + col;
        float s0 = 0.f, s1 = 0.f, s2 = 0.f;
        for (int k = ks * 128; k < ks * 128 + 128; ++k) { const float wv = __builtin_nontemporal_load(w + (size_t)k * 6 * DM); s0 += sc[k] * wv; s1 += sc[DM + k] * wv; s2 += sc[2 * DM + k] * wv; }
        red[(ks * 3 + 0) * 64 + (tid & 63)] = s0; red[(ks * 3 + 1) * 64 + (tid & 63)] = s1; red[(ks * 3 + 2) * 64 + (tid & 63)] = s2;
        __syncthreads();
        if (tid < 192) { const int v = tid >> 6, cc = tid & 63; float s = 0.f;
#pragma unroll
            for (int q = 0; q < 8; ++q) s += red[(q * 3 + v) * 64 + cc];
            const int colg = ch * 64 + cc; s += P.b_ada[l * 6 * DM + colg];
            const int j = colg >> 10, d = colg & 1023;
            P.mod()[(size_t)((l * 3 + v) * 6 + j) * DM + d] = s; }
        __syncthreads();
    }
    for (int i = bid * NTHR + tid; i < 256 * 16; i += nb * NTHR) {
        const int p = i >> 4, f = i & 15;
        const float inv = powf(10000.0f, -(float)f / 16.0f);
        const float angf = (float)p * inv;
        double a = (double)angf;
        const double twopi = 6.283185307179586476925286766559;
        a -= twopi * rint(a / twopi);
        const double a2 = a * a;
        double cs = 1.0, sn = 1.0;
        double tc = 0.0, ts = 0.0;
        for (int n = 16; n >= 1; --n) { tc = (tc + 1.0) * (-a2 / (double)((2 * n - 1) * (2 * n))); ts = (ts + 1.0) * (-a2 / (double)((2 * n) * (2 * n + 1))); }
        cs = 1.0 + tc; sn = a * (1.0 + ts);
        P.rope()[i * 2] = (float)cs; P.rope()[i * 2 + 1] = (float)sn;
    }
}

__device__ __forceinline__ f32x4 cvt4(const f16x4 v) { return (f32x4){(float)v[0], (float)v[1], (float)v[2], (float)v[3]}; }
__device__ __forceinline__ f16x4 pk4(const f32x4 v) { return (f16x4){(f16)v[0], (f16)v[1], (f16)v[2], (f16)v[3]}; }
__device__ __forceinline__ float dot4(const f32x4 a, const f32x4 b) { return a[0] * b[0] + a[1] * b[1] + a[2] * b[2] + a[3] * b[3]; }
template <bool FIRST, bool FINAL>
__device__ __forceinline__ void phase_n1(const Params& P, int l, int bid, int nb) {
    constexpr int R = 4;
    const int tid_ = opaque_tid(); const int wid = P.wv, lane = tid_ & 63;
    const int nrows = FINAL ? NLAT : MROWS;
    for (int rb = (bid * 8 + wid) * R; rb < nrows; rb += nb * 8 * R) {
        const int v = rb < NLAT ? (rb >> 14) : 2;
        f32x4 xv[R][4];
#pragma unroll
        for (int u = 0; u < R; ++u) {
            const int r = rb + u;
            if (FIRST) { const float* src = r < NLAT ? P.x + (size_t)r * DM : P.ctx + (size_t)(r - NLAT) * DM;
#pragma unroll
                for (int q = 0; q < 4; ++q) xv[u][q] = __builtin_nontemporal_load((const f32x4*)(src + q * 256 + lane * 4)); }
            else { const f16* src = P.X() + (size_t)r * DM;
#pragma unroll
                for (int q = 0; q < 4; ++q) xv[u][q] = cvt4(*(const f16x4*)(src + q * 256 + lane * 4)); }
        }
        if (!FIRST) {
            const int sl = P.inv()[(size_t)(lane & 15) * MROWS + rb + (lane >> 4)];
            const float af = P.aff()[(size_t)(lane & 15) * MROWS + rb + (lane >> 4)];
            const unsigned long long bal = __builtin_amdgcn_ballot_w64(sl >= 0);
            unsigned m[R];
#pragma unroll
            for (int u = 0; u < R; ++u) m[u] = (unsigned)(bal >> (16 * u)) & 0xffffu;
            const f16* ys = P.yslot();
            const float* g2 = modp(P, l - 1, v, 5);
            f32x4 gv[4];
#pragma unroll
            for (int q = 0; q < 4; ++q) gv[q] = *(const f32x4*)(g2 + q * 256 + lane * 4);
            while (m[0] | m[1] | m[2] | m[3]) {
                f16x4 yv[R][4]; float w[R];
#pragma unroll
                for (int u = 0; u < R; ++u) {
                    const int e = m[u] ? __builtin_ctz(m[u]) : 0;
                    const int sv = m[u] ? __builtin_amdgcn_readlane(sl, 16 * u + e) : 0;
                    w[u] = m[u] ? __int_as_float(__builtin_amdgcn_readlane(__float_as_int(af), 16 * u + e)) : 0.f;
                    m[u] &= m[u] - 1u;
                    const f16* y = ys + ((size_t)e * SLOTS_PAD + sv) * DM + lane * 4;
#pragma unroll
                    for (int q = 0; q < 4; ++q) yv[u][q] = __builtin_nontemporal_load((const f16x4*)(y + q * 256));
                }
#pragma unroll
                for (int u = 0; u < R; ++u)
#pragma unroll
                    for (int q = 0; q < 4; ++q) xv[u][q] += (w[u] * gv[q]) * cvt4(yv[u][q]);
            }
        }
        if (FINAL) {
#pragma unroll
            for (int u = 0; u < R; ++u)
#pragma unroll
                for (int q = 0; q < 4; ++q) __builtin_nontemporal_store(xv[u][q], (f32x4*)(P.out + (size_t)(rb + u) * DM + q * 256 + lane * 4));
            continue;
        }
        float ss[R];
#pragma unroll
        for (int u = 0; u < R; ++u) {
            f16* xd = P.Xw() + (size_t)(rb + u) * DM; float sacc = 0.f;
#pragma unroll
            for (int q = 0; q < 4; ++q) { *(f16x4*)(xd + q * 256 + lane * 4) = pk4(xv[u][q]); sacc += dot4(xv[u][q], xv[u][q]); }
            ss[u] = sacc;
        }
#pragma unroll
        for (int u = 0; u < R; ++u) ss[u] = rsqrtf(wave_sum(ss[u], lane) * (1.0f / DM) + 1e-6f);
        const float* g = P.norm1_g + l * DM; const float* sh = modp(P, l, v, 0); const float* scl = modp(P, l, v, 1);
#pragma unroll
        for (int q = 0; q < 4; ++q) {
            const int c0 = q * 256 + lane * 4;
            const f32x4 gq = *(const f32x4*)(g + c0), sq = *(const f32x4*)(sh + c0), cq = *(const f32x4*)(scl + c0);
            const f32x4 gm = gq * (1.0f + cq);
#pragma unroll
            for (int u = 0; u < R; ++u) *(f16x4*)(P.Hw() + (size_t)(rb + u) * DM + c0) = pk4(xv[u][q] * ss[u] * gm + sq);
        }
    }
}

#define N2_ZST 81920
template <bool POOL>
__device__ __forceinline__ void phase_n2(const Params& P, int l, int bid, int nb, float* lds, int nrows = MROWS) {
    const int tid = opaque_tid(), wid = P.wv, lane = tid & 63;
    const float* wr = P.router_w + (size_t)l * DM * NEXP;
    f16* wh = (f16*)lds;
    for (int i = tid; i < DM * NEXP; i += NTHR) { const int d = i >> 4, e = i & 15; wh[e * 1032 + d] = (f16)wr[i]; }
    f16* h2s = (f16*)lds + 16640;
    LAS unsigned char* zst = (LAS unsigned char*)lds + N2_ZST;
    const int j = l >> 1, nblk = nrows >> 4;
    const f16* Zg = P.Z();
    const f16* Xg = P.X();
    f16x4 xr[2][4]; f16x4 zr[2][4];
    auto prefetch = [&](int blk) {
        const int R0 = blk * 16, rb = R0 + wid * 2;
        if (POOL) {
            int s0, L; if (R0 < NLAT) { s0 = (R0 >> 14) << 14; L = SEQ; } else { s0 = NLAT + (((R0 - NLAT) >> 8) << 8); L = CTXL; }
#pragma unroll
            for (int i = 0; i < 8; ++i) { const int piece = wid * 8 + i; int rr = R0 - 8 + (piece >> 1); rr = rr < s0 ? s0 : (rr > s0 + L - 1 ? s0 + L - 1 : rr);
                __builtin_amdgcn_global_load_lds((const unsigned*)(Zg + (size_t)rr * DM + (piece & 1) * 512 + lane * 8), (LAS unsigned*)(zst + piece * 1024), 16, 0, 0); }
        } else {
#pragma unroll
            for (int u = 0; u < 2; ++u)
#pragma unroll
                for (int q = 0; q < 4; ++q) zr[u][q] = *(const f16x4*)(Zg + (size_t)(rb + u) * DM + q * 256 + lane * 4);
        }
#pragma unroll
        for (int u = 0; u < 2; ++u)
#pragma unroll
            for (int q = 0; q < 4; ++q) xr[u][q] = *(const f16x4*)(Xg + (size_t)(rb + u) * DM + q * 256 + lane * 4);
    };
    int blk = bid;
    if (blk < nblk) prefetch(blk);
    __syncthreads();
    while (blk < nblk) {
        const int R0 = blk * 16, rb = R0 + wid * 2;
        int v, s0, L;
        if (rb < NLAT) { v = rb >> 14; s0 = v << 14; L = SEQ; } else { v = 2; s0 = NLAT + (((rb - NLAT) >> 8) << 8); L = CTXL; }
        const int t = rb - s0;
        f32x4 g1v[4], gmv[4], shv[4], psv[4];
        { const float* g1 = modp(P, l, v, 2); const float* g = P.norm2_g + l * DM; const float* sh = modp(P, l, v, 3); const float* scl = modp(P, l, v, 4);
#pragma unroll
            for (int q = 0; q < 4; ++q) { const int c0 = q * 256 + lane * 4;
                g1v[q] = *(const f32x4*)(g1 + c0); const f32x4 gv = *(const f32x4*)(g + c0), cv = *(const f32x4*)(scl + c0); shv[q] = *(const f32x4*)(sh + c0); gmv[q] = gv * (1.0f + cv);
                if (POOL) psv[q] = *(const f32x4*)(P.pool_scale + j * DM + c0); } }
        f32x4 y[2][4];
        if (POOL) {
            asm volatile("s_waitcnt vmcnt(0)" ::: "memory");
            __syncthreads();
#pragma unroll
            for (int q = 0; q < 4; ++q) {
                const int h = 1 << q;
                const LAS f16* zb = (const LAS f16*)zst + q * 256 + lane * 4;
                f32x4 common = (f32x4){0.f, 0.f, 0.f, 0.f}, z0 = common, z1 = common;
#pragma unroll
                for (int d = -h; d <= h; ++d) {
                    const int tt = t + d; const bool ok = tt >= 0 && tt < L;
                    f32x4 zz = cvt4(*(const LAS f16x4*)(zb + (2 * wid + 8 + d) * DM));
                    if (!ok) zz = (f32x4){0.f, 0.f, 0.f, 0.f};
                    if (d == -h) z0 = zz; else if (d == h) z1 = zz; else common += zz;
                    if (d == 0) y[0][q] = zz;
                    if (d == 1) y[1][q] = zz;
                }
                const int c0n = min(t + h, L) - max(t - h, 0), c1n = min(t + 1 + h, L) - max(t + 1 - h, 0);
                y[0][q] = ((common + z0) * (1.0f / (float)c0n) - y[0][q]) * psv[q];
                y[1][q] = ((common + z1) * (1.0f / (float)c1n) - y[1][q]) * psv[q];
            }
            asm volatile("s_waitcnt lgkmcnt(0)" ::: "memory");
            __syncthreads();
        } else {
#pragma unroll
            for (int u = 0; u < 2; ++u)
#pragma unroll
                for (int q = 0; q < 4; ++q) y[u][q] = cvt4(zr[u][q]);
        }
        f32x4 xv[2][4]; float ss[2] = {0.f, 0.f};
#pragma unroll
        for (int q = 0; q < 4; ++q) {
#pragma unroll
            for (int u = 0; u < 2; ++u) { xv[u][q] = cvt4(xr[u][q]) + g1v[q] * y[u][q]; ss[u] += dot4(xv[u][q], xv[u][q]); }
        }
        const int nxt = blk + nb;
        asm volatile("" ::: "memory");
        if (nxt < nblk) prefetch(nxt);
#pragma unroll
        for (int u = 0; u < 2; ++u)
#pragma unroll
            for (int q = 0; q < 4; ++q) *(f16x4*)(P.Xw() + (size_t)(rb + u) * DM + q * 256 + lane * 4) = pk4(xv[u][q]);
        ss[0] = wave_sum(ss[0], lane); ss[1] = wave_sum(ss[1], lane);
        const float rs[2] = {rsqrtf(ss[0] * (1.0f / DM) + 1e-6f), rsqrtf(ss[1] * (1.0f / DM) + 1e-6f)};
        f16x4 h2h[2][4];
#pragma unroll
        for (int q = 0; q < 4; ++q) {
            const int c0 = q * 256 + lane * 4;
#pragma unroll
            for (int u = 0; u < 2; ++u) { h2h[u][q] = pk4(xv[u][q] * rs[u] * gmv[q] + shv[q]); *(f16x4*)(P.Hw() + (size_t)(rb + u) * DM + c0) = h2h[u][q]; }
        }
        asm volatile("s_waitcnt lgkmcnt(0)" ::: "memory"); __builtin_amdgcn_s_barrier(); asm volatile("" ::: "memory");
#pragma unroll
        for (int q = 0; q < 4; ++q)
#pragma unroll
            for (int u = 0; u < 2; ++u) *(f16x4*)(h2s + (2 * wid + u) * 1032 + q * 256 + lane * 4) = h2h[u][q];
        asm volatile("s_waitcnt lgkmcnt(0)" ::: "memory"); __builtin_amdgcn_s_barrier(); asm volatile("" ::: "memory");
        if (wid == 0) {
            const int r16 = lane & 15, kq = lane >> 4;
            f32x4 lg = (f32x4){0.f, 0.f, 0.f, 0.f};
#pragma unroll 8
            for (int ks = 0; ks < 32; ++ks) {
                const f16x8 av = *(const f16x8*)(h2s + r16 * 1032 + ks * 32 + kq * 8), bv = *(const f16x8*)(wh + r16 * 1032 + ks * 32 + kq * 8);
                lg = __builtin_amdgcn_mfma_f32_16x16x32_f16(av, bv, lg, 0, 0, 0);
            }
#pragma unroll
            for (int jj = 0; jj < 4; ++jj) {
                float mx = lg[jj];
                mx = fmaxf(mx, shx<1>(mx, lane)); mx = fmaxf(mx, shx<2>(mx, lane)); mx = fmaxf(mx, shx<4>(mx, lane)); mx = fmaxf(mx, shx<8>(mx, lane));
                const float pe = __expf(lg[jj] - mx);
                float den = pe;
                den += shx<1>(den, lane); den += shx<2>(den, lane); den += shx<4>(den, lane); den += shx<8>(den, lane);
                P.affw()[(size_t)r16 * MROWS + R0 + 4 * kq + jj] = pe / den;
            }
        }
        blk = nxt;
    }
}

__device__ __forceinline__ void phase_topk(const Params& P, int bid, int nb, unsigned* lds, int nprob = 64) {
    unsigned* hist = lds; unsigned* misc = lds + 256; unsigned* wsa = lds + 272; unsigned* wsb = lds + 288;
    const int tid = opaque_tid(), wid = tid >> 6, lane = tid & 63;
    for (int p = bid; p < nprob; p += nb) {
        const int set = p >> 4, e = p & 15;
        const int n = set < 2 ? SEQ : CTXL, C = n >> 3;
        const int r0 = set < 2 ? set * SEQ : NLAT + (set - 2) * CTXL;
        const int slot0 = set < 2 ? set * 2048 : 4096 + (set - 2) * 32;
        unsigned key[32];
#pragma unroll
        for (int i4 = 0; i4 < 8; ++i4) { const int idx = tid * 32 + i4 * 4;
            f32x4 v = (f32x4){0.f, 0.f, 0.f, 0.f}; if (idx < n) v = *(const f32x4*)(P.aff() + (size_t)e * MROWS + r0 + idx);
#pragma unroll
            for (int jj = 0; jj < 4; ++jj) key[i4 * 4 + jj] = idx < n ? (__float_as_uint(v[jj]) + 1u) : 0u; }
        unsigned T = 0u;
        for (int bit = 29; bit >= 0; --bit) {
            const unsigned cand = T | (1u << bit);
            unsigned wc = 0u;
#pragma unroll
            for (int i = 0; i < 32; ++i) wc += (unsigned)__builtin_popcountll(__builtin_amdgcn_ballot_w64(key[i] >= cand));
            unsigned* cb = misc + ((bit & 1) << 3);
            if (lane == 0) cb[wid] = wc;
            __syncthreads();
            unsigned tot = 0u;
#pragma unroll
            for (int w = 0; w < 8; ++w) tot += cb[w];
            if (tot >= (unsigned)C) T = cand;
        }
        unsigned cg = 0u, ce = 0u;
#pragma unroll
        for (int i = 0; i < 32; ++i) { cg += key[i] > T ? 1u : 0u; ce += key[i] == T ? 1u : 0u; }
        unsigned ig = cg, ie = ce;
#pragma unroll
        for (int o = 1; o < 64; o <<= 1) { const unsigned a = shup(ig, o, lane), b = shup(ie, o, lane); if (lane >= o) { ig += a; ie += b; } }
        if (lane == 63) { wsa[wid] = ig; wsb[wid] = ie; }
        __syncthreads();
        unsigned bg = 0u, be = 0u, totg = 0u;
#pragma unroll
        for (int w = 0; w < 8; ++w) { const unsigned ga = wsa[w]; totg += ga; if (w < wid) { bg += ga; be += wsb[w]; } }
        const unsigned krem = (unsigned)C - totg;
        unsigned pg = bg + ig - cg, pe = be + ie - ce;
#pragma unroll
        for (int i4 = 0; i4 < 8; ++i4) {
            int iv[4];
#pragma unroll
            for (int jj = 0; jj < 4; ++jj) {
                const int i = i4 * 4 + jj, idx = tid * 32 + i;
                bool sel = false; unsigned rank = 0u;
                if (key[i] > T) { sel = true; rank = pg + (pe < krem ? pe : krem); ++pg; }
                else if (key[i] == T && key[i] != 0u) { if (pe < krem) { sel = true; rank = pg + pe; } ++pe; }
                if (sel) P.rowidx()[e * SLOTS_PAD + slot0 + (int)rank] = r0 + idx;
                iv[jj] = sel ? slot0 + (int)rank : -1;
            }
            if (tid * 32 + i4 * 4 < n) *(int4*)(P.inv() + (size_t)e * MROWS + r0 + tid * 32 + i4 * 4) = make_int4(iv[0], iv[1], iv[2], iv[3]);
        }
        if (set == 3) for (int i = SLOTS + tid; i < SLOTS_PAD; i += NTHR) P.rowidx()[e * SLOTS_PAD + i] = 0;
        __syncthreads();
    }
}

#define XB_TMO      128
#define XB_XCNT(j)  (256  + 64 * (j))
#define XB_XSUB(j)  (1280 + 64 * (j))
#define XB_XGEN(j)  (2304 + 64 * (j))
#define XB_TOP      3328
#define XB_TOPGEN   3392
#define XCD_BAR_WORDS 3456
#define XB_SPIN_CAP (1u << 18)
__device__ __forceinline__ unsigned xb_ld(unsigned* p)              { return __hip_atomic_load(p, __ATOMIC_RELAXED, __HIP_MEMORY_SCOPE_AGENT); }
__device__ __forceinline__ unsigned xb_add(unsigned* p, unsigned v) { return __hip_atomic_fetch_add(p, v, __ATOMIC_RELAXED, __HIP_MEMORY_SCOPE_AGENT); }
__device__ __forceinline__ unsigned xb_xcc_id() { return (unsigned)__builtin_amdgcn_s_getreg((3 << 11) | 20) & 0xFu; }
#define XB_SPIN(cond, bar) do { unsigned _sp = 0; while (cond) { __builtin_amdgcn_s_sleep(1); \
    if ((++_sp & 255u) == 0u) { if (xb_ld(&(bar)[XB_TMO])) break; if (_sp > XB_SPIN_CAP) { atomicAdd(&(bar)[XB_TMO], 1u); break; } } } } while (0)
struct XcdBarrier { unsigned* bar; unsigned x; volatile LAS unsigned* st; };
__device__ __forceinline__ XcdBarrier xcd_barrier_post(unsigned* bar, volatile LAS unsigned* st) {
    XcdBarrier b; b.bar = bar; b.x = xb_xcc_id(); b.st = st;
    if (threadIdx.x == 0) (void)xb_add(&bar[XB_XCNT(b.x)], 1u);
    return b;
}
__device__ __forceinline__ void xcd_barrier_complete(unsigned* bar, unsigned x, unsigned& nloc, unsigned& nx) {
    const unsigned G = gridDim.x * gridDim.y * gridDim.z;
    unsigned sum, cnt, mine, sp = 0u;
    for (;;) {
        sum = 0u; cnt = 0u; mine = 0u;
#pragma unroll
        for (unsigned j = 0; j < 16; ++j) { const unsigned c = xb_ld(&bar[XB_XCNT(j)]); sum += c; cnt += (c > 0u) ? 1u : 0u; mine = (j == x) ? c : mine; }
        if (sum == G) break;
        __builtin_amdgcn_s_sleep(1);
        if ((++sp & 255u) == 0u) { if (xb_ld(&bar[XB_TMO])) break; if (sp > XB_SPIN_CAP) { atomicAdd(&bar[XB_TMO], 1u); break; } }
    }
    nloc = mine > 0u ? mine : 1u; nx = cnt > 0u ? cnt : 1u;
}
__device__ __forceinline__ void xcd_barrier(const XcdBarrier& b) {
    asm volatile("s_waitcnt vmcnt(0)" ::: "memory");
    __syncthreads();
    if (threadIdx.x == 0) {
        unsigned* bar = b.bar; asm volatile("" : "+s"(bar));
        const unsigned bx = (unsigned)__builtin_amdgcn_readfirstlane((int)xb_xcc_id());
        __builtin_amdgcn_s_waitcnt(0);
        unsigned nloc = b.st[0], nx = b.st[1];
        if (nloc == 0u) { xcd_barrier_complete(bar, bx, nloc, nx); b.st[0] = nloc; b.st[1] = nx; }
        const unsigned old = xb_add(&bar[XB_XSUB(bx)], 1u);
        const unsigned gen = old / nloc;
        if (old + 1u == (gen + 1u) * nloc) {
            __builtin_amdgcn_fence(__ATOMIC_RELEASE, "agent");
            asm volatile("s_waitcnt vmcnt(0)" ::: "memory");
            const unsigned og = xb_add(&bar[XB_TOP], 1u);
            const unsigned tg = og / nx;
            if (og + 1u == (tg + 1u) * nx) xb_add(&bar[XB_TOPGEN], 1u);
            else XB_SPIN(xb_ld(&bar[XB_TOPGEN]) == tg, bar);
            __builtin_amdgcn_fence(__ATOMIC_ACQUIRE, "agent");
            xb_add(&bar[XB_XGEN(bx)], 1u);
            asm volatile("s_waitcnt vmcnt(0)" ::: "memory");
        } else {
            XB_SPIN(xb_ld(&bar[XB_XGEN(bx)]) == gen, bar);
            __builtin_amdgcn_fence(__ATOMIC_ACQUIRE, "agent");
            asm volatile("s_waitcnt vmcnt(0)" ::: "memory");
        }
    }
    __syncthreads();
}

namespace fg {
constexpr int BM = 256, BK = 64, HALF = 128, HTB = HALF * BK * 2, STAGE_BYTES = 8 * HTB;
__device__ __forceinline__ int lds_byte(int r, int c) { const int st = (r >> 4) * 2 + (c >> 5), rr = r & 15, cc = c & 31, ob = rr * 64 + cc * 2; return st * 1024 + (ob ^ (((ob >> 9) & 1) << 5)); }
__device__ __forceinline__ void stage_rc(int b, int& R, int& C) { const int st = b / 1024, sb = b % 1024, swz = sb ^ (((sb >> 9) & 1) << 5); R = (st >> 1) * 16 + swz / 64; C = (st & 1) * 32 + (swz % 64) / 2; }
__device__ __forceinline__ int perm32(int rho) { const int n = rho >> 4, i = rho & 15; return 8 * (i >> 2) + 4 * n + (i & 3); }
#define KDUP 0
struct Unit { int e, pm, pn; int skip; };
__device__ __forceinline__ void xcd_order(int i, int& T) { const int c = blockIdx.x; T = i * (int)gridDim.x + c; }

template <class PR>
__device__ __forceinline__ void gemm_phase(LAS unsigned char* lds, const PR& S, int wv) {
    const int tid = opaque_tid_(wv), wid = __builtin_amdgcn_readfirstlane(tid >> 6), lane = tid & 63, wr = wid >> 2, wc = wid & 3, fr = lane & 15, fq = lane >> 4;
    constexpr int K = PR::K, nt = K / BK;
    unsigned voffB[2];
#pragma unroll
    for (int i = 0; i < 2; ++i) { int R, C; stage_rc(tid * 16 + i * 8192, R, C); const int Rb = (R & ~31) + perm32(R & 31); voffB[i] = (unsigned)(Rb * PR::LDB + C) * 2u; }
    const size_t kstep = (size_t)(BK * 2);
    const size_t hB = S.hstepB();
    const unsigned ldsw = (unsigned)wid * 1024u;
    const int aoff = lds_byte(wr * 64 + fr, fq * 8), boff = lds_byte(wc * 32 + fr, fq * 8);
#define FG_SA(b, h) (((b) * 2 + (h)) * HTB)
#define FG_SB(b, h) ((4 + (b) * 2 + (h)) * HTB)
#define FG_STAGE(bufoff, gbase, voff) do { _Pragma("unroll") for (int _i = 0; _i < 2; ++_i) \
        __builtin_amdgcn_global_load_lds((const unsigned*)((const char*)(gbase) + (voff)[_i]), (LAS unsigned*)(lds + (bufoff) + ldsw + _i * 8192), 16, 0, 0); } while (0)
#define FG_LDA(dst, b, h) do { _Pragma("unroll") for (int m = 0; m < 4; ++m) _Pragma("unroll") for (int k = 0; k < 2; ++k) dst[m][k] = *(const LAS f16x8*)(lds + FG_SA(b, h) + aoff + m * 2048 + k * 1024); } while (0)
#define FG_LDB(dst, b, h) do { _Pragma("unroll") for (int n = 0; n < 2; ++n) _Pragma("unroll") for (int k = 0; k < 2; ++k) dst[n][k] = *(const LAS f16x8*)(lds + FG_SB(b, h) + boff + n * 2048 + k * 1024); } while (0)
#define FG_MMA(ai, bj, At, Bt) do { __builtin_amdgcn_s_setprio(1); _Pragma("unroll") for (int m = 0; m < 4; ++m) _Pragma("unroll") for (int n = 0; n < 2; ++n) _Pragma("unroll") for (int k = 0; k < 2; ++k) \
        acc[ai][bj][m][n] = __builtin_amdgcn_mfma_f32_16x16x32_f16(Bt[n][k], At[m][k], acc[ai][bj][m][n], 0, 0, 0); __builtin_amdgcn_s_setprio(0); } while (0)
#define FG_WAIT_V(n) asm volatile("s_waitcnt vmcnt(" #n ")" ::: "memory")
#define FG_WAIT_L(n) asm volatile("s_waitcnt lgkmcnt(" #n ")" ::: "memory")
#define FG_BAR __builtin_amdgcn_s_barrier()
#define FG_SCHED __builtin_amdgcn_sched_barrier(0)
    Unit cur, nxt; int ui = 0;
    if (!S.next(0, cur)) return;
    f32x4 acc[2][2][4][2];
#pragma unroll
    for (int a = 0; a < 2; ++a)
#pragma unroll
        for (int b = 0; b < 2; ++b)
#pragma unroll
            for (int m = 0; m < 4; ++m)
#pragma unroll
                for (int n = 0; n < 2; ++n) acc[a][b][m][n] = (f32x4){0.f, 0.f, 0.f, 0.f};
    f16x8 At[4][2], B0[2][2], B1[2][2];
    unsigned vA[2][2], vN[2][2];
    { int Rr[2], Cc[2]; stage_rc(tid * 16, Rr[0], Cc[0]); stage_rc(tid * 16 + 8192, Rr[1], Cc[1]); S.a_voff(cur, Rr, Cc, vA); }
#pragma unroll
    for (int h = 0; h < 2; ++h)
#pragma unroll
        for (int i = 0; i < 2; ++i) { asm volatile("" : "+v"(vA[h][i])); vN[h][i] = vA[h][i]; }
    const char* cA = S.a_base(cur); const char* cB = S.b_base(cur);
    FG_STAGE(FG_SB(0, 0), cB, voffB); FG_STAGE(FG_SA(0, 0), cA, vA[0]); FG_STAGE(FG_SB(0, 1), cB + hB, voffB); FG_STAGE(FG_SA(0, 1), cA, vA[1]);
    if (wr == 1) FG_BAR;
    FG_WAIT_V(4); FG_BAR;
    FG_STAGE(FG_SB(1, 0), cB + kstep, voffB); FG_STAGE(FG_SA(1, 0), cA + kstep, vA[0]); FG_STAGE(FG_SB(1, 1), cB + hB + kstep, voffB);
    FG_WAIT_V(6); FG_BAR;
    for (;;) {
        const bool has_next = S.next(ui + 1, nxt);
        const char* nA = has_next ? S.a_base(nxt) : cA; const char* nB = has_next ? S.b_base(nxt) : cB;
        if (has_next) { int Rr[2], Cc[2]; int t2 = tid; asm volatile("" : "+v"(t2)); stage_rc(t2 * 16, Rr[0], Cc[0]); stage_rc(t2 * 16 + 8192, Rr[1], Cc[1]); S.a_voff(nxt, Rr, Cc, vN);
#pragma unroll
            for (int h = 0; h < 2; ++h)
#pragma unroll
                for (int i = 0; i < 2; ++i) asm volatile("" : "+v"(vN[h][i])); }
#pragma unroll 1
        for (int t = 0; t < nt; t += 2) {
            const bool last = (t == nt - 2);
            const char* a1 = cA + (size_t)(t + 1) * kstep;
            const char* a2 = last ? nA : cA + (size_t)(t + 2) * kstep; const char* b2 = last ? nB : cB + (size_t)(t + 2) * kstep;
            const char* a3 = a2 + kstep; const char* b3 = b2 + kstep;
            unsigned v2[2][2];
#pragma unroll
            for (int h = 0; h < 2; ++h)
#pragma unroll
                for (int i = 0; i < 2; ++i) v2[h][i] = last ? vN[h][i] : vA[h][i];
            FG_LDB(B0, 0, 0); FG_SCHED; FG_LDA(At, 0, 0); FG_STAGE(FG_SA(1, 1), a1, vA[1]);
            FG_WAIT_L(8); FG_BAR; FG_WAIT_L(0); FG_MMA(0, 0, At, B0); FG_BAR; FG_SCHED;
            FG_LDB(B1, 0, 1); FG_STAGE(FG_SB(0, 0), b2, voffB);
            FG_BAR; FG_WAIT_L(0); FG_MMA(0, 1, At, B1); FG_BAR;
            FG_LDA(At, 0, 1); FG_STAGE(FG_SA(0, 0), a2, v2[0]);
            FG_BAR; FG_WAIT_L(0); FG_MMA(1, 0, At, B0); FG_BAR; FG_SCHED;
            FG_STAGE(FG_SB(0, 1), b2 + hB, voffB);
            FG_WAIT_V(6); FG_BAR; FG_MMA(1, 1, At, B1); FG_BAR;
            FG_LDB(B0, 1, 0); FG_SCHED; FG_LDA(At, 1, 0); FG_STAGE(FG_SA(0, 1), a2, v2[1]);
            FG_WAIT_L(8); FG_BAR; FG_WAIT_L(0); FG_MMA(0, 0, At, B0); FG_BAR; FG_SCHED;
            FG_LDB(B1, 1, 1); FG_STAGE(FG_SB(1, 0), b3, voffB);
            FG_BAR; FG_WAIT_L(0); FG_MMA(0, 1, At, B1); FG_BAR;
            FG_LDA(At, 1, 1); FG_STAGE(FG_SA(1, 0), a3, v2[0]);
            FG_BAR; FG_WAIT_L(0); FG_MMA(1, 0, At, B0); FG_BAR; FG_SCHED;
            FG_STAGE(FG_SB(1, 1), b3 + hB, voffB);
            FG_WAIT_V(6); FG_BAR; FG_MMA(1, 1, At, B1); FG_BAR;
        }
        if (!KDUP || !cur.skip) S.epi(acc, cur, wr, wc, fr, fq);
        if (!has_next) break;
#pragma unroll
        for (int a = 0; a < 2; ++a)
#pragma unroll
            for (int b = 0; b < 2; ++b)
#pragma unroll
                for (int m = 0; m < 4; ++m)
#pragma unroll
                    for (int n = 0; n < 2; ++n) acc[a][b][m][n] = (f32x4){0.f, 0.f, 0.f, 0.f};
        cur = nxt; cA = nA; cB = nB; ++ui;
#pragma unroll
        for (int h = 0; h < 2; ++h)
#pragma unroll
            for (int i = 0; i < 2; ++i) vA[h][i] = vN[h][i];
    }
    FG_WAIT_V(0);
    if (wr == 0) FG_BAR;
    FG_BAR;
#undef FG_SA
#undef FG_SB
#undef FG_STAGE
#undef FG_LDA
#undef FG_LDB
#undef FG_MMA
#undef FG_WAIT_V
#undef FG_WAIT_L
#undef FG_BAR
#undef FG_SCHED
}

__device__ __forceinline__ f16x8 pack8(const f32x4 a, const f32x4 b) { return (f16x8){(f16)a[0], (f16)a[1], (f16)a[2], (f16)a[3], (f16)b[0], (f16)b[1], (f16)b[2], (f16)b[3]}; }

template <int K_, int LDA_, int LDB_> struct PRBase {
    static constexpr int K = K_, LDA = LDA_, LDB = LDB_;
    __device__ __forceinline__ void plain_voff(const int (&R)[2], const int (&C)[2], unsigned (&v)[2][2]) const {
#pragma unroll
        for (int h = 0; h < 2; ++h)
#pragma unroll
            for (int i = 0; i < 2; ++i) v[h][i] = (unsigned)((h * HALF + R[i]) * LDA + C[i]) * 2u;
    }
};
struct PRGateUp : PRBase<1024, 1024, 1024> {
    const f16* H; const int* rowidx; const f16* W; f16* act; int nunits; int bid; int rt;
    __device__ __forceinline__ size_t hstepB() const { return (size_t)DEXP * DM * 2; }
    __device__ __forceinline__ bool next(int i, Unit& u) const { const int ii = KDUP ? (i >> 1) : i; const int T = ii * (int)gridDim.x + bid; u.skip = KDUP ? ((i & 1) == 0) : 0; if (T >= nunits) return false;
        if (rt == 16 && gridDim.x == 256) { const int x = bid & 7, jj = bid >> 3; u.e = ii; u.pm = (x >> 1) * 4 + (jj >> 3); u.pn = (x & 1) * 8 + (jj & 7); return true; }
        const int per = rt * 16; u.e = T / per; const int t = T % per; u.pm = t >> 4; u.pn = t & 15; return true; }
    __device__ __forceinline__ const char* a_base(const Unit&) const { return (const char*)H; }
    __device__ __forceinline__ void a_voff(const Unit& u, const int (&R)[2], const int (&C)[2], unsigned (&v)[2][2]) const {
        const int* ri = rowidx + u.e * SLOTS_PAD + u.pm * BM;
#pragma unroll
        for (int h = 0; h < 2; ++h)
#pragma unroll
            for (int i = 0; i < 2; ++i) { const int g = ri[h * HALF + R[i]]; v[h][i] = (unsigned)(g * LDA + C[i]) * 2u; }
    }
    __device__ __forceinline__ const char* b_base(const Unit& u) const { return (const char*)(W + ((size_t)u.e * 2 * DEXP + (size_t)u.pn * HALF) * DM); }
    __device__ __forceinline__ void epi(const f32x4 (&acc)[2][2][4][2], const Unit& u, int wr, int wc, int fr, int fq) const {
        f16* base = act + ((size_t)u.e * SLOTS_PAD + (size_t)u.pm * BM + wr * 64 + fr) * DEXP + u.pn * HALF + wc * 32 + fq * 8;
#pragma unroll
        for (int ai = 0; ai < 2; ++ai)
#pragma unroll
            for (int m = 0; m < 4; ++m) {
                f32x4 o0, o1;
#pragma unroll
                for (int j = 0; j < 4; ++j) { o0[j] = silu_f(acc[ai][0][m][0][j]) * acc[ai][1][m][0][j]; o1[j] = silu_f(acc[ai][0][m][1][j]) * acc[ai][1][m][1][j]; }
                if (u.e < 8) __builtin_nontemporal_store(pack8(o0, o1), (f16x8*)(base + (size_t)(ai * HALF + m * 16) * DEXP));
                else *(f16x8*)(base + (size_t)(ai * HALF + m * 16) * DEXP) = pack8(o0, o1);
            }
    }
};
struct PRDown : PRBase<2048, 2048, 2048> {
    const f16* act; const f16* W; f16* y; int nunits; int bid; int rt;
    __device__ __forceinline__ size_t hstepB() const { return (size_t)HALF * DEXP * 2; }
    __device__ __forceinline__ bool next(int i, Unit& u) const { const int ii = KDUP ? (i >> 1) : i; const int T = ii * (int)gridDim.x + bid; u.skip = KDUP ? ((i & 1) == 0) : 0; if (T >= nunits) return false;
        if (rt == 16 && gridDim.x == 256) { const int x = bid & 7, jj = bid >> 3; u.e = 15 - (ii * 4 + (x >> 1)); u.pm = (x & 1) * 8 + (jj >> 2); u.pn = jj & 3; return true; }
        const int per = rt * 4; u.e = T / per; const int t = T % per; u.pm = t >> 2; u.pn = t & 3; return true; }
    __device__ __forceinline__ const char* a_base(const Unit& u) const { return (const char*)(act + ((size_t)u.e * SLOTS_PAD + (size_t)u.pm * BM) * DEXP); }
    __device__ __forceinline__ void a_voff(const Unit&, const int (&R)[2], const int (&C)[2], unsigned (&v)[2][2]) const { plain_voff(R, C, v); }
    __device__ __forceinline__ const char* b_base(const Unit& u) const { return (const char*)(W + ((size_t)u.e * DM + (size_t)u.pn * BM) * DEXP); }
    __device__ __forceinline__ void epi(const f32x4 (&acc)[2][2][4][2], const Unit& u, int wr, int wc, int fr, int fq) const {
        f16* base = y + ((size_t)u.e * SLOTS_PAD + (size_t)u.pm * BM + wr * 64 + fr) * DM + u.pn * BM + wc * 32 + fq * 8;
#pragma unroll
        for (int ai = 0; ai < 2; ++ai)
#pragma unroll
            for (int m = 0; m < 4; ++m)
#pragma unroll
                for (int bj = 0; bj < 2; ++bj) *(f16x8*)(base + (size_t)(ai * HALF + m * 16) * DM + bj * HALF) = pack8(acc[ai][bj][m][0], acc[ai][bj][m][1]);
    }
};
template <int K_> struct PRDense : PRBase<K_, 1024, K_> {
    const f16* A; const f16* W; f16* O0; f16* O1; f16* O2; int ncol; int mode; int bid; int npan; int kvx;
    __device__ __forceinline__ size_t hstepB() const { return (size_t)HALF * K_ * 2; }
    __device__ __forceinline__ bool next(int i, Unit& u) const { const int ii = KDUP ? (i >> 1) : i; int T = ii * (int)gridDim.x + bid; if (gridDim.x == 256) T = (ii * 8 + (bid & 7)) * 32 + (bid >> 3);
        u.skip = KDUP ? ((i & 1) == 0) : 0; const int nu = npan * ncol; if (T >= nu + kvx) return false; u.e = 0; if (T < nu) { u.pm = T / ncol; u.pn = T % ncol; } else { const int x = T - nu; u.pm = npan + (x >> 1); u.pn = 4 + (x & 1); } return true; }
    __device__ __forceinline__ const char* a_base(const Unit& u) const { return (const char*)(A + (size_t)u.pm * BM * 1024 + (mode == 2 ? u.pn * 256 : 0)); }
    __device__ __forceinline__ void a_voff(const Unit&, const int (&R)[2], const int (&C)[2], unsigned (&v)[2][2]) const { this->plain_voff(R, C, v); }
    __device__ __forceinline__ const char* b_base(const Unit& u) const { return (const char*)(W + (size_t)u.pn * BM * K_); }
    const float* qn; const float* kn; const float* rope; LAS float* xs; int lane;
    __device__ __forceinline__ void epi(const f32x4 (&acc)[2][2][4][2], const Unit& u, int wr, int wc, int fr, int fq) const {
        f16* base; int ld;
        const int row = u.pm * BM + wr * 64 + fr, colw = wc * 32 + fq * 8;
        if (mode == 1) { if (u.pn < 4) { base = O0 + (size_t)row * 1024 + u.pn * BM + colw; ld = 1024; } else if (u.pn == 4) { base = O1 + (size_t)row * 256 + colw; ld = 256; } else { base = O2 + (size_t)row * 256 + colw; ld = 256; } }
        else { base = O0 + (size_t)row * 1024 + u.pn * BM + colw; ld = 1024; }
        if (mode == 1 && u.pn < 5) {
            float ssq[2][4][2];
#pragma unroll
            for (int ai = 0; ai < 2; ++ai)
#pragma unroll
                for (int m = 0; m < 4; ++m)
#pragma unroll
                    for (int bj = 0; bj < 2; ++bj) { const f32x4 a = acc[ai][bj][m][0], b = acc[ai][bj][m][1];
                        float t = (a[0] * a[0] + a[1] * a[1]) + (a[2] * a[2] + a[3] * a[3]) + (b[0] * b[0] + b[1] * b[1]) + (b[2] * b[2] + b[3] * b[3]);
                        t += shx<16>(t, lane); t += shx<32>(t, lane); ssq[ai][m][bj] = t; }
            LAS float* mine = xs + ((wr * 4 + wc) * 16) * 16 + fr; const LAS float* theirs = xs + ((wr * 4 + (wc ^ 1)) * 16) * 16 + fr;
            if (fq == 0) {
#pragma unroll
                for (int ai = 0; ai < 2; ++ai)
#pragma unroll
                    for (int m = 0; m < 4; ++m)
#pragma unroll
                        for (int bj = 0; bj < 2; ++bj) mine[(ai * 8 + m * 2 + bj) * 16] = ssq[ai][m][bj];
            }
            asm volatile("s_waitcnt lgkmcnt(0)" ::: "memory"); __builtin_amdgcn_s_barrier(); asm volatile("" ::: "memory");
            const bool isq = u.pn < 4, lat = u.pm < 128;
            const float* nw = (isq ? qn : kn) + (wc & 1) * 32 + fq * 8;
            const f32x4 w0 = *(const f32x4*)nw, w1 = *(const f32x4*)(nw + 4);
            const float qs = isq ? 0.125f * 1.4426950408889634f : 1.0f;
#pragma unroll
            for (int ai = 0; ai < 2; ++ai)
#pragma unroll
                for (int m = 0; m < 4; ++m) {
                    f32x4 c0 = (f32x4){1.f, 1.f, 1.f, 1.f}, s0 = (f32x4){0.f, 0.f, 0.f, 0.f};
                    if (lat) { const int t = (row + ai * HALF + m * 16) & (SEQ - 1); const int pos = (wc & 1) ? (t & 63) : (t >> 6);
                        const float* tb = rope + (size_t)(pos * 16 + fq * 4) * 2; const f32x4 ta = *(const f32x4*)tb, tb2 = *(const f32x4*)(tb + 4);
                        c0 = (f32x4){ta[0], ta[2], tb2[0], tb2[2]}; s0 = (f32x4){ta[1], ta[3], tb2[1], tb2[3]}; }
#pragma unroll
                    for (int bj = 0; bj < 2; ++bj) {
                        const float tot = ssq[ai][m][bj] + theirs[(ai * 8 + m * 2 + bj) * 16];
                        const float rstd = rsqrtf(tot * (1.0f / 64.0f) + 1e-6f) * qs;
                        f32x4 a = acc[ai][bj][m][0] * rstd * w0, b = acc[ai][bj][m][1] * rstd * w1;
                        const f32x4 ra = (f32x4){a[0] * c0[0] - a[1] * s0[0], a[0] * s0[0] + a[1] * c0[0], a[2] * c0[1] - a[3] * s0[1], a[2] * s0[1] + a[3] * c0[1]};
                        const f32x4 rb = (f32x4){b[0] * c0[2] - b[1] * s0[2], b[0] * s0[2] + b[1] * c0[2], b[2] * c0[3] - b[3] * s0[3], b[2] * s0[3] + b[3] * c0[3]};
                        *(f16x8*)(base + (size_t)(ai * HALF + m * 16) * ld + bj * HALF) = pack8(ra, rb);
                    }
                }
            return;
        }
#pragma unroll
        for (int ai = 0; ai < 2; ++ai)
#pragma unroll
            for (int m = 0; m < 4; ++m)
#pragma unroll
                for (int bj = 0; bj < 2; ++bj) *(f16x8*)(base + (size_t)(ai * HALF + m * 16) * ld + bj * HALF) = pack8(acc[ai][bj][m][0], acc[ai][bj][m][1]);
    }
};
}

struct CvtJob { const float* src; f16* dst; int K, N, k0, n0; };
__device__ __forceinline__ bool cvt_job(const Params& P, int l, int u, CvtJob& jb, bool experts) {
    const int j = l >> 1;
    const int nexp = experts ? NEXP * 3 * 128 : 0;
    const int nmix = (l & 1) == 0 ? 16 : (96 + 64);
    if (u >= nexp + nmix) return false;
    if (u < nexp) {
        const int e = u / 384, r = u % 384, which = r >> 7, t = r & 127;
        if (which < 2) { jb.src = (which == 0 ? P.w_gate : P.w_up) + ((size_t)l * NEXP + e) * DM * DEXP; jb.dst = P.Wgu() + ((size_t)e * 2 + which) * DEXP * DM; jb.K = DM; jb.N = DEXP; jb.k0 = (t >> 4) * 128; jb.n0 = (t & 15) * 128; }
        else { jb.src = P.w_down + ((size_t)l * NEXP + e) * DEXP * DM; jb.dst = P.Wd() + (size_t)e * DM * DEXP; jb.K = DEXP; jb.N = DM; jb.k0 = (t >> 3) * 128; jb.n0 = (t & 7) * 128; }
    } else {
        const int t = u - nexp;
        if ((l & 1) == 0) { const int g = t >> 2, tt = t & 3; jb.src = P.pool_w + (size_t)(j * 4 + g) * 65536; jb.dst = P.Wmix() + (size_t)g * 65536; jb.K = 256; jb.N = 256; jb.k0 = (tt >> 1) * 128; jb.n0 = (tt & 1) * 128; }
        else if (t < 96) { jb.src = P.w_qkv + (size_t)j * DM * QKVD; jb.dst = P.Wmix(); jb.K = DM; jb.N = QKVD; jb.k0 = (t / 12) * 128; jb.n0 = (t % 12) * 128; }
        else { const int tt = t - 96; jb.src = P.w_o + (size_t)j * DM * DM; jb.dst = P.Wmix() + (size_t)QKVD * DM; jb.K = DM; jb.N = DM; jb.k0 = (tt >> 3) * 128; jb.n0 = (tt & 7) * 128; }
    }
    return true;
}
__device__ __forceinline__ void phase_convert(const Params& P, int l, int bid, int nb, f16* tile, bool experts = true) {
    const int tid = opaque_tid();
    CvtJob jb;
    int u = bid;
    bool have = cvt_job(P, l, u, jb, experts);
    f32x4 r[8];
    if (have) {
#pragma unroll
        for (int p = 0; p < 8; ++p) { const int id = tid + p * NTHR, kr = id >> 5, c4 = (id & 31) * 4; r[p] = __builtin_nontemporal_load((const f32x4*)(jb.src + (size_t)(jb.k0 + kr) * jb.N + jb.n0 + c4)); }
    }
    while (have) {
        __syncthreads();
#pragma unroll
        for (int p = 0; p < 8; ++p) { const int id = tid + p * NTHR, kr = id >> 5, c4 = (id & 31) * 4; *(f16x4*)(tile + kr * 136 + c4) = pk4(r[p]); }
        __syncthreads();
        const CvtJob cur = jb;
        u += nb; have = cvt_job(P, l, u, jb, experts);
        if (have) {
#pragma unroll
            for (int p = 0; p < 8; ++p) { const int id = tid + p * NTHR, kr = id >> 5, c4 = (id & 31) * 4; r[p] = __builtin_nontemporal_load((const f32x4*)(jb.src + (size_t)(jb.k0 + kr) * jb.N + jb.n0 + c4)); }
        }
        const int n = tid & 127, kg = (tid >> 7) * 32;
        f16* dp = cur.dst + (size_t)(cur.n0 + n) * cur.K + cur.k0 + kg;
#pragma unroll
        for (int i = 0; i < 4; ++i) { f16x8 o;
#pragma unroll
            for (int e = 0; e < 8; ++e) o[e] = tile[(kg + i * 8 + e) * 136 + n];
            *(f16x8*)(dp + i * 8) = o; }
    }
}
template <bool GATEUP, bool CTX>
__device__ __forceinline__ void phase_cvt_ctx(const Params& P, int l, int bid, int nb, f16* tile, int sel = -1, bool alt = false) {
    const int tid = opaque_tid(), wid = P.wv, lane = tid & 63, r16 = lane & 15, kq = lane >> 4;
    constexpr int NC = GATEUP ? 128 : 64;
    constexpr int KT = GATEUP ? 8 : 16, K = GATEUP ? DM : DEXP, N = GATEUP ? DEXP : DM, NB = N / NC;
    constexpr int NT = GATEUP ? 2 * KT : KT;
    const int sel_ = (GATEUP && !CTX) ? sel : -1; const int ntr = (GATEUP && sel_ < 0) ? NT : KT;
    constexpr int TS = NC + 4, TW = 128 * TS;
    constexpr int NLD = NC / 16;
    constexpr int WPC = 8 / (NC / 16);
    constexpr int NRB = 4 / WPC;
    const int cb = wid % (NC / 16), rb0 = (wid / (NC / 16)) * NRB;
    f16* asl = tile + 2 * TW;
    for (int job = bid; job < NEXP * NB; job += nb) {
        const int e = job / NB, nbk = job % NB;
        const f16* ap[2];
        if (CTX) {
#pragma unroll
            for (int p = 0; p < 2; ++p) { const int row = (tid >> 4) + p * 32;
                if (GATEUP) ap[p] = P.H() + (size_t)P.rowidx()[e * SLOTS_PAD + 4096 + row] * DM + (tid & 15) * 8;
                else ap[p] = P.act() + ((size_t)e * SLOTS_PAD + 4096 + row) * DEXP + (tid & 15) * 8; }
        }
        f32x4 acc[2][NRB];
#pragma unroll
        for (int w = 0; w < 2; ++w)
#pragma unroll
            for (int rb = 0; rb < NRB; ++rb) acc[w][rb] = (f32x4){0.f, 0.f, 0.f, 0.f};
        const float* srcs[2]; f16* dsts[2];
        if (GATEUP) { const size_t wo = ((size_t)l * NEXP + e) * DM * DEXP; srcs[0] = P.w_gate + wo; srcs[1] = P.w_up + wo; dsts[0] = P.Wgu() + (alt ? (OFF_WGU3 - OFF_WGU) / 2 : 0) + ((size_t)e * 2) * DEXP * DM; dsts[1] = dsts[0] + (size_t)DEXP * DM; }
        else { srcs[0] = P.w_down + ((size_t)l * NEXP + e) * DEXP * DM; srcs[1] = srcs[0]; dsts[0] = P.Wd() + (alt ? (OFF_WD3 - OFF_WD) / 2 : 0) + (size_t)e * DM * DEXP; dsts[1] = dsts[0]; }
        f32x4 r[2][NLD]; f16x8 ar[2][2];
        const unsigned ldoff = (unsigned)(((tid / (NC / 4)) * N + (tid % (NC / 4)) * 4) * 4);
#define CV_LOAD(ti, slot) do { const int which_ = GATEUP ? (sel_ >= 0 ? sel_ : ((ti) & 1)) : 0, kt_ = (GATEUP && sel_ < 0) ? ((ti) >> 1) : (ti); const char* sp_ = (const char*)(srcs[which_] + (size_t)(kt_ * 128) * N + nbk * NC); \
            _Pragma("unroll") for (int p = 0; p < NLD; ++p) r[slot][p] = __builtin_nontemporal_load((const f32x4*)(sp_ + (size_t)p * (NTHR / (NC / 4)) * N * 4 + ldoff)); \
            if (CTX) { _Pragma("unroll") for (int p = 0; p < 2; ++p) ar[slot][p] = *(const f16x8*)(ap[p] + kt_ * 128); } } while (0)
#define CV_TILE(ti, slot) do { const int which = GATEUP ? (sel_ >= 0 ? sel_ : ((ti) & 1)) : 0, kt = (GATEUP && sel_ < 0) ? ((ti) >> 1) : (ti); \
            f16* tl = tile + (slot) * TW; f16* al = asl + (slot) * (64 * 128); \
            _Pragma("unroll") for (int p = 0; p < NLD; ++p) { const int id = tid + p * NTHR, kr = id / (NC / 4), c4 = (id % (NC / 4)) * 4; *(f16x4*)(tl + kr * TS + c4) = pk4(r[slot][p]); } \
            if (CTX) { _Pragma("unroll") for (int p = 0; p < 2; ++p) { const int row = (tid >> 4) + p * 32; *(f16x8*)(al + row * 128 + (((tid & 15) ^ (row & 15)) * 8)) = ar[slot][p]; } } \
            if ((ti) + 2 < ntr) CV_LOAD((ti) + 2, slot); \
            asm volatile("s_waitcnt lgkmcnt(0)" ::: "memory"); __builtin_amdgcn_s_barrier(); asm volatile("" ::: "memory"); \
            f16* dp = dsts[which] + (size_t)(nbk * NC + cb * 16 + r16) * K + kt * 128 + kq * 8; \
            _Pragma("unroll") for (int ks = 0; ks < 4; ++ks) { f16x8 bv; \
                _Pragma("unroll") for (int i = 0; i < 8; ++i) bv[i] = tl[(ks * 32 + kq * 8 + i) * TS + cb * 16 + r16]; \
                if (rb0 == 0) *(f16x8*)(dp + ks * 32) = bv; \
                if (CTX) { _Pragma("unroll") for (int rb = 0; rb < NRB; ++rb) { const int row = (rb0 + rb) * 16 + r16; const f16x8 af = *(const f16x8*)(al + row * 128 + (((ks * 4 + kq) ^ r16) * 8)); \
                    acc[which][rb] = __builtin_amdgcn_mfma_f32_16x16x32_f16(bv, af, acc[which][rb], 0, 0, 0); } } } } while (0)
        CV_LOAD(0, 0); CV_LOAD(1, 1);
        for (int t2 = 0; t2 < ntr; t2 += 2) { CV_TILE(t2, 0); CV_TILE(t2 + 1, 1); }
#undef CV_LOAD
#undef CV_TILE
        asm volatile("s_waitcnt lgkmcnt(0)" ::: "memory"); __builtin_amdgcn_s_barrier(); asm volatile("" ::: "memory");
        if (CTX) {
#pragma unroll
            for (int rb = 0; rb < NRB; ++rb) {
                const size_t row = (size_t)e * SLOTS_PAD + 4096 + (rb0 + rb) * 16 + r16; const int col = nbk * NC + cb * 16 + 4 * kq;
                if (GATEUP) { f32x4 o;
#pragma unroll
                    for (int jj = 0; jj < 4; ++jj) o[jj] = silu_f(acc[0][rb][jj]) * acc[1][rb][jj];
                    *(f16x4*)(P.act() + row * DEXP + col) = pk4(o); }
                else *(f16x4*)(P.yslot() + row * DM + col) = pk4(acc[0][rb]);
            }
        }
    }
}

__device__ __forceinline__ void cvt3_job(const Params& P, int job, f16* tile) {
    if (job < 256) phase_cvt_ctx<false, false>(P, 3, job, 1 << 20, tile, -1, true);
    else { const int h = job - 256; phase_cvt_ctx<true, false>(P, 3, h >> 1, 1 << 20, tile, h & 1, true); }
}
__device__ __forceinline__ void phase_gateup_fast(const Params& P, LAS unsigned char* lds, int rt = 17, bool alt = false) { fg::PRGateUp S; S.H = P.H(); S.rowidx = P.rowidx(); S.W = P.Wgu() + (alt ? (OFF_WGU3 - OFF_WGU) / 2 : 0); S.act = P.act(); S.rt = rt; S.nunits = 16 * rt * 16; S.bid = opaque_bid(); fg::gemm_phase(lds, S, P.wv); }
__device__ __forceinline__ void phase_down_fast(const Params& P, LAS unsigned char* lds, int rt = 17, bool alt = false) { fg::PRDown S; S.act = P.act(); S.W = P.Wd() + (alt ? (OFF_WD3 - OFF_WD) / 2 : 0); S.y = P.yslot(); S.rt = rt; S.nunits = 16 * rt * 4; S.bid = opaque_bid(); fg::gemm_phase(lds, S, P.wv); }
__device__ __forceinline__ void phase_pool_fast(const Params& P, LAS unsigned char* lds) { fg::PRDense<256> S; S.qn = nullptr; S.kn = nullptr; S.rope = nullptr; S.xs = nullptr; S.lane = 0; S.npan = 130; S.kvx = 0; S.A = P.H(); S.W = P.Wmix(); S.O0 = P.Z(); S.O1 = nullptr; S.O2 = nullptr; S.ncol = 4; S.mode = 2; S.bid = opaque_bid(); fg::gemm_phase(lds, S, P.wv); }
__device__ __forceinline__ void phase_qkv_fast(const Params& P, LAS unsigned char* lds, bool lastl = false, int l = 1) { fg::PRDense<1024> S; S.qn = P.q_norm + (l >> 1) * 64; S.kn = P.k_norm + (l >> 1) * 64; S.rope = P.rope(); S.xs = (LAS float*)(lds + fg::STAGE_BYTES); S.lane = opaque_tid_(P.wv) & 63; S.npan = lastl ? 128 : 130; S.kvx = lastl ? 4 : 0; S.A = P.H(); S.W = P.Wmix(); S.O0 = P.Q(); S.O1 = P.Kb(); S.O2 = P.Vb(); S.ncol = 6; S.mode = 1; S.bid = opaque_bid(); fg::gemm_phase(lds, S, P.wv); }
__device__ __forceinline__ void phase_oproj_fast(const Params& P, LAS unsigned char* lds, bool lastl = false) { fg::PRDense<1024> S; S.qn = nullptr; S.kn = nullptr; S.rope = nullptr; S.xs = nullptr; S.lane = 0; S.npan = lastl ? 128 : 130; S.kvx = 0; S.A = P.O(); S.W = P.Wmix() + (size_t)QKVD * DM; S.O0 = P.Z(); S.O1 = nullptr; S.O2 = nullptr; S.ncol = 4; S.mode = 0; S.bid = opaque_bid(); fg::gemm_phase(lds, S, P.wv); }

typedef float f32x16 __attribute__((ext_vector_type(16)));
#define AT_KB 9216
#define AT_VB 8704
template <int VAR = 0>
__device__ __forceinline__ void phase_attn_fast(const Params& P, int l, LAS unsigned char* lds, bool do_ctx, int cvt_l = -1) {
    const int j = l >> 1;
    const int tid = opaque_tid(), wid = tid >> 6, lane = tid & 63, l32 = lane & 31, hi = lane >> 5;
    const int g = wid >> 1, qoff = (wid & 1) * 64, qoffu = (P.wv & 1) * 64;
    const int nunits = do_ctx ? 1040 : 1024;
    int ucount = 0;
    for (int u = opaque_bid(); u < nunits; u += gridDim.x, ++ucount) {
        int b, qblk, kv, qrow0, t0, t1, s0;
        if (u < 1024) { b = u >> 9; qblk = (u >> 2) & 127; kv = u & 3; s0 = b * SEQ; qrow0 = s0 + qblk * 128; t0 = qblk == 0 ? 2 : 0; t1 = qblk == 127 ? 4 : 6; }
        else { const int uu = u - 1024; b = uu >> 3; qblk = (uu >> 2) & 1; kv = uu & 3; s0 = NLAT + b * CTXL; qrow0 = s0 + qblk * 128; t0 = 0; t1 = 0; }
        const int cb = NLAT + b * CTXL, nloc = t1 - t0, ntiles = nloc + 4;
        const int h = kv * 4 + g;
        f16x8 Qf[2][4];
#pragma unroll
        for (int qb = 0; qb < 2; ++qb)
#pragma unroll
            for (int ks = 0; ks < 4; ++ks) Qf[qb][ks] = *(const f16x8*)(P.Q() + (size_t)(qrow0 + qoff + 32 * qb + l32) * 1024 + h * 64 + 16 * ks + 8 * hi);
        f32x16 OT[2][2];
#pragma unroll
        for (int db = 0; db < 2; ++db)
#pragma unroll
            for (int qb = 0; qb < 2; ++qb)
#pragma unroll
                for (int r = 0; r < 16; ++r) OT[db][qb][r] = 0.f;
        float mrun[2], lrun[2];
        { const float sk = P.sink[j * 16 + h] * 1.4426950408889634f; mrun[0] = sk; mrun[1] = sk; lrun[0] = hi == 0 ? 1.0f : 0.0f; lrun[1] = lrun[0]; }
        const int lkey = tid >> 3, lpc = tid & 7;
        f16x8 kreg, vreg;
        auto tile_row = [&](int it) -> int { return it < nloc ? (qrow0 - 128 + 64 * (t0 + it)) : (cb + 64 * (it - nloc)); };
        { const int kr = tile_row(0) + lkey; kreg = *(const f16x8*)(P.Kb() + (size_t)kr * 256 + kv * 64 + lpc * 8); vreg = *(const f16x8*)(P.Vb() + (size_t)kr * 256 + kv * 64 + lpc * 8); }
        __syncthreads();
        {
            LAS f16* Kl = (LAS f16*)(lds); LAS f16* Vl = (LAS f16*)(lds + 2 * AT_KB);
            *(LAS f16x8*)(Kl + lkey * 72 + lpc * 8) = kreg;
#pragma unroll
            for (int i = 0; i < 8; ++i) Vl[(lpc * 8 + i) * 68 + lkey] = vreg[i];
        }
        __syncthreads();
        for (int it = 0; it < ntiles; ++it) {
            const int buf = it & 1;
            if (it + 1 < ntiles) { const int kr = tile_row(it + 1) + lkey; kreg = *(const f16x8*)(P.Kb() + (size_t)kr * 256 + kv * 64 + lpc * 8); vreg = *(const f16x8*)(P.Vb() + (size_t)kr * 256 + kv * 64 + lpc * 8); }
            const LAS f16* Kl = (const LAS f16*)(lds + buf * AT_KB); const LAS f16* Vl = (const LAS f16*)(lds + 2 * AT_KB + buf * AT_VB);
            int cls = 0;
            if (it < nloc) { const int tl = t0 + it, dmin = qoffu + 65 - 64 * tl, dmax = qoffu + 191 - 64 * tl; cls = (dmin > 128 || dmax < -128) ? 2 : ((dmin >= -128 && dmax <= 128) ? 0 : 1); }
            if (cls != 2) {
            f32x16 S[2][2];
#pragma unroll
            for (int kb = 0; kb < 2; ++kb)
#pragma unroll
                for (int qb = 0; qb < 2; ++qb)
#pragma unroll
                    for (int r = 0; r < 16; ++r) S[kb][qb][r] = -mrun[qb];
#pragma unroll
            for (int ks = 0; ks < 4; ++ks)
#pragma unroll
                for (int kb = 0; kb < 2; ++kb) {
                    const f16x8 kf = *(const LAS f16x8*)(Kl + (32 * kb + l32) * 72 + 16 * ks + 8 * hi);
#pragma unroll
                    for (int qb = 0; qb < 2; ++qb) S[kb][qb] = __builtin_amdgcn_mfma_f32_32x32x16_f16(kf, Qf[qb][ks], S[kb][qb], 0, 0, 0);
                }
            if (cls == 1) {
                const int kt = 64 * (t0 + it);
#pragma unroll
                for (int qb = 0; qb < 2; ++qb) {
                    const int qp = 128 + qoff + 32 * qb + l32;
#pragma unroll
                    for (int kb = 0; kb < 2; ++kb)
#pragma unroll
                        for (int r = 0; r < 16; ++r) { const int kp = kt + 32 * kb + 8 * (r >> 2) + 4 * hi + (r & 3); const int d = qp - kp; if (d > 128 || d < -128) S[kb][qb][r] = -INFINITY; }
                }
            }
            f16x8 Pf[2][4];
#pragma unroll
            for (int qb = 0; qb < 2; ++qb) {
                float mx = S[0][qb][0];
#pragma unroll
                for (int kb = 0; kb < 2; ++kb)
#pragma unroll
                    for (int r = 0; r < 16; ++r) mx = fmaxf(mx, S[kb][qb][r]);
                { const auto sw = __builtin_amdgcn_permlane32_swap(__float_as_uint(mx), __float_as_uint(mx), false, false); mx = fmaxf(__uint_as_float(sw[0]), __uint_as_float(sw[1])); }
                if (__builtin_amdgcn_ballot_w64(mx > 8.0f) != 0ull) {
                    const float g = fmaxf(mx, 0.f), corr = __builtin_amdgcn_exp2f(-g);
                    mrun[qb] += g; lrun[qb] *= corr;
#pragma unroll
                    for (int kb = 0; kb < 2; ++kb)
#pragma unroll
                        for (int r = 0; r < 16; ++r) S[kb][qb][r] -= g;
#pragma unroll
                    for (int db = 0; db < 2; ++db)
#pragma unroll
                        for (int r = 0; r < 16; ++r) OT[db][qb][r] *= corr;
                }
                float ps = 0.f;
#pragma unroll
                for (int kb = 0; kb < 2; ++kb)
#pragma unroll
                    for (int r = 0; r < 16; ++r) { const float p = __builtin_amdgcn_exp2f(S[kb][qb][r]); S[kb][qb][r] = p; ps += p; }
                lrun[qb] += ps;
#pragma unroll
                for (int ks = 0; ks < 4; ++ks) { const int kb = ks >> 1, r0 = 8 * (ks & 1);
#pragma unroll
                    for (int e = 0; e < 8; ++e) Pf[qb][ks][e] = (f16)S[kb][qb][r0 + e]; }
            }
#pragma unroll
            for (int ks = 0; ks < 4; ++ks)
#pragma unroll
                for (int db = 0; db < 2; ++db) {
                    const LAS f16* vp = Vl + (32 * db + l32) * 68 + 16 * ks + 4 * hi;
                    const f16x4 v0 = *(const LAS f16x4*)vp, v1 = *(const LAS f16x4*)(vp + 8);
                    const f16x8 vf = (f16x8){v0[0], v0[1], v0[2], v0[3], v1[0], v1[1], v1[2], v1[3]};
#pragma unroll
                    for (int qb = 0; qb < 2; ++qb) OT[db][qb] = __builtin_amdgcn_mfma_f32_32x32x16_f16(vf, Pf[qb][ks], OT[db][qb], 0, 0, 0);
                }
            }
            if (it + 1 < ntiles) {
                LAS f16* Kw = (LAS f16*)(lds + (buf ^ 1) * AT_KB); LAS f16* Vw = (LAS f16*)(lds + 2 * AT_KB + (buf ^ 1) * AT_VB);
                *(LAS f16x8*)(Kw + lkey * 72 + lpc * 8) = kreg;
#pragma unroll
                for (int i = 0; i < 8; ++i) Vw[(lpc * 8 + i) * 68 + lkey] = vreg[i];
            }
            __syncthreads();
        }
#pragma unroll
        for (int qb = 0; qb < 2; ++qb) {
            const float lt = lrun[qb] + shx<32>(lrun[qb], lane);
            const float inv = 1.0f / lt;
            f16* op = P.O() + (size_t)(qrow0 + qoff + 32 * qb + l32) * 1024 + h * 64;
#pragma unroll
            for (int db = 0; db < 2; ++db)
#pragma unroll
                for (int i = 0; i < 4; ++i) {
                    const f16x4 o = (f16x4){(f16)(OT[db][qb][4 * i] * inv), (f16)(OT[db][qb][4 * i + 1] * inv), (f16)(OT[db][qb][4 * i + 2] * inv), (f16)(OT[db][qb][4 * i + 3] * inv)};
                    *(f16x4*)(op + 32 * db + 8 * i + 4 * hi) = o;
                }
        }
    }
}

#define MEGA_LDS (147456 + 16)
__device__ __forceinline__ const Params& opq(Params& q) { int z; asm volatile("s_mov_b32 %0, 0" : "=s"(z)); q.zoff = z; return q; }
__global__ __launch_bounds__(NTHR, 2) void mega(Params P) {
    extern __shared__ __attribute__((aligned(16))) unsigned char shm[];
    LAS unsigned char* lds = (LAS unsigned char*)shm;
    volatile LAS unsigned* st = (volatile LAS unsigned*)(lds + 147456);
    if (threadIdx.x == 0) { st[0] = 0u; st[1] = 0u; st[2] = 0u; st[3] = 0u; }
    __syncthreads();
    const XcdBarrier bar = xcd_barrier_post(P.bar(), st);
    const int nb = gridDim.x;
#define bid (opaque_bid())
    Params Q = P; Q.wv = __builtin_amdgcn_readfirstlane(threadIdx.x >> 6);
#define P (opq(Q))
    phase_ada(P, bid, nb, (float*)shm);
    __syncthreads();
    phase_convert(P, 0, bid, nb, (f16*)shm, false);
    xcd_barrier(bar);
    for (int l = 0; l < 4; ++l) {
        if (l == 0) phase_n1<true, false>(P, l, bid, nb); else { phase_n1<false, false>(P, l, bid, nb); __syncthreads(); phase_convert(P, l, bid, nb, (f16*)shm, false);
            }
        xcd_barrier(bar);
        if ((l & 1) == 0) {
            phase_pool_fast(P, lds);
            xcd_barrier(bar);
            phase_n2<true>(P, l, bid, nb, (float*)shm);
        } else {
            phase_qkv_fast(P, lds, l == 3, l);
            if (nb == 256 && (bid & 7) >= 2) { __syncthreads(); cvt3_job(P, (l == 1 ? 192 : 576) + ((bid & 7) - 2) * 32 + (bid >> 3), (f16*)shm); }
            xcd_barrier(bar);
            phase_attn_fast(P, l, lds, l != 3);
            if (l == 3 && nb != 256) { __syncthreads(); phase_cvt_ctx<true, false>(P, l, bid, nb, (f16*)shm, -1, true); phase_cvt_ctx<false, false>(P, l, bid, nb, (f16*)shm, -1, true); }
            xcd_barrier(bar);
            phase_oproj_fast(P, lds, l == 3);
            if (l == 1 && nb == 256 && (bid & 7) >= 2) { __syncthreads(); cvt3_job(P, 384 + ((bid & 7) - 2) * 32 + (bid >> 3), (f16*)shm); }
            xcd_barrier(bar);
            phase_n2<false>(P, l, bid, nb, (float*)shm, l == 3 ? NLAT : MROWS);
        }
        xcd_barrier(bar);
        phase_topk(P, bid, nb, (unsigned*)shm, l == 3 ? 32 : 64);
        if (l < 3 && nb == 256 && bid >= 64 && bid < 128) cvt3_job(P, l * 64 + bid - 64, (f16*)shm);
        xcd_barrier(bar);
        if (l < 3) { phase_cvt_ctx<true, true>(P, l, bid, nb, (f16*)shm); xcd_barrier(bar); }
        phase_gateup_fast(P, lds, 16, l == 3);
        if (l < 3) { __syncthreads(); phase_cvt_ctx<false, true>(P, l, bid, nb, (f16*)shm); }
        xcd_barrier(bar);
        phase_down_fast(P, lds, 16, l == 3);
        xcd_barrier(bar);
    }
    phase_n1<false, true>(P, 4, bid, nb);
#undef P
#undef bid
}

static inline size_t al256(size_t v) { return (v + 255) & ~(size_t)255; }

extern "C" void kernel_launch(void* const* d_in, const int* in_sizes, int n_in, void* d_out, int out_size, void* d_ws, size_t ws_size, hipStream_t stream) {
    Params P{};
    P.x = (const float*)d_in[0]; P.c = (const float*)d_in[1]; P.ctx = (const float*)d_in[2]; P.c_ctx = (const float*)d_in[3];
    P.w_ada = (const float*)d_in[4]; P.b_ada = (const float*)d_in[5]; P.norm1_g = (const float*)d_in[6]; P.norm2_g = (const float*)d_in[7];
    P.pool_w = (const float*)d_in[8]; P.pool_scale = (const float*)d_in[9]; P.w_qkv = (const float*)d_in[10]; P.w_o = (const float*)d_in[11];
    P.q_norm = (const float*)d_in[12]; P.k_norm = (const float*)d_in[13]; P.sink = (const float*)d_in[14]; P.router_w = (const float*)d_in[15];
    P.w_gate = (const float*)d_in[16]; P.w_up = (const float*)d_in[17]; P.w_down = (const float*)d_in[18];
    P.out = (float*)d_out;
    P.ws = (char*)d_ws; const size_t off = WS_TOTAL;
    if (off > ws_size) { fprintf(stderr, "workspace too small: need %zu have %zu\n", off, ws_size); return; }
    static int grid = 0;
    if (!grid) {
        int dev = 0, cus = 0, per_cu = 0;
        hipGetDevice(&dev);
        hipDeviceGetAttribute(&cus, hipDeviceAttributeMultiprocessorCount, dev);
        hipFuncSetAttribute((const void*)mega, hipFuncAttributeMaxDynamicSharedMemorySize, MEGA_LDS);
        hipOccupancyMaxActiveBlocksPerMultiprocessor(&per_cu, (const void*)mega, NTHR, MEGA_LDS);
        if (per_cu < 1) { fprintf(stderr, "mega: occupancy query says %d blocks per CU\n", per_cu); }
        grid = cus > 0 ? cus : 256;
    }
    hipMemsetAsync(P.bar(), 0, XCD_BAR_WORDS * sizeof(unsigned), stream);
    hipLaunchKernelGGL(mega, dim3(grid), dim3(NTHR), MEGA_LDS, stream, P);
}
```

```cpp
#include <hip/hip_runtime.h>
#include <stdint.h>
#include <stdio.h>

typedef _Float16 f16;
typedef _Float16 f16x2 __attribute__((ext_vector_type(2)));
typedef _Float16 f16x4 __attribute__((ext_vector_type(4)));
typedef _Float16 f16x8 __attribute__((ext_vector_type(8)));
typedef float f32x4 __attribute__((ext_vector_type(4)));
typedef float f32x2 __attribute__((ext_vector_type(2)));

#define LAS __attribute__((address_space(3)))
#define DM 1024
#define SEQ 16384
#define NLAT 32768
#define CTXL 256
#define NCTX 512
#define MROWS 33280
#define NEXP 16
#define DEXP 2048
#define SLOTS 4160
#define SLOTS_PAD 4352
#define QKVD 1536
#define NTHR 512

constexpr size_t al256c(size_t v) { return (v + 255) & ~(size_t)255; }
constexpr size_t OFF_BAR = 0;
constexpr size_t OFF_MOD = al256c(OFF_BAR + 16384);
constexpr size_t OFF_ROPE = al256c(OFF_MOD + (size_t)4 * 3 * 6 * DM * 4);
constexpr size_t OFF_X = al256c(OFF_ROPE + (size_t)256 * 16 * 2 * 4);
constexpr size_t OFF_H = al256c(OFF_X + (size_t)MROWS * DM * 4);
constexpr size_t OFF_Z = al256c(OFF_H + (size_t)MROWS * DM * 2);
constexpr size_t OFF_Q = al256c(OFF_Z + (size_t)MROWS * DM * 2);
constexpr size_t OFF_KB = al256c(OFF_Q + (size_t)MROWS * DM * 2);
constexpr size_t OFF_VB = al256c(OFF_KB + (size_t)MROWS * 256 * 2);
constexpr size_t OFF_VT = al256c(OFF_VB + (size_t)MROWS * 256 * 2);
constexpr size_t OFF_O = al256c(OFF_VT + (size_t)MROWS * 256 * 2);
constexpr size_t OFF_AFF = al256c(OFF_O + (size_t)MROWS * DM * 2);
constexpr size_t OFF_INV = al256c(OFF_AFF + (size_t)MROWS * 16 * 4);
constexpr size_t OFF_ROWIDX = al256c(OFF_INV + (size_t)MROWS * 16 * 4);
constexpr size_t OFF_ACT = al256c(OFF_ROWIDX + (size_t)NEXP * SLOTS_PAD * 4);
constexpr size_t OFF_YSLOT = al256c(OFF_ACT + (size_t)NEXP * SLOTS_PAD * DEXP * 2);
constexpr size_t OFF_WGU = al256c(OFF_YSLOT + (size_t)NEXP * SLOTS_PAD * DM * 2);
constexpr size_t OFF_WD = al256c(OFF_WGU + (size_t)NEXP * 2 * DEXP * DM * 2);
constexpr size_t OFF_WMIX = al256c(OFF_WD + (size_t)NEXP * DM * DEXP * 2);
constexpr size_t OFF_WGU3 = al256c(OFF_WMIX + (size_t)(QKVD + DM) * DM * 2);
constexpr size_t OFF_WD3 = al256c(OFF_WGU3 + (size_t)NEXP * 2 * DEXP * DM * 2);
constexpr size_t OFF_DUMMY = al256c(OFF_WD3 + (size_t)NEXP * DM * DEXP * 2);
constexpr size_t WS_TOTAL = OFF_DUMMY;
struct Params {
    const float *x, *c, *ctx, *c_ctx, *w_ada, *b_ada, *norm1_g, *norm2_g, *pool_w, *pool_scale, *w_qkv, *w_o, *q_norm, *k_norm, *sink, *router_w, *w_gate, *w_up, *w_down;
    float* out; char* ws; int wv; int zoff;
#define WSF(name, type, off) __host__ __device__ __forceinline__ type* name() const { return (type*)(ws + zoff + (off)); }
    WSF(bar, unsigned, OFF_BAR) WSF(mod, float, OFF_MOD) WSF(rope, float, OFF_ROPE) WSF(X, f16, OFF_X) WSF(H, f16, OFF_H) WSF(Z, f16, OFF_Z) WSF(Q, f16, OFF_Q) WSF(Kb, f16, OFF_KB) WSF(Vb, f16, OFF_VB) WSF(Vt, f16, OFF_VT)
    WSF(O, f16, OFF_O) WSF(aff, float, OFF_AFF) WSF(inv, int, OFF_INV) WSF(rowidx, int, OFF_ROWIDX) WSF(act, f16, OFF_ACT) WSF(yslot, f16, OFF_YSLOT) WSF(Wgu, f16, OFF_WGU) WSF(Wd, f16, OFF_WD) WSF(Wmix, f16, OFF_WMIX)
#undef WSF
#define WSW(name, type, off) __host__ __device__ __forceinline__ type* name() const { return (type*)(ws + zoff + (off)); }
    WSW(Xw, f16, OFF_X) WSW(Ow, f16, OFF_O) WSW(Hw, f16, OFF_H) WSW(affw, float, OFF_AFF) WSW(Qw, f16, OFF_Q) WSW(Kw, f16, OFF_KB)
#undef WSW
};

template <int O> __device__ __forceinline__ float shx(float v, int lane) {
    if (O == 1) return __int_as_float(__builtin_amdgcn_update_dpp(0, __float_as_int(v), 0xB1, 0xF, 0xF, true));
    if (O == 2) return __int_as_float(__builtin_amdgcn_update_dpp(0, __float_as_int(v), 0x4E, 0xF, 0xF, true));
    if (O < 32) return __int_as_float(__builtin_amdgcn_ds_swizzle(__float_as_int(v), (O << 10) | 0x1f));
    return __int_as_float(__builtin_amdgcn_ds_bpermute((lane ^ O) << 2, __float_as_int(v)));
}
__device__ __forceinline__ float wave_sum(float v, int lane) {
    v += shx<1>(v, lane); v += shx<2>(v, lane); v += shx<4>(v, lane); v += shx<8>(v, lane); v += shx<16>(v, lane); v += shx<32>(v, lane);
    return v;
}
__device__ __forceinline__ unsigned shup(unsigned v, int o, int lane) { return (unsigned)__builtin_amdgcn_ds_bpermute((lane - o) << 2, (int)v); }
__device__ __forceinline__ int opaque_bid() { int b = blockIdx.x; asm volatile("" : "+s"(b)); return b; }
#define opaque_tid() opaque_tid_(P.wv)
__device__ __forceinline__ int opaque_tid_(int wv) { int ln; asm volatile("v_mbcnt_lo_u32_b32 %0, -1, 0\n\tv_mbcnt_hi_u32_b32 %0, -1, %0" : "=v"(ln)); return (wv << 6) | ln; }
__device__ __forceinline__ float silu_f(float v) { return v * __builtin_amdgcn_rcpf(1.0f + __expf(-v)); }

__device__ __forceinline__ const float* modp(const Params& P, int l, int v, int j) { return P.mod() + (size_t)((l * 3 + v) * 6 + j) * DM; }

__device__ __forceinline__ void phase_ada(const Params& P, int bid, int nb, float* lds) {
    float* sc = lds; float* red = lds + 3 * DM;
    const int tid = opaque_tid();
    for (int i = tid; i < 3 * DM; i += NTHR) { const int v = i >> 10, k = i & 1023; const float cv = v < 2 ? P.c[v * DM + k] : P.c_ctx[k]; sc[i] = silu_f(cv); }
    __syncthreads();
    for (int u = bid; u < 4 * 96; u += nb) {
        const int l = u / 96, ch = u % 96, col = ch * 64 + (tid & 63), ks = tid >> 6;
        const float* w = P.w_ada + (size_t)l * DM * 6 * DM + col;
        float s0 = 0.f, s1 = 0.f, s2 = 0.f;
        for (int k = ks * 128; k < ks * 128 + 128; ++k) { const float wv = __builtin_nontemporal_load(w + (size_t)k * 6 * DM); s0 += sc[k] * wv; s1 += sc[DM + k] * wv; s2 += sc[2 * DM + k] * wv; }
        red[(ks * 3 + 0) * 64 + (tid & 63)] = s0; red[(ks * 3 + 1) * 64 + (tid & 63)] = s1; red[(ks * 3 + 2) * 64 + (tid & 63)] = s2;
        __syncthreads();
        if (tid < 192) { const int v = tid >> 6, cc = tid & 63; float s = 0.f;
#pragma unroll
            for (int q = 0; q < 8; ++q) s += red[(q * 3 + v) * 64 + cc];
            const int colg = ch * 64 + cc; s += P.b_ada[l * 6 * DM + colg];
            const int j = colg >> 10, d = colg & 1023;
            P.mod()[(size_t)((l * 3 + v) * 6 + j) * DM + d] = s; }
        __syncthreads();
    }
    for (int i = bid * NTHR + tid; i < 256 * 16; i += nb * NTHR) {
        const int p = i >> 4, f = i & 15;
        const float inv = powf(10000.0f, -(float)f / 16.0f);
        const float angf = (float)p * inv;
        double a = (double)angf;
        const double twopi = 6.283185307179586476925286766559;
        a -= twopi * rint(a / twopi);
        const double a2 = a * a;
        double cs = 1.0, sn = 1.0;
        double tc = 0.0, ts = 0.0;
        for (int n = 16; n >= 1; --n) { tc = (tc + 1.0) * (-a2 / (double)((2 * n - 1) * (2 * n))); ts = (ts + 1.0) * (-a2 / (double)((2 * n) * (2 * n + 1))); }
        cs = 1.0 + tc; sn = a * (1.0 + ts);
        P.rope()[i * 2] = (float)cs; P.rope()[i * 2 + 1] = (float)sn;
    }
}

__device__ __forceinline__ f32x4 cvt4(const f16x4 v) { return (f32x4){(float)v[0], (float)v[1], (float)v[2], (float)v[3]}; }
__device__ __forceinline__ f16x4 pk4(const f32x4 v) { return (f16x4){(f16)v[0], (f16)v[1], (f16)v[2], (f16)v[3]}; }
__device__ __forceinline__ float dot4(const f32x4 a, const f32x4 b) { return a[0] * b[0] + a[1] * b[1] + a[2] * b[2] + a[3] * b[3]; }
template <bool FIRST, bool FINAL>
__device__ __forceinline__ void phase_n1(const Params& P, int l, int bid, int nb) {
    constexpr int R = 4;
    const int tid_ = opaque_tid(); const int wid = P.wv, lane = tid_ & 63;
    const int nrows = FINAL ? NLAT : MROWS;
    for (int rb = (bid * 8 + wid) * R; rb < nrows; rb += nb * 8 * R) {
        const int v = rb < NLAT ? (rb >> 14) : 2;
        f32x4 xv[R][4];
#pragma unroll
        for (int u = 0; u < R; ++u) {
            const int r = rb + u;
            if (FIRST) { const float* src = r < NLAT ? P.x + (size_t)r * DM : P.ctx + (size_t)(r - NLAT) * DM;
#pragma unroll
                for (int q = 0; q < 4; ++q) xv[u][q] = __builtin_nontemporal_load((const f32x4*)(src + q * 256 + lane * 4)); }
            else { const f16* src = P.X() + (size_t)r * DM;
#pragma unroll
                for (int q = 0; q < 4; ++q) xv[u][q] = cvt4(*(const f16x4*)(src + q * 256 + lane * 4)); }
        }
        if (!FIRST) {
            const int sl = P.inv()[(size_t)(lane & 15) * MROWS + rb + (lane >> 4)];
            const float af = P.aff()[(size_t)(lane & 15) * MROWS + rb + (lane >> 4)];
            const unsigned long long bal = __builtin_amdgcn_ballot_w64(sl >= 0);
            unsigned m[R];
#pragma unroll
            for (int u = 0; u < R; ++u) m[u] = (unsigned)(bal >> (16 * u)) & 0xffffu;
            const f16* ys = P.yslot();
            const float* g2 = modp(P, l - 1, v, 5);
            f32x4 gv[4];
#pragma unroll
            for (int q = 0; q < 4; ++q) gv[q] = *(const f32x4*)(g2 + q * 256 + lane * 4);
            while (m[0] | m[1] | m[2] | m[3]) {
                f16x4 yv[R][4]; float w[R];
#pragma unroll
                for (int u = 0; u < R; ++u) {
                    const int e = m[u] ? __builtin_ctz(m[u]) : 0;
                    const int sv = m[u] ? __builtin_amdgcn_readlane(sl, 16 * u + e) : 0;
                    w[u] = m[u] ? __int_as_float(__builtin_amdgcn_readlane(__float_as_int(af), 16 * u + e)) : 0.f;
                    m[u] &= m[u] - 1u;
                    const f16* y = ys + ((size_t)e * SLOTS_PAD + sv) * DM + lane * 4;
#pragma unroll
                    for (int q = 0; q < 4; ++q) yv[u][q] = *(const f16x4*)(y + q * 256);
                }
#pragma unroll
                for (int u = 0; u < R; ++u)
#pragma unroll
                    for (int q = 0; q < 4; ++q) xv[u][q] += (w[u] * gv[q]) * cvt4(yv[u][q]);
            }
        }
        if (FINAL) {
#pragma unroll
            for (int u = 0; u < R; ++u)
#pragma unroll
                for (int q = 0; q < 4; ++q) __builtin_nontemporal_store(xv[u][q], (f32x4*)(P.out + (size_t)(rb + u) * DM + q * 256 + lane * 4));
            continue;
        }
        float ss[R];
#pragma unroll
        for (int u = 0; u < R; ++u) {
            f16* xd = P.Xw() + (size_t)(rb + u) * DM; float sacc = 0.f;
#pragma unroll
            for (int q = 0; q < 4; ++q) { *(f16x4*)(xd + q * 256 + lane * 4) = pk4(xv[u][q]); sacc += dot4(xv[u][q], xv[u][q]); }
            ss[u] = sacc;
        }
#pragma unroll
        for (int u = 0; u < R; ++u) ss[u] = rsqrtf(wave_sum(ss[u], lane) * (1.0f / DM) + 1e-6f);
        const float* g = P.norm1_g + l * DM; const float* sh = modp(P, l, v, 0); const float* scl = modp(P, l, v, 1);
#pragma unroll
        for (int q = 0; q < 4; ++q) {
            const int c0 = q * 256 + lane * 4;
            const f32x4 gq = *(const f32x4*)(g + c0), sq = *(const f32x4*)(sh + c0), cq = *(const f32x4*)(scl + c0);
            const f32x4 gm = gq * (1.0f + cq);
#pragma unroll
            for (int u = 0; u < R; ++u) *(f16x4*)(P.Hw() + (size_t)(rb + u) * DM + c0) = pk4(xv[u][q] * ss[u] * gm + sq);
        }
    }
}

#define N2_ZST 81920
template <bool POOL>
__device__ __forceinline__ void phase_n2(const Params& P, int l, int bid, int nb, float* lds, int nrows = MROWS) {
    const int tid = opaque_tid(), wid = P.wv, lane = tid & 63;
    const float* wr = P.router_w + (size_t)l * DM * NEXP;
    f16* wh = (f16*)lds;
    for (int i = tid; i < DM * NEXP; i += NTHR) { const int d = i >> 4, e = i & 15; wh[e * 1032 + d] = (f16)wr[i]; }
    f16* h2s = (f16*)lds + 16640;
    LAS unsigned char* zst = (LAS unsigned char*)lds + N2_ZST;
    const int j = l >> 1, nblk = nrows >> 4;
    const f16* Zg = P.Z();
    const f16* Xg = P.X();
    f16x4 xr[2][4]; f16x4 zr[2][4];
    auto prefetch = [&](int blk) {
        const int R0 = blk * 16, rb = R0 + wid * 2;
        if (POOL) {
            int s0, L; if (R0 < NLAT) { s0 = (R0 >> 14) << 14; L = SEQ; } else { s0 = NLAT + (((R0 - NLAT) >> 8) << 8); L = CTXL; }
#pragma unroll
            for (int i = 0; i < 8; ++i) { const int piece = wid * 8 + i; int rr = R0 - 8 + (piece >> 1); rr = rr < s0 ? s0 : (rr > s0 + L - 1 ? s0 + L - 1 : rr);
                __builtin_amdgcn_global_load_lds((const unsigned*)(Zg + (size_t)rr * DM + (piece & 1) * 512 + lane * 8), (LAS unsigned*)(zst + piece * 1024), 16, 0, 0); }
        } else {
#pragma unroll
            for (int u = 0; u < 2; ++u)
#pragma unroll
                for (int q = 0; q < 4; ++q) zr[u][q] = *(const f16x4*)(Zg + (size_t)(rb + u) * DM + q * 256 + lane * 4);
        }
#pragma unroll
        for (int u = 0; u < 2; ++u)
#pragma unroll
            for (int q = 0; q < 4; ++q) xr[u][q] = *(const f16x4*)(Xg + (size_t)(rb + u) * DM + q * 256 + lane * 4);
    };
    int blk = bid;
    if (blk < nblk) prefetch(blk);
    __syncthreads();
    while (blk < nblk) {
        const int R0 = blk * 16, rb = R0 + wid * 2;
        int v, s0, L;
        if (rb < NLAT) { v = rb >> 14; s0 = v << 14; L = SEQ; } else { v = 2; s0 = NLAT + (((rb - NLAT) >> 8) << 8); L = CTXL; }
        const int t = rb - s0;
        f32x4 g1v[4], gmv[4], shv[4], psv[4];
        { const float* g1 = modp(P, l, v, 2); const float* g = P.norm2_g + l * DM; const float* sh = modp(P, l, v, 3); const float* scl = modp(P, l, v, 4);
#pragma unroll
            for (int q = 0; q < 4; ++q) { const int c0 = q * 256 + lane * 4;
                g1v[q] = *(const f32x4*)(g1 + c0); const f32x4 gv = *(const f32x4*)(g + c0), cv = *(const f32x4*)(scl + c0); shv[q] = *(const f32x4*)(sh + c0); gmv[q] = gv * (1.0f + cv);
                if (POOL) psv[q] = *(const f32x4*)(P.pool_scale + j * DM + c0); } }
        f32x4 y[2][4];
        if (POOL) {
            asm volatile("s_waitcnt vmcnt(0)" ::: "memory");
            __syncthreads();
#pragma unroll
            for (int q = 0; q < 4; ++q) {
                const int h = 1 << q;
                const LAS f16* zb = (const LAS f16*)zst + q * 256 + lane * 4;
                f32x4 common = (f32x4){0.f, 0.f, 0.f, 0.f}, z0 = common, z1 = common;
#pragma unroll
                for (int d = -h; d <= h; ++d) {
                    const int tt = t + d; const bool ok = tt >= 0 && tt < L;
                    f32x4 zz = cvt4(*(const LAS f16x4*)(zb + (2 * wid + 8 + d) * DM));
                    if (!ok) zz = (f32x4){0.f, 0.f, 0.f, 0.f};
                    if (d == -h) z0 = zz; else if (d == h) z1 = zz; else common += zz;
                    if (d == 0) y[0][q] = zz;
                    if (d == 1) y[1][q] = zz;
                }
                const int c0n = min(t + h, L) - max(t - h, 0), c1n = min(t + 1 + h, L) - max(t + 1 - h, 0);
                y[0][q] = ((common + z0) * (1.0f / (float)c0n) - y[0][q]) * psv[q];
                y[1][q] = ((common + z1) * (1.0f / (float)c1n) - y[1][q]) * psv[q];
            }
            asm volatile("s_waitcnt lgkmcnt(0)" ::: "memory");
            __syncthreads();
        } else {
#pragma unroll
            for (int u = 0; u < 2; ++u)
#pragma unroll
                for (int q = 0; q < 4; ++q) y[u][q] = cvt4(zr[u][q]);
        }
        f32x4 xv[2][4]; float ss[2] = {0.f, 0.f};
#pragma unroll
        for (int q = 0; q < 4; ++q) {
#pragma unroll
            for (int u = 0; u < 2; ++u) { xv[u][q] = cvt4(xr[u][q]) + g1v[q] * y[u][q]; ss[u] += dot4(xv[u][q], xv[u][q]); }
        }
        const int nxt = blk + nb;
        asm volatile("" ::: "memory");
        if (nxt < nblk) prefetch(nxt);
#pragma unroll
        for (int u = 0; u < 2; ++u)
#pragma unroll
            for (int q = 0; q < 4; ++q) *(f16x4*)(P.Xw() + (size_t)(rb + u) * DM + q * 256 + lane * 4) = pk4(xv[u][q]);
        ss[0] = wave_sum(ss[0], lane); ss[1] = wave_sum(ss[1], lane);
        const float rs[2] = {rsqrtf(ss[0] * (1.0f / DM) + 1e-6f), rsqrtf(ss[1] * (1.0f / DM) + 1e-6f)};
        f16x4 h2h[2][4];
#pragma unroll
        for (int q = 0; q < 4; ++q) {
            const int c0 = q * 256 + lane * 4;
#pragma unroll
            for (int u = 0; u < 2; ++u) { h2h[u][q] = pk4(xv[u][q] * rs[u] * gmv[q] + shv[q]); *(f16x4*)(P.Hw() + (size_t)(rb + u) * DM + c0) = h2h[u][q]; }
        }
        asm volatile("s_waitcnt lgkmcnt(0)" ::: "memory"); __builtin_amdgcn_s_barrier(); asm volatile("" ::: "memory");
#pragma unroll
        for (int q = 0; q < 4; ++q)
#pragma unroll
            for (int u = 0; u < 2; ++u) *(f16x4*)(h2s + (2 * wid + u) * 1032 + q * 256 + lane * 4) = h2h[u][q];
        asm volatile("s_waitcnt lgkmcnt(0)" ::: "memory"); __builtin_amdgcn_s_barrier(); asm volatile("" ::: "memory");
        {
            const int r16 = lane & 15, kq = lane >> 4;
            f32x4 pl = (f32x4){0.f, 0.f, 0.f, 0.f};
#pragma unroll
            for (int ks = 0; ks < 4; ++ks) {
                const f16x8 av = *(const f16x8*)(h2s + r16 * 1032 + wid * 128 + ks * 32 + kq * 8), bv = *(const f16x8*)(wh + r16 * 1032 + wid * 128 + ks * 32 + kq * 8);
                pl = __builtin_amdgcn_mfma_f32_16x16x32_f16(av, bv, pl, 0, 0, 0);
            }
            *(f32x4*)(lds + 16640 + (wid * 64 + lane) * 4) = pl;
            asm volatile("s_waitcnt lgkmcnt(0)" ::: "memory"); __builtin_amdgcn_s_barrier(); asm volatile("" ::: "memory");
        }
        if (wid == 0) {
            const int r16 = lane & 15, kq = lane >> 4;
            f32x4 lg = (f32x4){0.f, 0.f, 0.f, 0.f};
#pragma unroll
            for (int w = 0; w < 8; ++w) lg += *(const f32x4*)(lds + 16640 + (w * 64 + lane) * 4);
#pragma unroll
            for (int jj = 0; jj < 4; ++jj) {
                float mx = lg[jj];
                mx = fmaxf(mx, shx<1>(mx, lane)); mx = fmaxf(mx, shx<2>(mx, lane)); mx = fmaxf(mx, shx<4>(mx, lane)); mx = fmaxf(mx, shx<8>(mx, lane));
                const float pe = __expf(lg[jj] - mx);
                float den = pe;
                den += shx<1>(den, lane); den += shx<2>(den, lane); den += shx<4>(den, lane); den += shx<8>(den, lane);
                P.affw()[(size_t)r16 * MROWS + R0 + 4 * kq + jj] = pe / den;
            }
        }
        blk = nxt;
    }
}

__device__ __forceinline__ void phase_topk(const Params& P, int bid, int nb, unsigned* lds, int nprob = 64) {
    unsigned* hist = lds; unsigned* misc = lds + 256; unsigned* wsa = lds + 272; unsigned* wsb = lds + 288;
    const int tid = opaque_tid(), wid = tid >> 6, lane = tid & 63;
    for (int p = bid; p < nprob; p += nb) {
        const int set = p >> 4, e = p & 15;
        const int n = set < 2 ? SEQ : CTXL, C = n >> 3;
        const int r0 = set < 2 ? set * SEQ : NLAT + (set - 2) * CTXL;
        const int slot0 = set < 2 ? set * 2048 : 4096 + (set - 2) * 32;
        unsigned key[32];
#pragma unroll
        for (int i4 = 0; i4 < 8; ++i4) { const int idx = tid * 32 + i4 * 4;
            f32x4 v = (f32x4){0.f, 0.f, 0.f, 0.f}; if (idx < n) v = *(const f32x4*)(P.aff() + (size_t)e * MROWS + r0 + idx);
#pragma unroll
            for (int jj = 0; jj < 4; ++jj) key[i4 * 4 + jj] = idx < n ? (__float_as_uint(v[jj]) + 1u) : 0u; }
        unsigned T = 0u;
        for (int bit = 29; bit >= 0; --bit) {
            const unsigned cand = T | (1u << bit);
            unsigned wc = 0u;
#pragma unroll
            for (int i = 0; i < 32; ++i) wc += (unsigned)__builtin_popcountll(__builtin_amdgcn_ballot_w64(key[i] >= cand));
            unsigned* cb = misc + ((bit & 1) << 3);
            if (lane == 0) cb[wid] = wc;
            __syncthreads();
            unsigned tot = 0u;
#pragma unroll
            for (int w = 0; w < 8; ++w) tot += cb[w];
            if (tot >= (unsigned)C) T = cand;
        }
        unsigned cg = 0u, ce = 0u;
#pragma unroll
        for (int i = 0; i < 32; ++i) { cg += key[i] > T ? 1u : 0u; ce += key[i] == T ? 1u : 0u; }
        unsigned ig = cg, ie = ce;
#pragma unroll
        for (int o = 1; o < 64; o <<= 1) { const unsigned a = shup(ig, o, lane), b = shup(ie, o, lane); if (lane >= o) { ig += a; ie += b; } }
        if (lane == 63) { wsa[wid] = ig; wsb[wid] = ie; }
        __syncthreads();
        unsigned bg = 0u, be = 0u, totg = 0u;
#pragma unroll
        for (int w = 0; w < 8; ++w) { const unsigned ga = wsa[w]; totg += ga; if (w < wid) { bg += ga; be += wsb[w]; } }
        const unsigned krem = (unsigned)C - totg;
        unsigned pg = bg + ig - cg, pe = be + ie - ce;
#pragma unroll
        for (int i4 = 0; i4 < 8; ++i4) {
            int iv[4];
#pragma unroll
            for (int jj = 0; jj < 4; ++jj) {
                const int i = i4 * 4 + jj, idx = tid * 32 + i;
                bool sel = false; unsigned rank = 0u;
                if (key[i] > T) { sel = true; rank = pg + (pe < krem ? pe : krem); ++pg; }
                else if (key[i] == T && key[i] != 0u) { if (pe < krem) { sel = true; rank = pg + pe; } ++pe; }
                if (sel) P.rowidx()[e * SLOTS_PAD + slot0 + (int)rank] = r0 + idx;
                iv[jj] = sel ? slot0 + (int)rank : -1;
            }
            if (tid * 32 + i4 * 4 < n) *(int4*)(P.inv() + (size_t)e * MROWS + r0 + tid * 32 + i4 * 4) = make_int4(iv[0], iv[1], iv[2], iv[3]);
        }
        if (set == 3) for (int i = SLOTS + tid; i < SLOTS_PAD; i += NTHR) P.rowidx()[e * SLOTS_PAD + i] = 0;
        __syncthreads();
    }
}

#define XB_TMO      128
#define XB_XCNT(j)  (256  + 64 * (j))
#define XB_XSUB(j)  (1280 + 64 * (j))
#define XB_XGEN(j)  (2304 + 64 * (j))
#define XB_TOP      3328
#define XB_TOPGEN   3392
#define XCD_BAR_WORDS 3456
#define XB_SPIN_CAP (1u << 18)
__device__ __forceinline__ unsigned xb_ld(unsigned* p)              { return __hip_atomic_load(p, __ATOMIC_RELAXED, __HIP_MEMORY_SCOPE_AGENT); }
__device__ __forceinline__ unsigned xb_add(unsigned* p, unsigned v) { return __hip_atomic_fetch_add(p, v, __ATOMIC_RELAXED, __HIP_MEMORY_SCOPE_AGENT); }
__device__ __forceinline__ unsigned xb_xcc_id() { return (unsigned)__builtin_amdgcn_s_getreg((3 << 11) | 20) & 0xFu; }
#define XB_SPIN(cond, bar) do { unsigned _sp = 0; while (cond) { __builtin_amdgcn_s_sleep(1); \
    if ((++_sp & 255u) == 0u) { if (xb_ld(&(bar)[XB_TMO])) break; if (_sp > XB_SPIN_CAP) { atomicAdd(&(bar)[XB_TMO], 1u); break; } } } } while (0)
struct XcdBarrier { unsigned* bar; unsigned x; volatile LAS unsigned* st; };
__device__ __forceinline__ XcdBarrier xcd_barrier_post(unsigned* bar, volatile LAS unsigned* st) {
    XcdBarrier b; b.bar = bar; b.x = xb_xcc_id(); b.st = st;
    if (threadIdx.x == 0) (void)xb_add(&bar[XB_XCNT(b.x)], 1u);
    return b;
}
__device__ __forceinline__ void xcd_barrier_complete(unsigned* bar, unsigned x, unsigned& nloc, unsigned& nx) {
    const unsigned G = gridDim.x * gridDim.y * gridDim.z;
    unsigned sum, cnt, mine, sp = 0u;
    for (;;) {
        sum = 0u; cnt = 0u; mine = 0u;
#pragma unroll
        for (unsigned j = 0; j < 16; ++j) { const unsigned c = xb_ld(&bar[XB_XCNT(j)]); sum += c; cnt += (c > 0u) ? 1u : 0u; mine = (j == x) ? c : mine; }
        if (sum == G) break;
        __builtin_amdgcn_s_sleep(1);
        if ((++sp & 255u) == 0u) { if (xb_ld(&bar[XB_TMO])) break; if (sp > XB_SPIN_CAP) { atomicAdd(&bar[XB_TMO], 1u); break; } }
    }
    nloc = mine > 0u ? mine : 1u; nx = cnt > 0u ? cnt : 1u;
}
__device__ __forceinline__ void xcd_barrier(const XcdBarrier& b) {
    asm volatile("s_waitcnt vmcnt(0)" ::: "memory");
    __syncthreads();
    if (threadIdx.x == 0) {
        unsigned* bar = b.bar; asm volatile("" : "+s"(bar));
        const unsigned bx = (unsigned)__builtin_amdgcn_readfirstlane((int)xb_xcc_id());
        __builtin_amdgcn_s_waitcnt(0);
        unsigned nloc = b.st[0], nx = b.st[1];
        if (nloc == 0u) { xcd_barrier_complete(bar, bx, nloc, nx); b.st[0] = nloc; b.st[1] = nx; }
        const unsigned old = xb_add(&bar[XB_XSUB(bx)], 1u);
        const unsigned gen = old / nloc;
        if (old + 1u == (gen + 1u) * nloc) {
            __builtin_amdgcn_fence(__ATOMIC_RELEASE, "agent");
            asm volatile("s_waitcnt vmcnt(0)" ::: "memory");
            const unsigned og = xb_add(&bar[XB_TOP], 1u);
            const unsigned tg = og / nx;
            if (og + 1u == (tg + 1u) * nx) xb_add(&bar[XB_TOPGEN], 1u);
            else XB_SPIN(xb_ld(&bar[XB_TOPGEN]) == tg, bar);
            __builtin_amdgcn_fence(__ATOMIC_ACQUIRE, "agent");
            xb_add(&bar[XB_XGEN(bx)], 1u);
            asm volatile("s_waitcnt vmcnt(0)" ::: "memory");
        } else {
            XB_SPIN(xb_ld(&bar[XB_XGEN(bx)]) == gen, bar);
            __builtin_amdgcn_fence(__ATOMIC_ACQUIRE, "agent");
            asm volatile("s_waitcnt vmcnt(0)" ::: "memory");
        }
    }
    __syncthreads();
}

namespace fg {
constexpr int BM = 256, BK = 64, HALF = 128, HTB = HALF * BK * 2, STAGE_BYTES = 8 * HTB;
__device__ __forceinline__ int lds_byte(int r, int c) { const int st = (r >> 4) * 2 + (c >> 5), rr = r & 15, cc = c & 31, ob = rr * 64 + cc * 2; return st * 1024 + (ob ^ (((ob >> 9) & 1) << 5)); }
__device__ __forceinline__ void stage_rc(int b, int& R, int& C) { const int st = b / 1024, sb = b % 1024, swz = sb ^ (((sb >> 9) & 1) << 5); R = (st >> 1) * 16 + swz / 64; C = (st & 1) * 32 + (swz % 64) / 2; }
__device__ __forceinline__ int perm32(int rho) { const int n = rho >> 4, i = rho & 15; return 8 * (i >> 2) + 4 * n + (i & 3); }
#define KDUP 0
struct Unit { int e, pm, pn; int skip; };
__device__ __forceinline__ void xcd_order(int i, int& T) { const int c = blockIdx.x; T = i * (int)gridDim.x + c; }

template <class PR>
__device__ __forceinline__ void gemm_phase(LAS unsigned char* lds, const PR& S, int wv) {
    const int tid = opaque_tid_(wv), wid = __builtin_amdgcn_readfirstlane(tid >> 6), lane = tid & 63, wr = wid >> 2, wc = wid & 3, fr = lane & 15, fq = lane >> 4;
    constexpr int K = PR::K, nt = K / BK;
    unsigned voffB[2];
#pragma unroll
    for (int i = 0; i < 2; ++i) { int R, C; stage_rc(tid * 16 + i * 8192, R, C); const int Rb = (R & ~31) + perm32(R & 31); voffB[i] = (unsigned)(Rb * PR::LDB + C) * 2u; }
    const size_t kstep = (size_t)(BK * 2);
    const size_t hB = S.hstepB();
    const unsigned ldsw = (unsigned)wid * 1024u;
    const int aoff = lds_byte(wr * 64 + fr, fq * 8), boff = lds_byte(wc * 32 + fr, fq * 8);
#define FG_SA(b, h) (((b) * 2 + (h)) * HTB)
#define FG_SB(b, h) ((4 + (b) * 2 + (h)) * HTB)
#define FG_STAGE(bufoff, gbase, voff) do { _Pragma("unroll") for (int _i = 0; _i < 2; ++_i) \
        __builtin_amdgcn_global_load_lds((const unsigned*)((const char*)(gbase) + (voff)[_i]), (LAS unsigned*)(lds + (bufoff) + ldsw + _i * 8192), 16, 0, 0); } while (0)
#define FG_LDA(dst, b, h) do { _Pragma("unroll") for (int m = 0; m < 4; ++m) _Pragma("unroll") for (int k = 0; k < 2; ++k) dst[m][k] = *(const LAS f16x8*)(lds + FG_SA(b, h) + aoff + m * 2048 + k * 1024); } while (0)
#define FG_LDB(dst, b, h) do { _Pragma("unroll") for (int n = 0; n < 2; ++n) _Pragma("unroll") for (int k = 0; k < 2; ++k) dst[n][k] = *(const LAS f16x8*)(lds + FG_SB(b, h) + boff + n * 2048 + k * 1024); } while (0)
#define FG_MMA(ai, bj, At, Bt) do { __builtin_amdgcn_s_setprio(1); _Pragma("unroll") for (int m = 0; m < 4; ++m) _Pragma("unroll") for (int n = 0; n < 2; ++n) _Pragma("unroll") for (int k = 0; k < 2; ++k) \
        acc[ai][bj][m][n] = __builtin_amdgcn_mfma_f32_16x16x32_f16(Bt[n][k], At[m][k], acc[ai][bj][m][n], 0, 0, 0); __builtin_amdgcn_s_setprio(0); } while (0)
#define FG_WAIT_V(n) asm volatile("s_waitcnt vmcnt(" #n ")" ::: "memory")
#define FG_WAIT_L(n) asm volatile("s_waitcnt lgkmcnt(" #n ")" ::: "memory")
#define FG_BAR __builtin_amdgcn_s_barrier()
#define FG_SCHED __builtin_amdgcn_sched_barrier(0)
    Unit cur, nxt; int ui = 0;
    if (!S.next(0, cur)) return;
    f32x4 acc[2][2][4][2];
#pragma unroll
    for (int a = 0; a < 2; ++a)
#pragma unroll
        for (int b = 0; b < 2; ++b)
#pragma unroll
            for (int m = 0; m < 4; ++m)
#pragma unroll
                for (int n = 0; n < 2; ++n) acc[a][b][m][n] = (f32x4){0.f, 0.f, 0.f, 0.f};
    f16x8 At[4][2], B0[2][2], B1[2][2];
    unsigned vA[2][2], vN[2][2];
    { int Rr[2], Cc[2]; stage_rc(tid * 16, Rr[0], Cc[0]); stage_rc(tid * 16 + 8192, Rr[1], Cc[1]); S.a_voff(cur, Rr, Cc, vA); }
#pragma unroll
    for (int h = 0; h < 2; ++h)
#pragma unroll
        for (int i = 0; i < 2; ++i) { asm volatile("" : "+v"(vA[h][i])); vN[h][i] = vA[h][i]; }
    const char* cA = S.a_base(cur); const char* cB = S.b_base(cur);
    FG_STAGE(FG_SB(0, 0), cB, voffB); FG_STAGE(FG_SA(0, 0), cA, vA[0]); FG_STAGE(FG_SB(0, 1), cB + hB, voffB); FG_STAGE(FG_SA(0, 1), cA, vA[1]);
    if (wr == 1) FG_BAR;
    FG_WAIT_V(4); FG_BAR;
    FG_STAGE(FG_SB(1, 0), cB + kstep, voffB); FG_STAGE(FG_SA(1, 0), cA + kstep, vA[0]); FG_STAGE(FG_SB(1, 1), cB + hB + kstep, voffB);
    FG_WAIT_V(6); FG_BAR;
    for (;;) {
        const bool has_next = S.next(ui + 1, nxt);
        const char* nA = has_next ? S.a_base(nxt) : cA; const char* nB = has_next ? S.b_base(nxt) : cB;
        if (has_next) { int Rr[2], Cc[2]; int t2 = tid; asm volatile("" : "+v"(t2)); stage_rc(t2 * 16, Rr[0], Cc[0]); stage_rc(t2 * 16 + 8192, Rr[1], Cc[1]); S.a_voff(nxt, Rr, Cc, vN);
#pragma unroll
            for (int h = 0; h < 2; ++h)
#pragma unroll
                for (int i = 0; i < 2; ++i) asm volatile("" : "+v"(vN[h][i])); }
#pragma unroll 1
        for (int t = 0; t < nt; t += 2) {
            const bool last = (t == nt - 2);
            const char* a1 = cA + (size_t)(t + 1) * kstep;
            const char* a2 = last ? nA : cA + (size_t)(t + 2) * kstep; const char* b2 = last ? nB : cB + (size_t)(t + 2) * kstep;
            const char* a3 = a2 + kstep; const char* b3 = b2 + kstep;
            unsigned v2[2][2];
#pragma unroll
            for (int h = 0; h < 2; ++h)
#pragma unroll
                for (int i = 0; i < 2; ++i) v2[h][i] = last ? vN[h][i] : vA[h][i];
            FG_LDB(B0, 0, 0); FG_SCHED; FG_LDA(At, 0, 0); FG_STAGE(FG_SA(1, 1), a1, vA[1]);
            FG_WAIT_L(8); FG_BAR; FG_WAIT_L(0); FG_MMA(0, 0, At, B0); FG_BAR; FG_SCHED;
            FG_LDB(B1, 0, 1); FG_STAGE(FG_SB(0, 0), b2, voffB);
            FG_BAR; FG_WAIT_L(0); FG_MMA(0, 1, At, B1); FG_BAR;
            FG_LDA(At, 0, 1); FG_STAGE(FG_SA(0, 0), a2, v2[0]);
            FG_BAR; FG_WAIT_L(0); FG_MMA(1, 0, At, B0); FG_BAR; FG_SCHED;
            FG_STAGE(FG_SB(0, 1), b2 + hB, voffB);
            FG_WAIT_V(6); FG_BAR; FG_MMA(1, 1, At, B1); FG_BAR;
            FG_LDB(B0, 1, 0); FG_SCHED; FG_LDA(At, 1, 0); FG_STAGE(FG_SA(0, 1), a2, v2[1]);
            FG_WAIT_L(8); FG_BAR; FG_WAIT_L(0); FG_MMA(0, 0, At, B0); FG_BAR; FG_SCHED;
            FG_LDB(B1, 1, 1); FG_STAGE(FG_SB(1, 0), b3, voffB);
            FG_BAR; FG_WAIT_L(0); FG_MMA(0, 1, At, B1); FG_BAR;
            FG_LDA(At, 1, 1); FG_STAGE(FG_SA(1, 0), a3, v2[0]);
            FG_BAR; FG_WAIT_L(0); FG_MMA(1, 0, At, B0); FG_BAR; FG_SCHED;
            FG_STAGE(FG_SB(1, 1), b3 + hB, voffB);
            FG_WAIT_V(6); FG_BAR; FG_MMA(1, 1, At, B1); FG_BAR;
        }
        if (!KDUP || !cur.skip) S.epi(acc, cur, wr, wc, fr, fq);
        if (!has_next) break;
#pragma unroll
        for (int a = 0; a < 2; ++a)
#pragma unroll
            for (int b = 0; b < 2; ++b)
#pragma unroll
                for (int m = 0; m < 4; ++m)
#pragma unroll
                    for (int n = 0; n < 2; ++n) acc[a][b][m][n] = (f32x4){0.f, 0.f, 0.f, 0.f};
        cur = nxt; cA = nA; cB = nB; ++ui;
#pragma unroll
        for (int h = 0; h < 2; ++h)
#pragma unroll
            for (int i = 0; i < 2; ++i) vA[h][i] = vN[h][i];
    }
    FG_WAIT_V(0);
    if (wr == 0) FG_BAR;
    FG_BAR;
#undef FG_SA
#undef FG_SB
#undef FG_STAGE
#undef FG_LDA
#undef FG_LDB
#undef FG_MMA
#undef FG_WAIT_V
#undef FG_WAIT_L
#undef FG_BAR
#undef FG_SCHED
}

__device__ __forceinline__ f16x8 pack8(const f32x4 a, const f32x4 b) { return (f16x8){(f16)a[0], (f16)a[1], (f16)a[2], (f16)a[3], (f16)b[0], (f16)b[1], (f16)b[2], (f16)b[3]}; }

template <int K_, int LDA_, int LDB_> struct PRBase {
    static constexpr int K = K_, LDA = LDA_, LDB = LDB_;
    __device__ __forceinline__ void plain_voff(const int (&R)[2], const int (&C)[2], unsigned (&v)[2][2]) const {
#pragma unroll
        for (int h = 0; h < 2; ++h)
#pragma unroll
            for (int i = 0; i < 2; ++i) v[h][i] = (unsigned)((h * HALF + R[i]) * LDA + C[i]) * 2u;
    }
};
struct PRGateUp : PRBase<1024, 1024, 1024> {
    const f16* H; const int* rowidx; const f16* W; f16* act; int nunits; int bid; int rt;
    __device__ __forceinline__ size_t hstepB() const { return (size_t)DEXP * DM * 2; }
    __device__ __forceinline__ bool next(int i, Unit& u) const { const int ii = KDUP ? (i >> 1) : i; const int T = ii * (int)gridDim.x + bid; u.skip = KDUP ? ((i & 1) == 0) : 0; if (T >= nunits) return false;
        if (rt == 16 && gridDim.x == 256) { const int x = bid & 7, jj = bid >> 3; u.e = ii; u.pm = (x >> 1) * 4 + (jj >> 3); u.pn = (x & 1) * 8 + (jj & 7); return true; }
        const int per = rt * 16; u.e = T / per; const int t = T % per; u.pm = t >> 4; u.pn = t & 15; return true; }
    __device__ __forceinline__ const char* a_base(const Unit&) const { return (const char*)H; }
    __device__ __forceinline__ void a_voff(const Unit& u, const int (&R)[2], const int (&C)[2], unsigned (&v)[2][2]) const {
        const int* ri = rowidx + u.e * SLOTS_PAD + u.pm * BM;
#pragma unroll
        for (int h = 0; h < 2; ++h)
#pragma unroll
            for (int i = 0; i < 2; ++i) { const int g = ri[h * HALF + R[i]]; v[h][i] = (unsigned)(g * LDA + C[i]) * 2u; }
    }
    __device__ __forceinline__ const char* b_base(const Unit& u) const { return (const char*)(W + ((size_t)u.e * 2 * DEXP + (size_t)u.pn * HALF) * DM); }
    __device__ __forceinline__ void epi(const f32x4 (&acc)[2][2][4][2], const Unit& u, int wr, int wc, int fr, int fq) const {
        f16* base = act + ((size_t)u.e * SLOTS_PAD + (size_t)u.pm * BM + wr * 64 + fr) * DEXP + u.pn * HALF + wc * 32 + fq * 8;
#pragma unroll
        for (int ai = 0; ai < 2; ++ai)
#pragma unroll
            for (int m = 0; m < 4; ++m) {
                f32x4 o0, o1;
#pragma unroll
                for (int j = 0; j < 4; ++j) { o0[j] = silu_f(acc[ai][0][m][0][j]) * acc[ai][1][m][0][j]; o1[j] = silu_f(acc[ai][0][m][1][j]) * acc[ai][1][m][1][j]; }
                if (u.e < 8) __builtin_nontemporal_store(pack8(o0, o1), (f16x8*)(base + (size_t)(ai * HALF + m * 16) * DEXP));
                else *(f16x8*)(base + (size_t)(ai * HALF + m * 16) * DEXP) = pack8(o0, o1);
            }
    }
};
struct PRDown : PRBase<2048, 2048, 2048> {
    const f16* act; const f16* W; f16* y; int nunits; int bid; int rt;
    __device__ __forceinline__ size_t hstepB() const { return (size_t)HALF * DEXP * 2; }
    __device__ __forceinline__ bool next(int i, Unit& u) const { const int ii = KDUP ? (i >> 1) : i; const int T = ii * (int)gridDim.x + bid; u.skip = KDUP ? ((i & 1) == 0) : 0; if (T >= nunits) return false;
        if (rt == 16 && gridDim.x == 256) { const int x = bid & 7, jj = bid >> 3; u.e = 15 - (ii * 4 + (x >> 1)); u.pm = (x & 1) * 8 + (jj >> 2); u.pn = jj & 3; return true; }
        const int per = rt * 4; u.e = T / per; const int t = T % per; u.pm = t >> 2; u.pn = t & 3; return true; }
    __device__ __forceinline__ const char* a_base(const Unit& u) const { return (const char*)(act + ((size_t)u.e * SLOTS_PAD + (size_t)u.pm * BM) * DEXP); }
    __device__ __forceinline__ void a_voff(const Unit&, const int (&R)[2], const int (&C)[2], unsigned (&v)[2][2]) const { plain_voff(R, C, v); }
    __device__ __forceinline__ const char* b_base(const Unit& u) const { return (const char*)(W + ((size_t)u.e * DM + (size_t)u.pn * BM) * DEXP); }
    __device__ __forceinline__ void epi(const f32x4 (&acc)[2][2][4][2], const Unit& u, int wr, int wc, int fr, int fq) const {
        f16* base = y + ((size_t)u.e * SLOTS_PAD + (size_t)u.pm * BM + wr * 64 + fr) * DM + u.pn * BM + wc * 32 + fq * 8;
#pragma unroll
        for (int ai = 0; ai < 2; ++ai)
#pragma unroll
            for (int m = 0; m < 4; ++m)
#pragma unroll
                for (int bj = 0; bj < 2; ++bj) *(f16x8*)(base + (size_t)(ai * HALF + m * 16) * DM + bj * HALF) = pack8(acc[ai][bj][m][0], acc[ai][bj][m][1]);
    }
};
template <int K_> struct PRDense : PRBase<K_, 1024, K_> {
    const f16* A; const f16* W; f16* O0; f16* O1; f16* O2; int ncol; int mode; int bid; int npan; int kvx;
    __device__ __forceinline__ size_t hstepB() const { return (size_t)HALF * K_ * 2; }
    __device__ __forceinline__ bool next(int i, Unit& u) const { const int ii = KDUP ? (i >> 1) : i; int T = ii * (int)gridDim.x + bid; if (gridDim.x == 256) T = (ii * 8 + (bid & 7)) * 32 + (bid >> 3);
        u.skip = KDUP ? ((i & 1) == 0) : 0; const int nu = npan * ncol; if (T >= nu + kvx) return false; u.e = 0; if (T < nu) { u.pm = T / ncol; u.pn = T % ncol; } else { const int x = T - nu; u.pm = npan + (x >> 1); u.pn = 4 + (x & 1); } return true; }
    __device__ __forceinline__ const char* a_base(const Unit& u) const { return (const char*)(A + (size_t)u.pm * BM * 1024 + (mode == 2 ? u.pn * 256 : 0)); }
    __device__ __forceinline__ void a_voff(const Unit&, const int (&R)[2], const int (&C)[2], unsigned (&v)[2][2]) const { this->plain_voff(R, C, v); }
    __device__ __forceinline__ const char* b_base(const Unit& u) const { return (const char*)(W + (size_t)u.pn * BM * K_); }
    const float* qn; const float* kn; const float* rope; LAS float* xs; int lane;
    __device__ __forceinline__ void epi(const f32x4 (&acc)[2][2][4][2], const Unit& u, int wr, int wc, int fr, int fq) const {
        f16* base; int ld;
        const int row = u.pm * BM + wr * 64 + fr, colw = wc * 32 + fq * 8;
        if (mode == 1) { if (u.pn < 4) { base = O0 + (size_t)row * 1024 + u.pn * BM + colw; ld = 1024; } else if (u.pn == 4) { base = O1 + (size_t)row * 256 + colw; ld = 256; } else { base = O2 + (size_t)row * 256 + colw; ld = 256; } }
        else { base = O0 + (size_t)row * 1024 + u.pn * BM + colw; ld = 1024; }
        if (mode == 1 && u.pn < 5) {
            float ssq[2][4][2];
#pragma unroll
            for (int ai = 0; ai < 2; ++ai)
#pragma unroll
                for (int m = 0; m < 4; ++m)
#pragma unroll
                    for (int bj = 0; bj < 2; ++bj) { const f32x4 a = acc[ai][bj][m][0], b = acc[ai][bj][m][1];
                        float t = (a[0] * a[0] + a[1] * a[1]) + (a[2] * a[2] + a[3] * a[3]) + (b[0] * b[0] + b[1] * b[1]) + (b[2] * b[2] + b[3] * b[3]);
                        t += shx<16>(t, lane); t += shx<32>(t, lane); ssq[ai][m][bj] = t; }
            LAS float* mine = xs + ((wr * 4 + wc) * 16) * 16 + fr; const LAS float* theirs = xs + ((wr * 4 + (wc ^ 1)) * 16) * 16 + fr;
            if (fq == 0) {
#pragma unroll
                for (int ai = 0; ai < 2; ++ai)
#pragma unroll
                    for (int m = 0; m < 4; ++m)
#pragma unroll
                        for (int bj = 0; bj < 2; ++bj) mine[(ai * 8 + m * 2 + bj) * 16] = ssq[ai][m][bj];
            }
            asm volatile("s_waitcnt lgkmcnt(0)" ::: "memory"); __builtin_amdgcn_s_barrier(); asm volatile("" ::: "memory");
            const bool isq = u.pn < 4, lat = u.pm < 128;
            const float* nw = (isq ? qn : kn) + (wc & 1) * 32 + fq * 8;
            const f32x4 w0 = *(const f32x4*)nw, w1 = *(const f32x4*)(nw + 4);
            const float qs = isq ? 0.125f * 1.4426950408889634f : 1.0f;
#pragma unroll
            for (int ai = 0; ai < 2; ++ai)
#pragma unroll
                for (int m = 0; m < 4; ++m) {
                    f32x4 c0 = (f32x4){1.f, 1.f, 1.f, 1.f}, s0 = (f32x4){0.f, 0.f, 0.f, 0.f};
                    if (lat) { const int t = (row + ai * HALF + m * 16) & (SEQ - 1); const int pos = (wc & 1) ? (t & 63) : (t >> 6);
                        const float* tb = rope + (size_t)(pos * 16 + fq * 4) * 2; const f32x4 ta = *(const f32x4*)tb, tb2 = *(const f32x4*)(tb + 4);
                        c0 = (f32x4){ta[0], ta[2], tb2[0], tb2[2]}; s0 = (f32x4){ta[1], ta[3], tb2[1], tb2[3]}; }
#pragma unroll
                    for (int bj = 0; bj < 2; ++bj) {
                        const float tot = ssq[ai][m][bj] + theirs[(ai * 8 + m * 2 + bj) * 16];
                        const float rstd = rsqrtf(tot * (1.0f / 64.0f) + 1e-6f) * qs;
                        f32x4 a = acc[ai][bj][m][0] * rstd * w0, b = acc[ai][bj][m][1] * rstd * w1;
                        const f32x4 ra = (f32x4){a[0] * c0[0] - a[1] * s0[0], a[0] * s0[0] + a[1] * c0[0], a[2] * c0[1] - a[3] * s0[1], a[2] * s0[1] + a[3] * c0[1]};
                        const f32x4 rb = (f32x4){b[0] * c0[2] - b[1] * s0[2], b[0] * s0[2] + b[1] * c0[2], b[2] * c0[3] - b[3] * s0[3], b[2] * s0[3] + b[3] * c0[3]};
                        *(f16x8*)(base + (size_t)(ai * HALF + m * 16) * ld + bj * HALF) = pack8(ra, rb);
                    }
                }
            return;
        }
#pragma unroll
        for (int ai = 0; ai < 2; ++ai)
#pragma unroll
            for (int m = 0; m < 4; ++m)
#pragma unroll
                for (int bj = 0; bj < 2; ++bj) *(f16x8*)(base + (size_t)(ai * HALF + m * 16) * ld + bj * HALF) = pack8(acc[ai][bj][m][0], acc[ai][bj][m][1]);
    }
};
}

struct CvtJob { const float* src; f16* dst; int K, N, k0, n0; };
__device__ __forceinline__ bool cvt_job(const Params& P, int l, int u, CvtJob& jb, bool experts) {
    const int j = l >> 1;
    const int nexp = experts ? NEXP * 3 * 128 : 0;
    const int nmix = (l & 1) == 0 ? 16 : (96 + 64);
    if (u >= nexp + nmix) return false;
    if (u < nexp) {
        const int e = u / 384, r = u % 384, which = r >> 7, t = r & 127;
        if (which < 2) { jb.src = (which == 0 ? P.w_gate : P.w_up) + ((size_t)l * NEXP + e) * DM * DEXP; jb.dst = P.Wgu() + ((size_t)e * 2 + which) * DEXP * DM; jb.K = DM; jb.N = DEXP; jb.k0 = (t >> 4) * 128; jb.n0 = (t & 15) * 128; }
        else { jb.src = P.w_down + ((size_t)l * NEXP + e) * DEXP * DM; jb.dst = P.Wd() + (size_t)e * DM * DEXP; jb.K = DEXP; jb.N = DM; jb.k0 = (t >> 3) * 128; jb.n0 = (t & 7) * 128; }
    } else {
        const int t = u - nexp;
        if ((l & 1) == 0) { const int g = t >> 2, tt = t & 3; jb.src = P.pool_w + (size_t)(j * 4 + g) * 65536; jb.dst = P.Wmix() + (size_t)g * 65536; jb.K = 256; jb.N = 256; jb.k0 = (tt >> 1) * 128; jb.n0 = (tt & 1) * 128; }
        else if (t < 96) { jb.src = P.w_qkv + (size_t)j * DM * QKVD; jb.dst = P.Wmix(); jb.K = DM; jb.N = QKVD; jb.k0 = (t / 12) * 128; jb.n0 = (t % 12) * 128; }
        else { const int tt = t - 96; jb.src = P.w_o + (size_t)j * DM * DM; jb.dst = P.Wmix() + (size_t)QKVD * DM; jb.K = DM; jb.N = DM; jb.k0 = (tt >> 3) * 128; jb.n0 = (tt & 7) * 128; }
    }
    return true;
}
__device__ __forceinline__ void phase_convert(const Params& P, int l, int bid, int nb, f16* tile, bool experts = true) {
    const int tid = opaque_tid();
    CvtJob jb;
    int u = bid;
    bool have = cvt_job(P, l, u, jb, experts);
    f32x4 r[8];
    if (have) {
#pragma unroll
        for (int p = 0; p < 8; ++p) { const int id = tid + p * NTHR, kr = id >> 5, c4 = (id & 31) * 4; r[p] = __builtin_nontemporal_load((const f32x4*)(jb.src + (size_t)(jb.k0 + kr) * jb.N + jb.n0 + c4)); }
    }
    while (have) {
        __syncthreads();
#pragma unroll
        for (int p = 0; p < 8; ++p) { const int id = tid + p * NTHR, kr = id >> 5, c4 = (id & 31) * 4; *(f16x4*)(tile + kr * 136 + c4) = pk4(r[p]); }
        __syncthreads();
        const CvtJob cur = jb;
        u += nb; have = cvt_job(P, l, u, jb, experts);
        if (have) {
#pragma unroll
            for (int p = 0; p < 8; ++p) { const int id = tid + p * NTHR, kr = id >> 5, c4 = (id & 31) * 4; r[p] = __builtin_nontemporal_load((const f32x4*)(jb.src + (size_t)(jb.k0 + kr) * jb.N + jb.n0 + c4)); }
        }
        const int n = tid & 127, kg = (tid >> 7) * 32;
        f16* dp = cur.dst + (size_t)(cur.n0 + n) * cur.K + cur.k0 + kg;
#pragma unroll
        for (int i = 0; i < 4; ++i) { f16x8 o;
#pragma unroll
            for (int e = 0; e < 8; ++e) o[e] = tile[(kg + i * 8 + e) * 136 + n];
            *(f16x8*)(dp + i * 8) = o; }
    }
}
template <bool GATEUP, bool CTX>
__device__ __forceinline__ void phase_cvt_ctx(const Params& P, int l, int bid, int nb, f16* tile, int sel = -1, bool alt = false) {
    const int tid = opaque_tid(), wid = P.wv, lane = tid & 63, r16 = lane & 15, kq = lane >> 4;
    constexpr int NC = GATEUP ? 128 : 64;
    constexpr int KT = GATEUP ? 8 : 16, K = GATEUP ? DM : DEXP, N = GATEUP ? DEXP : DM, NB = N / NC;
    constexpr int NT = GATEUP ? 2 * KT : KT;
    const int sel_ = (GATEUP && !CTX) ? sel : -1; const int ntr = (GATEUP && sel_ < 0) ? NT : KT;
    constexpr int TS = NC + 4, TW = 128 * TS;
    constexpr int NLD = NC / 16;
    constexpr int WPC = 8 / (NC / 16);
    constexpr int NRB = 4 / WPC;
    const int cb = wid % (NC / 16), rb0 = (wid / (NC / 16)) * NRB;
    f16* asl = tile + 2 * TW;
    for (int job = bid; job < NEXP * NB; job += nb) {
        const int e = job / NB, nbk = job % NB;
        const f16* ap[2];
        if (CTX) {
#pragma unroll
            for (int p = 0; p < 2; ++p) { const int row = (tid >> 4) + p * 32;
                if (GATEUP) ap[p] = P.H() + (size_t)P.rowidx()[e * SLOTS_PAD + 4096 + row] * DM + (tid & 15) * 8;
                else ap[p] = P.act() + ((size_t)e * SLOTS_PAD + 4096 + row) * DEXP + (tid & 15) * 8; }
        }
        f32x4 acc[2][NRB];
#pragma unroll
        for (int w = 0; w < 2; ++w)
#pragma unroll
            for (int rb = 0; rb < NRB; ++rb) acc[w][rb] = (f32x4){0.f, 0.f, 0.f, 0.f};
        const float* srcs[2]; f16* dsts[2];
        if (GATEUP) { const size_t wo = ((size_t)l * NEXP + e) * DM * DEXP; srcs[0] = P.w_gate + wo; srcs[1] = P.w_up + wo; dsts[0] = P.Wgu() + (alt ? (OFF_WGU3 - OFF_WGU) / 2 : 0) + ((size_t)e * 2) * DEXP * DM; dsts[1] = dsts[0] + (size_t)DEXP * DM; }
        else { srcs[0] = P.w_down + ((size_t)l * NEXP + e) * DEXP * DM; srcs[1] = srcs[0]; dsts[0] = P.Wd() + (alt ? (OFF_WD3 - OFF_WD) / 2 : 0) + (size_t)e * DM * DEXP; dsts[1] = dsts[0]; }
        f32x4 r[2][NLD]; f16x8 ar[2][2];
        const unsigned ldoff = (unsigned)(((tid / (NC / 4)) * N + (tid % (NC / 4)) * 4) * 4);
#define CV_LOAD(ti, slot) do { const int which_ = GATEUP ? (sel_ >= 0 ? sel_ : ((ti) & 1)) : 0, kt_ = (GATEUP && sel_ < 0) ? ((ti) >> 1) : (ti); const char* sp_ = (const char*)(srcs[which_] + (size_t)(kt_ * 128) * N + nbk * NC); \
            _Pragma("unroll") for (int p = 0; p < NLD; ++p) r[slot][p] = __builtin_nontemporal_load((const f32x4*)(sp_ + (size_t)p * (NTHR / (NC / 4)) * N * 4 + ldoff)); \
            if (CTX) { _Pragma("unroll") for (int p = 0; p < 2; ++p) ar[slot][p] = *(const f16x8*)(ap[p] + kt_ * 128); } } while (0)
#define CV_TILE(ti, slot) do { const int which = GATEUP ? (sel_ >= 0 ? sel_ : ((ti) & 1)) : 0, kt = (GATEUP && sel_ < 0) ? ((ti) >> 1) : (ti); \
            f16* tl = tile + (slot) * TW; f16* al = asl + (slot) * (64 * 128); \
            _Pragma("unroll") for (int p = 0; p < NLD; ++p) { const int id = tid + p * NTHR, kr = id / (NC / 4), c4 = (id % (NC / 4)) * 4; *(f16x4*)(tl + kr * TS + c4) = pk4(r[slot][p]); } \
            if (CTX) { _Pragma("unroll") for (int p = 0; p < 2; ++p) { const int row = (tid >> 4) + p * 32; *(f16x8*)(al + row * 128 + (((tid & 15) ^ (row & 15)) * 8)) = ar[slot][p]; } } \
            if ((ti) + 2 < ntr) CV_LOAD((ti) + 2, slot); \
            asm volatile("s_waitcnt lgkmcnt(0)" ::: "memory"); __builtin_amdgcn_s_barrier(); asm volatile("" ::: "memory"); \
            f16* dp = dsts[which] + (size_t)(nbk * NC + cb * 16 + r16) * K + kt * 128 + kq * 8; \
            _Pragma("unroll") for (int ks = 0; ks < 4; ++ks) { f16x8 bv; \
                _Pragma("unroll") for (int i = 0; i < 8; ++i) bv[i] = tl[(ks * 32 + kq * 8 + i) * TS + cb * 16 + r16]; \
                if (rb0 == 0) *(f16x8*)(dp + ks * 32) = bv; \
                if (CTX) { _Pragma("unroll") for (int rb = 0; rb < NRB; ++rb) { const int row = (rb0 + rb) * 16 + r16; const f16x8 af = *(const f16x8*)(al + row * 128 + (((ks * 4 + kq) ^ r16) * 8)); \
                    acc[which][rb] = __builtin_amdgcn_mfma_f32_16x16x32_f16(bv, af, acc[which][rb], 0, 0, 0); } } } } while (0)
        CV_LOAD(0, 0); CV_LOAD(1, 1);
        for (int t2 = 0; t2 < ntr; t2 += 2) { CV_TILE(t2, 0); CV_TILE(t2 + 1, 1); }
#undef CV_LOAD
#undef CV_TILE
        asm volatile("s_waitcnt lgkmcnt(0)" ::: "memory"); __builtin_amdgcn_s_barrier(); asm volatile("" ::: "memory");
        if (CTX) {
#pragma unroll
            for (int rb = 0; rb < NRB; ++rb) {
                const size_t row = (size_t)e * SLOTS_PAD + 4096 + (rb0 + rb) * 16 + r16; const int col = nbk * NC + cb * 16 + 4 * kq;
                if (GATEUP) { f32x4 o;
#pragma unroll
                    for (int jj = 0; jj < 4; ++jj) o[jj] = silu_f(acc[0][rb][jj]) * acc[1][rb][jj];
                    *(f16x4*)(P.act() + row * DEXP + col) = pk4(o); }
                else *(f16x4*)(P.yslot() + row * DM + col) = pk4(acc[0][rb]);
            }
        }
    }
}

__device__ __forceinline__ void cvt3_job(const Params& P, int job, f16* tile) {
    if (job < 256) phase_cvt_ctx<false, false>(P, 3, job, 1 << 20, tile, -1, true);
    else { const int h = job - 256; phase_cvt_ctx<true, false>(P, 3, h >> 1, 1 << 20, tile, h & 1, true); }
}
__device__ __forceinline__ void phase_gateup_fast(const Params& P, LAS unsigned char* lds, int rt = 17, bool alt = false) { fg::PRGateUp S; S.H = P.H(); S.rowidx = P.rowidx(); S.W = P.Wgu() + (alt ? (OFF_WGU3 - OFF_WGU) / 2 : 0); S.act = P.act(); S.rt = rt; S.nunits = 16 * rt * 16; S.bid = opaque_bid(); fg::gemm_phase(lds, S, P.wv); }
__device__ __forceinline__ void phase_down_fast(const Params& P, LAS unsigned char* lds, int rt = 17, bool alt = false) { fg::PRDown S; S.act = P.act(); S.W = P.Wd() + (alt ? (OFF_WD3 - OFF_WD) / 2 : 0); S.y = P.yslot(); S.rt = rt; S.nunits = 16 * rt * 4; S.bid = opaque_bid(); fg::gemm_phase(lds, S, P.wv); }
__device__ __forceinline__ void phase_pool_fast(const Params& P, LAS unsigned char* lds) { fg::PRDense<256> S; S.qn = nullptr; S.kn = nullptr; S.rope = nullptr; S.xs = nullptr; S.lane = 0; S.npan = 130; S.kvx = 0; S.A = P.H(); S.W = P.Wmix(); S.O0 = P.Z(); S.O1 = nullptr; S.O2 = nullptr; S.ncol = 4; S.mode = 2; S.bid = opaque_bid(); fg::gemm_phase(lds, S, P.wv); }
__device__ __forceinline__ void phase_qkv_fast(const Params& P, LAS unsigned char* lds, bool lastl = false, int l = 1) { fg::PRDense<1024> S; S.qn = P.q_norm + (l >> 1) * 64; S.kn = P.k_norm + (l >> 1) * 64; S.rope = P.rope(); S.xs = (LAS float*)(lds + fg::STAGE_BYTES); S.lane = opaque_tid_(P.wv) & 63; S.npan = lastl ? 128 : 130; S.kvx = lastl ? 4 : 0; S.A = P.H(); S.W = P.Wmix(); S.O0 = P.Q(); S.O1 = P.Kb(); S.O2 = P.Vb(); S.ncol = 6; S.mode = 1; S.bid = opaque_bid(); fg::gemm_phase(lds, S, P.wv); }
__device__ __forceinline__ void phase_oproj_fast(const Params& P, LAS unsigned char* lds, bool lastl = false) { fg::PRDense<1024> S; S.qn = nullptr; S.kn = nullptr; S.rope = nullptr; S.xs = nullptr; S.lane = 0; S.npan = lastl ? 128 : 130; S.kvx = 0; S.A = P.O(); S.W = P.Wmix() + (size_t)QKVD * DM; S.O0 = P.Z(); S.O1 = nullptr; S.O2 = nullptr; S.ncol = 4; S.mode = 0; S.bid = opaque_bid(); fg::gemm_phase(lds, S, P.wv); }

typedef float f32x16 __attribute__((ext_vector_type(16)));
#define AT_KB 9216
#define AT_VB 8704
template <int VAR = 0>
__device__ __forceinline__ void phase_attn_fast(const Params& P, int l, LAS unsigned char* lds, bool do_ctx, int cvt_l = -1) {
    const int j = l >> 1;
    const int tid = opaque_tid(), wid = tid >> 6, lane = tid & 63, l32 = lane & 31, hi = lane >> 5;
    const int g = wid >> 1, qoff = (wid & 1) * 64, qoffu = (P.wv & 1) * 64;
    const int nunits = do_ctx ? 1040 : 1024;
    int ucount = 0;
    for (int u = opaque_bid(); u < nunits; u += gridDim.x, ++ucount) {
        int b, qblk, kv, qrow0, t0, t1, s0;
        if (u < 1024) { b = u >> 9; qblk = (u >> 2) & 127; kv = u & 3; s0 = b * SEQ; qrow0 = s0 + qblk * 128; t0 = qblk == 0 ? 2 : 0; t1 = qblk == 127 ? 4 : 6; }
        else { const int uu = u - 1024; b = uu >> 3; qblk = (uu >> 2) & 1; kv = uu & 3; s0 = NLAT + b * CTXL; qrow0 = s0 + qblk * 128; t0 = 0; t1 = 0; }
        const int cb = NLAT + b * CTXL, nloc = t1 - t0, ntiles = nloc + 4;
        const int h = kv * 4 + g;
        f16x8 Qf[2][4];
#pragma unroll
        for (int qb = 0; qb < 2; ++qb)
#pragma unroll
            for (int ks = 0; ks < 4; ++ks) Qf[qb][ks] = *(const f16x8*)(P.Q() + (size_t)(qrow0 + qoff + 32 * qb + l32) * 1024 + h * 64 + 16 * ks + 8 * hi);
        f32x16 OT[2][2];
#pragma unroll
        for (int db = 0; db < 2; ++db)
#pragma unroll
            for (int qb = 0; qb < 2; ++qb)
#pragma unroll
                for (int r = 0; r < 16; ++r) OT[db][qb][r] = 0.f;
        float mrun[2], lrun[2];
        { const float sk = P.sink[j * 16 + h] * 1.4426950408889634f; mrun[0] = sk; mrun[1] = sk; lrun[0] = hi == 0 ? 1.0f : 0.0f; lrun[1] = lrun[0]; }
        const int lkey = tid >> 3, lpc = tid & 7;
        f16x8 kreg, vreg;
        auto tile_row = [&](int it) -> int { return it < nloc ? (qrow0 - 128 + 64 * (t0 + it)) : (cb + 64 * (it - nloc)); };
        { const int kr = tile_row(0) + lkey; kreg = *(const f16x8*)(P.Kb() + (size_t)kr * 256 + kv * 64 + lpc * 8); vreg = *(const f16x8*)(P.Vb() + (size_t)kr * 256 + kv * 64 + lpc * 8); }
        __syncthreads();
        {
            LAS f16* Kl = (LAS f16*)(lds); LAS f16* Vl = (LAS f16*)(lds + 2 * AT_KB);
            *(LAS f16x8*)(Kl + lkey * 72 + lpc * 8) = kreg;
#pragma unroll
            for (int i = 0; i < 8; ++i) Vl[(lpc * 8 + i) * 68 + lkey] = vreg[i];
        }
        __syncthreads();
        for (int it = 0; it < ntiles; ++it) {
            const int buf = it & 1;
            if (it + 1 < ntiles) { const int kr = tile_row(it + 1) + lkey; kreg = *(const f16x8*)(P.Kb() + (size_t)kr * 256 + kv * 64 + lpc * 8); vreg = *(const f16x8*)(P.Vb() + (size_t)kr * 256 + kv * 64 + lpc * 8); }
            const LAS f16* Kl = (const LAS f16*)(lds + buf * AT_KB); const LAS f16* Vl = (const LAS f16*)(lds + 2 * AT_KB + buf * AT_VB);
            int cls = 0;
            if (it < nloc) { const int tl = t0 + it, dmin = qoffu + 65 - 64 * tl, dmax = qoffu + 191 - 64 * tl; cls = (dmin > 128 || dmax < -128) ? 2 : ((dmin >= -128 && dmax <= 128) ? 0 : 1); }
            if (cls != 2) {
            f32x16 S[2][2];
#pragma unroll
            for (int kb = 0; kb < 2; ++kb)
#pragma unroll
                for (int qb = 0; qb < 2; ++qb)
#pragma unroll
                    for (int r = 0; r < 16; ++r) S[kb][qb][r] = -mrun[qb];
#pragma unroll
            for (int ks = 0; ks < 4; ++ks)
#pragma unroll
                for (int kb = 0; kb < 2; ++kb) {
                    const f16x8 kf = *(const LAS f16x8*)(Kl + (32 * kb + l32) * 72 + 16 * ks + 8 * hi);
#pragma unroll
                    for (int qb = 0; qb < 2; ++qb) S[kb][qb] = __builtin_amdgcn_mfma_f32_32x32x16_f16(kf, Qf[qb][ks], S[kb][qb], 0, 0, 0);
                }
            if (cls == 1) {
                const int kt = 64 * (t0 + it);
#pragma unroll
                for (int qb = 0; qb < 2; ++qb) {
                    const int qp = 128 + qoff + 32 * qb + l32;
#pragma unroll
                    for (int kb = 0; kb < 2; ++kb)
#pragma unroll
                        for (int r = 0; r < 16; ++r) { const int kp = kt + 32 * kb + 8 * (r >> 2) + 4 * hi + (r & 3); const int d = qp - kp; if (d > 128 || d < -128) S[kb][qb][r] = -INFINITY; }
                }
            }
            f16x8 Pf[2][4];
#pragma unroll
            for (int qb = 0; qb < 2; ++qb) {
                float mx = S[0][qb][0];
#pragma unroll
                for (int kb = 0; kb < 2; ++kb)
#pragma unroll
                    for (int r = 0; r < 16; ++r) mx = fmaxf(mx, S[kb][qb][r]);
                { const auto sw = __builtin_amdgcn_permlane32_swap(__float_as_uint(mx), __float_as_uint(mx), false, false); mx = fmaxf(__uint_as_float(sw[0]), __uint_as_float(sw[1])); }
                if (__builtin_amdgcn_ballot_w64(mx > 8.0f) != 0ull) {
                    const float g = fmaxf(mx, 0.f), corr = __builtin_amdgcn_exp2f(-g);
                    mrun[qb] += g; lrun[qb] *= corr;
#pragma unroll
                    for (int kb = 0; kb < 2; ++kb)
#pragma unroll
                        for (int r = 0; r < 16; ++r) S[kb][qb][r] -= g;
#pragma unroll
                    for (int db = 0; db < 2; ++db)
#pragma unroll
                        for (int r = 0; r < 16; ++r) OT[db][qb][r] *= corr;
                }
                float ps = 0.f;
#pragma unroll
                for (int kb = 0; kb < 2; ++kb)
#pragma unroll
                    for (int r = 0; r < 16; ++r) { const float p = __builtin_amdgcn_exp2f(S[kb][qb][r]); S[kb][qb][r] = p; ps += p; }
                lrun[qb] += ps;
#pragma unroll
                for (int ks = 0; ks < 4; ++ks) { const int kb = ks >> 1, r0 = 8 * (ks & 1);
#pragma unroll
                    for (int e = 0; e < 8; ++e) Pf[qb][ks][e] = (f16)S[kb][qb][r0 + e]; }
            }
#pragma unroll
            for (int ks = 0; ks < 4; ++ks)
#pragma unroll
                for (int db = 0; db < 2; ++db) {
                    const LAS f16* vp = Vl + (32 * db + l32) * 68 + 16 * ks + 4 * hi;
                    const f16x4 v0 = *(const LAS f16x4*)vp, v1 = *(const LAS f16x4*)(vp + 8);
                    const f16x8 vf = (f16x8){v0[0], v0[1], v0[2], v0[3], v1[0], v1[1], v1[2], v1[3]};
#pragma unroll
                    for (int qb = 0; qb < 2; ++qb) OT[db][qb] = __builtin_amdgcn_mfma_f32_32x32x16_f16(vf, Pf[qb][ks], OT[db][qb], 0, 0, 0);
                }
            }
            if (it + 1 < ntiles) {
                LAS f16* Kw = (LAS f16*)(lds + (buf ^ 1) * AT_KB); LAS f16* Vw = (LAS f16*)(lds + 2 * AT_KB + (buf ^ 1) * AT_VB);
                *(LAS f16x8*)(Kw + lkey * 72 + lpc * 8) = kreg;
#pragma unroll
                for (int i = 0; i < 8; ++i) Vw[(lpc * 8 + i) * 68 + lkey] = vreg[i];
            }
            __syncthreads();
        }
#pragma unroll
        for (int qb = 0; qb < 2; ++qb) {
            const float lt = lrun[qb] + shx<32>(lrun[qb], lane);
            const float inv = 1.0f / lt;
            f16* op = P.O() + (size_t)(qrow0 + qoff + 32 * qb + l32) * 1024 + h * 64;
#pragma unroll
            for (int db = 0; db < 2; ++db)
#pragma unroll
                for (int i = 0; i < 4; ++i) {
                    const f16x4 o = (f16x4){(f16)(OT[db][qb][4 * i] * inv), (f16)(OT[db][qb][4 * i + 1] * inv), (f16)(OT[db][qb][4 * i + 2] * inv), (f16)(OT[db][qb][4 * i + 3] * inv)};
                    *(f16x4*)(op + 32 * db + 8 * i + 4 * hi) = o;
                }
        }
    }
}

#define MEGA_LDS (147456 + 16)
__device__ __forceinline__ const Params& opq(Params& q) { int z; asm volatile("s_mov_b32 %0, 0" : "=s"(z)); q.zoff = z; return q; }
__global__ __launch_bounds__(NTHR, 2) void mega(Params P) {
    extern __shared__ __attribute__((aligned(16))) unsigned char shm[];
    LAS unsigned char* lds = (LAS unsigned char*)shm;
    volatile LAS unsigned* st = (volatile LAS unsigned*)(lds + 147456);
    if (threadIdx.x == 0) { st[0] = 0u; st[1] = 0u; st[2] = 0u; st[3] = 0u; }
    __syncthreads();
    const XcdBarrier bar = xcd_barrier_post(P.bar(), st);
    const int nb = gridDim.x;
#define bid (opaque_bid())
    Params Q = P; Q.wv = __builtin_amdgcn_readfirstlane(threadIdx.x >> 6);
#define P (opq(Q))
    phase_ada(P, bid, nb, (float*)shm);
    __syncthreads();
    phase_convert(P, 0, bid, nb, (f16*)shm, false);
    xcd_barrier(bar);
    for (int l = 0; l < 4; ++l) {
        if (l == 0) phase_n1<true, false>(P, l, bid, nb); else { phase_n1<false, false>(P, l, bid, nb); __syncthreads(); phase_convert(P, l, bid, nb, (f16*)shm, false);
            }
        xcd_barrier(bar);
        if ((l & 1) == 0) {
            phase_pool_fast(P, lds);
            xcd_barrier(bar);
            phase_n2<true>(P, l, bid, nb, (float*)shm);
        } else {
            phase_qkv_fast(P, lds, l == 3, l);
            if (nb == 256 && (bid & 7) >= 2) { __syncthreads(); cvt3_job(P, (l == 1 ? 192 : 576) + ((bid & 7) - 2) * 32 + (bid >> 3), (f16*)shm); }
            xcd_barrier(bar);
            phase_attn_fast(P, l, lds, l != 3);
            if (l == 3 && nb != 256) { __syncthreads(); phase_cvt_ctx<true, false>(P, l, bid, nb, (f16*)shm, -1, true); phase_cvt_ctx<false, false>(P, l, bid, nb, (f16*)shm, -1, true); }
            xcd_barrier(bar);
            phase_oproj_fast(P, lds, l == 3);
            if (l == 1 && nb == 256 && (bid & 7) >= 2) { __syncthreads(); cvt3_job(P, 384 + ((bid & 7) - 2) * 32 + (bid >> 3), (f16*)shm); }
            xcd_barrier(bar);
            phase_n2<false>(P, l, bid, nb, (float*)shm, l == 3 ? NLAT : MROWS);
        }
        xcd_barrier(bar);
        phase_topk(P, bid, nb, (unsigned*)shm, l == 3 ? 32 : 64);
        if (l < 3 && nb == 256 && bid >= 64 && bid < 128) cvt3_job(P, l * 64 + bid - 64, (f16*)shm);
        xcd_barrier(bar);
        if (l < 3) { phase_cvt_ctx<true, true>(P, l, bid, nb, (f16*)shm); xcd_barrier(bar); }
        phase_gateup_fast(P, lds, 16, l == 3);
        if (l < 3) { __syncthreads(); phase_cvt_ctx<false, true>(P, l, bid, nb, (f16*)shm); }
        xcd_barrier(bar);
        phase_down_fast(P, lds, 16, l == 3);
        xcd_barrier(bar);
    }
    phase_n1<false, true>(P, 4, bid, nb);
#undef P
#undef bid
}

static inline size_t al256(size_t v) { return (v + 255) & ~(size_t)255; }

extern "C" void kernel_launch(void* const* d_in, const int* in_sizes, int n_in, void* d_out, int out_size, void* d_ws, size_t ws_size, hipStream_t stream) {
    Params P{};
    P.x = (const float*)d_in[0]; P.c = (const float*)d_in[1]; P.ctx = (const float*)d_in[2]; P.c_ctx = (const float*)d_in[3];
    P.w_ada = (const float*)d_in[4]; P.b_ada = (const float*)d_in[5]; P.norm1_g = (const float*)d_in[6]; P.norm2_g = (const float*)d_in[7];
    P.pool_w = (const float*)d_in[8]; P.pool_scale = (const float*)d_in[9]; P.w_qkv = (const float*)d_in[10]; P.w_o = (const float*)d_in[11];
    P.q_norm = (const float*)d_in[12]; P.k_norm = (const float*)d_in[13]; P.sink = (const float*)d_in[14]; P.router_w = (const float*)d_in[15];
    P.w_gate = (const float*)d_in[16]; P.w_up = (const float*)d_in[17]; P.w_down = (const float*)d_in[18];
    P.out = (float*)d_out;
    P.ws = (char*)d_ws; const size_t off = WS_TOTAL;
    if (off > ws_size) { fprintf(stderr, "workspace too small: need %zu have %zu\n", off, ws_size); return; }
    static int grid = 0;
    if (!grid) {
        int dev = 0, cus = 0, per_cu = 0;
        hipGetDevice(&dev);
        hipDeviceGetAttribute(&cus, hipDeviceAttributeMultiprocessorCount, dev);
        hipFuncSetAttribute((const void*)mega, hipFuncAttributeMaxDynamicSharedMemorySize, MEGA_LDS);
        hipOccupancyMaxActiveBlocksPerMultiprocessor(&per_cu, (const void*)mega, NTHR, MEGA_LDS);
        if (per_cu < 1) { fprintf(stderr, "mega: occupancy query says %d blocks per CU\n", per_cu); }
        grid = cus > 0 ? cus : 256;
    }
    hipMemsetAsync(P.bar(), 0, XCD_BAR_WORDS * sizeof(unsigned), stream);
    hipLaunchKernelGGL(mega, dim3(grid), dim3(NTHR), MEGA_LDS, stream, P);
}
```

```cpp
#include <hip/hip_runtime.h>
#include <stdint.h>
#include <stdio.h>

typedef _Float16 f16;
typedef _Float16 f16x2 __attribute__((ext_vector_type(2)));
typedef _Float16 f16x4 __attribute__((ext_vector_type(4)));
typedef _Float16 f16x8 __attribute__((ext_vector_type(8)));
typedef float f32x4 __attribute__((ext_vector_type(4)));
typedef float f32x2 __attribute__((ext_vector_type(2)));
typedef unsigned u32x2 __attribute__((ext_vector_type(2)));
typedef unsigned u32x4 __attribute__((ext_vector_type(4)));
#define RM_BITS 3
#define RM_ADD (0x00010001u << (RM_BITS - 1))
#define RM_MASK (~(0x00010001u * ((1u << RM_BITS) - 1u)))
__device__ __forceinline__ f16x4 rm4(f16x4 v) { u32x2 b = __builtin_bit_cast(u32x2, v); b = (b + RM_ADD) & RM_MASK; return __builtin_bit_cast(f16x4, b); }
__device__ __forceinline__ f16x8 rm8(f16x8 v) { u32x4 b = __builtin_bit_cast(u32x4, v); b = (b + RM_ADD) & RM_MASK; return __builtin_bit_cast(f16x8, b); }

#define LAS __attribute__((address_space(3)))
#define DM 1024
#define SEQ 16384
#define NLAT 32768
#define CTXL 256
#define NCTX 512
#define MROWS 33280
#define NEXP 16
#define DEXP 2048
#define SLOTS 4160
#define SLOTS_PAD 4352
#define QKVD 1536
#define NTHR 512

constexpr size_t al256c(size_t v) { return (v + 255) & ~(size_t)255; }
constexpr size_t OFF_BAR = 0;
constexpr size_t OFF_MOD = al256c(OFF_BAR + 16384);
constexpr size_t OFF_ROPE = al256c(OFF_MOD + (size_t)4 * 3 * 6 * DM * 4);
constexpr size_t OFF_X = al256c(OFF_ROPE + (size_t)256 * 16 * 2 * 4);
constexpr size_t OFF_H = al256c(OFF_X + (size_t)MROWS * DM * 4);
constexpr size_t OFF_Z = al256c(OFF_H + (size_t)MROWS * DM * 2);
constexpr size_t OFF_Q = al256c(OFF_Z + (size_t)MROWS * DM * 2);
constexpr size_t OFF_KB = al256c(OFF_Q + (size_t)MROWS * DM * 2);
constexpr size_t OFF_VB = al256c(OFF_KB + (size_t)MROWS * 256 * 2);
constexpr size_t OFF_VT = al256c(OFF_VB + (size_t)MROWS * 256 * 2);
constexpr size_t OFF_O = al256c(OFF_VT + (size_t)MROWS * 256 * 2);
constexpr size_t OFF_AFF = al256c(OFF_O + (size_t)MROWS * DM * 2);
constexpr size_t OFF_INV = al256c(OFF_AFF + (size_t)MROWS * 16 * 4);
constexpr size_t OFF_ROWIDX = al256c(OFF_INV + (size_t)MROWS * 16 * 4);
constexpr size_t OFF_ACT = al256c(OFF_ROWIDX + (size_t)NEXP * SLOTS_PAD * 4);
constexpr size_t OFF_YSLOT = al256c(OFF_ACT + (size_t)NEXP * SLOTS_PAD * DEXP * 2);
constexpr size_t OFF_WGU = al256c(OFF_YSLOT + (size_t)NEXP * SLOTS_PAD * DM * 2);
constexpr size_t OFF_WD = al256c(OFF_WGU + (size_t)NEXP * 2 * DEXP * DM * 2);
constexpr size_t OFF_WMIX = al256c(OFF_WD + (size_t)NEXP * DM * DEXP * 2);
constexpr size_t OFF_WGU3 = al256c(OFF_WMIX + (size_t)(QKVD + DM) * DM * 2);
constexpr size_t OFF_WD3 = al256c(OFF_WGU3 + (size_t)NEXP * 2 * DEXP * DM * 2);
constexpr size_t OFF_DUMMY = al256c(OFF_WD3 + (size_t)NEXP * DM * DEXP * 2);
constexpr size_t WS_TOTAL = OFF_DUMMY;
struct Params {
    const float *x, *c, *ctx, *c_ctx, *w_ada, *b_ada, *norm1_g, *norm2_g, *pool_w, *pool_scale, *w_qkv, *w_o, *q_norm, *k_norm, *sink, *router_w, *w_gate, *w_up, *w_down;
    float* out; char* ws; int wv; int zoff;
#define WSF(name, type, off) __host__ __device__ __forceinline__ type* name() const { return (type*)(ws + zoff + (off)); }
    WSF(bar, unsigned, OFF_BAR) WSF(mod, float, OFF_MOD) WSF(rope, float, OFF_ROPE) WSF(X, f16, OFF_X) WSF(H, f16, OFF_H) WSF(Z, f16, OFF_Z) WSF(Q, f16, OFF_Q) WSF(Kb, f16, OFF_KB) WSF(Vb, f16, OFF_VB) WSF(Vt, f16, OFF_VT)
    WSF(O, f16, OFF_O) WSF(aff, float, OFF_AFF) WSF(inv, int, OFF_INV) WSF(rowidx, int, OFF_ROWIDX) WSF(act, f16, OFF_ACT) WSF(yslot, f16, OFF_YSLOT) WSF(Wgu, f16, OFF_WGU) WSF(Wd, f16, OFF_WD) WSF(Wmix, f16, OFF_WMIX)
#undef WSF
#define WSW(name, type, off) __host__ __device__ __forceinline__ type* name() const { return (type*)(ws + zoff + (off)); }
    WSW(Xw, f16, OFF_X) WSW(Ow, f16, OFF_O) WSW(Hw, f16, OFF_H) WSW(affw, float, OFF_AFF) WSW(Qw, f16, OFF_Q) WSW(Kw, f16, OFF_KB)
#undef WSW
};

template <int O> __device__ __forceinline__ float shx(float v, int lane) {
    if (O == 1) return __int_as_float(__builtin_amdgcn_update_dpp(0, __float_as_int(v), 0xB1, 0xF, 0xF, true));
    if (O == 2) return __int_as_float(__builtin_amdgcn_update_dpp(0, __float_as_int(v), 0x4E, 0xF, 0xF, true));
    if (O < 32) return __int_as_float(__builtin_amdgcn_ds_swizzle(__float_as_int(v), (O << 10) | 0x1f));
    return __int_as_float(__builtin_amdgcn_ds_bpermute((lane ^ O) << 2, __float_as_int(v)));
}
__device__ __forceinline__ float wave_sum(float v, int lane) {
    v += shx<1>(v, lane); v += shx<2>(v, lane); v += shx<4>(v, lane); v += shx<8>(v, lane); v += shx<16>(v, lane); v += shx<32>(v, lane);
    return v;
}
__device__ __forceinline__ unsigned shup(unsigned v, int o, int lane) { return (unsigned)__builtin_amdgcn_ds_bpermute((lane - o) << 2, (int)v); }
__device__ __forceinline__ int opaque_bid() { int b = blockIdx.x; asm volatile("" : "+s"(b)); return b; }
#define opaque_tid() opaque_tid_(P.wv)
__device__ __forceinline__ int opaque_tid_(int wv) { int ln; asm volatile("v_mbcnt_lo_u32_b32 %0, -1, 0\n\tv_mbcnt_hi_u32_b32 %0, -1, %0" : "=v"(ln)); return (wv << 6) | ln; }
__device__ __forceinline__ float silu_f(float v) { return v * __builtin_amdgcn_rcpf(1.0f + __expf(-v)); }

__device__ __forceinline__ const float* modp(const Params& P, int l, int v, int j) { return P.mod() + (size_t)((l * 3 + v) * 6 + j) * DM; }

__device__ __forceinline__ void phase_ada(const Params& P, int bid, int nb, float* lds) {
    float* sc = lds; float* red = lds + 3 * DM;
    const int tid = opaque_tid();
    for (int i = tid; i < 3 * DM; i += NTHR) { const int v = i >> 10, k = i & 1023; const float cv = v < 2 ? P.c[v * DM + k] : P.c_ctx[k]; sc[i] = silu_f(cv); }
    __syncthreads();
    for (int u = bid; u < 4 * 96; u += nb) {
        const int l = u / 96, ch = u % 96, col = ch * 64 + (tid & 63), ks = tid >> 6;
        const float* w = P.w_ada + (size_t)l * DM * 6 * DM + col;
        float s0 = 0.f, s1 = 0.f, s2 = 0.f;
        for (int k = ks * 128; k < ks * 128 + 128; ++k) { const float wv = __builtin_nontemporal_load(w + (size_t)k * 6 * DM); s0 += sc[k] * wv; s1 += sc[DM + k] * wv; s2 += sc[2 * DM + k] * wv; }
        red[(ks * 3 + 0) * 64 + (tid & 63)] = s0; red[(ks * 3 + 1) * 64 + (tid & 63)] = s1; red[(ks * 3 + 2) * 64 + (tid & 63)] = s2;
        __syncthreads();
        if (tid < 192) { const int v = tid >> 6, cc = tid & 63; float s = 0.f;
#pragma unroll
            for (int q = 0; q < 8; ++q) s += red[(q * 3 + v) * 64 + cc];
            const int colg = ch * 64 + cc; s += P.b_ada[l * 6 * DM + colg];
            const int j = colg >> 10, d = colg & 1023;
            P.mod()[(size_t)((l * 3 + v) * 6 + j) * DM + d] = s; }
        __syncthreads();
    }
    for (int i = bid * NTHR + tid; i < 256 * 16; i += nb * NTHR) {
        const int p = i >> 4, f = i & 15;
        const float inv = powf(10000.0f, -(float)f / 16.0f);
        const float angf = (float)p * inv;
        double a = (double)angf;
        const double twopi = 6.283185307179586476925286766559;
        a -= twopi * rint(a / twopi);
        const double a2 = a * a;
        double cs = 1.0, sn = 1.0;
        double tc = 0.0, ts = 0.0;
        for (int n = 16; n >= 1; --n) { tc = (tc + 1.0) * (-a2 / (double)((2 * n - 1) * (2 * n))); ts = (ts + 1.0) * (-a2 / (double)((2 * n) * (2 * n + 1))); }
        cs = 1.0 + tc; sn = a * (1.0 + ts);
        P.rope()[i * 2] = (float)cs; P.rope()[i * 2 + 1] = (float)sn;
    }
}

__device__ __forceinline__ f32x4 cvt4(const f16x4 v) { return (f32x4){(float)v[0], (float)v[1], (float)v[2], (float)v[3]}; }
__device__ __forceinline__ f16x4 pk4(const f32x4 v) { return (f16x4){(f16)v[0], (f16)v[1], (f16)v[2], (f16)v[3]}; }
__device__ __forceinline__ float dot4(const f32x4 a, const f32x4 b) { return a[0] * b[0] + a[1] * b[1] + a[2] * b[2] + a[3] * b[3]; }
template <bool FIRST, bool FINAL>
__device__ __forceinline__ void phase_n1(const Params& P, int l, int bid, int nb) {
    constexpr int R = 4;
    const int tid_ = opaque_tid(); const int wid = P.wv, lane = tid_ & 63;
    const int nrows = FINAL ? NLAT : MROWS;
    for (int rb = (bid * 8 + wid) * R; rb < nrows; rb += nb * 8 * R) {
        const int v = rb < NLAT ? (rb >> 14) : 2;
        f32x4 xv[R][4];
#pragma unroll
        for (int u = 0; u < R; ++u) {
            const int r = rb + u;
            if (FIRST) { const float* src = r < NLAT ? P.x + (size_t)r * DM : P.ctx + (size_t)(r - NLAT) * DM;
#pragma unroll
                for (int q = 0; q < 4; ++q) xv[u][q] = __builtin_nontemporal_load((const f32x4*)(src + q * 256 + lane * 4)); }
            else { const f16* src = P.X() + (size_t)r * DM;
#pragma unroll
                for (int q = 0; q < 4; ++q) xv[u][q] = cvt4(*(const f16x4*)(src + q * 256 + lane * 4)); }
        }
        if (!FIRST) {
            const int sl = P.inv()[(size_t)(lane & 15) * MROWS + rb + (lane >> 4)];
            const float af = P.aff()[(size_t)(lane & 15) * MROWS + rb + (lane >> 4)];
            const unsigned long long bal = __builtin_amdgcn_ballot_w64(sl >= 0);
            unsigned m[R];
#pragma unroll
            for (int u = 0; u < R; ++u) m[u] = (unsigned)(bal >> (16 * u)) & 0xffffu;
            const f16* ys = P.yslot();
            const float* g2 = modp(P, l - 1, v, 5);
            f32x4 gv[4];
#pragma unroll
            for (int q = 0; q < 4; ++q) gv[q] = *(const f32x4*)(g2 + q * 256 + lane * 4);
            while (m[0] | m[1] | m[2] | m[3]) {
                f16x4 yv[R][4]; float w[R];
#pragma unroll
                for (int u = 0; u < R; ++u) {
                    const int e = m[u] ? __builtin_ctz(m[u]) : 0;
                    const int sv = m[u] ? __builtin_amdgcn_readlane(sl, 16 * u + e) : 0;
                    w[u] = m[u] ? __int_as_float(__builtin_amdgcn_readlane(__float_as_int(af), 16 * u + e)) : 0.f;
                    m[u] &= m[u] - 1u;
                    const f16* y = ys + ((size_t)e * SLOTS_PAD + sv) * DM + lane * 4;
#pragma unroll
                    for (int q = 0; q < 4; ++q) yv[u][q] = *(const f16x4*)(y + q * 256);
                }
#pragma unroll
                for (int u = 0; u < R; ++u)
#pragma unroll
                    for (int q = 0; q < 4; ++q) xv[u][q] += (w[u] * gv[q]) * cvt4(yv[u][q]);
            }
        }
        if (FINAL) {
#pragma unroll
            for (int u = 0; u < R; ++u)
#pragma unroll
                for (int q = 0; q < 4; ++q) __builtin_nontemporal_store(xv[u][q], (f32x4*)(P.out + (size_t)(rb + u) * DM + q * 256 + lane * 4));
            continue;
        }
        float ss[R];
#pragma unroll
        for (int u = 0; u < R; ++u) {
            f16* xd = P.Xw() + (size_t)(rb + u) * DM; float sacc = 0.f;
#pragma unroll
            for (int q = 0; q < 4; ++q) { *(f16x4*)(xd + q * 256 + lane * 4) = pk4(xv[u][q]); sacc += dot4(xv[u][q], xv[u][q]); }
            ss[u] = sacc;
        }
#pragma unroll
        for (int u = 0; u < R; ++u) ss[u] = rsqrtf(wave_sum(ss[u], lane) * (1.0f / DM) + 1e-6f);
        const float* g = P.norm1_g + l * DM; const float* sh = modp(P, l, v, 0); const float* scl = modp(P, l, v, 1);
#pragma unroll
        for (int q = 0; q < 4; ++q) {
            const int c0 = q * 256 + lane * 4;
            const f32x4 gq = *(const f32x4*)(g + c0), sq = *(const f32x4*)(sh + c0), cq = *(const f32x4*)(scl + c0);
            const f32x4 gm = gq * (1.0f + cq);
#pragma unroll
            for (int u = 0; u < R; ++u) *(f16x4*)(P.Hw() + (size_t)(rb + u) * DM + c0) = rm4(pk4(xv[u][q] * ss[u] * gm + sq));
        }
    }
}

#define N2_ZST 81920
template <bool POOL>
__device__ __forceinline__ void phase_n2(const Params& P, int l, int bid, int nb, float* lds, int nrows = MROWS) {
    const int tid = opaque_tid(), wid = P.wv, lane = tid & 63;
    const float* wr = P.router_w + (size_t)l * DM * NEXP;
    f16* wh = (f16*)lds;
    for (int i = tid; i < DM * NEXP; i += NTHR) { const int d = i >> 4, e = i & 15; wh[e * 1032 + d] = (f16)wr[i]; }
    f16* h2s = (f16*)lds + 16640;
    LAS unsigned char* zst = (LAS unsigned char*)lds + N2_ZST;
    const int j = l >> 1, nblk = nrows >> 4;
    const f16* Zg = P.Z();
    const f16* Xg = P.X();
    f16x4 xr[2][4]; f16x4 zr[2][4];
    auto prefetch = [&](int blk) {
        const int R0 = blk * 16, rb = R0 + wid * 2;
        if (POOL) {
            int s0, L; if (R0 < NLAT) { s0 = (R0 >> 14) << 14; L = SEQ; } else { s0 = NLAT + (((R0 - NLAT) >> 8) << 8); L = CTXL; }
#pragma unroll
            for (int i = 0; i < 8; ++i) { const int piece = wid * 8 + i; int rr = R0 - 8 + (piece >> 1); rr = rr < s0 ? s0 : (rr > s0 + L - 1 ? s0 + L - 1 : rr);
                __builtin_amdgcn_global_load_lds((const unsigned*)(Zg + (size_t)rr * DM + (piece & 1) * 512 + lane * 8), (LAS unsigned*)(zst + piece * 1024), 16, 0, 0); }
        } else {
#pragma unroll
            for (int u = 0; u < 2; ++u)
#pragma unroll
                for (int q = 0; q < 4; ++q) zr[u][q] = *(const f16x4*)(Zg + (size_t)(rb + u) * DM + q * 256 + lane * 4);
        }
#pragma unroll
        for (int u = 0; u < 2; ++u)
#pragma unroll
            for (int q = 0; q < 4; ++q) xr[u][q] = *(const f16x4*)(Xg + (size_t)(rb + u) * DM + q * 256 + lane * 4);
    };
    int blk = bid;
    if (blk < nblk) prefetch(blk);
    __syncthreads();
    while (blk < nblk) {
        const int R0 = blk * 16, rb = R0 + wid * 2;
        int v, s0, L;
        if (rb < NLAT) { v = rb >> 14; s0 = v << 14; L = SEQ; } else { v = 2; s0 = NLAT + (((rb - NLAT) >> 8) << 8); L = CTXL; }
        const int t = rb - s0;
        f32x4 g1v[4], gmv[4], shv[4], psv[4];
        { const float* g1 = modp(P, l, v, 2); const float* g = P.norm2_g + l * DM; const float* sh = modp(P, l, v, 3); const float* scl = modp(P, l, v, 4);
#pragma unroll
            for (int q = 0; q < 4; ++q) { const int c0 = q * 256 + lane * 4;
                g1v[q] = *(const f32x4*)(g1 + c0); const f32x4 gv = *(const f32x4*)(g + c0), cv = *(const f32x4*)(scl + c0); shv[q] = *(const f32x4*)(sh + c0); gmv[q] = gv * (1.0f + cv);
                if (POOL) psv[q] = *(const f32x4*)(P.pool_scale + j * DM + c0); } }
        f32x4 y[2][4];
        if (POOL) {
            asm volatile("s_waitcnt vmcnt(0)" ::: "memory");
            __syncthreads();
#pragma unroll
            for (int q = 0; q < 4; ++q) {
                const int h = 1 << q;
                const LAS f16* zb = (const LAS f16*)zst + q * 256 + lane * 4;
                f32x4 common = (f32x4){0.f, 0.f, 0.f, 0.f}, z0 = common, z1 = common;
#pragma unroll
                for (int d = -h; d <= h; ++d) {
                    const int tt = t + d; const bool ok = tt >= 0 && tt < L;
                    f32x4 zz = cvt4(*(const LAS f16x4*)(zb + (2 * wid + 8 + d) * DM));
                    if (!ok) zz = (f32x4){0.f, 0.f, 0.f, 0.f};
                    if (d == -h) z0 = zz; else if (d == h) z1 = zz; else common += zz;
                    if (d == 0) y[0][q] = zz;
                    if (d == 1) y[1][q] = zz;
                }
                const int c0n = min(t + h, L) - max(t - h, 0), c1n = min(t + 1 + h, L) - max(t + 1 - h, 0);
                y[0][q] = ((common + z0) * (1.0f / (float)c0n) - y[0][q]) * psv[q];
                y[1][q] = ((common + z1) * (1.0f / (float)c1n) - y[1][q]) * psv[q];
            }
            asm volatile("s_waitcnt lgkmcnt(0)" ::: "memory");
            __syncthreads();
        } else {
#pragma unroll
            for (int u = 0; u < 2; ++u)
#pragma unroll
                for (int q = 0; q < 4; ++q) y[u][q] = cvt4(zr[u][q]);
        }
        f32x4 xv[2][4]; float ss[2] = {0.f, 0.f};
#pragma unroll
        for (int q = 0; q < 4; ++q) {
#pragma unroll
            for (int u = 0; u < 2; ++u) { xv[u][q] = cvt4(xr[u][q]) + g1v[q] * y[u][q]; ss[u] += dot4(xv[u][q], xv[u][q]); }
        }
        const int nxt = blk + nb;
        asm volatile("" ::: "memory");
        if (nxt < nblk) prefetch(nxt);
#pragma unroll
        for (int u = 0; u < 2; ++u)
#pragma unroll
            for (int q = 0; q < 4; ++q) *(f16x4*)(P.Xw() + (size_t)(rb + u) * DM + q * 256 + lane * 4) = pk4(xv[u][q]);
        ss[0] = wave_sum(ss[0], lane); ss[1] = wave_sum(ss[1], lane);
        const float rs[2] = {rsqrtf(ss[0] * (1.0f / DM) + 1e-6f), rsqrtf(ss[1] * (1.0f / DM) + 1e-6f)};
        f16x4 h2h[2][4];
#pragma unroll
        for (int q = 0; q < 4; ++q) {
            const int c0 = q * 256 + lane * 4;
#pragma unroll
            for (int u = 0; u < 2; ++u) { h2h[u][q] = rm4(pk4(xv[u][q] * rs[u] * gmv[q] + shv[q])); *(f16x4*)(P.Hw() + (size_t)(rb + u) * DM + c0) = h2h[u][q]; }
        }
        asm volatile("s_waitcnt lgkmcnt(0)" ::: "memory"); __builtin_amdgcn_s_barrier(); asm volatile("" ::: "memory");
#pragma unroll
        for (int q = 0; q < 4; ++q)
#pragma unroll
            for (int u = 0; u < 2; ++u) *(f16x4*)(h2s + (2 * wid + u) * 1032 + q * 256 + lane * 4) = h2h[u][q];
        asm volatile("s_waitcnt lgkmcnt(0)" ::: "memory"); __builtin_amdgcn_s_barrier(); asm volatile("" ::: "memory");
        if (wid == 0) {
            const int r16 = lane & 15, kq = lane >> 4;
            f32x4 lg = (f32x4){0.f, 0.f, 0.f, 0.f};
#pragma unroll 8
            for (int ks = 0; ks < 32; ++ks) {
                const f16x8 av = *(const f16x8*)(h2s + r16 * 1032 + ks * 32 + kq * 8), bv = *(const f16x8*)(wh + r16 * 1032 + ks * 32 + kq * 8);
                lg = __builtin_amdgcn_mfma_f32_16x16x32_f16(av, bv, lg, 0, 0, 0);
            }
#pragma unroll
            for (int jj = 0; jj < 4; ++jj) {
                float mx = lg[jj];
                mx = fmaxf(mx, shx<1>(mx, lane)); mx = fmaxf(mx, shx<2>(mx, lane)); mx = fmaxf(mx, shx<4>(mx, lane)); mx = fmaxf(mx, shx<8>(mx, lane));
                const float pe = __expf(lg[jj] - mx);
                float den = pe;
                den += shx<1>(den, lane); den += shx<2>(den, lane); den += shx<4>(den, lane); den += shx<8>(den, lane);
                P.affw()[(size_t)r16 * MROWS + R0 + 4 * kq + jj] = pe / den;
            }
        }
        blk = nxt;
    }
}

__device__ __forceinline__ void phase_topk(const Params& P, int bid, int nb, unsigned* lds, int nprob = 64) {
    unsigned* hist = lds; unsigned* misc = lds + 256; unsigned* wsa = lds + 272; unsigned* wsb = lds + 288;
    const int tid = opaque_tid(), wid = tid >> 6, lane = tid & 63;
    for (int p = bid; p < nprob; p += nb) {
        const int set = p >> 4, e = p & 15;
        const int n = set < 2 ? SEQ : CTXL, C = n >> 3;
        const int r0 = set < 2 ? set * SEQ : NLAT + (set - 2) * CTXL;
        const int slot0 = set < 2 ? set * 2048 : 4096 + (set - 2) * 32;
        unsigned key[32];
#pragma unroll
        for (int i4 = 0; i4 < 8; ++i4) { const int idx = tid * 32 + i4 * 4;
            f32x4 v = (f32x4){0.f, 0.f, 0.f, 0.f}; if (idx < n) v = *(const f32x4*)(P.aff() + (size_t)e * MROWS + r0 + idx);
#pragma unroll
            for (int jj = 0; jj < 4; ++jj) key[i4 * 4 + jj] = idx < n ? (__float_as_uint(v[jj]) + 1u) : 0u; }
        unsigned T = 0u;
        for (int bit = 29; bit >= 0; --bit) {
            const unsigned cand = T | (1u << bit);
            unsigned wc = 0u;
#pragma unroll
            for (int i = 0; i < 32; ++i) wc += (unsigned)__builtin_popcountll(__builtin_amdgcn_ballot_w64(key[i] >= cand));
            unsigned* cb = misc + ((bit & 1) << 3);
            if (lane == 0) cb[wid] = wc;
            __syncthreads();
            unsigned tot = 0u;
#pragma unroll
            for (int w = 0; w < 8; ++w) tot += cb[w];
            if (tot >= (unsigned)C) T = cand;
        }
        unsigned cg = 0u, ce = 0u;
#pragma unroll
        for (int i = 0; i < 32; ++i) { cg += key[i] > T ? 1u : 0u; ce += key[i] == T ? 1u : 0u; }
        unsigned ig = cg, ie = ce;
#pragma unroll
        for (int o = 1; o < 64; o <<= 1) { const unsigned a = shup(ig, o, lane), b = shup(ie, o, lane); if (lane >= o) { ig += a; ie += b; } }
        if (lane == 63) { wsa[wid] = ig; wsb[wid] = ie; }
        __syncthreads();
        unsigned bg = 0u, be = 0u, totg = 0u;
#pragma unroll
        for (int w = 0; w < 8; ++w) { const unsigned ga = wsa[w]; totg += ga; if (w < wid) { bg += ga; be += wsb[w]; } }
        const unsigned krem = (unsigned)C - totg;
        unsigned pg = bg + ig - cg, pe = be + ie - ce;
#pragma unroll
        for (int i4 = 0; i4 < 8; ++i4) {
            int iv[4];
#pragma unroll
            for (int jj = 0; jj < 4; ++jj) {
                const int i = i4 * 4 + jj, idx = tid * 32 + i;
                bool sel = false; unsigned rank = 0u;
                if (key[i] > T) { sel = true; rank = pg + (pe < krem ? pe : krem); ++pg; }
                else if (key[i] == T && key[i] != 0u) { if (pe < krem) { sel = true; rank = pg + pe; } ++pe; }
                if (sel) P.rowidx()[e * SLOTS_PAD + slot0 + (int)rank] = r0 + idx;
                iv[jj] = sel ? slot0 + (int)rank : -1;
            }
            if (tid * 32 + i4 * 4 < n) *(int4*)(P.inv() + (size_t)e * MROWS + r0 + tid * 32 + i4 * 4) = make_int4(iv[0], iv[1], iv[2], iv[3]);
        }
        if (set == 3) for (int i = SLOTS + tid; i < SLOTS_PAD; i += NTHR) P.rowidx()[e * SLOTS_PAD + i] = 0;
        __syncthreads();
    }
}

#define XB_TMO      128
#define XB_XCNT(j)  (256  + 64 * (j))
#define XB_XSUB(j)  (1280 + 64 * (j))
#define XB_XGEN(j)  (2304 + 64 * (j))
#define XB_TOP      3328
#define XB_TOPGEN   3392
#define XCD_BAR_WORDS 3456
#define XB_SPIN_CAP (1u << 18)
__device__ __forceinline__ unsigned xb_ld(unsigned* p)              { return __hip_atomic_load(p, __ATOMIC_RELAXED, __HIP_MEMORY_SCOPE_AGENT); }
__device__ __forceinline__ unsigned xb_add(unsigned* p, unsigned v) { return __hip_atomic_fetch_add(p, v, __ATOMIC_RELAXED, __HIP_MEMORY_SCOPE_AGENT); }
__device__ __forceinline__ unsigned xb_xcc_id() { return (unsigned)__builtin_amdgcn_s_getreg((3 << 11) | 20) & 0xFu; }
#define XB_SPIN(cond, bar) do { unsigned _sp = 0; while (cond) { __builtin_amdgcn_s_sleep(1); \
    if ((++_sp & 255u) == 0u) { if (xb_ld(&(bar)[XB_TMO])) break; if (_sp > XB_SPIN_CAP) { atomicAdd(&(bar)[XB_TMO], 1u); break; } } } } while (0)
struct XcdBarrier { unsigned* bar; unsigned x; volatile LAS unsigned* st; };
__device__ __forceinline__ XcdBarrier xcd_barrier_post(unsigned* bar, volatile LAS unsigned* st) {
    XcdBarrier b; b.bar = bar; b.x = xb_xcc_id(); b.st = st;
    if (threadIdx.x == 0) (void)xb_add(&bar[XB_XCNT(b.x)], 1u);
    return b;
}
__device__ __forceinline__ void xcd_barrier_complete(unsigned* bar, unsigned x, unsigned& nloc, unsigned& nx) {
    const unsigned G = gridDim.x * gridDim.y * gridDim.z;
    unsigned sum, cnt, mine, sp = 0u;
    for (;;) {
        sum = 0u; cnt = 0u; mine = 0u;
#pragma unroll
        for (unsigned j = 0; j < 16; ++j) { const unsigned c = xb_ld(&bar[XB_XCNT(j)]); sum += c; cnt += (c > 0u) ? 1u : 0u; mine = (j == x) ? c : mine; }
        if (sum == G) break;
        __builtin_amdgcn_s_sleep(1);
        if ((++sp & 255u) == 0u) { if (xb_ld(&bar[XB_TMO])) break; if (sp > XB_SPIN_CAP) { atomicAdd(&bar[XB_TMO], 1u); break; } }
    }
    nloc = mine > 0u ? mine : 1u; nx = cnt > 0u ? cnt : 1u;
}
__device__ __forceinline__ void xcd_barrier(const XcdBarrier& b) {
    asm volatile("s_waitcnt vmcnt(0)" ::: "memory");
    __syncthreads();
    if (threadIdx.x == 0) {
        unsigned* bar = b.bar; asm volatile("" : "+s"(bar));
        const unsigned bx = (unsigned)__builtin_amdgcn_readfirstlane((int)xb_xcc_id());
        __builtin_amdgcn_s_waitcnt(0);
        unsigned nloc = b.st[0], nx = b.st[1];
        if (nloc == 0u) { xcd_barrier_complete(bar, bx, nloc, nx); b.st[0] = nloc; b.st[1] = nx; }
        const unsigned old = xb_add(&bar[XB_XSUB(bx)], 1u);
        const unsigned gen = old / nloc;
        if (old + 1u == (gen + 1u) * nloc) {
            __builtin_amdgcn_fence(__ATOMIC_RELEASE, "agent");
            asm volatile("s_waitcnt vmcnt(0)" ::: "memory");
            const unsigned og = xb_add(&bar[XB_TOP], 1u);
            const unsigned tg = og / nx;
            if (og + 1u == (tg + 1u) * nx) xb_add(&bar[XB_TOPGEN], 1u);
            else XB_SPIN(xb_ld(&bar[XB_TOPGEN]) == tg, bar);
            __builtin_amdgcn_fence(__ATOMIC_ACQUIRE, "agent");
            xb_add(&bar[XB_XGEN(bx)], 1u);
            asm volatile("s_waitcnt vmcnt(0)" ::: "memory");
        } else {
            XB_SPIN(xb_ld(&bar[XB_XGEN(bx)]) == gen, bar);
            __builtin_amdgcn_fence(__ATOMIC_ACQUIRE, "agent");
            asm volatile("s_waitcnt vmcnt(0)" ::: "memory");
        }
    }
    __syncthreads();
}

namespace fg {
constexpr int BM = 256, BK = 64, HALF = 128, HTB = HALF * BK * 2, STAGE_BYTES = 8 * HTB;
__device__ __forceinline__ int lds_byte(int r, int c) { const int st = (r >> 4) * 2 + (c >> 5), rr = r & 15, cc = c & 31, ob = rr * 64 + cc * 2; return st * 1024 + (ob ^ (((ob >> 9) & 1) << 5)); }
__device__ __forceinline__ void stage_rc(int b, int& R, int& C) { const int st = b / 1024, sb = b % 1024, swz = sb ^ (((sb >> 9) & 1) << 5); R = (st >> 1) * 16 + swz / 64; C = (st & 1) * 32 + (swz % 64) / 2; }
__device__ __forceinline__ int perm32(int rho) { const int n = rho >> 4, i = rho & 15; return 8 * (i >> 2) + 4 * n + (i & 3); }
#define KDUP 0
struct Unit { int e, pm, pn; int skip; };
__device__ __forceinline__ void xcd_order(int i, int& T) { const int c = blockIdx.x; T = i * (int)gridDim.x + c; }

template <class PR>
__device__ __forceinline__ void gemm_phase(LAS unsigned char* lds, const PR& S, int wv) {
    const int tid = opaque_tid_(wv), wid = __builtin_amdgcn_readfirstlane(tid >> 6), lane = tid & 63, wr = wid >> 2, wc = wid & 3, fr = lane & 15, fq = lane >> 4;
    constexpr int K = PR::K, nt = K / BK;
    unsigned voffB[2];
#pragma unroll
    for (int i = 0; i < 2; ++i) { int R, C; stage_rc(tid * 16 + i * 8192, R, C); const int Rb = (R & ~31) + perm32(R & 31); voffB[i] = (unsigned)(Rb * PR::LDB + C) * 2u; }
    const size_t kstep = (size_t)(BK * 2);
    const size_t hB = S.hstepB();
    const unsigned ldsw = (unsigned)wid * 1024u;
    const int aoff = lds_byte(wr * 64 + fr, fq * 8), boff = lds_byte(wc * 32 + fr, fq * 8);
#define FG_SA(b, h) (((b) * 2 + (h)) * HTB)
#define FG_SB(b, h) ((4 + (b) * 2 + (h)) * HTB)
#define FG_STAGE(bufoff, gbase, voff) do { _Pragma("unroll") for (int _i = 0; _i < 2; ++_i) \
        __builtin_amdgcn_global_load_lds((const unsigned*)((const char*)(gbase) + (voff)[_i]), (LAS unsigned*)(lds + (bufoff) + ldsw + _i * 8192), 16, 0, 0); } while (0)
#define FG_LDA(dst, b, h) do { _Pragma("unroll") for (int m = 0; m < 4; ++m) _Pragma("unroll") for (int k = 0; k < 2; ++k) dst[m][k] = *(const LAS f16x8*)(lds + FG_SA(b, h) + aoff + m * 2048 + k * 1024); } while (0)
#define FG_LDB(dst, b, h) do { _Pragma("unroll") for (int n = 0; n < 2; ++n) _Pragma("unroll") for (int k = 0; k < 2; ++k) dst[n][k] = *(const LAS f16x8*)(lds + FG_SB(b, h) + boff + n * 2048 + k * 1024); } while (0)
#define FG_MMA(ai, bj, At, Bt) do { __builtin_amdgcn_s_setprio(1); _Pragma("unroll") for (int m = 0; m < 4; ++m) _Pragma("unroll") for (int n = 0; n < 2; ++n) _Pragma("unroll") for (int k = 0; k < 2; ++k) \
        acc[ai][bj][m][n] = __builtin_amdgcn_mfma_f32_16x16x32_f16(Bt[n][k], At[m][k], acc[ai][bj][m][n], 0, 0, 0); __builtin_amdgcn_s_setprio(0); } while (0)
#define FG_WAIT_V(n) asm volatile("s_waitcnt vmcnt(" #n ")" ::: "memory")
#define FG_WAIT_L(n) asm volatile("s_waitcnt lgkmcnt(" #n ")" ::: "memory")
#define FG_BAR __builtin_amdgcn_s_barrier()
#define FG_SCHED __builtin_amdgcn_sched_barrier(0)
    Unit cur, nxt; int ui = 0;
    if (!S.next(0, cur)) return;
    f32x4 acc[2][2][4][2];
#pragma unroll
    for (int a = 0; a < 2; ++a)
#pragma unroll
        for (int b = 0; b < 2; ++b)
#pragma unroll
            for (int m = 0; m < 4; ++m)
#pragma unroll
                for (int n = 0; n < 2; ++n) acc[a][b][m][n] = (f32x4){0.f, 0.f, 0.f, 0.f};
    f16x8 At[4][2], B0[2][2], B1[2][2];
    unsigned vA[2][2], vN[2][2];
    { int Rr[2], Cc[2]; stage_rc(tid * 16, Rr[0], Cc[0]); stage_rc(tid * 16 + 8192, Rr[1], Cc[1]); S.a_voff(cur, Rr, Cc, vA); }
#pragma unroll
    for (int h = 0; h < 2; ++h)
#pragma unroll
        for (int i = 0; i < 2; ++i) { asm volatile("" : "+v"(vA[h][i])); vN[h][i] = vA[h][i]; }
    const char* cA = S.a_base(cur); const char* cB = S.b_base(cur);
    FG_STAGE(FG_SB(0, 0), cB, voffB); FG_STAGE(FG_SA(0, 0), cA, vA[0]); FG_STAGE(FG_SB(0, 1), cB + hB, voffB); FG_STAGE(FG_SA(0, 1), cA, vA[1]);
    if (wr == 1) FG_BAR;
    FG_WAIT_V(4); FG_BAR;
    FG_STAGE(FG_SB(1, 0), cB + kstep, voffB); FG_STAGE(FG_SA(1, 0), cA + kstep, vA[0]); FG_STAGE(FG_SB(1, 1), cB + hB + kstep, voffB);
    FG_WAIT_V(6); FG_BAR;
    for (;;) {
        const bool has_next = S.next(ui + 1, nxt);
        const char* nA = has_next ? S.a_base(nxt) : cA; const char* nB = has_next ? S.b_base(nxt) : cB;
        if (has_next) { int Rr[2], Cc[2]; int t2 = tid; asm volatile("" : "+v"(t2)); stage_rc(t2 * 16, Rr[0], Cc[0]); stage_rc(t2 * 16 + 8192, Rr[1], Cc[1]); S.a_voff(nxt, Rr, Cc, vN);
#pragma unroll
            for (int h = 0; h < 2; ++h)
#pragma unroll
                for (int i = 0; i < 2; ++i) asm volatile("" : "+v"(vN[h][i])); }
#pragma unroll 1
        for (int t = 0; t < nt; t += 2) {
            const bool last = (t == nt - 2);
            const char* a1 = cA + (size_t)(t + 1) * kstep;
            const char* a2 = last ? nA : cA + (size_t)(t + 2) * kstep; const char* b2 = last ? nB : cB + (size_t)(t + 2) * kstep;
            const char* a3 = a2 + kstep; const char* b3 = b2 + kstep;
            unsigned v2[2][2];
#pragma unroll
            for (int h = 0; h < 2; ++h)
#pragma unroll
                for (int i = 0; i < 2; ++i) v2[h][i] = last ? vN[h][i] : vA[h][i];
            FG_LDB(B0, 0, 0); FG_SCHED; FG_LDA(At, 0, 0); FG_STAGE(FG_SA(1, 1), a1, vA[1]);
            FG_WAIT_L(8); FG_BAR; FG_WAIT_L(0); FG_MMA(0, 0, At, B0); FG_BAR; FG_SCHED;
            FG_LDB(B1, 0, 1); FG_STAGE(FG_SB(0, 0), b2, voffB);
            FG_BAR; FG_WAIT_L(0); FG_MMA(0, 1, At, B1); FG_BAR;
            FG_LDA(At, 0, 1); FG_STAGE(FG_SA(0, 0), a2, v2[0]);
            FG_BAR; FG_WAIT_L(0); FG_MMA(1, 0, At, B0); FG_BAR; FG_SCHED;
            FG_STAGE(FG_SB(0, 1), b2 + hB, voffB);
            FG_WAIT_V(6); FG_BAR; FG_MMA(1, 1, At, B1); FG_BAR;
            FG_LDB(B0, 1, 0); FG_SCHED; FG_LDA(At, 1, 0); FG_STAGE(FG_SA(0, 1), a2, v2[1]);
            FG_WAIT_L(8); FG_BAR; FG_WAIT_L(0); FG_MMA(0, 0, At, B0); FG_BAR; FG_SCHED;
            FG_LDB(B1, 1, 1); FG_STAGE(FG_SB(1, 0), b3, voffB);
            FG_BAR; FG_WAIT_L(0); FG_MMA(0, 1, At, B1); FG_BAR;
            FG_LDA(At, 1, 1); FG_STAGE(FG_SA(1, 0), a3, v2[0]);
            FG_BAR; FG_WAIT_L(0); FG_MMA(1, 0, At, B0); FG_BAR; FG_SCHED;
            FG_STAGE(FG_SB(1, 1), b3 + hB, voffB);
            FG_WAIT_V(6); FG_BAR; FG_MMA(1, 1, At, B1); FG_BAR;
        }
        if (!KDUP || !cur.skip) S.epi(acc, cur, wr, wc, fr, fq);
        if (!has_next) break;
#pragma unroll
        for (int a = 0; a < 2; ++a)
#pragma unroll
            for (int b = 0; b < 2; ++b)
#pragma unroll
                for (int m = 0; m < 4; ++m)
#pragma unroll
                    for (int n = 0; n < 2; ++n) acc[a][b][m][n] = (f32x4){0.f, 0.f, 0.f, 0.f};
        cur = nxt; cA = nA; cB = nB; ++ui;
#pragma unroll
        for (int h = 0; h < 2; ++h)
#pragma unroll
            for (int i = 0; i < 2; ++i) vA[h][i] = vN[h][i];
    }
    FG_WAIT_V(0);
    if (wr == 0) FG_BAR;
    FG_BAR;
#undef FG_SA
#undef FG_SB
#undef FG_STAGE
#undef FG_LDA
#undef FG_LDB
#undef FG_MMA
#undef FG_WAIT_V
#undef FG_WAIT_L
#undef FG_BAR
#undef FG_SCHED
}

__device__ __forceinline__ f16x8 pack8(const f32x4 a, const f32x4 b) { return (f16x8){(f16)a[0], (f16)a[1], (f16)a[2], (f16)a[3], (f16)b[0], (f16)b[1], (f16)b[2], (f16)b[3]}; }

template <int K_, int LDA_, int LDB_> struct PRBase {
    static constexpr int K = K_, LDA = LDA_, LDB = LDB_;
    __device__ __forceinline__ void plain_voff(const int (&R)[2], const int (&C)[2], unsigned (&v)[2][2]) const {
#pragma unroll
        for (int h = 0; h < 2; ++h)
#pragma unroll
            for (int i = 0; i < 2; ++i) v[h][i] = (unsigned)((h * HALF + R[i]) * LDA + C[i]) * 2u;
    }
};
struct PRGateUp : PRBase<1024, 1024, 1024> {
    const f16* H; const int* rowidx; const f16* W; f16* act; int nunits; int bid; int rt;
    __device__ __forceinline__ size_t hstepB() const { return (size_t)DEXP * DM * 2; }
    __device__ __forceinline__ bool next(int i, Unit& u) const { const int ii = KDUP ? (i >> 1) : i; const int T = ii * (int)gridDim.x + bid; u.skip = KDUP ? ((i & 1) == 0) : 0; if (T >= nunits) return false;
        if (rt == 16 && gridDim.x == 256) { const int x = bid & 7, jj = bid >> 3; u.e = ii; u.pm = (x >> 1) * 4 + (jj >> 3); u.pn = (x & 1) * 8 + (jj & 7); return true; }
        const int per = rt * 16; u.e = T / per; const int t = T % per; u.pm = t >> 4; u.pn = t & 15; return true; }
    __device__ __forceinline__ const char* a_base(const Unit&) const { return (const char*)H; }
    __device__ __forceinline__ void a_voff(const Unit& u, const int (&R)[2], const int (&C)[2], unsigned (&v)[2][2]) const {
        const int* ri = rowidx + u.e * SLOTS_PAD + u.pm * BM;
#pragma unroll
        for (int h = 0; h < 2; ++h)
#pragma unroll
            for (int i = 0; i < 2; ++i) { const int g = ri[h * HALF + R[i]]; v[h][i] = (unsigned)(g * LDA + C[i]) * 2u; }
    }
    __device__ __forceinline__ const char* b_base(const Unit& u) const { return (const char*)(W + ((size_t)u.e * 2 * DEXP + (size_t)u.pn * HALF) * DM); }
    __device__ __forceinline__ void epi(const f32x4 (&acc)[2][2][4][2], const Unit& u, int wr, int wc, int fr, int fq) const {
        f16* base = act + ((size_t)u.e * SLOTS_PAD + (size_t)u.pm * BM + wr * 64 + fr) * DEXP + u.pn * HALF + wc * 32 + fq * 8;
#pragma unroll
        for (int ai = 0; ai < 2; ++ai)
#pragma unroll
            for (int m = 0; m < 4; ++m) {
                f32x4 o0, o1;
#pragma unroll
                for (int j = 0; j < 4; ++j) { o0[j] = silu_f(acc[ai][0][m][0][j]) * acc[ai][1][m][0][j]; o1[j] = silu_f(acc[ai][0][m][1][j]) * acc[ai][1][m][1][j]; }
                if (u.e < 8) __builtin_nontemporal_store(rm8(pack8(o0, o1)), (f16x8*)(base + (size_t)(ai * HALF + m * 16) * DEXP));
                else *(f16x8*)(base + (size_t)(ai * HALF + m * 16) * DEXP) = rm8(pack8(o0, o1));
            }
    }
};
struct PRDown : PRBase<2048, 2048, 2048> {
    const f16* act; const f16* W; f16* y; int nunits; int bid; int rt;
    __device__ __forceinline__ size_t hstepB() const { return (size_t)HALF * DEXP * 2; }
    __device__ __forceinline__ bool next(int i, Unit& u) const { const int ii = KDUP ? (i >> 1) : i; const int T = ii * (int)gridDim.x + bid; u.skip = KDUP ? ((i & 1) == 0) : 0; if (T >= nunits) return false;
        if (rt == 16 && gridDim.x == 256) { const int x = bid & 7, jj = bid >> 3; u.e = 15 - (ii * 4 + (x >> 1)); u.pm = (x & 1) * 8 + (jj >> 2); u.pn = jj & 3; return true; }
        const int per = rt * 4; u.e = T / per; const int t = T % per; u.pm = t >> 2; u.pn = t & 3; return true; }
    __device__ __forceinline__ const char* a_base(const Unit& u) const { return (const char*)(act + ((size_t)u.e * SLOTS_PAD + (size_t)u.pm * BM) * DEXP); }
    __device__ __forceinline__ void a_voff(const Unit&, const int (&R)[2], const int (&C)[2], unsigned (&v)[2][2]) const { plain_voff(R, C, v); }
    __device__ __forceinline__ const char* b_base(const Unit& u) const { return (const char*)(W + ((size_t)u.e * DM + (size_t)u.pn * BM) * DEXP); }
    __device__ __forceinline__ void epi(const f32x4 (&acc)[2][2][4][2], const Unit& u, int wr, int wc, int fr, int fq) const {
        f16* base = y + ((size_t)u.e * SLOTS_PAD + (size_t)u.pm * BM + wr * 64 + fr) * DM + u.pn * BM + wc * 32 + fq * 8;
#pragma unroll
        for (int ai = 0; ai < 2; ++ai)
#pragma unroll
            for (int m = 0; m < 4; ++m)
#pragma unroll
                for (int bj = 0; bj < 2; ++bj) *(f16x8*)(base + (size_t)(ai * HALF + m * 16) * DM + bj * HALF) = pack8(acc[ai][bj][m][0], acc[ai][bj][m][1]);
    }
};
template <int K_> struct PRDense : PRBase<K_, 1024, K_> {
    const f16* A; const f16* W; f16* O0; f16* O1; f16* O2; int ncol; int mode; int bid; int npan; int kvx;
    __device__ __forceinline__ size_t hstepB() const { return (size_t)HALF * K_ * 2; }
    __device__ __forceinline__ bool next(int i, Unit& u) const { const int ii = KDUP ? (i >> 1) : i; int T = ii * (int)gridDim.x + bid; if (gridDim.x == 256) T = (ii * 8 + (bid & 7)) * 32 + (bid >> 3);
        u.skip = KDUP ? ((i & 1) == 0) : 0; const int nu = npan * ncol; if (T >= nu + kvx) return false; u.e = 0; if (T < nu) { u.pm = T / ncol; u.pn = T % ncol; } else { const int x = T - nu; u.pm = npan + (x >> 1); u.pn = 4 + (x & 1); } return true; }
    __device__ __forceinline__ const char* a_base(const Unit& u) const { return (const char*)(A + (size_t)u.pm * BM * 1024 + (mode == 2 ? u.pn * 256 : 0)); }
    __device__ __forceinline__ void a_voff(const Unit&, const int (&R)[2], const int (&C)[2], unsigned (&v)[2][2]) const { this->plain_voff(R, C, v); }
    __device__ __forceinline__ const char* b_base(const Unit& u) const { return (const char*)(W + (size_t)u.pn * BM * K_); }
    const float* qn; const float* kn; const float* rope; LAS float* xs; int lane;
    __device__ __forceinline__ void epi(const f32x4 (&acc)[2][2][4][2], const Unit& u, int wr, int wc, int fr, int fq) const {
        f16* base; int ld;
        const int row = u.pm * BM + wr * 64 + fr, colw = wc * 32 + fq * 8;
        if (mode == 1) { if (u.pn < 4) { base = O0 + (size_t)row * 1024 + u.pn * BM + colw; ld = 1024; } else if (u.pn == 4) { base = O1 + (size_t)row * 256 + colw; ld = 256; } else { base = O2 + (size_t)row * 256 + colw; ld = 256; } }
        else { base = O0 + (size_t)row * 1024 + u.pn * BM + colw; ld = 1024; }
        if (mode == 1 && u.pn < 5) {
            float ssq[2][4][2];
#pragma unroll
            for (int ai = 0; ai < 2; ++ai)
#pragma unroll
                for (int m = 0; m < 4; ++m)
#pragma unroll
                    for (int bj = 0; bj < 2; ++bj) { const f32x4 a = acc[ai][bj][m][0], b = acc[ai][bj][m][1];
                        float t = (a[0] * a[0] + a[1] * a[1]) + (a[2] * a[2] + a[3] * a[3]) + (b[0] * b[0] + b[1] * b[1]) + (b[2] * b[2] + b[3] * b[3]);
                        t += shx<16>(t, lane); t += shx<32>(t, lane); ssq[ai][m][bj] = t; }
            LAS float* mine = xs + ((wr * 4 + wc) * 16) * 16 + fr; const LAS float* theirs = xs + ((wr * 4 + (wc ^ 1)) * 16) * 16 + fr;
            if (fq == 0) {
#pragma unroll
                for (int ai = 0; ai < 2; ++ai)
#pragma unroll
                    for (int m = 0; m < 4; ++m)
#pragma unroll
                        for (int bj = 0; bj < 2; ++bj) mine[(ai * 8 + m * 2 + bj) * 16] = ssq[ai][m][bj];
            }
            asm volatile("s_waitcnt lgkmcnt(0)" ::: "memory"); __builtin_amdgcn_s_barrier(); asm volatile("" ::: "memory");
            const bool isq = u.pn < 4, lat = u.pm < 128;
            const float* nw = (isq ? qn : kn) + (wc & 1) * 32 + fq * 8;
            const f32x4 w0 = *(const f32x4*)nw, w1 = *(const f32x4*)(nw + 4);
            const float qs = isq ? 0.125f * 1.4426950408889634f : 1.0f;
#pragma unroll
            for (int ai = 0; ai < 2; ++ai)
#pragma unroll
                for (int m = 0; m < 4; ++m) {
                    f32x4 c0 = (f32x4){1.f, 1.f, 1.f, 1.f}, s0 = (f32x4){0.f, 0.f, 0.f, 0.f};
                    if (lat) { const int t = (row + ai * HALF + m * 16) & (SEQ - 1); const int pos = (wc & 1) ? (t & 63) : (t >> 6);
                        const float* tb = rope + (size_t)(pos * 16 + fq * 4) * 2; const f32x4 ta = *(const f32x4*)tb, tb2 = *(const f32x4*)(tb + 4);
                        c0 = (f32x4){ta[0], ta[2], tb2[0], tb2[2]}; s0 = (f32x4){ta[1], ta[3], tb2[1], tb2[3]}; }
#pragma unroll
                    for (int bj = 0; bj < 2; ++bj) {
                        const float tot = ssq[ai][m][bj] + theirs[(ai * 8 + m * 2 + bj) * 16];
                        const float rstd = rsqrtf(tot * (1.0f / 64.0f) + 1e-6f) * qs;
                        f32x4 a = acc[ai][bj][m][0] * rstd * w0, b = acc[ai][bj][m][1] * rstd * w1;
                        const f32x4 ra = (f32x4){a[0] * c0[0] - a[1] * s0[0], a[0] * s0[0] + a[1] * c0[0], a[2] * c0[1] - a[3] * s0[1], a[2] * s0[1] + a[3] * c0[1]};
                        const f32x4 rb = (f32x4){b[0] * c0[2] - b[1] * s0[2], b[0] * s0[2] + b[1] * c0[2], b[2] * c0[3] - b[3] * s0[3], b[2] * s0[3] + b[3] * c0[3]};
                        *(f16x8*)(base + (size_t)(ai * HALF + m * 16) * ld + bj * HALF) = pack8(ra, rb);
                    }
                }
            return;
        }
#pragma unroll
        for (int ai = 0; ai < 2; ++ai)
#pragma unroll
            for (int m = 0; m < 4; ++m)
#pragma unroll
                for (int bj = 0; bj < 2; ++bj) *(f16x8*)(base + (size_t)(ai * HALF + m * 16) * ld + bj * HALF) = pack8(acc[ai][bj][m][0], acc[ai][bj][m][1]);
    }
};
}

struct CvtJob { const float* src; f16* dst; int K, N, k0, n0; };
__device__ __forceinline__ bool cvt_job(const Params& P, int l, int u, CvtJob& jb, bool experts) {
    const int j = l >> 1;
    const int nexp = experts ? NEXP * 3 * 128 : 0;
    const int nmix = (l & 1) == 0 ? 16 : (96 + 64);
    if (u >= nexp + nmix) return false;
    if (u < nexp) {
        const int e = u / 384, r = u % 384, which = r >> 7, t = r & 127;
        if (which < 2) { jb.src = (which == 0 ? P.w_gate : P.w_up) + ((size_t)l * NEXP + e) * DM * DEXP; jb.dst = P.Wgu() + ((size_t)e * 2 + which) * DEXP * DM; jb.K = DM; jb.N = DEXP; jb.k0 = (t >> 4) * 128; jb.n0 = (t & 15) * 128; }
        else { jb.src = P.w_down + ((size_t)l * NEXP + e) * DEXP * DM; jb.dst = P.Wd() + (size_t)e * DM * DEXP; jb.K = DEXP; jb.N = DM; jb.k0 = (t >> 3) * 128; jb.n0 = (t & 7) * 128; }
    } else {
        const int t = u - nexp;
        if ((l & 1) == 0) { const int g = t >> 2, tt = t & 3; jb.src = P.pool_w + (size_t)(j * 4 + g) * 65536; jb.dst = P.Wmix() + (size_t)g * 65536; jb.K = 256; jb.N = 256; jb.k0 = (tt >> 1) * 128; jb.n0 = (tt & 1) * 128; }
        else if (t < 96) { jb.src = P.w_qkv + (size_t)j * DM * QKVD; jb.dst = P.Wmix(); jb.K = DM; jb.N = QKVD; jb.k0 = (t / 12) * 128; jb.n0 = (t % 12) * 128; }
        else { const int tt = t - 96; jb.src = P.w_o + (size_t)j * DM * DM; jb.dst = P.Wmix() + (size_t)QKVD * DM; jb.K = DM; jb.N = DM; jb.k0 = (tt >> 3) * 128; jb.n0 = (tt & 7) * 128; }
    }
    return true;
}
__device__ __forceinline__ void phase_convert(const Params& P, int l, int bid, int nb, f16* tile, bool experts = true) {
    const int tid = opaque_tid();
    CvtJob jb;
    int u = bid;
    bool have = cvt_job(P, l, u, jb, experts);
    f32x4 r[8];
    if (have) {
#pragma unroll
        for (int p = 0; p < 8; ++p) { const int id = tid + p * NTHR, kr = id >> 5, c4 = (id & 31) * 4; r[p] = __builtin_nontemporal_load((const f32x4*)(jb.src + (size_t)(jb.k0 + kr) * jb.N + jb.n0 + c4)); }
    }
    while (have) {
        __syncthreads();
#pragma unroll
        for (int p = 0; p < 8; ++p) { const int id = tid + p * NTHR, kr = id >> 5, c4 = (id & 31) * 4; *(f16x4*)(tile + kr * 136 + c4) = pk4(r[p]); }
        __syncthreads();
        const CvtJob cur = jb;
        u += nb; have = cvt_job(P, l, u, jb, experts);
        if (have) {
#pragma unroll
            for (int p = 0; p < 8; ++p) { const int id = tid + p * NTHR, kr = id >> 5, c4 = (id & 31) * 4; r[p] = __builtin_nontemporal_load((const f32x4*)(jb.src + (size_t)(jb.k0 + kr) * jb.N + jb.n0 + c4)); }
        }
        const int n = tid & 127, kg = (tid >> 7) * 32;
        f16* dp = cur.dst + (size_t)(cur.n0 + n) * cur.K + cur.k0 + kg;
#pragma unroll
        for (int i = 0; i < 4; ++i) { f16x8 o;
#pragma unroll
            for (int e = 0; e < 8; ++e) o[e] = tile[(kg + i * 8 + e) * 136 + n];
            *(f16x8*)(dp + i * 8) = rm8(o); }
    }
}
template <bool GATEUP, bool CTX>
__device__ __forceinline__ void phase_cvt_ctx(const Params& P, int l, int bid, int nb, f16* tile, int sel = -1, bool alt = false) {
    const int tid = opaque_tid(), wid = P.wv, lane = tid & 63, r16 = lane & 15, kq = lane >> 4;
    constexpr int NC = GATEUP ? 128 : 64;
    constexpr int KT = GATEUP ? 8 : 16, K = GATEUP ? DM : DEXP, N = GATEUP ? DEXP : DM, NB = N / NC;
    constexpr int NT = GATEUP ? 2 * KT : KT;
    const int sel_ = (GATEUP && !CTX) ? sel : -1; const int ntr = (GATEUP && sel_ < 0) ? NT : KT;
    constexpr int TS = NC + 4, TW = 128 * TS;
    constexpr int NLD = NC / 16;
    constexpr int WPC = 8 / (NC / 16);
    constexpr int NRB = 4 / WPC;
    const int cb = wid % (NC / 16), rb0 = (wid / (NC / 16)) * NRB;
    f16* asl = tile + 2 * TW;
    for (int job = bid; job < NEXP * NB; job += nb) {
        const int e = job / NB, nbk = job % NB;
        const f16* ap[2];
        if (CTX) {
#pragma unroll
            for (int p = 0; p < 2; ++p) { const int row = (tid >> 4) + p * 32;
                if (GATEUP) ap[p] = P.H() + (size_t)P.rowidx()[e * SLOTS_PAD + 4096 + row] * DM + (tid & 15) * 8;
                else ap[p] = P.act() + ((size_t)e * SLOTS_PAD + 4096 + row) * DEXP + (tid & 15) * 8; }
        }
        f32x4 acc[2][NRB];
#pragma unroll
        for (int w = 0; w < 2; ++w)
#pragma unroll
            for (int rb = 0; rb < NRB; ++rb) acc[w][rb] = (f32x4){0.f, 0.f, 0.f, 0.f};
        const float* srcs[2]; f16* dsts[2];
        if (GATEUP) { const size_t wo = ((size_t)l * NEXP + e) * DM * DEXP; srcs[0] = P.w_gate + wo; srcs[1] = P.w_up + wo; dsts[0] = P.Wgu() + (alt ? (OFF_WGU3 - OFF_WGU) / 2 : 0) + ((size_t)e * 2) * DEXP * DM; dsts[1] = dsts[0] + (size_t)DEXP * DM; }
        else { srcs[0] = P.w_down + ((size_t)l * NEXP + e) * DEXP * DM; srcs[1] = srcs[0]; dsts[0] = P.Wd() + (alt ? (OFF_WD3 - OFF_WD) / 2 : 0) + (size_t)e * DM * DEXP; dsts[1] = dsts[0]; }
        f32x4 r[2][NLD]; f16x8 ar[2][2];
        const unsigned ldoff = (unsigned)(((tid / (NC / 4)) * N + (tid % (NC / 4)) * 4) * 4);
#define CV_LOAD(ti, slot) do { const int which_ = GATEUP ? (sel_ >= 0 ? sel_ : ((ti) & 1)) : 0, kt_ = (GATEUP && sel_ < 0) ? ((ti) >> 1) : (ti); const char* sp_ = (const char*)(srcs[which_] + (size_t)(kt_ * 128) * N + nbk * NC); \
            _Pragma("unroll") for (int p = 0; p < NLD; ++p) r[slot][p] = __builtin_nontemporal_load((const f32x4*)(sp_ + (size_t)p * (NTHR / (NC / 4)) * N * 4 + ldoff)); \
            if (CTX) { _Pragma("unroll") for (int p = 0; p < 2; ++p) ar[slot][p] = *(const f16x8*)(ap[p] + kt_ * 128); } } while (0)
#define CV_TILE(ti, slot) do { const int which = GATEUP ? (sel_ >= 0 ? sel_ : ((ti) & 1)) : 0, kt = (GATEUP && sel_ < 0) ? ((ti) >> 1) : (ti); \
            f16* tl = tile + (slot) * TW; f16* al = asl + (slot) * (64 * 128); \
            _Pragma("unroll") for (int p = 0; p < NLD; ++p) { const int id = tid + p * NTHR, kr = id / (NC / 4), c4 = (id % (NC / 4)) * 4; *(f16x4*)(tl + kr * TS + c4) = pk4(r[slot][p]); } \
            if (CTX) { _Pragma("unroll") for (int p = 0; p < 2; ++p) { const int row = (tid >> 4) + p * 32; *(f16x8*)(al + row * 128 + (((tid & 15) ^ (row & 15)) * 8)) = ar[slot][p]; } } \
            if ((ti) + 2 < ntr) CV_LOAD((ti) + 2, slot); \
            asm volatile("s_waitcnt lgkmcnt(0)" ::: "memory"); __builtin_amdgcn_s_barrier(); asm volatile("" ::: "memory"); \
            f16* dp = dsts[which] + (size_t)(nbk * NC + cb * 16 + r16) * K + kt * 128 + kq * 8; \
            _Pragma("unroll") for (int ks = 0; ks < 4; ++ks) { f16x8 bv; \
                _Pragma("unroll") for (int i = 0; i < 8; ++i) bv[i] = tl[(ks * 32 + kq * 8 + i) * TS + cb * 16 + r16]; \
                if (rb0 == 0) *(f16x8*)(dp + ks * 32) = rm8(bv); \
                if (CTX) { _Pragma("unroll") for (int rb = 0; rb < NRB; ++rb) { const int row = (rb0 + rb) * 16 + r16; const f16x8 af = *(const f16x8*)(al + row * 128 + (((ks * 4 + kq) ^ r16) * 8)); \
                    acc[which][rb] = __builtin_amdgcn_mfma_f32_16x16x32_f16(bv, af, acc[which][rb], 0, 0, 0); } } } } while (0)
        CV_LOAD(0, 0); CV_LOAD(1, 1);
        for (int t2 = 0; t2 < ntr; t2 += 2) { CV_TILE(t2, 0); CV_TILE(t2 + 1, 1); }
#undef CV_LOAD
#undef CV_TILE
        asm volatile("s_waitcnt lgkmcnt(0)" ::: "memory"); __builtin_amdgcn_s_barrier(); asm volatile("" ::: "memory");
        if (CTX) {
#pragma unroll
            for (int rb = 0; rb < NRB; ++rb) {
                const size_t row = (size_t)e * SLOTS_PAD + 4096 + (rb0 + rb) * 16 + r16; const int col = nbk * NC + cb * 16 + 4 * kq;
                if (GATEUP) { f32x4 o;
#pragma unroll
                    for (int jj = 0; jj < 4; ++jj) o[jj] = silu_f(acc[0][rb][jj]) * acc[1][rb][jj];
                    *(f16x4*)(P.act() + row * DEXP + col) = pk4(o); }
                else *(f16x4*)(P.yslot() + row * DM + col) = pk4(acc[0][rb]);
            }
        }
    }
}

__device__ __forceinline__ void cvt3_job(const Params& P, int job, f16* tile) {
    if (job < 256) phase_cvt_ctx<false, false>(P, 3, job, 1 << 20, tile, -1, true);
    else { const int h = job - 256; phase_cvt_ctx<true, false>(P, 3, h >> 1, 1 << 20, tile, h & 1, true); }
}
__device__ __forceinline__ void phase_gateup_fast(const Params& P, LAS unsigned char* lds, int rt = 17, bool alt = false) { fg::PRGateUp S; S.H = P.H(); S.rowidx = P.rowidx(); S.W = P.Wgu() + (alt ? (OFF_WGU3 - OFF_WGU) / 2 : 0); S.act = P.act(); S.rt = rt; S.nunits = 16 * rt * 16; S.bid = opaque_bid(); fg::gemm_phase(lds, S, P.wv); }
__device__ __forceinline__ void phase_down_fast(const Params& P, LAS unsigned char* lds, int rt = 17, bool alt = false) { fg::PRDown S; S.act = P.act(); S.W = P.Wd() + (alt ? (OFF_WD3 - OFF_WD) / 2 : 0); S.y = P.yslot(); S.rt = rt; S.nunits = 16 * rt * 4; S.bid = opaque_bid(); fg::gemm_phase(lds, S, P.wv); }
__device__ __forceinline__ void phase_pool_fast(const Params& P, LAS unsigned char* lds) { fg::PRDense<256> S; S.qn = nullptr; S.kn = nullptr; S.rope = nullptr; S.xs = nullptr; S.lane = 0; S.npan = 130; S.kvx = 0; S.A = P.H(); S.W = P.Wmix(); S.O0 = P.Z(); S.O1 = nullptr; S.O2 = nullptr; S.ncol = 4; S.mode = 2; S.bid = opaque_bid(); fg::gemm_phase(lds, S, P.wv); }
__device__ __forceinline__ void phase_qkv_fast(const Params& P, LAS unsigned char* lds, bool lastl = false, int l = 1) { fg::PRDense<1024> S; S.qn = P.q_norm + (l >> 1) * 64; S.kn = P.k_norm + (l >> 1) * 64; S.rope = P.rope(); S.xs = (LAS float*)(lds + fg::STAGE_BYTES); S.lane = opaque_tid_(P.wv) & 63; S.npan = lastl ? 128 : 130; S.kvx = lastl ? 4 : 0; S.A = P.H(); S.W = P.Wmix(); S.O0 = P.Q(); S.O1 = P.Kb(); S.O2 = P.Vb(); S.ncol = 6; S.mode = 1; S.bid = opaque_bid(); fg::gemm_phase(lds, S, P.wv); }
__device__ __forceinline__ void phase_oproj_fast(const Params& P, LAS unsigned char* lds, bool lastl = false) { fg::PRDense<1024> S; S.qn = nullptr; S.kn = nullptr; S.rope = nullptr; S.xs = nullptr; S.lane = 0; S.npan = lastl ? 128 : 130; S.kvx = 0; S.A = P.O(); S.W = P.Wmix() + (size_t)QKVD * DM; S.O0 = P.Z(); S.O1 = nullptr; S.O2 = nullptr; S.ncol = 4; S.mode = 0; S.bid = opaque_bid(); fg::gemm_phase(lds, S, P.wv); }

typedef float f32x16 __attribute__((ext_vector_type(16)));
#define AT_KB 9216
#define AT_VB 8704
template <int VAR = 0>
__device__ __forceinline__ void phase_attn_fast(const Params& P, int l, LAS unsigned char* lds, bool do_ctx, int cvt_l = -1) {
    const int j = l >> 1;
    const int tid = opaque_tid(), wid = tid >> 6, lane = tid & 63, l32 = lane & 31, hi = lane >> 5;
    const int g = wid >> 1, qoff = (wid & 1) * 64, qoffu = (P.wv & 1) * 64;
    const int nunits = do_ctx ? 1040 : 1024;
    int ucount = 0;
    for (int u = opaque_bid(); u < nunits; u += gridDim.x, ++ucount) {
        int b, qblk, kv, qrow0, t0, t1, s0;
        if (u < 1024) { b = u >> 9; qblk = (u >> 2) & 127; kv = u & 3; s0 = b * SEQ; qrow0 = s0 + qblk * 128; t0 = qblk == 0 ? 2 : 0; t1 = qblk == 127 ? 4 : 6; }
        else { const int uu = u - 1024; b = uu >> 3; qblk = (uu >> 2) & 1; kv = uu & 3; s0 = NLAT + b * CTXL; qrow0 = s0 + qblk * 128; t0 = 0; t1 = 0; }
        const int cb = NLAT + b * CTXL, nloc = t1 - t0, ntiles = nloc + 4;
        const int h = kv * 4 + g;
        f16x8 Qf[2][4];
#pragma unroll
        for (int qb = 0; qb < 2; ++qb)
#pragma unroll
            for (int ks = 0; ks < 4; ++ks) Qf[qb][ks] = *(const f16x8*)(P.Q() + (size_t)(qrow0 + qoff + 32 * qb + l32) * 1024 + h * 64 + 16 * ks + 8 * hi);
        f32x16 OT[2][2];
#pragma unroll
        for (int db = 0; db < 2; ++db)
#pragma unroll
            for (int qb = 0; qb < 2; ++qb)
#pragma unroll
                for (int r = 0; r < 16; ++r) OT[db][qb][r] = 0.f;
        float mrun[2], lrun[2];
        { const float sk = P.sink[j * 16 + h] * 1.4426950408889634f; mrun[0] = sk; mrun[1] = sk; lrun[0] = hi == 0 ? 1.0f : 0.0f; lrun[1] = lrun[0]; }
        const int lkey = tid >> 3, lpc = tid & 7;
        f16x8 kreg, vreg;
        auto tile_row = [&](int it) -> int { return it < nloc ? (qrow0 - 128 + 64 * (t0 + it)) : (cb + 64 * (it - nloc)); };
        { const int kr = tile_row(0) + lkey; kreg = *(const f16x8*)(P.Kb() + (size_t)kr * 256 + kv * 64 + lpc * 8); vreg = *(const f16x8*)(P.Vb() + (size_t)kr * 256 + kv * 64 + lpc * 8); }
        __syncthreads();
        {
            LAS f16* Kl = (LAS f16*)(lds); LAS f16* Vl = (LAS f16*)(lds + 2 * AT_KB);
            *(LAS f16x8*)(Kl + lkey * 72 + lpc * 8) = kreg;
#pragma unroll
            for (int i = 0; i < 8; ++i) Vl[(lpc * 8 + i) * 68 + lkey] = vreg[i];
        }
        __syncthreads();
        for (int it = 0; it < ntiles; ++it) {
            const int buf = it & 1;
            if (it + 1 < ntiles) { const int kr = tile_row(it + 1) + lkey; kreg = *(const f16x8*)(P.Kb() + (size_t)kr * 256 + kv * 64 + lpc * 8); vreg = *(const f16x8*)(P.Vb() + (size_t)kr * 256 + kv * 64 + lpc * 8); }
            const LAS f16* Kl = (const LAS f16*)(lds + buf * AT_KB); const LAS f16* Vl = (const LAS f16*)(lds + 2 * AT_KB + buf * AT_VB);
            int cls = 0;
            if (it < nloc) { const int tl = t0 + it, dmin = qoffu + 65 - 64 * tl, dmax = qoffu + 191 - 64 * tl; cls = (dmin > 128 || dmax < -128) ? 2 : ((dmin >= -128 && dmax <= 128) ? 0 : 1); }
            if (cls != 2) {
            f32x16 S[2][2];
#pragma unroll
            for (int kb = 0; kb < 2; ++kb)
#pragma unroll
                for (int qb = 0; qb < 2; ++qb)
#pragma unroll
                    for (int r = 0; r < 16; ++r) S[kb][qb][r] = -mrun[qb];
#pragma unroll
            for (int ks = 0; ks < 4; ++ks)
#pragma unroll
                for (int kb = 0; kb < 2; ++kb) {
                    const f16x8 kf = *(const LAS f16x8*)(Kl + (32 * kb + l32) * 72 + 16 * ks + 8 * hi);
#pragma unroll
                    for (int qb = 0; qb < 2; ++qb) S[kb][qb] = __builtin_amdgcn_mfma_f32_32x32x16_f16(kf, Qf[qb][ks], S[kb][qb], 0, 0, 0);
                }
            if (cls == 1) {
                const int kt = 64 * (t0 + it);
#pragma unroll
                for (int qb = 0; qb < 2; ++qb) {
                    const int qp = 128 + qoff + 32 * qb + l32;
#pragma unroll
                    for (int kb = 0; kb < 2; ++kb)
#pragma unroll
                        for (int r = 0; r < 16; ++r) { const int kp = kt + 32 * kb + 8 * (r >> 2) + 4 * hi + (r & 3); const int d = qp - kp; if (d > 128 || d < -128) S[kb][qb][r] = -INFINITY; }
                }
            }
            f16x8 Pf[2][4];
#pragma unroll
            for (int qb = 0; qb < 2; ++qb) {
                float mx = S[0][qb][0];
#pragma unroll
                for (int kb = 0; kb < 2; ++kb)
#pragma unroll
                    for (int r = 0; r < 16; ++r) mx = fmaxf(mx, S[kb][qb][r]);
                { const auto sw = __builtin_amdgcn_permlane32_swap(__float_as_uint(mx), __float_as_uint(mx), false, false); mx = fmaxf(__uint_as_float(sw[0]), __uint_as_float(sw[1])); }
                if (__builtin_amdgcn_ballot_w64(mx > 8.0f) != 0ull) {
                    const float g = fmaxf(mx, 0.f), corr = __builtin_amdgcn_exp2f(-g);
                    mrun[qb] += g; lrun[qb] *= corr;
#pragma unroll
                    for (int kb = 0; kb < 2; ++kb)
#pragma unroll
                        for (int r = 0; r < 16; ++r) S[kb][qb][r] -= g;
#pragma unroll
                    for (int db = 0; db < 2; ++db)
#pragma unroll
                        for (int r = 0; r < 16; ++r) OT[db][qb][r] *= corr;
                }
                float ps = 0.f;
#pragma unroll
                for (int kb = 0; kb < 2; ++kb)
#pragma unroll
                    for (int r = 0; r < 16; ++r) { const float p = __builtin_amdgcn_exp2f(S[kb][qb][r]); S[kb][qb][r] = p; ps += p; }
                lrun[qb] += ps;
#pragma unroll
                for (int ks = 0; ks < 4; ++ks) { const int kb = ks >> 1, r0 = 8 * (ks & 1);
#pragma unroll
                    for (int e = 0; e < 8; ++e) Pf[qb][ks][e] = (f16)S[kb][qb][r0 + e]; }
            }
#pragma unroll
            for (int ks = 0; ks < 4; ++ks)
#pragma unroll
                for (int db = 0; db < 2; ++db) {
                    const LAS f16* vp = Vl + (32 * db + l32) * 68 + 16 * ks + 4 * hi;
                    const f16x4 v0 = *(const LAS f16x4*)vp, v1 = *(const LAS f16x4*)(vp + 8);
                    const f16x8 vf = (f16x8){v0[0], v0[1], v0[2], v0[3], v1[0], v1[1], v1[2], v1[3]};
#pragma unroll
                    for (int qb = 0; qb < 2; ++qb) OT[db][qb] = __builtin_amdgcn_mfma_f32_32x32x16_f16(vf, Pf[qb][ks], OT[db][qb], 0, 0, 0);
                }
            }
            if (it + 1 < ntiles) {
                LAS f16* Kw = (LAS f16*)(lds + (buf ^ 1) * AT_KB); LAS f16* Vw = (LAS f16*)(lds + 2 * AT_KB + (buf ^ 1) * AT_VB);
                *(LAS f16x8*)(Kw + lkey * 72 + lpc * 8) = kreg;
#pragma unroll
                for (int i = 0; i < 8; ++i) Vw[(lpc * 8 + i) * 68 + lkey] = vreg[i];
            }
            __syncthreads();
        }
#pragma unroll
        for (int qb = 0; qb < 2; ++qb) {
            const float lt = lrun[qb] + shx<32>(lrun[qb], lane);
            const float inv = 1.0f / lt;
            f16* op = P.O() + (size_t)(qrow0 + qoff + 32 * qb + l32) * 1024 + h * 64;
#pragma unroll
            for (int db = 0; db < 2; ++db)
#pragma unroll
                for (int i = 0; i < 4; ++i) {
                    const f16x4 o = (f16x4){(f16)(OT[db][qb][4 * i] * inv), (f16)(OT[db][qb][4 * i + 1] * inv), (f16)(OT[db][qb][4 * i + 2] * inv), (f16)(OT[db][qb][4 * i + 3] * inv)};
                    *(f16x4*)(op + 32 * db + 8 * i + 4 * hi) = o;
                }
        }
    }
}

#define MEGA_LDS (147456 + 16)
__device__ __forceinline__ const Params& opq(Params& q) { int z; asm volatile("s_mov_b32 %0, 0" : "=s"(z)); q.zoff = z; return q; }
__global__ __launch_bounds__(NTHR, 2) void mega(Params P) {
    extern __shared__ __attribute__((aligned(16))) unsigned char shm[];
    LAS unsigned char* lds = (LAS unsigned char*)shm;
    volatile LAS unsigned* st = (volatile LAS unsigned*)(lds + 147456);
    if (threadIdx.x == 0) { st[0] = 0u; st[1] = 0u; st[2] = 0u; st[3] = 0u; }
    __syncthreads();
    const XcdBarrier bar = xcd_barrier_post(P.bar(), st);
    const int nb = gridDim.x;
#define bid (opaque_bid())
    Params Q = P; Q.wv = __builtin_amdgcn_readfirstlane(threadIdx.x >> 6);
#define P (opq(Q))
    phase_ada(P, bid, nb, (float*)shm);
    __syncthreads();
    phase_convert(P, 0, bid, nb, (f16*)shm, false);
    xcd_barrier(bar);
    for (int l = 0; l < 4; ++l) {
        if (l == 0) phase_n1<true, false>(P, l, bid, nb); else { phase_n1<false, false>(P, l, bid, nb); __syncthreads(); phase_convert(P, l, bid, nb, (f16*)shm, false);
            }
        xcd_barrier(bar);
        if ((l & 1) == 0) {
            phase_pool_fast(P, lds);
            xcd_barrier(bar);
            phase_n2<true>(P, l, bid, nb, (float*)shm);
        } else {
            phase_qkv_fast(P, lds, l == 3, l);
            if (nb == 256 && (bid & 7) >= 2) { __syncthreads(); cvt3_job(P, (l == 1 ? 192 : 576) + ((bid & 7) - 2) * 32 + (bid >> 3), (f16*)shm); }
            xcd_barrier(bar);
            phase_attn_fast(P, l, lds, l != 3);
            if (l == 3 && nb != 256) { __syncthreads(); phase_cvt_ctx<true, false>(P, l, bid, nb, (f16*)shm, -1, true); phase_cvt_ctx<false, false>(P, l, bid, nb, (f16*)shm, -1, true); }
            xcd_barrier(bar);
            phase_oproj_fast(P, lds, l == 3);
            if (l == 1 && nb == 256 && (bid & 7) >= 2) { __syncthreads(); cvt3_job(P, 384 + ((bid & 7) - 2) * 32 + (bid >> 3), (f16*)shm); }
            xcd_barrier(bar);
            phase_n2<false>(P, l, bid, nb, (float*)shm, l == 3 ? NLAT : MROWS);
        }
        xcd_barrier(bar);
        phase_topk(P, bid, nb, (unsigned*)shm, l == 3 ? 32 : 64);
        if (l < 3 && nb == 256 && bid >= 64 && bid < 128) cvt3_job(P, l * 64 + bid - 64, (f16*)shm);
        xcd_barrier(bar);
        if (l < 3) { phase_cvt_ctx<true, true>(P, l, bid, nb, (f16*)shm); xcd_barrier(bar); }
        phase_gateup_fast(P, lds, 16, l == 3);
        if (l < 3) { __syncthreads(); phase_cvt_ctx<false, true>(P, l, bid, nb, (f16*)shm); }
        xcd_barrier(bar);
        phase_down_fast(P, lds, 16, l == 3);
        xcd_barrier(bar);
    }
    phase_n1<false, true>(P, 4, bid, nb);
#undef P
#undef bid
}

static inline size_t al256(size_t v) { return (v + 255) & ~(size_t)255; }

extern "C" void kernel_launch(void* const* d_in, const int* in_sizes, int n_in, void* d_out, int out_size, void* d_ws, size_t ws_size, hipStream_t stream) {
    Params P{};
    P.x = (const float*)d_in[0]; P.c = (const float*)d_in[1]; P.ctx = (const float*)d_in[2]; P.c_ctx = (const float*)d_in[3];
    P.w_ada = (const float*)d_in[4]; P.b_ada = (const float*)d_in[5]; P.norm1_g = (const float*)d_in[6]; P.norm2_g = (const float*)d_in[7];
    P.pool_w = (const float*)d_in[8]; P.pool_scale = (const float*)d_in[9]; P.w_qkv = (const float*)d_in[10]; P.w_o = (const float*)d_in[11];
    P.q_norm = (const float*)d_in[12]; P.k_norm = (const float*)d_in[13]; P.sink = (const float*)d_in[14]; P.router_w = (const float*)d_in[15];
    P.w_gate = (const float*)d_in[16]; P.w_up = (const float*)d_in[17]; P.w_down = (const float*)d_in[18];
    P.out = (float*)d_out;
    P.ws = (char*)d_ws; const size_t off = WS_TOTAL;
    if (off > ws_size) { fprintf(stderr, "workspace too small: need %zu have %zu\n", off, ws_size); return; }
    static int grid = 0;
    if (!grid) {
        int dev = 0, cus = 0, per_cu = 0;
        hipGetDevice(&dev);
        hipDeviceGetAttribute(&cus, hipDeviceAttributeMultiprocessorCount, dev);
        hipFuncSetAttribute((const void*)mega, hipFuncAttributeMaxDynamicSharedMemorySize, MEGA_LDS);
        hipOccupancyMaxActiveBlocksPerMultiprocessor(&per_cu, (const void*)mega, NTHR, MEGA_LDS);
        if (per_cu < 1) { fprintf(stderr, "mega: occupancy query says %d blocks per CU\n", per_cu); }
        grid = cus > 0 ? cus : 256;
    }
    hipMemsetAsync(P.bar(), 0, XCD_BAR_WORDS * sizeof(unsigned), stream);
    hipLaunchKernelGGL(mega, dim3(grid), dim3(NTHR), MEGA_LDS, stream, P);
}
```

```cpp
#include <hip/hip_runtime.h>
#include <stdint.h>
#include <stdio.h>

typedef _Float16 f16;
typedef _Float16 f16x2 __attribute__((ext_vector_type(2)));
typedef _Float16 f16x4 __attribute__((ext_vector_type(4)));
typedef _Float16 f16x8 __attribute__((ext_vector_type(8)));
typedef float f32x4 __attribute__((ext_vector_type(4)));
typedef float f32x2 __attribute__((ext_vector_type(2)));
typedef unsigned u32x2 __attribute__((ext_vector_type(2)));
typedef unsigned u32x4 __attribute__((ext_vector_type(4)));
#define RM_BITS 4
#define RM_ADD (0x00010001u << (RM_BITS - 1))
#define RM_MASK (~(0x00010001u * ((1u << RM_BITS) - 1u)))
__device__ __forceinline__ f16x4 rm4(f16x4 v) { u32x2 b = __builtin_bit_cast(u32x2, v); b = (b + RM_ADD) & RM_MASK; return __builtin_bit_cast(f16x4, b); }
__device__ __forceinline__ f16x8 rm8(f16x8 v) { u32x4 b = __builtin_bit_cast(u32x4, v); b = (b + RM_ADD) & RM_MASK; return __builtin_bit_cast(f16x8, b); }

#define LAS __attribute__((address_space(3)))
#define DM 1024
#define SEQ 16384
#define NLAT 32768
#define CTXL 256
#define NCTX 512
#define MROWS 33280
#define NEXP 16
#define DEXP 2048
#define SLOTS 4160
#define SLOTS_PAD 4352
#define QKVD 1536
#define NTHR 512

constexpr size_t al256c(size_t v) { return (v + 255) & ~(size_t)255; }
constexpr size_t OFF_BAR = 0;
constexpr size_t OFF_MOD = al256c(OFF_BAR + 16384);
constexpr size_t OFF_ROPE = al256c(OFF_MOD + (size_t)4 * 3 * 6 * DM * 4);
constexpr size_t OFF_X = al256c(OFF_ROPE + (size_t)256 * 16 * 2 * 4);
constexpr size_t OFF_H = al256c(OFF_X + (size_t)MROWS * DM * 4);
constexpr size_t OFF_Z = al256c(OFF_H + (size_t)MROWS * DM * 2);
constexpr size_t OFF_Q = al256c(OFF_Z + (size_t)MROWS * DM * 2);
constexpr size_t OFF_KB = al256c(OFF_Q + (size_t)MROWS * DM * 2);
constexpr size_t OFF_VB = al256c(OFF_KB + (size_t)MROWS * 256 * 2);
constexpr size_t OFF_VT = al256c(OFF_VB + (size_t)MROWS * 256 * 2);
constexpr size_t OFF_O = al256c(OFF_VT + (size_t)MROWS * 256 * 2);
constexpr size_t OFF_AFF = al256c(OFF_O + (size_t)MROWS * DM * 2);
constexpr size_t OFF_INV = al256c(OFF_AFF + (size_t)MROWS * 16 * 4);
constexpr size_t OFF_ROWIDX = al256c(OFF_INV + (size_t)MROWS * 16 * 4);
constexpr size_t OFF_ACT = al256c(OFF_ROWIDX + (size_t)NEXP * SLOTS_PAD * 4);
constexpr size_t OFF_YSLOT = al256c(OFF_ACT + (size_t)NEXP * SLOTS_PAD * DEXP * 2);
constexpr size_t OFF_WGU = al256c(OFF_YSLOT + (size_t)NEXP * SLOTS_PAD * DM * 2);
constexpr size_t OFF_WD = al256c(OFF_WGU + (size_t)NEXP * 2 * DEXP * DM * 2);
constexpr size_t OFF_WMIX = al256c(OFF_WD + (size_t)NEXP * DM * DEXP * 2);
constexpr size_t OFF_WGU3 = al256c(OFF_WMIX + (size_t)(QKVD + DM) * DM * 2);
constexpr size_t OFF_WD3 = al256c(OFF_WGU3 + (size_t)NEXP * 2 * DEXP * DM * 2);
constexpr size_t OFF_DUMMY = al256c(OFF_WD3 + (size_t)NEXP * DM * DEXP * 2);
constexpr size_t WS_TOTAL = OFF_DUMMY;
struct Params {
    const float *x, *c, *ctx, *c_ctx, *w_ada, *b_ada, *norm1_g, *norm2_g, *pool_w, *pool_scale, *w_qkv, *w_o, *q_norm, *k_norm, *sink, *router_w, *w_gate, *w_up, *w_down;
    float* out; char* ws; int wv; int zoff;
#define WSF(name, type, off) __host__ __device__ __forceinline__ type* name() const { return (type*)(ws + zoff + (off)); }
    WSF(bar, unsigned, OFF_BAR) WSF(mod, float, OFF_MOD) WSF(rope, float, OFF_ROPE) WSF(X, f16, OFF_X) WSF(H, f16, OFF_H) WSF(Z, f16, OFF_Z) WSF(Q, f16, OFF_Q) WSF(Kb, f16, OFF_KB) WSF(Vb, f16, OFF_VB) WSF(Vt, f16, OFF_VT)
    WSF(O, f16, OFF_O) WSF(aff, float, OFF_AFF) WSF(inv, int, OFF_INV) WSF(rowidx, int, OFF_ROWIDX) WSF(act, f16, OFF_ACT) WSF(yslot, f16, OFF_YSLOT) WSF(Wgu, f16, OFF_WGU) WSF(Wd, f16, OFF_WD) WSF(Wmix, f16, OFF_WMIX)
#undef WSF
#define WSW(name, type, off) __host__ __device__ __forceinline__ type* name() const { return (type*)(ws + zoff + (off)); }
    WSW(Xw, f16, OFF_X) WSW(Ow, f16, OFF_O) WSW(Hw, f16, OFF_H) WSW(affw, float, OFF_AFF) WSW(Qw, f16, OFF_Q) WSW(Kw, f16, OFF_KB)
#undef WSW
};

template <int O> __device__ __forceinline__ float shx(float v, int lane) {
    if (O == 1) return __int_as_float(__builtin_amdgcn_update_dpp(0, __float_as_int(v), 0xB1, 0xF, 0xF, true));
    if (O == 2) return __int_as_float(__builtin_amdgcn_update_dpp(0, __float_as_int(v), 0x4E, 0xF, 0xF, true));
    if (O < 32) return __int_as_float(__builtin_amdgcn_ds_swizzle(__float_as_int(v), (O << 10) | 0x1f));
    return __int_as_float(__builtin_amdgcn_ds_bpermute((lane ^ O) << 2, __float_as_int(v)));
}
__device__ __forceinline__ float wave_sum(float v, int lane) {
    v += shx<1>(v, lane); v += shx<2>(v, lane); v += shx<4>(v, lane); v += shx<8>(v, lane); v += shx<16>(v, lane); v += shx<32>(v, lane);
    return v;
}
__device__ __forceinline__ unsigned shup(unsigned v, int o, int lane) { return (unsigned)__builtin_amdgcn_ds_bpermute((lane - o) << 2, (int)v); }
__device__ __forceinline__ int opaque_bid() { int b = blockIdx.x; asm volatile("" : "+s"(b)); return b; }
#define opaque_tid() opaque_tid_(P.wv)
__device__ __forceinline__ int opaque_tid_(int wv) { int ln; asm volatile("v_mbcnt_lo_u32_b32 %0, -1, 0\n\tv_mbcnt_hi_u32_b32 %0, -1, %0" : "=v"(ln)); return (wv << 6) | ln; }
__device__ __forceinline__ float silu_f(float v) { return v * __builtin_amdgcn_rcpf(1.0f + __expf(-v)); }

__device__ __forceinline__ const float* modp(const Params& P, int l, int v, int j) { return P.mod() + (size_t)((l * 3 + v) * 6 + j) * DM; }

__device__ __forceinline__ void phase_ada(const Params& P, int bid, int nb, float* lds) {
    float* sc = lds; float* red = lds + 3 * DM;
    const int tid = opaque_tid();
    for (int i = tid; i < 3 * DM; i += NTHR) { const int v = i >> 10, k = i & 1023; const float cv = v < 2 ? P.c[v * DM + k] : P.c_ctx[k]; sc[i] = silu_f(cv); }
    __syncthreads();
    for (int u = bid; u < 4 * 96; u += nb) {
        const int l = u / 96, ch = u % 96, col = ch * 64 + (tid & 63), ks = tid >> 6;
        const float* w = P.w_ada + (size_t)l * DM * 6 * DM + col;
        float s0 = 0.f, s1 = 0.f, s2 = 0.f;
        for (int k = ks * 128; k < ks * 128 + 128; ++k) { const float wv = __builtin_nontemporal_load(w + (size_t)k * 6 * DM); s0 += sc[k] * wv; s1 += sc[DM + k] * wv; s2 += sc[2 * DM + k] * wv; }
        red[(ks * 3 + 0) * 64 + (tid & 63)] = s0; red[(ks * 3 + 1) * 64 + (tid & 63)] = s1; red[(ks * 3 + 2) * 64 + (tid & 63)] = s2;
        __syncthreads();
        if (tid < 192) { const int v = tid >> 6, cc = tid & 63; float s = 0.f;
#pragma unroll
            for (int q = 0; q < 8; ++q) s += red[(q * 3 + v) * 64 + cc];
            const int colg = ch * 64 + cc; s += P.b_ada[l * 6 * DM + colg];
            const int j = colg >> 10, d = colg & 1023;
            P.mod()[(size_t)((l * 3 + v) * 6 + j) * DM + d] = s; }
        __syncthreads();
    }
    for (int i = bid * NTHR + tid; i < 256 * 16; i += nb * NTHR) {
        const int p = i >> 4, f = i & 15;
        const float inv = powf(10000.0f, -(float)f / 16.0f);
        const float angf = (float)p * inv;
        double a = (double)angf;
        const double twopi = 6.283185307179586476925286766559;
        a -= twopi * rint(a / twopi);
        const double a2 = a * a;
        double cs = 1.0, sn = 1.0;
        double tc = 0.0, ts = 0.0;
        for (int n = 16; n >= 1; --n) { tc = (tc + 1.0) * (-a2 / (double)((2 * n - 1) * (2 * n))); ts = (ts + 1.0) * (-a2 / (double)((2 * n) * (2 * n + 1))); }
        cs = 1.0 + tc; sn = a * (1.0 + ts);
        P.rope()[i * 2] = (float)cs; P.rope()[i * 2 + 1] = (float)sn;
    }
}

__device__ __forceinline__ f32x4 cvt4(const f16x4 v) { return (f32x4){(float)v[0], (float)v[1], (float)v[2], (float)v[3]}; }
__device__ __forceinline__ f16x4 pk4(const f32x4 v) { return (f16x4){(f16)v[0], (f16)v[1], (f16)v[2], (f16)v[3]}; }
__device__ __forceinline__ float dot4(const f32x4 a, const f32x4 b) { return a[0] * b[0] + a[1] * b[1] + a[2] * b[2] + a[3] * b[3]; }
template <bool FIRST, bool FINAL>
__device__ __forceinline__ void phase_n1(const Params& P, int l, int bid, int nb) {
    constexpr int R = 4;
    const int tid_ = opaque_tid(); const int wid = P.wv, lane = tid_ & 63;
    const int nrows = FINAL ? NLAT : MROWS;
    for (int rb = (bid * 8 + wid) * R; rb < nrows; rb += nb * 8 * R) {
        const int v = rb < NLAT ? (rb >> 14) : 2;
        f32x4 xv[R][4];
#pragma unroll
        for (int u = 0; u < R; ++u) {
            const int r = rb + u;
            if (FIRST) { const float* src = r < NLAT ? P.x + (size_t)r * DM : P.ctx + (size_t)(r - NLAT) * DM;
#pragma unroll
                for (int q = 0; q < 4; ++q) xv[u][q] = __builtin_nontemporal_load((const f32x4*)(src + q * 256 + lane * 4)); }
            else { const f16* src = P.X() + (size_t)r * DM;
#pragma unroll
                for (int q = 0; q < 4; ++q) xv[u][q] = cvt4(*(const f16x4*)(src + q * 256 + lane * 4)); }
        }
        if (!FIRST) {
            const int sl = P.inv()[(size_t)(lane & 15) * MROWS + rb + (lane >> 4)];
            const float af = P.aff()[(size_t)(lane & 15) * MROWS + rb + (lane >> 4)];
            const unsigned long long bal = __builtin_amdgcn_ballot_w64(sl >= 0);
            unsigned m[R];
#pragma unroll
            for (int u = 0; u < R; ++u) m[u] = (unsigned)(bal >> (16 * u)) & 0xffffu;
            const f16* ys = P.yslot();
            const float* g2 = modp(P, l - 1, v, 5);
            f32x4 gv[4];
#pragma unroll
            for (int q = 0; q < 4; ++q) gv[q] = *(const f32x4*)(g2 + q * 256 + lane * 4);
            while (m[0] | m[1] | m[2] | m[3]) {
                f16x4 yv[R][4]; float w[R];
#pragma unroll
                for (int u = 0; u < R; ++u) {
                    const int e = m[u] ? __builtin_ctz(m[u]) : 0;
                    const int sv = m[u] ? __builtin_amdgcn_readlane(sl, 16 * u + e) : 0;
                    w[u] = m[u] ? __int_as_float(__builtin_amdgcn_readlane(__float_as_int(af), 16 * u + e)) : 0.f;
                    m[u] &= m[u] - 1u;
                    const f16* y = ys + ((size_t)e * SLOTS_PAD + sv) * DM + lane * 4;
#pragma unroll
                    for (int q = 0; q < 4; ++q) yv[u][q] = *(const f16x4*)(y + q * 256);
                }
#pragma unroll
                for (int u = 0; u < R; ++u)
#pragma unroll
                    for (int q = 0; q < 4; ++q) xv[u][q] += (w[u] * gv[q]) * cvt4(yv[u][q]);
            }
        }
        if (FINAL) {
#pragma unroll
            for (int u = 0; u < R; ++u)
#pragma unroll
                for (int q = 0; q < 4; ++q) __builtin_nontemporal_store(xv[u][q], (f32x4*)(P.out + (size_t)(rb + u) * DM + q * 256 + lane * 4));
            continue;
        }
        float ss[R];
#pragma unroll
        for (int u = 0; u < R; ++u) {
            f16* xd = P.Xw() + (size_t)(rb + u) * DM; float sacc = 0.f;
#pragma unroll
            for (int q = 0; q < 4; ++q) { *(f16x4*)(xd + q * 256 + lane * 4) = pk4(xv[u][q]); sacc += dot4(xv[u][q], xv[u][q]); }
            ss[u] = sacc;
        }
#pragma unroll
        for (int u = 0; u < R; ++u) ss[u] = rsqrtf(wave_sum(ss[u], lane) * (1.0f / DM) + 1e-6f);
        const float* g = P.norm1_g + l * DM; const float* sh = modp(P, l, v, 0); const float* scl = modp(P, l, v, 1);
#pragma unroll
        for (int q = 0; q < 4; ++q) {
            const int c0 = q * 256 + lane * 4;
            const f32x4 gq = *(const f32x4*)(g + c0), sq = *(const f32x4*)(sh + c0), cq = *(const f32x4*)(scl + c0);
            const f32x4 gm = gq * (1.0f + cq);
#pragma unroll
            for (int u = 0; u < R; ++u) *(f16x4*)(P.Hw() + (size_t)(rb + u) * DM + c0) = rm4(pk4(xv[u][q] * ss[u] * gm + sq));
        }
    }
}

#define N2_ZST 81920
template <bool POOL>
__device__ __forceinline__ void phase_n2(const Params& P, int l, int bid, int nb, float* lds, int nrows = MROWS) {
    const int tid = opaque_tid(), wid = P.wv, lane = tid & 63;
    const float* wr = P.router_w + (size_t)l * DM * NEXP;
    f16* wh = (f16*)lds;
    for (int i = tid; i < DM * NEXP; i += NTHR) { const int d = i >> 4, e = i & 15; wh[e * 1032 + d] = (f16)wr[i]; }
    f16* h2s = (f16*)lds + 16640;
    LAS unsigned char* zst = (LAS unsigned char*)lds + N2_ZST;
    const int j = l >> 1, nblk = nrows >> 4;
    const f16* Zg = P.Z();
    const f16* Xg = P.X();
    f16x4 xr[2][4]; f16x4 zr[2][4];
    auto prefetch = [&](int blk) {
        const int R0 = blk * 16, rb = R0 + wid * 2;
        if (POOL) {
            int s0, L; if (R0 < NLAT) { s0 = (R0 >> 14) << 14; L = SEQ; } else { s0 = NLAT + (((R0 - NLAT) >> 8) << 8); L = CTXL; }
#pragma unroll
            for (int i = 0; i < 8; ++i) { const int piece = wid * 8 + i; int rr = R0 - 8 + (piece >> 1); rr = rr < s0 ? s0 : (rr > s0 + L - 1 ? s0 + L - 1 : rr);
                __builtin_amdgcn_global_load_lds((const unsigned*)(Zg + (size_t)rr * DM + (piece & 1) * 512 + lane * 8), (LAS unsigned*)(zst + piece * 1024), 16, 0, 0); }
        } else {
#pragma unroll
            for (int u = 0; u < 2; ++u)
#pragma unroll
                for (int q = 0; q < 4; ++q) zr[u][q] = *(const f16x4*)(Zg + (size_t)(rb + u) * DM + q * 256 + lane * 4);
        }
#pragma unroll
        for (int u = 0; u < 2; ++u)
#pragma unroll
            for (int q = 0; q < 4; ++q) xr[u][q] = *(const f16x4*)(Xg + (size_t)(rb + u) * DM + q * 256 + lane * 4);
    };
    int blk = bid;
    if (blk < nblk) prefetch(blk);
    __syncthreads();
    while (blk < nblk) {
        const int R0 = blk * 16, rb = R0 + wid * 2;
        int v, s0, L;
        if (rb < NLAT) { v = rb >> 14; s0 = v << 14; L = SEQ; } else { v = 2; s0 = NLAT + (((rb - NLAT) >> 8) << 8); L = CTXL; }
        const int t = rb - s0;
        f32x4 g1v[4], gmv[4], shv[4], psv[4];
        { const float* g1 = modp(P, l, v, 2); const float* g = P.norm2_g + l * DM; const float* sh = modp(P, l, v, 3); const float* scl = modp(P, l, v, 4);
#pragma unroll
            for (int q = 0; q < 4; ++q) { const int c0 = q * 256 + lane * 4;
                g1v[q] = *(const f32x4*)(g1 + c0); const f32x4 gv = *(const f32x4*)(g + c0), cv = *(const f32x4*)(scl + c0); shv[q] = *(const f32x4*)(sh + c0); gmv[q] = gv * (1.0f + cv);
                if (POOL) psv[q] = *(const f32x4*)(P.pool_scale + j * DM + c0); } }
        f32x4 y[2][4];
        if (POOL) {
            asm volatile("s_waitcnt vmcnt(0)" ::: "memory");
            __syncthreads();
#pragma unroll
            for (int q = 0; q < 4; ++q) {
                const int h = 1 << q;
                const LAS f16* zb = (const LAS f16*)zst + q * 256 + lane * 4;
                f32x4 common = (f32x4){0.f, 0.f, 0.f, 0.f}, z0 = common, z1 = common;
#pragma unroll
                for (int d = -h; d <= h; ++d) {
                    const int tt = t + d; const bool ok = tt >= 0 && tt < L;
                    f32x4 zz = cvt4(*(const LAS f16x4*)(zb + (2 * wid + 8 + d) * DM));
                    if (!ok) zz = (f32x4){0.f, 0.f, 0.f, 0.f};
                    if (d == -h) z0 = zz; else if (d == h) z1 = zz; else common += zz;
                    if (d == 0) y[0][q] = zz;
                    if (d == 1) y[1][q] = zz;
                }
                const int c0n = min(t + h, L) - max(t - h, 0), c1n = min(t + 1 + h, L) - max(t + 1 - h, 0);
                y[0][q] = ((common + z0) * (1.0f / (float)c0n) - y[0][q]) * psv[q];
                y[1][q] = ((common + z1) * (1.0f / (float)c1n) - y[1][q]) * psv[q];
            }
            asm volatile("s_waitcnt lgkmcnt(0)" ::: "memory");
            __syncthreads();
        } else {
#pragma unroll
            for (int u = 0; u < 2; ++u)
#pragma unroll
                for (int q = 0; q < 4; ++q) y[u][q] = cvt4(zr[u][q]);
        }
        f32x4 xv[2][4]; float ss[2] = {0.f, 0.f};
#pragma unroll
        for (int q = 0; q < 4; ++q) {
#pragma unroll
            for (int u = 0; u < 2; ++u) { xv[u][q] = cvt4(xr[u][q]) + g1v[q] * y[u][q]; ss[u] += dot4(xv[u][q], xv[u][q]); }
        }
        const int nxt = blk + nb;
        asm volatile("" ::: "memory");
        if (nxt < nblk) prefetch(nxt);
#pragma unroll
        for (int u = 0; u < 2; ++u)
#pragma unroll
            for (int q = 0; q < 4; ++q) *(f16x4*)(P.Xw() + (size_t)(rb + u) * DM + q * 256 + lane * 4) = pk4(xv[u][q]);
        ss[0] = wave_sum(ss[0], lane); ss[1] = wave_sum(ss[1], lane);
        const float rs[2] = {rsqrtf(ss[0] * (1.0f / DM) + 1e-6f), rsqrtf(ss[1] * (1.0f / DM) + 1e-6f)};
        f16x4 h2h[2][4];
#pragma unroll
        for (int q = 0; q < 4; ++q) {
            const int c0 = q * 256 + lane * 4;
#pragma unroll
            for (int u = 0; u < 2; ++u) { h2h[u][q] = rm4(pk4(xv[u][q] * rs[u] * gmv[q] + shv[q])); *(f16x4*)(P.Hw() + (size_t)(rb + u) * DM + c0) = h2h[u][q]; }
        }
        asm volatile("s_waitcnt lgkmcnt(0)" ::: "memory"); __builtin_amdgcn_s_barrier(); asm volatile("" ::: "memory");
#pragma unroll
        for (int q = 0; q < 4; ++q)
#pragma unroll
            for (int u = 0; u < 2; ++u) *(f16x4*)(h2s + (2 * wid + u) * 1032 + q * 256 + lane * 4) = h2h[u][q];
        asm volatile("s_waitcnt lgkmcnt(0)" ::: "memory"); __builtin_amdgcn_s_barrier(); asm volatile("" ::: "memory");
        if (wid == 0) {
            const int r16 = lane & 15, kq = lane >> 4;
            f32x4 lg = (f32x4){0.f, 0.f, 0.f, 0.f};
#pragma unroll 8
            for (int ks = 0; ks < 32; ++ks) {
                const f16x8 av = *(const f16x8*)(h2s + r16 * 1032 + ks * 32 + kq * 8), bv = *(const f16x8*)(wh + r16 * 1032 + ks * 32 + kq * 8);
                lg = __builtin_amdgcn_mfma_f32_16x16x32_f16(av, bv, lg, 0, 0, 0);
            }
#pragma unroll
            for (int jj = 0; jj < 4; ++jj) {
                float mx = lg[jj];
                mx = fmaxf(mx, shx<1>(mx, lane)); mx = fmaxf(mx, shx<2>(mx, lane)); mx = fmaxf(mx, shx<4>(mx, lane)); mx = fmaxf(mx, shx<8>(mx, lane));
                const float pe = __expf(lg[jj] - mx);
                float den = pe;
                den += shx<1>(den, lane); den += shx<2>(den, lane); den += shx<4>(den, lane); den += shx<8>(den, lane);
                P.affw()[(size_t)r16 * MROWS + R0 + 4 * kq + jj] = pe / den;
            }
        }
        blk = nxt;
    }
}

__device__ __forceinline__ void phase_topk(const Params& P, int bid, int nb, unsigned* lds, int nprob = 64) {
    unsigned* hist = lds; unsigned* misc = lds + 256; unsigned* wsa = lds + 272; unsigned* wsb = lds + 288;
    const int tid = opaque_tid(), wid = tid >> 6, lane = tid & 63;
    for (int p = bid; p < nprob; p += nb) {
        const int set = p >> 4, e = p & 15;
        const int n = set < 2 ? SEQ : CTXL, C = n >> 3;
        const int r0 = set < 2 ? set * SEQ : NLAT + (set - 2) * CTXL;
        const int slot0 = set < 2 ? set * 2048 : 4096 + (set - 2) * 32;
        unsigned key[32];
#pragma unroll
        for (int i4 = 0; i4 < 8; ++i4) { const int idx = tid * 32 + i4 * 4;
            f32x4 v = (f32x4){0.f, 0.f, 0.f, 0.f}; if (idx < n) v = *(const f32x4*)(P.aff() + (size_t)e * MROWS + r0 + idx);
#pragma unroll
            for (int jj = 0; jj < 4; ++jj) key[i4 * 4 + jj] = idx < n ? (__float_as_uint(v[jj]) + 1u) : 0u; }
        unsigned T = 0u;
        for (int bit = 29; bit >= 0; --bit) {
            const unsigned cand = T | (1u << bit);
            unsigned wc = 0u;
#pragma unroll
            for (int i = 0; i < 32; ++i) wc += (unsigned)__builtin_popcountll(__builtin_amdgcn_ballot_w64(key[i] >= cand));
            unsigned* cb = misc + ((bit & 1) << 3);
            if (lane == 0) cb[wid] = wc;
            __syncthreads();
            unsigned tot = 0u;
#pragma unroll
            for (int w = 0; w < 8; ++w) tot += cb[w];
            if (tot >= (unsigned)C) T = cand;
        }
        unsigned cg = 0u, ce = 0u;
#pragma unroll
        for (int i = 0; i < 32; ++i) { cg += key[i] > T ? 1u : 0u; ce += key[i] == T ? 1u : 0u; }
        unsigned ig = cg, ie = ce;
#pragma unroll
        for (int o = 1; o < 64; o <<= 1) { const unsigned a = shup(ig, o, lane), b = shup(ie, o, lane); if (lane >= o) { ig += a; ie += b; } }
        if (lane == 63) { wsa[wid] = ig; wsb[wid] = ie; }
        __syncthreads();
        unsigned bg = 0u, be = 0u, totg = 0u;
#pragma unroll
        for (int w = 0; w < 8; ++w) { const unsigned ga = wsa[w]; totg += ga; if (w < wid) { bg += ga; be += wsb[w]; } }
        const unsigned krem = (unsigned)C - totg;
        unsigned pg = bg + ig - cg, pe = be + ie - ce;
#pragma unroll
        for (int i4 = 0; i4 < 8; ++i4) {
            int iv[4];
#pragma unroll
            for (int jj = 0; jj < 4; ++jj) {
                const int i = i4 * 4 + jj, idx = tid * 32 + i;
                bool sel = false; unsigned rank = 0u;
                if (key[i] > T) { sel = true; rank = pg + (pe < krem ? pe : krem); ++pg; }
                else if (key[i] == T && key[i] != 0u) { if (pe < krem) { sel = true; rank = pg + pe; } ++pe; }
                if (sel) P.rowidx()[e * SLOTS_PAD + slot0 + (int)rank] = r0 + idx;
                iv[jj] = sel ? slot0 + (int)rank : -1;
            }
            if (tid * 32 + i4 * 4 < n) *(int4*)(P.inv() + (size_t)e * MROWS + r0 + tid * 32 + i4 * 4) = make_int4(iv[0], iv[1], iv[2], iv[3]);
        }
        if (set == 3) for (int i = SLOTS + tid; i < SLOTS_PAD; i += NTHR) P.rowidx()[e * SLOTS_PAD + i] = 0;
        __syncthreads();
    }
}

#define XB_TMO      128
#define XB_XCNT(j)  (256  + 64 * (j))
#define XB_XSUB(j)  (1280 + 64 * (j))
#define XB_XGEN(j)  (2304 + 64 * (j))
#define XB_TOP      3328
#define XB_TOPGEN   3392
#define XCD_BAR_WORDS 3456
#define XB_SPIN_CAP (1u << 18)
__device__ __forceinline__ unsigned xb_ld(unsigned* p)              { return __hip_atomic_load(p, __ATOMIC_RELAXED, __HIP_MEMORY_SCOPE_AGENT); }
__device__ __forceinline__ unsigned xb_add(unsigned* p, unsigned v) { return __hip_atomic_fetch_add(p, v, __ATOMIC_RELAXED, __HIP_MEMORY_SCOPE_AGENT); }
__device__ __forceinline__ unsigned xb_xcc_id() { return (unsigned)__builtin_amdgcn_s_getreg((3 << 11) | 20) & 0xFu; }
#define XB_SPIN(cond, bar) do { unsigned _sp = 0; while (cond) { __builtin_amdgcn_s_sleep(1); \
    if ((++_sp & 255u) == 0u) { if (xb_ld(&(bar)[XB_TMO])) break; if (_sp > XB_SPIN_CAP) { atomicAdd(&(bar)[XB_TMO], 1u); break; } } } } while (0)
struct XcdBarrier { unsigned* bar; unsigned x; volatile LAS unsigned* st; };
__device__ __forceinline__ XcdBarrier xcd_barrier_post(unsigned* bar, volatile LAS unsigned* st) {
    XcdBarrier b; b.bar = bar; b.x = xb_xcc_id(); b.st = st;
    if (threadIdx.x == 0) (void)xb_add(&bar[XB_XCNT(b.x)], 1u);
    return b;
}
__device__ __forceinline__ void xcd_barrier_complete(unsigned* bar, unsigned x, unsigned& nloc, unsigned& nx) {
    const unsigned G = gridDim.x * gridDim.y * gridDim.z;
    unsigned sum, cnt, mine, sp = 0u;
    for (;;) {
        sum = 0u; cnt = 0u; mine = 0u;
#pragma unroll
        for (unsigned j = 0; j < 16; ++j) { const unsigned c = xb_ld(&bar[XB_XCNT(j)]); sum += c; cnt += (c > 0u) ? 1u : 0u; mine = (j == x) ? c : mine; }
        if (sum == G) break;
        __builtin_amdgcn_s_sleep(1);
        if ((++sp & 255u) == 0u) { if (xb_ld(&bar[XB_TMO])) break; if (sp > XB_SPIN_CAP) { atomicAdd(&bar[XB_TMO], 1u); break; } }
    }
    nloc = mine > 0u ? mine : 1u; nx = cnt > 0u ? cnt : 1u;
}
__device__ __forceinline__ void xcd_barrier(const XcdBarrier& b) {
    asm volatile("s_waitcnt vmcnt(0)" ::: "memory");
    __syncthreads();
    if (threadIdx.x == 0) {
        unsigned* bar = b.bar; asm volatile("" : "+s"(bar));
        const unsigned bx = (unsigned)__builtin_amdgcn_readfirstlane((int)xb_xcc_id());
        __builtin_amdgcn_s_waitcnt(0);
        unsigned nloc = b.st[0], nx = b.st[1];
        if (nloc == 0u) { xcd_barrier_complete(bar, bx, nloc, nx); b.st[0] = nloc; b.st[1] = nx; }
        const unsigned old = xb_add(&bar[XB_XSUB(bx)], 1u);
        const unsigned gen = old / nloc;
        if (old + 1u == (gen + 1u) * nloc) {
            __builtin_amdgcn_fence(__ATOMIC_RELEASE, "agent");
            asm volatile("s_waitcnt vmcnt(0)" ::: "memory");
            const unsigned og = xb_add(&bar[XB_TOP], 1u);
            const unsigned tg = og / nx;
            if (og + 1u == (tg + 1u) * nx) xb_add(&bar[XB_TOPGEN], 1u);
            else XB_SPIN(xb_ld(&bar[XB_TOPGEN]) == tg, bar);
            __builtin_amdgcn_fence(__ATOMIC_ACQUIRE, "agent");
            xb_add(&bar[XB_XGEN(bx)], 1u);
            asm volatile("s_waitcnt vmcnt(0)" ::: "memory");
        } else {
            XB_SPIN(xb_ld(&bar[XB_XGEN(bx)]) == gen, bar);
            __builtin_amdgcn_fence(__ATOMIC_ACQUIRE, "agent");
            asm volatile("s_waitcnt vmcnt(0)" ::: "memory");
        }
    }
    __syncthreads();
}

namespace fg {
constexpr int BM = 256, BK = 64, HALF = 128, HTB = HALF * BK * 2, STAGE_BYTES = 8 * HTB;
__device__ __forceinline__ int lds_byte(int r, int c) { const int st = (r >> 4) * 2 + (c >> 5), rr = r & 15, cc = c & 31, ob = rr * 64 + cc * 2; return st * 1024 + (ob ^ (((ob >> 9) & 1) << 5)); }
__device__ __forceinline__ void stage_rc(int b, int& R, int& C) { const int st = b / 1024, sb = b % 1024, swz = sb ^ (((sb >> 9) & 1) << 5); R = (st >> 1) * 16 + swz / 64; C = (st & 1) * 32 + (swz % 64) / 2; }
__device__ __forceinline__ int perm32(int rho) { const int n = rho >> 4, i = rho & 15; return 8 * (i >> 2) + 4 * n + (i & 3); }
#define KDUP 0
struct Unit { int e, pm, pn; int skip; };
__device__ __forceinline__ void xcd_order(int i, int& T) { const int c = blockIdx.x; T = i * (int)gridDim.x + c; }

template <class PR>
__device__ __forceinline__ void gemm_phase(LAS unsigned char* lds, const PR& S, int wv) {
    const int tid = opaque_tid_(wv), wid = __builtin_amdgcn_readfirstlane(tid >> 6), lane = tid & 63, wr = wid >> 2, wc = wid & 3, fr = lane & 15, fq = lane >> 4;
    constexpr int K = PR::K, nt = K / BK;
    unsigned voffB[2];
#pragma unroll
    for (int i = 0; i < 2; ++i) { int R, C; stage_rc(tid * 16 + i * 8192, R, C); const int Rb = (R & ~31) + perm32(R & 31); voffB[i] = (unsigned)(Rb * PR::LDB + C) * 2u; }
    const size_t kstep = (size_t)(BK * 2);
    const size_t hB = S.hstepB();
    const unsigned ldsw = (unsigned)wid * 1024u;
    const int aoff = lds_byte(wr * 64 + fr, fq * 8), boff = lds_byte(wc * 32 + fr, fq * 8);
#define FG_SA(b, h) (((b) * 2 + (h)) * HTB)
#define FG_SB(b, h) ((4 + (b) * 2 + (h)) * HTB)
#define FG_STAGE(bufoff, gbase, voff) do { _Pragma("unroll") for (int _i = 0; _i < 2; ++_i) \
        __builtin_amdgcn_global_load_lds((const unsigned*)((const char*)(gbase) + (voff)[_i]), (LAS unsigned*)(lds + (bufoff) + ldsw + _i * 8192), 16, 0, 0); } while (0)
#define FG_LDA(dst, b, h) do { _Pragma("unroll") for (int m = 0; m < 4; ++m) _Pragma("unroll") for (int k = 0; k < 2; ++k) dst[m][k] = *(const LAS f16x8*)(lds + FG_SA(b, h) + aoff + m * 2048 + k * 1024); } while (0)
#define FG_LDB(dst, b, h) do { _Pragma("unroll") for (int n = 0; n < 2; ++n) _Pragma("unroll") for (int k = 0; k < 2; ++k) dst[n][k] = *(const LAS f16x8*)(lds + FG_SB(b, h) + boff + n * 2048 + k * 1024); } while (0)
#define FG_MMA(ai, bj, At, Bt) do { __builtin_amdgcn_s_setprio(1); _Pragma("unroll") for (int m = 0; m < 4; ++m) _Pragma("unroll") for (int n = 0; n < 2; ++n) _Pragma("unroll") for (int k = 0; k < 2; ++k) \
        acc[ai][bj][m][n] = __builtin_amdgcn_mfma_f32_16x16x32_f16(Bt[n][k], At[m][k], acc[ai][bj][m][n], 0, 0, 0); __builtin_amdgcn_s_setprio(0); } while (0)
#define FG_WAIT_V(n) asm volatile("s_waitcnt vmcnt(" #n ")" ::: "memory")
#define FG_WAIT_L(n) asm volatile("s_waitcnt lgkmcnt(" #n ")" ::: "memory")
#define FG_BAR __builtin_amdgcn_s_barrier()
#define FG_SCHED __builtin_amdgcn_sched_barrier(0)
    Unit cur, nxt; int ui = 0;
    if (!S.next(0, cur)) return;
    f32x4 acc[2][2][4][2];
#pragma unroll
    for (int a = 0; a < 2; ++a)
#pragma unroll
        for (int b = 0; b < 2; ++b)
#pragma unroll
            for (int m = 0; m < 4; ++m)
#pragma unroll
                for (int n = 0; n < 2; ++n) acc[a][b][m][n] = (f32x4){0.f, 0.f, 0.f, 0.f};
    f16x8 At[4][2], B0[2][2], B1[2][2];
    unsigned vA[2][2], vN[2][2];
    { int Rr[2], Cc[2]; stage_rc(tid * 16, Rr[0], Cc[0]); stage_rc(tid * 16 + 8192, Rr[1], Cc[1]); S.a_voff(cur, Rr, Cc, vA); }
#pragma unroll
    for (int h = 0; h < 2; ++h)
#pragma unroll
        for (int i = 0; i < 2; ++i) { asm volatile("" : "+v"(vA[h][i])); vN[h][i] = vA[h][i]; }
    const char* cA = S.a_base(cur); const char* cB = S.b_base(cur);
    FG_STAGE(FG_SB(0, 0), cB, voffB); FG_STAGE(FG_SA(0, 0), cA, vA[0]); FG_STAGE(FG_SB(0, 1), cB + hB, voffB); FG_STAGE(FG_SA(0, 1), cA, vA[1]);
    if (wr == 1) FG_BAR;
    FG_WAIT_V(4); FG_BAR;
    FG_STAGE(FG_SB(1, 0), cB + kstep, voffB); FG_STAGE(FG_SA(1, 0), cA + kstep, vA[0]); FG_STAGE(FG_SB(1, 1), cB + hB + kstep, voffB);
    FG_WAIT_V(6); FG_BAR;
    for (;;) {
        const bool has_next = S.next(ui + 1, nxt);
        const char* nA = has_next ? S.a_base(nxt) : cA; const char* nB = has_next ? S.b_base(nxt) : cB;
        if (has_next) { int Rr[2], Cc[2]; int t2 = tid; asm volatile("" : "+v"(t2)); stage_rc(t2 * 16, Rr[0], Cc[0]); stage_rc(t2 * 16 + 8192, Rr[1], Cc[1]); S.a_voff(nxt, Rr, Cc, vN);
#pragma unroll
            for (int h = 0; h < 2; ++h)
#pragma unroll
                for (int i = 0; i < 2; ++i) asm volatile("" : "+v"(vN[h][i])); }
#pragma unroll 1
        for (int t = 0; t < nt; t += 2) {
            const bool last = (t == nt - 2);
            const char* a1 = cA + (size_t)(t + 1) * kstep;
            const char* a2 = last ? nA : cA + (size_t)(t + 2) * kstep; const char* b2 = last ? nB : cB + (size_t)(t + 2) * kstep;
            const char* a3 = a2 + kstep; const char* b3 = b2 + kstep;
            unsigned v2[2][2];
#pragma unroll
            for (int h = 0; h < 2; ++h)
#pragma unroll
                for (int i = 0; i < 2; ++i) v2[h][i] = last ? vN[h][i] : vA[h][i];
            FG_LDB(B0, 0, 0); FG_SCHED; FG_LDA(At, 0, 0); FG_STAGE(FG_SA(1, 1), a1, vA[1]);
            FG_WAIT_L(8); FG_BAR; FG_WAIT_L(0); FG_MMA(0, 0, At, B0); FG_BAR; FG_SCHED;
            FG_LDB(B1, 0, 1); FG_STAGE(FG_SB(0, 0), b2, voffB);
            FG_BAR; FG_WAIT_L(0); FG_MMA(0, 1, At, B1); FG_BAR;
            FG_LDA(At, 0, 1); FG_STAGE(FG_SA(0, 0), a2, v2[0]);
            FG_BAR; FG_WAIT_L(0); FG_MMA(1, 0, At, B0); FG_BAR; FG_SCHED;
            FG_STAGE(FG_SB(0, 1), b2 + hB, voffB);
            FG_WAIT_V(6); FG_BAR; FG_MMA(1, 1, At, B1); FG_BAR;
            FG_LDB(B0, 1, 0); FG_SCHED; FG_LDA(At, 1, 0); FG_STAGE(FG_SA(0, 1), a2, v2[1]);
            FG_WAIT_L(8); FG_BAR; FG_WAIT_L(0); FG_MMA(0, 0, At, B0); FG_BAR; FG_SCHED;
            FG_LDB(B1, 1, 1); FG_STAGE(FG_SB(1, 0), b3, voffB);
            FG_BAR; FG_WAIT_L(0); FG_MMA(0, 1, At, B1); FG_BAR;
            FG_LDA(At, 1, 1); FG_STAGE(FG_SA(1, 0), a3, v2[0]);
            FG_BAR; FG_WAIT_L(0); FG_MMA(1, 0, At, B0); FG_BAR; FG_SCHED;
            FG_STAGE(FG_SB(1, 1), b3 + hB, voffB);
            FG_WAIT_V(6); FG_BAR; FG_MMA(1, 1, At, B1); FG_BAR;
        }
        if (!KDUP || !cur.skip) S.epi(acc, cur, wr, wc, fr, fq);
        if (!has_next) break;
#pragma unroll
        for (int a = 0; a < 2; ++a)
#pragma unroll
            for (int b = 0; b < 2; ++b)
#pragma unroll
                for (int m = 0; m < 4; ++m)
#pragma unroll
                    for (int n = 0; n < 2; ++n) acc[a][b][m][n] = (f32x4){0.f, 0.f, 0.f, 0.f};
        cur = nxt; cA = nA; cB = nB; ++ui;
#pragma unroll
        for (int h = 0; h < 2; ++h)
#pragma unroll
            for (int i = 0; i < 2; ++i) vA[h][i] = vN[h][i];
    }
    FG_WAIT_V(0);
    if (wr == 0) FG_BAR;
    FG_BAR;
#undef FG_SA
#undef FG_SB
#undef FG_STAGE
#undef FG_LDA
#undef FG_LDB
#undef FG_MMA
#undef FG_WAIT_V
#undef FG_WAIT_L
#undef FG_BAR
#undef FG_SCHED
}

__device__ __forceinline__ f16x8 pack8(const f32x4 a, const f32x4 b) { return (f16x8){(f16)a[0], (f16)a[1], (f16)a[2], (f16)a[3], (f16)b[0], (f16)b[1], (f16)b[2], (f16)b[3]}; }

template <int K_, int LDA_, int LDB_> struct PRBase {
    static constexpr int K = K_, LDA = LDA_, LDB = LDB_;
    __device__ __forceinline__ void plain_voff(const int (&R)[2], const int (&C)[2], unsigned (&v)[2][2]) const {
#pragma unroll
        for (int h = 0; h < 2; ++h)
#pragma unroll
            for (int i = 0; i < 2; ++i) v[h][i] = (unsigned)((h * HALF + R[i]) * LDA + C[i]) * 2u;
    }
};
struct PRGateUp : PRBase<1024, 1024, 1024> {
    const f16* H; const int* rowidx; const f16* W; f16* act; int nunits; int bid; int rt;
    __device__ __forceinline__ size_t hstepB() const { return (size_t)DEXP * DM * 2; }
    __device__ __forceinline__ bool next(int i, Unit& u) const { const int ii = KDUP ? (i >> 1) : i; const int T = ii * (int)gridDim.x + bid; u.skip = KDUP ? ((i & 1) == 0) : 0; if (T >= nunits) return false;
        if (rt == 16 && gridDim.x == 256) { const int x = bid & 7, jj = bid >> 3; u.e = ii; u.pm = (x >> 1) * 4 + (jj >> 3); u.pn = (x & 1) * 8 + (jj & 7); return true; }
        const int per = rt * 16; u.e = T / per; const int t = T % per; u.pm = t >> 4; u.pn = t & 15; return true; }
    __device__ __forceinline__ const char* a_base(const Unit&) const { return (const char*)H; }
    __device__ __forceinline__ void a_voff(const Unit& u, const int (&R)[2], const int (&C)[2], unsigned (&v)[2][2]) const {
        const int* ri = rowidx + u.e * SLOTS_PAD + u.pm * BM;
#pragma unroll
        for (int h = 0; h < 2; ++h)
#pragma unroll
            for (int i = 0; i < 2; ++i) { const int g = ri[h * HALF + R[i]]; v[h][i] = (unsigned)(g * LDA + C[i]) * 2u; }
    }
    __device__ __forceinline__ const char* b_base(const Unit& u) const { return (const char*)(W + ((size_t)u.e * 2 * DEXP + (size_t)u.pn * HALF) * DM); }
    __device__ __forceinline__ void epi(const f32x4 (&acc)[2][2][4][2], const Unit& u, int wr, int wc, int fr, int fq) const {
        f16* base = act + ((size_t)u.e * SLOTS_PAD + (size_t)u.pm * BM + wr * 64 + fr) * DEXP + u.pn * HALF + wc * 32 + fq * 8;
#pragma unroll
        for (int ai = 0; ai < 2; ++ai)
#pragma unroll
            for (int m = 0; m < 4; ++m) {
                f32x4 o0, o1;
#pragma unroll
                for (int j = 0; j < 4; ++j) { o0[j] = silu_f(acc[ai][0][m][0][j]) * acc[ai][1][m][0][j]; o1[j] = silu_f(acc[ai][0][m][1][j]) * acc[ai][1][m][1][j]; }
                if (u.e < 8) __builtin_nontemporal_store(rm8(pack8(o0, o1)), (f16x8*)(base + (size_t)(ai * HALF + m * 16) * DEXP));
                else *(f16x8*)(base + (size_t)(ai * HALF + m * 16) * DEXP) = rm8(pack8(o0, o1));
            }
    }
};
struct PRDown : PRBase<2048, 2048, 2048> {
    const f16* act; const f16* W; f16* y; int nunits; int bid; int rt;
    __device__ __forceinline__ size_t hstepB() const { return (size_t)HALF * DEXP * 2; }
    __device__ __forceinline__ bool next(int i, Unit& u) const { const int ii = KDUP ? (i >> 1) : i; const int T = ii * (int)gridDim.x + bid; u.skip = KDUP ? ((i & 1) == 0) : 0; if (T >= nunits) return false;
        if (rt == 16 && gridDim.x == 256) { const int x = bid & 7, jj = bid >> 3; u.e = 15 - (ii * 4 + (x >> 1)); u.pm = (x & 1) * 8 + (jj >> 2); u.pn = jj & 3; return true; }
        const int per = rt * 4; u.e = T / per; const int t = T % per; u.pm = t >> 2; u.pn = t & 3; return true; }
    __device__ __forceinline__ const char* a_base(const Unit& u) const { return (const char*)(act + ((size_t)u.e * SLOTS_PAD + (size_t)u.pm * BM) * DEXP); }
    __device__ __forceinline__ void a_voff(const Unit&, const int (&R)[2], const int (&C)[2], unsigned (&v)[2][2]) const { plain_voff(R, C, v); }
    __device__ __forceinline__ const char* b_base(const Unit& u) const { return (const char*)(W + ((size_t)u.e * DM + (size_t)u.pn * BM) * DEXP); }
    __device__ __forceinline__ void epi(const f32x4 (&acc)[2][2][4][2], const Unit& u, int wr, int wc, int fr, int fq) const {
        f16* base = y + ((size_t)u.e * SLOTS_PAD + (size_t)u.pm * BM + wr * 64 + fr) * DM + u.pn * BM + wc * 32 + fq * 8;
#pragma unroll
        for (int ai = 0; ai < 2; ++ai)
#pragma unroll
            for (int m = 0; m < 4; ++m)
#pragma unroll
                for (int bj = 0; bj < 2; ++bj) *(f16x8*)(base + (size_t)(ai * HALF + m * 16) * DM + bj * HALF) = pack8(acc[ai][bj][m][0], acc[ai][bj][m][1]);
    }
};
template <int K_> struct PRDense : PRBase<K_, 1024, K_> {
    const f16* A; const f16* W; f16* O0; f16* O1; f16* O2; int ncol; int mode; int bid; int npan; int kvx;
    __device__ __forceinline__ size_t hstepB() const { return (size_t)HALF * K_ * 2; }
    __device__ __forceinline__ bool next(int i, Unit& u) const { const int ii = KDUP ? (i >> 1) : i; int T = ii * (int)gridDim.x + bid; if (gridDim.x == 256) T = (ii * 8 + (bid & 7)) * 32 + (bid >> 3);
        u.skip = KDUP ? ((i & 1) == 0) : 0; const int nu = npan * ncol; if (T >= nu + kvx) return false; u.e = 0; if (T < nu) { u.pm = T / ncol; u.pn = T % ncol; } else { const int x = T - nu; u.pm = npan + (x >> 1); u.pn = 4 + (x & 1); } return true; }
    __device__ __forceinline__ const char* a_base(const Unit& u) const { return (const char*)(A + (size_t)u.pm * BM * 1024 + (mode == 2 ? u.pn * 256 : 0)); }
    __device__ __forceinline__ void a_voff(const Unit&, const int (&R)[2], const int (&C)[2], unsigned (&v)[2][2]) const { this->plain_voff(R, C, v); }
    __device__ __forceinline__ const char* b_base(const Unit& u) const { return (const char*)(W + (size_t)u.pn * BM * K_); }
    const float* qn; const float* kn; const float* rope; LAS float* xs; int lane;
    __device__ __forceinline__ void epi(const f32x4 (&acc)[2][2][4][2], const Unit& u, int wr, int wc, int fr, int fq) const {
        f16* base; int ld;
        const int row = u.pm * BM + wr * 64 + fr, colw = wc * 32 + fq * 8;
        if (mode == 1) { if (u.pn < 4) { base = O0 + (size_t)row * 1024 + u.pn * BM + colw; ld = 1024; } else if (u.pn == 4) { base = O1 + (size_t)row * 256 + colw; ld = 256; } else { base = O2 + (size_t)row * 256 + colw; ld = 256; } }
        else { base = O0 + (size_t)row * 1024 + u.pn * BM + colw; ld = 1024; }
        if (mode == 1 && u.pn < 5) {
            float ssq[2][4][2];
#pragma unroll
            for (int ai = 0; ai < 2; ++ai)
#pragma unroll
                for (int m = 0; m < 4; ++m)
#pragma unroll
                    for (int bj = 0; bj < 2; ++bj) { const f32x4 a = acc[ai][bj][m][0], b = acc[ai][bj][m][1];
                        float t = (a[0] * a[0] + a[1] * a[1]) + (a[2] * a[2] + a[3] * a[3]) + (b[0] * b[0] + b[1] * b[1]) + (b[2] * b[2] + b[3] * b[3]);
                        t += shx<16>(t, lane); t += shx<32>(t, lane); ssq[ai][m][bj] = t; }
            LAS float* mine = xs + ((wr * 4 + wc) * 16) * 16 + fr; const LAS float* theirs = xs + ((wr * 4 + (wc ^ 1)) * 16) * 16 + fr;
            if (fq == 0) {
#pragma unroll
                for (int ai = 0; ai < 2; ++ai)
#pragma unroll
                    for (int m = 0; m < 4; ++m)
#pragma unroll
                        for (int bj = 0; bj < 2; ++bj) mine[(ai * 8 + m * 2 + bj) * 16] = ssq[ai][m][bj];
            }
            asm volatile("s_waitcnt lgkmcnt(0)" ::: "memory"); __builtin_amdgcn_s_barrier(); asm volatile("" ::: "memory");
            const bool isq = u.pn < 4, lat = u.pm < 128;
            const float* nw = (isq ? qn : kn) + (wc & 1) * 32 + fq * 8;
            const f32x4 w0 = *(const f32x4*)nw, w1 = *(const f32x4*)(nw + 4);
            const float qs = isq ? 0.125f * 1.4426950408889634f : 1.0f;
#pragma unroll
            for (int ai = 0; ai < 2; ++ai)
#pragma unroll
                for (int m = 0; m < 4; ++m) {
                    f32x4 c0 = (f32x4){1.f, 1.f, 1.f, 1.f}, s0 = (f32x4){0.f, 0.f, 0.f, 0.f};
                    if (lat) { const int t = (row + ai * HALF + m * 16) & (SEQ - 1); const int pos = (wc & 1) ? (t & 63) : (t >> 6);
                        const float* tb = rope + (size_t)(pos * 16 + fq * 4) * 2; const f32x4 ta = *(const f32x4*)tb, tb2 = *(const f32x4*)(tb + 4);
                        c0 = (f32x4){ta[0], ta[2], tb2[0], tb2[2]}; s0 = (f32x4){ta[1], ta[3], tb2[1], tb2[3]}; }
#pragma unroll
                    for (int bj = 0; bj < 2; ++bj) {
                        const float tot = ssq[ai][m][bj] + theirs[(ai * 8 + m * 2 + bj) * 16];
                        const float rstd = rsqrtf(tot * (1.0f / 64.0f) + 1e-6f) * qs;
                        f32x4 a = acc[ai][bj][m][0] * rstd * w0, b = acc[ai][bj][m][1] * rstd * w1;
                        const f32x4 ra = (f32x4){a[0] * c0[0] - a[1] * s0[0], a[0] * s0[0] + a[1] * c0[0], a[2] * c0[1] - a[3] * s0[1], a[2] * s0[1] + a[3] * c0[1]};
                        const f32x4 rb = (f32x4){b[0] * c0[2] - b[1] * s0[2], b[0] * s0[2] + b[1] * c0[2], b[2] * c0[3] - b[3] * s0[3], b[2] * s0[3] + b[3] * c0[3]};
                        *(f16x8*)(base + (size_t)(ai * HALF + m * 16) * ld + bj * HALF) = pack8(ra, rb);
                    }
                }
            return;
        }
#pragma unroll
        for (int ai = 0; ai < 2; ++ai)
#pragma unroll
            for (int m = 0; m < 4; ++m)
#pragma unroll
                for (int bj = 0; bj < 2; ++bj) *(f16x8*)(base + (size_t)(ai * HALF + m * 16) * ld + bj * HALF) = pack8(acc[ai][bj][m][0], acc[ai][bj][m][1]);
    }
};
}

struct CvtJob { const float* src; f16* dst; int K, N, k0, n0; };
__device__ __forceinline__ bool cvt_job(const Params& P, int l, int u, CvtJob& jb, bool experts) {
    const int j = l >> 1;
    const int nexp = experts ? NEXP * 3 * 128 : 0;
    const int nmix = (l & 1) == 0 ? 16 : (96 + 64);
    if (u >= nexp + nmix) return false;
    if (u < nexp) {
        const int e = u / 384, r = u % 384, which = r >> 7, t = r & 127;
        if (which < 2) { jb.src = (which == 0 ? P.w_gate : P.w_up) + ((size_t)l * NEXP + e) * DM * DEXP; jb.dst = P.Wgu() + ((size_t)e * 2 + which) * DEXP * DM; jb.K = DM; jb.N = DEXP; jb.k0 = (t >> 4) * 128; jb.n0 = (t & 15) * 128; }
        else { jb.src = P.w_down + ((size_t)l * NEXP + e) * DEXP * DM; jb.dst = P.Wd() + (size_t)e * DM * DEXP; jb.K = DEXP; jb.N = DM; jb.k0 = (t >> 3) * 128; jb.n0 = (t & 7) * 128; }
    } else {
        const int t = u - nexp;
        if ((l & 1) == 0) { const int g = t >> 2, tt = t & 3; jb.src = P.pool_w + (size_t)(j * 4 + g) * 65536; jb.dst = P.Wmix() + (size_t)g * 65536; jb.K = 256; jb.N = 256; jb.k0 = (tt >> 1) * 128; jb.n0 = (tt & 1) * 128; }
        else if (t < 96) { jb.src = P.w_qkv + (size_t)j * DM * QKVD; jb.dst = P.Wmix(); jb.K = DM; jb.N = QKVD; jb.k0 = (t / 12) * 128; jb.n0 = (t % 12) * 128; }
        else { const int tt = t - 96; jb.src = P.w_o + (size_t)j * DM * DM; jb.dst = P.Wmix() + (size_t)QKVD * DM; jb.K = DM; jb.N = DM; jb.k0 = (tt >> 3) * 128; jb.n0 = (tt & 7) * 128; }
    }
    return true;
}
__device__ __forceinline__ void phase_convert(const Params& P, int l, int bid, int nb, f16* tile, bool experts = true) {
    const int tid = opaque_tid();
    CvtJob jb;
    int u = bid;
    bool have = cvt_job(P, l, u, jb, experts);
    f32x4 r[8];
    if (have) {
#pragma unroll
        for (int p = 0; p < 8; ++p) { const int id = tid + p * NTHR, kr = id >> 5, c4 = (id & 31) * 4; r[p] = __builtin_nontemporal_load((const f32x4*)(jb.src + (size_t)(jb.k0 + kr) * jb.N + jb.n0 + c4)); }
    }
    while (have) {
        __syncthreads();
#pragma unroll
        for (int p = 0; p < 8; ++p) { const int id = tid + p * NTHR, kr = id >> 5, c4 = (id & 31) * 4; *(f16x4*)(tile + kr * 136 + c4) = pk4(r[p]); }
        __syncthreads();
        const CvtJob cur = jb;
        u += nb; have = cvt_job(P, l, u, jb, experts);
        if (have) {
#pragma unroll
            for (int p = 0; p < 8; ++p) { const int id = tid + p * NTHR, kr = id >> 5, c4 = (id & 31) * 4; r[p] = __builtin_nontemporal_load((const f32x4*)(jb.src + (size_t)(jb.k0 + kr) * jb.N + jb.n0 + c4)); }
        }
        const int n = tid & 127, kg = (tid >> 7) * 32;
        f16* dp = cur.dst + (size_t)(cur.n0 + n) * cur.K + cur.k0 + kg;
#pragma unroll
        for (int i = 0; i < 4; ++i) { f16x8 o;
#pragma unroll
            for (int e = 0; e < 8; ++e) o[e] = tile[(kg + i * 8 + e) * 136 + n];
            *(f16x8*)(dp + i * 8) = rm8(o); }
    }
}
template <bool GATEUP, bool CTX>
__device__ __forceinline__ void phase_cvt_ctx(const Params& P, int l, int bid, int nb, f16* tile, int sel = -1, bool alt = false) {
    const int tid = opaque_tid(), wid = P.wv, lane = tid & 63, r16 = lane & 15, kq = lane >> 4;
    constexpr int NC = GATEUP ? 128 : 64;
    constexpr int KT = GATEUP ? 8 : 16, K = GATEUP ? DM : DEXP, N = GATEUP ? DEXP : DM, NB = N / NC;
    constexpr int NT = GATEUP ? 2 * KT : KT;
    const int sel_ = (GATEUP && !CTX) ? sel : -1; const int ntr = (GATEUP && sel_ < 0) ? NT : KT;
    constexpr int TS = NC + 4, TW = 128 * TS;
    constexpr int NLD = NC / 16;
    constexpr int WPC = 8 / (NC / 16);
    constexpr int NRB = 4 / WPC;
    const int cb = wid % (NC / 16), rb0 = (wid / (NC / 16)) * NRB;
    f16* asl = tile + 2 * TW;
    for (int job = bid; job < NEXP * NB; job += nb) {
        const int e = job / NB, nbk = job % NB;
        const f16* ap[2];
        if (CTX) {
#pragma unroll
            for (int p = 0; p < 2; ++p) { const int row = (tid >> 4) + p * 32;
                if (GATEUP) ap[p] = P.H() + (size_t)P.rowidx()[e * SLOTS_PAD + 4096 + row] * DM + (tid & 15) * 8;
                else ap[p] = P.act() + ((size_t)e * SLOTS_PAD + 4096 + row) * DEXP + (tid & 15) * 8; }
        }
        f32x4 acc[2][NRB];
#pragma unroll
        for (int w = 0; w < 2; ++w)
#pragma unroll
            for (int rb = 0; rb < NRB; ++rb) acc[w][rb] = (f32x4){0.f, 0.f, 0.f, 0.f};
        const float* srcs[2]; f16* dsts[2];
        if (GATEUP) { const size_t wo = ((size_t)l * NEXP + e) * DM * DEXP; srcs[0] = P.w_gate + wo; srcs[1] = P.w_up + wo; dsts[0] = P.Wgu() + (alt ? (OFF_WGU3 - OFF_WGU) / 2 : 0) + ((size_t)e * 2) * DEXP * DM; dsts[1] = dsts[0] + (size_t)DEXP * DM; }
        else { srcs[0] = P.w_down + ((size_t)l * NEXP + e) * DEXP * DM; srcs[1] = srcs[0]; dsts[0] = P.Wd() + (alt ? (OFF_WD3 - OFF_WD) / 2 : 0) + (size_t)e * DM * DEXP; dsts[1] = dsts[0]; }
        f32x4 r[2][NLD]; f16x8 ar[2][2];
        const unsigned ldoff = (unsigned)(((tid / (NC / 4)) * N + (tid % (NC / 4)) * 4) * 4);
#define CV_LOAD(ti, slot) do { const int which_ = GATEUP ? (sel_ >= 0 ? sel_ : ((ti) & 1)) : 0, kt_ = (GATEUP && sel_ < 0) ? ((ti) >> 1) : (ti); const char* sp_ = (const char*)(srcs[which_] + (size_t)(kt_ * 128) * N + nbk * NC); \
            _Pragma("unroll") for (int p = 0; p < NLD; ++p) r[slot][p] = __builtin_nontemporal_load((const f32x4*)(sp_ + (size_t)p * (NTHR / (NC / 4)) * N * 4 + ldoff)); \
            if (CTX) { _Pragma("unroll") for (int p = 0; p < 2; ++p) ar[slot][p] = *(const f16x8*)(ap[p] + kt_ * 128); } } while (0)
#define CV_TILE(ti, slot) do { const int which = GATEUP ? (sel_ >= 0 ? sel_ : ((ti) & 1)) : 0, kt = (GATEUP && sel_ < 0) ? ((ti) >> 1) : (ti); \
            f16* tl = tile + (slot) * TW; f16* al = asl + (slot) * (64 * 128); \
            _Pragma("unroll") for (int p = 0; p < NLD; ++p) { const int id = tid + p * NTHR, kr = id / (NC / 4), c4 = (id % (NC / 4)) * 4; *(f16x4*)(tl + kr * TS + c4) = pk4(r[slot][p]); } \
            if (CTX) { _Pragma("unroll") for (int p = 0; p < 2; ++p) { const int row = (tid >> 4) + p * 32; *(f16x8*)(al + row * 128 + (((tid & 15) ^ (row & 15)) * 8)) = ar[slot][p]; } } \
            if ((ti) + 2 < ntr) CV_LOAD((ti) + 2, slot); \
            asm volatile("s_waitcnt lgkmcnt(0)" ::: "memory"); __builtin_amdgcn_s_barrier(); asm volatile("" ::: "memory"); \
            f16* dp = dsts[which] + (size_t)(nbk * NC + cb * 16 + r16) * K + kt * 128 + kq * 8; \
            _Pragma("unroll") for (int ks = 0; ks < 4; ++ks) { f16x8 bv; \
                _Pragma("unroll") for (int i = 0; i < 8; ++i) bv[i] = tl[(ks * 32 + kq * 8 + i) * TS + cb * 16 + r16]; \
                if (rb0 == 0) *(f16x8*)(dp + ks * 32) = rm8(bv); \
                if (CTX) { _Pragma("unroll") for (int rb = 0; rb < NRB; ++rb) { const int row = (rb0 + rb) * 16 + r16; const f16x8 af = *(const f16x8*)(al + row * 128 + (((ks * 4 + kq) ^ r16) * 8)); \
                    acc[which][rb] = __builtin_amdgcn_mfma_f32_16x16x32_f16(bv, af, acc[which][rb], 0, 0, 0); } } } } while (0)
        CV_LOAD(0, 0); CV_LOAD(1, 1);
        for (int t2 = 0; t2 < ntr; t2 += 2) { CV_TILE(t2, 0); CV_TILE(t2 + 1, 1); }
#undef CV_LOAD
#undef CV_TILE
        asm volatile("s_waitcnt lgkmcnt(0)" ::: "memory"); __builtin_amdgcn_s_barrier(); asm volatile("" ::: "memory");
        if (CTX) {
#pragma unroll
            for (int rb = 0; rb < NRB; ++rb) {
                const size_t row = (size_t)e * SLOTS_PAD + 4096 + (rb0 + rb) * 16 + r16; const int col = nbk * NC + cb * 16 + 4 * kq;
                if (GATEUP) { f32x4 o;
#pragma unroll
                    for (int jj = 0; jj < 4; ++jj) o[jj] = silu_f(acc[0][rb][jj]) * acc[1][rb][jj];
                    *(f16x4*)(P.act() + row * DEXP + col) = pk4(o); }
                else *(f16x4*)(P.yslot() + row * DM + col) = pk4(acc[0][rb]);
            }
        }
    }
}

__device__ __forceinline__ void cvt3_job(const Params& P, int job, f16* tile) {
    if (job < 256) phase_cvt_ctx<false, false>(P, 3, job, 1 << 20, tile, -1, true);
    else { const int h = job - 256; phase_cvt_ctx<true, false>(P, 3, h >> 1, 1 << 20, tile, h & 1, true); }
}
__device__ __forceinline__ void phase_gateup_fast(const Params& P, LAS unsigned char* lds, int rt = 17, bool alt = false) { fg::PRGateUp S; S.H = P.H(); S.rowidx = P.rowidx(); S.W = P.Wgu() + (alt ? (OFF_WGU3 - OFF_WGU) / 2 : 0); S.act = P.act(); S.rt = rt; S.nunits = 16 * rt * 16; S.bid = opaque_bid(); fg::gemm_phase(lds, S, P.wv); }
__device__ __forceinline__ void phase_down_fast(const Params& P, LAS unsigned char* lds, int rt = 17, bool alt = false) { fg::PRDown S; S.act = P.act(); S.W = P.Wd() + (alt ? (OFF_WD3 - OFF_WD) / 2 : 0); S.y = P.yslot(); S.rt = rt; S.nunits = 16 * rt * 4; S.bid = opaque_bid(); fg::gemm_phase(lds, S, P.wv); }
__device__ __forceinline__ void phase_pool_fast(const Params& P, LAS unsigned char* lds) { fg::PRDense<256> S; S.qn = nullptr; S.kn = nullptr; S.rope = nullptr; S.xs = nullptr; S.lane = 0; S.npan = 130; S.kvx = 0; S.A = P.H(); S.W = P.Wmix(); S.O0 = P.Z(); S.O1 = nullptr; S.O2 = nullptr; S.ncol = 4; S.mode = 2; S.bid = opaque_bid(); fg::gemm_phase(lds, S, P.wv); }
__device__ __forceinline__ void phase_qkv_fast(const Params& P, LAS unsigned char* lds, bool lastl = false, int l = 1) { fg::PRDense<1024> S; S.qn = P.q_norm + (l >> 1) * 64; S.kn = P.k_norm + (l >> 1) * 64; S.rope = P.rope(); S.xs = (LAS float*)(lds + fg::STAGE_BYTES); S.lane = opaque_tid_(P.wv) & 63; S.npan = lastl ? 128 : 130; S.kvx = lastl ? 4 : 0; S.A = P.H(); S.W = P.Wmix(); S.O0 = P.Q(); S.O1 = P.Kb(); S.O2 = P.Vb(); S.ncol = 6; S.mode = 1; S.bid = opaque_bid(); fg::gemm_phase(lds, S, P.wv); }
__device__ __forceinline__ void phase_oproj_fast(const Params& P, LAS unsigned char* lds, bool lastl = false) { fg::PRDense<1024> S; S.qn = nullptr; S.kn = nullptr; S.rope = nullptr; S.xs = nullptr; S.lane = 0; S.npan = lastl ? 128 : 130; S.kvx = 0; S.A = P.O(); S.W = P.Wmix() + (size_t)QKVD * DM; S.O0 = P.Z(); S.O1 = nullptr; S.O2 = nullptr; S.ncol = 4; S.mode = 0; S.bid = opaque_bid(); fg::gemm_phase(lds, S, P.wv); }

typedef float f32x16 __attribute__((ext_vector_type(16)));
#define AT_KB 9216
#define AT_VB 8704
template <int VAR = 0>
__device__ __forceinline__ void phase_attn_fast(const Params& P, int l, LAS unsigned char* lds, bool do_ctx, int cvt_l = -1) {
    const int j = l >> 1;
    const int tid = opaque_tid(), wid = tid >> 6, lane = tid & 63, l32 = lane & 31, hi = lane >> 5;
    const int g = wid >> 1, qoff = (wid & 1) * 64, qoffu = (P.wv & 1) * 64;
    const int nunits = do_ctx ? 1040 : 1024;
    int ucount = 0;
    for (int u = opaque_bid(); u < nunits; u += gridDim.x, ++ucount) {
        int b, qblk, kv, qrow0, t0, t1, s0;
        if (u < 1024) { b = u >> 9; qblk = (u >> 2) & 127; kv = u & 3; s0 = b * SEQ; qrow0 = s0 + qblk * 128; t0 = qblk == 0 ? 2 : 0; t1 = qblk == 127 ? 4 : 6; }
        else { const int uu = u - 1024; b = uu >> 3; qblk = (uu >> 2) & 1; kv = uu & 3; s0 = NLAT + b * CTXL; qrow0 = s0 + qblk * 128; t0 = 0; t1 = 0; }
        const int cb = NLAT + b * CTXL, nloc = t1 - t0, ntiles = nloc + 4;
        const int h = kv * 4 + g;
        f16x8 Qf[2][4];
#pragma unroll
        for (int qb = 0; qb < 2; ++qb)
#pragma unroll
            for (int ks = 0; ks < 4; ++ks) Qf[qb][ks] = *(const f16x8*)(P.Q() + (size_t)(qrow0 + qoff + 32 * qb + l32) * 1024 + h * 64 + 16 * ks + 8 * hi);
        f32x16 OT[2][2];
#pragma unroll
        for (int db = 0; db < 2; ++db)
#pragma unroll
            for (int qb = 0; qb < 2; ++qb)
#pragma unroll
                for (int r = 0; r < 16; ++r) OT[db][qb][r] = 0.f;
        float mrun[2], lrun[2];
        { const float sk = P.sink[j * 16 + h] * 1.4426950408889634f; mrun[0] = sk; mrun[1] = sk; lrun[0] = hi == 0 ? 1.0f : 0.0f; lrun[1] = lrun[0]; }
        const int lkey = tid >> 3, lpc = tid & 7;
        f16x8 kreg, vreg;
        auto tile_row = [&](int it) -> int { return it < nloc ? (qrow0 - 128 + 64 * (t0 + it)) : (cb + 64 * (it - nloc)); };
        { const int kr = tile_row(0) + lkey; kreg = *(const f16x8*)(P.Kb() + (size_t)kr * 256 + kv * 64 + lpc * 8); vreg = *(const f16x8*)(P.Vb() + (size_t)kr * 256 + kv * 64 + lpc * 8); }
        __syncthreads();
        {
            LAS f16* Kl = (LAS f16*)(lds); LAS f16* Vl = (LAS f16*)(lds + 2 * AT_KB);
            *(LAS f16x8*)(Kl + lkey * 72 + lpc * 8) = kreg;
#pragma unroll
            for (int i = 0; i < 8; ++i) Vl[(lpc * 8 + i) * 68 + lkey] = vreg[i];
        }
        __syncthreads();
        for (int it = 0; it < ntiles; ++it) {
            const int buf = it & 1;
            if (it + 1 < ntiles) { const int kr = tile_row(it + 1) + lkey; kreg = *(const f16x8*)(P.Kb() + (size_t)kr * 256 + kv * 64 + lpc * 8); vreg = *(const f16x8*)(P.Vb() + (size_t)kr * 256 + kv * 64 + lpc * 8); }
            const LAS f16* Kl = (const LAS f16*)(lds + buf * AT_KB); const LAS f16* Vl = (const LAS f16*)(lds + 2 * AT_KB + buf * AT_VB);
            int cls = 0;
            if (it < nloc) { const int tl = t0 + it, dmin = qoffu + 65 - 64 * tl, dmax = qoffu + 191 - 64 * tl; cls = (dmin > 128 || dmax < -128) ? 2 : ((dmin >= -128 && dmax <= 128) ? 0 : 1); }
            if (cls != 2) {
            f32x16 S[2][2];
#pragma unroll
            for (int kb = 0; kb < 2; ++kb)
#pragma unroll
                for (int qb = 0; qb < 2; ++qb)
#pragma unroll
                    for (int r = 0; r < 16; ++r) S[kb][qb][r] = -mrun[qb];
#pragma unroll
            for (int ks = 0; ks < 4; ++ks)
#pragma unroll
                for (int kb = 0; kb < 2; ++kb) {
                    const f16x8 kf = *(const LAS f16x8*)(Kl + (32 * kb + l32) * 72 + 16 * ks + 8 * hi);
#pragma unroll
                    for (int qb = 0; qb < 2; ++qb) S[kb][qb] = __builtin_amdgcn_mfma_f32_32x32x16_f16(kf, Qf[qb][ks], S[kb][qb], 0, 0, 0);
                }
            if (cls == 1) {
                const int kt = 64 * (t0 + it);
#pragma unroll
                for (int qb = 0; qb < 2; ++qb) {
                    const int qp = 128 + qoff + 32 * qb + l32;
#pragma unroll
                    for (int kb = 0; kb < 2; ++kb)
#pragma unroll
                        for (int r = 0; r < 16; ++r) { const int kp = kt + 32 * kb + 8 * (r >> 2) + 4 * hi + (r & 3); const int d = qp - kp; if (d > 128 || d < -128) S[kb][qb][r] = -INFINITY; }
                }
            }
            f16x8 Pf[2][4];
#pragma unroll
            for (int qb = 0; qb < 2; ++qb) {
                float mx = S[0][qb][0];
#pragma unroll
                for (int kb = 0; kb < 2; ++kb)
#pragma unroll
                    for (int r = 0; r < 16; ++r) mx = fmaxf(mx, S[kb][qb][r]);
                { const auto sw = __builtin_amdgcn_permlane32_swap(__float_as_uint(mx), __float_as_uint(mx), false, false); mx = fmaxf(__uint_as_float(sw[0]), __uint_as_float(sw[1])); }
                if (__builtin_amdgcn_ballot_w64(mx > 8.0f) != 0ull) {
                    const float g = fmaxf(mx, 0.f), corr = __builtin_amdgcn_exp2f(-g);
                    mrun[qb] += g; lrun[qb] *= corr;
#pragma unroll
                    for (int kb = 0; kb < 2; ++kb)
#pragma unroll
                        for (int r = 0; r < 16; ++r) S[kb][qb][r] -= g;
#pragma unroll
                    for (int db = 0; db < 2; ++db)
#pragma unroll
                        for (int r = 0; r < 16; ++r) OT[db][qb][r] *= corr;
                }
                float ps = 0.f;
#pragma unroll
                for (int kb = 0; kb < 2; ++kb)
#pragma unroll
                    for (int r = 0; r < 16; ++r) { const float p = __builtin_amdgcn_exp2f(S[kb][qb][r]); S[kb][qb][r] = p; ps += p; }
                lrun[qb] += ps;
#pragma unroll
                for (int ks = 0; ks < 4; ++ks) { const int kb = ks >> 1, r0 = 8 * (ks & 1);
#pragma unroll
                    for (int e = 0; e < 8; ++e) Pf[qb][ks][e] = (f16)S[kb][qb][r0 + e]; }
            }
#pragma unroll
            for (int ks = 0; ks < 4; ++ks)
#pragma unroll
                for (int db = 0; db < 2; ++db) {
                    const LAS f16* vp = Vl + (32 * db + l32) * 68 + 16 * ks + 4 * hi;
                    const f16x4 v0 = *(const LAS f16x4*)vp, v1 = *(const LAS f16x4*)(vp + 8);
                    const f16x8 vf = (f16x8){v0[0], v0[1], v0[2], v0[3], v1[0], v1[1], v1[2], v1[3]};
#pragma unroll
                    for (int qb = 0; qb < 2; ++qb) OT[db][qb] = __builtin_amdgcn_mfma_f32_32x32x16_f16(vf, Pf[qb][ks], OT[db][qb], 0, 0, 0);
                }
            }
            if (it + 1 < ntiles) {
                LAS f16* Kw = (LAS f16*)(lds + (buf ^ 1) * AT_KB); LAS f16* Vw = (LAS f16*)(lds + 2 * AT_KB + (buf ^ 1) * AT_VB);
                *(LAS f16x8*)(Kw + lkey * 72 + lpc * 8) = kreg;
#pragma unroll
                for (int i = 0; i < 8; ++i) Vw[(lpc * 8 + i) * 68 + lkey] = vreg[i];
            }
            __syncthreads();
        }
#pragma unroll
        for (int qb = 0; qb < 2; ++qb) {
            const float lt = lrun[qb] + shx<32>(lrun[qb], lane);
            const float inv = 1.0f / lt;
            f16* op = P.O() + (size_t)(qrow0 + qoff + 32 * qb + l32) * 1024 + h * 64;
#pragma unroll
            for (int db = 0; db < 2; ++db)
#pragma unroll
                for (int i = 0; i < 4; ++i) {
                    const f16x4 o = (f16x4){(f16)(OT[db][qb][4 * i] * inv), (f16)(OT[db][qb][4 * i + 1] * inv), (f16)(OT[db][qb][4 * i + 2] * inv), (f16)(OT[db][qb][4 * i + 3] * inv)};
                    *(f16x4*)(op + 32 * db + 8 * i + 4 * hi) = o;
                }
        }
    }
}

#define MEGA_LDS (147456 + 16)
__device__ __forceinline__ const Params& opq(Params& q) { int z; asm volatile("s_mov_b32 %0, 0" : "=s"(z)); q.zoff = z; return q; }
__global__ __launch_bounds__(NTHR, 2) void mega(Params P) {
    extern __shared__ __attribute__((aligned(16))) unsigned char shm[];
    LAS unsigned char* lds = (LAS unsigned char*)shm;
    volatile LAS unsigned* st = (volatile LAS unsigned*)(lds + 147456);
    if (threadIdx.x == 0) { st[0] = 0u; st[1] = 0u; st[2] = 0u; st[3] = 0u; }
    __syncthreads();
    const XcdBarrier bar = xcd_barrier_post(P.bar(), st);
    const int nb = gridDim.x;
#define bid (opaque_bid())
    Params Q = P; Q.wv = __builtin_amdgcn_readfirstlane(threadIdx.x >> 6);
#define P (opq(Q))
    phase_ada(P, bid, nb, (float*)shm);
    __syncthreads();
    phase_convert(P, 0, bid, nb, (f16*)shm, false);
    xcd_barrier(bar);
    for (int l = 0; l < 4; ++l) {
        if (l == 0) phase_n1<true, false>(P, l, bid, nb); else { phase_n1<false, false>(P, l, bid, nb); __syncthreads(); phase_convert(P, l, bid, nb, (f16*)shm, false);
            }
        xcd_barrier(bar);
        if ((l & 1) == 0) {
            phase_pool_fast(P, lds);
            xcd_barrier(bar);
            phase_n2<true>(P, l, bid, nb, (float*)shm);
        } else {
            phase_qkv_fast(P, lds, l == 3, l);
            if (nb == 256 && (bid & 7) >= 2) { __syncthreads(); cvt3_job(P, (l == 1 ? 192 : 576) + ((bid & 7) - 2) * 32 + (bid >> 3), (f16*)shm); }
            xcd_barrier(bar);
            phase_attn_fast(P, l, lds, l != 3);
            if (l == 3 && nb != 256) { __syncthreads(); phase_cvt_ctx<true, false>(P, l, bid, nb, (f16*)shm, -1, true); phase_cvt_ctx<false, false>(P, l, bid, nb, (f16*)shm, -1, true); }
            xcd_barrier(bar);
            phase_oproj_fast(P, lds, l == 3);
            if (l == 1 && nb == 256 && (bid & 7) >= 2) { __syncthreads(); cvt3_job(P, 384 + ((bid & 7) - 2) * 32 + (bid >> 3), (f16*)shm); }
            xcd_barrier(bar);
            phase_n2<false>(P, l, bid, nb, (float*)shm, l == 3 ? NLAT : MROWS);
        }
        xcd_barrier(bar);
        phase_topk(P, bid, nb, (unsigned*)shm, l == 3 ? 32 : 64);
        if (l < 3 && nb == 256 && bid >= 64 && bid < 128) cvt3_job(P, l * 64 + bid - 64, (f16*)shm);
        xcd_barrier(bar);
        if (l < 3) { phase_cvt_ctx<true, true>(P, l, bid, nb, (f16*)shm); xcd_barrier(bar); }
        phase_gateup_fast(P, lds, 16, l == 3);
        if (l < 3) { __syncthreads(); phase_cvt_ctx<false, true>(P, l, bid, nb, (f16*)shm); }
        xcd_barrier(bar);
        phase_down_fast(P, lds, 16, l == 3);
        xcd_barrier(bar);
    }
    phase_n1<false, true>(P, 4, bid, nb);
#undef P
#undef bid
}

static inline size_t al256(size_t v) { return (v + 255) & ~(size_t)255; }

extern "C" void kernel_launch(void* const* d_in, const int* in_sizes, int n_in, void* d_out, int out_size, void* d_ws, size_t ws_size, hipStream_t stream) {
    Params P{};
    P.x = (const float*)d_in[0]; P.c = (const float*)d_in[1]; P.ctx = (const float*)d_in[2]; P.c_ctx = (const float*)d_in[3];
    P.w_ada = (const float*)d_in[4]; P.b_ada = (const float*)d_in[5]; P.norm1_g = (const float*)d_in[6]; P.norm2_g = (const float*)d_in[7];
    P.pool_w = (const float*)d_in[8]; P.pool_scale = (const float*)d_in[9]; P.w_qkv = (const float*)d_in[10]; P.w_o = (const float*)d_in[11];
    P.q_norm = (const float*)d_in[12]; P.k_norm = (const float*)d_in[13]; P.sink = (const float*)d_in[14]; P.router_w = (const float*)d_in[15];
    P.w_gate = (const float*)d_in[16]; P.w_up = (const float*)d_in[17]; P.w_down = (const float*)d_in[18];
    P.out = (float*)d_out;
    P.ws = (char*)d_ws; const size_t off = WS_TOTAL;
    if (off > ws_size) { fprintf(stderr, "workspace too small: need %zu have %zu\n", off, ws_size); return; }
    static int grid = 0;
    if (!grid) {
        int dev = 0, cus = 0, per_cu = 0;
        hipGetDevice(&dev);
        hipDeviceGetAttribute(&cus, hipDeviceAttributeMultiprocessorCount, dev);
        hipFuncSetAttribute((const void*)mega, hipFuncAttributeMaxDynamicSharedMemorySize, MEGA_LDS);
        hipOccupancyMaxActiveBlocksPerMultiprocessor(&per_cu, (const void*)mega, NTHR, MEGA_LDS);
        if (per_cu < 1) { fprintf(stderr, "mega: occupancy query says %d blocks per CU\n", per_cu); }
        grid = cus > 0 ? cus : 256;
    }
    hipMemsetAsync(P.bar(), 0, XCD_BAR_WORDS * sizeof(unsigned), stream);
    hipLaunchKernelGGL(mega, dim3(grid), dim3(NTHR), MEGA_LDS, stream, P);
}
```

```cpp
#include <hip/hip_runtime.h>
#include <stdint.h>
#include <stdio.h>

typedef _Float16 f16;
typedef _Float16 f16x2 __attribute__((ext_vector_type(2)));
typedef _Float16 f16x4 __attribute__((ext_vector_type(4)));
typedef _Float16 f16x8 __attribute__((ext_vector_type(8)));
typedef float f32x4 __attribute__((ext_vector_type(4)));
typedef float f32x2 __attribute__((ext_vector_type(2)));
typedef unsigned u32x2 __attribute__((ext_vector_type(2)));
typedef unsigned u32x4 __attribute__((ext_vector_type(4)));
#define RM_BITS 4
#define RM_ADD (0x00010001u << (RM_BITS - 1))
#define RM_MASK (~(0x00010001u * ((1u << RM_BITS) - 1u)))
__device__ __forceinline__ f16x4 rm4(f16x4 v) { u32x2 b = __builtin_bit_cast(u32x2, v); b = (b + RM_ADD) & RM_MASK; return __builtin_bit_cast(f16x4, b); }
__device__ __forceinline__ f16x8 rm8(f16x8 v) { u32x4 b = __builtin_bit_cast(u32x4, v); b = (b + RM_ADD) & RM_MASK; return __builtin_bit_cast(f16x8, b); }

#define LAS __attribute__((address_space(3)))
#define DM 1024
#define SEQ 16384
#define NLAT 32768
#define CTXL 256
#define NCTX 512
#define MROWS 33280
#define NEXP 16
#define DEXP 2048
#define SLOTS 4160
#define SLOTS_PAD 4352
#define QKVD 1536
#define NTHR 512

constexpr size_t al256c(size_t v) { return (v + 255) & ~(size_t)255; }
constexpr size_t OFF_BAR = 0;
constexpr size_t OFF_MOD = al256c(OFF_BAR + 16384);
constexpr size_t OFF_ROPE = al256c(OFF_MOD + (size_t)4 * 3 * 6 * DM * 4);
constexpr size_t OFF_X = al256c(OFF_ROPE + (size_t)256 * 16 * 2 * 4);
constexpr size_t OFF_H = al256c(OFF_X + (size_t)MROWS * DM * 4);
constexpr size_t OFF_Z = al256c(OFF_H + (size_t)MROWS * DM * 2);
constexpr size_t OFF_Q = al256c(OFF_Z + (size_t)MROWS * DM * 2);
constexpr size_t OFF_KB = al256c(OFF_Q + (size_t)MROWS * DM * 2);
constexpr size_t OFF_VB = al256c(OFF_KB + (size_t)MROWS * 256 * 2);
constexpr size_t OFF_VT = al256c(OFF_VB + (size_t)MROWS * 256 * 2);
constexpr size_t OFF_O = al256c(OFF_VT + (size_t)MROWS * 256 * 2);
constexpr size_t OFF_AFF = al256c(OFF_O + (size_t)MROWS * DM * 2);
constexpr size_t OFF_INV = al256c(OFF_AFF + (size_t)MROWS * 16 * 4);
constexpr size_t OFF_ROWIDX = al256c(OFF_INV + (size_t)MROWS * 16 * 4);
constexpr size_t OFF_ACT = al256c(OFF_ROWIDX + (size_t)NEXP * SLOTS_PAD * 4);
constexpr size_t OFF_YSLOT = al256c(OFF_ACT + (size_t)NEXP * SLOTS_PAD * DEXP * 2);
constexpr size_t OFF_WGU = al256c(OFF_YSLOT + (size_t)NEXP * SLOTS_PAD * DM * 2);
constexpr size_t OFF_WD = al256c(OFF_WGU + (size_t)NEXP * 2 * DEXP * DM * 2);
constexpr size_t OFF_WMIX = al256c(OFF_WD + (size_t)NEXP * DM * DEXP * 2);
constexpr size_t OFF_WGU3 = al256c(OFF_WMIX + (size_t)(QKVD + DM) * DM * 2);
constexpr size_t OFF_WD3 = al256c(OFF_WGU3 + (size_t)NEXP * 2 * DEXP * DM * 2);
constexpr size_t OFF_DUMMY = al256c(OFF_WD3 + (size_t)NEXP * DM * DEXP * 2);
constexpr size_t WS_TOTAL = OFF_DUMMY;
struct Params {
    const float *x, *c, *ctx, *c_ctx, *w_ada, *b_ada, *norm1_g, *norm2_g, *pool_w, *pool_scale, *w_qkv, *w_o, *q_norm, *k_norm, *sink, *router_w, *w_gate, *w_up, *w_down;
    float* out; char* ws; int wv; int zoff;
#define WSF(name, type, off) __host__ __device__ __forceinline__ type* name() const { return (type*)(ws + zoff + (off)); }
    WSF(bar, unsigned, OFF_BAR) WSF(mod, float, OFF_MOD) WSF(rope, float, OFF_ROPE) WSF(X, f16, OFF_X) WSF(H, f16, OFF_H) WSF(Z, f16, OFF_Z) WSF(Q, f16, OFF_Q) WSF(Kb, f16, OFF_KB) WSF(Vb, f16, OFF_VB) WSF(Vt, f16, OFF_VT)
    WSF(O, f16, OFF_O) WSF(aff, float, OFF_AFF) WSF(inv, int, OFF_INV) WSF(rowidx, int, OFF_ROWIDX) WSF(act, f16, OFF_ACT) WSF(yslot, f16, OFF_YSLOT) WSF(Wgu, f16, OFF_WGU) WSF(Wd, f16, OFF_WD) WSF(Wmix, f16, OFF_WMIX)
#undef WSF
#define WSW(name, type, off) __host__ __device__ __forceinline__ type* name() const { return (type*)(ws + zoff + (off)); }
    WSW(Xw, f16, OFF_X) WSW(Ow, f16, OFF_O) WSW(Hw, f16, OFF_H) WSW(affw, float, OFF_AFF) WSW(Qw, f16, OFF_Q) WSW(Kw, f16, OFF_KB)
#undef WSW
};

template <int O> __device__ __forceinline__ float shx(float v, int lane) {
    if (O == 1) return __int_as_float(__builtin_amdgcn_update_dpp(0, __float_as_int(v), 0xB1, 0xF, 0xF, true));
    if (O == 2) return __int_as_float(__builtin_amdgcn_update_dpp(0, __float_as_int(v), 0x4E, 0xF, 0xF, true));
    if (O < 32) return __int_as_float(__builtin_amdgcn_ds_swizzle(__float_as_int(v), (O << 10) | 0x1f));
    return __int_as_float(__builtin_amdgcn_ds_bpermute((lane ^ O) << 2, __float_as_int(v)));
}
__device__ __forceinline__ float wave_sum(float v, int lane) {
    v += shx<1>(v, lane); v += shx<2>(v, lane); v += shx<4>(v, lane); v += shx<8>(v, lane); v += shx<16>(v, lane); v += shx<32>(v, lane);
    return v;
}
__device__ __forceinline__ unsigned shup(unsigned v, int o, int lane) { return (unsigned)__builtin_amdgcn_ds_bpermute((lane - o) << 2, (int)v); }
__device__ __forceinline__ int opaque_bid() { int b = blockIdx.x; asm volatile("" : "+s"(b)); return b; }
#define opaque_tid() opaque_tid_(P.wv)
__device__ __forceinline__ int opaque_tid_(int wv) { int ln; asm volatile("v_mbcnt_lo_u32_b32 %0, -1, 0\n\tv_mbcnt_hi_u32_b32 %0, -1, %0" : "=v"(ln)); return (wv << 6) | ln; }
__device__ __forceinline__ float silu_f(float v) { return v * __builtin_amdgcn_rcpf(1.0f + __expf(-v)); }

__device__ __forceinline__ const float* modp(const Params& P, int l, int v, int j) { return P.mod() + (size_t)((l * 3 + v) * 6 + j) * DM; }

__device__ __forceinline__ void phase_ada(const Params& P, int bid, int nb, float* lds) {
    float* sc = lds; float* red = lds + 3 * DM;
    const int tid = opaque_tid();
    for (int i = tid; i < 3 * DM; i += NTHR) { const int v = i >> 10, k = i & 1023; const float cv = v < 2 ? P.c[v * DM + k] : P.c_ctx[k]; sc[i] = silu_f(cv); }
    __syncthreads();
    for (int u = bid; u < 4 * 96; u += nb) {
        const int l = u / 96, ch = u % 96, col = ch * 64 + (tid & 63), ks = tid >> 6;
        const float* w = P.w_ada + (size_t)l * DM * 6 * DM + col;
        float s0 = 0.f, s1 = 0.f, s2 = 0.f;
        for (int k = ks * 128; k < ks * 128 + 128; ++k) { const float wv = __builtin_nontemporal_load(w + (size_t)k * 6 * DM); s0 += sc[k] * wv; s1 += sc[DM + k] * wv; s2 += sc[2 * DM + k] * wv; }
        red[(ks * 3 + 0) * 64 + (tid & 63)] = s0; red[(ks * 3 + 1) * 64 + (tid & 63)] = s1; red[(ks * 3 + 2) * 64 + (tid & 63)] = s2;
        __syncthreads();
        if (tid < 192) { const int v = tid >> 6, cc = tid & 63; float s = 0.f;
#pragma unroll
            for (int q = 0; q < 8; ++q) s += red[(q * 3 + v) * 64 + cc];
            const int colg = ch * 64 + cc; s += P.b_ada[l * 6 * DM + colg];
            const int j = colg >> 10, d = colg & 1023;
            P.mod()[(size_t)((l * 3 + v) * 6 + j) * DM + d] = s; }
        __syncthreads();
    }
    for (int i = bid * NTHR + tid; i < 256 * 16; i += nb * NTHR) {
        const int p = i >> 4, f = i & 15;
        const float inv = powf(10000.0f, -(float)f / 16.0f);
        const float angf = (float)p * inv;
        double a = (double)angf;
        const double twopi = 6.283185307179586476925286766559;
        a -= twopi * rint(a / twopi);
        const double a2 = a * a;
        double cs = 1.0, sn = 1.0;
        double tc = 0.0, ts = 0.0;
        for (int n = 16; n >= 1; --n) { tc = (tc + 1.0) * (-a2 / (double)((2 * n - 1) * (2 * n))); ts = (ts + 1.0) * (-a2 / (double)((2 * n) * (2 * n + 1))); }
        cs = 1.0 + tc; sn = a * (1.0 + ts);
        P.rope()[i * 2] = (float)cs; P.rope()[i * 2 + 1] = (float)sn;
    }
}

__device__ __forceinline__ f32x4 cvt4(const f16x4 v) { return (f32x4){(float)v[0], (float)v[1], (float)v[2], (float)v[3]}; }
__device__ __forceinline__ f16x4 pk4(const f32x4 v) { return (f16x4){(f16)v[0], (f16)v[1], (f16)v[2], (f16)v[3]}; }
__device__ __forceinline__ float dot4(const f32x4 a, const f32x4 b) { return a[0] * b[0] + a[1] * b[1] + a[2] * b[2] + a[3] * b[3]; }
template <bool FIRST, bool FINAL>
__device__ __forceinline__ void phase_n1(const Params& P, int l, int bid, int nb) {
    constexpr int R = 4;
    const int tid_ = opaque_tid(); const int wid = P.wv, lane = tid_ & 63;
    const int nrows = FINAL ? NLAT : MROWS;
    for (int rb = (bid * 8 + wid) * R; rb < nrows; rb += nb * 8 * R) {
        const int v = rb < NLAT ? (rb >> 14) : 2;
        f32x4 xv[R][4];
#pragma unroll
        for (int u = 0; u < R; ++u) {
            const int r = rb + u;
            if (FIRST) { const float* src = r < NLAT ? P.x + (size_t)r * DM : P.ctx + (size_t)(r - NLAT) * DM;
#pragma unroll
                for (int q = 0; q < 4; ++q) xv[u][q] = __builtin_nontemporal_load((const f32x4*)(src + q * 256 + lane * 4)); }
            else { const f16* src = P.X() + (size_t)r * DM;
#pragma unroll
                for (int q = 0; q < 4; ++q) xv[u][q] = cvt4(*(const f16x4*)(src + q * 256 + lane * 4)); }
        }
        if (!FIRST) {
            const int sl = P.inv()[(size_t)(lane & 15) * MROWS + rb + (lane >> 4)];
            const float af = P.aff()[(size_t)(lane & 15) * MROWS + rb + (lane >> 4)];
            const unsigned long long bal = __builtin_amdgcn_ballot_w64(sl >= 0);
            unsigned m[R];
#pragma unroll
            for (int u = 0; u < R; ++u) m[u] = (unsigned)(bal >> (16 * u)) & 0xffffu;
            const f16* ys = P.yslot();
            const float* g2 = modp(P, l - 1, v, 5);
            f32x4 gv[4];
#pragma unroll
            for (int q = 0; q < 4; ++q) gv[q] = *(const f32x4*)(g2 + q * 256 + lane * 4);
            while (m[0] | m[1] | m[2] | m[3]) {
                f16x4 yv[R][4]; float w[R];
#pragma unroll
                for (int u = 0; u < R; ++u) {
                    const int e = m[u] ? __builtin_ctz(m[u]) : 0;
                    const int sv = m[u] ? __builtin_amdgcn_readlane(sl, 16 * u + e) : 0;
                    w[u] = m[u] ? __int_as_float(__builtin_amdgcn_readlane(__float_as_int(af), 16 * u + e)) : 0.f;
                    m[u] &= m[u] - 1u;
                    const f16* y = ys + ((size_t)e * SLOTS_PAD + sv) * DM + lane * 4;
#pragma unroll
                    for (int q = 0; q < 4; ++q) yv[u][q] = *(const f16x4*)(y + q * 256);
                }
#pragma unroll
                for (int u = 0; u < R; ++u)
#pragma unroll
                    for (int q = 0; q < 4; ++q) xv[u][q] += (w[u] * gv[q]) * cvt4(yv[u][q]);
            }
        }
        if (FINAL) {
#pragma unroll
            for (int u = 0; u < R; ++u)
#pragma unroll
                for (int q = 0; q < 4; ++q) __builtin_nontemporal_store(xv[u][q], (f32x4*)(P.out + (size_t)(rb + u) * DM + q * 256 + lane * 4));
            continue;
        }
        float ss[R];
#pragma unroll
        for (int u = 0; u < R; ++u) {
            f16* xd = P.Xw() + (size_t)(rb + u) * DM; float sacc = 0.f;
#pragma unroll
            for (int q = 0; q < 4; ++q) { *(f16x4*)(xd + q * 256 + lane * 4) = pk4(xv[u][q]); sacc += dot4(xv[u][q], xv[u][q]); }
            ss[u] = sacc;
        }
#pragma unroll
        for (int u = 0; u < R; ++u) ss[u] = rsqrtf(wave_sum(ss[u], lane) * (1.0f / DM) + 1e-6f);
        const float* g = P.norm1_g + l * DM; const float* sh = modp(P, l, v, 0); const float* scl = modp(P, l, v, 1);
#pragma unroll
        for (int q = 0; q < 4; ++q) {
            const int c0 = q * 256 + lane * 4;
            const f32x4 gq = *(const f32x4*)(g + c0), sq = *(const f32x4*)(sh + c0), cq = *(const f32x4*)(scl + c0);
            const f32x4 gm = gq * (1.0f + cq);
#pragma unroll
            for (int u = 0; u < R; ++u) *(f16x4*)(P.Hw() + (size_t)(rb + u) * DM + c0) = rm4(pk4(xv[u][q] * ss[u] * gm + sq));
        }
    }
}

#define N2_ZST 81920
template <bool POOL>
__device__ __forceinline__ void phase_n2(const Params& P, int l, int bid, int nb, float* lds, int nrows = MROWS) {
    const int tid = opaque_tid(), wid = P.wv, lane = tid & 63;
    const float* wr = P.router_w + (size_t)l * DM * NEXP;
    f16* wh = (f16*)lds;
    for (int i = tid; i < DM * NEXP; i += NTHR) { const int d = i >> 4, e = i & 15; wh[e * 1032 + d] = (f16)wr[i]; }
    f16* h2s = (f16*)lds + 16640;
    LAS unsigned char* zst = (LAS unsigned char*)lds + N2_ZST;
    const int j = l >> 1, nblk = nrows >> 4;
    const f16* Zg = P.Z();
    const f16* Xg = P.X();
    f16x4 xr[2][4]; f16x4 zr[2][4];
    auto prefetch = [&](int blk) {
        const int R0 = blk * 16, rb = R0 + wid * 2;
        if (POOL) {
            int s0, L; if (R0 < NLAT) { s0 = (R0 >> 14) << 14; L = SEQ; } else { s0 = NLAT + (((R0 - NLAT) >> 8) << 8); L = CTXL; }
#pragma unroll
            for (int i = 0; i < 8; ++i) { const int piece = wid * 8 + i; int rr = R0 - 8 + (piece >> 1); rr = rr < s0 ? s0 : (rr > s0 + L - 1 ? s0 + L - 1 : rr);
                __builtin_amdgcn_global_load_lds((const unsigned*)(Zg + (size_t)rr * DM + (piece & 1) * 512 + lane * 8), (LAS unsigned*)(zst + piece * 1024), 16, 0, 0); }
        } else {
#pragma unroll
            for (int u = 0; u < 2; ++u)
#pragma unroll
                for (int q = 0; q < 4; ++q) zr[u][q] = *(const f16x4*)(Zg + (size_t)(rb + u) * DM + q * 256 + lane * 4);
        }
#pragma unroll
        for (int u = 0; u < 2; ++u)
#pragma unroll
            for (int q = 0; q < 4; ++q) xr[u][q] = *(const f16x4*)(Xg + (size_t)(rb + u) * DM + q * 256 + lane * 4);
    };
    int blk = bid;
    if (blk < nblk) prefetch(blk);
    __syncthreads();
    while (blk < nblk) {
        const int R0 = blk * 16, rb = R0 + wid * 2;
        int v, s0, L;
        if (rb < NLAT) { v = rb >> 14; s0 = v << 14; L = SEQ; } else { v = 2; s0 = NLAT + (((rb - NLAT) >> 8) << 8); L = CTXL; }
        const int t = rb - s0;
        f32x4 g1v[4], gmv[4], shv[4], psv[4];
        { const float* g1 = modp(P, l, v, 2); const float* g = P.norm2_g + l * DM; const float* sh = modp(P, l, v, 3); const float* scl = modp(P, l, v, 4);
#pragma unroll
            for (int q = 0; q < 4; ++q) { const int c0 = q * 256 + lane * 4;
                g1v[q] = *(const f32x4*)(g1 + c0); const f32x4 gv = *(const f32x4*)(g + c0), cv = *(const f32x4*)(scl + c0); shv[q] = *(const f32x4*)(sh + c0); gmv[q] = gv * (1.0f + cv);
                if (POOL) psv[q] = *(const f32x4*)(P.pool_scale + j * DM + c0); } }
        f32x4 y[2][4];
        if (POOL) {
            asm volatile("s_waitcnt vmcnt(0)" ::: "memory");
            __syncthreads();
#pragma unroll
            for (int q = 0; q < 4; ++q) {
                const int h = 1 << q;
                const LAS f16* zb = (const LAS f16*)zst + q * 256 + lane * 4;
                f32x4 common = (f32x4){0.f, 0.f, 0.f, 0.f}, z0 = common, z1 = common;
#pragma unroll
                for (int d = -h; d <= h; ++d) {
                    const int tt = t + d; const bool ok = tt >= 0 && tt < L;
                    f32x4 zz = cvt4(*(const LAS f16x4*)(zb + (2 * wid + 8 + d) * DM));
                    if (!ok) zz = (f32x4){0.f, 0.f, 0.f, 0.f};
                    if (d == -h) z0 = zz; else if (d == h) z1 = zz; else common += zz;
                    if (d == 0) y[0][q] = zz;
                    if (d == 1) y[1][q] = zz;
                }
                const int c0n = min(t + h, L) - max(t - h, 0), c1n = min(t + 1 + h, L) - max(t + 1 - h, 0);
                y[0][q] = ((common + z0) * (1.0f / (float)c0n) - y[0][q]) * psv[q];
                y[1][q] = ((common + z1) * (1.0f / (float)c1n) - y[1][q]) * psv[q];
            }
            asm volatile("s_waitcnt lgkmcnt(0)" ::: "memory");
            __syncthreads();
        } else {
#pragma unroll
            for (int u = 0; u < 2; ++u)
#pragma unroll
                for (int q = 0; q < 4; ++q) y[u][q] = cvt4(zr[u][q]);
        }
        f32x4 xv[2][4]; float ss[2] = {0.f, 0.f};
#pragma unroll
        for (int q = 0; q < 4; ++q) {
#pragma unroll
            for (int u = 0; u < 2; ++u) { xv[u][q] = cvt4(xr[u][q]) + g1v[q] * y[u][q]; ss[u] += dot4(xv[u][q], xv[u][q]); }
        }
        const int nxt = blk + nb;
        asm volatile("" ::: "memory");
        if (nxt < nblk) prefetch(nxt);
#pragma unroll
        for (int u = 0; u < 2; ++u)
#pragma unroll
            for (int q = 0; q < 4; ++q) *(f16x4*)(P.Xw() + (size_t)(rb + u) * DM + q * 256 + lane * 4) = pk4(xv[u][q]);
        ss[0] = wave_sum(ss[0], lane); ss[1] = wave_sum(ss[1], lane);
        const float rs[2] = {rsqrtf(ss[0] * (1.0f / DM) + 1e-6f), rsqrtf(ss[1] * (1.0f / DM) + 1e-6f)};
        f16x4 h2h[2][4];
#pragma unroll
        for (int q = 0; q < 4; ++q) {
            const int c0 = q * 256 + lane * 4;
#pragma unroll
            for (int u = 0; u < 2; ++u) { h2h[u][q] = rm4(pk4(xv[u][q] * rs[u] * gmv[q] + shv[q])); *(f16x4*)(P.Hw() + (size_t)(rb + u) * DM + c0) = h2h[u][q]; }
        }
        asm volatile("s_waitcnt lgkmcnt(0)" ::: "memory"); __builtin_amdgcn_s_barrier(); asm volatile("" ::: "memory");
#pragma unroll
        for (int q = 0; q < 4; ++q)
#pragma unroll
            for (int u = 0; u < 2; ++u) *(f16x4*)(h2s + (2 * wid + u) * 1032 + q * 256 + lane * 4) = h2h[u][q];
        asm volatile("s_waitcnt lgkmcnt(0)" ::: "memory"); __builtin_amdgcn_s_barrier(); asm volatile("" ::: "memory");
        if (wid == 0) {
            const int r16 = lane & 15, kq = lane >> 4;
            f32x4 lg = (f32x4){0.f, 0.f, 0.f, 0.f};
#pragma unroll 8
            for (int ks = 0; ks < 32; ++ks) {
                const f16x8 av = *(const f16x8*)(h2s + r16 * 1032 + ks * 32 + kq * 8), bv = *(const f16x8*)(wh + r16 * 1032 + ks * 32 + kq * 8);
                lg = __builtin_amdgcn_mfma_f32_16x16x32_f16(av, bv, lg, 0, 0, 0);
            }
#pragma unroll
            for (int jj = 0; jj < 4; ++jj) {
                float mx = lg[jj];
                mx = fmaxf(mx, shx<1>(mx, lane)); mx = fmaxf(mx, shx<2>(mx, lane)); mx = fmaxf(mx, shx<4>(mx, lane)); mx = fmaxf(mx, shx<8>(mx, lane));
                const float pe = __expf(lg[jj] - mx);
                float den = pe;
                den += shx<1>(den, lane); den += shx<2>(den, lane); den += shx<4>(den, lane); den += shx<8>(den, lane);
                P.affw()[(size_t)r16 * MROWS + R0 + 4 * kq + jj] = pe / den;
            }
        }
        blk = nxt;
    }
}

__device__ __forceinline__ void phase_topk(const Params& P, int bid, int nb, unsigned* lds, int nprob = 64) {
    unsigned* hist = lds; unsigned* misc = lds + 256; unsigned* wsa = lds + 272; unsigned* wsb = lds + 288;
    const int tid = opaque_tid(), wid = tid >> 6, lane = tid & 63;
    for (int p = bid; p < nprob; p += nb) {
        const int set = p >> 4, e = p & 15;
        const int n = set < 2 ? SEQ : CTXL, C = n >> 3;
        const int r0 = set < 2 ? set * SEQ : NLAT + (set - 2) * CTXL;
        const int slot0 = set < 2 ? set * 2048 : 4096 + (set - 2) * 32;
        unsigned key[32];
#pragma unroll
        for (int i4 = 0; i4 < 8; ++i4) { const int idx = tid * 32 + i4 * 4;
            f32x4 v = (f32x4){0.f, 0.f, 0.f, 0.f}; if (idx < n) v = *(const f32x4*)(P.aff() + (size_t)e * MROWS + r0 + idx);
#pragma unroll
            for (int jj = 0; jj < 4; ++jj) key[i4 * 4 + jj] = idx < n ? (__float_as_uint(v[jj]) + 1u) : 0u; }
        unsigned T = 0u;
        for (int bit = 29; bit >= 0; --bit) {
            const unsigned cand = T | (1u << bit);
            unsigned wc = 0u;
#pragma unroll
            for (int i = 0; i < 32; ++i) wc += (unsigned)__builtin_popcountll(__builtin_amdgcn_ballot_w64(key[i] >= cand));
            unsigned* cb = misc + ((bit & 1) << 3);
            if (lane == 0) cb[wid] = wc;
            __syncthreads();
            unsigned tot = 0u;
#pragma unroll
            for (int w = 0; w < 8; ++w) tot += cb[w];
            if (tot >= (unsigned)C) T = cand;
        }
        unsigned cg = 0u, ce = 0u;
#pragma unroll
        for (int i = 0; i < 32; ++i) { cg += key[i] > T ? 1u : 0u; ce += key[i] == T ? 1u : 0u; }
        unsigned ig = cg, ie = ce;
#pragma unroll
        for (int o = 1; o < 64; o <<= 1) { const unsigned a = shup(ig, o, lane), b = shup(ie, o, lane); if (lane >= o) { ig += a; ie += b; } }
        if (lane == 63) { wsa[wid] = ig; wsb[wid] = ie; }
        __syncthreads();
        unsigned bg = 0u, be = 0u, totg = 0u;
#pragma unroll
        for (int w = 0; w < 8; ++w) { const unsigned ga = wsa[w]; totg += ga; if (w < wid) { bg += ga; be += wsb[w]; } }
        const unsigned krem = (unsigned)C - totg;
        unsigned pg = bg + ig - cg, pe = be + ie - ce;
#pragma unroll
        for (int i4 = 0; i4 < 8; ++i4) {
            int iv[4];
#pragma unroll
            for (int jj = 0; jj < 4; ++jj) {
                const int i = i4 * 4 + jj, idx = tid * 32 + i;
                bool sel = false; unsigned rank = 0u;
                if (key[i] > T) { sel = true; rank = pg + (pe < krem ? pe : krem); ++pg; }
                else if (key[i] == T && key[i] != 0u) { if (pe < krem) { sel = true; rank = pg + pe; } ++pe; }
                if (sel) P.rowidx()[e * SLOTS_PAD + slot0 + (int)rank] = r0 + idx;
                iv[jj] = sel ? slot0 + (int)rank : -1;
            }
            if (tid * 32 + i4 * 4 < n) *(int4*)(P.inv() + (size_t)e * MROWS + r0 + tid * 32 + i4 * 4) = make_int4(iv[0], iv[1], iv[2], iv[3]);
        }
        if (set == 3) for (int i = SLOTS + tid; i < SLOTS_PAD; i += NTHR) P.rowidx()[e * SLOTS_PAD + i] = 0;
        __syncthreads();
    }
}

#define XB_TMO      128
#define XB_XCNT(j)  (256  + 64 * (j))
#define XB_XSUB(j)  (1280 + 64 * (j))
#define XB_XGEN(j)  (2304 + 64 * (j))
#define XB_TOP      3328
#define XB_TOPGEN   3392
#define XCD_BAR_WORDS 3456
#define XB_SPIN_CAP (1u << 18)
__device__ __forceinline__ unsigned xb_ld(unsigned* p)              { return __hip_atomic_load(p, __ATOMIC_RELAXED, __HIP_MEMORY_SCOPE_AGENT); }
__device__ __forceinline__ unsigned xb_add(unsigned* p, unsigned v) { return __hip_atomic_fetch_add(p, v, __ATOMIC_RELAXED, __HIP_MEMORY_SCOPE_AGENT); }
__device__ __forceinline__ unsigned xb_xcc_id() { return (unsigned)__builtin_amdgcn_s_getreg((3 << 11) | 20) & 0xFu; }
#define XB_SPIN(cond, bar) do { unsigned _sp = 0; while (cond) { __builtin_amdgcn_s_sleep(1); \
    if ((++_sp & 255u) == 0u) { if (xb_ld(&(bar)[XB_TMO])) break; if (_sp > XB_SPIN_CAP) { atomicAdd(&(bar)[XB_TMO], 1u); break; } } } } while (0)
struct XcdBarrier { unsigned* bar; unsigned x; volatile LAS unsigned* st; };
__device__ __forceinline__ XcdBarrier xcd_barrier_post(unsigned* bar, volatile LAS unsigned* st) {
    XcdBarrier b; b.bar = bar; b.x = xb_xcc_id(); b.st = st;
    if (threadIdx.x == 0) (void)xb_add(&bar[XB_XCNT(b.x)], 1u);
    return b;
}
__device__ __forceinline__ void xcd_barrier_complete(unsigned* bar, unsigned x, unsigned& nloc, unsigned& nx) {
    const unsigned G = gridDim.x * gridDim.y * gridDim.z;
    unsigned sum, cnt, mine, sp = 0u;
    for (;;) {
        sum = 0u; cnt = 0u; mine = 0u;
#pragma unroll
        for (unsigned j = 0; j < 16; ++j) { const unsigned c = xb_ld(&bar[XB_XCNT(j)]); sum += c; cnt += (c > 0u) ? 1u : 0u; mine = (j == x) ? c : mine; }
        if (sum == G) break;
        __builtin_amdgcn_s_sleep(1);
        if ((++sp & 255u) == 0u) { if (xb_ld(&bar[XB_TMO])) break; if (sp > XB_SPIN_CAP) { atomicAdd(&bar[XB_TMO], 1u); break; } }
    }
    nloc = mine > 0u ? mine : 1u; nx = cnt > 0u ? cnt : 1u;
}
__device__ __forceinline__ void xcd_barrier(const XcdBarrier& b) {
    asm volatile("s_waitcnt vmcnt(0)" ::: "memory");
    __syncthreads();
    if (threadIdx.x == 0) {
        unsigned* bar = b.bar; asm volatile("" : "+s"(bar));
        const unsigned bx = (unsigned)__builtin_amdgcn_readfirstlane((int)xb_xcc_id());
        __builtin_amdgcn_s_waitcnt(0);
        unsigned nloc = b.st[0], nx = b.st[1];
        if (nloc == 0u) { xcd_barrier_complete(bar, bx, nloc, nx); b.st[0] = nloc; b.st[1] = nx; }
        const unsigned old = xb_add(&bar[XB_XSUB(bx)], 1u);
        const unsigned gen = old / nloc;
        if (old + 1u == (gen + 1u) * nloc) {
            __builtin_amdgcn_fence(__ATOMIC_RELEASE, "agent");
            asm volatile("s_waitcnt vmcnt(0)" ::: "memory");
            const unsigned og = xb_add(&bar[XB_TOP], 1u);
            const unsigned tg = og / nx;
            if (og + 1u == (tg + 1u) * nx) xb_add(&bar[XB_TOPGEN], 1u);
            else XB_SPIN(xb_ld(&bar[XB_TOPGEN]) == tg, bar);
            __builtin_amdgcn_fence(__ATOMIC_ACQUIRE, "agent");
            xb_add(&bar[XB_XGEN(bx)], 1u);
            asm volatile("s_waitcnt vmcnt(0)" ::: "memory");
        } else {
            XB_SPIN(xb_ld(&bar[XB_XGEN(bx)]) == gen, bar);
            __builtin_amdgcn_fence(__ATOMIC_ACQUIRE, "agent");
            asm volatile("s_waitcnt vmcnt(0)" ::: "memory");
        }
    }
    __syncthreads();
}

namespace fg {
constexpr int BM = 256, BK = 64, HALF = 128, HTB = HALF * BK * 2, STAGE_BYTES = 8 * HTB;
__device__ __forceinline__ int lds_byte(int r, int c) { const int st = (r >> 4) * 2 + (c >> 5), rr = r & 15, cc = c & 31, ob = rr * 64 + cc * 2; return st * 1024 + (ob ^ (((ob >> 9) & 1) << 5)); }
__device__ __forceinline__ void stage_rc(int b, int& R, int& C) { const int st = b / 1024, sb = b % 1024, swz = sb ^ (((sb >> 9) & 1) << 5); R = (st >> 1) * 16 + swz / 64; C = (st & 1) * 32 + (swz % 64) / 2; }
__device__ __forceinline__ int perm32(int rho) { const int n = rho >> 4, i = rho & 15; return 8 * (i >> 2) + 4 * n + (i & 3); }
#define KDUP 0
struct Unit { int e, pm, pn; int skip; };
__device__ __forceinline__ void xcd_order(int i, int& T) { const int c = blockIdx.x; T = i * (int)gridDim.x + c; }

template <class PR>
__device__ __forceinline__ void gemm_phase(LAS unsigned char* lds, const PR& S, int wv) {
    const int tid = opaque_tid_(wv), wid = __builtin_amdgcn_readfirstlane(tid >> 6), lane = tid & 63, wr = wid >> 2, wc = wid & 3, fr = lane & 15, fq = lane >> 4;
    constexpr int K = PR::K, nt = K / BK;
    unsigned voffB[2];
#pragma unroll
    for (int i = 0; i < 2; ++i) { int R, C; stage_rc(tid * 16 + i * 8192, R, C); const int Rb = (R & ~31) + perm32(R & 31); voffB[i] = (unsigned)(Rb * PR::LDB + C) * 2u; }
    const size_t kstep = (size_t)(BK * 2);
    const size_t hB = S.hstepB();
    const unsigned ldsw = (unsigned)wid * 1024u;
    const int aoff = lds_byte(wr * 64 + fr, fq * 8), boff = lds_byte(wc * 32 + fr, fq * 8);
#define FG_SA(b, h) (((b) * 2 + (h)) * HTB)
#define FG_SB(b, h) ((4 + (b) * 2 + (h)) * HTB)
#define FG_STAGE(bufoff, gbase, voff) do { _Pragma("unroll") for (int _i = 0; _i < 2; ++_i) \
        __builtin_amdgcn_global_load_lds((const unsigned*)((const char*)(gbase) + (voff)[_i]), (LAS unsigned*)(lds + (bufoff) + ldsw + _i * 8192), 16, 0, 0); } while (0)
#define FG_LDA(dst, b, h) do { _Pragma("unroll") for (int m = 0; m < 4; ++m) _Pragma("unroll") for (int k = 0; k < 2; ++k) dst[m][k] = *(const LAS f16x8*)(lds + FG_SA(b, h) + aoff + m * 2048 + k * 1024); } while (0)
#define FG_LDB(dst, b, h) do { _Pragma("unroll") for (int n = 0; n < 2; ++n) _Pragma("unroll") for (int k = 0; k < 2; ++k) dst[n][k] = *(const LAS f16x8*)(lds + FG_SB(b, h) + boff + n * 2048 + k * 1024); } while (0)
#define FG_MMA(ai, bj, At, Bt) do { __builtin_amdgcn_s_setprio(1); _Pragma("unroll") for (int m = 0; m < 4; ++m) _Pragma("unroll") for (int n = 0; n < 2; ++n) _Pragma("unroll") for (int k = 0; k < 2; ++k) \
        acc[ai][bj][m][n] = __builtin_amdgcn_mfma_f32_16x16x32_f16(Bt[n][k], At[m][k], acc[ai][bj][m][n], 0, 0, 0); __builtin_amdgcn_s_setprio(0); } while (0)
#define FG_WAIT_V(n) asm volatile("s_waitcnt vmcnt(" #n ")" ::: "memory")
#define FG_WAIT_L(n) asm volatile("s_waitcnt lgkmcnt(" #n ")" ::: "memory")
#define FG_BAR __builtin_amdgcn_s_barrier()
#define FG_SCHED __builtin_amdgcn_sched_barrier(0)
    Unit cur, nxt; int ui = 0;
    if (!S.next(0, cur)) return;
    f32x4 acc[2][2][4][2];
#pragma unroll
    for (int a = 0; a < 2; ++a)
#pragma unroll
        for (int b = 0; b < 2; ++b)
#pragma unroll
            for (int m = 0; m < 4; ++m)
#pragma unroll
                for (int n = 0; n < 2; ++n) acc[a][b][m][n] = (f32x4){0.f, 0.f, 0.f, 0.f};
    f16x8 At[4][2], B0[2][2], B1[2][2];
    unsigned vA[2][2], vN[2][2];
    { int Rr[2], Cc[2]; stage_rc(tid * 16, Rr[0], Cc[0]); stage_rc(tid * 16 + 8192, Rr[1], Cc[1]); S.a_voff(cur, Rr, Cc, vA); }
#pragma unroll
    for (int h = 0; h < 2; ++h)
#pragma unroll
        for (int i = 0; i < 2; ++i) { asm volatile("" : "+v"(vA[h][i])); vN[h][i] = vA[h][i]; }
    const char* cA = S.a_base(cur); const char* cB = S.b_base(cur);
    FG_STAGE(FG_SB(0, 0), cB, voffB); FG_STAGE(FG_SA(0, 0), cA, vA[0]); FG_STAGE(FG_SB(0, 1), cB + hB, voffB); FG_STAGE(FG_SA(0, 1), cA, vA[1]);
    if (wr == 1) FG_BAR;
    FG_WAIT_V(4); FG_BAR;
    FG_STAGE(FG_SB(1, 0), cB + kstep, voffB); FG_STAGE(FG_SA(1, 0), cA + kstep, vA[0]); FG_STAGE(FG_SB(1, 1), cB + hB + kstep, voffB);
    FG_WAIT_V(6); FG_BAR;
    for (;;) {
        const bool has_next = S.next(ui + 1, nxt);
        const char* nA = has_next ? S.a_base(nxt) : cA; const char* nB = has_next ? S.b_base(nxt) : cB;
        if (has_next) { int Rr[2], Cc[2]; int t2 = tid; asm volatile("" : "+v"(t2)); stage_rc(t2 * 16, Rr[0], Cc[0]); stage_rc(t2 * 16 + 8192, Rr[1], Cc[1]); S.a_voff(nxt, Rr, Cc, vN);
#pragma unroll
            for (int h = 0; h < 2; ++h)
#pragma unroll
                for (int i = 0; i < 2; ++i) asm volatile("" : "+v"(vN[h][i])); }
#pragma unroll 1
        for (int t = 0; t < nt; t += 2) {
            const bool last = (t == nt - 2);
            const char* a1 = cA + (size_t)(t + 1) * kstep;
            const char* a2 = last ? nA : cA + (size_t)(t + 2) * kstep; const char* b2 = last ? nB : cB + (size_t)(t + 2) * kstep;
            const char* a3 = a2 + kstep; const char* b3 = b2 + kstep;
            unsigned v2[2][2];
#pragma unroll
            for (int h = 0; h < 2; ++h)
#pragma unroll
                for (int i = 0; i < 2; ++i) v2[h][i] = last ? vN[h][i] : vA[h][i];
            FG_LDB(B0, 0, 0); FG_SCHED; FG_LDA(At, 0, 0); FG_STAGE(FG_SA(1, 1), a1, vA[1]);
            FG_WAIT_L(8); FG_BAR; FG_WAIT_L(0); FG_MMA(0, 0, At, B0); FG_BAR; FG_SCHED;
            FG_LDB(B1, 0, 1); FG_STAGE(FG_SB(0, 0), b2, voffB);
            FG_BAR; FG_WAIT_L(0); FG_MMA(0, 1, At, B1); FG_BAR;
            FG_LDA(At, 0, 1); FG_STAGE(FG_SA(0, 0), a2, v2[0]);
            FG_BAR; FG_WAIT_L(0); FG_MMA(1, 0, At, B0); FG_BAR; FG_SCHED;
            FG_STAGE(FG_SB(0, 1), b2 + hB, voffB);
            FG_WAIT_V(6); FG_BAR; FG_MMA(1, 1, At, B1); FG_BAR;
            FG_LDB(B0, 1, 0); FG_SCHED; FG_LDA(At, 1, 0); FG_STAGE(FG_SA(0, 1), a2, v2[1]);
            FG_WAIT_L(8); FG_BAR; FG_WAIT_L(0); FG_MMA(0, 0, At, B0); FG_BAR; FG_SCHED;
            FG_LDB(B1, 1, 1); FG_STAGE(FG_SB(1, 0), b3, voffB);
            FG_BAR; FG_WAIT_L(0); FG_MMA(0, 1, At, B1); FG_BAR;
            FG_LDA(At, 1, 1); FG_STAGE(FG_SA(1, 0), a3, v2[0]);
            FG_BAR; FG_WAIT_L(0); FG_MMA(1, 0, At, B0); FG_BAR; FG_SCHED;
            FG_STAGE(FG_SB(1, 1), b3 + hB, voffB);
            FG_WAIT_V(6); FG_BAR; FG_MMA(1, 1, At, B1); FG_BAR;
        }
        if (!KDUP || !cur.skip) S.epi(acc, cur, wr, wc, fr, fq);
        if (!has_next) break;
#pragma unroll
        for (int a = 0; a < 2; ++a)
#pragma unroll
            for (int b = 0; b < 2; ++b)
#pragma unroll
                for (int m = 0; m < 4; ++m)
#pragma unroll
                    for (int n = 0; n < 2; ++n) acc[a][b][m][n] = (f32x4){0.f, 0.f, 0.f, 0.f};
        cur = nxt; cA = nA; cB = nB; ++ui;
#pragma unroll
        for (int h = 0; h < 2; ++h)
#pragma unroll
            for (int i = 0; i < 2; ++i) vA[h][i] = vN[h][i];
    }
    FG_WAIT_V(0);
    if (wr == 0) FG_BAR;
    FG_BAR;
#undef FG_SA
#undef FG_SB
#undef FG_STAGE
#undef FG_LDA
#undef FG_LDB
#undef FG_MMA
#undef FG_WAIT_V
#undef FG_WAIT_L
#undef FG_BAR
#undef FG_SCHED
}

__device__ __forceinline__ f16x8 pack8(const f32x4 a, const f32x4 b) { return (f16x8){(f16)a[0], (f16)a[1], (f16)a[2], (f16)a[3], (f16)b[0], (f16)b[1], (f16)b[2], (f16)b[3]}; }

template <int K_, int LDA_, int LDB_> struct PRBase {
    static constexpr int K = K_, LDA = LDA_, LDB = LDB_;
    __device__ __forceinline__ void plain_voff(const int (&R)[2], const int (&C)[2], unsigned (&v)[2][2]) const {
#pragma unroll
        for (int h = 0; h < 2; ++h)
#pragma unroll
            for (int i = 0; i < 2; ++i) v[h][i] = (unsigned)((h * HALF + R[i]) * LDA + C[i]) * 2u;
    }
};
struct PRGateUp : PRBase<1024, 1024, 1024> {
    const f16* H; const int* rowidx; const f16* W; f16* act; int nunits; int bid; int rt;
    __device__ __forceinline__ size_t hstepB() const { return (size_t)DEXP * DM * 2; }
    __device__ __forceinline__ bool next(int i, Unit& u) const { const int ii = KDUP ? (i >> 1) : i; const int T = ii * (int)gridDim.x + bid; u.skip = KDUP ? ((i & 1) == 0) : 0; if (T >= nunits) return false;
        if (rt == 16 && gridDim.x == 256) { const int x = bid & 7, jj = bid >> 3; u.e = ii; u.pm = (x >> 1) * 4 + (jj >> 3); u.pn = (x & 1) * 8 + (jj & 7); return true; }
        const int per = rt * 16; u.e = T / per; const int t = T % per; u.pm = t >> 4; u.pn = t & 15; return true; }
    __device__ __forceinline__ const char* a_base(const Unit&) const { return (const char*)H; }
    __device__ __forceinline__ void a_voff(const Unit& u, const int (&R)[2], const int (&C)[2], unsigned (&v)[2][2]) const {
        const int* ri = rowidx + u.e * SLOTS_PAD + u.pm * BM;
#pragma unroll
        for (int h = 0; h < 2; ++h)
#pragma unroll
            for (int i = 0; i < 2; ++i) { const int g = ri[h * HALF + R[i]]; v[h][i] = (unsigned)(g * LDA + C[i]) * 2u; }
    }
    __device__ __forceinline__ const char* b_base(const Unit& u) const { return (const char*)(W + ((size_t)u.e * 2 * DEXP + (size_t)u.pn * HALF) * DM); }
    __device__ __forceinline__ void epi(const f32x4 (&acc)[2][2][4][2], const Unit& u, int wr, int wc, int fr, int fq) const {
        f16* base = act + ((size_t)u.e * SLOTS_PAD + (size_t)u.pm * BM + wr * 64 + fr) * DEXP + u.pn * HALF + wc * 32 + fq * 8;
#pragma unroll
        for (int ai = 0; ai < 2; ++ai)
#pragma unroll
            for (int m = 0; m < 4; ++m) {
                f32x4 o0, o1;
#pragma unroll
                for (int j = 0; j < 4; ++j) { o0[j] = silu_f(acc[ai][0][m][0][j]) * acc[ai][1][m][0][j]; o1[j] = silu_f(acc[ai][0][m][1][j]) * acc[ai][1][m][1][j]; }
                if (u.e < 8) __builtin_nontemporal_store(rm8(pack8(o0, o1)), (f16x8*)(base + (size_t)(ai * HALF + m * 16) * DEXP));
                else *(f16x8*)(base + (size_t)(ai * HALF + m * 16) * DEXP) = rm8(pack8(o0, o1));
            }
    }
};
struct PRDown : PRBase<2048, 2048, 2048> {
    const f16* act; const f16* W; f16* y; int nunits; int bid; int rt;
    __device__ __forceinline__ size_t hstepB() const { return (size_t)HALF * DEXP * 2; }
    __device__ __forceinline__ bool next(int i, Unit& u) const { const int ii = KDUP ? (i >> 1) : i; const int T = ii * (int)gridDim.x + bid; u.skip = KDUP ? ((i & 1) == 0) : 0; if (T >= nunits) return false;
        if (rt == 16 && gridDim.x == 256) { const int x = bid & 7, jj = bid >> 3; u.e = 15 - (ii * 4 + (x >> 1)); u.pm = (x & 1) * 8 + (jj >> 2); u.pn = jj & 3; return true; }
        const int per = rt * 4; u.e = T / per; const int t = T % per; u.pm = t >> 2; u.pn = t & 3; return true; }
    __device__ __forceinline__ const char* a_base(const Unit& u) const { return (const char*)(act + ((size_t)u.e * SLOTS_PAD + (size_t)u.pm * BM) * DEXP); }
    __device__ __forceinline__ void a_voff(const Unit&, const int (&R)[2], const int (&C)[2], unsigned (&v)[2][2]) const { plain_voff(R, C, v); }
    __device__ __forceinline__ const char* b_base(const Unit& u) const { return (const char*)(W + ((size_t)u.e * DM + (size_t)u.pn * BM) * DEXP); }
    __device__ __forceinline__ void epi(const f32x4 (&acc)[2][2][4][2], const Unit& u, int wr, int wc, int fr, int fq) const {
        f16* base = y + ((size_t)u.e * SLOTS_PAD + (size_t)u.pm * BM + wr * 64 + fr) * DM + u.pn * BM + wc * 32 + fq * 8;
#pragma unroll
        for (int ai = 0; ai < 2; ++ai)
#pragma unroll
            for (int m = 0; m < 4; ++m)
#pragma unroll
                for (int bj = 0; bj < 2; ++bj) *(f16x8*)(base + (size_t)(ai * HALF + m * 16) * DM + bj * HALF) = pack8(acc[ai][bj][m][0], acc[ai][bj][m][1]);
    }
};
template <int K_> struct PRDense : PRBase<K_, 1024, K_> {
    const f16* A; const f16* W; f16* O0; f16* O1; f16* O2; int ncol; int mode; int bid; int npan; int kvx;
    __device__ __forceinline__ size_t hstepB() const { return (size_t)HALF * K_ * 2; }
    __device__ __forceinline__ bool next(int i, Unit& u) const { const int ii = KDUP ? (i >> 1) : i; int T = ii * (int)gridDim.x + bid; if (gridDim.x == 256) T = (ii * 8 + (bid & 7)) * 32 + (bid >> 3);
        u.skip = KDUP ? ((i & 1) == 0) : 0; const int nu = npan * ncol; if (T >= nu + kvx) return false; u.e = 0; if (T < nu) { u.pm = T / ncol; u.pn = T % ncol; } else { const int x = T - nu; u.pm = npan + (x >> 1); u.pn = 4 + (x & 1); } return true; }
    __device__ __forceinline__ const char* a_base(const Unit& u) const { return (const char*)(A + (size_t)u.pm * BM * 1024 + (mode == 2 ? u.pn * 256 : 0)); }
    __device__ __forceinline__ void a_voff(const Unit&, const int (&R)[2], const int (&C)[2], unsigned (&v)[2][2]) const { this->plain_voff(R, C, v); }
    __device__ __forceinline__ const char* b_base(const Unit& u) const { return (const char*)(W + (size_t)u.pn * BM * K_); }
    const float* qn; const float* kn; const float* rope; LAS float* xs; int lane;
    __device__ __forceinline__ void epi(const f32x4 (&acc)[2][2][4][2], const Unit& u, int wr, int wc, int fr, int fq) const {
        f16* base; int ld;
        const int row = u.pm * BM + wr * 64 + fr, colw = wc * 32 + fq * 8;
        if (mode == 1) { if (u.pn < 4) { base = O0 + (size_t)row * 1024 + u.pn * BM + colw; ld = 1024; } else if (u.pn == 4) { base = O1 + (size_t)row * 256 + colw; ld = 256; } else { base = O2 + (size_t)row * 256 + colw; ld = 256; } }
        else { base = O0 + (size_t)row * 1024 + u.pn * BM + colw; ld = 1024; }
        if (mode == 1 && u.pn < 5) {
            float ssq[2][4][2];
#pragma unroll
            for (int ai = 0; ai < 2; ++ai)
#pragma unroll
                for (int m = 0; m < 4; ++m)
#pragma unroll
                    for (int bj = 0; bj < 2; ++bj) { const f32x4 a = acc[ai][bj][m][0], b = acc[ai][bj][m][1];
                        float t = (a[0] * a[0] + a[1] * a[1]) + (a[2] * a[2] + a[3] * a[3]) + (b[0] * b[0] + b[1] * b[1]) + (b[2] * b[2] + b[3] * b[3]);
                        t += shx<16>(t, lane); t += shx<32>(t, lane); ssq[ai][m][bj] = t; }
            LAS float* mine = xs + ((wr * 4 + wc) * 16) * 16 + fr; const LAS float* theirs = xs + ((wr * 4 + (wc ^ 1)) * 16) * 16 + fr;
            if (fq == 0) {
#pragma unroll
                for (int ai = 0; ai < 2; ++ai)
#pragma unroll
                    for (int m = 0; m < 4; ++m)
#pragma unroll
                        for (int bj = 0; bj < 2; ++bj) mine[(ai * 8 + m * 2 + bj) * 16] = ssq[ai][m][bj];
            }
            asm volatile("s_waitcnt lgkmcnt(0)" ::: "memory"); __builtin_amdgcn_s_barrier(); asm volatile("" ::: "memory");
            const bool isq = u.pn < 4, lat = u.pm < 128;
            const float* nw = (isq ? qn : kn) + (wc & 1) * 32 + fq * 8;
            const f32x4 w0 = *(const f32x4*)nw, w1 = *(const f32x4*)(nw + 4);
            const float qs = isq ? 0.125f * 1.4426950408889634f : 1.0f;
#pragma unroll
            for (int ai = 0; ai < 2; ++ai)
#pragma unroll
                for (int m = 0; m < 4; ++m) {
                    f32x4 c0 = (f32x4){1.f, 1.f, 1.f, 1.f}, s0 = (f32x4){0.f, 0.f, 0.f, 0.f};
                    if (lat) { const int t = (row + ai * HALF + m * 16) & (SEQ - 1); const int pos = (wc & 1) ? (t & 63) : (t >> 6);
                        const float* tb = rope + (size_t)(pos * 16 + fq * 4) * 2; const f32x4 ta = *(const f32x4*)tb, tb2 = *(const f32x4*)(tb + 4);
                        c0 = (f32x4){ta[0], ta[2], tb2[0], tb2[2]}; s0 = (f32x4){ta[1], ta[3], tb2[1], tb2[3]}; }
#pragma unroll
                    for (int bj = 0; bj < 2; ++bj) {
                        const float tot = ssq[ai][m][bj] + theirs[(ai * 8 + m * 2 + bj) * 16];
                        const float rstd = rsqrtf(tot * (1.0f / 64.0f) + 1e-6f) * qs;
                        f32x4 a = acc[ai][bj][m][0] * rstd * w0, b = acc[ai][bj][m][1] * rstd * w1;
                        const f32x4 ra = (f32x4){a[0] * c0[0] - a[1] * s0[0], a[0] * s0[0] + a[1] * c0[0], a[2] * c0[1] - a[3] * s0[1], a[2] * s0[1] + a[3] * c0[1]};
                        const f32x4 rb = (f32x4){b[0] * c0[2] - b[1] * s0[2], b[0] * s0[2] + b[1] * c0[2], b[2] * c0[3] - b[3] * s0[3], b[2] * s0[3] + b[3] * c0[3]};
                        *(f16x8*)(base + (size_t)(ai * HALF + m * 16) * ld + bj * HALF) = rm8(pack8(ra, rb));
                    }
                }
            return;
        }
#pragma unroll
        for (int ai = 0; ai < 2; ++ai)
#pragma unroll
            for (int m = 0; m < 4; ++m)
#pragma unroll
                for (int bj = 0; bj < 2; ++bj) { const f16x8 o = pack8(acc[ai][bj][m][0], acc[ai][bj][m][1]); *(f16x8*)(base + (size_t)(ai * HALF + m * 16) * ld + bj * HALF) = (mode == 1) ? rm8(o) : o; }
    }
};
}

struct CvtJob { const float* src; f16* dst; int K, N, k0, n0; };
__device__ __forceinline__ bool cvt_job(const Params& P, int l, int u, CvtJob& jb, bool experts) {
    const int j = l >> 1;
    const int nexp = experts ? NEXP * 3 * 128 : 0;
    const int nmix = (l & 1) == 0 ? 16 : (96 + 64);
    if (u >= nexp + nmix) return false;
    if (u < nexp) {
        const int e = u / 384, r = u % 384, which = r >> 7, t = r & 127;
        if (which < 2) { jb.src = (which == 0 ? P.w_gate : P.w_up) + ((size_t)l * NEXP + e) * DM * DEXP; jb.dst = P.Wgu() + ((size_t)e * 2 + which) * DEXP * DM; jb.K = DM; jb.N = DEXP; jb.k0 = (t >> 4) * 128; jb.n0 = (t & 15) * 128; }
        else { jb.src = P.w_down + ((size_t)l * NEXP + e) * DEXP * DM; jb.dst = P.Wd() + (size_t)e * DM * DEXP; jb.K = DEXP; jb.N = DM; jb.k0 = (t >> 3) * 128; jb.n0 = (t & 7) * 128; }
    } else {
        const int t = u - nexp;
        if ((l & 1) == 0) { const int g = t >> 2, tt = t & 3; jb.src = P.pool_w + (size_t)(j * 4 + g) * 65536; jb.dst = P.Wmix() + (size_t)g * 65536; jb.K = 256; jb.N = 256; jb.k0 = (tt >> 1) * 128; jb.n0 = (tt & 1) * 128; }
        else if (t < 96) { jb.src = P.w_qkv + (size_t)j * DM * QKVD; jb.dst = P.Wmix(); jb.K = DM; jb.N = QKVD; jb.k0 = (t / 12) * 128; jb.n0 = (t % 12) * 128; }
        else { const int tt = t - 96; jb.src = P.w_o + (size_t)j * DM * DM; jb.dst = P.Wmix() + (size_t)QKVD * DM; jb.K = DM; jb.N = DM; jb.k0 = (tt >> 3) * 128; jb.n0 = (tt & 7) * 128; }
    }
    return true;
}
__device__ __forceinline__ void phase_convert(const Params& P, int l, int bid, int nb, f16* tile, bool experts = true) {
    const int tid = opaque_tid();
    CvtJob jb;
    int u = bid;
    bool have = cvt_job(P, l, u, jb, experts);
    f32x4 r[8];
    if (have) {
#pragma unroll
        for (int p = 0; p < 8; ++p) { const int id = tid + p * NTHR, kr = id >> 5, c4 = (id & 31) * 4; r[p] = __builtin_nontemporal_load((const f32x4*)(jb.src + (size_t)(jb.k0 + kr) * jb.N + jb.n0 + c4)); }
    }
    while (have) {
        __syncthreads();
#pragma unroll
        for (int p = 0; p < 8; ++p) { const int id = tid + p * NTHR, kr = id >> 5, c4 = (id & 31) * 4; *(f16x4*)(tile + kr * 136 + c4) = pk4(r[p]); }
        __syncthreads();
        const CvtJob cur = jb;
        u += nb; have = cvt_job(P, l, u, jb, experts);
        if (have) {
#pragma unroll
            for (int p = 0; p < 8; ++p) { const int id = tid + p * NTHR, kr = id >> 5, c4 = (id & 31) * 4; r[p] = __builtin_nontemporal_load((const f32x4*)(jb.src + (size_t)(jb.k0 + kr) * jb.N + jb.n0 + c4)); }
        }
        const int n = tid & 127, kg = (tid >> 7) * 32;
        f16* dp = cur.dst + (size_t)(cur.n0 + n) * cur.K + cur.k0 + kg;
#pragma unroll
        for (int i = 0; i < 4; ++i) { f16x8 o;
#pragma unroll
            for (int e = 0; e < 8; ++e) o[e] = tile[(kg + i * 8 + e) * 136 + n];
            *(f16x8*)(dp + i * 8) = rm8(o); }
    }
}
template <bool GATEUP, bool CTX>
__device__ __forceinline__ void phase_cvt_ctx(const Params& P, int l, int bid, int nb, f16* tile, int sel = -1, bool alt = false) {
    const int tid = opaque_tid(), wid = P.wv, lane = tid & 63, r16 = lane & 15, kq = lane >> 4;
    constexpr int NC = GATEUP ? 128 : 64;
    constexpr int KT = GATEUP ? 8 : 16, K = GATEUP ? DM : DEXP, N = GATEUP ? DEXP : DM, NB = N / NC;
    constexpr int NT = GATEUP ? 2 * KT : KT;
    const int sel_ = (GATEUP && !CTX) ? sel : -1; const int ntr = (GATEUP && sel_ < 0) ? NT : KT;
    constexpr int TS = NC + 4, TW = 128 * TS;
    constexpr int NLD = NC / 16;
    constexpr int WPC = 8 / (NC / 16);
    constexpr int NRB = 4 / WPC;
    const int cb = wid % (NC / 16), rb0 = (wid / (NC / 16)) * NRB;
    f16* asl = tile + 2 * TW;
    for (int job = bid; job < NEXP * NB; job += nb) {
        const int e = job / NB, nbk = job % NB;
        const f16* ap[2];
        if (CTX) {
#pragma unroll
            for (int p = 0; p < 2; ++p) { const int row = (tid >> 4) + p * 32;
                if (GATEUP) ap[p] = P.H() + (size_t)P.rowidx()[e * SLOTS_PAD + 4096 + row] * DM + (tid & 15) * 8;
                else ap[p] = P.act() + ((size_t)e * SLOTS_PAD + 4096 + row) * DEXP + (tid & 15) * 8; }
        }
        f32x4 acc[2][NRB];
#pragma unroll
        for (int w = 0; w < 2; ++w)
#pragma unroll
            for (int rb = 0; rb < NRB; ++rb) acc[w][rb] = (f32x4){0.f, 0.f, 0.f, 0.f};
        const float* srcs[2]; f16* dsts[2];
        if (GATEUP) { const size_t wo = ((size_t)l * NEXP + e) * DM * DEXP; srcs[0] = P.w_gate + wo; srcs[1] = P.w_up + wo; dsts[0] = P.Wgu() + (alt ? (OFF_WGU3 - OFF_WGU) / 2 : 0) + ((size_t)e * 2) * DEXP * DM; dsts[1] = dsts[0] + (size_t)DEXP * DM; }
        else { srcs[0] = P.w_down + ((size_t)l * NEXP + e) * DEXP * DM; srcs[1] = srcs[0]; dsts[0] = P.Wd() + (alt ? (OFF_WD3 - OFF_WD) / 2 : 0) + (size_t)e * DM * DEXP; dsts[1] = dsts[0]; }
        f32x4 r[2][NLD]; f16x8 ar[2][2];
        const unsigned ldoff = (unsigned)(((tid / (NC / 4)) * N + (tid % (NC / 4)) * 4) * 4);
#define CV_LOAD(ti, slot) do { const int which_ = GATEUP ? (sel_ >= 0 ? sel_ : ((ti) & 1)) : 0, kt_ = (GATEUP && sel_ < 0) ? ((ti) >> 1) : (ti); const char* sp_ = (const char*)(srcs[which_] + (size_t)(kt_ * 128) * N + nbk * NC); \
            _Pragma("unroll") for (int p = 0; p < NLD; ++p) r[slot][p] = __builtin_nontemporal_load((const f32x4*)(sp_ + (size_t)p * (NTHR / (NC / 4)) * N * 4 + ldoff)); \
            if (CTX) { _Pragma("unroll") for (int p = 0; p < 2; ++p) ar[slot][p] = *(const f16x8*)(ap[p] + kt_ * 128); } } while (0)
#define CV_TILE(ti, slot) do { const int which = GATEUP ? (sel_ >= 0 ? sel_ : ((ti) & 1)) : 0, kt = (GATEUP && sel_ < 0) ? ((ti) >> 1) : (ti); \
            f16* tl = tile + (slot) * TW; f16* al = asl + (slot) * (64 * 128); \
            _Pragma("unroll") for (int p = 0; p < NLD; ++p) { const int id = tid + p * NTHR, kr = id / (NC / 4), c4 = (id % (NC / 4)) * 4; *(f16x4*)(tl + kr * TS + c4) = pk4(r[slot][p]); } \
            if (CTX) { _Pragma("unroll") for (int p = 0; p < 2; ++p) { const int row = (tid >> 4) + p * 32; *(f16x8*)(al + row * 128 + (((tid & 15) ^ (row & 15)) * 8)) = ar[slot][p]; } } \
            if ((ti) + 2 < ntr) CV_LOAD((ti) + 2, slot); \
            asm volatile("s_waitcnt lgkmcnt(0)" ::: "memory"); __builtin_amdgcn_s_barrier(); asm volatile("" ::: "memory"); \
            f16* dp = dsts[which] + (size_t)(nbk * NC + cb * 16 + r16) * K + kt * 128 + kq * 8; \
            _Pragma("unroll") for (int ks = 0; ks < 4; ++ks) { f16x8 bv; \
                _Pragma("unroll") for (int i = 0; i < 8; ++i) bv[i] = tl[(ks * 32 + kq * 8 + i) * TS + cb * 16 + r16]; \
                if (rb0 == 0) *(f16x8*)(dp + ks * 32) = rm8(bv); \
                if (CTX) { _Pragma("unroll") for (int rb = 0; rb < NRB; ++rb) { const int row = (rb0 + rb) * 16 + r16; const f16x8 af = *(const f16x8*)(al + row * 128 + (((ks * 4 + kq) ^ r16) * 8)); \
                    acc[which][rb] = __builtin_amdgcn_mfma_f32_16x16x32_f16(bv, af, acc[which][rb], 0, 0, 0); } } } } while (0)
        CV_LOAD(0, 0); CV_LOAD(1, 1);
        for (int t2 = 0; t2 < ntr; t2 += 2) { CV_TILE(t2, 0); CV_TILE(t2 + 1, 1); }
#undef CV_LOAD
#undef CV_TILE
        asm volatile("s_waitcnt lgkmcnt(0)" ::: "memory"); __builtin_amdgcn_s_barrier(); asm volatile("" ::: "memory");
        if (CTX) {
#pragma unroll
            for (int rb = 0; rb < NRB; ++rb) {
                const size_t row = (size_t)e * SLOTS_PAD + 4096 + (rb0 + rb) * 16 + r16; const int col = nbk * NC + cb * 16 + 4 * kq;
                if (GATEUP) { f32x4 o;
#pragma unroll
                    for (int jj = 0; jj < 4; ++jj) o[jj] = silu_f(acc[0][rb][jj]) * acc[1][rb][jj];
                    *(f16x4*)(P.act() + row * DEXP + col) = pk4(o); }
                else *(f16x4*)(P.yslot() + row * DM + col) = pk4(acc[0][rb]);
            }
        }
    }
}

__device__ __forceinline__ void cvt3_job(const Params& P, int job, f16* tile) {
    if (job < 256) phase_cvt_ctx<false, false>(P, 3, job, 1 << 20, tile, -1, true);
    else { const int h = job - 256; phase_cvt_ctx<true, false>(P, 3, h >> 1, 1 << 20, tile, h & 1, true); }
}
__device__ __forceinline__ void phase_gateup_fast(const Params& P, LAS unsigned char* lds, int rt = 17, bool alt = false) { fg::PRGateUp S; S.H = P.H(); S.rowidx = P.rowidx(); S.W = P.Wgu() + (alt ? (OFF_WGU3 - OFF_WGU) / 2 : 0); S.act = P.act(); S.rt = rt; S.nunits = 16 * rt * 16; S.bid = opaque_bid(); fg::gemm_phase(lds, S, P.wv); }
__device__ __forceinline__ void phase_down_fast(const Params& P, LAS unsigned char* lds, int rt = 17, bool alt = false) { fg::PRDown S; S.act = P.act(); S.W = P.Wd() + (alt ? (OFF_WD3 - OFF_WD) / 2 : 0); S.y = P.yslot(); S.rt = rt; S.nunits = 16 * rt * 4; S.bid = opaque_bid(); fg::gemm_phase(lds, S, P.wv); }
__device__ __forceinline__ void phase_pool_fast(const Params& P, LAS unsigned char* lds) { fg::PRDense<256> S; S.qn = nullptr; S.kn = nullptr; S.rope = nullptr; S.xs = nullptr; S.lane = 0; S.npan = 130; S.kvx = 0; S.A = P.H(); S.W = P.Wmix(); S.O0 = P.Z(); S.O1 = nullptr; S.O2 = nullptr; S.ncol = 4; S.mode = 2; S.bid = opaque_bid(); fg::gemm_phase(lds, S, P.wv); }
__device__ __forceinline__ void phase_qkv_fast(const Params& P, LAS unsigned char* lds, bool lastl = false, int l = 1) { fg::PRDense<1024> S; S.qn = P.q_norm + (l >> 1) * 64; S.kn = P.k_norm + (l >> 1) * 64; S.rope = P.rope(); S.xs = (LAS float*)(lds + fg::STAGE_BYTES); S.lane = opaque_tid_(P.wv) & 63; S.npan = lastl ? 128 : 130; S.kvx = lastl ? 4 : 0; S.A = P.H(); S.W = P.Wmix(); S.O0 = P.Q(); S.O1 = P.Kb(); S.O2 = P.Vb(); S.ncol = 6; S.mode = 1; S.bid = opaque_bid(); fg::gemm_phase(lds, S, P.wv); }
__device__ __forceinline__ void phase_oproj_fast(const Params& P, LAS unsigned char* lds, bool lastl = false) { fg::PRDense<1024> S; S.qn = nullptr; S.kn = nullptr; S.rope = nullptr; S.xs = nullptr; S.lane = 0; S.npan = lastl ? 128 : 130; S.kvx = 0; S.A = P.O(); S.W = P.Wmix() + (size_t)QKVD * DM; S.O0 = P.Z(); S.O1 = nullptr; S.O2 = nullptr; S.ncol = 4; S.mode = 0; S.bid = opaque_bid(); fg::gemm_phase(lds, S, P.wv); }

typedef float f32x16 __attribute__((ext_vector_type(16)));
#define AT_KB 9216
#define AT_VB 8704
template <int VAR = 0>
__device__ __forceinline__ void phase_attn_fast(const Params& P, int l, LAS unsigned char* lds, bool do_ctx, int cvt_l = -1) {
    const int j = l >> 1;
    const int tid = opaque_tid(), wid = tid >> 6, lane = tid & 63, l32 = lane & 31, hi = lane >> 5;
    const int g = wid >> 1, qoff = (wid & 1) * 64, qoffu = (P.wv & 1) * 64;
    const int nunits = do_ctx ? 1040 : 1024;
    int ucount = 0;
    for (int u = opaque_bid(); u < nunits; u += gridDim.x, ++ucount) {
        int b, qblk, kv, qrow0, t0, t1, s0;
        if (u < 1024) { b = u >> 9; qblk = (u >> 2) & 127; kv = u & 3; s0 = b * SEQ; qrow0 = s0 + qblk * 128; t0 = qblk == 0 ? 2 : 0; t1 = qblk == 127 ? 4 : 6; }
        else { const int uu = u - 1024; b = uu >> 3; qblk = (uu >> 2) & 1; kv = uu & 3; s0 = NLAT + b * CTXL; qrow0 = s0 + qblk * 128; t0 = 0; t1 = 0; }
        const int cb = NLAT + b * CTXL, nloc = t1 - t0, ntiles = nloc + 4;
        const int h = kv * 4 + g;
        f16x8 Qf[2][4];
#pragma unroll
        for (int qb = 0; qb < 2; ++qb)
#pragma unroll
            for (int ks = 0; ks < 4; ++ks) Qf[qb][ks] = *(const f16x8*)(P.Q() + (size_t)(qrow0 + qoff + 32 * qb + l32) * 1024 + h * 64 + 16 * ks + 8 * hi);
        f32x16 OT[2][2];
#pragma unroll
        for (int db = 0; db < 2; ++db)
#pragma unroll
            for (int qb = 0; qb < 2; ++qb)
#pragma unroll
                for (int r = 0; r < 16; ++r) OT[db][qb][r] = 0.f;
        float mrun[2], lrun[2];
        { const float sk = P.sink[j * 16 + h] * 1.4426950408889634f; mrun[0] = sk; mrun[1] = sk; lrun[0] = hi == 0 ? 1.0f : 0.0f; lrun[1] = lrun[0]; }
        const int lkey = tid >> 3, lpc = tid & 7;
        f16x8 kreg, vreg;
        auto tile_row = [&](int it) -> int { return it < nloc ? (qrow0 - 128 + 64 * (t0 + it)) : (cb + 64 * (it - nloc)); };
        { const int kr = tile_row(0) + lkey; kreg = *(const f16x8*)(P.Kb() + (size_t)kr * 256 + kv * 64 + lpc * 8); vreg = *(const f16x8*)(P.Vb() + (size_t)kr * 256 + kv * 64 + lpc * 8); }
        __syncthreads();
        {
            LAS f16* Kl = (LAS f16*)(lds); LAS f16* Vl = (LAS f16*)(lds + 2 * AT_KB);
            *(LAS f16x8*)(Kl + lkey * 72 + lpc * 8) = kreg;
#pragma unroll
            for (int i = 0; i < 8; ++i) Vl[(lpc * 8 + i) * 68 + lkey] = vreg[i];
        }
        __syncthreads();
        for (int it = 0; it < ntiles; ++it) {
            const int buf = it & 1;
            if (it + 1 < ntiles) { const int kr = tile_row(it + 1) + lkey; kreg = *(const f16x8*)(P.Kb() + (size_t)kr * 256 + kv * 64 + lpc * 8); vreg = *(const f16x8*)(P.Vb() + (size_t)kr * 256 + kv * 64 + lpc * 8); }
            const LAS f16* Kl = (const LAS f16*)(lds + buf * AT_KB); const LAS f16* Vl = (const LAS f16*)(lds + 2 * AT_KB + buf * AT_VB);
            int cls = 0;
            if (it < nloc) { const int tl = t0 + it, dmin = qoffu + 65 - 64 * tl, dmax = qoffu + 191 - 64 * tl; cls = (dmin > 128 || dmax < -128) ? 2 : ((dmin >= -128 && dmax <= 128) ? 0 : 1); }
            if (cls != 2) {
            f32x16 S[2][2];
#pragma unroll
            for (int kb = 0; kb < 2; ++kb)
#pragma unroll
                for (int qb = 0; qb < 2; ++qb)
#pragma unroll
                    for (int r = 0; r < 16; ++r) S[kb][qb][r] = -mrun[qb];
#pragma unroll
            for (int ks = 0; ks < 4; ++ks)
#pragma unroll
                for (int kb = 0; kb < 2; ++kb) {
                    const f16x8 kf = *(const LAS f16x8*)(Kl + (32 * kb + l32) * 72 + 16 * ks + 8 * hi);
#pragma unroll
                    for (int qb = 0; qb < 2; ++qb) S[kb][qb] = __builtin_amdgcn_mfma_f32_32x32x16_f16(kf, Qf[qb][ks], S[kb][qb], 0, 0, 0);
                }
            if (cls == 1) {
                const int kt = 64 * (t0 + it);
#pragma unroll
                for (int qb = 0; qb < 2; ++qb) {
                    const int qp = 128 + qoff + 32 * qb + l32;
#pragma unroll
                    for (int kb = 0; kb < 2; ++kb)
#pragma unroll
                        for (int r = 0; r < 16; ++r) { const int kp = kt + 32 * kb + 8 * (r >> 2) + 4 * hi + (r & 3); const int d = qp - kp; if (d > 128 || d < -128) S[kb][qb][r] = -INFINITY; }
                }
            }
            f16x8 Pf[2][4];
#pragma unroll
            for (int qb = 0; qb < 2; ++qb) {
                float mx = S[0][qb][0];
#pragma unroll
                for (int kb = 0; kb < 2; ++kb)
#pragma unroll
                    for (int r = 0; r < 16; ++r) mx = fmaxf(mx, S[kb][qb][r]);
                { const auto sw = __builtin_amdgcn_permlane32_swap(__float_as_uint(mx), __float_as_uint(mx), false, false); mx = fmaxf(__uint_as_float(sw[0]), __uint_as_float(sw[1])); }
                if (__builtin_amdgcn_ballot_w64(mx > 8.0f) != 0ull) {
                    const float g = fmaxf(mx, 0.f), corr = __builtin_amdgcn_exp2f(-g);
                    mrun[qb] += g; lrun[qb] *= corr;
#pragma unroll
                    for (int kb = 0; kb < 2; ++kb)
#pragma unroll
                        for (int r = 0; r < 16; ++r) S[kb][qb][r] -= g;
#pragma unroll
                    for (int db = 0; db < 2; ++db)
#pragma unroll
                        for (int r = 0; r < 16; ++r) OT[db][qb][r] *= corr;
                }
                float ps = 0.f;
#pragma unroll
                for (int kb = 0; kb < 2; ++kb)
#pragma unroll
                    for (int r = 0; r < 16; ++r) { const float p = __builtin_amdgcn_exp2f(S[kb][qb][r]); S[kb][qb][r] = p; ps += p; }
                lrun[qb] += ps;
#pragma unroll
                for (int ks = 0; ks < 4; ++ks) { const int kb = ks >> 1, r0 = 8 * (ks & 1);
#pragma unroll
                    for (int e = 0; e < 8; ++e) Pf[qb][ks][e] = (f16)S[kb][qb][r0 + e]; }
            }
#pragma unroll
            for (int ks = 0; ks < 4; ++ks)
#pragma unroll
                for (int db = 0; db < 2; ++db) {
                    const LAS f16* vp = Vl + (32 * db + l32) * 68 + 16 * ks + 4 * hi;
                    const f16x4 v0 = *(const LAS f16x4*)vp, v1 = *(const LAS f16x4*)(vp + 8);
                    const f16x8 vf = (f16x8){v0[0], v0[1], v0[2], v0[3], v1[0], v1[1], v1[2], v1[3]};
#pragma unroll
                    for (int qb = 0; qb < 2; ++qb) OT[db][qb] = __builtin_amdgcn_mfma_f32_32x32x16_f16(vf, Pf[qb][ks], OT[db][qb], 0, 0, 0);
                }
            }
            if (it + 1 < ntiles) {
                LAS f16* Kw = (LAS f16*)(lds + (buf ^ 1) * AT_KB); LAS f16* Vw = (LAS f16*)(lds + 2 * AT_KB + (buf ^ 1) * AT_VB);
                *(LAS f16x8*)(Kw + lkey * 72 + lpc * 8) = kreg;
#pragma unroll
                for (int i = 0; i < 8; ++i) Vw[(lpc * 8 + i) * 68 + lkey] = vreg[i];
            }
            __syncthreads();
        }
#pragma unroll
        for (int qb = 0; qb < 2; ++qb) {
            const float lt = lrun[qb] + shx<32>(lrun[qb], lane);
            const float inv = 1.0f / lt;
            f16* op = P.O() + (size_t)(qrow0 + qoff + 32 * qb + l32) * 1024 + h * 64;
#pragma unroll
            for (int db = 0; db < 2; ++db)
#pragma unroll
                for (int i = 0; i < 4; ++i) {
                    const f16x4 o = (f16x4){(f16)(OT[db][qb][4 * i] * inv), (f16)(OT[db][qb][4 * i + 1] * inv), (f16)(OT[db][qb][4 * i + 2] * inv), (f16)(OT[db][qb][4 * i + 3] * inv)};
                    *(f16x4*)(op + 32 * db + 8 * i + 4 * hi) = rm4(o);
                }
        }
    }
}

#define MEGA_LDS (147456 + 16)
__device__ __forceinline__ const Params& opq(Params& q) { int z; asm volatile("s_mov_b32 %0, 0" : "=s"(z)); q.zoff = z; return q; }
__global__ __launch_bounds__(NTHR, 2) void mega(Params P) {
    extern __shared__ __attribute__((aligned(16))) unsigned char shm[];
    LAS unsigned char* lds = (LAS unsigned char*)shm;
    volatile LAS unsigned* st = (volatile LAS unsigned*)(lds + 147456);
    if (threadIdx.x == 0) { st[0] = 0u; st[1] = 0u; st[2] = 0u; st[3] = 0u; }
    __syncthreads();
    const XcdBarrier bar = xcd_barrier_post(P.bar(), st);
    const int nb = gridDim.x;
#define bid (opaque_bid())
    Params Q = P; Q.wv = __builtin_amdgcn_readfirstlane(threadIdx.x >> 6);
#define P (opq(Q))
    phase_ada(P, bid, nb, (float*)shm);
    __syncthreads();
    phase_convert(P, 0, bid, nb, (f16*)shm, false);
    xcd_barrier(bar);
    for (int l = 0; l < 4; ++l) {
        if (l == 0) phase_n1<true, false>(P, l, bid, nb); else { phase_n1<false, false>(P, l, bid, nb); __syncthreads(); phase_convert(P, l, bid, nb, (f16*)shm, false);
            }
        xcd_barrier(bar);
        if ((l & 1) == 0) {
            phase_pool_fast(P, lds);
            xcd_barrier(bar);
            phase_n2<true>(P, l, bid, nb, (float*)shm);
        } else {
            phase_qkv_fast(P, lds, l == 3, l);
            if (nb == 256 && (bid & 7) >= 2) { __syncthreads(); cvt3_job(P, (l == 1 ? 192 : 576) + ((bid & 7) - 2) * 32 + (bid >> 3), (f16*)shm); }
            xcd_barrier(bar);
            phase_attn_fast(P, l, lds, l != 3);
            if (l == 3 && nb != 256) { __syncthreads(); phase_cvt_ctx<true, false>(P, l, bid, nb, (f16*)shm, -1, true); phase_cvt_ctx<false, false>(P, l, bid, nb, (f16*)shm, -1, true); }
            xcd_barrier(bar);
            phase_oproj_fast(P, lds, l == 3);
            if (l == 1 && nb == 256 && (bid & 7) >= 2) { __syncthreads(); cvt3_job(P, 384 + ((bid & 7) - 2) * 32 + (bid >> 3), (f16*)shm); }
            xcd_barrier(bar);
            phase_n2<false>(P, l, bid, nb, (float*)shm, l == 3 ? NLAT : MROWS);
        }
        xcd_barrier(bar);
        phase_topk(P, bid, nb, (unsigned*)shm, l == 3 ? 32 : 64);
        if (l < 3 && nb == 256 && bid >= 64 && bid < 128) cvt3_job(P, l * 64 + bid - 64, (f16*)shm);
        xcd_barrier(bar);
        if (l < 3) { phase_cvt_ctx<true, true>(P, l, bid, nb, (f16*)shm); xcd_barrier(bar); }
        phase_gateup_fast(P, lds, 16, l == 3);
        if (l < 3) { __syncthreads(); phase_cvt_ctx<false, true>(P, l, bid, nb, (f16*)shm); }
        xcd_barrier(bar);
        phase_down_fast(P, lds, 16, l == 3);
        xcd_barrier(bar);
    }
    phase_n1<false, true>(P, 4, bid, nb);
#undef P
#undef bid
}

static inline size_t al256(size_t v) { return (v + 255) & ~(size_t)255; }

extern "C" void kernel_launch(void* const* d_in, const int* in_sizes, int n_in, void* d_out, int out_size, void* d_ws, size_t ws_size, hipStream_t stream) {
    Params P{};
    P.x = (const float*)d_in[0]; P.c = (const float*)d_in[1]; P.ctx = (const float*)d_in[2]; P.c_ctx = (const float*)d_in[3];
    P.w_ada = (const float*)d_in[4]; P.b_ada = (const float*)d_in[5]; P.norm1_g = (const float*)d_in[6]; P.norm2_g = (const float*)d_in[7];
    P.pool_w = (const float*)d_in[8]; P.pool_scale = (const float*)d_in[9]; P.w_qkv = (const float*)d_in[10]; P.w_o = (const float*)d_in[11];
    P.q_norm = (const float*)d_in[12]; P.k_norm = (const float*)d_in[13]; P.sink = (const float*)d_in[14]; P.router_w = (const float*)d_in[15];
    P.w_gate = (const float*)d_in[16]; P.w_up = (const float*)d_in[17]; P.w_down = (const float*)d_in[18];
    P.out = (float*)d_out;
    P.ws = (char*)d_ws; const size_t off = WS_TOTAL;
    if (off > ws_size) { fprintf(stderr, "workspace too small: need %zu have %zu\n", off, ws_size); return; }
    static int grid = 0;
    if (!grid) {
        int dev = 0, cus = 0, per_cu = 0;
        hipGetDevice(&dev);
        hipDeviceGetAttribute(&cus, hipDeviceAttributeMultiprocessorCount, dev);
        hipFuncSetAttribute((const void*)mega, hipFuncAttributeMaxDynamicSharedMemorySize, MEGA_LDS);
        hipOccupancyMaxActiveBlocksPerMultiprocessor(&per_cu, (const void*)mega, NTHR, MEGA_LDS);
        if (per_cu < 1) { fprintf(stderr, "mega: occupancy query says %d blocks per CU\n", per_cu); }
        grid = cus > 0 ? cus : 256;
    }
    hipMemsetAsync(P.bar(), 0, XCD_BAR_WORDS * sizeof(unsigned), stream);
    hipLaunchKernelGGL(mega, dim3(grid), dim3(NTHR), MEGA_LDS, stream, P);
}
```

```cpp
#include <hip/hip_runtime.h>
#include <stdint.h>
#include <stdio.h>

typedef _Float16 f16;
typedef _Float16 f16x2 __attribute__((ext_vector_type(2)));
typedef _Float16 f16x4 __attribute__((ext_vector_type(4)));
typedef _Float16 f16x8 __attribute__((ext_vector_type(8)));
typedef float f32x4 __attribute__((ext_vector_type(4)));
typedef float f32x2 __attribute__((ext_vector_type(2)));
typedef unsigned u32x2 __attribute__((ext_vector_type(2)));
typedef unsigned u32x4 __attribute__((ext_vector_type(4)));
#define RM_BITS 4
#define RM_ADD (0x00010001u << (RM_BITS - 1))
#define RM_MASK (~(0x00010001u * ((1u << RM_BITS) - 1u)))
__device__ __forceinline__ f16x4 rm4(f16x4 v) { u32x2 b = __builtin_bit_cast(u32x2, v); b = (b + RM_ADD) & RM_MASK; return __builtin_bit_cast(f16x4, b); }
__device__ __forceinline__ f16x8 rm8(f16x8 v) { u32x4 b = __builtin_bit_cast(u32x4, v); b = (b + RM_ADD) & RM_MASK; return __builtin_bit_cast(f16x8, b); }
#define RMW_BITS 5
__device__ __forceinline__ f16x8 rmw8(f16x8 v) { u32x4 b = __builtin_bit_cast(u32x4, v); b = (b + (0x00010001u << (RMW_BITS - 1))) & ~(0x00010001u * ((1u << RMW_BITS) - 1u)); return __builtin_bit_cast(f16x8, b); }

#define LAS __attribute__((address_space(3)))
#define DM 1024
#define SEQ 16384
#define NLAT 32768
#define CTXL 256
#define NCTX 512
#define MROWS 33280
#define NEXP 16
#define DEXP 2048
#define SLOTS 4160
#define SLOTS_PAD 4352
#define QKVD 1536
#define NTHR 512

constexpr size_t al256c(size_t v) { return (v + 255) & ~(size_t)255; }
constexpr size_t OFF_BAR = 0;
constexpr size_t OFF_MOD = al256c(OFF_BAR + 16384);
constexpr size_t OFF_ROPE = al256c(OFF_MOD + (size_t)4 * 3 * 6 * DM * 4);
constexpr size_t OFF_X = al256c(OFF_ROPE + (size_t)256 * 16 * 2 * 4);
constexpr size_t OFF_H = al256c(OFF_X + (size_t)MROWS * DM * 4);
constexpr size_t OFF_Z = al256c(OFF_H + (size_t)MROWS * DM * 2);
constexpr size_t OFF_Q = al256c(OFF_Z + (size_t)MROWS * DM * 2);
constexpr size_t OFF_KB = al256c(OFF_Q + (size_t)MROWS * DM * 2);
constexpr size_t OFF_VB = al256c(OFF_KB + (size_t)MROWS * 256 * 2);
constexpr size_t OFF_VT = al256c(OFF_VB + (size_t)MROWS * 256 * 2);
constexpr size_t OFF_O = al256c(OFF_VT + (size_t)MROWS * 256 * 2);
constexpr size_t OFF_AFF = al256c(OFF_O + (size_t)MROWS * DM * 2);
constexpr size_t OFF_INV = al256c(OFF_AFF + (size_t)MROWS * 16 * 4);
constexpr size_t OFF_ROWIDX = al256c(OFF_INV + (size_t)MROWS * 16 * 4);
constexpr size_t OFF_ACT = al256c(OFF_ROWIDX + (size_t)NEXP * SLOTS_PAD * 4);
constexpr size_t OFF_YSLOT = al256c(OFF_ACT + (size_t)NEXP * SLOTS_PAD * DEXP * 2);
constexpr size_t OFF_WGU = al256c(OFF_YSLOT + (size_t)NEXP * SLOTS_PAD * DM * 2);
constexpr size_t OFF_WD = al256c(OFF_WGU + (size_t)NEXP * 2 * DEXP * DM * 2);
constexpr size_t OFF_WMIX = al256c(OFF_WD + (size_t)NEXP * DM * DEXP * 2);
constexpr size_t OFF_WGU3 = al256c(OFF_WMIX + (size_t)(QKVD + DM) * DM * 2);
constexpr size_t OFF_WD3 = al256c(OFF_WGU3 + (size_t)NEXP * 2 * DEXP * DM * 2);
constexpr size_t OFF_DUMMY = al256c(OFF_WD3 + (size_t)NEXP * DM * DEXP * 2);
constexpr size_t WS_TOTAL = OFF_DUMMY;
struct Params {
    const float *x, *c, *ctx, *c_ctx, *w_ada, *b_ada, *norm1_g, *norm2_g, *pool_w, *pool_scale, *w_qkv, *w_o, *q_norm, *k_norm, *sink, *router_w, *w_gate, *w_up, *w_down;
    float* out; char* ws; int wv; int zoff;
#define WSF(name, type, off) __host__ __device__ __forceinline__ type* name() const { return (type*)(ws + zoff + (off)); }
    WSF(bar, unsigned, OFF_BAR) WSF(mod, float, OFF_MOD) WSF(rope, float, OFF_ROPE) WSF(X, f16, OFF_X) WSF(H, f16, OFF_H) WSF(Z, f16, OFF_Z) WSF(Q, f16, OFF_Q) WSF(Kb, f16, OFF_KB) WSF(Vb, f16, OFF_VB) WSF(Vt, f16, OFF_VT)
    WSF(O, f16, OFF_O) WSF(aff, float, OFF_AFF) WSF(inv, int, OFF_INV) WSF(rowidx, int, OFF_ROWIDX) WSF(act, f16, OFF_ACT) WSF(yslot, f16, OFF_YSLOT) WSF(Wgu, f16, OFF_WGU) WSF(Wd, f16, OFF_WD) WSF(Wmix, f16, OFF_WMIX)
#undef WSF
#define WSW(name, type, off) __host__ __device__ __forceinline__ type* name() const { return (type*)(ws + zoff + (off)); }
    WSW(Xw, f16, OFF_X) WSW(Ow, f16, OFF_O) WSW(Hw, f16, OFF_H) WSW(affw, float, OFF_AFF) WSW(Qw, f16, OFF_Q) WSW(Kw, f16, OFF_KB)
#undef WSW
};

template <int O> __device__ __forceinline__ float shx(float v, int lane) {
    if (O == 1) return __int_as_float(__builtin_amdgcn_update_dpp(0, __float_as_int(v), 0xB1, 0xF, 0xF, true));
    if (O == 2) return __int_as_float(__builtin_amdgcn_update_dpp(0, __float_as_int(v), 0x4E, 0xF, 0xF, true));
    if (O < 32) return __int_as_float(__builtin_amdgcn_ds_swizzle(__float_as_int(v), (O << 10) | 0x1f));
    return __int_as_float(__builtin_amdgcn_ds_bpermute((lane ^ O) << 2, __float_as_int(v)));
}
__device__ __forceinline__ float wave_sum(float v, int lane) {
    v += shx<1>(v, lane); v += shx<2>(v, lane); v += shx<4>(v, lane); v += shx<8>(v, lane); v += shx<16>(v, lane); v += shx<32>(v, lane);
    return v;
}
__device__ __forceinline__ unsigned shup(unsigned v, int o, int lane) { return (unsigned)__builtin_amdgcn_ds_bpermute((lane - o) << 2, (int)v); }
__device__ __forceinline__ int opaque_bid() { int b = blockIdx.x; asm volatile("" : "+s"(b)); return b; }
#define opaque_tid() opaque_tid_(P.wv)
__device__ __forceinline__ int opaque_tid_(int wv) { int ln; asm volatile("v_mbcnt_lo_u32_b32 %0, -1, 0\n\tv_mbcnt_hi_u32_b32 %0, -1, %0" : "=v"(ln)); return (wv << 6) | ln; }
__device__ __forceinline__ float silu_f(float v) { return v * __builtin_amdgcn_rcpf(1.0f + __expf(-v)); }

__device__ __forceinline__ const float* modp(const Params& P, int l, int v, int j) { return P.mod() + (size_t)((l * 3 + v) * 6 + j) * DM; }

__device__ __forceinline__ void phase_ada(const Params& P, int bid, int nb, float* lds) {
    float* sc = lds; float* red = lds + 3 * DM;
    const int tid = opaque_tid();
    for (int i = tid; i < 3 * DM; i += NTHR) { const int v = i >> 10, k = i & 1023; const float cv = v < 2 ? P.c[v * DM + k] : P.c_ctx[k]; sc[i] = silu_f(cv); }
    __syncthreads();
    for (int u = bid; u < 4 * 96; u += nb) {
        const int l = u / 96, ch = u % 96, col = ch * 64 + (tid & 63), ks = tid >> 6;
        const float* w = P.w_ada + (size_t)l * DM * 6 * DM + col;
        float s0 = 0.f, s1 = 0.f, s2 = 0.f;
        for (int k = ks * 128; k < ks * 128 + 128; ++k) { const float wv = __builtin_nontemporal_load(w + (size_t)k * 6 * DM); s0 += sc[k] * wv; s1 += sc[DM + k] * wv; s2 += sc[2 * DM + k] * wv; }
        red[(ks * 3 + 0) * 64 + (tid & 63)] = s0; red[(ks * 3 + 1) * 64 + (tid & 63)] = s1; red[(ks * 3 + 2) * 64 + (tid & 63)] = s2;
        __syncthreads();
        if (tid < 192) { const int v = tid >> 6, cc = tid & 63; float s = 0.f;
#pragma unroll
            for (int q = 0; q < 8; ++q) s += red[(q * 3 + v) * 64 + cc];
            const int colg = ch * 64 + cc; s += P.b_ada[l * 6 * DM + colg];
            const int j = colg >> 10, d = colg & 1023;
            P.mod()[(size_t)((l * 3 + v) * 6 + j) * DM + d] = s; }
        __syncthreads();
    }
    for (int i = bid * NTHR + tid; i < 256 * 16; i += nb * NTHR) {
        const int p = i >> 4, f = i & 15;
        const float inv = powf(10000.0f, -(float)f / 16.0f);
        const float angf = (float)p * inv;
        double a = (double)angf;
        const double twopi = 6.283185307179586476925286766559;
        a -= twopi * rint(a / twopi);
        const double a2 = a * a;
        double cs = 1.0, sn = 1.0;
        double tc = 0.0, ts = 0.0;
        for (int n = 16; n >= 1; --n) { tc = (tc + 1.0) * (-a2 / (double)((2 * n - 1) * (2 * n))); ts = (ts + 1.0) * (-a2 / (double)((2 * n) * (2 * n + 1))); }
        cs = 1.0 + tc; sn = a * (1.0 + ts);
        P.rope()[i * 2] = (float)cs; P.rope()[i * 2 + 1] = (float)sn;
    }
}

__device__ __forceinline__ f32x4 cvt4(const f16x4 v) { return (f32x4){(float)v[0], (float)v[1], (float)v[2], (float)v[3]}; }
__device__ __forceinline__ f16x4 pk4(const f32x4 v) { return (f16x4){(f16)v[0], (f16)v[1], (f16)v[2], (f16)v[3]}; }
__device__ __forceinline__ float dot4(const f32x4 a, const f32x4 b) { return a[0] * b[0] + a[1] * b[1] + a[2] * b[2] + a[3] * b[3]; }
template <bool FIRST, bool FINAL>
__device__ __forceinline__ void phase_n1(const Params& P, int l, int bid, int nb) {
    constexpr int R = 4;
    const int tid_ = opaque_tid(); const int wid = P.wv, lane = tid_ & 63;
    const int nrows = FINAL ? NLAT : MROWS;
    for (int rb = (bid * 8 + wid) * R; rb < nrows; rb += nb * 8 * R) {
        const int v = rb < NLAT ? (rb >> 14) : 2;
        f32x4 xv[R][4];
#pragma unroll
        for (int u = 0; u < R; ++u) {
            const int r = rb + u;
            if (FIRST) { const float* src = r < NLAT ? P.x + (size_t)r * DM : P.ctx + (size_t)(r - NLAT) * DM;
#pragma unroll
                for (int q = 0; q < 4; ++q) xv[u][q] = __builtin_nontemporal_load((const f32x4*)(src + q * 256 + lane * 4)); }
            else { const f16* src = P.X() + (size_t)r * DM;
#pragma unroll
                for (int q = 0; q < 4; ++q) xv[u][q] = cvt4(*(const f16x4*)(src + q * 256 + lane * 4)); }
        }
        if (!FIRST) {
            const int sl = P.inv()[(size_t)(lane & 15) * MROWS + rb + (lane >> 4)];
            const float af = P.aff()[(size_t)(lane & 15) * MROWS + rb + (lane >> 4)];
            const unsigned long long bal = __builtin_amdgcn_ballot_w64(sl >= 0);
            unsigned m[R];
#pragma unroll
            for (int u = 0; u < R; ++u) m[u] = (unsigned)(bal >> (16 * u)) & 0xffffu;
            const f16* ys = P.yslot();
            const float* g2 = modp(P, l - 1, v, 5);
            f32x4 gv[4];
#pragma unroll
            for (int q = 0; q < 4; ++q) gv[q] = *(const f32x4*)(g2 + q * 256 + lane * 4);
            while (m[0] | m[1] | m[2] | m[3]) {
                f16x4 yv[R][4]; float w[R];
#pragma unroll
                for (int u = 0; u < R; ++u) {
                    const int e = m[u] ? __builtin_ctz(m[u]) : 0;
                    const int sv = m[u] ? __builtin_amdgcn_readlane(sl, 16 * u + e) : 0;
                    w[u] = m[u] ? __int_as_float(__builtin_amdgcn_readlane(__float_as_int(af), 16 * u + e)) : 0.f;
                    m[u] &= m[u] - 1u;
                    const f16* y = ys + ((size_t)e * SLOTS_PAD + sv) * DM + lane * 4;
#pragma unroll
                    for (int q = 0; q < 4; ++q) yv[u][q] = *(const f16x4*)(y + q * 256);
                }
#pragma unroll
                for (int u = 0; u < R; ++u)
#pragma unroll
                    for (int q = 0; q < 4; ++q) xv[u][q] += (w[u] * gv[q]) * cvt4(yv[u][q]);
            }
        }
        if (FINAL) {
#pragma unroll
            for (int u = 0; u < R; ++u)
#pragma unroll
                for (int q = 0; q < 4; ++q) __builtin_nontemporal_store(xv[u][q], (f32x4*)(P.out + (size_t)(rb + u) * DM + q * 256 + lane * 4));
            continue;
        }
        float ss[R];
#pragma unroll
        for (int u = 0; u < R; ++u) {
            f16* xd = P.Xw() + (size_t)(rb + u) * DM; float sacc = 0.f;
#pragma unroll
            for (int q = 0; q < 4; ++q) { *(f16x4*)(xd + q * 256 + lane * 4) = pk4(xv[u][q]); sacc += dot4(xv[u][q], xv[u][q]); }
            ss[u] = sacc;
        }
#pragma unroll
        for (int u = 0; u < R; ++u) ss[u] = rsqrtf(wave_sum(ss[u], lane) * (1.0f / DM) + 1e-6f);
        const float* g = P.norm1_g + l * DM; const float* sh = modp(P, l, v, 0); const float* scl = modp(P, l, v, 1);
#pragma unroll
        for (int q = 0; q < 4; ++q) {
            const int c0 = q * 256 + lane * 4;
            const f32x4 gq = *(const f32x4*)(g + c0), sq = *(const f32x4*)(sh + c0), cq = *(const f32x4*)(scl + c0);
            const f32x4 gm = gq * (1.0f + cq);
#pragma unroll
            for (int u = 0; u < R; ++u) *(f16x4*)(P.Hw() + (size_t)(rb + u) * DM + c0) = rm4(pk4(xv[u][q] * ss[u] * gm + sq));
        }
    }
}

#define N2_ZST 81920
template <bool POOL>
__device__ __forceinline__ void phase_n2(const Params& P, int l, int bid, int nb, float* lds, int nrows = MROWS) {
    const int tid = opaque_tid(), wid = P.wv, lane = tid & 63;
    const float* wr = P.router_w + (size_t)l * DM * NEXP;
    f16* wh = (f16*)lds;
    for (int i = tid; i < DM * NEXP; i += NTHR) { const int d = i >> 4, e = i & 15; wh[e * 1032 + d] = (f16)wr[i]; }
    f16* h2s = (f16*)lds + 16640;
    LAS unsigned char* zst = (LAS unsigned char*)lds + N2_ZST;
    const int j = l >> 1, nblk = nrows >> 4;
    const f16* Zg = P.Z();
    const f16* Xg = P.X();
    f16x4 xr[2][4]; f16x4 zr[2][4];
    auto prefetch = [&](int blk) {
        const int R0 = blk * 16, rb = R0 + wid * 2;
        if (POOL) {
            int s0, L; if (R0 < NLAT) { s0 = (R0 >> 14) << 14; L = SEQ; } else { s0 = NLAT + (((R0 - NLAT) >> 8) << 8); L = CTXL; }
#pragma unroll
            for (int i = 0; i < 8; ++i) { const int piece = wid * 8 + i; int rr = R0 - 8 + (piece >> 1); rr = rr < s0 ? s0 : (rr > s0 + L - 1 ? s0 + L - 1 : rr);
                __builtin_amdgcn_global_load_lds((const unsigned*)(Zg + (size_t)rr * DM + (piece & 1) * 512 + lane * 8), (LAS unsigned*)(zst + piece * 1024), 16, 0, 0); }
        } else {
#pragma unroll
            for (int u = 0; u < 2; ++u)
#pragma unroll
                for (int q = 0; q < 4; ++q) zr[u][q] = *(const f16x4*)(Zg + (size_t)(rb + u) * DM + q * 256 + lane * 4);
        }
#pragma unroll
        for (int u = 0; u < 2; ++u)
#pragma unroll
            for (int q = 0; q < 4; ++q) xr[u][q] = *(const f16x4*)(Xg + (size_t)(rb + u) * DM + q * 256 + lane * 4);
    };
    int blk = bid;
    if (blk < nblk) prefetch(blk);
    __syncthreads();
    while (blk < nblk) {
        const int R0 = blk * 16, rb = R0 + wid * 2;
        int v, s0, L;
        if (rb < NLAT) { v = rb >> 14; s0 = v << 14; L = SEQ; } else { v = 2; s0 = NLAT + (((rb - NLAT) >> 8) << 8); L = CTXL; }
        const int t = rb - s0;
        f32x4 g1v[4], gmv[4], shv[4], psv[4];
        { const float* g1 = modp(P, l, v, 2); const float* g = P.norm2_g + l * DM; const float* sh = modp(P, l, v, 3); const float* scl = modp(P, l, v, 4);
#pragma unroll
            for (int q = 0; q < 4; ++q) { const int c0 = q * 256 + lane * 4;
                g1v[q] = *(const f32x4*)(g1 + c0); const f32x4 gv = *(const f32x4*)(g + c0), cv = *(const f32x4*)(scl + c0); shv[q] = *(const f32x4*)(sh + c0); gmv[q] = gv * (1.0f + cv);
                if (POOL) psv[q] = *(const f32x4*)(P.pool_scale + j * DM + c0); } }
        f32x4 y[2][4];
        if (POOL) {
            asm volatile("s_waitcnt vmcnt(0)" ::: "memory");
            __syncthreads();
#pragma unroll
            for (int q = 0; q < 4; ++q) {
                const int h = 1 << q;
                const LAS f16* zb = (const LAS f16*)zst + q * 256 + lane * 4;
                f32x4 common = (f32x4){0.f, 0.f, 0.f, 0.f}, z0 = common, z1 = common;
#pragma unroll
                for (int d = -h; d <= h; ++d) {
                    const int tt = t + d; const bool ok = tt >= 0 && tt < L;
                    f32x4 zz = cvt4(*(const LAS f16x4*)(zb + (2 * wid + 8 + d) * DM));
                    if (!ok) zz = (f32x4){0.f, 0.f, 0.f, 0.f};
                    if (d == -h) z0 = zz; else if (d == h) z1 = zz; else common += zz;
                    if (d == 0) y[0][q] = zz;
                    if (d == 1) y[1][q] = zz;
                }
                const int c0n = min(t + h, L) - max(t - h, 0), c1n = min(t + 1 + h, L) - max(t + 1 - h, 0);
                y[0][q] = ((common + z0) * (1.0f / (float)c0n) - y[0][q]) * psv[q];
                y[1][q] = ((common + z1) * (1.0f / (float)c1n) - y[1][q]) * psv[q];
            }
            asm volatile("s_waitcnt lgkmcnt(0)" ::: "memory");
            __syncthreads();
        } else {
#pragma unroll
            for (int u = 0; u < 2; ++u)
#pragma unroll
                for (int q = 0; q < 4; ++q) y[u][q] = cvt4(zr[u][q]);
        }
        f32x4 xv[2][4]; float ss[2] = {0.f, 0.f};
#pragma unroll
        for (int q = 0; q < 4; ++q) {
#pragma unroll
            for (int u = 0; u < 2; ++u) { xv[u][q] = cvt4(xr[u][q]) + g1v[q] * y[u][q]; ss[u] += dot4(xv[u][q], xv[u][q]); }
        }
        const int nxt = blk + nb;
        asm volatile("" ::: "memory");
        if (nxt < nblk) prefetch(nxt);
#pragma unroll
        for (int u = 0; u < 2; ++u)
#pragma unroll
            for (int q = 0; q < 4; ++q) *(f16x4*)(P.Xw() + (size_t)(rb + u) * DM + q * 256 + lane * 4) = pk4(xv[u][q]);
        ss[0] = wave_sum(ss[0], lane); ss[1] = wave_sum(ss[1], lane);
        const float rs[2] = {rsqrtf(ss[0] * (1.0f / DM) + 1e-6f), rsqrtf(ss[1] * (1.0f / DM) + 1e-6f)};
        f16x4 h2h[2][4];
#pragma unroll
        for (int q = 0; q < 4; ++q) {
            const int c0 = q * 256 + lane * 4;
#pragma unroll
            for (int u = 0; u < 2; ++u) { h2h[u][q] = pk4(xv[u][q] * rs[u] * gmv[q] + shv[q]); *(f16x4*)(P.Hw() + (size_t)(rb + u) * DM + c0) = rm4(h2h[u][q]); }
        }
        asm volatile("s_waitcnt lgkmcnt(0)" ::: "memory"); __builtin_amdgcn_s_barrier(); asm volatile("" ::: "memory");
#pragma unroll
        for (int q = 0; q < 4; ++q)
#pragma unroll
            for (int u = 0; u < 2; ++u) *(f16x4*)(h2s + (2 * wid + u) * 1032 + q * 256 + lane * 4) = h2h[u][q];
        asm volatile("s_waitcnt lgkmcnt(0)" ::: "memory"); __builtin_amdgcn_s_barrier(); asm volatile("" ::: "memory");
        if (wid == 0) {
            const int r16 = lane & 15, kq = lane >> 4;
            f32x4 lg = (f32x4){0.f, 0.f, 0.f, 0.f};
#pragma unroll 8
            for (int ks = 0; ks < 32; ++ks) {
                const f16x8 av = *(const f16x8*)(h2s + r16 * 1032 + ks * 32 + kq * 8), bv = *(const f16x8*)(wh + r16 * 1032 + ks * 32 + kq * 8);
                lg = __builtin_amdgcn_mfma_f32_16x16x32_f16(av, bv, lg, 0, 0, 0);
            }
#pragma unroll
            for (int jj = 0; jj < 4; ++jj) {
                float mx = lg[jj];
                mx = fmaxf(mx, shx<1>(mx, lane)); mx = fmaxf(mx, shx<2>(mx, lane)); mx = fmaxf(mx, shx<4>(mx, lane)); mx = fmaxf(mx, shx<8>(mx, lane));
                const float pe = __expf(lg[jj] - mx);
                float den = pe;
                den += shx<1>(den, lane); den += shx<2>(den, lane); den += shx<4>(den, lane); den += shx<8>(den, lane);
                P.affw()[(size_t)r16 * MROWS + R0 + 4 * kq + jj] = pe / den;
            }
        }
        blk = nxt;
    }
}

__device__ __forceinline__ void phase_topk(const Params& P, int bid, int nb, unsigned* lds, int nprob = 64) {
    unsigned* hist = lds; unsigned* misc = lds + 256; unsigned* wsa = lds + 272; unsigned* wsb = lds + 288;
    const int tid = opaque_tid(), wid = tid >> 6, lane = tid & 63;
    for (int p = bid; p < nprob; p += nb) {
        const int set = p >> 4, e = p & 15;
        const int n = set < 2 ? SEQ : CTXL, C = n >> 3;
        const int r0 = set < 2 ? set * SEQ : NLAT + (set - 2) * CTXL;
        const int slot0 = set < 2 ? set * 2048 : 4096 + (set - 2) * 32;
        unsigned key[32];
#pragma unroll
        for (int i4 = 0; i4 < 8; ++i4) { const int idx = tid * 32 + i4 * 4;
            f32x4 v = (f32x4){0.f, 0.f, 0.f, 0.f}; if (idx < n) v = *(const f32x4*)(P.aff() + (size_t)e * MROWS + r0 + idx);
#pragma unroll
            for (int jj = 0; jj < 4; ++jj) key[i4 * 4 + jj] = idx < n ? (__float_as_uint(v[jj]) + 1u) : 0u; }
        unsigned T = 0u;
        for (int bit = 29; bit >= 0; --bit) {
            const unsigned cand = T | (1u << bit);
            unsigned wc = 0u;
#pragma unroll
            for (int i = 0; i < 32; ++i) wc += (unsigned)__builtin_popcountll(__builtin_amdgcn_ballot_w64(key[i] >= cand));
            unsigned* cb = misc + ((bit & 1) << 3);
            if (lane == 0) cb[wid] = wc;
            __syncthreads();
            unsigned tot = 0u;
#pragma unroll
            for (int w = 0; w < 8; ++w) tot += cb[w];
            if (tot >= (unsigned)C) T = cand;
        }
        unsigned cg = 0u, ce = 0u;
#pragma unroll
        for (int i = 0; i < 32; ++i) { cg += key[i] > T ? 1u : 0u; ce += key[i] == T ? 1u : 0u; }
        unsigned ig = cg, ie = ce;
#pragma unroll
        for (int o = 1; o < 64; o <<= 1) { const unsigned a = shup(ig, o, lane), b = shup(ie, o, lane); if (lane >= o) { ig += a; ie += b; } }
        if (lane == 63) { wsa[wid] = ig; wsb[wid] = ie; }
        __syncthreads();
        unsigned bg = 0u, be = 0u, totg = 0u;
#pragma unroll
        for (int w = 0; w < 8; ++w) { const unsigned ga = wsa[w]; totg += ga; if (w < wid) { bg += ga; be += wsb[w]; } }
        const unsigned krem = (unsigned)C - totg;
        unsigned pg = bg + ig - cg, pe = be + ie - ce;
#pragma unroll
        for (int i4 = 0; i4 < 8; ++i4) {
            int iv[4];
#pragma unroll
            for (int jj = 0; jj < 4; ++jj) {
                const int i = i4 * 4 + jj, idx = tid * 32 + i;
                bool sel = false; unsigned rank = 0u;
                if (key[i] > T) { sel = true; rank = pg + (pe < krem ? pe : krem); ++pg; }
                else if (key[i] == T && key[i] != 0u) { if (pe < krem) { sel = true; rank = pg + pe; } ++pe; }
                if (sel) P.rowidx()[e * SLOTS_PAD + slot0 + (int)rank] = r0 + idx;
                iv[jj] = sel ? slot0 + (int)rank : -1;
            }
            if (tid * 32 + i4 * 4 < n) *(int4*)(P.inv() + (size_t)e * MROWS + r0 + tid * 32 + i4 * 4) = make_int4(iv[0], iv[1], iv[2], iv[3]);
        }
        if (set == 3) for (int i = SLOTS + tid; i < SLOTS_PAD; i += NTHR) P.rowidx()[e * SLOTS_PAD + i] = 0;
        __syncthreads();
    }
}

#define XB_TMO      128
#define XB_XCNT(j)  (256  + 64 * (j))
#define XB_XSUB(j)  (1280 + 64 * (j))
#define XB_XGEN(j)  (2304 + 64 * (j))
#define XB_TOP      3328
#define XB_TOPGEN   3392
#define XCD_BAR_WORDS 3456
#define XB_SPIN_CAP (1u << 18)
__device__ __forceinline__ unsigned xb_ld(unsigned* p)              { return __hip_atomic_load(p, __ATOMIC_RELAXED, __HIP_MEMORY_SCOPE_AGENT); }
__device__ __forceinline__ unsigned xb_add(unsigned* p, unsigned v) { return __hip_atomic_fetch_add(p, v, __ATOMIC_RELAXED, __HIP_MEMORY_SCOPE_AGENT); }
__device__ __forceinline__ unsigned xb_xcc_id() { return (unsigned)__builtin_amdgcn_s_getreg((3 << 11) | 20) & 0xFu; }
#define XB_SPIN(cond, bar) do { unsigned _sp = 0; while (cond) { __builtin_amdgcn_s_sleep(1); \
    if ((++_sp & 255u) == 0u) { if (xb_ld(&(bar)[XB_TMO])) break; if (_sp > XB_SPIN_CAP) { atomicAdd(&(bar)[XB_TMO], 1u); break; } } } } while (0)
struct XcdBarrier { unsigned* bar; unsigned x; volatile LAS unsigned* st; };
__device__ __forceinline__ XcdBarrier xcd_barrier_post(unsigned* bar, volatile LAS unsigned* st) {
    XcdBarrier b; b.bar = bar; b.x = xb_xcc_id(); b.st = st;
    if (threadIdx.x == 0) (void)xb_add(&bar[XB_XCNT(b.x)], 1u);
    return b;
}
__device__ __forceinline__ void xcd_barrier_complete(unsigned* bar, unsigned x, unsigned& nloc, unsigned& nx) {
    const unsigned G = gridDim.x * gridDim.y * gridDim.z;
    unsigned sum, cnt, mine, sp = 0u;
    for (;;) {
        sum = 0u; cnt = 0u; mine = 0u;
#pragma unroll
        for (unsigned j = 0; j < 16; ++j) { const unsigned c = xb_ld(&bar[XB_XCNT(j)]); sum += c; cnt += (c > 0u) ? 1u : 0u; mine = (j == x) ? c : mine; }
        if (sum == G) break;
        __builtin_amdgcn_s_sleep(1);
        if ((++sp & 255u) == 0u) { if (xb_ld(&bar[XB_TMO])) break; if (sp > XB_SPIN_CAP) { atomicAdd(&bar[XB_TMO], 1u); break; } }
    }
    nloc = mine > 0u ? mine : 1u; nx = cnt > 0u ? cnt : 1u;
}
__device__ __forceinline__ void xcd_barrier(const XcdBarrier& b) {
    asm volatile("s_waitcnt vmcnt(0)" ::: "memory");
    __syncthreads();
    if (threadIdx.x == 0) {
        unsigned* bar = b.bar; asm volatile("" : "+s"(bar));
        const unsigned bx = (unsigned)__builtin_amdgcn_readfirstlane((int)xb_xcc_id());
        __builtin_amdgcn_s_waitcnt(0);
        unsigned nloc = b.st[0], nx = b.st[1];
        if (nloc == 0u) { xcd_barrier_complete(bar, bx, nloc, nx); b.st[0] = nloc; b.st[1] = nx; }
        const unsigned old = xb_add(&bar[XB_XSUB(bx)], 1u);
        const unsigned gen = old / nloc;
        if (old + 1u == (gen + 1u) * nloc) {
            __builtin_amdgcn_fence(__ATOMIC_RELEASE, "agent");
            asm volatile("s_waitcnt vmcnt(0)" ::: "memory");
            const unsigned og = xb_add(&bar[XB_TOP], 1u);
            const unsigned tg = og / nx;
            if (og + 1u == (tg + 1u) * nx) xb_add(&bar[XB_TOPGEN], 1u);
            else XB_SPIN(xb_ld(&bar[XB_TOPGEN]) == tg, bar);
            __builtin_amdgcn_fence(__ATOMIC_ACQUIRE, "agent");
            xb_add(&bar[XB_XGEN(bx)], 1u);
            asm volatile("s_waitcnt vmcnt(0)" ::: "memory");
        } else {
            XB_SPIN(xb_ld(&bar[XB_XGEN(bx)]) == gen, bar);
            __builtin_amdgcn_fence(__ATOMIC_ACQUIRE, "agent");
            asm volatile("s_waitcnt vmcnt(0)" ::: "memory");
        }
    }
    __syncthreads();
}

namespace fg {
constexpr int BM = 256, BK = 64, HALF = 128, HTB = HALF * BK * 2, STAGE_BYTES = 8 * HTB;
__device__ __forceinline__ int lds_byte(int r, int c) { const int st = (r >> 4) * 2 + (c >> 5), rr = r & 15, cc = c & 31, ob = rr * 64 + cc * 2; return st * 1024 + (ob ^ (((ob >> 9) & 1) << 5)); }
__device__ __forceinline__ void stage_rc(int b, int& R, int& C) { const int st = b / 1024, sb = b % 1024, swz = sb ^ (((sb >> 9) & 1) << 5); R = (st >> 1) * 16 + swz / 64; C = (st & 1) * 32 + (swz % 64) / 2; }
__device__ __forceinline__ int perm32(int rho) { const int n = rho >> 4, i = rho & 15; return 8 * (i >> 2) + 4 * n + (i & 3); }
#define KDUP 0
struct Unit { int e, pm, pn; int skip; };
__device__ __forceinline__ void xcd_order(int i, int& T) { const int c = blockIdx.x; T = i * (int)gridDim.x + c; }

template <class PR>
__device__ __forceinline__ void gemm_phase(LAS unsigned char* lds, const PR& S, int wv) {
    const int tid = opaque_tid_(wv), wid = __builtin_amdgcn_readfirstlane(tid >> 6), lane = tid & 63, wr = wid >> 2, wc = wid & 3, fr = lane & 15, fq = lane >> 4;
    constexpr int K = PR::K, nt = K / BK;
    unsigned voffB[2];
#pragma unroll
    for (int i = 0; i < 2; ++i) { int R, C; stage_rc(tid * 16 + i * 8192, R, C); const int Rb = (R & ~31) + perm32(R & 31); voffB[i] = (unsigned)(Rb * PR::LDB + C) * 2u; }
    const size_t kstep = (size_t)(BK * 2);
    const size_t hB = S.hstepB();
    const unsigned ldsw = (unsigned)wid * 1024u;
    const int aoff = lds_byte(wr * 64 + fr, fq * 8), boff = lds_byte(wc * 32 + fr, fq * 8);
#define FG_SA(b, h) (((b) * 2 + (h)) * HTB)
#define FG_SB(b, h) ((4 + (b) * 2 + (h)) * HTB)
#define FG_STAGE(bufoff, gbase, voff) do { _Pragma("unroll") for (int _i = 0; _i < 2; ++_i) \
        __builtin_amdgcn_global_load_lds((const unsigned*)((const char*)(gbase) + (voff)[_i]), (LAS unsigned*)(lds + (bufoff) + ldsw + _i * 8192), 16, 0, 0); } while (0)
#define FG_LDA(dst, b, h) do { _Pragma("unroll") for (int m = 0; m < 4; ++m) _Pragma("unroll") for (int k = 0; k < 2; ++k) dst[m][k] = *(const LAS f16x8*)(lds + FG_SA(b, h) + aoff + m * 2048 + k * 1024); } while (0)
#define FG_LDB(dst, b, h) do { _Pragma("unroll") for (int n = 0; n < 2; ++n) _Pragma("unroll") for (int k = 0; k < 2; ++k) dst[n][k] = *(const LAS f16x8*)(lds + FG_SB(b, h) + boff + n * 2048 + k * 1024); } while (0)
#define FG_MMA(ai, bj, At, Bt) do { __builtin_amdgcn_s_setprio(1); _Pragma("unroll") for (int m = 0; m < 4; ++m) _Pragma("unroll") for (int n = 0; n < 2; ++n) _Pragma("unroll") for (int k = 0; k < 2; ++k) \
        acc[ai][bj][m][n] = __builtin_amdgcn_mfma_f32_16x16x32_f16(Bt[n][k], At[m][k], acc[ai][bj][m][n], 0, 0, 0); __builtin_amdgcn_s_setprio(0); } while (0)
#define FG_WAIT_V(n) asm volatile("s_waitcnt vmcnt(" #n ")" ::: "memory")
#define FG_WAIT_L(n) asm volatile("s_waitcnt lgkmcnt(" #n ")" ::: "memory")
#define FG_BAR __builtin_amdgcn_s_barrier()
#define FG_SCHED __builtin_amdgcn_sched_barrier(0)
    Unit cur, nxt; int ui = 0;
    if (!S.next(0, cur)) return;
    f32x4 acc[2][2][4][2];
#pragma unroll
    for (int a = 0; a < 2; ++a)
#pragma unroll
        for (int b = 0; b < 2; ++b)
#pragma unroll
            for (int m = 0; m < 4; ++m)
#pragma unroll
                for (int n = 0; n < 2; ++n) acc[a][b][m][n] = (f32x4){0.f, 0.f, 0.f, 0.f};
    f16x8 At[4][2], B0[2][2], B1[2][2];
    unsigned vA[2][2], vN[2][2];
    { int Rr[2], Cc[2]; stage_rc(tid * 16, Rr[0], Cc[0]); stage_rc(tid * 16 + 8192, Rr[1], Cc[1]); S.a_voff(cur, Rr, Cc, vA); }
#pragma unroll
    for (int h = 0; h < 2; ++h)
#pragma unroll
        for (int i = 0; i < 2; ++i) { asm volatile("" : "+v"(vA[h][i])); vN[h][i] = vA[h][i]; }
    const char* cA = S.a_base(cur); const char* cB = S.b_base(cur);
    FG_STAGE(FG_SB(0, 0), cB, voffB); FG_STAGE(FG_SA(0, 0), cA, vA[0]); FG_STAGE(FG_SB(0, 1), cB + hB, voffB); FG_STAGE(FG_SA(0, 1), cA, vA[1]);
    if (wr == 1) FG_BAR;
    FG_WAIT_V(4); FG_BAR;
    FG_STAGE(FG_SB(1, 0), cB + kstep, voffB); FG_STAGE(FG_SA(1, 0), cA + kstep, vA[0]); FG_STAGE(FG_SB(1, 1), cB + hB + kstep, voffB);
    FG_WAIT_V(6); FG_BAR;
    for (;;) {
        const bool has_next = S.next(ui + 1, nxt);
        const char* nA = has_next ? S.a_base(nxt) : cA; const char* nB = has_next ? S.b_base(nxt) : cB;
        if (has_next) { int Rr[2], Cc[2]; int t2 = tid; asm volatile("" : "+v"(t2)); stage_rc(t2 * 16, Rr[0], Cc[0]); stage_rc(t2 * 16 + 8192, Rr[1], Cc[1]); S.a_voff(nxt, Rr, Cc, vN);
#pragma unroll
            for (int h = 0; h < 2; ++h)
#pragma unroll
                for (int i = 0; i < 2; ++i) asm volatile("" : "+v"(vN[h][i])); }
#pragma unroll 1
        for (int t = 0; t < nt; t += 2) {
            const bool last = (t == nt - 2);
            const char* a1 = cA + (size_t)(t + 1) * kstep;
            const char* a2 = last ? nA : cA + (size_t)(t + 2) * kstep; const char* b2 = last ? nB : cB + (size_t)(t + 2) * kstep;
            const char* a3 = a2 + kstep; const char* b3 = b2 + kstep;
            unsigned v2[2][2];
#pragma unroll
            for (int h = 0; h < 2; ++h)
#pragma unroll
                for (int i = 0; i < 2; ++i) v2[h][i] = last ? vN[h][i] : vA[h][i];
            FG_LDB(B0, 0, 0); FG_SCHED; FG_LDA(At, 0, 0); FG_STAGE(FG_SA(1, 1), a1, vA[1]);
            FG_WAIT_L(8); FG_BAR; FG_WAIT_L(0); FG_MMA(0, 0, At, B0); FG_BAR; FG_SCHED;
            FG_LDB(B1, 0, 1); FG_STAGE(FG_SB(0, 0), b2, voffB);
            FG_BAR; FG_WAIT_L(0); FG_MMA(0, 1, At, B1); FG_BAR;
            FG_LDA(At, 0, 1); FG_STAGE(FG_SA(0, 0), a2, v2[0]);
            FG_BAR; FG_WAIT_L(0); FG_MMA(1, 0, At, B0); FG_BAR; FG_SCHED;
            FG_STAGE(FG_SB(0, 1), b2 + hB, voffB);
            FG_WAIT_V(6); FG_BAR; FG_MMA(1, 1, At, B1); FG_BAR;
            FG_LDB(B0, 1, 0); FG_SCHED; FG_LDA(At, 1, 0); FG_STAGE(FG_SA(0, 1), a2, v2[1]);
            FG_WAIT_L(8); FG_BAR; FG_WAIT_L(0); FG_MMA(0, 0, At, B0); FG_BAR; FG_SCHED;
            FG_LDB(B1, 1, 1); FG_STAGE(FG_SB(1, 0), b3, voffB);
            FG_BAR; FG_WAIT_L(0); FG_MMA(0, 1, At, B1); FG_BAR;
            FG_LDA(At, 1, 1); FG_STAGE(FG_SA(1, 0), a3, v2[0]);
            FG_BAR; FG_WAIT_L(0); FG_MMA(1, 0, At, B0); FG_BAR; FG_SCHED;
            FG_STAGE(FG_SB(1, 1), b3 + hB, voffB);
            FG_WAIT_V(6); FG_BAR; FG_MMA(1, 1, At, B1); FG_BAR;
        }
        if (!KDUP || !cur.skip) S.epi(acc, cur, wr, wc, fr, fq);
        if (!has_next) break;
#pragma unroll
        for (int a = 0; a < 2; ++a)
#pragma unroll
            for (int b = 0; b < 2; ++b)
#pragma unroll
                for (int m = 0; m < 4; ++m)
#pragma unroll
                    for (int n = 0; n < 2; ++n) acc[a][b][m][n] = (f32x4){0.f, 0.f, 0.f, 0.f};
        cur = nxt; cA = nA; cB = nB; ++ui;
#pragma unroll
        for (int h = 0; h < 2; ++h)
#pragma unroll
            for (int i = 0; i < 2; ++i) vA[h][i] = vN[h][i];
    }
    FG_WAIT_V(0);
    if (wr == 0) FG_BAR;
    FG_BAR;
#undef FG_SA
#undef FG_SB
#undef FG_STAGE
#undef FG_LDA
#undef FG_LDB
#undef FG_MMA
#undef FG_WAIT_V
#undef FG_WAIT_L
#undef FG_BAR
#undef FG_SCHED
}

__device__ __forceinline__ f16x8 pack8(const f32x4 a, const f32x4 b) { return (f16x8){(f16)a[0], (f16)a[1], (f16)a[2], (f16)a[3], (f16)b[0], (f16)b[1], (f16)b[2], (f16)b[3]}; }

template <int K_, int LDA_, int LDB_> struct PRBase {
    static constexpr int K = K_, LDA = LDA_, LDB = LDB_;
    __device__ __forceinline__ void plain_voff(const int (&R)[2], const int (&C)[2], unsigned (&v)[2][2]) const {
#pragma unroll
        for (int h = 0; h < 2; ++h)
#pragma unroll
            for (int i = 0; i < 2; ++i) v[h][i] = (unsigned)((h * HALF + R[i]) * LDA + C[i]) * 2u;
    }
};
struct PRGateUp : PRBase<1024, 1024, 1024> {
    const f16* H; const int* rowidx; const f16* W; f16* act; int nunits; int bid; int rt;
    __device__ __forceinline__ size_t hstepB() const { return (size_t)DEXP * DM * 2; }
    __device__ __forceinline__ bool next(int i, Unit& u) const { const int ii = KDUP ? (i >> 1) : i; const int T = ii * (int)gridDim.x + bid; u.skip = KDUP ? ((i & 1) == 0) : 0; if (T >= nunits) return false;
        if (rt == 16 && gridDim.x == 256) { const int x = bid & 7, jj = bid >> 3; u.e = ii; u.pm = (x >> 1) * 4 + (jj >> 3); u.pn = (x & 1) * 8 + (jj & 7); return true; }
        const int per = rt * 16; u.e = T / per; const int t = T % per; u.pm = t >> 4; u.pn = t & 15; return true; }
    __device__ __forceinline__ const char* a_base(const Unit&) const { return (const char*)H; }
    __device__ __forceinline__ void a_voff(const Unit& u, const int (&R)[2], const int (&C)[2], unsigned (&v)[2][2]) const {
        const int* ri = rowidx + u.e * SLOTS_PAD + u.pm * BM;
#pragma unroll
        for (int h = 0; h < 2; ++h)
#pragma unroll
            for (int i = 0; i < 2; ++i) { const int g = ri[h * HALF + R[i]]; v[h][i] = (unsigned)(g * LDA + C[i]) * 2u; }
    }
    __device__ __forceinline__ const char* b_base(const Unit& u) const { return (const char*)(W + ((size_t)u.e * 2 * DEXP + (size_t)u.pn * HALF) * DM); }
    __device__ __forceinline__ void epi(const f32x4 (&acc)[2][2][4][2], const Unit& u, int wr, int wc, int fr, int fq) const {
        f16* base = act + ((size_t)u.e * SLOTS_PAD + (size_t)u.pm * BM + wr * 64 + fr) * DEXP + u.pn * HALF + wc * 32 + fq * 8;
#pragma unroll
        for (int ai = 0; ai < 2; ++ai)
#pragma unroll
            for (int m = 0; m < 4; ++m) {
                f32x4 o0, o1;
#pragma unroll
                for (int j = 0; j < 4; ++j) { o0[j] = silu_f(acc[ai][0][m][0][j]) * acc[ai][1][m][0][j]; o1[j] = silu_f(acc[ai][0][m][1][j]) * acc[ai][1][m][1][j]; }
                if (u.e < 8) __builtin_nontemporal_store(rm8(pack8(o0, o1)), (f16x8*)(base + (size_t)(ai * HALF + m * 16) * DEXP));
                else *(f16x8*)(base + (size_t)(ai * HALF + m * 16) * DEXP) = rm8(pack8(o0, o1));
            }
    }
};
struct PRDown : PRBase<2048, 2048, 2048> {
    const f16* act; const f16* W; f16* y; int nunits; int bid; int rt;
    __device__ __forceinline__ size_t hstepB() const { return (size_t)HALF * DEXP * 2; }
    __device__ __forceinline__ bool next(int i, Unit& u) const { const int ii = KDUP ? (i >> 1) : i; const int T = ii * (int)gridDim.x + bid; u.skip = KDUP ? ((i & 1) == 0) : 0; if (T >= nunits) return false;
        if (rt == 16 && gridDim.x == 256) { const int x = bid & 7, jj = bid >> 3; u.e = 15 - (ii * 4 + (x >> 1)); u.pm = (x & 1) * 8 + (jj >> 2); u.pn = jj & 3; return true; }
        const int per = rt * 4; u.e = T / per; const int t = T % per; u.pm = t >> 2; u.pn = t & 3; return true; }
    __device__ __forceinline__ const char* a_base(const Unit& u) const { return (const char*)(act + ((size_t)u.e * SLOTS_PAD + (size_t)u.pm * BM) * DEXP); }
    __device__ __forceinline__ void a_voff(const Unit&, const int (&R)[2], const int (&C)[2], unsigned (&v)[2][2]) const { plain_voff(R, C, v); }
    __device__ __forceinline__ const char* b_base(const Unit& u) const { return (const char*)(W + ((size_t)u.e * DM + (size_t)u.pn * BM) * DEXP); }
    __device__ __forceinline__ void epi(const f32x4 (&acc)[2][2][4][2], const Unit& u, int wr, int wc, int fr, int fq) const {
        f16* base = y + ((size_t)u.e * SLOTS_PAD + (size_t)u.pm * BM + wr * 64 + fr) * DM + u.pn * BM + wc * 32 + fq * 8;
#pragma unroll
        for (int ai = 0; ai < 2; ++ai)
#pragma unroll
            for (int m = 0; m < 4; ++m)
#pragma unroll
                for (int bj = 0; bj < 2; ++bj) *(f16x8*)(base + (size_t)(ai * HALF + m * 16) * DM + bj * HALF) = pack8(acc[ai][bj][m][0], acc[ai][bj][m][1]);
    }
};
template <int K_> struct PRDense : PRBase<K_, 1024, K_> {
    const f16* A; const f16* W; f16* O0; f16* O1; f16* O2; int ncol; int mode; int bid; int npan; int kvx;
    __device__ __forceinline__ size_t hstepB() const { return (size_t)HALF * K_ * 2; }
    __device__ __forceinline__ bool next(int i, Unit& u) const { const int ii = KDUP ? (i >> 1) : i; int T = ii * (int)gridDim.x + bid; if (gridDim.x == 256) T = (ii * 8 + (bid & 7)) * 32 + (bid >> 3);
        u.skip = KDUP ? ((i & 1) == 0) : 0; const int nu = npan * ncol; if (T >= nu + kvx) return false; u.e = 0; if (T < nu) { u.pm = T / ncol; u.pn = T % ncol; } else { const int x = T - nu; u.pm = npan + (x >> 1); u.pn = 4 + (x & 1); } return true; }
    __device__ __forceinline__ const char* a_base(const Unit& u) const { return (const char*)(A + (size_t)u.pm * BM * 1024 + (mode == 2 ? u.pn * 256 : 0)); }
    __device__ __forceinline__ void a_voff(const Unit&, const int (&R)[2], const int (&C)[2], unsigned (&v)[2][2]) const { this->plain_voff(R, C, v); }
    __device__ __forceinline__ const char* b_base(const Unit& u) const { return (const char*)(W + (size_t)u.pn * BM * K_); }
    const float* qn; const float* kn; const float* rope; LAS float* xs; int lane;
    __device__ __forceinline__ void epi(const f32x4 (&acc)[2][2][4][2], const Unit& u, int wr, int wc, int fr, int fq) const {
        f16* base; int ld;
        const int row = u.pm * BM + wr * 64 + fr, colw = wc * 32 + fq * 8;
        if (mode == 1) { if (u.pn < 4) { base = O0 + (size_t)row * 1024 + u.pn * BM + colw; ld = 1024; } else if (u.pn == 4) { base = O1 + (size_t)row * 256 + colw; ld = 256; } else { base = O2 + (size_t)row * 256 + colw; ld = 256; } }
        else { base = O0 + (size_t)row * 1024 + u.pn * BM + colw; ld = 1024; }
        if (mode == 1 && u.pn < 5) {
            float ssq[2][4][2];
#pragma unroll
            for (int ai = 0; ai < 2; ++ai)
#pragma unroll
                for (int m = 0; m < 4; ++m)
#pragma unroll
                    for (int bj = 0; bj < 2; ++bj) { const f32x4 a = acc[ai][bj][m][0], b = acc[ai][bj][m][1];
                        float t = (a[0] * a[0] + a[1] * a[1]) + (a[2] * a[2] + a[3] * a[3]) + (b[0] * b[0] + b[1] * b[1]) + (b[2] * b[2] + b[3] * b[3]);
                        t += shx<16>(t, lane); t += shx<32>(t, lane); ssq[ai][m][bj] = t; }
            LAS float* mine = xs + ((wr * 4 + wc) * 16) * 16 + fr; const LAS float* theirs = xs + ((wr * 4 + (wc ^ 1)) * 16) * 16 + fr;
            if (fq == 0) {
#pragma unroll
                for (int ai = 0; ai < 2; ++ai)
#pragma unroll
                    for (int m = 0; m < 4; ++m)
#pragma unroll
                        for (int bj = 0; bj < 2; ++bj) mine[(ai * 8 + m * 2 + bj) * 16] = ssq[ai][m][bj];
            }
            asm volatile("s_waitcnt lgkmcnt(0)" ::: "memory"); __builtin_amdgcn_s_barrier(); asm volatile("" ::: "memory");
            const bool isq = u.pn < 4, lat = u.pm < 128;
            const float* nw = (isq ? qn : kn) + (wc & 1) * 32 + fq * 8;
            const f32x4 w0 = *(const f32x4*)nw, w1 = *(const f32x4*)(nw + 4);
            const float qs = isq ? 0.125f * 1.4426950408889634f : 1.0f;
#pragma unroll
            for (int ai = 0; ai < 2; ++ai)
#pragma unroll
                for (int m = 0; m < 4; ++m) {
                    f32x4 c0 = (f32x4){1.f, 1.f, 1.f, 1.f}, s0 = (f32x4){0.f, 0.f, 0.f, 0.f};
                    if (lat) { const int t = (row + ai * HALF + m * 16) & (SEQ - 1); const int pos = (wc & 1) ? (t & 63) : (t >> 6);
                        const float* tb = rope + (size_t)(pos * 16 + fq * 4) * 2; const f32x4 ta = *(const f32x4*)tb, tb2 = *(const f32x4*)(tb + 4);
                        c0 = (f32x4){ta[0], ta[2], tb2[0], tb2[2]}; s0 = (f32x4){ta[1], ta[3], tb2[1], tb2[3]}; }
#pragma unroll
                    for (int bj = 0; bj < 2; ++bj) {
                        const float tot = ssq[ai][m][bj] + theirs[(ai * 8 + m * 2 + bj) * 16];
                        const float rstd = rsqrtf(tot * (1.0f / 64.0f) + 1e-6f) * qs;
                        f32x4 a = acc[ai][bj][m][0] * rstd * w0, b = acc[ai][bj][m][1] * rstd * w1;
                        const f32x4 ra = (f32x4){a[0] * c0[0] - a[1] * s0[0], a[0] * s0[0] + a[1] * c0[0], a[2] * c0[1] - a[3] * s0[1], a[2] * s0[1] + a[3] * c0[1]};
                        const f32x4 rb = (f32x4){b[0] * c0[2] - b[1] * s0[2], b[0] * s0[2] + b[1] * c0[2], b[2] * c0[3] - b[3] * s0[3], b[2] * s0[3] + b[3] * c0[3]};
                        *(f16x8*)(base + (size_t)(ai * HALF + m * 16) * ld + bj * HALF) = rm8(pack8(ra, rb));
                    }
                }
            return;
        }
#pragma unroll
        for (int ai = 0; ai < 2; ++ai)
#pragma unroll
            for (int m = 0; m < 4; ++m)
#pragma unroll
                for (int bj = 0; bj < 2; ++bj) { const f16x8 o = pack8(acc[ai][bj][m][0], acc[ai][bj][m][1]); *(f16x8*)(base + (size_t)(ai * HALF + m * 16) * ld + bj * HALF) = (mode == 1) ? rm8(o) : o; }
    }
};
}

struct CvtJob { const float* src; f16* dst; int K, N, k0, n0; };
__device__ __forceinline__ bool cvt_job(const Params& P, int l, int u, CvtJob& jb, bool experts) {
    const int j = l >> 1;
    const int nexp = experts ? NEXP * 3 * 128 : 0;
    const int nmix = (l & 1) == 0 ? 16 : (96 + 64);
    if (u >= nexp + nmix) return false;
    if (u < nexp) {
        const int e = u / 384, r = u % 384, which = r >> 7, t = r & 127;
        if (which < 2) { jb.src = (which == 0 ? P.w_gate : P.w_up) + ((size_t)l * NEXP + e) * DM * DEXP; jb.dst = P.Wgu() + ((size_t)e * 2 + which) * DEXP * DM; jb.K = DM; jb.N = DEXP; jb.k0 = (t >> 4) * 128; jb.n0 = (t & 15) * 128; }
        else { jb.src = P.w_down + ((size_t)l * NEXP + e) * DEXP * DM; jb.dst = P.Wd() + (size_t)e * DM * DEXP; jb.K = DEXP; jb.N = DM; jb.k0 = (t >> 3) * 128; jb.n0 = (t & 7) * 128; }
    } else {
        const int t = u - nexp;
        if ((l & 1) == 0) { const int g = t >> 2, tt = t & 3; jb.src = P.pool_w + (size_t)(j * 4 + g) * 65536; jb.dst = P.Wmix() + (size_t)g * 65536; jb.K = 256; jb.N = 256; jb.k0 = (tt >> 1) * 128; jb.n0 = (tt & 1) * 128; }
        else if (t < 96) { jb.src = P.w_qkv + (size_t)j * DM * QKVD; jb.dst = P.Wmix(); jb.K = DM; jb.N = QKVD; jb.k0 = (t / 12) * 128; jb.n0 = (t % 12) * 128; }
        else { const int tt = t - 96; jb.src = P.w_o + (size_t)j * DM * DM; jb.dst = P.Wmix() + (size_t)QKVD * DM; jb.K = DM; jb.N = DM; jb.k0 = (tt >> 3) * 128; jb.n0 = (tt & 7) * 128; }
    }
    return true;
}
__device__ __forceinline__ void phase_convert(const Params& P, int l, int bid, int nb, f16* tile, bool experts = true) {
    const int tid = opaque_tid();
    CvtJob jb;
    int u = bid;
    bool have = cvt_job(P, l, u, jb, experts);
    f32x4 r[8];
    if (have) {
#pragma unroll
        for (int p = 0; p < 8; ++p) { const int id = tid + p * NTHR, kr = id >> 5, c4 = (id & 31) * 4; r[p] = __builtin_nontemporal_load((const f32x4*)(jb.src + (size_t)(jb.k0 + kr) * jb.N + jb.n0 + c4)); }
    }
    while (have) {
        __syncthreads();
#pragma unroll
        for (int p = 0; p < 8; ++p) { const int id = tid + p * NTHR, kr = id >> 5, c4 = (id & 31) * 4; *(f16x4*)(tile + kr * 136 + c4) = pk4(r[p]); }
        __syncthreads();
        const CvtJob cur = jb;
        u += nb; have = cvt_job(P, l, u, jb, experts);
        if (have) {
#pragma unroll
            for (int p = 0; p < 8; ++p) { const int id = tid + p * NTHR, kr = id >> 5, c4 = (id & 31) * 4; r[p] = __builtin_nontemporal_load((const f32x4*)(jb.src + (size_t)(jb.k0 + kr) * jb.N + jb.n0 + c4)); }
        }
        const int n = tid & 127, kg = (tid >> 7) * 32;
        f16* dp = cur.dst + (size_t)(cur.n0 + n) * cur.K + cur.k0 + kg;
#pragma unroll
        for (int i = 0; i < 4; ++i) { f16x8 o;
#pragma unroll
            for (int e = 0; e < 8; ++e) o[e] = tile[(kg + i * 8 + e) * 136 + n];
            *(f16x8*)(dp + i * 8) = rmw8(o); }
    }
}
template <bool GATEUP, bool CTX>
__device__ __forceinline__ void phase_cvt_ctx(const Params& P, int l, int bid, int nb, f16* tile, int sel = -1, bool alt = false) {
    const int tid = opaque_tid(), wid = P.wv, lane = tid & 63, r16 = lane & 15, kq = lane >> 4;
    constexpr int NC = GATEUP ? 128 : 64;
    constexpr int KT = GATEUP ? 8 : 16, K = GATEUP ? DM : DEXP, N = GATEUP ? DEXP : DM, NB = N / NC;
    constexpr int NT = GATEUP ? 2 * KT : KT;
    const int sel_ = (GATEUP && !CTX) ? sel : -1; const int ntr = (GATEUP && sel_ < 0) ? NT : KT;
    constexpr int TS = NC + 4, TW = 128 * TS;
    constexpr int NLD = NC / 16;
    constexpr int WPC = 8 / (NC / 16);
    constexpr int NRB = 4 / WPC;
    const int cb = wid % (NC / 16), rb0 = (wid / (NC / 16)) * NRB;
    f16* asl = tile + 2 * TW;
    for (int job = bid; job < NEXP * NB; job += nb) {
        const int e = job / NB, nbk = job % NB;
        const f16* ap[2];
        if (CTX) {
#pragma unroll
            for (int p = 0; p < 2; ++p) { const int row = (tid >> 4) + p * 32;
                if (GATEUP) ap[p] = P.H() + (size_t)P.rowidx()[e * SLOTS_PAD + 4096 + row] * DM + (tid & 15) * 8;
                else ap[p] = P.act() + ((size_t)e * SLOTS_PAD + 4096 + row) * DEXP + (tid & 15) * 8; }
        }
        f32x4 acc[2][NRB];
#pragma unroll
        for (int w = 0; w < 2; ++w)
#pragma unroll
            for (int rb = 0; rb < NRB; ++rb) acc[w][rb] = (f32x4){0.f, 0.f, 0.f, 0.f};
        const float* srcs[2]; f16* dsts[2];
        if (GATEUP) { const size_t wo = ((size_t)l * NEXP + e) * DM * DEXP; srcs[0] = P.w_gate + wo; srcs[1] = P.w_up + wo; dsts[0] = P.Wgu() + (alt ? (OFF_WGU3 - OFF_WGU) / 2 : 0) + ((size_t)e * 2) * DEXP * DM; dsts[1] = dsts[0] + (size_t)DEXP * DM; }
        else { srcs[0] = P.w_down + ((size_t)l * NEXP + e) * DEXP * DM; srcs[1] = srcs[0]; dsts[0] = P.Wd() + (alt ? (OFF_WD3 - OFF_WD) / 2 : 0) + (size_t)e * DM * DEXP; dsts[1] = dsts[0]; }
        f32x4 r[2][NLD]; f16x8 ar[2][2];
        const unsigned ldoff = (unsigned)(((tid / (NC / 4)) * N + (tid % (NC / 4)) * 4) * 4);
#define CV_LOAD(ti, slot) do { const int which_ = GATEUP ? (sel_ >= 0 ? sel_ : ((ti) & 1)) : 0, kt_ = (GATEUP && sel_ < 0) ? ((ti) >> 1) : (ti); const char* sp_ = (const char*)(srcs[which_] + (size_t)(kt_ * 128) * N + nbk * NC); \
            _Pragma("unroll") for (int p = 0; p < NLD; ++p) r[slot][p] = __builtin_nontemporal_load((const f32x4*)(sp_ + (size_t)p * (NTHR / (NC / 4)) * N * 4 + ldoff)); \
            if (CTX) { _Pragma("unroll") for (int p = 0; p < 2; ++p) ar[slot][p] = *(const f16x8*)(ap[p] + kt_ * 128); } } while (0)
#define CV_TILE(ti, slot) do { const int which = GATEUP ? (sel_ >= 0 ? sel_ : ((ti) & 1)) : 0, kt = (GATEUP && sel_ < 0) ? ((ti) >> 1) : (ti); \
            f16* tl = tile + (slot) * TW; f16* al = asl + (slot) * (64 * 128); \
            _Pragma("unroll") for (int p = 0; p < NLD; ++p) { const int id = tid + p * NTHR, kr = id / (NC / 4), c4 = (id % (NC / 4)) * 4; *(f16x4*)(tl + kr * TS + c4) = pk4(r[slot][p]); } \
            if (CTX) { _Pragma("unroll") for (int p = 0; p < 2; ++p) { const int row = (tid >> 4) + p * 32; *(f16x8*)(al + row * 128 + (((tid & 15) ^ (row & 15)) * 8)) = ar[slot][p]; } } \
            if ((ti) + 2 < ntr) CV_LOAD((ti) + 2, slot); \
            asm volatile("s_waitcnt lgkmcnt(0)" ::: "memory"); __builtin_amdgcn_s_barrier(); asm volatile("" ::: "memory"); \
            f16* dp = dsts[which] + (size_t)(nbk * NC + cb * 16 + r16) * K + kt * 128 + kq * 8; \
            _Pragma("unroll") for (int ks = 0; ks < 4; ++ks) { f16x8 bv; \
                _Pragma("unroll") for (int i = 0; i < 8; ++i) bv[i] = tl[(ks * 32 + kq * 8 + i) * TS + cb * 16 + r16]; \
                if (rb0 == 0) *(f16x8*)(dp + ks * 32) = rmw8(bv); \
                if (CTX) { _Pragma("unroll") for (int rb = 0; rb < NRB; ++rb) { const int row = (rb0 + rb) * 16 + r16; const f16x8 af = *(const f16x8*)(al + row * 128 + (((ks * 4 + kq) ^ r16) * 8)); \
                    acc[which][rb] = __builtin_amdgcn_mfma_f32_16x16x32_f16(bv, af, acc[which][rb], 0, 0, 0); } } } } while (0)
        CV_LOAD(0, 0); CV_LOAD(1, 1);
        for (int t2 = 0; t2 < ntr; t2 += 2) { CV_TILE(t2, 0); CV_TILE(t2 + 1, 1); }
#undef CV_LOAD
#undef CV_TILE
        asm volatile("s_waitcnt lgkmcnt(0)" ::: "memory"); __builtin_amdgcn_s_barrier(); asm volatile("" ::: "memory");
        if (CTX) {
#pragma unroll
            for (int rb = 0; rb < NRB; ++rb) {
                const size_t row = (size_t)e * SLOTS_PAD + 4096 + (rb0 + rb) * 16 + r16; const int col = nbk * NC + cb * 16 + 4 * kq;
                if (GATEUP) { f32x4 o;
#pragma unroll
                    for (int jj = 0; jj < 4; ++jj) o[jj] = silu_f(acc[0][rb][jj]) * acc[1][rb][jj];
                    *(f16x4*)(P.act() + row * DEXP + col) = pk4(o); }
                else *(f16x4*)(P.yslot() + row * DM + col) = pk4(acc[0][rb]);
            }
        }
    }
}

__device__ __forceinline__ void cvt3_job(const Params& P, int job, f16* tile) {
    if (job < 256) phase_cvt_ctx<false, false>(P, 3, job, 1 << 20, tile, -1, true);
    else { const int h = job - 256; phase_cvt_ctx<true, false>(P, 3, h >> 1, 1 << 20, tile, h & 1, true); }
}
__device__ __forceinline__ void phase_gateup_fast(const Params& P, LAS unsigned char* lds, int rt = 17, bool alt = false) { fg::PRGateUp S; S.H = P.H(); S.rowidx = P.rowidx(); S.W = P.Wgu() + (alt ? (OFF_WGU3 - OFF_WGU) / 2 : 0); S.act = P.act(); S.rt = rt; S.nunits = 16 * rt * 16; S.bid = opaque_bid(); fg::gemm_phase(lds, S, P.wv); }
__device__ __forceinline__ void phase_down_fast(const Params& P, LAS unsigned char* lds, int rt = 17, bool alt = false) { fg::PRDown S; S.act = P.act(); S.W = P.Wd() + (alt ? (OFF_WD3 - OFF_WD) / 2 : 0); S.y = P.yslot(); S.rt = rt; S.nunits = 16 * rt * 4; S.bid = opaque_bid(); fg::gemm_phase(lds, S, P.wv); }
__device__ __forceinline__ void phase_pool_fast(const Params& P, LAS unsigned char* lds) { fg::PRDense<256> S; S.qn = nullptr; S.kn = nullptr; S.rope = nullptr; S.xs = nullptr; S.lane = 0; S.npan = 130; S.kvx = 0; S.A = P.H(); S.W = P.Wmix(); S.O0 = P.Z(); S.O1 = nullptr; S.O2 = nullptr; S.ncol = 4; S.mode = 2; S.bid = opaque_bid(); fg::gemm_phase(lds, S, P.wv); }
__device__ __forceinline__ void phase_qkv_fast(const Params& P, LAS unsigned char* lds, bool lastl = false, int l = 1) { fg::PRDense<1024> S; S.qn = P.q_norm + (l >> 1) * 64; S.kn = P.k_norm + (l >> 1) * 64; S.rope = P.rope(); S.xs = (LAS float*)(lds + fg::STAGE_BYTES); S.lane = opaque_tid_(P.wv) & 63; S.npan = lastl ? 128 : 130; S.kvx = lastl ? 4 : 0; S.A = P.H(); S.W = P.Wmix(); S.O0 = P.Q(); S.O1 = P.Kb(); S.O2 = P.Vb(); S.ncol = 6; S.mode = 1; S.bid = opaque_bid(); fg::gemm_phase(lds, S, P.wv); }
__device__ __forceinline__ void phase_oproj_fast(const Params& P, LAS unsigned char* lds, bool lastl = false) { fg::PRDense<1024> S; S.qn = nullptr; S.kn = nullptr; S.rope = nullptr; S.xs = nullptr; S.lane = 0; S.npan = lastl ? 128 : 130; S.kvx = 0; S.A = P.O(); S.W = P.Wmix() + (size_t)QKVD * DM; S.O0 = P.Z(); S.O1 = nullptr; S.O2 = nullptr; S.ncol = 4; S.mode = 0; S.bid = opaque_bid(); fg::gemm_phase(lds, S, P.wv); }

typedef float f32x16 __attribute__((ext_vector_type(16)));
#define AT_KB 9216
#define AT_VB 8704
template <int VAR = 0>
__device__ __forceinline__ void phase_attn_fast(const Params& P, int l, LAS unsigned char* lds, bool do_ctx, int cvt_l = -1) {
    const int j = l >> 1;
    const int tid = opaque_tid(), wid = tid >> 6, lane = tid & 63, l32 = lane & 31, hi = lane >> 5;
    const int g = wid >> 1, qoff = (wid & 1) * 64, qoffu = (P.wv & 1) * 64;
    const int nunits = do_ctx ? 1040 : 1024;
    int ucount = 0;
    for (int u = opaque_bid(); u < nunits; u += gridDim.x, ++ucount) {
        int b, qblk, kv, qrow0, t0, t1, s0;
        if (u < 1024) { b = u >> 9; qblk = (u >> 2) & 127; kv = u & 3; s0 = b * SEQ; qrow0 = s0 + qblk * 128; t0 = qblk == 0 ? 2 : 0; t1 = qblk == 127 ? 4 : 6; }
        else { const int uu = u - 1024; b = uu >> 3; qblk = (uu >> 2) & 1; kv = uu & 3; s0 = NLAT + b * CTXL; qrow0 = s0 + qblk * 128; t0 = 0; t1 = 0; }
        const int cb = NLAT + b * CTXL, nloc = t1 - t0, ntiles = nloc + 4;
        const int h = kv * 4 + g;
        f16x8 Qf[2][4];
#pragma unroll
        for (int qb = 0; qb < 2; ++qb)
#pragma unroll
            for (int ks = 0; ks < 4; ++ks) Qf[qb][ks] = *(const f16x8*)(P.Q() + (size_t)(qrow0 + qoff + 32 * qb + l32) * 1024 + h * 64 + 16 * ks + 8 * hi);
        f32x16 OT[2][2];
#pragma unroll
        for (int db = 0; db < 2; ++db)
#pragma unroll
            for (int qb = 0; qb < 2; ++qb)
#pragma unroll
                for (int r = 0; r < 16; ++r) OT[db][qb][r] = 0.f;
        float mrun[2], lrun[2];
        { const float sk = P.sink[j * 16 + h] * 1.4426950408889634f; mrun[0] = sk; mrun[1] = sk; lrun[0] = hi == 0 ? 1.0f : 0.0f; lrun[1] = lrun[0]; }
        const int lkey = tid >> 3, lpc = tid & 7;
        f16x8 kreg, vreg;
        auto tile_row = [&](int it) -> int { return it < nloc ? (qrow0 - 128 + 64 * (t0 + it)) : (cb + 64 * (it - nloc)); };
        { const int kr = tile_row(0) + lkey; kreg = *(const f16x8*)(P.Kb() + (size_t)kr * 256 + kv * 64 + lpc * 8); vreg = *(const f16x8*)(P.Vb() + (size_t)kr * 256 + kv * 64 + lpc * 8); }
        __syncthreads();
        {
            LAS f16* Kl = (LAS f16*)(lds); LAS f16* Vl = (LAS f16*)(lds + 2 * AT_KB);
            *(LAS f16x8*)(Kl + lkey * 72 + lpc * 8) = kreg;
#pragma unroll
            for (int i = 0; i < 8; ++i) Vl[(lpc * 8 + i) * 68 + lkey] = vreg[i];
        }
        __syncthreads();
        for (int it = 0; it < ntiles; ++it) {
            const int buf = it & 1;
            if (it + 1 < ntiles) { const int kr = tile_row(it + 1) + lkey; kreg = *(const f16x8*)(P.Kb() + (size_t)kr * 256 + kv * 64 + lpc * 8); vreg = *(const f16x8*)(P.Vb() + (size_t)kr * 256 + kv * 64 + lpc * 8); }
            const LAS f16* Kl = (const LAS f16*)(lds + buf * AT_KB); const LAS f16* Vl = (const LAS f16*)(lds + 2 * AT_KB + buf * AT_VB);
            int cls = 0;
            if (it < nloc) { const int tl = t0 + it, dmin = qoffu + 65 - 64 * tl, dmax = qoffu + 191 - 64 * tl; cls = (dmin > 128 || dmax < -128) ? 2 : ((dmin >= -128 && dmax <= 128) ? 0 : 1); }
            if (cls != 2) {
            f32x16 S[2][2];
#pragma unroll
            for (int kb = 0; kb < 2; ++kb)
#pragma unroll
                for (int qb = 0; qb < 2; ++qb)
#pragma unroll
                    for (int r = 0; r < 16; ++r) S[kb][qb][r] = -mrun[qb];
#pragma unroll
            for (int ks = 0; ks < 4; ++ks)
#pragma unroll
                for (int kb = 0; kb < 2; ++kb) {
                    const f16x8 kf = *(const LAS f16x8*)(Kl + (32 * kb + l32) * 72 + 16 * ks + 8 * hi);
#pragma unroll
                    for (int qb = 0; qb < 2; ++qb) S[kb][qb] = __builtin_amdgcn_mfma_f32_32x32x16_f16(kf, Qf[qb][ks], S[kb][qb], 0, 0, 0);
                }
            if (cls == 1) {
                const int kt = 64 * (t0 + it);
#pragma unroll
                for (int qb = 0; qb < 2; ++qb) {
                    const int qp = 128 + qoff + 32 * qb + l32;
#pragma unroll
                    for (int kb = 0; kb < 2; ++kb)
#pragma unroll
                        for (int r = 0; r < 16; ++r) { const int kp = kt + 32 * kb + 8 * (r >> 2) + 4 * hi + (r & 3); const int d = qp - kp; if (d > 128 || d < -128) S[kb][qb][r] = -INFINITY; }
                }
            }
            f16x8 Pf[2][4];
#pragma unroll
            for (int qb = 0; qb < 2; ++qb) {
                float mx = S[0][qb][0];
#pragma unroll
                for (int kb = 0; kb < 2; ++kb)
#pragma unroll
                    for (int r = 0; r < 16; ++r) mx = fmaxf(mx, S[kb][qb][r]);
                { const auto sw = __builtin_amdgcn_permlane32_swap(__float_as_uint(mx), __float_as_uint(mx), false, false); mx = fmaxf(__uint_as_float(sw[0]), __uint_as_float(sw[1])); }
                if (__builtin_amdgcn_ballot_w64(mx > 8.0f) != 0ull) {
                    const float g = fmaxf(mx, 0.f), corr = __builtin_amdgcn_exp2f(-g);
                    mrun[qb] += g; lrun[qb] *= corr;
#pragma unroll
                    for (int kb = 0; kb < 2; ++kb)
#pragma unroll
                        for (int r = 0; r < 16; ++r) S[kb][qb][r] -= g;
#pragma unroll
                    for (int db = 0; db < 2; ++db)
#pragma unroll
                        for (int r = 0; r < 16; ++r) OT[db][qb][r] *= corr;
                }
                float ps = 0.f;
#pragma unroll
                for (int kb = 0; kb < 2; ++kb)
#pragma unroll
                    for (int r = 0; r < 16; ++r) { const float p = __builtin_amdgcn_exp2f(S[kb][qb][r]); S[kb][qb][r] = p; ps += p; }
                lrun[qb] += ps;
#pragma unroll
                for (int ks = 0; ks < 4; ++ks) { const int kb = ks >> 1, r0 = 8 * (ks & 1);
#pragma unroll
                    for (int e = 0; e < 8; ++e) Pf[qb][ks][e] = (f16)S[kb][qb][r0 + e]; }
            }
#pragma unroll
            for (int ks = 0; ks < 4; ++ks)
#pragma unroll
                for (int db = 0; db < 2; ++db) {
                    const LAS f16* vp = Vl + (32 * db + l32) * 68 + 16 * ks + 4 * hi;
                    const f16x4 v0 = *(const LAS f16x4*)vp, v1 = *(const LAS f16x4*)(vp + 8);
                    const f16x8 vf = (f16x8){v0[0], v0[1], v0[2], v0[3], v1[0], v1[1], v1[2], v1[3]};
#pragma unroll
                    for (int qb = 0; qb < 2; ++qb) OT[db][qb] = __builtin_amdgcn_mfma_f32_32x32x16_f16(vf, Pf[qb][ks], OT[db][qb], 0, 0, 0);
                }
            }
            if (it + 1 < ntiles) {
                LAS f16* Kw = (LAS f16*)(lds + (buf ^ 1) * AT_KB); LAS f16* Vw = (LAS f16*)(lds + 2 * AT_KB + (buf ^ 1) * AT_VB);
                *(LAS f16x8*)(Kw + lkey * 72 + lpc * 8) = kreg;
#pragma unroll
                for (int i = 0; i < 8; ++i) Vw[(lpc * 8 + i) * 68 + lkey] = vreg[i];
            }
            __syncthreads();
        }
#pragma unroll
        for (int qb = 0; qb < 2; ++qb) {
            const float lt = lrun[qb] + shx<32>(lrun[qb], lane);
            const float inv = 1.0f / lt;
            f16* op = P.O() + (size_t)(qrow0 + qoff + 32 * qb + l32) * 1024 + h * 64;
#pragma unroll
            for (int db = 0; db < 2; ++db)
#pragma unroll
                for (int i = 0; i < 4; ++i) {
                    const f16x4 o = (f16x4){(f16)(OT[db][qb][4 * i] * inv), (f16)(OT[db][qb][4 * i + 1] * inv), (f16)(OT[db][qb][4 * i + 2] * inv), (f16)(OT[db][qb][4 * i + 3] * inv)};
                    *(f16x4*)(op + 32 * db + 8 * i + 4 * hi) = rm4(o);
                }
        }
    }
}

#define MEGA_LDS (147456 + 16)
__device__ __forceinline__ const Params& opq(Params& q) { int z; asm volatile("s_mov_b32 %0, 0" : "=s"(z)); q.zoff = z; return q; }
__global__ __launch_bounds__(NTHR, 2) void mega(Params P) {
    extern __shared__ __attribute__((aligned(16))) unsigned char shm[];
    LAS unsigned char* lds = (LAS unsigned char*)shm;
    volatile LAS unsigned* st = (volatile LAS unsigned*)(lds + 147456);
    if (threadIdx.x == 0) { st[0] = 0u; st[1] = 0u; st[2] = 0u; st[3] = 0u; }
    __syncthreads();
    const XcdBarrier bar = xcd_barrier_post(P.bar(), st);
    const int nb = gridDim.x;
#define bid (opaque_bid())
    Params Q = P; Q.wv = __builtin_amdgcn_readfirstlane(threadIdx.x >> 6);
#define P (opq(Q))
    phase_ada(P, bid, nb, (float*)shm);
    __syncthreads();
    phase_convert(P, 0, bid, nb, (f16*)shm, false);
    xcd_barrier(bar);
    for (int l = 0; l < 4; ++l) {
        if (l == 0) phase_n1<true, false>(P, l, bid, nb); else { phase_n1<false, false>(P, l, bid, nb); __syncthreads(); phase_convert(P, l, bid, nb, (f16*)shm, false);
            }
        xcd_barrier(bar);
        if ((l & 1) == 0) {
            phase_pool_fast(P, lds);
            xcd_barrier(bar);
            phase_n2<true>(P, l, bid, nb, (float*)shm);
        } else {
            phase_qkv_fast(P, lds, l == 3, l);
            if (nb == 256 && (bid & 7) >= 2) { __syncthreads(); cvt3_job(P, (l == 1 ? 192 : 576) + ((bid & 7) - 2) * 32 + (bid >> 3), (f16*)shm); }
            xcd_barrier(bar);
            phase_attn_fast(P, l, lds, l != 3);
            if (l == 3 && nb != 256) { __syncthreads(); phase_cvt_ctx<true, false>(P, l, bid, nb, (f16*)shm, -1, true); phase_cvt_ctx<false, false>(P, l, bid, nb, (f16*)shm, -1, true); }
            xcd_barrier(bar);
            phase_oproj_fast(P, lds, l == 3);
            if (l == 1 && nb == 256 && (bid & 7) >= 2) { __syncthreads(); cvt3_job(P, 384 + ((bid & 7) - 2) * 32 + (bid >> 3), (f16*)shm); }
            xcd_barrier(bar);
            phase_n2<false>(P, l, bid, nb, (float*)shm, l == 3 ? NLAT : MROWS);
        }
        xcd_barrier(bar);
        phase_topk(P, bid, nb, (unsigned*)shm, l == 3 ? 32 : 64);
        if (l < 3 && nb == 256 && bid >= 64 && bid < 128) cvt3_job(P, l * 64 + bid - 64, (f16*)shm);
        xcd_barrier(bar);
        if (l < 3) { phase_cvt_ctx<true, true>(P, l, bid, nb, (f16*)shm); xcd_barrier(bar); }
        phase_gateup_fast(P, lds, 16, l == 3);
        if (l < 3) { __syncthreads(); phase_cvt_ctx<false, true>(P, l, bid, nb, (f16*)shm); }
        xcd_barrier(bar);
        phase_down_fast(P, lds, 16, l == 3);
        xcd_barrier(bar);
    }
    phase_n1<false, true>(P, 4, bid, nb);
#undef P
#undef bid
}

static inline size_t al256(size_t v) { return (v + 255) & ~(size_t)255; }

extern "C" void kernel_launch(void* const* d_in, const int* in_sizes, int n_in, void* d_out, int out_size, void* d_ws, size_t ws_size, hipStream_t stream) {
    Params P{};
    P.x = (const float*)d_in[0]; P.c = (const float*)d_in[1]; P.ctx = (const float*)d_in[2]; P.c_ctx = (const float*)d_in[3];
    P.w_ada = (const float*)d_in[4]; P.b_ada = (const float*)d_in[5]; P.norm1_g = (const float*)d_in[6]; P.norm2_g = (const float*)d_in[7];
    P.pool_w = (const float*)d_in[8]; P.pool_scale = (const float*)d_in[9]; P.w_qkv = (const float*)d_in[10]; P.w_o = (const float*)d_in[11];
    P.q_norm = (const float*)d_in[12]; P.k_norm = (const float*)d_in[13]; P.sink = (const float*)d_in[14]; P.router_w = (const float*)d_in[15];
    P.w_gate = (const float*)d_in[16]; P.w_up = (const float*)d_in[17]; P.w_down = (const float*)d_in[18];
    P.out = (float*)d_out;
    P.ws = (char*)d_ws; const size_t off = WS_TOTAL;
    if (off > ws_size) { fprintf(stderr, "workspace too small: need %zu have %zu\n", off, ws_size); return; }
    static int grid = 0;
    if (!grid) {
        int dev = 0, cus = 0, per_cu = 0;
        hipGetDevice(&dev);
        hipDeviceGetAttribute(&cus, hipDeviceAttributeMultiprocessorCount, dev);
        hipFuncSetAttribute((const void*)mega, hipFuncAttributeMaxDynamicSharedMemorySize, MEGA_LDS);
        hipOccupancyMaxActiveBlocksPerMultiprocessor(&per_cu, (const void*)mega, NTHR, MEGA_LDS);
        if (per_cu < 1) { fprintf(stderr, "mega: occupancy query says %d blocks per CU\n", per_cu); }
        grid = cus > 0 ? cus : 256;
    }
    hipMemsetAsync(P.bar(), 0, XCD_BAR_WORDS * sizeof(unsigned), stream);
    hipLaunchKernelGGL(mega, dim3(grid), dim3(NTHR), MEGA_LDS, stream, P);
}
```

```cpp
#include <hip/hip_runtime.h>
#include <stdint.h>
#include <stdio.h>

typedef _Float16 f16;
typedef _Float16 f16x2 __attribute__((ext_vector_type(2)));
typedef _Float16 f16x4 __attribute__((ext_vector_type(4)));
typedef _Float16 f16x8 __attribute__((ext_vector_type(8)));
typedef float f32x4 __attribute__((ext_vector_type(4)));
typedef float f32x2 __attribute__((ext_vector_type(2)));
typedef unsigned u32x2 __attribute__((ext_vector_type(2)));
typedef unsigned u32x4 __attribute__((ext_vector_type(4)));
#define RM_BITS 5
#define RM_ADD (0x00010001u << (RM_BITS - 1))
#define RM_MASK (~(0x00010001u * ((1u << RM_BITS) - 1u)))
__device__ __forceinline__ f16x4 rm4(f16x4 v) { u32x2 b = __builtin_bit_cast(u32x2, v); b = (b + RM_ADD) & RM_MASK; return __builtin_bit_cast(f16x4, b); }
__device__ __forceinline__ f16x8 rm8(f16x8 v) { u32x4 b = __builtin_bit_cast(u32x4, v); b = (b + RM_ADD) & RM_MASK; return __builtin_bit_cast(f16x8, b); }
#define RMW_BITS 5
__device__ __forceinline__ f16x8 rmw8(f16x8 v) { u32x4 b = __builtin_bit_cast(u32x4, v); b = (b + (0x00010001u << (RMW_BITS - 1))) & ~(0x00010001u * ((1u << RMW_BITS) - 1u)); return __builtin_bit_cast(f16x8, b); }

#define LAS __attribute__((address_space(3)))
#define DM 1024
#define SEQ 16384
#define NLAT 32768
#define CTXL 256
#define NCTX 512
#define MROWS 33280
#define NEXP 16
#define DEXP 2048
#define SLOTS 4160
#define SLOTS_PAD 4352
#define QKVD 1536
#define NTHR 512

constexpr size_t al256c(size_t v) { return (v + 255) & ~(size_t)255; }
constexpr size_t OFF_BAR = 0;
constexpr size_t OFF_MOD = al256c(OFF_BAR + 16384);
constexpr size_t OFF_ROPE = al256c(OFF_MOD + (size_t)4 * 3 * 6 * DM * 4);
constexpr size_t OFF_X = al256c(OFF_ROPE + (size_t)256 * 16 * 2 * 4);
constexpr size_t OFF_H = al256c(OFF_X + (size_t)MROWS * DM * 4);
constexpr size_t OFF_Z = al256c(OFF_H + (size_t)MROWS * DM * 2);
constexpr size_t OFF_Q = al256c(OFF_Z + (size_t)MROWS * DM * 2);
constexpr size_t OFF_KB = al256c(OFF_Q + (size_t)MROWS * DM * 2);
constexpr size_t OFF_VB = al256c(OFF_KB + (size_t)MROWS * 256 * 2);
constexpr size_t OFF_VT = al256c(OFF_VB + (size_t)MROWS * 256 * 2);
constexpr size_t OFF_O = al256c(OFF_VT + (size_t)MROWS * 256 * 2);
constexpr size_t OFF_AFF = al256c(OFF_O + (size_t)MROWS * DM * 2);
constexpr size_t OFF_INV = al256c(OFF_AFF + (size_t)MROWS * 16 * 4);
constexpr size_t OFF_ROWIDX = al256c(OFF_INV + (size_t)MROWS * 16 * 4);
constexpr size_t OFF_ACT = al256c(OFF_ROWIDX + (size_t)NEXP * SLOTS_PAD * 4);
constexpr size_t OFF_YSLOT = al256c(OFF_ACT + (size_t)NEXP * SLOTS_PAD * DEXP * 2);
constexpr size_t OFF_WGU = al256c(OFF_YSLOT + (size_t)NEXP * SLOTS_PAD * DM * 2);
constexpr size_t OFF_WD = al256c(OFF_WGU + (size_t)NEXP * 2 * DEXP * DM * 2);
constexpr size_t OFF_WMIX = al256c(OFF_WD + (size_t)NEXP * DM * DEXP * 2);
constexpr size_t OFF_WGU3 = al256c(OFF_WMIX + (size_t)(QKVD + DM) * DM * 2);
constexpr size_t OFF_WD3 = al256c(OFF_WGU3 + (size_t)NEXP * 2 * DEXP * DM * 2);
constexpr size_t OFF_DUMMY = al256c(OFF_WD3 + (size_t)NEXP * DM * DEXP * 2);
constexpr size_t WS_TOTAL = OFF_DUMMY;
struct Params {
    const float *x, *c, *ctx, *c_ctx, *w_ada, *b_ada, *norm1_g, *norm2_g, *pool_w, *pool_scale, *w_qkv, *w_o, *q_norm, *k_norm, *sink, *router_w, *w_gate, *w_up, *w_down;
    float* out; char* ws; int wv; int zoff;
#define WSF(name, type, off) __host__ __device__ __forceinline__ type* name() const { return (type*)(ws + zoff + (off)); }
    WSF(bar, unsigned, OFF_BAR) WSF(mod, float, OFF_MOD) WSF(rope, float, OFF_ROPE) WSF(X, f16, OFF_X) WSF(H, f16, OFF_H) WSF(Z, f16, OFF_Z) WSF(Q, f16, OFF_Q) WSF(Kb, f16, OFF_KB) WSF(Vb, f16, OFF_VB) WSF(Vt, f16, OFF_VT)
    WSF(O, f16, OFF_O) WSF(aff, float, OFF_AFF) WSF(inv, int, OFF_INV) WSF(rowidx, int, OFF_ROWIDX) WSF(act, f16, OFF_ACT) WSF(yslot, f16, OFF_YSLOT) WSF(Wgu, f16, OFF_WGU) WSF(Wd, f16, OFF_WD) WSF(Wmix, f16, OFF_WMIX)
#undef WSF
#define WSW(name, type, off) __host__ __device__ __forceinline__ type* name() const { return (type*)(ws + zoff + (off)); }
    WSW(Xw, f16, OFF_X) WSW(Ow, f16, OFF_O) WSW(Hw, f16, OFF_H) WSW(affw, float, OFF_AFF) WSW(Qw, f16, OFF_Q) WSW(Kw, f16, OFF_KB)
#undef WSW
};

template <int O> __device__ __forceinline__ float shx(float v, int lane) {
    if (O == 1) return __int_as_float(__builtin_amdgcn_update_dpp(0, __float_as_int(v), 0xB1, 0xF, 0xF, true));
    if (O == 2) return __int_as_float(__builtin_amdgcn_update_dpp(0, __float_as_int(v), 0x4E, 0xF, 0xF, true));
    if (O < 32) return __int_as_float(__builtin_amdgcn_ds_swizzle(__float_as_int(v), (O << 10) | 0x1f));
    return __int_as_float(__builtin_amdgcn_ds_bpermute((lane ^ O) << 2, __float_as_int(v)));
}
__device__ __forceinline__ float wave_sum(float v, int lane) {
    v += shx<1>(v, lane); v += shx<2>(v, lane); v += shx<4>(v, lane); v += shx<8>(v, lane); v += shx<16>(v, lane); v += shx<32>(v, lane);
    return v;
}
__device__ __forceinline__ unsigned shup(unsigned v, int o, int lane) { return (unsigned)__builtin_amdgcn_ds_bpermute((lane - o) << 2, (int)v); }
__device__ __forceinline__ int opaque_bid() { int b = blockIdx.x; asm volatile("" : "+s"(b)); return b; }
#define opaque_tid() opaque_tid_(P.wv)
__device__ __forceinline__ int opaque_tid_(int wv) { int ln; asm volatile("v_mbcnt_lo_u32_b32 %0, -1, 0\n\tv_mbcnt_hi_u32_b32 %0, -1, %0" : "=v"(ln)); return (wv << 6) | ln; }
__device__ __forceinline__ float silu_f(float v) { return v * __builtin_amdgcn_rcpf(1.0f + __expf(-v)); }

__device__ __forceinline__ const float* modp(const Params& P, int l, int v, int j) { return P.mod() + (size_t)((l * 3 + v) * 6 + j) * DM; }

__device__ __forceinline__ void phase_ada(const Params& P, int bid, int nb, float* lds) {
    float* sc = lds; float* red = lds + 3 * DM;
    const int tid = opaque_tid();
    for (int i = tid; i < 3 * DM; i += NTHR) { const int v = i >> 10, k = i & 1023; const float cv = v < 2 ? P.c[v * DM + k] : P.c_ctx[k]; sc[i] = silu_f(cv); }
    __syncthreads();
    for (int u = bid; u < 4 * 96; u += nb) {
        const int l = u / 96, ch = u % 96, col = ch * 64 + (tid & 63), ks = tid >> 6;
        const float* w = P.w_ada + (size_t)l * DM * 6 * DM + col;
        float s0 = 0.f, s1 = 0.f, s2 = 0.f;
        for (int k = ks * 128; k < ks * 128 + 128; ++k) { const float wv = __builtin_nontemporal_load(w + (size_t)k * 6 * DM); s0 += sc[k] * wv; s1 += sc[DM + k] * wv; s2 += sc[2 * DM + k] * wv; }
        red[(ks * 3 + 0) * 64 + (tid & 63)] = s0; red[(ks * 3 + 1) * 64 + (tid & 63)] = s1; red[(ks * 3 + 2) * 64 + (tid & 63)] = s2;
        __syncthreads();
        if (tid < 192) { const int v = tid >> 6, cc = tid & 63; float s = 0.f;
#pragma unroll
            for (int q = 0; q < 8; ++q) s += red[(q * 3 + v) * 64 + cc];
            const int colg = ch * 64 + cc; s += P.b_ada[l * 6 * DM + colg];
            const int j = colg >> 10, d = colg & 1023;
            P.mod()[(size_t)((l * 3 + v) * 6 + j) * DM + d] = s; }
        __syncthreads();
    }
    for (int i = bid * NTHR + tid; i < 256 * 16; i += nb * NTHR) {
        const int p = i >> 4, f = i & 15;
        const float inv = powf(10000.0f, -(float)f / 16.0f);
        const float angf = (float)p * inv;
        double a = (double)angf;
        const double twopi = 6.283185307179586476925286766559;
        a -= twopi * rint(a / twopi);
        const double a2 = a * a;
        double cs = 1.0, sn = 1.0;
        double tc = 0.0, ts = 0.0;
        for (int n = 16; n >= 1; --n) { tc = (tc + 1.0) * (-a2 / (double)((2 * n - 1) * (2 * n))); ts = (ts + 1.0) * (-a2 / (double)((2 * n) * (2 * n + 1))); }
        cs = 1.0 + tc; sn = a * (1.0 + ts);
        P.rope()[i * 2] = (float)cs; P.rope()[i * 2 + 1] = (float)sn;
    }
}

__device__ __forceinline__ f32x4 cvt4(const f16x4 v) { return (f32x4){(float)v[0], (float)v[1], (float)v[2], (float)v[3]}; }
__device__ __forceinline__ f16x4 pk4(const f32x4 v) { return (f16x4){(f16)v[0], (f16)v[1], (f16)v[2], (f16)v[3]}; }
__device__ __forceinline__ float dot4(const f32x4 a, const f32x4 b) { return a[0] * b[0] + a[1] * b[1] + a[2] * b[2] + a[3] * b[3]; }
template <bool FIRST, bool FINAL>
__device__ __forceinline__ void phase_n1(const Params& P, int l, int bid, int nb) {
    constexpr int R = 4;
    const int tid_ = opaque_tid(); const int wid = P.wv, lane = tid_ & 63;
    const int nrows = FINAL ? NLAT : MROWS;
    for (int rb = (bid * 8 + wid) * R; rb < nrows; rb += nb * 8 * R) {
        const int v = rb < NLAT ? (rb >> 14) : 2;
        f32x4 xv[R][4];
#pragma unroll
        for (int u = 0; u < R; ++u) {
            const int r = rb + u;
            if (FIRST) { const float* src = r < NLAT ? P.x + (size_t)r * DM : P.ctx + (size_t)(r - NLAT) * DM;
#pragma unroll
                for (int q = 0; q < 4; ++q) xv[u][q] = __builtin_nontemporal_load((const f32x4*)(src + q * 256 + lane * 4)); }
            else { const f16* src = P.X() + (size_t)r * DM;
#pragma unroll
                for (int q = 0; q < 4; ++q) xv[u][q] = cvt4(*(const f16x4*)(src + q * 256 + lane * 4)); }
        }
        if (!FIRST) {
            const int sl = P.inv()[(size_t)(lane & 15) * MROWS + rb + (lane >> 4)];
            const float af = P.aff()[(size_t)(lane & 15) * MROWS + rb + (lane >> 4)];
            const unsigned long long bal = __builtin_amdgcn_ballot_w64(sl >= 0);
            unsigned m[R];
#pragma unroll
            for (int u = 0; u < R; ++u) m[u] = (unsigned)(bal >> (16 * u)) & 0xffffu;
            const f16* ys = P.yslot();
            const float* g2 = modp(P, l - 1, v, 5);
            f32x4 gv[4];
#pragma unroll
            for (int q = 0; q < 4; ++q) gv[q] = *(const f32x4*)(g2 + q * 256 + lane * 4);
            while (m[0] | m[1] | m[2] | m[3]) {
                f16x4 yv[R][4]; float w[R];
#pragma unroll
                for (int u = 0; u < R; ++u) {
                    const int e = m[u] ? __builtin_ctz(m[u]) : 0;
                    const int sv = m[u] ? __builtin_amdgcn_readlane(sl, 16 * u + e) : 0;
                    w[u] = m[u] ? __int_as_float(__builtin_amdgcn_readlane(__float_as_int(af), 16 * u + e)) : 0.f;
                    m[u] &= m[u] - 1u;
                    const f16* y = ys + ((size_t)e * SLOTS_PAD + sv) * DM + lane * 4;
#pragma unroll
                    for (int q = 0; q < 4; ++q) yv[u][q] = *(const f16x4*)(y + q * 256);
                }
#pragma unroll
                for (int u = 0; u < R; ++u)
#pragma unroll
                    for (int q = 0; q < 4; ++q) xv[u][q] += (w[u] * gv[q]) * cvt4(yv[u][q]);
            }
        }
        if (FINAL) {
#pragma unroll
            for (int u = 0; u < R; ++u)
#pragma unroll
                for (int q = 0; q < 4; ++q) __builtin_nontemporal_store(xv[u][q], (f32x4*)(P.out + (size_t)(rb + u) * DM + q * 256 + lane * 4));
            continue;
        }
        float ss[R];
#pragma unroll
        for (int u = 0; u < R; ++u) {
            f16* xd = P.Xw() + (size_t)(rb + u) * DM; float sacc = 0.f;
#pragma unroll
            for (int q = 0; q < 4; ++q) { *(f16x4*)(xd + q * 256 + lane * 4) = pk4(xv[u][q]); sacc += dot4(xv[u][q], xv[u][q]); }
            ss[u] = sacc;
        }
#pragma unroll
        for (int u = 0; u < R; ++u) ss[u] = rsqrtf(wave_sum(ss[u], lane) * (1.0f / DM) + 1e-6f);
        const float* g = P.norm1_g + l * DM; const float* sh = modp(P, l, v, 0); const float* scl = modp(P, l, v, 1);
#pragma unroll
        for (int q = 0; q < 4; ++q) {
            const int c0 = q * 256 + lane * 4;
            const f32x4 gq = *(const f32x4*)(g + c0), sq = *(const f32x4*)(sh + c0), cq = *(const f32x4*)(scl + c0);
            const f32x4 gm = gq * (1.0f + cq);
#pragma unroll
            for (int u = 0; u < R; ++u) *(f16x4*)(P.Hw() + (size_t)(rb + u) * DM + c0) = rm4(pk4(xv[u][q] * ss[u] * gm + sq));
        }
    }
}

#define N2_ZST 81920
template <bool POOL>
__device__ __forceinline__ void phase_n2(const Params& P, int l, int bid, int nb, float* lds, int nrows = MROWS) {
    const int tid = opaque_tid(), wid = P.wv, lane = tid & 63;
    const float* wr = P.router_w + (size_t)l * DM * NEXP;
    f16* wh = (f16*)lds;
    for (int i = tid; i < DM * NEXP; i += NTHR) { const int d = i >> 4, e = i & 15; wh[e * 1032 + d] = (f16)wr[i]; }
    f16* h2s = (f16*)lds + 16640;
    LAS unsigned char* zst = (LAS unsigned char*)lds + N2_ZST;
    const int j = l >> 1, nblk = nrows >> 4;
    const f16* Zg = P.Z();
    const f16* Xg = P.X();
    f16x4 xr[2][4]; f16x4 zr[2][4];
    auto prefetch = [&](int blk) {
        const int R0 = blk * 16, rb = R0 + wid * 2;
        if (POOL) {
            int s0, L; if (R0 < NLAT) { s0 = (R0 >> 14) << 14; L = SEQ; } else { s0 = NLAT + (((R0 - NLAT) >> 8) << 8); L = CTXL; }
#pragma unroll
            for (int i = 0; i < 8; ++i) { const int piece = wid * 8 + i; int rr = R0 - 8 + (piece >> 1); rr = rr < s0 ? s0 : (rr > s0 + L - 1 ? s0 + L - 1 : rr);
                __builtin_amdgcn_global_load_lds((const unsigned*)(Zg + (size_t)rr * DM + (piece & 1) * 512 + lane * 8), (LAS unsigned*)(zst + piece * 1024), 16, 0, 0); }
        } else {
#pragma unroll
            for (int u = 0; u < 2; ++u)
#pragma unroll
                for (int q = 0; q < 4; ++q) zr[u][q] = *(const f16x4*)(Zg + (size_t)(rb + u) * DM + q * 256 + lane * 4);
        }
#pragma unroll
        for (int u = 0; u < 2; ++u)
#pragma unroll
            for (int q = 0; q < 4; ++q) xr[u][q] = *(const f16x4*)(Xg + (size_t)(rb + u) * DM + q * 256 + lane * 4);
    };
    int blk = bid;
    if (blk < nblk) prefetch(blk);
    __syncthreads();
    while (blk < nblk) {
        const int R0 = blk * 16, rb = R0 + wid * 2;
        int v, s0, L;
        if (rb < NLAT) { v = rb >> 14; s0 = v << 14; L = SEQ; } else { v = 2; s0 = NLAT + (((rb - NLAT) >> 8) << 8); L = CTXL; }
        const int t = rb - s0;
        f32x4 g1v[4], gmv[4], shv[4], psv[4];
        { const float* g1 = modp(P, l, v, 2); const float* g = P.norm2_g + l * DM; const float* sh = modp(P, l, v, 3); const float* scl = modp(P, l, v, 4);
#pragma unroll
            for (int q = 0; q < 4; ++q) { const int c0 = q * 256 + lane * 4;
                g1v[q] = *(const f32x4*)(g1 + c0); const f32x4 gv = *(const f32x4*)(g + c0), cv = *(const f32x4*)(scl + c0); shv[q] = *(const f32x4*)(sh + c0); gmv[q] = gv * (1.0f + cv);
                if (POOL) psv[q] = *(const f32x4*)(P.pool_scale + j * DM + c0); } }
        f32x4 y[2][4];
        if (POOL) {
            asm volatile("s_waitcnt vmcnt(0)" ::: "memory");
            __syncthreads();
#pragma unroll
            for (int q = 0; q < 4; ++q) {
                const int h = 1 << q;
                const LAS f16* zb = (const LAS f16*)zst + q * 256 + lane * 4;
                f32x4 common = (f32x4){0.f, 0.f, 0.f, 0.f}, z0 = common, z1 = common;
#pragma unroll
                for (int d = -h; d <= h; ++d) {
                    const int tt = t + d; const bool ok = tt >= 0 && tt < L;
                    f32x4 zz = cvt4(*(const LAS f16x4*)(zb + (2 * wid + 8 + d) * DM));
                    if (!ok) zz = (f32x4){0.f, 0.f, 0.f, 0.f};
                    if (d == -h) z0 = zz; else if (d == h) z1 = zz; else common += zz;
                    if (d == 0) y[0][q] = zz;
                    if (d == 1) y[1][q] = zz;
                }
                const int c0n = min(t + h, L) - max(t - h, 0), c1n = min(t + 1 + h, L) - max(t + 1 - h, 0);
                y[0][q] = ((common + z0) * (1.0f / (float)c0n) - y[0][q]) * psv[q];
                y[1][q] = ((common + z1) * (1.0f / (float)c1n) - y[1][q]) * psv[q];
            }
            asm volatile("s_waitcnt lgkmcnt(0)" ::: "memory");
            __syncthreads();
        } else {
#pragma unroll
            for (int u = 0; u < 2; ++u)
#pragma unroll
                for (int q = 0; q < 4; ++q) y[u][q] = cvt4(zr[u][q]);
        }
        f32x4 xv[2][4]; float ss[2] = {0.f, 0.f};
#pragma unroll
        for (int q = 0; q < 4; ++q) {
#pragma unroll
            for (int u = 0; u < 2; ++u) { xv[u][q] = cvt4(xr[u][q]) + g1v[q] * y[u][q]; ss[u] += dot4(xv[u][q], xv[u][q]); }
        }
        const int nxt = blk + nb;
        asm volatile("" ::: "memory");
        if (nxt < nblk) prefetch(nxt);
#pragma unroll
        for (int u = 0; u < 2; ++u)
#pragma unroll
            for (int q = 0; q < 4; ++q) *(f16x4*)(P.Xw() + (size_t)(rb + u) * DM + q * 256 + lane * 4) = pk4(xv[u][q]);
        ss[0] = wave_sum(ss[0], lane); ss[1] = wave_sum(ss[1], lane);
        const float rs[2] = {rsqrtf(ss[0] * (1.0f / DM) + 1e-6f), rsqrtf(ss[1] * (1.0f / DM) + 1e-6f)};
        f16x4 h2h[2][4];
#pragma unroll
        for (int q = 0; q < 4; ++q) {
            const int c0 = q * 256 + lane * 4;
#pragma unroll
            for (int u = 0; u < 2; ++u) { h2h[u][q] = pk4(xv[u][q] * rs[u] * gmv[q] + shv[q]); *(f16x4*)(P.Hw() + (size_t)(rb + u) * DM + c0) = rm4(h2h[u][q]); }
        }
        asm volatile("s_waitcnt lgkmcnt(0)" ::: "memory"); __builtin_amdgcn_s_barrier(); asm volatile("" ::: "memory");
#pragma unroll
        for (int q = 0; q < 4; ++q)
#pragma unroll
            for (int u = 0; u < 2; ++u) *(f16x4*)(h2s + (2 * wid + u) * 1032 + q * 256 + lane * 4) = h2h[u][q];
        asm volatile("s_waitcnt lgkmcnt(0)" ::: "memory"); __builtin_amdgcn_s_barrier(); asm volatile("" ::: "memory");
        if (wid == 0) {
            const int r16 = lane & 15, kq = lane >> 4;
            f32x4 lg = (f32x4){0.f, 0.f, 0.f, 0.f};
#pragma unroll 8
            for (int ks = 0; ks < 32; ++ks) {
                const f16x8 av = *(const f16x8*)(h2s + r16 * 1032 + ks * 32 + kq * 8), bv = *(const f16x8*)(wh + r16 * 1032 + ks * 32 + kq * 8);
                lg = __builtin_amdgcn_mfma_f32_16x16x32_f16(av, bv, lg, 0, 0, 0);
            }
#pragma unroll
            for (int jj = 0; jj < 4; ++jj) {
                float mx = lg[jj];
                mx = fmaxf(mx, shx<1>(mx, lane)); mx = fmaxf(mx, shx<2>(mx, lane)); mx = fmaxf(mx, shx<4>(mx, lane)); mx = fmaxf(mx, shx<8>(mx, lane));
                const float pe = __expf(lg[jj] - mx);
                float den = pe;
                den += shx<1>(den, lane); den += shx<2>(den, lane); den += shx<4>(den, lane); den += shx<8>(den, lane);
                P.affw()[(size_t)r16 * MROWS + R0 + 4 * kq + jj] = pe / den;
            }
        }
        blk = nxt;
    }
}

__device__ __forceinline__ void phase_topk(const Params& P, int bid, int nb, unsigned* lds, int nprob = 64) {
    unsigned* hist = lds; unsigned* misc = lds + 256; unsigned* wsa = lds + 272; unsigned* wsb = lds + 288;
    const int tid = opaque_tid(), wid = tid >> 6, lane = tid & 63;
    for (int p = bid; p < nprob; p += nb) {
        const int set = p >> 4, e = p & 15;
        const int n = set < 2 ? SEQ : CTXL, C = n >> 3;
        const int r0 = set < 2 ? set * SEQ : NLAT + (set - 2) * CTXL;
        const int slot0 = set < 2 ? set * 2048 : 4096 + (set - 2) * 32;
        unsigned key[32];
#pragma unroll
        for (int i4 = 0; i4 < 8; ++i4) { const int idx = tid * 32 + i4 * 4;
            f32x4 v = (f32x4){0.f, 0.f, 0.f, 0.f}; if (idx < n) v = *(const f32x4*)(P.aff() + (size_t)e * MROWS + r0 + idx);
#pragma unroll
            for (int jj = 0; jj < 4; ++jj) key[i4 * 4 + jj] = idx < n ? (__float_as_uint(v[jj]) + 1u) : 0u; }
        unsigned T = 0u;
        for (int bit = 29; bit >= 0; --bit) {
            const unsigned cand = T | (1u << bit);
            unsigned wc = 0u;
#pragma unroll
            for (int i = 0; i < 32; ++i) wc += (unsigned)__builtin_popcountll(__builtin_amdgcn_ballot_w64(key[i] >= cand));
            unsigned* cb = misc + ((bit & 1) << 3);
            if (lane == 0) cb[wid] = wc;
            __syncthreads();
            unsigned tot = 0u;
#pragma unroll
            for (int w = 0; w < 8; ++w) tot += cb[w];
            if (tot >= (unsigned)C) T = cand;
        }
        unsigned cg = 0u, ce = 0u;
#pragma unroll
        for (int i = 0; i < 32; ++i) { cg += key[i] > T ? 1u : 0u; ce += key[i] == T ? 1u : 0u; }
        unsigned ig = cg, ie = ce;
#pragma unroll
        for (int o = 1; o < 64; o <<= 1) { const unsigned a = shup(ig, o, lane), b = shup(ie, o, lane); if (lane >= o) { ig += a; ie += b; } }
        if (lane == 63) { wsa[wid] = ig; wsb[wid] = ie; }
        __syncthreads();
        unsigned bg = 0u, be = 0u, totg = 0u;
#pragma unroll
        for (int w = 0; w < 8; ++w) { const unsigned ga = wsa[w]; totg += ga; if (w < wid) { bg += ga; be += wsb[w]; } }
        const unsigned krem = (unsigned)C - totg;
        unsigned pg = bg + ig - cg, pe = be + ie - ce;
#pragma unroll
        for (int i4 = 0; i4 < 8; ++i4) {
            int iv[4];
#pragma unroll
            for (int jj = 0; jj < 4; ++jj) {
                const int i = i4 * 4 + jj, idx = tid * 32 + i;
                bool sel = false; unsigned rank = 0u;
                if (key[i] > T) { sel = true; rank = pg + (pe < krem ? pe : krem); ++pg; }
                else if (key[i] == T && key[i] != 0u) { if (pe < krem) { sel = true; rank = pg + pe; } ++pe; }
                if (sel) P.rowidx()[e * SLOTS_PAD + slot0 + (int)rank] = r0 + idx;
                iv[jj] = sel ? slot0 + (int)rank : -1;
            }
            if (tid * 32 + i4 * 4 < n) *(int4*)(P.inv() + (size_t)e * MROWS + r0 + tid * 32 + i4 * 4) = make_int4(iv[0], iv[1], iv[2], iv[3]);
        }
        if (set == 3) for (int i = SLOTS + tid; i < SLOTS_PAD; i += NTHR) P.rowidx()[e * SLOTS_PAD + i] = 0;
        __syncthreads();
    }
}

#define XB_TMO      128
#define XB_XCNT(j)  (256  + 64 * (j))
#define XB_XSUB(j)  (1280 + 64 * (j))
#define XB_XGEN(j)  (2304 + 64 * (j))
#define XB_TOP      3328
#define XB_TOPGEN   3392
#define XCD_BAR_WORDS 3456
#define XB_SPIN_CAP (1u << 18)
__device__ __forceinline__ unsigned xb_ld(unsigned* p)              { return __hip_atomic_load(p, __ATOMIC_RELAXED, __HIP_MEMORY_SCOPE_AGENT); }
__device__ __forceinline__ unsigned xb_add(unsigned* p, unsigned v) { return __hip_atomic_fetch_add(p, v, __ATOMIC_RELAXED, __HIP_MEMORY_SCOPE_AGENT); }
__device__ __forceinline__ unsigned xb_xcc_id() { return (unsigned)__builtin_amdgcn_s_getreg((3 << 11) | 20) & 0xFu; }
#define XB_SPIN(cond, bar) do { unsigned _sp = 0; while (cond) { __builtin_amdgcn_s_sleep(1); \
    if ((++_sp & 255u) == 0u) { if (xb_ld(&(bar)[XB_TMO])) break; if (_sp > XB_SPIN_CAP) { atomicAdd(&(bar)[XB_TMO], 1u); break; } } } } while (0)
struct XcdBarrier { unsigned* bar; unsigned x; volatile LAS unsigned* st; };
__device__ __forceinline__ XcdBarrier xcd_barrier_post(unsigned* bar, volatile LAS unsigned* st) {
    XcdBarrier b; b.bar = bar; b.x = xb_xcc_id(); b.st = st;
    if (threadIdx.x == 0) (void)xb_add(&bar[XB_XCNT(b.x)], 1u);
    return b;
}
__device__ __forceinline__ void xcd_barrier_complete(unsigned* bar, unsigned x, unsigned& nloc, unsigned& nx) {
    const unsigned G = gridDim.x * gridDim.y * gridDim.z;
    unsigned sum, cnt, mine, sp = 0u;
    for (;;) {
        sum = 0u; cnt = 0u; mine = 0u;
#pragma unroll
        for (unsigned j = 0; j < 16; ++j) { const unsigned c = xb_ld(&bar[XB_XCNT(j)]); sum += c; cnt += (c > 0u) ? 1u : 0u; mine = (j == x) ? c : mine; }
        if (sum == G) break;
        __builtin_amdgcn_s_sleep(1);
        if ((++sp & 255u) == 0u) { if (xb_ld(&bar[XB_TMO])) break; if (sp > XB_SPIN_CAP) { atomicAdd(&bar[XB_TMO], 1u); break; } }
    }
    nloc = mine > 0u ? mine : 1u; nx = cnt > 0u ? cnt : 1u;
}
__device__ __forceinline__ void xcd_barrier(const XcdBarrier& b) {
    asm volatile("s_waitcnt vmcnt(0)" ::: "memory");
    __syncthreads();
    if (threadIdx.x == 0) {
        unsigned* bar = b.bar; asm volatile("" : "+s"(bar));
        const unsigned bx = (unsigned)__builtin_amdgcn_readfirstlane((int)xb_xcc_id());
        __builtin_amdgcn_s_waitcnt(0);
        unsigned nloc = b.st[0], nx = b.st[1];
        if (nloc == 0u) { xcd_barrier_complete(bar, bx, nloc, nx); b.st[0] = nloc; b.st[1] = nx; }
        const unsigned old = xb_add(&bar[XB_XSUB(bx)], 1u);
        const unsigned gen = old / nloc;
        if (old + 1u == (gen + 1u) * nloc) {
            __builtin_amdgcn_fence(__ATOMIC_RELEASE, "agent");
            asm volatile("s_waitcnt vmcnt(0)" ::: "memory");
            const unsigned og = xb_add(&bar[XB_TOP], 1u);
            const unsigned tg = og / nx;
            if (og + 1u == (tg + 1u) * nx) xb_add(&bar[XB_TOPGEN], 1u);
            else XB_SPIN(xb_ld(&bar[XB_TOPGEN]) == tg, bar);
            __builtin_amdgcn_fence(__ATOMIC_ACQUIRE, "agent");
            xb_add(&bar[XB_XGEN(bx)], 1u);
            asm volatile("s_waitcnt vmcnt(0)" ::: "memory");
        } else {
            XB_SPIN(xb_ld(&bar[XB_XGEN(bx)]) == gen, bar);
            __builtin_amdgcn_fence(__ATOMIC_ACQUIRE, "agent");
            asm volatile("s_waitcnt vmcnt(0)" ::: "memory");
        }
    }
    __syncthreads();
}

namespace fg {
constexpr int BM = 256, BK = 64, HALF = 128, HTB = HALF * BK * 2, STAGE_BYTES = 8 * HTB;
__device__ __forceinline__ int lds_byte(int r, int c) { const int st = (r >> 4) * 2 + (c >> 5), rr = r & 15, cc = c & 31, ob = rr * 64 + cc * 2; return st * 1024 + (ob ^ (((ob >> 9) & 1) << 5)); }
__device__ __forceinline__ void stage_rc(int b, int& R, int& C) { const int st = b / 1024, sb = b % 1024, swz = sb ^ (((sb >> 9) & 1) << 5); R = (st >> 1) * 16 + swz / 64; C = (st & 1) * 32 + (swz % 64) / 2; }
__device__ __forceinline__ int perm32(int rho) { const int n = rho >> 4, i = rho & 15; return 8 * (i >> 2) + 4 * n + (i & 3); }
#define KDUP 0
struct Unit { int e, pm, pn; int skip; };
__device__ __forceinline__ void xcd_order(int i, int& T) { const int c = blockIdx.x; T = i * (int)gridDim.x + c; }

template <class PR>
__device__ __forceinline__ void gemm_phase(LAS unsigned char* lds, const PR& S, int wv) {
    const int tid = opaque_tid_(wv), wid = __builtin_amdgcn_readfirstlane(tid >> 6), lane = tid & 63, wr = wid >> 2, wc = wid & 3, fr = lane & 15, fq = lane >> 4;
    constexpr int K = PR::K, nt = K / BK;
    unsigned voffB[2];
#pragma unroll
    for (int i = 0; i < 2; ++i) { int R, C; stage_rc(tid * 16 + i * 8192, R, C); const int Rb = (R & ~31) + perm32(R & 31); voffB[i] = (unsigned)(Rb * PR::LDB + C) * 2u; }
    const size_t kstep = (size_t)(BK * 2);
    const size_t hB = S.hstepB();
    const unsigned ldsw = (unsigned)wid * 1024u;
    const int aoff = lds_byte(wr * 64 + fr, fq * 8), boff = lds_byte(wc * 32 + fr, fq * 8);
#define FG_SA(b, h) (((b) * 2 + (h)) * HTB)
#define FG_SB(b, h) ((4 + (b) * 2 + (h)) * HTB)
#define FG_STAGE(bufoff, gbase, voff) do { _Pragma("unroll") for (int _i = 0; _i < 2; ++_i) \
        __builtin_amdgcn_global_load_lds((const unsigned*)((const char*)(gbase) + (voff)[_i]), (LAS unsigned*)(lds + (bufoff) + ldsw + _i * 8192), 16, 0, 0); } while (0)
#define FG_LDA(dst, b, h) do { _Pragma("unroll") for (int m = 0; m < 4; ++m) _Pragma("unroll") for (int k = 0; k < 2; ++k) dst[m][k] = *(const LAS f16x8*)(lds + FG_SA(b, h) + aoff + m * 2048 + k * 1024); } while (0)
#define FG_LDB(dst, b, h) do { _Pragma("unroll") for (int n = 0; n < 2; ++n) _Pragma("unroll") for (int k = 0; k < 2; ++k) dst[n][k] = *(const LAS f16x8*)(lds + FG_SB(b, h) + boff + n * 2048 + k * 1024); } while (0)
#define FG_MMA(ai, bj, At, Bt) do { __builtin_amdgcn_s_setprio(1); _Pragma("unroll") for (int m = 0; m < 4; ++m) _Pragma("unroll") for (int n = 0; n < 2; ++n) _Pragma("unroll") for (int k = 0; k < 2; ++k) \
        acc[ai][bj][m][n] = __builtin_amdgcn_mfma_f32_16x16x32_f16(Bt[n][k], At[m][k], acc[ai][bj][m][n], 0, 0, 0); __builtin_amdgcn_s_setprio(0); } while (0)
#define FG_WAIT_V(n) asm volatile("s_waitcnt vmcnt(" #n ")" ::: "memory")
#define FG_WAIT_L(n) asm volatile("s_waitcnt lgkmcnt(" #n ")" ::: "memory")
#define FG_BAR __builtin_amdgcn_s_barrier()
#define FG_SCHED __builtin_amdgcn_sched_barrier(0)
    Unit cur, nxt; int ui = 0;
    if (!S.next(0, cur)) return;
    f32x4 acc[2][2][4][2];
#pragma unroll
    for (int a = 0; a < 2; ++a)
#pragma unroll
        for (int b = 0; b < 2; ++b)
#pragma unroll
            for (int m = 0; m < 4; ++m)
#pragma unroll
                for (int n = 0; n < 2; ++n) acc[a][b][m][n] = (f32x4){0.f, 0.f, 0.f, 0.f};
    f16x8 At[4][2], B0[2][2], B1[2][2];
    unsigned vA[2][2], vN[2][2];
    { int Rr[2], Cc[2]; stage_rc(tid * 16, Rr[0], Cc[0]); stage_rc(tid * 16 + 8192, Rr[1], Cc[1]); S.a_voff(cur, Rr, Cc, vA); }
#pragma unroll
    for (int h = 0; h < 2; ++h)
#pragma unroll
        for (int i = 0; i < 2; ++i) { asm volatile("" : "+v"(vA[h][i])); vN[h][i] = vA[h][i]; }
    const char* cA = S.a_base(cur); const char* cB = S.b_base(cur);
    FG_STAGE(FG_SB(0, 0), cB, voffB); FG_STAGE(FG_SA(0, 0), cA, vA[0]); FG_STAGE(FG_SB(0, 1), cB + hB, voffB); FG_STAGE(FG_SA(0, 1), cA, vA[1]);
    if (wr == 1) FG_BAR;
    FG_WAIT_V(4); FG_BAR;
    FG_STAGE(FG_SB(1, 0), cB + kstep, voffB); FG_STAGE(FG_SA(1, 0), cA + kstep, vA[0]); FG_STAGE(FG_SB(1, 1), cB + hB + kstep, voffB);
    FG_WAIT_V(6); FG_BAR;
    for (;;) {
        const bool has_next = S.next(ui + 1, nxt);
        const char* nA = has_next ? S.a_base(nxt) : cA; const char* nB = has_next ? S.b_base(nxt) : cB;
        if (has_next) { int Rr[2], Cc[2]; int t2 = tid; asm volatile("" : "+v"(t2)); stage_rc(t2 * 16, Rr[0], Cc[0]); stage_rc(t2 * 16 + 8192, Rr[1], Cc[1]); S.a_voff(nxt, Rr, Cc, vN);
#pragma unroll
            for (int h = 0; h < 2; ++h)
#pragma unroll
                for (int i = 0; i < 2; ++i) asm volatile("" : "+v"(vN[h][i])); }
#pragma unroll 1
        for (int t = 0; t < nt; t += 2) {
            const bool last = (t == nt - 2);
            const char* a1 = cA + (size_t)(t + 1) * kstep;
            const char* a2 = last ? nA : cA + (size_t)(t + 2) * kstep; const char* b2 = last ? nB : cB + (size_t)(t + 2) * kstep;
            const char* a3 = a2 + kstep; const char* b3 = b2 + kstep;
            unsigned v2[2][2];
#pragma unroll
            for (int h = 0; h < 2; ++h)
#pragma unroll
                for (int i = 0; i < 2; ++i) v2[h][i] = last ? vN[h][i] : vA[h][i];
            FG_LDB(B0, 0, 0); FG_SCHED; FG_LDA(At, 0, 0); FG_STAGE(FG_SA(1, 1), a1, vA[1]);
            FG_WAIT_L(8); FG_BAR; FG_WAIT_L(0); FG_MMA(0, 0, At, B0); FG_BAR; FG_SCHED;
            FG_LDB(B1, 0, 1); FG_STAGE(FG_SB(0, 0), b2, voffB);
            FG_BAR; FG_WAIT_L(0); FG_MMA(0, 1, At, B1); FG_BAR;
            FG_LDA(At, 0, 1); FG_STAGE(FG_SA(0, 0), a2, v2[0]);
            FG_BAR; FG_WAIT_L(0); FG_MMA(1, 0, At, B0); FG_BAR; FG_SCHED;
            FG_STAGE(FG_SB(0, 1), b2 + hB, voffB);
            FG_WAIT_V(6); FG_BAR; FG_MMA(1, 1, At, B1); FG_BAR;
            FG_LDB(B0, 1, 0); FG_SCHED; FG_LDA(At, 1, 0); FG_STAGE(FG_SA(0, 1), a2, v2[1]);
            FG_WAIT_L(8); FG_BAR; FG_WAIT_L(0); FG_MMA(0, 0, At, B0); FG_BAR; FG_SCHED;
            FG_LDB(B1, 1, 1); FG_STAGE(FG_SB(1, 0), b3, voffB);
            FG_BAR; FG_WAIT_L(0); FG_MMA(0, 1, At, B1); FG_BAR;
            FG_LDA(At, 1, 1); FG_STAGE(FG_SA(1, 0), a3, v2[0]);
            FG_BAR; FG_WAIT_L(0); FG_MMA(1, 0, At, B0); FG_BAR; FG_SCHED;
            FG_STAGE(FG_SB(1, 1), b3 + hB, voffB);
            FG_WAIT_V(6); FG_BAR; FG_MMA(1, 1, At, B1); FG_BAR;
        }
        if (!KDUP || !cur.skip) S.epi(acc, cur, wr, wc, fr, fq);
        if (!has_next) break;
#pragma unroll
        for (int a = 0; a < 2; ++a)
#pragma unroll
            for (int b = 0; b < 2; ++b)
#pragma unroll
                for (int m = 0; m < 4; ++m)
#pragma unroll
                    for (int n = 0; n < 2; ++n) acc[a][b][m][n] = (f32x4){0.f, 0.f, 0.f, 0.f};
        cur = nxt; cA = nA; cB = nB; ++ui;
#pragma unroll
        for (int h = 0; h < 2; ++h)
#pragma unroll
            for (int i = 0; i < 2; ++i) vA[h][i] = vN[h][i];
    }
    FG_WAIT_V(0);
    if (wr == 0) FG_BAR;
    FG_BAR;
#undef FG_SA
#undef FG_SB
#undef FG_STAGE
#undef FG_LDA
#undef FG_LDB
#undef FG_MMA
#undef FG_WAIT_V
#undef FG_WAIT_L
#undef FG_BAR
#undef FG_SCHED
}

__device__ __forceinline__ f16x8 pack8(const f32x4 a, const f32x4 b) { return (f16x8){(f16)a[0], (f16)a[1], (f16)a[2], (f16)a[3], (f16)b[0], (f16)b[1], (f16)b[2], (f16)b[3]}; }

template <int K_, int LDA_, int LDB_> struct PRBase {
    static constexpr int K = K_, LDA = LDA_, LDB = LDB_;
    __device__ __forceinline__ void plain_voff(const int (&R)[2], const int (&C)[2], unsigned (&v)[2][2]) const {
#pragma unroll
        for (int h = 0; h < 2; ++h)
#pragma unroll
            for (int i = 0; i < 2; ++i) v[h][i] = (unsigned)((h * HALF + R[i]) * LDA + C[i]) * 2u;
    }
};
struct PRGateUp : PRBase<1024, 1024, 1024> {
    const f16* H; const int* rowidx; const f16* W; f16* act; int nunits; int bid; int rt;
    __device__ __forceinline__ size_t hstepB() const { return (size_t)DEXP * DM * 2; }
    __device__ __forceinline__ bool next(int i, Unit& u) const { const int ii = KDUP ? (i >> 1) : i; const int T = ii * (int)gridDim.x + bid; u.skip = KDUP ? ((i & 1) == 0) : 0; if (T >= nunits) return false;
        if (rt == 16 && gridDim.x == 256) { const int x = bid & 7, jj = bid >> 3; u.e = ii; u.pm = (x >> 1) * 4 + (jj >> 3); u.pn = (x & 1) * 8 + (jj & 7); return true; }
        const int per = rt * 16; u.e = T / per; const int t = T % per; u.pm = t >> 4; u.pn = t & 15; return true; }
    __device__ __forceinline__ const char* a_base(const Unit&) const { return (const char*)H; }
    __device__ __forceinline__ void a_voff(const Unit& u, const int (&R)[2], const int (&C)[2], unsigned (&v)[2][2]) const {
        const int* ri = rowidx + u.e * SLOTS_PAD + u.pm * BM;
#pragma unroll
        for (int h = 0; h < 2; ++h)
#pragma unroll
            for (int i = 0; i < 2; ++i) { const int g = ri[h * HALF + R[i]]; v[h][i] = (unsigned)(g * LDA + C[i]) * 2u; }
    }
    __device__ __forceinline__ const char* b_base(const Unit& u) const { return (const char*)(W + ((size_t)u.e * 2 * DEXP + (size_t)u.pn * HALF) * DM); }
    __device__ __forceinline__ void epi(const f32x4 (&acc)[2][2][4][2], const Unit& u, int wr, int wc, int fr, int fq) const {
        f16* base = act + ((size_t)u.e * SLOTS_PAD + (size_t)u.pm * BM + wr * 64 + fr) * DEXP + u.pn * HALF + wc * 32 + fq * 8;
#pragma unroll
        for (int ai = 0; ai < 2; ++ai)
#pragma unroll
            for (int m = 0; m < 4; ++m) {
                f32x4 o0, o1;
#pragma unroll
                for (int j = 0; j < 4; ++j) { o0[j] = silu_f(acc[ai][0][m][0][j]) * acc[ai][1][m][0][j]; o1[j] = silu_f(acc[ai][0][m][1][j]) * acc[ai][1][m][1][j]; }
                if (u.e < 8) __builtin_nontemporal_store(rm8(pack8(o0, o1)), (f16x8*)(base + (size_t)(ai * HALF + m * 16) * DEXP));
                else *(f16x8*)(base + (size_t)(ai * HALF + m * 16) * DEXP) = rm8(pack8(o0, o1));
            }
    }
};
struct PRDown : PRBase<2048, 2048, 2048> {
    const f16* act; const f16* W; f16* y; int nunits; int bid; int rt;
    __device__ __forceinline__ size_t hstepB() const { return (size_t)HALF * DEXP * 2; }
    __device__ __forceinline__ bool next(int i, Unit& u) const { const int ii = KDUP ? (i >> 1) : i; const int T = ii * (int)gridDim.x + bid; u.skip = KDUP ? ((i & 1) == 0) : 0; if (T >= nunits) return false;
        if (rt == 16 && gridDim.x == 256) { const int x = bid & 7, jj = bid >> 3; u.e = 15 - (ii * 4 + (x >> 1)); u.pm = (x & 1) * 8 + (jj >> 2); u.pn = jj & 3; return true; }
        const int per = rt * 4; u.e = T / per; const int t = T % per; u.pm = t >> 2; u.pn = t & 3; return true; }
    __device__ __forceinline__ const char* a_base(const Unit& u) const { return (const char*)(act + ((size_t)u.e * SLOTS_PAD + (size_t)u.pm * BM) * DEXP); }
    __device__ __forceinline__ void a_voff(const Unit&, const int (&R)[2], const int (&C)[2], unsigned (&v)[2][2]) const { plain_voff(R, C, v); }
    __device__ __forceinline__ const char* b_base(const Unit& u) const { return (const char*)(W + ((size_t)u.e * DM + (size_t)u.pn * BM) * DEXP); }
    __device__ __forceinline__ void epi(const f32x4 (&acc)[2][2][4][2], const Unit& u, int wr, int wc, int fr, int fq) const {
        f16* base = y + ((size_t)u.e * SLOTS_PAD + (size_t)u.pm * BM + wr * 64 + fr) * DM + u.pn * BM + wc * 32 + fq * 8;
#pragma unroll
        for (int ai = 0; ai < 2; ++ai)
#pragma unroll
            for (int m = 0; m < 4; ++m)
#pragma unroll
                for (int bj = 0; bj < 2; ++bj) *(f16x8*)(base + (size_t)(ai * HALF + m * 16) * DM + bj * HALF) = pack8(acc[ai][bj][m][0], acc[ai][bj][m][1]);
    }
};
template <int K_> struct PRDense : PRBase<K_, 1024, K_> {
    const f16* A; const f16* W; f16* O0; f16* O1; f16* O2; int ncol; int mode; int bid; int npan; int kvx;
    __device__ __forceinline__ size_t hstepB() const { return (size_t)HALF * K_ * 2; }
    __device__ __forceinline__ bool next(int i, Unit& u) const { const int ii = KDUP ? (i >> 1) : i; int T = ii * (int)gridDim.x + bid; if (gridDim.x == 256) T = (ii * 8 + (bid & 7)) * 32 + (bid >> 3);
        u.skip = KDUP ? ((i & 1) == 0) : 0; const int nu = npan * ncol; if (T >= nu + kvx) return false; u.e = 0; if (T < nu) { u.pm = T / ncol; u.pn = T % ncol; } else { const int x = T - nu; u.pm = npan + (x >> 1); u.pn = 4 + (x & 1); } return true; }
    __device__ __forceinline__ const char* a_base(const Unit& u) const { return (const char*)(A + (size_t)u.pm * BM * 1024 + (mode == 2 ? u.pn * 256 : 0)); }
    __device__ __forceinline__ void a_voff(const Unit&, const int (&R)[2], const int (&C)[2], unsigned (&v)[2][2]) const { this->plain_voff(R, C, v); }
    __device__ __forceinline__ const char* b_base(const Unit& u) const { return (const char*)(W + (size_t)u.pn * BM * K_); }
    const float* qn; const float* kn; const float* rope; LAS float* xs; int lane;
    __device__ __forceinline__ void epi(const f32x4 (&acc)[2][2][4][2], const Unit& u, int wr, int wc, int fr, int fq) const {
        f16* base; int ld;
        const int row = u.pm * BM + wr * 64 + fr, colw = wc * 32 + fq * 8;
        if (mode == 1) { if (u.pn < 4) { base = O0 + (size_t)row * 1024 + u.pn * BM + colw; ld = 1024; } else if (u.pn == 4) { base = O1 + (size_t)row * 256 + colw; ld = 256; } else { base = O2 + (size_t)row * 256 + colw; ld = 256; } }
        else { base = O0 + (size_t)row * 1024 + u.pn * BM + colw; ld = 1024; }
        if (mode == 1 && u.pn < 5) {
            float ssq[2][4][2];
#pragma unroll
            for (int ai = 0; ai < 2; ++ai)
#pragma unroll
                for (int m = 0; m < 4; ++m)
#pragma unroll
                    for (int bj = 0; bj < 2; ++bj) { const f32x4 a = acc[ai][bj][m][0], b = acc[ai][bj][m][1];
                        float t = (a[0] * a[0] + a[1] * a[1]) + (a[2] * a[2] + a[3] * a[3]) + (b[0] * b[0] + b[1] * b[1]) + (b[2] * b[2] + b[3] * b[3]);
                        t += shx<16>(t, lane); t += shx<32>(t, lane); ssq[ai][m][bj] = t; }
            LAS float* mine = xs + ((wr * 4 + wc) * 16) * 16 + fr; const LAS float* theirs = xs + ((wr * 4 + (wc ^ 1)) * 16) * 16 + fr;
            if (fq == 0) {
#pragma unroll
                for (int ai = 0; ai < 2; ++ai)
#pragma unroll
                    for (int m = 0; m < 4; ++m)
#pragma unroll
                        for (int bj = 0; bj < 2; ++bj) mine[(ai * 8 + m * 2 + bj) * 16] = ssq[ai][m][bj];
            }
            asm volatile("s_waitcnt lgkmcnt(0)" ::: "memory"); __builtin_amdgcn_s_barrier(); asm volatile("" ::: "memory");
            const bool isq = u.pn < 4, lat = u.pm < 128;
            const float* nw = (isq ? qn : kn) + (wc & 1) * 32 + fq * 8;
            const f32x4 w0 = *(const f32x4*)nw, w1 = *(const f32x4*)(nw + 4);
            const float qs = isq ? 0.125f * 1.4426950408889634f : 1.0f;
#pragma unroll
            for (int ai = 0; ai < 2; ++ai)
#pragma unroll
                for (int m = 0; m < 4; ++m) {
                    f32x4 c0 = (f32x4){1.f, 1.f, 1.f, 1.f}, s0 = (f32x4){0.f, 0.f, 0.f, 0.f};
                    if (lat) { const int t = (row + ai * HALF + m * 16) & (SEQ - 1); const int pos = (wc & 1) ? (t & 63) : (t >> 6);
                        const float* tb = rope + (size_t)(pos * 16 + fq * 4) * 2; const f32x4 ta = *(const f32x4*)tb, tb2 = *(const f32x4*)(tb + 4);
                        c0 = (f32x4){ta[0], ta[2], tb2[0], tb2[2]}; s0 = (f32x4){ta[1], ta[3], tb2[1], tb2[3]}; }
#pragma unroll
                    for (int bj = 0; bj < 2; ++bj) {
                        const float tot = ssq[ai][m][bj] + theirs[(ai * 8 + m * 2 + bj) * 16];
                        const float rstd = rsqrtf(tot * (1.0f / 64.0f) + 1e-6f) * qs;
                        f32x4 a = acc[ai][bj][m][0] * rstd * w0, b = acc[ai][bj][m][1] * rstd * w1;
                        const f32x4 ra = (f32x4){a[0] * c0[0] - a[1] * s0[0], a[0] * s0[0] + a[1] * c0[0], a[2] * c0[1] - a[3] * s0[1], a[2] * s0[1] + a[3] * c0[1]};
                        const f32x4 rb = (f32x4){b[0] * c0[2] - b[1] * s0[2], b[0] * s0[2] + b[1] * c0[2], b[2] * c0[3] - b[3] * s0[3], b[2] * s0[3] + b[3] * c0[3]};
                        *(f16x8*)(base + (size_t)(ai * HALF + m * 16) * ld + bj * HALF) = rm8(pack8(ra, rb));
                    }
                }
            return;
        }
#pragma unroll
        for (int ai = 0; ai < 2; ++ai)
#pragma unroll
            for (int m = 0; m < 4; ++m)
#pragma unroll
                for (int bj = 0; bj < 2; ++bj) { const f16x8 o = pack8(acc[ai][bj][m][0], acc[ai][bj][m][1]); *(f16x8*)(base + (size_t)(ai * HALF + m * 16) * ld + bj * HALF) = (mode == 1) ? rm8(o) : o; }
    }
};
}

struct CvtJob { const float* src; f16* dst; int K, N, k0, n0; };
__device__ __forceinline__ bool cvt_job(const Params& P, int l, int u, CvtJob& jb, bool experts) {
    const int j = l >> 1;
    const int nexp = experts ? NEXP * 3 * 128 : 0;
    const int nmix = (l & 1) == 0 ? 16 : (96 + 64);
    if (u >= nexp + nmix) return false;
    if (u < nexp) {
        const int e = u / 384, r = u % 384, which = r >> 7, t = r & 127;
        if (which < 2) { jb.src = (which == 0 ? P.w_gate : P.w_up) + ((size_t)l * NEXP + e) * DM * DEXP; jb.dst = P.Wgu() + ((size_t)e * 2 + which) * DEXP * DM; jb.K = DM; jb.N = DEXP; jb.k0 = (t >> 4) * 128; jb.n0 = (t & 15) * 128; }
        else { jb.src = P.w_down + ((size_t)l * NEXP + e) * DEXP * DM; jb.dst = P.Wd() + (size_t)e * DM * DEXP; jb.K = DEXP; jb.N = DM; jb.k0 = (t >> 3) * 128; jb.n0 = (t & 7) * 128; }
    } else {
        const int t = u - nexp;
        if ((l & 1) == 0) { const int g = t >> 2, tt = t & 3; jb.src = P.pool_w + (size_t)(j * 4 + g) * 65536; jb.dst = P.Wmix() + (size_t)g * 65536; jb.K = 256; jb.N = 256; jb.k0 = (tt >> 1) * 128; jb.n0 = (tt & 1) * 128; }
        else if (t < 96) { jb.src = P.w_qkv + (size_t)j * DM * QKVD; jb.dst = P.Wmix(); jb.K = DM; jb.N = QKVD; jb.k0 = (t / 12) * 128; jb.n0 = (t % 12) * 128; }
        else { const int tt = t - 96; jb.src = P.w_o + (size_t)j * DM * DM; jb.dst = P.Wmix() + (size_t)QKVD * DM; jb.K = DM; jb.N = DM; jb.k0 = (tt >> 3) * 128; jb.n0 = (tt & 7) * 128; }
    }
    return true;
}
__device__ __forceinline__ void phase_convert(const Params& P, int l, int bid, int nb, f16* tile, bool experts = true) {
    const int tid = opaque_tid();
    CvtJob jb;
    int u = bid;
    bool have = cvt_job(P, l, u, jb, experts);
    f32x4 r[8];
    if (have) {
#pragma unroll
        for (int p = 0; p < 8; ++p) { const int id = tid + p * NTHR, kr = id >> 5, c4 = (id & 31) * 4; r[p] = __builtin_nontemporal_load((const f32x4*)(jb.src + (size_t)(jb.k0 + kr) * jb.N + jb.n0 + c4)); }
    }
    while (have) {
        __syncthreads();
#pragma unroll
        for (int p = 0; p < 8; ++p) { const int id = tid + p * NTHR, kr = id >> 5, c4 = (id & 31) * 4; *(f16x4*)(tile + kr * 136 + c4) = pk4(r[p]); }
        __syncthreads();
        const CvtJob cur = jb;
        u += nb; have = cvt_job(P, l, u, jb, experts);
        if (have) {
#pragma unroll
            for (int p = 0; p < 8; ++p) { const int id = tid + p * NTHR, kr = id >> 5, c4 = (id & 31) * 4; r[p] = __builtin_nontemporal_load((const f32x4*)(jb.src + (size_t)(jb.k0 + kr) * jb.N + jb.n0 + c4)); }
        }
        const int n = tid & 127, kg = (tid >> 7) * 32;
        f16* dp = cur.dst + (size_t)(cur.n0 + n) * cur.K + cur.k0 + kg;
#pragma unroll
        for (int i = 0; i < 4; ++i) { f16x8 o;
#pragma unroll
            for (int e = 0; e < 8; ++e) o[e] = tile[(kg + i * 8 + e) * 136 + n];
            *(f16x8*)(dp + i * 8) = rmw8(o); }
    }
}
template <bool GATEUP, bool CTX>
__device__ __forceinline__ void phase_cvt_ctx(const Params& P, int l, int bid, int nb, f16* tile, int sel = -1, bool alt = false) {
    const int tid = opaque_tid(), wid = P.wv, lane = tid & 63, r16 = lane & 15, kq = lane >> 4;
    constexpr int NC = GATEUP ? 128 : 64;
    constexpr int KT = GATEUP ? 8 : 16, K = GATEUP ? DM : DEXP, N = GATEUP ? DEXP : DM, NB = N / NC;
    constexpr int NT = GATEUP ? 2 * KT : KT;
    const int sel_ = (GATEUP && !CTX) ? sel : -1; const int ntr = (GATEUP && sel_ < 0) ? NT : KT;
    constexpr int TS = NC + 4, TW = 128 * TS;
    constexpr int NLD = NC / 16;
    constexpr int WPC = 8 / (NC / 16);
    constexpr int NRB = 4 / WPC;
    const int cb = wid % (NC / 16), rb0 = (wid / (NC / 16)) * NRB;
    f16* asl = tile + 2 * TW;
    for (int job = bid; job < NEXP * NB; job += nb) {
        const int e = job / NB, nbk = job % NB;
        const f16* ap[2];
        if (CTX) {
#pragma unroll
            for (int p = 0; p < 2; ++p) { const int row = (tid >> 4) + p * 32;
                if (GATEUP) ap[p] = P.H() + (size_t)P.rowidx()[e * SLOTS_PAD + 4096 + row] * DM + (tid & 15) * 8;
                else ap[p] = P.act() + ((size_t)e * SLOTS_PAD + 4096 + row) * DEXP + (tid & 15) * 8; }
        }
        f32x4 acc[2][NRB];
#pragma unroll
        for (int w = 0; w < 2; ++w)
#pragma unroll
            for (int rb = 0; rb < NRB; ++rb) acc[w][rb] = (f32x4){0.f, 0.f, 0.f, 0.f};
        const float* srcs[2]; f16* dsts[2];
        if (GATEUP) { const size_t wo = ((size_t)l * NEXP + e) * DM * DEXP; srcs[0] = P.w_gate + wo; srcs[1] = P.w_up + wo; dsts[0] = P.Wgu() + (alt ? (OFF_WGU3 - OFF_WGU) / 2 : 0) + ((size_t)e * 2) * DEXP * DM; dsts[1] = dsts[0] + (size_t)DEXP * DM; }
        else { srcs[0] = P.w_down + ((size_t)l * NEXP + e) * DEXP * DM; srcs[1] = srcs[0]; dsts[0] = P.Wd() + (alt ? (OFF_WD3 - OFF_WD) / 2 : 0) + (size_t)e * DM * DEXP; dsts[1] = dsts[0]; }
        f32x4 r[2][NLD]; f16x8 ar[2][2];
        const unsigned ldoff = (unsigned)(((tid / (NC / 4)) * N + (tid % (NC / 4)) * 4) * 4);
#define CV_LOAD(ti, slot) do { const int which_ = GATEUP ? (sel_ >= 0 ? sel_ : ((ti) & 1)) : 0, kt_ = (GATEUP && sel_ < 0) ? ((ti) >> 1) : (ti); const char* sp_ = (const char*)(srcs[which_] + (size_t)(kt_ * 128) * N + nbk * NC); \
            _Pragma("unroll") for (int p = 0; p < NLD; ++p) r[slot][p] = __builtin_nontemporal_load((const f32x4*)(sp_ + (size_t)p * (NTHR / (NC / 4)) * N * 4 + ldoff)); \
            if (CTX) { _Pragma("unroll") for (int p = 0; p < 2; ++p) ar[slot][p] = *(const f16x8*)(ap[p] + kt_ * 128); } } while (0)
#define CV_TILE(ti, slot) do { const int which = GATEUP ? (sel_ >= 0 ? sel_ : ((ti) & 1)) : 0, kt = (GATEUP && sel_ < 0) ? ((ti) >> 1) : (ti); \
            f16* tl = tile + (slot) * TW; f16* al = asl + (slot) * (64 * 128); \
            _Pragma("unroll") for (int p = 0; p < NLD; ++p) { const int id = tid + p * NTHR, kr = id / (NC / 4), c4 = (id % (NC / 4)) * 4; *(f16x4*)(tl + kr * TS + c4) = pk4(r[slot][p]); } \
            if (CTX) { _Pragma("unroll") for (int p = 0; p < 2; ++p) { const int row = (tid >> 4) + p * 32; *(f16x8*)(al + row * 128 + (((tid & 15) ^ (row & 15)) * 8)) = ar[slot][p]; } } \
            if ((ti) + 2 < ntr) CV_LOAD((ti) + 2, slot); \
            asm volatile("s_waitcnt lgkmcnt(0)" ::: "memory"); __builtin_amdgcn_s_barrier(); asm volatile("" ::: "memory"); \
            f16* dp = dsts[which] + (size_t)(nbk * NC + cb * 16 + r16) * K + kt * 128 + kq * 8; \
            _Pragma("unroll") for (int ks = 0; ks < 4; ++ks) { f16x8 bv; \
                _Pragma("unroll") for (int i = 0; i < 8; ++i) bv[i] = tl[(ks * 32 + kq * 8 + i) * TS + cb * 16 + r16]; \
                if (rb0 == 0) *(f16x8*)(dp + ks * 32) = rmw8(bv); \
                if (CTX) { _Pragma("unroll") for (int rb = 0; rb < NRB; ++rb) { const int row = (rb0 + rb) * 16 + r16; const f16x8 af = *(const f16x8*)(al + row * 128 + (((ks * 4 + kq) ^ r16) * 8)); \
                    acc[which][rb] = __builtin_amdgcn_mfma_f32_16x16x32_f16(bv, af, acc[which][rb], 0, 0, 0); } } } } while (0)
        CV_LOAD(0, 0); CV_LOAD(1, 1);
        for (int t2 = 0; t2 < ntr; t2 += 2) { CV_TILE(t2, 0); CV_TILE(t2 + 1, 1); }
#undef CV_LOAD
#undef CV_TILE
        asm volatile("s_waitcnt lgkmcnt(0)" ::: "memory"); __builtin_amdgcn_s_barrier(); asm volatile("" ::: "memory");
        if (CTX) {
#pragma unroll
            for (int rb = 0; rb < NRB; ++rb) {
                const size_t row = (size_t)e * SLOTS_PAD + 4096 + (rb0 + rb) * 16 + r16; const int col = nbk * NC + cb * 16 + 4 * kq;
                if (GATEUP) { f32x4 o;
#pragma unroll
                    for (int jj = 0; jj < 4; ++jj) o[jj] = silu_f(acc[0][rb][jj]) * acc[1][rb][jj];
                    *(f16x4*)(P.act() + row * DEXP + col) = pk4(o); }
                else *(f16x4*)(P.yslot() + row * DM + col) = pk4(acc[0][rb]);
            }
        }
    }
}

__device__ __forceinline__ void cvt3_job(const Params& P, int job, f16* tile) {
    if (job < 256) phase_cvt_ctx<false, false>(P, 3, job, 1 << 20, tile, -1, true);
    else { const int h = job - 256; phase_cvt_ctx<true, false>(P, 3, h >> 1, 1 << 20, tile, h & 1, true); }
}
__device__ __forceinline__ void phase_gateup_fast(const Params& P, LAS unsigned char* lds, int rt = 17, bool alt = false) { fg::PRGateUp S; S.H = P.H(); S.rowidx = P.rowidx(); S.W = P.Wgu() + (alt ? (OFF_WGU3 - OFF_WGU) / 2 : 0); S.act = P.act(); S.rt = rt; S.nunits = 16 * rt * 16; S.bid = opaque_bid(); fg::gemm_phase(lds, S, P.wv); }
__device__ __forceinline__ void phase_down_fast(const Params& P, LAS unsigned char* lds, int rt = 17, bool alt = false) { fg::PRDown S; S.act = P.act(); S.W = P.Wd() + (alt ? (OFF_WD3 - OFF_WD) / 2 : 0); S.y = P.yslot(); S.rt = rt; S.nunits = 16 * rt * 4; S.bid = opaque_bid(); fg::gemm_phase(lds, S, P.wv); }
__device__ __forceinline__ void phase_pool_fast(const Params& P, LAS unsigned char* lds) { fg::PRDense<256> S; S.qn = nullptr; S.kn = nullptr; S.rope = nullptr; S.xs = nullptr; S.lane = 0; S.npan = 130; S.kvx = 0; S.A = P.H(); S.W = P.Wmix(); S.O0 = P.Z(); S.O1 = nullptr; S.O2 = nullptr; S.ncol = 4; S.mode = 2; S.bid = opaque_bid(); fg::gemm_phase(lds, S, P.wv); }
__device__ __forceinline__ void phase_qkv_fast(const Params& P, LAS unsigned char* lds, bool lastl = false, int l = 1) { fg::PRDense<1024> S; S.qn = P.q_norm + (l >> 1) * 64; S.kn = P.k_norm + (l >> 1) * 64; S.rope = P.rope(); S.xs = (LAS float*)(lds + fg::STAGE_BYTES); S.lane = opaque_tid_(P.wv) & 63; S.npan = lastl ? 128 : 130; S.kvx = lastl ? 4 : 0; S.A = P.H(); S.W = P.Wmix(); S.O0 = P.Q(); S.O1 = P.Kb(); S.O2 = P.Vb(); S.ncol = 6; S.mode = 1; S.bid = opaque_bid(); fg::gemm_phase(lds, S, P.wv); }
__device__ __forceinline__ void phase_oproj_fast(const Params& P, LAS unsigned char* lds, bool lastl = false) { fg::PRDense<1024> S; S.qn = nullptr; S.kn = nullptr; S.rope = nullptr; S.xs = nullptr; S.lane = 0; S.npan = lastl ? 128 : 130; S.kvx = 0; S.A = P.O(); S.W = P.Wmix() + (size_t)QKVD * DM; S.O0 = P.Z(); S.O1 = nullptr; S.O2 = nullptr; S.ncol = 4; S.mode = 0; S.bid = opaque_bid(); fg::gemm_phase(lds, S, P.wv); }

typedef float f32x16 __attribute__((ext_vector_type(16)));
#define AT_KB 9216
#define AT_VB 8704
template <int VAR = 0>
__device__ __forceinline__ void phase_attn_fast(const Params& P, int l, LAS unsigned char* lds, bool do_ctx, int cvt_l = -1) {
    const int j = l >> 1;
    const int tid = opaque_tid(), wid = tid >> 6, lane = tid & 63, l32 = lane & 31, hi = lane >> 5;
    const int g = wid >> 1, qoff = (wid & 1) * 64, qoffu = (P.wv & 1) * 64;
    const int nunits = do_ctx ? 1040 : 1024;
    int ucount = 0;
    for (int u = opaque_bid(); u < nunits; u += gridDim.x, ++ucount) {
        int b, qblk, kv, qrow0, t0, t1, s0;
        if (u < 1024) { b = u >> 9; qblk = (u >> 2) & 127; kv = u & 3; s0 = b * SEQ; qrow0 = s0 + qblk * 128; t0 = qblk == 0 ? 2 : 0; t1 = qblk == 127 ? 4 : 6; }
        else { const int uu = u - 1024; b = uu >> 3; qblk = (uu >> 2) & 1; kv = uu & 3; s0 = NLAT + b * CTXL; qrow0 = s0 + qblk * 128; t0 = 0; t1 = 0; }
        const int cb = NLAT + b * CTXL, nloc = t1 - t0, ntiles = nloc + 4;
        const int h = kv * 4 + g;
        f16x8 Qf[2][4];
#pragma unroll
        for (int qb = 0; qb < 2; ++qb)
#pragma unroll
            for (int ks = 0; ks < 4; ++ks) Qf[qb][ks] = *(const f16x8*)(P.Q() + (size_t)(qrow0 + qoff + 32 * qb + l32) * 1024 + h * 64 + 16 * ks + 8 * hi);
        f32x16 OT[2][2];
#pragma unroll
        for (int db = 0; db < 2; ++db)
#pragma unroll
            for (int qb = 0; qb < 2; ++qb)
#pragma unroll
                for (int r = 0; r < 16; ++r) OT[db][qb][r] = 0.f;
        float mrun[2], lrun[2];
        { const float sk = P.sink[j * 16 + h] * 1.4426950408889634f; mrun[0] = sk; mrun[1] = sk; lrun[0] = hi == 0 ? 1.0f : 0.0f; lrun[1] = lrun[0]; }
        const int lkey = tid >> 3, lpc = tid & 7;
        f16x8 kreg, vreg;
        auto tile_row = [&](int it) -> int { return it < nloc ? (qrow0 - 128 + 64 * (t0 + it)) : (cb + 64 * (it - nloc)); };
        { const int kr = tile_row(0) + lkey; kreg = *(const f16x8*)(P.Kb() + (size_t)kr * 256 + kv * 64 + lpc * 8); vreg = *(const f16x8*)(P.Vb() + (size_t)kr * 256 + kv * 64 + lpc * 8); }
        __syncthreads();
        {
            LAS f16* Kl = (LAS f16*)(lds); LAS f16* Vl = (LAS f16*)(lds + 2 * AT_KB);
            *(LAS f16x8*)(Kl + lkey * 72 + lpc * 8) = kreg;
#pragma unroll
            for (int i = 0; i < 8; ++i) Vl[(lpc * 8 + i) * 68 + lkey] = vreg[i];
        }
        __syncthreads();
        for (int it = 0; it < ntiles; ++it) {
            const int buf = it & 1;
            if (it + 1 < ntiles) { const int kr = tile_row(it + 1) + lkey; kreg = *(const f16x8*)(P.Kb() + (size_t)kr * 256 + kv * 64 + lpc * 8); vreg = *(const f16x8*)(P.Vb() + (size_t)kr * 256 + kv * 64 + lpc * 8); }
            const LAS f16* Kl = (const LAS f16*)(lds + buf * AT_KB); const LAS f16* Vl = (const LAS f16*)(lds + 2 * AT_KB + buf * AT_VB);
            int cls = 0;
            if (it < nloc) { const int tl = t0 + it, dmin = qoffu + 65 - 64 * tl, dmax = qoffu + 191 - 64 * tl; cls = (dmin > 128 || dmax < -128) ? 2 : ((dmin >= -128 && dmax <= 128) ? 0 : 1); }
            if (cls != 2) {
            f32x16 S[2][2];
#pragma unroll
            for (int kb = 0; kb < 2; ++kb)
#pragma unroll
                for (int qb = 0; qb < 2; ++qb)
#pragma unroll
                    for (int r = 0; r < 16; ++r) S[kb][qb][r] = -mrun[qb];
#pragma unroll
            for (int ks = 0; ks < 4; ++ks)
#pragma unroll
                for (int kb = 0; kb < 2; ++kb) {
                    const f16x8 kf = *(const LAS f16x8*)(Kl + (32 * kb + l32) * 72 + 16 * ks + 8 * hi);
#pragma unroll
                    for (int qb = 0; qb < 2; ++qb) S[kb][qb] = __builtin_amdgcn_mfma_f32_32x32x16_f16(kf, Qf[qb][ks], S[kb][qb], 0, 0, 0);
                }
            if (cls == 1) {
                const int kt = 64 * (t0 + it);
#pragma unroll
                for (int qb = 0; qb < 2; ++qb) {
                    const int qp = 128 + qoff + 32 * qb + l32;
#pragma unroll
                    for (int kb = 0; kb < 2; ++kb)
#pragma unroll
                        for (int r = 0; r < 16; ++r) { const int kp = kt + 32 * kb + 8 * (r >> 2) + 4 * hi + (r & 3); const int d = qp - kp; if (d > 128 || d < -128) S[kb][qb][r] = -INFINITY; }
                }
            }
            f16x8 Pf[2][4];
#pragma unroll
            for (int qb = 0; qb < 2; ++qb) {
                float mx = S[0][qb][0];
#pragma unroll
                for (int kb = 0; kb < 2; ++kb)
#pragma unroll
                    for (int r = 0; r < 16; ++r) mx = fmaxf(mx, S[kb][qb][r]);
                { const auto sw = __builtin_amdgcn_permlane32_swap(__float_as_uint(mx), __float_as_uint(mx), false, false); mx = fmaxf(__uint_as_float(sw[0]), __uint_as_float(sw[1])); }
                if (__builtin_amdgcn_ballot_w64(mx > 8.0f) != 0ull) {
                    const float g = fmaxf(mx, 0.f), corr = __builtin_amdgcn_exp2f(-g);
                    mrun[qb] += g; lrun[qb] *= corr;
#pragma unroll
                    for (int kb = 0; kb < 2; ++kb)
#pragma unroll
                        for (int r = 0; r < 16; ++r) S[kb][qb][r] -= g;
#pragma unroll
                    for (int db = 0; db < 2; ++db)
#pragma unroll
                        for (int r = 0; r < 16; ++r) OT[db][qb][r] *= corr;
                }
                float ps = 0.f;
#pragma unroll
                for (int kb = 0; kb < 2; ++kb)
#pragma unroll
                    for (int r = 0; r < 16; ++r) { const float p = __builtin_amdgcn_exp2f(S[kb][qb][r]); S[kb][qb][r] = p; ps += p; }
                lrun[qb] += ps;
#pragma unroll
                for (int ks = 0; ks < 4; ++ks) { const int kb = ks >> 1, r0 = 8 * (ks & 1);
#pragma unroll
                    for (int e = 0; e < 8; ++e) Pf[qb][ks][e] = (f16)S[kb][qb][r0 + e]; }
            }
#pragma unroll
            for (int ks = 0; ks < 4; ++ks)
#pragma unroll
                for (int db = 0; db < 2; ++db) {
                    const LAS f16* vp = Vl + (32 * db + l32) * 68 + 16 * ks + 4 * hi;
                    const f16x4 v0 = *(const LAS f16x4*)vp, v1 = *(const LAS f16x4*)(vp + 8);
                    const f16x8 vf = (f16x8){v0[0], v0[1], v0[2], v0[3], v1[0], v1[1], v1[2], v1[3]};
#pragma unroll
                    for (int qb = 0; qb < 2; ++qb) OT[db][qb] = __builtin_amdgcn_mfma_f32_32x32x16_f16(vf, Pf[qb][ks], OT[db][qb], 0, 0, 0);
                }
            }
            if (it + 1 < ntiles) {
                LAS f16* Kw = (LAS f16*)(lds + (buf ^ 1) * AT_KB); LAS f16* Vw = (LAS f16*)(lds + 2 * AT_KB + (buf ^ 1) * AT_VB);
                *(LAS f16x8*)(Kw + lkey * 72 + lpc * 8) = kreg;
#pragma unroll
                for (int i = 0; i < 8; ++i) Vw[(lpc * 8 + i) * 68 + lkey] = vreg[i];
            }
            __syncthreads();
        }
#pragma unroll
        for (int qb = 0; qb < 2; ++qb) {
            const float lt = lrun[qb] + shx<32>(lrun[qb], lane);
            const float inv = 1.0f / lt;
            f16* op = P.O() + (size_t)(qrow0 + qoff + 32 * qb + l32) * 1024 + h * 64;
#pragma unroll
            for (int db = 0; db < 2; ++db)
#pragma unroll
                for (int i = 0; i < 4; ++i) {
                    const f16x4 o = (f16x4){(f16)(OT[db][qb][4 * i] * inv), (f16)(OT[db][qb][4 * i + 1] * inv), (f16)(OT[db][qb][4 * i + 2] * inv), (f16)(OT[db][qb][4 * i + 3] * inv)};
                    *(f16x4*)(op + 32 * db + 8 * i + 4 * hi) = rm4(o);
                }
        }
    }
}

#define MEGA_LDS (147456 + 16)
__device__ __forceinline__ const Params& opq(Params& q) { int z; asm volatile("s_mov_b32 %0, 0" : "=s"(z)); q.zoff = z; return q; }
__global__ __launch_bounds__(NTHR, 2) void mega(Params P) {
    extern __shared__ __attribute__((aligned(16))) unsigned char shm[];
    LAS unsigned char* lds = (LAS unsigned char*)shm;
    volatile LAS unsigned* st = (volatile LAS unsigned*)(lds + 147456);
    if (threadIdx.x == 0) { st[0] = 0u; st[1] = 0u; st[2] = 0u; st[3] = 0u; }
    __syncthreads();
    const XcdBarrier bar = xcd_barrier_post(P.bar(), st);
    const int nb = gridDim.x;
#define bid (opaque_bid())
    Params Q = P; Q.wv = __builtin_amdgcn_readfirstlane(threadIdx.x >> 6);
#define P (opq(Q))
    phase_ada(P, bid, nb, (float*)shm);
    __syncthreads();
    phase_convert(P, 0, bid, nb, (f16*)shm, false);
    xcd_barrier(bar);
    for (int l = 0; l < 4; ++l) {
        if (l == 0) phase_n1<true, false>(P, l, bid, nb); else { phase_n1<false, false>(P, l, bid, nb); __syncthreads(); phase_convert(P, l, bid, nb, (f16*)shm, false);
            }
        xcd_barrier(bar);
        if ((l & 1) == 0) {
            phase_pool_fast(P, lds);
            xcd_barrier(bar);
            phase_n2<true>(P, l, bid, nb, (float*)shm);
        } else {
            phase_qkv_fast(P, lds, l == 3, l);
            if (nb == 256 && (bid & 7) >= 2) { __syncthreads(); cvt3_job(P, (l == 1 ? 192 : 576) + ((bid & 7) - 2) * 32 + (bid >> 3), (f16*)shm); }
            xcd_barrier(bar);
            phase_attn_fast(P, l, lds, l != 3);
            if (l == 3 && nb != 256) { __syncthreads(); phase_cvt_ctx<true, false>(P, l, bid, nb, (f16*)shm, -1, true); phase_cvt_ctx<false, false>(P, l, bid, nb, (f16*)shm, -1, true); }
            xcd_barrier(bar);
            phase_oproj_fast(P, lds, l == 3);
            if (l == 1 && nb == 256 && (bid & 7) >= 2) { __syncthreads(); cvt3_job(P, 384 + ((bid & 7) - 2) * 32 + (bid >> 3), (f16*)shm); }
            xcd_barrier(bar);
            phase_n2<false>(P, l, bid, nb, (float*)shm, l == 3 ? NLAT : MROWS);
        }
        xcd_barrier(bar);
        phase_topk(P, bid, nb, (unsigned*)shm, l == 3 ? 32 : 64);
        if (l < 3 && nb == 256 && bid >= 64 && bid < 128) cvt3_job(P, l * 64 + bid - 64, (f16*)shm);
        xcd_barrier(bar);
        if (l < 3) { phase_cvt_ctx<true, true>(P, l, bid, nb, (f16*)shm); xcd_barrier(bar); }
        phase_gateup_fast(P, lds, 16, l == 3);
        if (l < 3) { __syncthreads(); phase_cvt_ctx<false, true>(P, l, bid, nb, (f16*)shm); }
        xcd_barrier(bar);
        phase_down_fast(P, lds, 16, l == 3);
        xcd_barrier(bar);
    }
    phase_n1<false, true>(P, 4, bid, nb);
#undef P
#undef bid
}

static inline size_t al256(size_t v) { return (v + 255) & ~(size_t)255; }

extern "C" void kernel_launch(void* const* d_in, const int* in_sizes, int n_in, void* d_out, int out_size, void* d_ws, size_t ws_size, hipStream_t stream) {
    Params P{};
    P.x = (const float*)d_in[0]; P.c = (const float*)d_in[1]; P.ctx = (const float*)d_in[2]; P.c_ctx = (const float*)d_in[3];
    P.w_ada = (const float*)d_in[4]; P.b_ada = (const float*)d_in[5]; P.norm1_g = (const float*)d_in[6]; P.norm2_g = (const float*)d_in[7];
    P.pool_w = (const float*)d_in[8]; P.pool_scale = (const float*)d_in[9]; P.w_qkv = (const float*)d_in[10]; P.w_o = (const float*)d_in[11];
    P.q_norm = (const float*)d_in[12]; P.k_norm = (const float*)d_in[13]; P.sink = (const float*)d_in[14]; P.router_w = (const float*)d_in[15];
    P.w_gate = (const float*)d_in[16]; P.w_up = (const float*)d_in[17]; P.w_down = (const float*)d_in[18];
    P.out = (float*)d_out;
    P.ws = (char*)d_ws; const size_t off = WS_TOTAL;
    if (off > ws_size) { fprintf(stderr, "workspace too small: need %zu have %zu\n", off, ws_size); return; }
    static int grid = 0;
    if (!grid) {
        int dev = 0, cus = 0, per_cu = 0;
        hipGetDevice(&dev);
        hipDeviceGetAttribute(&cus, hipDeviceAttributeMultiprocessorCount, dev);
        hipFuncSetAttribute((const void*)mega, hipFuncAttributeMaxDynamicSharedMemorySize, MEGA_LDS);
        hipOccupancyMaxActiveBlocksPerMultiprocessor(&per_cu, (const void*)mega, NTHR, MEGA_LDS);
        if (per_cu < 1) { fprintf(stderr, "mega: occupancy query says %d blocks per CU\n", per_cu); }
        grid = cus > 0 ? cus : 256;
    }
    hipMemsetAsync(P.bar(), 0, XCD_BAR_WORDS * sizeof(unsigned), stream);
    hipLaunchKernelGGL(mega, dim3(grid), dim3(NTHR), MEGA_LDS, stream, P);
}
```

```cpp
#include <hip/hip_runtime.h>
#include <stdint.h>
#include <stdio.h>

typedef _Float16 f16;
typedef _Float16 f16x2 __attribute__((ext_vector_type(2)));
typedef _Float16 f16x4 __attribute__((ext_vector_type(4)));
typedef _Float16 f16x8 __attribute__((ext_vector_type(8)));
typedef float f32x4 __attribute__((ext_vector_type(4)));
typedef float f32x2 __attribute__((ext_vector_type(2)));
typedef unsigned u32x2 __attribute__((ext_vector_type(2)));
typedef unsigned u32x4 __attribute__((ext_vector_type(4)));
#define RM_BITS 5
#define RM_ADD (0x00010001u << (RM_BITS - 1))
#define RM_MASK (~(0x00010001u * ((1u << RM_BITS) - 1u)))
__device__ __forceinline__ f16x4 rm4(f16x4 v) { u32x2 b = __builtin_bit_cast(u32x2, v); b = (b + RM_ADD) & RM_MASK; return __builtin_bit_cast(f16x4, b); }
__device__ __forceinline__ f16x8 rm8(f16x8 v) { u32x4 b = __builtin_bit_cast(u32x4, v); b = (b + RM_ADD) & RM_MASK; return __builtin_bit_cast(f16x8, b); }
#define RMW_BITS 5
__device__ __forceinline__ f16x8 rmw8(f16x8 v) { u32x4 b = __builtin_bit_cast(u32x4, v); b = (b + (0x00010001u << (RMW_BITS - 1))) & ~(0x00010001u * ((1u << RMW_BITS) - 1u)); return __builtin_bit_cast(f16x8, b); }

#define LAS __attribute__((address_space(3)))
#define DM 1024
#define SEQ 16384
#define NLAT 32768
#define CTXL 256
#define NCTX 512
#define MROWS 33280
#define NEXP 16
#define DEXP 2048
#define SLOTS 4160
#define SLOTS_PAD 4352
#define QKVD 1536
#define NTHR 512

constexpr size_t al256c(size_t v) { return (v + 255) & ~(size_t)255; }
constexpr size_t OFF_BAR = 0;
constexpr size_t OFF_MOD = al256c(OFF_BAR + 16384);
constexpr size_t OFF_ROPE = al256c(OFF_MOD + (size_t)4 * 3 * 6 * DM * 4);
constexpr size_t OFF_X = al256c(OFF_ROPE + (size_t)256 * 16 * 2 * 4);
constexpr size_t OFF_H = al256c(OFF_X + (size_t)MROWS * DM * 4);
constexpr size_t OFF_Z = al256c(OFF_H + (size_t)MROWS * DM * 2);
constexpr size_t OFF_Q = al256c(OFF_Z + (size_t)MROWS * DM * 2);
constexpr size_t OFF_KB = al256c(OFF_Q + (size_t)MROWS * DM * 2);
constexpr size_t OFF_VB = al256c(OFF_KB + (size_t)MROWS * 256 * 2);
constexpr size_t OFF_VT = al256c(OFF_VB + (size_t)MROWS * 256 * 2);
constexpr size_t OFF_O = al256c(OFF_VT + (size_t)MROWS * 256 * 2);
constexpr size_t OFF_AFF = al256c(OFF_O + (size_t)MROWS * DM * 2);
constexpr size_t OFF_INV = al256c(OFF_AFF + (size_t)MROWS * 16 * 4);
constexpr size_t OFF_ROWIDX = al256c(OFF_INV + (size_t)MROWS * 16 * 4);
constexpr size_t OFF_ACT = al256c(OFF_ROWIDX + (size_t)NEXP * SLOTS_PAD * 4);
constexpr size_t OFF_YSLOT = al256c(OFF_ACT + (size_t)NEXP * SLOTS_PAD * DEXP * 2);
constexpr size_t OFF_WGU = al256c(OFF_YSLOT + (size_t)NEXP * SLOTS_PAD * DM * 2);
constexpr size_t OFF_WD = al256c(OFF_WGU + (size_t)NEXP * 2 * DEXP * DM * 2);
constexpr size_t OFF_WMIX = al256c(OFF_WD + (size_t)NEXP * DM * DEXP * 2);
constexpr size_t OFF_WGU3 = al256c(OFF_WMIX + (size_t)(QKVD + DM) * DM * 2);
constexpr size_t OFF_WD3 = al256c(OFF_WGU3 + (size_t)NEXP * 2 * DEXP * DM * 2);
constexpr size_t OFF_DUMMY = al256c(OFF_WD3 + (size_t)NEXP * DM * DEXP * 2);
constexpr size_t WS_TOTAL = OFF_DUMMY;
struct Params {
    const float *x, *c, *ctx, *c_ctx, *w_ada, *b_ada, *norm1_g, *norm2_g, *pool_w, *pool_scale, *w_qkv, *w_o, *q_norm, *k_norm, *sink, *router_w, *w_gate, *w_up, *w_down;
    float* out; char* ws; int wv; int zoff;
#define WSF(name, type, off) __host__ __device__ __forceinline__ type* name() const { return (type*)(ws + zoff + (off)); }
    WSF(bar, unsigned, OFF_BAR) WSF(mod, float, OFF_MOD) WSF(rope, float, OFF_ROPE) WSF(X, f16, OFF_X) WSF(H, f16, OFF_H) WSF(Z, f16, OFF_Z) WSF(Q, f16, OFF_Q) WSF(Kb, f16, OFF_KB) WSF(Vb, f16, OFF_VB) WSF(Vt, f16, OFF_VT)
    WSF(O, f16, OFF_O) WSF(aff, float, OFF_AFF) WSF(inv, int, OFF_INV) WSF(rowidx, int, OFF_ROWIDX) WSF(act, f16, OFF_ACT) WSF(yslot, f16, OFF_YSLOT) WSF(Wgu, f16, OFF_WGU) WSF(Wd, f16, OFF_WD) WSF(Wmix, f16, OFF_WMIX)
#undef WSF
#define WSW(name, type, off) __host__ __device__ __forceinline__ type* name() const { return (type*)(ws + zoff + (off)); }
    WSW(Xw, f16, OFF_X) WSW(Ow, f16, OFF_O) WSW(Hw, f16, OFF_H) WSW(affw, float, OFF_AFF) WSW(Qw, f16, OFF_Q) WSW(Kw, f16, OFF_KB)
#undef WSW
};

template <int O> __device__ __forceinline__ float shx(float v, int lane) {
    if (O == 1) return __int_as_float(__builtin_amdgcn_update_dpp(0, __float_as_int(v), 0xB1, 0xF, 0xF, true));
    if (O == 2) return __int_as_float(__builtin_amdgcn_update_dpp(0, __float_as_int(v), 0x4E, 0xF, 0xF, true));
    if (O < 32) return __int_as_float(__builtin_amdgcn_ds_swizzle(__float_as_int(v), (O << 10) | 0x1f));
    return __int_as_float(__builtin_amdgcn_ds_bpermute((lane ^ O) << 2, __float_as_int(v)));
}
__device__ __forceinline__ float wave_sum(float v, int lane) {
    v += shx<1>(v, lane); v += shx<2>(v, lane); v += shx<4>(v, lane); v += shx<8>(v, lane); v += shx<16>(v, lane); v += shx<32>(v, lane);
    return v;
}
__device__ __forceinline__ unsigned shup(unsigned v, int o, int lane) { return (unsigned)__builtin_amdgcn_ds_bpermute((lane - o) << 2, (int)v); }
__device__ __forceinline__ int opaque_bid() { int b = blockIdx.x; asm volatile("" : "+s"(b)); return b; }
#define opaque_tid() opaque_tid_(P.wv)
__device__ __forceinline__ int opaque_tid_(int wv) { int ln; asm volatile("v_mbcnt_lo_u32_b32 %0, -1, 0\n\tv_mbcnt_hi_u32_b32 %0, -1, %0" : "=v"(ln)); return (wv << 6) | ln; }
__device__ __forceinline__ float silu_f(float v) { return v * __builtin_amdgcn_rcpf(1.0f + __expf(-v)); }

__device__ __forceinline__ const float* modp(const Params& P, int l, int v, int j) { return P.mod() + (size_t)((l * 3 + v) * 6 + j) * DM; }

__device__ __forceinline__ void phase_ada(const Params& P, int bid, int nb, float* lds) {
    float* sc = lds; float* red = lds + 3 * DM;
    const int tid = opaque_tid();
    for (int i = tid; i < 3 * DM; i += NTHR) { const int v = i >> 10, k = i & 1023; const float cv = v < 2 ? P.c[v * DM + k] : P.c_ctx[k]; sc[i] = silu_f(cv); }
    __syncthreads();
    for (int u = bid; u < 4 * 96; u += nb) {
        const int l = u / 96, ch = u % 96, col = ch * 64 + (tid & 63), ks = tid >> 6;
        const float* w = P.w_ada + (size_t)l * DM * 6 * DM + col;
        float s0 = 0.f, s1 = 0.f, s2 = 0.f;
        for (int k = ks * 128; k < ks * 128 + 128; ++k) { const float wv = __builtin_nontemporal_load(w + (size_t)k * 6 * DM); s0 += sc[k] * wv; s1 += sc[DM + k] * wv; s2 += sc[2 * DM + k] * wv; }
        red[(ks * 3 + 0) * 64 + (tid & 63)] = s0; red[(ks * 3 + 1) * 64 + (tid & 63)] = s1; red[(ks * 3 + 2) * 64 + (tid & 63)] = s2;
        __syncthreads();
        if (tid < 192) { const int v = tid >> 6, cc = tid & 63; float s = 0.f;
#pragma unroll
            for (int q = 0; q < 8; ++q) s += red[(q * 3 + v) * 64 + cc];
            const int colg = ch * 64 + cc; s += P.b_ada[l * 6 * DM + colg];
            const int j = colg >> 10, d = colg & 1023;
            P.mod()[(size_t)((l * 3 + v) * 6 + j) * DM + d] = s; }
        __syncthreads();
    }
    for (int i = bid * NTHR + tid; i < 256 * 16; i += nb * NTHR) {
        const int p = i >> 4, f = i & 15;
        const float inv = powf(10000.0f, -(float)f / 16.0f);
        const float angf = (float)p * inv;
        double a = (double)angf;
        const double twopi = 6.283185307179586476925286766559;
        a -= twopi * rint(a / twopi);
        const double a2 = a * a;
        double cs = 1.0, sn = 1.0;
        double tc = 0.0, ts = 0.0;
        for (int n = 16; n >= 1; --n) { tc = (tc + 1.0) * (-a2 / (double)((2 * n - 1) * (2 * n))); ts = (ts + 1.0) * (-a2 / (double)((2 * n) * (2 * n + 1))); }
        cs = 1.0 + tc; sn = a * (1.0 + ts);
        P.rope()[i * 2] = (float)cs; P.rope()[i * 2 + 1] = (float)sn;
    }
}

__device__ __forceinline__ f32x4 cvt4(const f16x4 v) { return (f32x4){(float)v[0], (float)v[1], (float)v[2], (float)v[3]}; }
__device__ __forceinline__ f16x4 pk4(const f32x4 v) { return (f16x4){(f16)v[0], (f16)v[1], (f16)v[2], (f16)v[3]}; }
__device__ __forceinline__ float dot4(const f32x4 a, const f32x4 b) { return a[0] * b[0] + a[1] * b[1] + a[2] * b[2] + a[3] * b[3]; }
template <bool FIRST, bool FINAL>
__device__ __forceinline__ void phase_n1(const Params& P, int l, int bid, int nb) {
    constexpr int R = 4;
    const int tid_ = opaque_tid(); const int wid = P.wv, lane = tid_ & 63;
    const int nrows = FINAL ? NLAT : MROWS;
    for (int rb = (bid * 8 + wid) * R; rb < nrows; rb += nb * 8 * R) {
        const int v = rb < NLAT ? (rb >> 14) : 2;
        f32x4 xv[R][4];
#pragma unroll
        for (int u = 0; u < R; ++u) {
            const int r = rb + u;
            if (FIRST) { const float* src = r < NLAT ? P.x + (size_t)r * DM : P.ctx + (size_t)(r - NLAT) * DM;
#pragma unroll
                for (int q = 0; q < 4; ++q) xv[u][q] = __builtin_nontemporal_load((const f32x4*)(src + q * 256 + lane * 4)); }
            else { const f16* src = P.X() + (size_t)r * DM;
#pragma unroll
                for (int q = 0; q < 4; ++q) xv[u][q] = cvt4(*(const f16x4*)(src + q * 256 + lane * 4)); }
        }
        if (!FIRST) {
            const int sl = P.inv()[(size_t)(lane & 15) * MROWS + rb + (lane >> 4)];
            const float af = P.aff()[(size_t)(lane & 15) * MROWS + rb + (lane >> 4)];
            const unsigned long long bal = __builtin_amdgcn_ballot_w64(sl >= 0);
            unsigned m[R];
#pragma unroll
            for (int u = 0; u < R; ++u) m[u] = (unsigned)(bal >> (16 * u)) & 0xffffu;
            const f16* ys = P.yslot();
            const float* g2 = modp(P, l - 1, v, 5);
            f32x4 gv[4];
#pragma unroll
            for (int q = 0; q < 4; ++q) gv[q] = *(const f32x4*)(g2 + q * 256 + lane * 4);
            while (m[0] | m[1] | m[2] | m[3]) {
                f16x4 yv[R][4]; float w[R];
#pragma unroll
                for (int u = 0; u < R; ++u) {
                    const int e = m[u] ? __builtin_ctz(m[u]) : 0;
                    const int sv = m[u] ? __builtin_amdgcn_readlane(sl, 16 * u + e) : 0;
                    w[u] = m[u] ? __int_as_float(__builtin_amdgcn_readlane(__float_as_int(af), 16 * u + e)) : 0.f;
                    m[u] &= m[u] - 1u;
                    const f16* y = ys + ((size_t)e * SLOTS_PAD + sv) * DM + lane * 4;
#pragma unroll
                    for (int q = 0; q < 4; ++q) yv[u][q] = *(const f16x4*)(y + q * 256);
                }
#pragma unroll
                for (int u = 0; u < R; ++u)
#pragma unroll
                    for (int q = 0; q < 4; ++q) xv[u][q] += (w[u] * gv[q]) * cvt4(yv[u][q]);
            }
        }
        if (FINAL) {
#pragma unroll
            for (int u = 0; u < R; ++u)
#pragma unroll
                for (int q = 0; q < 4; ++q) __builtin_nontemporal_store(xv[u][q], (f32x4*)(P.out + (size_t)(rb + u) * DM + q * 256 + lane * 4));
            continue;
        }
        float ss[R];
#pragma unroll
        for (int u = 0; u < R; ++u) {
            f16* xd = P.Xw() + (size_t)(rb + u) * DM; float sacc = 0.f;
#pragma unroll
            for (int q = 0; q < 4; ++q) { *(f16x4*)(xd + q * 256 + lane * 4) = pk4(xv[u][q]); sacc += dot4(xv[u][q], xv[u][q]); }
            ss[u] = sacc;
        }
#pragma unroll
        for (int u = 0; u < R; ++u) ss[u] = rsqrtf(wave_sum(ss[u], lane) * (1.0f / DM) + 1e-6f);
        const float* g = P.norm1_g + l * DM; const float* sh = modp(P, l, v, 0); const float* scl = modp(P, l, v, 1);
#pragma unroll
        for (int q = 0; q < 4; ++q) {
            const int c0 = q * 256 + lane * 4;
            const f32x4 gq = *(const f32x4*)(g + c0), sq = *(const f32x4*)(sh + c0), cq = *(const f32x4*)(scl + c0);
            const f32x4 gm = gq * (1.0f + cq);
#pragma unroll
            for (int u = 0; u < R; ++u) *(f16x4*)(P.Hw() + (size_t)(rb + u) * DM + c0) = rm4(pk4(xv[u][q] * ss[u] * gm + sq));
        }
    }
}

#define N2_ZST 81920
template <bool POOL>
__device__ __forceinline__ void phase_n2(const Params& P, int l, int bid, int nb, float* lds, int nrows = MROWS) {
    const int tid = opaque_tid(), wid = P.wv, lane = tid & 63;
    const float* wr = P.router_w + (size_t)l * DM * NEXP;
    f16* wh = (f16*)lds;
    for (int i = tid; i < DM * NEXP; i += NTHR) { const int d = i >> 4, e = i & 15; wh[e * 1032 + d] = (f16)wr[i]; }
    f16* h2s = (f16*)lds + 16640;
    LAS unsigned char* zst = (LAS unsigned char*)lds + N2_ZST;
    const int j = l >> 1, nblk = nrows >> 4;
    const f16* Zg = P.Z();
    const f16* Xg = P.X();
    f16x4 xr[2][4]; f16x4 zr[2][4];
    auto prefetch = [&](int blk) {
        const int R0 = blk * 16, rb = R0 + wid * 2;
        if (POOL) {
            int s0, L; if (R0 < NLAT) { s0 = (R0 >> 14) << 14; L = SEQ; } else { s0 = NLAT + (((R0 - NLAT) >> 8) << 8); L = CTXL; }
#pragma unroll
            for (int i = 0; i < 8; ++i) { const int piece = wid * 8 + i; int rr = R0 - 8 + (piece >> 1); rr = rr < s0 ? s0 : (rr > s0 + L - 1 ? s0 + L - 1 : rr);
                __builtin_amdgcn_global_load_lds((const unsigned*)(Zg + (size_t)rr * DM + (piece & 1) * 512 + lane * 8), (LAS unsigned*)(zst + piece * 1024), 16, 0, 0); }
        } else {
#pragma unroll
            for (int u = 0; u < 2; ++u)
#pragma unroll
                for (int q = 0; q < 4; ++q) zr[u][q] = *(const f16x4*)(Zg + (size_t)(rb + u) * DM + q * 256 + lane * 4);
        }
#pragma unroll
        for (int u = 0; u < 2; ++u)
#pragma unroll
            for (int q = 0; q < 4; ++q) xr[u][q] = *(const f16x4*)(Xg + (size_t)(rb + u) * DM + q * 256 + lane * 4);
    };
    int blk = bid;
    if (blk < nblk) prefetch(blk);
    __syncthreads();
    while (blk < nblk) {
        const int R0 = blk * 16, rb = R0 + wid * 2;
        int v, s0, L;
        if (rb < NLAT) { v = rb >> 14; s0 = v << 14; L = SEQ; } else { v = 2; s0 = NLAT + (((rb - NLAT) >> 8) << 8); L = CTXL; }
        const int t = rb - s0;
        if (POOL) asm volatile("s_waitcnt vmcnt(16)" ::: "memory");
        f32x4 g1v[4], gmv[4], shv[4], psv[4];
        { const float* g1 = modp(P, l, v, 2); const float* g = P.norm2_g + l * DM; const float* sh = modp(P, l, v, 3); const float* scl = modp(P, l, v, 4);
#pragma unroll
            for (int q = 0; q < 4; ++q) { const int c0 = q * 256 + lane * 4;
                g1v[q] = *(const f32x4*)(g1 + c0); const f32x4 gv = *(const f32x4*)(g + c0), cv = *(const f32x4*)(scl + c0); shv[q] = *(const f32x4*)(sh + c0); gmv[q] = gv * (1.0f + cv);
                if (POOL) psv[q] = *(const f32x4*)(P.pool_scale + j * DM + c0); } }
        f32x4 y[2][4];
        if (POOL) {
            asm volatile("s_waitcnt lgkmcnt(0)" ::: "memory"); __builtin_amdgcn_s_barrier(); asm volatile("" ::: "memory");
            if (t >= 8 && t + 9 < L) {
#pragma unroll
                for (int q = 0; q < 4; ++q) {
                    const int h = 1 << q;
                    const LAS f16* zb = (const LAS f16*)zst + q * 256 + lane * 4 + (2 * wid + 8) * DM;
#define ZROW(d) (*(const LAS f16x4*)(zb + (d) * DM))
                    const f32x4 z0 = cvt4(ZROW(-h)), z1 = cvt4(ZROW(h)), own0 = cvt4(ZROW(0)), own1 = (h == 1) ? z1 : cvt4(ZROW(1));
                    f32x4 common = (f32x4){0.f, 0.f, 0.f, 0.f};
#pragma unroll
                    for (int d = -h + 1; d + 1 <= h - 1; d += 2) { const f16x4 pr = ZROW(d) + ZROW(d + 1); common += cvt4(pr); }
                    common += cvt4(ZROW(h - 1));
#undef ZROW
                    const float inv = 0.5f / (float)h;
                    y[0][q] = ((common + z0) * inv - own0) * psv[q];
                    y[1][q] = ((common + z1) * inv - own1) * psv[q];
                }
            } else {
#pragma unroll
            for (int q = 0; q < 4; ++q) {
                const int h = 1 << q;
                const LAS f16* zb = (const LAS f16*)zst + q * 256 + lane * 4;
                f32x4 common = (f32x4){0.f, 0.f, 0.f, 0.f}, z0 = common, z1 = common;
#pragma unroll
                for (int d = -h; d <= h; ++d) {
                    const int tt = t + d; const bool ok = tt >= 0 && tt < L;
                    f32x4 zz = cvt4(*(const LAS f16x4*)(zb + (2 * wid + 8 + d) * DM));
                    if (!ok) zz = (f32x4){0.f, 0.f, 0.f, 0.f};
                    if (d == -h) z0 = zz; else if (d == h) z1 = zz; else common += zz;
                    if (d == 0) y[0][q] = zz;
                    if (d == 1) y[1][q] = zz;
                }
                const int c0n = min(t + h, L) - max(t - h, 0), c1n = min(t + 1 + h, L) - max(t + 1 - h, 0);
                y[0][q] = ((common + z0) * (1.0f / (float)c0n) - y[0][q]) * psv[q];
                y[1][q] = ((common + z1) * (1.0f / (float)c1n) - y[1][q]) * psv[q];
            }
            }
            asm volatile("s_waitcnt lgkmcnt(0)" ::: "memory"); __builtin_amdgcn_s_barrier(); asm volatile("" ::: "memory");
        } else {
#pragma unroll
            for (int u = 0; u < 2; ++u)
#pragma unroll
                for (int q = 0; q < 4; ++q) y[u][q] = cvt4(zr[u][q]);
        }
        f32x4 xv[2][4]; float ss[2] = {0.f, 0.f};
#pragma unroll
        for (int q = 0; q < 4; ++q) {
#pragma unroll
            for (int u = 0; u < 2; ++u) { xv[u][q] = cvt4(xr[u][q]) + g1v[q] * y[u][q]; ss[u] += dot4(xv[u][q], xv[u][q]); }
        }
        const int nxt = blk + nb;
        asm volatile("" ::: "memory");
        if (nxt < nblk) prefetch(nxt);
#pragma unroll
        for (int u = 0; u < 2; ++u)
#pragma unroll
            for (int q = 0; q < 4; ++q) *(f16x4*)(P.Xw() + (size_t)(rb + u) * DM + q * 256 + lane * 4) = pk4(xv[u][q]);
        ss[0] = wave_sum(ss[0], lane); ss[1] = wave_sum(ss[1], lane);
        const float rs[2] = {rsqrtf(ss[0] * (1.0f / DM) + 1e-6f), rsqrtf(ss[1] * (1.0f / DM) + 1e-6f)};
        f16x4 h2h[2][4];
#pragma unroll
        for (int q = 0; q < 4; ++q) {
            const int c0 = q * 256 + lane * 4;
#pragma unroll
            for (int u = 0; u < 2; ++u) { h2h[u][q] = pk4(xv[u][q] * rs[u] * gmv[q] + shv[q]); *(f16x4*)(P.Hw() + (size_t)(rb + u) * DM + c0) = rm4(h2h[u][q]); }
        }
        asm volatile("s_waitcnt lgkmcnt(0)" ::: "memory"); __builtin_amdgcn_s_barrier(); asm volatile("" ::: "memory");
#pragma unroll
        for (int q = 0; q < 4; ++q)
#pragma unroll
            for (int u = 0; u < 2; ++u) *(f16x4*)(h2s + (2 * wid + u) * 1032 + q * 256 + lane * 4) = h2h[u][q];
        asm volatile("s_waitcnt lgkmcnt(0)" ::: "memory"); __builtin_amdgcn_s_barrier(); asm volatile("" ::: "memory");
        {
            const int r16 = lane & 15, kq = lane >> 4;
            f32x4 pl = (f32x4){0.f, 0.f, 0.f, 0.f};
#pragma unroll
            for (int ks = 0; ks < 4; ++ks) {
                const f16x8 av = *(const f16x8*)(h2s + r16 * 1032 + wid * 128 + ks * 32 + kq * 8), bv = *(const f16x8*)(wh + r16 * 1032 + wid * 128 + ks * 32 + kq * 8);
                pl = __builtin_amdgcn_mfma_f32_16x16x32_f16(av, bv, pl, 0, 0, 0);
            }
            *(f32x4*)(lds + 16640 + (wid * 64 + lane) * 4) = pl;
            asm volatile("s_waitcnt lgkmcnt(0)" ::: "memory"); __builtin_amdgcn_s_barrier(); asm volatile("" ::: "memory");
        }
        if (wid == 0) {
            const int r16 = lane & 15, kq = lane >> 4;
            f32x4 lg = (f32x4){0.f, 0.f, 0.f, 0.f};
#pragma unroll
            for (int w = 0; w < 8; ++w) lg += *(const f32x4*)(lds + 16640 + (w * 64 + lane) * 4);
#pragma unroll
            for (int jj = 0; jj < 4; ++jj) {
                float mx = lg[jj];
                mx = fmaxf(mx, shx<1>(mx, lane)); mx = fmaxf(mx, shx<2>(mx, lane)); mx = fmaxf(mx, shx<4>(mx, lane)); mx = fmaxf(mx, shx<8>(mx, lane));
                const float pe = __expf(lg[jj] - mx);
                float den = pe;
                den += shx<1>(den, lane); den += shx<2>(den, lane); den += shx<4>(den, lane); den += shx<8>(den, lane);
                P.affw()[(size_t)r16 * MROWS + R0 + 4 * kq + jj] = pe * __builtin_amdgcn_rcpf(den);
            }
        }
        blk = nxt;
    }
}

__device__ __forceinline__ void phase_topk(const Params& P, int bid, int nb, unsigned* lds, int nprob = 64) {
    unsigned* hist = lds; unsigned* misc = lds + 256; unsigned* wsa = lds + 272; unsigned* wsb = lds + 288;
    const int tid = opaque_tid(), wid = tid >> 6, lane = tid & 63;
    for (int p = bid; p < nprob; p += nb) {
        const int set = p >> 4, e = p & 15;
        const int n = set < 2 ? SEQ : CTXL, C = n >> 3;
        const int r0 = set < 2 ? set * SEQ : NLAT + (set - 2) * CTXL;
        const int slot0 = set < 2 ? set * 2048 : 4096 + (set - 2) * 32;
        unsigned key[32];
#pragma unroll
        for (int i4 = 0; i4 < 8; ++i4) { const int idx = tid * 32 + i4 * 4;
            f32x4 v = (f32x4){0.f, 0.f, 0.f, 0.f}; if (idx < n) v = *(const f32x4*)(P.aff() + (size_t)e * MROWS + r0 + idx);
#pragma unroll
            for (int jj = 0; jj < 4; ++jj) key[i4 * 4 + jj] = idx < n ? (__float_as_uint(v[jj]) + 1u) : 0u; }
        unsigned T = 0u;
        for (int bit = 29; bit >= 0; --bit) {
            const unsigned cand = T | (1u << bit);
            unsigned wc = 0u;
#pragma unroll
            for (int i = 0; i < 32; ++i) wc += (unsigned)__builtin_popcountll(__builtin_amdgcn_ballot_w64(key[i] >= cand));
            unsigned* cb = misc + ((bit & 1) << 3);
            if (lane == 0) cb[wid] = wc;
            __syncthreads();
            unsigned tot = 0u;
#pragma unroll
            for (int w = 0; w < 8; ++w) tot += cb[w];
            if (tot >= (unsigned)C) T = cand;
        }
        unsigned cg = 0u, ce = 0u;
#pragma unroll
        for (int i = 0; i < 32; ++i) { cg += key[i] > T ? 1u : 0u; ce += key[i] == T ? 1u : 0u; }
        unsigned ig = cg, ie = ce;
#pragma unroll
        for (int o = 1; o < 64; o <<= 1) { const unsigned a = shup(ig, o, lane), b = shup(ie, o, lane); if (lane >= o) { ig += a; ie += b; } }
        if (lane == 63) { wsa[wid] = ig; wsb[wid] = ie; }
        __syncthreads();
        unsigned bg = 0u, be = 0u, totg = 0u;
#pragma unroll
        for (int w = 0; w < 8; ++w) { const unsigned ga = wsa[w]; totg += ga; if (w < wid) { bg += ga; be += wsb[w]; } }
        const unsigned krem = (unsigned)C - totg;
        unsigned pg = bg + ig - cg, pe = be + ie - ce;
#pragma unroll
        for (int i4 = 0; i4 < 8; ++i4) {
            int iv[4];
#pragma unroll
            for (int jj = 0; jj < 4; ++jj) {
                const int i = i4 * 4 + jj, idx = tid * 32 + i;
                bool sel = false; unsigned rank = 0u;
                if (key[i] > T) { sel = true; rank = pg + (pe < krem ? pe : krem); ++pg; }
                else if (key[i] == T && key[i] != 0u) { if (pe < krem) { sel = true; rank = pg + pe; } ++pe; }
                if (sel) P.rowidx()[e * SLOTS_PAD + slot0 + (int)rank] = r0 + idx;
                iv[jj] = sel ? slot0 + (int)rank : -1;
            }
            if (tid * 32 + i4 * 4 < n) *(int4*)(P.inv() + (size_t)e * MROWS + r0 + tid * 32 + i4 * 4) = make_int4(iv[0], iv[1], iv[2], iv[3]);
        }
        if (set == 3) for (int i = SLOTS + tid; i < SLOTS_PAD; i += NTHR) P.rowidx()[e * SLOTS_PAD + i] = 0;
        __syncthreads();
    }
}

#define XB_TMO      128
#define XB_XCNT(j)  (256  + 64 * (j))
#define XB_XSUB(j)  (1280 + 64 * (j))
#define XB_XGEN(j)  (2304 + 64 * (j))
#define XB_TOP      3328
#define XB_TOPGEN   3392
#define XCD_BAR_WORDS 3456
#define XB_SPIN_CAP (1u << 18)
__device__ __forceinline__ unsigned xb_ld(unsigned* p)              { return __hip_atomic_load(p, __ATOMIC_RELAXED, __HIP_MEMORY_SCOPE_AGENT); }
__device__ __forceinline__ unsigned xb_add(unsigned* p, unsigned v) { return __hip_atomic_fetch_add(p, v, __ATOMIC_RELAXED, __HIP_MEMORY_SCOPE_AGENT); }
__device__ __forceinline__ unsigned xb_xcc_id() { return (unsigned)__builtin_amdgcn_s_getreg((3 << 11) | 20) & 0xFu; }
#define XB_SPIN(cond, bar) do { unsigned _sp = 0; while (cond) { __builtin_amdgcn_s_sleep(1); \
    if ((++_sp & 255u) == 0u) { if (xb_ld(&(bar)[XB_TMO])) break; if (_sp > XB_SPIN_CAP) { atomicAdd(&(bar)[XB_TMO], 1u); break; } } } } while (0)
struct XcdBarrier { unsigned* bar; unsigned x; volatile LAS unsigned* st; };
__device__ __forceinline__ XcdBarrier xcd_barrier_post(unsigned* bar, volatile LAS unsigned* st) {
    XcdBarrier b; b.bar = bar; b.x = xb_xcc_id(); b.st = st;
    if (threadIdx.x == 0) (void)xb_add(&bar[XB_XCNT(b.x)], 1u);
    return b;
}
__device__ __forceinline__ void xcd_barrier_complete(unsigned* bar, unsigned x, unsigned& nloc, unsigned& nx) {
    const unsigned G = gridDim.x * gridDim.y * gridDim.z;
    unsigned sum, cnt, mine, sp = 0u;
    for (;;) {
        sum = 0u; cnt = 0u; mine = 0u;
#pragma unroll
        for (unsigned j = 0; j < 16; ++j) { const unsigned c = xb_ld(&bar[XB_XCNT(j)]); sum += c; cnt += (c > 0u) ? 1u : 0u; mine = (j == x) ? c : mine; }
        if (sum == G) break;
        __builtin_amdgcn_s_sleep(1);
        if ((++sp & 255u) == 0u) { if (xb_ld(&bar[XB_TMO])) break; if (sp > XB_SPIN_CAP) { atomicAdd(&bar[XB_TMO], 1u); break; } }
    }
    nloc = mine > 0u ? mine : 1u; nx = cnt > 0u ? cnt : 1u;
}
__device__ __forceinline__ void xcd_barrier(const XcdBarrier& b) {
    asm volatile("s_waitcnt vmcnt(0)" ::: "memory");
    __syncthreads();
    if (threadIdx.x == 0) {
        unsigned* bar = b.bar; asm volatile("" : "+s"(bar));
        const unsigned bx = (unsigned)__builtin_amdgcn_readfirstlane((int)xb_xcc_id());
        __builtin_amdgcn_s_waitcnt(0);
        unsigned nloc = b.st[0], nx = b.st[1];
        if (nloc == 0u) { xcd_barrier_complete(bar, bx, nloc, nx); b.st[0] = nloc; b.st[1] = nx; }
        const unsigned old = xb_add(&bar[XB_XSUB(bx)], 1u);
        const unsigned gen = old / nloc;
        if (old + 1u == (gen + 1u) * nloc) {
            __builtin_amdgcn_fence(__ATOMIC_RELEASE, "agent");
            asm volatile("s_waitcnt vmcnt(0)" ::: "memory");
            const unsigned og = xb_add(&bar[XB_TOP], 1u);
            const unsigned tg = og / nx;
            if (og + 1u == (tg + 1u) * nx) xb_add(&bar[XB_TOPGEN], 1u);
            else XB_SPIN(xb_ld(&bar[XB_TOPGEN]) == tg, bar);
            __builtin_amdgcn_fence(__ATOMIC_ACQUIRE, "agent");
            xb_add(&bar[XB_XGEN(bx)], 1u);
            asm volatile("s_waitcnt vmcnt(0)" ::: "memory");
        } else {
            XB_SPIN(xb_ld(&bar[XB_XGEN(bx)]) == gen, bar);
            __builtin_amdgcn_fence(__ATOMIC_ACQUIRE, "agent");
            asm volatile("s_waitcnt vmcnt(0)" ::: "memory");
        }
    }
    __syncthreads();
}

namespace fg {
constexpr int BM = 256, BK = 64, HALF = 128, HTB = HALF * BK * 2, STAGE_BYTES = 8 * HTB;
__device__ __forceinline__ int lds_byte(int r, int c) { const int st = (r >> 4) * 2 + (c >> 5), rr = r & 15, cc = c & 31, ob = rr * 64 + cc * 2; return st * 1024 + (ob ^ (((ob >> 9) & 1) << 5)); }
__device__ __forceinline__ void stage_rc(int b, int& R, int& C) { const int st = b / 1024, sb = b % 1024, swz = sb ^ (((sb >> 9) & 1) << 5); R = (st >> 1) * 16 + swz / 64; C = (st & 1) * 32 + (swz % 64) / 2; }
__device__ __forceinline__ int perm32(int rho) { const int n = rho >> 4, i = rho & 15; return 8 * (i >> 2) + 4 * n + (i & 3); }
#define KDUP 0
struct Unit { int e, pm, pn; int skip; };
__device__ __forceinline__ void xcd_order(int i, int& T) { const int c = blockIdx.x; T = i * (int)gridDim.x + c; }

template <class PR>
__device__ __forceinline__ void gemm_phase(LAS unsigned char* lds, const PR& S, int wv) {
    const int tid = opaque_tid_(wv), wid = __builtin_amdgcn_readfirstlane(tid >> 6), lane = tid & 63, wr = wid >> 2, wc = wid & 3, fr = lane & 15, fq = lane >> 4;
    constexpr int K = PR::K, nt = K / BK;
    unsigned voffB[2];
#pragma unroll
    for (int i = 0; i < 2; ++i) { int R, C; stage_rc(tid * 16 + i * 8192, R, C); const int Rb = (R & ~31) + perm32(R & 31); voffB[i] = (unsigned)(Rb * PR::LDB + C) * 2u; }
    const size_t kstep = (size_t)(BK * 2);
    const size_t hB = S.hstepB();
    const unsigned ldsw = (unsigned)wid * 1024u;
    const int aoff = lds_byte(wr * 64 + fr, fq * 8), boff = lds_byte(wc * 32 + fr, fq * 8);
#define FG_SA(b, h) (((b) * 2 + (h)) * HTB)
#define FG_SB(b, h) ((4 + (b) * 2 + (h)) * HTB)
#define FG_STAGE(bufoff, gbase, voff) do { _Pragma("unroll") for (int _i = 0; _i < 2; ++_i) \
        __builtin_amdgcn_global_load_lds((const unsigned*)((const char*)(gbase) + (voff)[_i]), (LAS unsigned*)(lds + (bufoff) + ldsw + _i * 8192), 16, 0, 0); } while (0)
#define FG_LDA(dst, b, h) do { _Pragma("unroll") for (int m = 0; m < 4; ++m) _Pragma("unroll") for (int k = 0; k < 2; ++k) dst[m][k] = *(const LAS f16x8*)(lds + FG_SA(b, h) + aoff + m * 2048 + k * 1024); } while (0)
#define FG_LDB(dst, b, h) do { _Pragma("unroll") for (int n = 0; n < 2; ++n) _Pragma("unroll") for (int k = 0; k < 2; ++k) dst[n][k] = *(const LAS f16x8*)(lds + FG_SB(b, h) + boff + n * 2048 + k * 1024); } while (0)
#define FG_MMA(ai, bj, At, Bt) do { __builtin_amdgcn_s_setprio(1); _Pragma("unroll") for (int m = 0; m < 4; ++m) _Pragma("unroll") for (int n = 0; n < 2; ++n) _Pragma("unroll") for (int k = 0; k < 2; ++k) \
        acc[ai][bj][m][n] = __builtin_amdgcn_mfma_f32_16x16x32_f16(Bt[n][k], At[m][k], acc[ai][bj][m][n], 0, 0, 0); __builtin_amdgcn_s_setprio(0); } while (0)
#define FG_WAIT_V(n) asm volatile("s_waitcnt vmcnt(" #n ")" ::: "memory")
#define FG_WAIT_L(n) asm volatile("s_waitcnt lgkmcnt(" #n ")" ::: "memory")
#define FG_BAR __builtin_amdgcn_s_barrier()
#define FG_SCHED __builtin_amdgcn_sched_barrier(0)
    Unit cur, nxt; int ui = 0;
    if (!S.next(0, cur)) return;
    f32x4 acc[2][2][4][2];
#pragma unroll
    for (int a = 0; a < 2; ++a)
#pragma unroll
        for (int b = 0; b < 2; ++b)
#pragma unroll
            for (int m = 0; m < 4; ++m)
#pragma unroll
                for (int n = 0; n < 2; ++n) acc[a][b][m][n] = (f32x4){0.f, 0.f, 0.f, 0.f};
    f16x8 At[4][2], B0[2][2], B1[2][2];
    unsigned vA[2][2], vN[2][2];
    { int Rr[2], Cc[2]; stage_rc(tid * 16, Rr[0], Cc[0]); stage_rc(tid * 16 + 8192, Rr[1], Cc[1]); S.a_voff(cur, Rr, Cc, vA); }
#pragma unroll
    for (int h = 0; h < 2; ++h)
#pragma unroll
        for (int i = 0; i < 2; ++i) { asm volatile("" : "+v"(vA[h][i])); vN[h][i] = vA[h][i]; }
    const char* cA = S.a_base(cur); const char* cB = S.b_base(cur);
    FG_STAGE(FG_SB(0, 0), cB, voffB); FG_STAGE(FG_SA(0, 0), cA, vA[0]); FG_STAGE(FG_SB(0, 1), cB + hB, voffB); FG_STAGE(FG_SA(0, 1), cA, vA[1]);
    if (wr == 1) FG_BAR;
    FG_WAIT_V(4); FG_BAR;
    FG_STAGE(FG_SB(1, 0), cB + kstep, voffB); FG_STAGE(FG_SA(1, 0), cA + kstep, vA[0]); FG_STAGE(FG_SB(1, 1), cB + hB + kstep, voffB);
    FG_WAIT_V(6); FG_BAR;
    for (;;) {
        const bool has_next = S.next(ui + 1, nxt);
        const char* nA = has_next ? S.a_base(nxt) : cA; const char* nB = has_next ? S.b_base(nxt) : cB;
        if (has_next) { int Rr[2], Cc[2]; int t2 = tid; asm volatile("" : "+v"(t2)); stage_rc(t2 * 16, Rr[0], Cc[0]); stage_rc(t2 * 16 + 8192, Rr[1], Cc[1]); S.a_voff(nxt, Rr, Cc, vN);
#pragma unroll
            for (int h = 0; h < 2; ++h)
#pragma unroll
                for (int i = 0; i < 2; ++i) asm volatile("" : "+v"(vN[h][i])); }
#pragma unroll 1
        for (int t = 0; t < nt; t += 2) {
            const bool last = (t == nt - 2);
            const char* a1 = cA + (size_t)(t + 1) * kstep;
            const char* a2 = last ? nA : cA + (size_t)(t + 2) * kstep; const char* b2 = last ? nB : cB + (size_t)(t + 2) * kstep;
            const char* a3 = a2 + kstep; const char* b3 = b2 + kstep;
            unsigned v2[2][2];
#pragma unroll
            for (int h = 0; h < 2; ++h)
#pragma unroll
                for (int i = 0; i < 2; ++i) v2[h][i] = last ? vN[h][i] : vA[h][i];
            FG_LDB(B0, 0, 0); FG_SCHED; FG_LDA(At, 0, 0); FG_STAGE(FG_SA(1, 1), a1, vA[1]);
            FG_WAIT_L(8); FG_BAR; FG_WAIT_L(0); FG_MMA(0, 0, At, B0); FG_BAR; FG_SCHED;
            FG_LDB(B1, 0, 1); FG_STAGE(FG_SB(0, 0), b2, voffB);
            FG_BAR; FG_WAIT_L(0); FG_MMA(0, 1, At, B1); FG_BAR;
            FG_LDA(At, 0, 1); FG_STAGE(FG_SA(0, 0), a2, v2[0]);
            FG_BAR; FG_WAIT_L(0); FG_MMA(1, 0, At, B0); FG_BAR; FG_SCHED;
            FG_STAGE(FG_SB(0, 1), b2 + hB, voffB);
            FG_WAIT_V(6); FG_BAR; FG_MMA(1, 1, At, B1); FG_BAR;
            FG_LDB(B0, 1, 0); FG_SCHED; FG_LDA(At, 1, 0); FG_STAGE(FG_SA(0, 1), a2, v2[1]);
            FG_WAIT_L(8); FG_BAR; FG_WAIT_L(0); FG_MMA(0, 0, At, B0); FG_BAR; FG_SCHED;
            FG_LDB(B1, 1, 1); FG_STAGE(FG_SB(1, 0), b3, voffB);
            FG_BAR; FG_WAIT_L(0); FG_MMA(0, 1, At, B1); FG_BAR;
            FG_LDA(At, 1, 1); FG_STAGE(FG_SA(1, 0), a3, v2[0]);
            FG_BAR; FG_WAIT_L(0); FG_MMA(1, 0, At, B0); FG_BAR; FG_SCHED;
            FG_STAGE(FG_SB(1, 1), b3 + hB, voffB);
            FG_WAIT_V(6); FG_BAR; FG_MMA(1, 1, At, B1); FG_BAR;
        }
        if (!KDUP || !cur.skip) S.epi(acc, cur, wr, wc, fr, fq);
        if (!has_next) break;
#pragma unroll
        for (int a = 0; a < 2; ++a)
#pragma unroll
            for (int b = 0; b < 2; ++b)
#pragma unroll
                for (int m = 0; m < 4; ++m)
#pragma unroll
                    for (int n = 0; n < 2; ++n) acc[a][b][m][n] = (f32x4){0.f, 0.f, 0.f, 0.f};
        cur = nxt; cA = nA; cB = nB; ++ui;
#pragma unroll
        for (int h = 0; h < 2; ++h)
#pragma unroll
            for (int i = 0; i < 2; ++i) vA[h][i] = vN[h][i];
    }
    FG_WAIT_V(0);
    if (wr == 0) FG_BAR;
    FG_BAR;
#undef FG_SA
#undef FG_SB
#undef FG_STAGE
#undef FG_LDA
#undef FG_LDB
#undef FG_MMA
#undef FG_WAIT_V
#undef FG_WAIT_L
#undef FG_BAR
#undef FG_SCHED
}

__device__ __forceinline__ f16x8 pack8(const f32x4 a, const f32x4 b) { return (f16x8){(f16)a[0], (f16)a[1], (f16)a[2], (f16)a[3], (f16)b[0], (f16)b[1], (f16)b[2], (f16)b[3]}; }

template <int K_, int LDA_, int LDB_> struct PRBase {
    static constexpr int K = K_, LDA = LDA_, LDB = LDB_;
    __device__ __forceinline__ void plain_voff(const int (&R)[2], const int (&C)[2], unsigned (&v)[2][2]) const {
#pragma unroll
        for (int h = 0; h < 2; ++h)
#pragma unroll
            for (int i = 0; i < 2; ++i) v[h][i] = (unsigned)((h * HALF + R[i]) * LDA + C[i]) * 2u;
    }
};
struct PRGateUp : PRBase<1024, 1024, 1024> {
    const f16* H; const int* rowidx; const f16* W; f16* act; int nunits; int bid; int rt;
    __device__ __forceinline__ size_t hstepB() const { return (size_t)DEXP * DM * 2; }
    __device__ __forceinline__ bool next(int i, Unit& u) const { const int ii = KDUP ? (i >> 1) : i; const int T = ii * (int)gridDim.x + bid; u.skip = KDUP ? ((i & 1) == 0) : 0; if (T >= nunits) return false;
        if (rt == 16 && gridDim.x == 256) { const int x = bid & 7, jj = bid >> 3; u.e = ii; u.pm = (x >> 1) * 4 + (jj >> 3); u.pn = (x & 1) * 8 + (jj & 7); return true; }
        const int per = rt * 16; u.e = T / per; const int t = T % per; u.pm = t >> 4; u.pn = t & 15; return true; }
    __device__ __forceinline__ const char* a_base(const Unit&) const { return (const char*)H; }
    __device__ __forceinline__ void a_voff(const Unit& u, const int (&R)[2], const int (&C)[2], unsigned (&v)[2][2]) const {
        const int* ri = rowidx + u.e * SLOTS_PAD + u.pm * BM;
#pragma unroll
        for (int h = 0; h < 2; ++h)
#pragma unroll
            for (int i = 0; i < 2; ++i) { const int g = ri[h * HALF + R[i]]; v[h][i] = (unsigned)(g * LDA + C[i]) * 2u; }
    }
    __device__ __forceinline__ const char* b_base(const Unit& u) const { return (const char*)(W + ((size_t)u.e * 2 * DEXP + (size_t)u.pn * HALF) * DM); }
    __device__ __forceinline__ void epi(const f32x4 (&acc)[2][2][4][2], const Unit& u, int wr, int wc, int fr, int fq) const {
        f16* base = act + ((size_t)u.e * SLOTS_PAD + (size_t)u.pm * BM + wr * 64 + fr) * DEXP + u.pn * HALF + wc * 32 + fq * 8;
#pragma unroll
        for (int ai = 0; ai < 2; ++ai)
#pragma unroll
            for (int m = 0; m < 4; ++m) {
                f32x4 o0, o1;
#pragma unroll
                for (int j = 0; j < 4; ++j) { o0[j] = silu_f(acc[ai][0][m][0][j]) * acc[ai][1][m][0][j]; o1[j] = silu_f(acc[ai][0][m][1][j]) * acc[ai][1][m][1][j]; }
                if (u.e < 8) __builtin_nontemporal_store(rm8(pack8(o0, o1)), (f16x8*)(base + (size_t)(ai * HALF + m * 16) * DEXP));
                else *(f16x8*)(base + (size_t)(ai * HALF + m * 16) * DEXP) = rm8(pack8(o0, o1));
            }
    }
};
struct PRDown : PRBase<2048, 2048, 2048> {
    const f16* act; const f16* W; f16* y; int nunits; int bid; int rt;
    __device__ __forceinline__ size_t hstepB() const { return (size_t)HALF * DEXP * 2; }
    __device__ __forceinline__ bool next(int i, Unit& u) const { const int ii = KDUP ? (i >> 1) : i; const int T = ii * (int)gridDim.x + bid; u.skip = KDUP ? ((i & 1) == 0) : 0; if (T >= nunits) return false;
        if (rt == 16 && gridDim.x == 256) { const int x = bid & 7, jj = bid >> 3; u.e = 15 - (ii * 4 + (x >> 1)); u.pm = (x & 1) * 8 + (jj >> 2); u.pn = jj & 3; return true; }
        const int per = rt * 4; u.e = T / per; const int t = T % per; u.pm = t >> 2; u.pn = t & 3; return true; }
    __device__ __forceinline__ const char* a_base(const Unit& u) const { return (const char*)(act + ((size_t)u.e * SLOTS_PAD + (size_t)u.pm * BM) * DEXP); }
    __device__ __forceinline__ void a_voff(const Unit&, const int (&R)[2], const int (&C)[2], unsigned (&v)[2][2]) const { plain_voff(R, C, v); }
    __device__ __forceinline__ const char* b_base(const Unit& u) const { return (const char*)(W + ((size_t)u.e * DM + (size_t)u.pn * BM) * DEXP); }
    __device__ __forceinline__ void epi(const f32x4 (&acc)[2][2][4][2], const Unit& u, int wr, int wc, int fr, int fq) const {
        f16* base = y + ((size_t)u.e * SLOTS_PAD + (size_t)u.pm * BM + wr * 64 + fr) * DM + u.pn * BM + wc * 32 + fq * 8;
#pragma unroll
        for (int ai = 0; ai < 2; ++ai)
#pragma unroll
            for (int m = 0; m < 4; ++m)
#pragma unroll
                for (int bj = 0; bj < 2; ++bj) *(f16x8*)(base + (size_t)(ai * HALF + m * 16) * DM + bj * HALF) = pack8(acc[ai][bj][m][0], acc[ai][bj][m][1]);
    }
};
template <int K_> struct PRDense : PRBase<K_, 1024, K_> {
    const f16* A; const f16* W; f16* O0; f16* O1; f16* O2; int ncol; int mode; int bid; int npan; int kvx;
    __device__ __forceinline__ size_t hstepB() const { return (size_t)HALF * K_ * 2; }
    __device__ __forceinline__ bool next(int i, Unit& u) const { const int ii = KDUP ? (i >> 1) : i; int T = ii * (int)gridDim.x + bid; if (gridDim.x == 256) T = (ii * 8 + (bid & 7)) * 32 + (bid >> 3);
        u.skip = KDUP ? ((i & 1) == 0) : 0; const int nu = npan * ncol; if (T >= nu + kvx) return false; u.e = 0; if (T < nu) { u.pm = T / ncol; u.pn = T % ncol; } else { const int x = T - nu; u.pm = npan + (x >> 1); u.pn = 4 + (x & 1); } return true; }
    __device__ __forceinline__ const char* a_base(const Unit& u) const { return (const char*)(A + (size_t)u.pm * BM * 1024 + (mode == 2 ? u.pn * 256 : 0)); }
    __device__ __forceinline__ void a_voff(const Unit&, const int (&R)[2], const int (&C)[2], unsigned (&v)[2][2]) const { this->plain_voff(R, C, v); }
    __device__ __forceinline__ const char* b_base(const Unit& u) const { return (const char*)(W + (size_t)u.pn * BM * K_); }
    const float* qn; const float* kn; const float* rope; LAS float* xs; int lane;
    __device__ __forceinline__ void epi(const f32x4 (&acc)[2][2][4][2], const Unit& u, int wr, int wc, int fr, int fq) const {
        f16* base; int ld;
        const int row = u.pm * BM + wr * 64 + fr, colw = wc * 32 + fq * 8;
        if (mode == 1) { if (u.pn < 4) { base = O0 + (size_t)row * 1024 + u.pn * BM + colw; ld = 1024; } else if (u.pn == 4) { base = O1 + (size_t)row * 256 + colw; ld = 256; } else { base = O2 + (size_t)row * 256 + colw; ld = 256; } }
        else { base = O0 + (size_t)row * 1024 + u.pn * BM + colw; ld = 1024; }
        if (mode == 1 && u.pn < 5) {
            float ssq[2][4][2];
#pragma unroll
            for (int ai = 0; ai < 2; ++ai)
#pragma unroll
                for (int m = 0; m < 4; ++m)
#pragma unroll
                    for (int bj = 0; bj < 2; ++bj) { const f32x4 a = acc[ai][bj][m][0], b = acc[ai][bj][m][1];
                        float t = (a[0] * a[0] + a[1] * a[1]) + (a[2] * a[2] + a[3] * a[3]) + (b[0] * b[0] + b[1] * b[1]) + (b[2] * b[2] + b[3] * b[3]);
                        t += shx<16>(t, lane); t += shx<32>(t, lane); ssq[ai][m][bj] = t; }
            LAS float* mine = xs + ((wr * 4 + wc) * 16) * 16 + fr; const LAS float* theirs = xs + ((wr * 4 + (wc ^ 1)) * 16) * 16 + fr;
            if (fq == 0) {
#pragma unroll
                for (int ai = 0; ai < 2; ++ai)
#pragma unroll
                    for (int m = 0; m < 4; ++m)
#pragma unroll
                        for (int bj = 0; bj < 2; ++bj) mine[(ai * 8 + m * 2 + bj) * 16] = ssq[ai][m][bj];
            }
            asm volatile("s_waitcnt lgkmcnt(0)" ::: "memory"); __builtin_amdgcn_s_barrier(); asm volatile("" ::: "memory");
            const bool isq = u.pn < 4, lat = u.pm < 128;
            const float* nw = (isq ? qn : kn) + (wc & 1) * 32 + fq * 8;
            const f32x4 w0 = *(const f32x4*)nw, w1 = *(const f32x4*)(nw + 4);
            const float qs = isq ? 0.125f * 1.4426950408889634f : 1.0f;
#pragma unroll
            for (int ai = 0; ai < 2; ++ai)
#pragma unroll
                for (int m = 0; m < 4; ++m) {
                    f32x4 c0 = (f32x4){1.f, 1.f, 1.f, 1.f}, s0 = (f32x4){0.f, 0.f, 0.f, 0.f};
                    if (lat) { const int t = (row + ai * HALF + m * 16) & (SEQ - 1); const int pos = (wc & 1) ? (t & 63) : (t >> 6);
                        const float* tb = rope + (size_t)(pos * 16 + fq * 4) * 2; const f32x4 ta = *(const f32x4*)tb, tb2 = *(const f32x4*)(tb + 4);
                        c0 = (f32x4){ta[0], ta[2], tb2[0], tb2[2]}; s0 = (f32x4){ta[1], ta[3], tb2[1], tb2[3]}; }
#pragma unroll
                    for (int bj = 0; bj < 2; ++bj) {
                        const float tot = ssq[ai][m][bj] + theirs[(ai * 8 + m * 2 + bj) * 16];
                        const float rstd = rsqrtf(tot * (1.0f / 64.0f) + 1e-6f) * qs;
                        f32x4 a = acc[ai][bj][m][0] * rstd * w0, b = acc[ai][bj][m][1] * rstd * w1;
                        const f32x4 ra = (f32x4){a[0] * c0[0] - a[1] * s0[0], a[0] * s0[0] + a[1] * c0[0], a[2] * c0[1] - a[3] * s0[1], a[2] * s0[1] + a[3] * c0[1]};
                        const f32x4 rb = (f32x4){b[0] * c0[2] - b[1] * s0[2], b[0] * s0[2] + b[1] * c0[2], b[2] * c0[3] - b[3] * s0[3], b[2] * s0[3] + b[3] * c0[3]};
                        *(f16x8*)(base + (size_t)(ai * HALF + m * 16) * ld + bj * HALF) = rm8(pack8(ra, rb));
                    }
                }
            return;
        }
#pragma unroll
        for (int ai = 0; ai < 2; ++ai)
#pragma unroll
            for (int m = 0; m < 4; ++m)
#pragma unroll
                for (int bj = 0; bj < 2; ++bj) { const f16x8 o = pack8(acc[ai][bj][m][0], acc[ai][bj][m][1]); *(f16x8*)(base + (size_t)(ai * HALF + m * 16) * ld + bj * HALF) = (mode == 1) ? rm8(o) : o; }
    }
};
}

struct CvtJob { const float* src; f16* dst; int K, N, k0, n0; };
__device__ __forceinline__ bool cvt_job(const Params& P, int l, int u, CvtJob& jb, bool experts) {
    const int j = l >> 1;
    const int nexp = experts ? NEXP * 3 * 128 : 0;
    const int nmix = (l & 1) == 0 ? 16 : (96 + 64);
    if (u >= nexp + nmix) return false;
    if (u < nexp) {
        const int e = u / 384, r = u % 384, which = r >> 7, t = r & 127;
        if (which < 2) { jb.src = (which == 0 ? P.w_gate : P.w_up) + ((size_t)l * NEXP + e) * DM * DEXP; jb.dst = P.Wgu() + ((size_t)e * 2 + which) * DEXP * DM; jb.K = DM; jb.N = DEXP; jb.k0 = (t >> 4) * 128; jb.n0 = (t & 15) * 128; }
        else { jb.src = P.w_down + ((size_t)l * NEXP + e) * DEXP * DM; jb.dst = P.Wd() + (size_t)e * DM * DEXP; jb.K = DEXP; jb.N = DM; jb.k0 = (t >> 3) * 128; jb.n0 = (t & 7) * 128; }
    } else {
        const int t = u - nexp;
        if ((l & 1) == 0) { const int g = t >> 2, tt = t & 3; jb.src = P.pool_w + (size_t)(j * 4 + g) * 65536; jb.dst = P.Wmix() + (size_t)g * 65536; jb.K = 256; jb.N = 256; jb.k0 = (tt >> 1) * 128; jb.n0 = (tt & 1) * 128; }
        else if (t < 96) { jb.src = P.w_qkv + (size_t)j * DM * QKVD; jb.dst = P.Wmix(); jb.K = DM; jb.N = QKVD; jb.k0 = (t / 12) * 128; jb.n0 = (t % 12) * 128; }
        else { const int tt = t - 96; jb.src = P.w_o + (size_t)j * DM * DM; jb.dst = P.Wmix() + (size_t)QKVD * DM; jb.K = DM; jb.N = DM; jb.k0 = (tt >> 3) * 128; jb.n0 = (tt & 7) * 128; }
    }
    return true;
}
__device__ __forceinline__ void phase_convert(const Params& P, int l, int bid, int nb, f16* tile, bool experts = true) {
    const int tid = opaque_tid();
    CvtJob jb;
    int u = bid;
    bool have = cvt_job(P, l, u, jb, experts);
    f32x4 r[8];
    if (have) {
#pragma unroll
        for (int p = 0; p < 8; ++p) { const int id = tid + p * NTHR, kr = id >> 5, c4 = (id & 31) * 4; r[p] = __builtin_nontemporal_load((const f32x4*)(jb.src + (size_t)(jb.k0 + kr) * jb.N + jb.n0 + c4)); }
    }
    while (have) {
        __syncthreads();
#pragma unroll
        for (int p = 0; p < 8; ++p) { const int id = tid + p * NTHR, kr = id >> 5, c4 = (id & 31) * 4; *(f16x4*)(tile + kr * 136 + c4) = pk4(r[p]); }
        __syncthreads();
        const CvtJob cur = jb;
        u += nb; have = cvt_job(P, l, u, jb, experts);
        if (have) {
#pragma unroll
            for (int p = 0; p < 8; ++p) { const int id = tid + p * NTHR, kr = id >> 5, c4 = (id & 31) * 4; r[p] = __builtin_nontemporal_load((const f32x4*)(jb.src + (size_t)(jb.k0 + kr) * jb.N + jb.n0 + c4)); }
        }
        const int n = tid & 127, kg = (tid >> 7) * 32;
        f16* dp = cur.dst + (size_t)(cur.n0 + n) * cur.K + cur.k0 + kg;
#pragma unroll
        for (int i = 0; i < 4; ++i) { f16x8 o;
#pragma unroll
            for (int e = 0; e < 8; ++e) o[e] = tile[(kg + i * 8 + e) * 136 + n];
            *(f16x8*)(dp + i * 8) = rmw8(o); }
    }
}
template <bool GATEUP, bool CTX>
__device__ __forceinline__ void phase_cvt_ctx(const Params& P, int l, int bid, int nb, f16* tile, int sel = -1, bool alt = false) {
    const int tid = opaque_tid(), wid = P.wv, lane = tid & 63, r16 = lane & 15, kq = lane >> 4;
    constexpr int NC = GATEUP ? 128 : 64;
    constexpr int KT = GATEUP ? 8 : 16, K = GATEUP ? DM : DEXP, N = GATEUP ? DEXP : DM, NB = N / NC;
    constexpr int NT = GATEUP ? 2 * KT : KT;
    const int sel_ = (GATEUP && !CTX) ? sel : -1; const int ntr = (GATEUP && sel_ < 0) ? NT : KT;
    constexpr int TS = NC + 4, TW = 128 * TS;
    constexpr int NLD = NC / 16;
    constexpr int WPC = 8 / (NC / 16);
    constexpr int NRB = 4 / WPC;
    const int cb = wid % (NC / 16), rb0 = (wid / (NC / 16)) * NRB;
    f16* asl = tile + 2 * TW;
    for (int job = bid; job < NEXP * NB; job += nb) {
        const int e = job / NB, nbk = job % NB;
        const f16* ap[2];
        if (CTX) {
#pragma unroll
            for (int p = 0; p < 2; ++p) { const int row = (tid >> 4) + p * 32;
                if (GATEUP) ap[p] = P.H() + (size_t)P.rowidx()[e * SLOTS_PAD + 4096 + row] * DM + (tid & 15) * 8;
                else ap[p] = P.act() + ((size_t)e * SLOTS_PAD + 4096 + row) * DEXP + (tid & 15) * 8; }
        }
        f32x4 acc[2][NRB];
#pragma unroll
        for (int w = 0; w < 2; ++w)
#pragma unroll
            for (int rb = 0; rb < NRB; ++rb) acc[w][rb] = (f32x4){0.f, 0.f, 0.f, 0.f};
        const float* srcs[2]; f16* dsts[2];
        if (GATEUP) { const size_t wo = ((size_t)l * NEXP + e) * DM * DEXP; srcs[0] = P.w_gate + wo; srcs[1] = P.w_up + wo; dsts[0] = P.Wgu() + (alt ? (OFF_WGU3 - OFF_WGU) / 2 : 0) + ((size_t)e * 2) * DEXP * DM; dsts[1] = dsts[0] + (size_t)DEXP * DM; }
        else { srcs[0] = P.w_down + ((size_t)l * NEXP + e) * DEXP * DM; srcs[1] = srcs[0]; dsts[0] = P.Wd() + (alt ? (OFF_WD3 - OFF_WD) / 2 : 0) + (size_t)e * DM * DEXP; dsts[1] = dsts[0]; }
        f32x4 r[2][NLD]; f16x8 ar[2][2];
        const unsigned ldoff = (unsigned)(((tid / (NC / 4)) * N + (tid % (NC / 4)) * 4) * 4);
#define CV_LOAD(ti, slot) do { const int which_ = GATEUP ? (sel_ >= 0 ? sel_ : ((ti) & 1)) : 0, kt_ = (GATEUP && sel_ < 0) ? ((ti) >> 1) : (ti); const char* sp_ = (const char*)(srcs[which_] + (size_t)(kt_ * 128) * N + nbk * NC); \
            _Pragma("unroll") for (int p = 0; p < NLD; ++p) r[slot][p] = __builtin_nontemporal_load((const f32x4*)(sp_ + (size_t)p * (NTHR / (NC / 4)) * N * 4 + ldoff)); \
            if (CTX) { _Pragma("unroll") for (int p = 0; p < 2; ++p) ar[slot][p] = *(const f16x8*)(ap[p] + kt_ * 128); } } while (0)
#define CV_TILE(ti, slot) do { const int which = GATEUP ? (sel_ >= 0 ? sel_ : ((ti) & 1)) : 0, kt = (GATEUP && sel_ < 0) ? ((ti) >> 1) : (ti); \
            f16* tl = tile + (slot) * TW; f16* al = asl + (slot) * (64 * 128); \
            _Pragma("unroll") for (int p = 0; p < NLD; ++p) { const int id = tid + p * NTHR, kr = id / (NC / 4), c4 = (id % (NC / 4)) * 4; *(f16x4*)(tl + kr * TS + c4) = pk4(r[slot][p]); } \
            if (CTX) { _Pragma("unroll") for (int p = 0; p < 2; ++p) { const int row = (tid >> 4) + p * 32; *(f16x8*)(al + row * 128 + (((tid & 15) ^ (row & 15)) * 8)) = ar[slot][p]; } } \
            if ((ti) + 2 < ntr) CV_LOAD((ti) + 2, slot); \
            asm volatile("s_waitcnt lgkmcnt(0)" ::: "memory"); __builtin_amdgcn_s_barrier(); asm volatile("" ::: "memory"); \
            f16* dp = dsts[which] + (size_t)(nbk * NC + cb * 16 + r16) * K + kt * 128 + kq * 8; \
            _Pragma("unroll") for (int ks = 0; ks < 4; ++ks) { f16x8 bv; \
                _Pragma("unroll") for (int i = 0; i < 8; ++i) bv[i] = tl[(ks * 32 + kq * 8 + i) * TS + cb * 16 + r16]; \
                if (rb0 == 0) *(f16x8*)(dp + ks * 32) = rmw8(bv); \
                if (CTX) { _Pragma("unroll") for (int rb = 0; rb < NRB; ++rb) { const int row = (rb0 + rb) * 16 + r16; const f16x8 af = *(const f16x8*)(al + row * 128 + (((ks * 4 + kq) ^ r16) * 8)); \
                    acc[which][rb] = __builtin_amdgcn_mfma_f32_16x16x32_f16(bv, af, acc[which][rb], 0, 0, 0); } } } } while (0)
        CV_LOAD(0, 0); CV_LOAD(1, 1);
        for (int t2 = 0; t2 < ntr; t2 += 2) { CV_TILE(t2, 0); CV_TILE(t2 + 1, 1); }
#undef CV_LOAD
#undef CV_TILE
        asm volatile("s_waitcnt lgkmcnt(0)" ::: "memory"); __builtin_amdgcn_s_barrier(); asm volatile("" ::: "memory");
        if (CTX) {
#pragma unroll
            for (int rb = 0; rb < NRB; ++rb) {
                const size_t row = (size_t)e * SLOTS_PAD + 4096 + (rb0 + rb) * 16 + r16; const int col = nbk * NC + cb * 16 + 4 * kq;
                if (GATEUP) { f32x4 o;
#pragma unroll
                    for (int jj = 0; jj < 4; ++jj) o[jj] = silu_f(acc[0][rb][jj]) * acc[1][rb][jj];
                    *(f16x4*)(P.act() + row * DEXP + col) = pk4(o); }
                else *(f16x4*)(P.yslot() + row * DM + col) = pk4(acc[0][rb]);
            }
        }
    }
}

__device__ __forceinline__ void cvt3_job(const Params& P, int job, f16* tile) {
    if (job < 256) phase_cvt_ctx<false, false>(P, 3, job, 1 << 20, tile, -1, true);
    else { const int h = job - 256; phase_cvt_ctx<true, false>(P, 3, h >> 1, 1 << 20, tile, h & 1, true); }
}
__device__ __forceinline__ void phase_gateup_fast(const Params& P, LAS unsigned char* lds, int rt = 17, bool alt = false) { fg::PRGateUp S; S.H = P.H(); S.rowidx = P.rowidx(); S.W = P.Wgu() + (alt ? (OFF_WGU3 - OFF_WGU) / 2 : 0); S.act = P.act(); S.rt = rt; S.nunits = 16 * rt * 16; S.bid = opaque_bid(); fg::gemm_phase(lds, S, P.wv); }
__device__ __forceinline__ void phase_down_fast(const Params& P, LAS unsigned char* lds, int rt = 17, bool alt = false) { fg::PRDown S; S.act = P.act(); S.W = P.Wd() + (alt ? (OFF_WD3 - OFF_WD) / 2 : 0); S.y = P.yslot(); S.rt = rt; S.nunits = 16 * rt * 4; S.bid = opaque_bid(); fg::gemm_phase(lds, S, P.wv); }
__device__ __forceinline__ void phase_pool_fast(const Params& P, LAS unsigned char* lds) { fg::PRDense<256> S; S.qn = nullptr; S.kn = nullptr; S.rope = nullptr; S.xs = nullptr; S.lane = 0; S.npan = 130; S.kvx = 0; S.A = P.H(); S.W = P.Wmix(); S.O0 = P.Z(); S.O1 = nullptr; S.O2 = nullptr; S.ncol = 4; S.mode = 2; S.bid = opaque_bid(); fg::gemm_phase(lds, S, P.wv); }
__device__ __forceinline__ void phase_qkv_fast(const Params& P, LAS unsigned char* lds, bool lastl = false, int l = 1) { fg::PRDense<1024> S; S.qn = P.q_norm + (l >> 1) * 64; S.kn = P.k_norm + (l >> 1) * 64; S.rope = P.rope(); S.xs = (LAS float*)(lds + fg::STAGE_BYTES); S.lane = opaque_tid_(P.wv) & 63; S.npan = lastl ? 128 : 130; S.kvx = lastl ? 4 : 0; S.A = P.H(); S.W = P.Wmix(); S.O0 = P.Q(); S.O1 = P.Kb(); S.O2 = P.Vb(); S.ncol = 6; S.mode = 1; S.bid = opaque_bid(); fg::gemm_phase(lds, S, P.wv); }
__device__ __forceinline__ void phase_oproj_fast(const Params& P, LAS unsigned char* lds, bool lastl = false) { fg::PRDense<1024> S; S.qn = nullptr; S.kn = nullptr; S.rope = nullptr; S.xs = nullptr; S.lane = 0; S.npan = lastl ? 128 : 130; S.kvx = 0; S.A = P.O(); S.W = P.Wmix() + (size_t)QKVD * DM; S.O0 = P.Z(); S.O1 = nullptr; S.O2 = nullptr; S.ncol = 4; S.mode = 0; S.bid = opaque_bid(); fg::gemm_phase(lds, S, P.wv); }

typedef float f32x16 __attribute__((ext_vector_type(16)));
#define AT_KB 9216
#define AT_VB 8704
template <int VAR = 0>
__device__ __forceinline__ void phase_attn_fast(const Params& P, int l, LAS unsigned char* lds, bool do_ctx, int cvt_l = -1) {
    const int j = l >> 1;
    const int tid = opaque_tid(), wid = tid >> 6, lane = tid & 63, l32 = lane & 31, hi = lane >> 5;
    const int g = wid >> 1, qoff = (wid & 1) * 64, qoffu = (P.wv & 1) * 64;
    const int nunits = do_ctx ? 1040 : 1024;
    int ucount = 0;
    for (int u = opaque_bid(); u < nunits; u += gridDim.x, ++ucount) {
        int b, qblk, kv, qrow0, t0, t1, s0;
        if (u < 1024) { b = u >> 9; qblk = (u >> 2) & 127; kv = u & 3; s0 = b * SEQ; qrow0 = s0 + qblk * 128; t0 = qblk == 0 ? 2 : 0; t1 = qblk == 127 ? 4 : 6; }
        else { const int uu = u - 1024; b = uu >> 3; qblk = (uu >> 2) & 1; kv = uu & 3; s0 = NLAT + b * CTXL; qrow0 = s0 + qblk * 128; t0 = 0; t1 = 0; }
        const int cb = NLAT + b * CTXL, nloc = t1 - t0, ntiles = nloc + 4;
        const int h = kv * 4 + g;
        f16x8 Qf[2][4];
#pragma unroll
        for (int qb = 0; qb < 2; ++qb)
#pragma unroll
            for (int ks = 0; ks < 4; ++ks) Qf[qb][ks] = *(const f16x8*)(P.Q() + (size_t)(qrow0 + qoff + 32 * qb + l32) * 1024 + h * 64 + 16 * ks + 8 * hi);
        f32x16 OT[2][2];
#pragma unroll
        for (int db = 0; db < 2; ++db)
#pragma unroll
            for (int qb = 0; qb < 2; ++qb)
#pragma unroll
                for (int r = 0; r < 16; ++r) OT[db][qb][r] = 0.f;
        float mrun[2], lrun[2];
        { const float sk = P.sink[j * 16 + h] * 1.4426950408889634f; mrun[0] = sk; mrun[1] = sk; lrun[0] = hi == 0 ? 1.0f : 0.0f; lrun[1] = lrun[0]; }
        const int lkey = tid >> 3, lpc = tid & 7;
        f16x8 kreg, vreg;
        auto tile_row = [&](int it) -> int { return it < nloc ? (qrow0 - 128 + 64 * (t0 + it)) : (cb + 64 * (it - nloc)); };
        { const int kr = tile_row(0) + lkey; kreg = *(const f16x8*)(P.Kb() + (size_t)kr * 256 + kv * 64 + lpc * 8); vreg = *(const f16x8*)(P.Vb() + (size_t)kr * 256 + kv * 64 + lpc * 8); }
        __syncthreads();
        {
            LAS f16* Kl = (LAS f16*)(lds); LAS f16* Vl = (LAS f16*)(lds + 2 * AT_KB);
            *(LAS f16x8*)(Kl + lkey * 72 + lpc * 8) = kreg;
#pragma unroll
            for (int i = 0; i < 8; ++i) Vl[(lpc * 8 + i) * 68 + lkey] = vreg[i];
        }
        __syncthreads();
        for (int it = 0; it < ntiles; ++it) {
            const int buf = it & 1;
            if (it + 1 < ntiles) { const int kr = tile_row(it + 1) + lkey; kreg = *(const f16x8*)(P.Kb() + (size_t)kr * 256 + kv * 64 + lpc * 8); vreg = *(const f16x8*)(P.Vb() + (size_t)kr * 256 + kv * 64 + lpc * 8); }
            const LAS f16* Kl = (const LAS f16*)(lds + buf * AT_KB); const LAS f16* Vl = (const LAS f16*)(lds + 2 * AT_KB + buf * AT_VB);
            int cls = 0;
            if (it < nloc) { const int tl = t0 + it, dmin = qoffu + 65 - 64 * tl, dmax = qoffu + 191 - 64 * tl; cls = (dmin > 128 || dmax < -128) ? 2 : ((dmin >= -128 && dmax <= 128) ? 0 : 1); }
            if (cls != 2) {
            f32x16 S[2][2];
#pragma unroll
            for (int kb = 0; kb < 2; ++kb)
#pragma unroll
                for (int qb = 0; qb < 2; ++qb)
#pragma unroll
                    for (int r = 0; r < 16; ++r) S[kb][qb][r] = -mrun[qb];
#pragma unroll
            for (int ks = 0; ks < 4; ++ks)
#pragma unroll
                for (int kb = 0; kb < 2; ++kb) {
                    const f16x8 kf = *(const LAS f16x8*)(Kl + (32 * kb + l32) * 72 + 16 * ks + 8 * hi);
#pragma unroll
                    for (int qb = 0; qb < 2; ++qb) S[kb][qb] = __builtin_amdgcn_mfma_f32_32x32x16_f16(kf, Qf[qb][ks], S[kb][qb], 0, 0, 0);
                }
            if (cls == 1) {
                const int kt = 64 * (t0 + it);
#pragma unroll
                for (int qb = 0; qb < 2; ++qb) {
                    const int qp = 128 + qoff + 32 * qb + l32;
#pragma unroll
                    for (int kb = 0; kb < 2; ++kb)
#pragma unroll
                        for (int r = 0; r < 16; ++r) { const int kp = kt + 32 * kb + 8 * (r >> 2) + 4 * hi + (r & 3); const int d = qp - kp; if (d > 128 || d < -128) S[kb][qb][r] = -INFINITY; }
                }
            }
            f16x8 Pf[2][4];
#pragma unroll
            for (int qb = 0; qb < 2; ++qb) {
                float mx = S[0][qb][0];
#pragma unroll
                for (int kb = 0; kb < 2; ++kb)
#pragma unroll
                    for (int r = 0; r < 16; ++r) mx = fmaxf(mx, S[kb][qb][r]);
                { const auto sw = __builtin_amdgcn_permlane32_swap(__float_as_uint(mx), __float_as_uint(mx), false, false); mx = fmaxf(__uint_as_float(sw[0]), __uint_as_float(sw[1])); }
                if (__builtin_amdgcn_ballot_w64(mx > 8.0f) != 0ull) {
                    const float g = fmaxf(mx, 0.f), corr = __builtin_amdgcn_exp2f(-g);
                    mrun[qb] += g; lrun[qb] *= corr;
#pragma unroll
                    for (int kb = 0; kb < 2; ++kb)
#pragma unroll
                        for (int r = 0; r < 16; ++r) S[kb][qb][r] -= g;
#pragma unroll
                    for (int db = 0; db < 2; ++db)
#pragma unroll
                        for (int r = 0; r < 16; ++r) OT[db][qb][r] *= corr;
                }
                float ps = 0.f;
#pragma unroll
                for (int kb = 0; kb < 2; ++kb)
#pragma unroll
                    for (int r = 0; r < 16; ++r) { const float p = __builtin_amdgcn_exp2f(S[kb][qb][r]); S[kb][qb][r] = p; ps += p; }
                lrun[qb] += ps;
#pragma unroll
                for (int ks = 0; ks < 4; ++ks) { const int kb = ks >> 1, r0 = 8 * (ks & 1);
#pragma unroll
                    for (int e = 0; e < 8; ++e) Pf[qb][ks][e] = (f16)S[kb][qb][r0 + e]; }
            }
#pragma unroll
            for (int ks = 0; ks < 4; ++ks)
#pragma unroll
                for (int db = 0; db < 2; ++db) {
                    const LAS f16* vp = Vl + (32 * db + l32) * 68 + 16 * ks + 4 * hi;
                    const f16x4 v0 = *(const LAS f16x4*)vp, v1 = *(const LAS f16x4*)(vp + 8);
                    const f16x8 vf = (f16x8){v0[0], v0[1], v0[2], v0[3], v1[0], v1[1], v1[2], v1[3]};
#pragma unroll
                    for (int qb = 0; qb < 2; ++qb) OT[db][qb] = __builtin_amdgcn_mfma_f32_32x32x16_f16(vf, Pf[qb][ks], OT[db][qb], 0, 0, 0);
                }
            }
            if (it + 1 < ntiles) {
                LAS f16* Kw = (LAS f16*)(lds + (buf ^ 1) * AT_KB); LAS f16* Vw = (LAS f16*)(lds + 2 * AT_KB + (buf ^ 1) * AT_VB);
                *(LAS f16x8*)(Kw + lkey * 72 + lpc * 8) = kreg;
#pragma unroll
                for (int i = 0; i < 8; ++i) Vw[(lpc * 8 + i) * 68 + lkey] = vreg[i];
            }
            __syncthreads();
        }
#pragma unroll
        for (int qb = 0; qb < 2; ++qb) {
            const float lt = lrun[qb] + shx<32>(lrun[qb], lane);
            const float inv = 1.0f / lt;
            f16* op = P.O() + (size_t)(qrow0 + qoff + 32 * qb + l32) * 1024 + h * 64;
#pragma unroll
            for (int db = 0; db < 2; ++db)
#pragma unroll
                for (int i = 0; i < 4; ++i) {
                    const f16x4 o = (f16x4){(f16)(OT[db][qb][4 * i] * inv), (f16)(OT[db][qb][4 * i + 1] * inv), (f16)(OT[db][qb][4 * i + 2] * inv), (f16)(OT[db][qb][4 * i + 3] * inv)};
                    *(f16x4*)(op + 32 * db + 8 * i + 4 * hi) = rm4(o);
                }
        }
    }
}

#define MEGA_LDS (147456 + 16)
__device__ __forceinline__ const Params& opq(Params& q) { int z; asm volatile("s_mov_b32 %0, 0" : "=s"(z)); q.zoff = z; return q; }
__global__ __launch_bounds__(NTHR, 2) void mega(Params P) {
    extern __shared__ __attribute__((aligned(16))) unsigned char shm[];
    LAS unsigned char* lds = (LAS unsigned char*)shm;
    volatile LAS unsigned* st = (volatile LAS unsigned*)(lds + 147456);
    if (threadIdx.x == 0) { st[0] = 0u; st[1] = 0u; st[2] = 0u; st[3] = 0u; }
    __syncthreads();
    const XcdBarrier bar = xcd_barrier_post(P.bar(), st);
    const int nb = gridDim.x;
#define bid (opaque_bid())
    Params Q = P; Q.wv = __builtin_amdgcn_readfirstlane(threadIdx.x >> 6);
#define P (opq(Q))
    phase_ada(P, bid, nb, (float*)shm);
    __syncthreads();
    phase_convert(P, 0, bid, nb, (f16*)shm, false);
    xcd_barrier(bar);
    for (int l = 0; l < 4; ++l) {
        if (l == 0) phase_n1<true, false>(P, l, bid, nb); else { phase_n1<false, false>(P, l, bid, nb); __syncthreads(); phase_convert(P, l, bid, nb, (f16*)shm, false);
            }
        xcd_barrier(bar);
        if ((l & 1) == 0) {
            phase_pool_fast(P, lds);
            xcd_barrier(bar);
            phase_n2<true>(P, l, bid, nb, (float*)shm);
        } else {
            phase_qkv_fast(P, lds, l == 3, l);
            if (nb == 256 && (bid & 7) >= 2) { __syncthreads(); cvt3_job(P, (l == 1 ? 192 : 576) + ((bid & 7) - 2) * 32 + (bid >> 3), (f16*)shm); }
            xcd_barrier(bar);
            phase_attn_fast(P, l, lds, l != 3);
            if (l == 3 && nb != 256) { __syncthreads(); phase_cvt_ctx<true, false>(P, l, bid, nb, (f16*)shm, -1, true); phase_cvt_ctx<false, false>(P, l, bid, nb, (f16*)shm, -1, true); }
            xcd_barrier(bar);
            phase_oproj_fast(P, lds, l == 3);
            if (l == 1 && nb == 256 && (bid & 7) >= 2) { __syncthreads(); cvt3_job(P, 384 + ((bid & 7) - 2) * 32 + (bid >> 3), (f16*)shm); }
            xcd_barrier(bar);
            phase_n2<false>(P, l, bid, nb, (float*)shm, l == 3 ? NLAT : MROWS);
        }
        xcd_barrier(bar);
        phase_topk(P, bid, nb, (unsigned*)shm, l == 3 ? 32 : 64);
        if (l < 3 && nb == 256 && bid >= 64 && bid < 128) cvt3_job(P, l * 64 + bid - 64, (f16*)shm);
        xcd_barrier(bar);
        if (l < 3) { phase_cvt_ctx<true, true>(P, l, bid, nb, (f16*)shm); xcd_barrier(bar); }
        phase_gateup_fast(P, lds, 16, l == 3);
        if (l < 3) { __syncthreads(); phase_cvt_ctx<false, true>(P, l, bid, nb, (f16*)shm); }
        xcd_barrier(bar);
        phase_down_fast(P, lds, 16, l == 3);
        xcd_barrier(bar);
    }
    phase_n1<false, true>(P, 4, bid, nb);
#undef P
#undef bid
}

static inline size_t al256(size_t v) { return (v + 255) & ~(size_t)255; }

extern "C" void kernel_launch(void* const* d_in, const int* in_sizes, int n_in, void* d_out, int out_size, void* d_ws, size_t ws_size, hipStream_t stream) {
    Params P{};
    P.x = (const float*)d_in[0]; P.c = (const float*)d_in[1]; P.ctx = (const float*)d_in[2]; P.c_ctx = (const float*)d_in[3];
    P.w_ada = (const float*)d_in[4]; P.b_ada = (const float*)d_in[5]; P.norm1_g = (const float*)d_in[6]; P.norm2_g = (const float*)d_in[7];
    P.pool_w = (const float*)d_in[8]; P.pool_scale = (const float*)d_in[9]; P.w_qkv = (const float*)d_in[10]; P.w_o = (const float*)d_in[11];
    P.q_norm = (const float*)d_in[12]; P.k_norm = (const float*)d_in[13]; P.sink = (const float*)d_in[14]; P.router_w = (const float*)d_in[15];
    P.w_gate = (const float*)d_in[16]; P.w_up = (const float*)d_in[17]; P.w_down = (const float*)d_in[18];
    P.out = (float*)d_out;
    P.ws = (char*)d_ws; const size_t off = WS_TOTAL;
    if (off > ws_size) { fprintf(stderr, "workspace too small: need %zu have %zu\n", off, ws_size); return; }
    static int grid = 0;
    if (!grid) {
        int dev = 0, cus = 0, per_cu = 0;
        hipGetDevice(&dev);
        hipDeviceGetAttribute(&cus, hipDeviceAttributeMultiprocessorCount, dev);
        hipFuncSetAttribute((const void*)mega, hipFuncAttributeMaxDynamicSharedMemorySize, MEGA_LDS);
        hipOccupancyMaxActiveBlocksPerMultiprocessor(&per_cu, (const void*)mega, NTHR, MEGA_LDS);
        if (per_cu < 1) { fprintf(stderr, "mega: occupancy query says %d blocks per CU\n", per_cu); }
        grid = cus > 0 ? cus : 256;
    }
    hipMemsetAsync(P.bar(), 0, XCD_BAR_WORDS * sizeof(unsigned), stream);
    hipLaunchKernelGGL(mega, dim3(grid), dim3(NTHR), MEGA_LDS, stream, P);
}
```

```cpp
#include <hip/hip_runtime.h>
#include <stdint.h>
#include <stdio.h>

typedef _Float16 f16;
typedef _Float16 f16x2 __attribute__((ext_vector_type(2)));
typedef _Float16 f16x4 __attribute__((ext_vector_type(4)));
typedef _Float16 f16x8 __attribute__((ext_vector_type(8)));
typedef float f32x4 __attribute__((ext_vector_type(4)));
typedef float f32x2 __attribute__((ext_vector_type(2)));
typedef unsigned u32x2 __attribute__((ext_vector_type(2)));
typedef unsigned u32x4 __attribute__((ext_vector_type(4)));
#define RM_BITS 5
#define RM_ADD (0x00010001u << (RM_BITS - 1))
#define RM_MASK (~(0x00010001u * ((1u << RM_BITS) - 1u)))
__device__ __forceinline__ f16x4 rm4(f16x4 v) { u32x2 b = __builtin_bit_cast(u32x2, v); b = (b + RM_ADD) & RM_MASK; return __builtin_bit_cast(f16x4, b); }
__device__ __forceinline__ f16x8 rm8(f16x8 v) { u32x4 b = __builtin_bit_cast(u32x4, v); b = (b + RM_ADD) & RM_MASK; return __builtin_bit_cast(f16x8, b); }
#define RMW_BITS 5
__device__ __forceinline__ f16x8 rmw8(f16x8 v) { u32x4 b = __builtin_bit_cast(u32x4, v); b = (b + (0x00010001u << (RMW_BITS - 1))) & ~(0x00010001u * ((1u << RMW_BITS) - 1u)); return __builtin_bit_cast(f16x8, b); }

#define LAS __attribute__((address_space(3)))
#define DM 1024
#define SEQ 16384
#define NLAT 32768
#define CTXL 256
#define NCTX 512
#define MROWS 33280
#define NEXP 16
#define DEXP 2048
#define SLOTS 4160
#define SLOTS_PAD 4352
#define QKVD 1536
#define NTHR 512

constexpr size_t al256c(size_t v) { return (v + 255) & ~(size_t)255; }
constexpr size_t OFF_BAR = 0;
constexpr size_t OFF_MOD = al256c(OFF_BAR + 16384);
constexpr size_t OFF_ROPE = al256c(OFF_MOD + (size_t)4 * 3 * 6 * DM * 4);
constexpr size_t OFF_X = al256c(OFF_ROPE + (size_t)256 * 16 * 2 * 4);
constexpr size_t OFF_H = al256c(OFF_X + (size_t)MROWS * DM * 4);
constexpr size_t OFF_Z = al256c(OFF_H + (size_t)MROWS * DM * 2);
constexpr size_t OFF_Q = al256c(OFF_Z + (size_t)MROWS * DM * 2);
constexpr size_t OFF_KB = al256c(OFF_Q + (size_t)MROWS * DM * 2);
constexpr size_t OFF_VB = al256c(OFF_KB + (size_t)MROWS * 256 * 2);
constexpr size_t OFF_VT = al256c(OFF_VB + (size_t)MROWS * 256 * 2);
constexpr size_t OFF_O = al256c(OFF_VT + (size_t)MROWS * 256 * 2);
constexpr size_t OFF_AFF = al256c(OFF_O + (size_t)MROWS * DM * 2);
constexpr size_t OFF_INV = al256c(OFF_AFF + (size_t)MROWS * 16 * 4);
constexpr size_t OFF_ROWIDX = al256c(OFF_INV + (size_t)MROWS * 16 * 4);
constexpr size_t OFF_ACT = al256c(OFF_ROWIDX + (size_t)NEXP * SLOTS_PAD * 4);
constexpr size_t OFF_YSLOT = al256c(OFF_ACT + (size_t)NEXP * SLOTS_PAD * DEXP * 2);
constexpr size_t OFF_WGU = al256c(OFF_YSLOT + (size_t)NEXP * SLOTS_PAD * DM * 2);
constexpr size_t OFF_WD = al256c(OFF_WGU + (size_t)NEXP * 2 * DEXP * DM * 2);
constexpr size_t OFF_WMIX = al256c(OFF_WD + (size_t)NEXP * DM * DEXP * 2);
constexpr size_t OFF_WGU3 = al256c(OFF_WMIX + (size_t)(QKVD + DM) * DM * 2);
constexpr size_t OFF_WD3 = al256c(OFF_WGU3 + (size_t)NEXP * 2 * DEXP * DM * 2);
constexpr size_t OFF_DUMMY = al256c(OFF_WD3 + (size_t)NEXP * DM * DEXP * 2);
constexpr size_t WS_TOTAL = OFF_DUMMY;
struct Params {
    const float *x, *c, *ctx, *c_ctx, *w_ada, *b_ada, *norm1_g, *norm2_g, *pool_w, *pool_scale, *w_qkv, *w_o, *q_norm, *k_norm, *sink, *router_w, *w_gate, *w_up, *w_down;
    float* out; char* ws; int wv; int zoff;
#define WSF(name, type, off) __host__ __device__ __forceinline__ type* name() const { return (type*)(ws + zoff + (off)); }
    WSF(bar, unsigned, OFF_BAR) WSF(mod, float, OFF_MOD) WSF(rope, float, OFF_ROPE) WSF(X, f16, OFF_X) WSF(H, f16, OFF_H) WSF(Z, f16, OFF_Z) WSF(Q, f16, OFF_Q) WSF(Kb, f16, OFF_KB) WSF(Vb, f16, OFF_VB) WSF(Vt, f16, OFF_VT)
    WSF(O, f16, OFF_O) WSF(aff, float, OFF_AFF) WSF(inv, int, OFF_INV) WSF(rowidx, int, OFF_ROWIDX) WSF(act, f16, OFF_ACT) WSF(yslot, f16, OFF_YSLOT) WSF(Wgu, f16, OFF_WGU) WSF(Wd, f16, OFF_WD) WSF(Wmix, f16, OFF_WMIX)
#undef WSF
#define WSW(name, type, off) __host__ __device__ __forceinline__ type* name() const { return (type*)(ws + zoff + (off)); }
    WSW(Xw, f16, OFF_X) WSW(Ow, f16, OFF_O) WSW(Hw, f16, OFF_H) WSW(affw, float, OFF_AFF) WSW(Qw, f16, OFF_Q) WSW(Kw, f16, OFF_KB)
#undef WSW
};

template <int O> __device__ __forceinline__ float shx(float v, int lane) {
    if (O == 1) return __int_as_float(__builtin_amdgcn_update_dpp(0, __float_as_int(v), 0xB1, 0xF, 0xF, true));
    if (O == 2) return __int_as_float(__builtin_amdgcn_update_dpp(0, __float_as_int(v), 0x4E, 0xF, 0xF, true));
    if (O < 32) return __int_as_float(__builtin_amdgcn_ds_swizzle(__float_as_int(v), (O << 10) | 0x1f));
    return __int_as_float(__builtin_amdgcn_ds_bpermute((lane ^ O) << 2, __float_as_int(v)));
}
__device__ __forceinline__ float wave_sum(float v, int lane) {
    v += shx<1>(v, lane); v += shx<2>(v, lane); v += shx<4>(v, lane); v += shx<8>(v, lane); v += shx<16>(v, lane); v += shx<32>(v, lane);
    return v;
}
__device__ __forceinline__ unsigned shup(unsigned v, int o, int lane) { return (unsigned)__builtin_amdgcn_ds_bpermute((lane - o) << 2, (int)v); }
__device__ __forceinline__ int opaque_bid() { int b = blockIdx.x; asm volatile("" : "+s"(b)); return b; }
#define opaque_tid() opaque_tid_(P.wv)
__device__ __forceinline__ int opaque_tid_(int wv) { int ln; asm volatile("v_mbcnt_lo_u32_b32 %0, -1, 0\n\tv_mbcnt_hi_u32_b32 %0, -1, %0" : "=v"(ln)); return (wv << 6) | ln; }
__device__ __forceinline__ float silu_f(float v) { return v * __builtin_amdgcn_rcpf(1.0f + __expf(-v)); }

__device__ __forceinline__ const float* modp(const Params& P, int l, int v, int j) { return P.mod() + (size_t)((l * 3 + v) * 6 + j) * DM; }

__device__ __forceinline__ void phase_ada(const Params& P, int bid, int nb, float* lds) {
    float* sc = lds; float* red = lds + 3 * DM;
    const int tid = opaque_tid();
    for (int i = tid; i < 3 * DM; i += NTHR) { const int v = i >> 10, k = i & 1023; const float cv = v < 2 ? P.c[v * DM + k] : P.c_ctx[k]; sc[i] = silu_f(cv); }
    __syncthreads();
    for (int u = bid; u < 4 * 96; u += nb) {
        const int l = u / 96, ch = u % 96, col = ch * 64 + (tid & 63), ks = tid >> 6;
        const float* w = P.w_ada + (size_t)l * DM * 6 * DM + col;
        float s0 = 0.f, s1 = 0.f, s2 = 0.f;
        for (int k = ks * 128; k < ks * 128 + 128; ++k) { const float wv = __builtin_nontemporal_load(w + (size_t)k * 6 * DM); s0 += sc[k] * wv; s1 += sc[DM + k] * wv; s2 += sc[2 * DM + k] * wv; }
        red[(ks * 3 + 0) * 64 + (tid & 63)] = s0; red[(ks * 3 + 1) * 64 + (tid & 63)] = s1; red[(ks * 3 + 2) * 64 + (tid & 63)] = s2;
        __syncthreads();
        if (tid < 192) { const int v = tid >> 6, cc = tid & 63; float s = 0.f;
#pragma unroll
            for (int q = 0; q < 8; ++q) s += red[(q * 3 + v) * 64 + cc];
            const int colg = ch * 64 + cc; s += P.b_ada[l * 6 * DM + colg];
            const int j = colg >> 10, d = colg & 1023;
            P.mod()[(size_t)((l * 3 + v) * 6 + j) * DM + d] = s; }
        __syncthreads();
    }
    for (int i = bid * NTHR + tid; i < 256 * 16; i += nb * NTHR) {
        const int p = i >> 4, f = i & 15;
        const float inv = powf(10000.0f, -(float)f / 16.0f);
        const float angf = (float)p * inv;
        double a = (double)angf;
        const double twopi = 6.283185307179586476925286766559;
        a -= twopi * rint(a / twopi);
        const double a2 = a * a;
        double cs = 1.0, sn = 1.0;
        double tc = 0.0, ts = 0.0;
        for (int n = 16; n >= 1; --n) { tc = (tc + 1.0) * (-a2 / (double)((2 * n - 1) * (2 * n))); ts = (ts + 1.0) * (-a2 / (double)((2 * n) * (2 * n + 1))); }
        cs = 1.0 + tc; sn = a * (1.0 + ts);
        P.rope()[i * 2] = (float)cs; P.rope()[i * 2 + 1] = (float)sn;
    }
}

__device__ __forceinline__ f32x4 cvt4(const f16x4 v) { return (f32x4){(float)v[0], (float)v[1], (float)v[2], (float)v[3]}; }
__device__ __forceinline__ f16x4 pk4(const f32x4 v) { return (f16x4){(f16)v[0], (f16)v[1], (f16)v[2], (f16)v[3]}; }
__device__ __forceinline__ float dot4(const f32x4 a, const f32x4 b) { return a[0] * b[0] + a[1] * b[1] + a[2] * b[2] + a[3] * b[3]; }
template <bool FIRST, bool FINAL>
__device__ __forceinline__ void phase_n1(const Params& P, int l, int bid, int nb) {
    constexpr int R = 4;
    const int tid_ = opaque_tid(); const int wid = P.wv, lane = tid_ & 63;
    const int nrows = FINAL ? NLAT : MROWS;
    for (int rb = (bid * 8 + wid) * R; rb < nrows; rb += nb * 8 * R) {
        const int v = rb < NLAT ? (rb >> 14) : 2;
        f32x4 xv[R][4];
#pragma unroll
        for (int u = 0; u < R; ++u) {
            const int r = rb + u;
            if (FIRST) { const float* src = r < NLAT ? P.x + (size_t)r * DM : P.ctx + (size_t)(r - NLAT) * DM;
#pragma unroll
                for (int q = 0; q < 4; ++q) xv[u][q] = __builtin_nontemporal_load((const f32x4*)(src + q * 256 + lane * 4)); }
            else { const f16* src = P.X() + (size_t)r * DM;
#pragma unroll
                for (int q = 0; q < 4; ++q) xv[u][q] = cvt4(*(const f16x4*)(src + q * 256 + lane * 4)); }
        }
        if (!FIRST) {
            const int sl = P.inv()[(size_t)(lane & 15) * MROWS + rb + (lane >> 4)];
            const float af = P.aff()[(size_t)(lane & 15) * MROWS + rb + (lane >> 4)];
            const unsigned long long bal = __builtin_amdgcn_ballot_w64(sl >= 0);
            unsigned m[R];
#pragma unroll
            for (int u = 0; u < R; ++u) m[u] = (unsigned)(bal >> (16 * u)) & 0xffffu;
            const f16* ys = P.yslot();
            const float* g2 = modp(P, l - 1, v, 5);
            f32x4 gv[4];
#pragma unroll
            for (int q = 0; q < 4; ++q) gv[q] = *(const f32x4*)(g2 + q * 256 + lane * 4);
            while (m[0] | m[1] | m[2] | m[3]) {
                f16x4 yv[R][4]; float w[R];
#pragma unroll
                for (int u = 0; u < R; ++u) {
                    const int e = m[u] ? __builtin_ctz(m[u]) : 0;
                    const int sv = m[u] ? __builtin_amdgcn_readlane(sl, 16 * u + e) : 0;
                    w[u] = m[u] ? __int_as_float(__builtin_amdgcn_readlane(__float_as_int(af), 16 * u + e)) : 0.f;
                    m[u] &= m[u] - 1u;
                    const f16* y = ys + ((size_t)e * SLOTS_PAD + sv) * DM + lane * 4;
#pragma unroll
                    for (int q = 0; q < 4; ++q) yv[u][q] = *(const f16x4*)(y + q * 256);
                }
#pragma unroll
                for (int u = 0; u < R; ++u)
#pragma unroll
                    for (int q = 0; q < 4; ++q) xv[u][q] += (w[u] * gv[q]) * cvt4(yv[u][q]);
            }
        }
        if (FINAL) {
#pragma unroll
            for (int u = 0; u < R; ++u)
#pragma unroll
                for (int q = 0; q < 4; ++q) __builtin_nontemporal_store(xv[u][q], (f32x4*)(P.out + (size_t)(rb + u) * DM + q * 256 + lane * 4));
            continue;
        }
        float ss[R];
#pragma unroll
        for (int u = 0; u < R; ++u) {
            f16* xd = P.Xw() + (size_t)(rb + u) * DM; float sacc = 0.f;
#pragma unroll
            for (int q = 0; q < 4; ++q) { *(f16x4*)(xd + q * 256 + lane * 4) = pk4(xv[u][q]); sacc += dot4(xv[u][q], xv[u][q]); }
            ss[u] = sacc;
        }
#pragma unroll
        for (int u = 0; u < R; ++u) ss[u] = rsqrtf(wave_sum(ss[u], lane) * (1.0f / DM) + 1e-6f);
        const float* g = P.norm1_g + l * DM; const float* sh = modp(P, l, v, 0); const float* scl = modp(P, l, v, 1);
#pragma unroll
        for (int q = 0; q < 4; ++q) {
            const int c0 = q * 256 + lane * 4;
            const f32x4 gq = *(const f32x4*)(g + c0), sq = *(const f32x4*)(sh + c0), cq = *(const f32x4*)(scl + c0);
            const f32x4 gm = gq * (1.0f + cq);
#pragma unroll
            for (int u = 0; u < R; ++u) *(f16x4*)(P.Hw() + (size_t)(rb + u) * DM + c0) = rm4(pk4(xv[u][q] * ss[u] * gm + sq));
        }
    }
}

#define N2_ZST 81920
template <bool POOL>
__device__ __forceinline__ void phase_n2(const Params& P, int l, int bid, int nb, float* lds, int nrows = MROWS) {
    const int tid = opaque_tid(), wid = P.wv, lane = tid & 63;
    const float* wr = P.router_w + (size_t)l * DM * NEXP;
    f16* wh = (f16*)lds;
    for (int i = tid; i < DM * NEXP; i += NTHR) { const int d = i >> 4, e = i & 15; wh[e * 1032 + d] = (f16)wr[i]; }
    f16* h2s = (f16*)lds + 16640;
    LAS unsigned char* zst = (LAS unsigned char*)lds + N2_ZST;
    const int j = l >> 1, nblk = nrows >> 4;
    const f16* Zg = P.Z();
    const f16* Xg = P.X();
    f16x4 xr[2][4]; f16x4 zr[2][4];
    auto prefetch = [&](int blk) {
        const int R0 = blk * 16, rb = R0 + wid * 2;
        if (POOL) {
            int s0, L; if (R0 < NLAT) { s0 = (R0 >> 14) << 14; L = SEQ; } else { s0 = NLAT + (((R0 - NLAT) >> 8) << 8); L = CTXL; }
#pragma unroll
            for (int i = 0; i < 8; ++i) { const int piece = wid * 8 + i; int rr = R0 - 8 + (piece >> 1); rr = rr < s0 ? s0 : (rr > s0 + L - 1 ? s0 + L - 1 : rr);
                __builtin_amdgcn_global_load_lds((const unsigned*)(Zg + (size_t)rr * DM + (piece & 1) * 512 + lane * 8), (LAS unsigned*)(zst + piece * 1024), 16, 0, 0); }
        } else {
#pragma unroll
            for (int u = 0; u < 2; ++u)
#pragma unroll
                for (int q = 0; q < 4; ++q) zr[u][q] = *(const f16x4*)(Zg + (size_t)(rb + u) * DM + q * 256 + lane * 4);
        }
#pragma unroll
        for (int u = 0; u < 2; ++u)
#pragma unroll
            for (int q = 0; q < 4; ++q) xr[u][q] = *(const f16x4*)(Xg + (size_t)(rb + u) * DM + q * 256 + lane * 4);
    };
    int blk = bid;
    if (blk < nblk) prefetch(blk);
    __syncthreads();
    while (blk < nblk) {
        const int R0 = blk * 16, rb = R0 + wid * 2;
        int v, s0, L;
        if (rb < NLAT) { v = rb >> 14; s0 = v << 14; L = SEQ; } else { v = 2; s0 = NLAT + (((rb - NLAT) >> 8) << 8); L = CTXL; }
        const int t = rb - s0;
        if (POOL) asm volatile("s_waitcnt vmcnt(16)" ::: "memory");
        f32x4 g1v[4], gmv[4], shv[4], psv[4];
        { const float* g1 = modp(P, l, v, 2); const float* g = P.norm2_g + l * DM; const float* sh = modp(P, l, v, 3); const float* scl = modp(P, l, v, 4);
#pragma unroll
            for (int q = 0; q < 4; ++q) { const int c0 = q * 256 + lane * 4;
                g1v[q] = *(const f32x4*)(g1 + c0); const f32x4 gv = *(const f32x4*)(g + c0), cv = *(const f32x4*)(scl + c0); shv[q] = *(const f32x4*)(sh + c0); gmv[q] = gv * (1.0f + cv);
                if (POOL) psv[q] = *(const f32x4*)(P.pool_scale + j * DM + c0); } }
        f32x4 y[2][4];
        if (POOL) {
            asm volatile("s_waitcnt lgkmcnt(0)" ::: "memory"); __builtin_amdgcn_s_barrier(); asm volatile("" ::: "memory");
            if (t >= 8 && t + 9 < L) {
#pragma unroll
                for (int q = 0; q < 4; ++q) {
                    const int h = 1 << q;
                    const LAS f16* zb = (const LAS f16*)zst + q * 256 + lane * 4 + (2 * wid + 8) * DM;
#define ZROW(d) (*(const LAS f16x4*)(zb + (d) * DM))
                    const f32x4 z0 = cvt4(ZROW(-h)), z1 = cvt4(ZROW(h)), own0 = cvt4(ZROW(0)), own1 = (h == 1) ? z1 : cvt4(ZROW(1));
                    f32x4 common = (f32x4){0.f, 0.f, 0.f, 0.f};
#pragma unroll
                    for (int d = -h + 1; d + 1 <= h - 1; d += 2) { const f16x4 pr = ZROW(d) + ZROW(d + 1); common += cvt4(pr); }
                    common += cvt4(ZROW(h - 1));
#undef ZROW
                    const float inv = 0.5f / (float)h;
                    y[0][q] = ((common + z0) * inv - own0) * psv[q];
                    y[1][q] = ((common + z1) * inv - own1) * psv[q];
                }
            } else {
#pragma unroll
            for (int q = 0; q < 4; ++q) {
                const int h = 1 << q;
                const LAS f16* zb = (const LAS f16*)zst + q * 256 + lane * 4;
                f32x4 common = (f32x4){0.f, 0.f, 0.f, 0.f}, z0 = common, z1 = common;
#pragma unroll
                for (int d = -h; d <= h; ++d) {
                    const int tt = t + d; const bool ok = tt >= 0 && tt < L;
                    f32x4 zz = cvt4(*(const LAS f16x4*)(zb + (2 * wid + 8 + d) * DM));
                    if (!ok) zz = (f32x4){0.f, 0.f, 0.f, 0.f};
                    if (d == -h) z0 = zz; else if (d == h) z1 = zz; else common += zz;
                    if (d == 0) y[0][q] = zz;
                    if (d == 1) y[1][q] = zz;
                }
                const int c0n = min(t + h, L) - max(t - h, 0), c1n = min(t + 1 + h, L) - max(t + 1 - h, 0);
                y[0][q] = ((common + z0) * (1.0f / (float)c0n) - y[0][q]) * psv[q];
                y[1][q] = ((common + z1) * (1.0f / (float)c1n) - y[1][q]) * psv[q];
            }
            }
            asm volatile("s_waitcnt lgkmcnt(0)" ::: "memory"); __builtin_amdgcn_s_barrier(); asm volatile("" ::: "memory");
        } else {
#pragma unroll
            for (int u = 0; u < 2; ++u)
#pragma unroll
                for (int q = 0; q < 4; ++q) y[u][q] = cvt4(zr[u][q]);
        }
        f32x4 xv[2][4]; float ss[2] = {0.f, 0.f};
#pragma unroll
        for (int q = 0; q < 4; ++q) {
#pragma unroll
            for (int u = 0; u < 2; ++u) { xv[u][q] = cvt4(xr[u][q]) + g1v[q] * y[u][q]; ss[u] += dot4(xv[u][q], xv[u][q]); }
        }
        const int nxt = blk + nb;
        asm volatile("" ::: "memory");
        if (nxt < nblk) prefetch(nxt);
#pragma unroll
        for (int u = 0; u < 2; ++u)
#pragma unroll
            for (int q = 0; q < 4; ++q) *(f16x4*)(P.Xw() + (size_t)(rb + u) * DM + q * 256 + lane * 4) = pk4(xv[u][q]);
        ss[0] = wave_sum(ss[0], lane); ss[1] = wave_sum(ss[1], lane);
        const float rs[2] = {rsqrtf(ss[0] * (1.0f / DM) + 1e-6f), rsqrtf(ss[1] * (1.0f / DM) + 1e-6f)};
        f16x4 h2h[2][4];
#pragma unroll
        for (int q = 0; q < 4; ++q) {
            const int c0 = q * 256 + lane * 4;
#pragma unroll
            for (int u = 0; u < 2; ++u) { h2h[u][q] = pk4(xv[u][q] * rs[u] * gmv[q] + shv[q]); *(f16x4*)(P.Hw() + (size_t)(rb + u) * DM + c0) = rm4(h2h[u][q]); }
        }
        asm volatile("s_waitcnt lgkmcnt(0)" ::: "memory"); __builtin_amdgcn_s_barrier(); asm volatile("" ::: "memory");
#pragma unroll
        for (int q = 0; q < 4; ++q)
#pragma unroll
            for (int u = 0; u < 2; ++u) *(f16x4*)(h2s + (2 * wid + u) * 1032 + q * 256 + lane * 4) = h2h[u][q];
        asm volatile("s_waitcnt lgkmcnt(0)" ::: "memory"); __builtin_amdgcn_s_barrier(); asm volatile("" ::: "memory");
        {
            const int r16 = lane & 15, kq = lane >> 4;
            f32x4 pl = (f32x4){0.f, 0.f, 0.f, 0.f};
#pragma unroll
            for (int ks = 0; ks < 4; ++ks) {
                const f16x8 av = *(const f16x8*)(h2s + r16 * 1032 + wid * 128 + ks * 32 + kq * 8), bv = *(const f16x8*)(wh + r16 * 1032 + wid * 128 + ks * 32 + kq * 8);
                pl = __builtin_amdgcn_mfma_f32_16x16x32_f16(av, bv, pl, 0, 0, 0);
            }
            *(f32x4*)(lds + 16640 + (wid * 64 + lane) * 4) = pl;
            asm volatile("s_waitcnt lgkmcnt(0)" ::: "memory"); __builtin_amdgcn_s_barrier(); asm volatile("" ::: "memory");
        }
        if (wid == 0) {
            const int r16 = lane & 15, kq = lane >> 4;
            f32x4 lg = (f32x4){0.f, 0.f, 0.f, 0.f};
#pragma unroll
            for (int w = 0; w < 8; ++w) lg += *(const f32x4*)(lds + 16640 + (w * 64 + lane) * 4);
#pragma unroll
            for (int jj = 0; jj < 4; ++jj) {
                float mx = lg[jj];
                mx = fmaxf(mx, shx<1>(mx, lane)); mx = fmaxf(mx, shx<2>(mx, lane)); mx = fmaxf(mx, shx<4>(mx, lane)); mx = fmaxf(mx, shx<8>(mx, lane));
                const float pe = __expf(lg[jj] - mx);
                float den = pe;
                den += shx<1>(den, lane); den += shx<2>(den, lane); den += shx<4>(den, lane); den += shx<8>(den, lane);
                P.affw()[(size_t)r16 * MROWS + R0 + 4 * kq + jj] = pe * __builtin_amdgcn_rcpf(den);
            }
        }
        blk = nxt;
    }
}

__device__ __forceinline__ void phase_topk(const Params& P, int bid, int nb, unsigned* lds, int nprob = 64) {
    unsigned* hist = lds; unsigned* misc = lds + 256; unsigned* wsa = lds + 272; unsigned* wsb = lds + 288;
    const int tid = opaque_tid(), wid = tid >> 6, lane = tid & 63;
    for (int p = bid; p < nprob; p += nb) {
        const int set = p >> 4, e = p & 15;
        const int n = set < 2 ? SEQ : CTXL, C = n >> 3;
        const int r0 = set < 2 ? set * SEQ : NLAT + (set - 2) * CTXL;
        const int slot0 = set < 2 ? set * 2048 : 4096 + (set - 2) * 32;
        unsigned key[32];
#pragma unroll
        for (int i4 = 0; i4 < 8; ++i4) { const int idx = tid * 32 + i4 * 4;
            f32x4 v = (f32x4){0.f, 0.f, 0.f, 0.f}; if (idx < n) v = *(const f32x4*)(P.aff() + (size_t)e * MROWS + r0 + idx);
#pragma unroll
            for (int jj = 0; jj < 4; ++jj) key[i4 * 4 + jj] = idx < n ? (__float_as_uint(v[jj]) + 1u) : 0u; }
        unsigned T = 0u;
        for (int bit = 29; bit >= 0; --bit) {
            const unsigned cand = T | (1u << bit);
            unsigned wc = 0u;
#pragma unroll
            for (int i = 0; i < 32; ++i) wc += (unsigned)__builtin_popcountll(__builtin_amdgcn_ballot_w64(key[i] >= cand));
            unsigned* cb = misc + ((bit & 1) << 3);
            if (lane == 0) cb[wid] = wc;
            __syncthreads();
            unsigned tot = 0u;
#pragma unroll
            for (int w = 0; w < 8; ++w) tot += cb[w];
            if (tot >= (unsigned)C) T = cand;
            if (tot == (unsigned)C) { T = cand - 1u; break; }
        }
        unsigned cg = 0u, ce = 0u;
#pragma unroll
        for (int i = 0; i < 32; ++i) { cg += key[i] > T ? 1u : 0u; ce += key[i] == T ? 1u : 0u; }
        unsigned ig = cg, ie = ce;
#pragma unroll
        for (int o = 1; o < 64; o <<= 1) { const unsigned a = shup(ig, o, lane), b = shup(ie, o, lane); if (lane >= o) { ig += a; ie += b; } }
        if (lane == 63) { wsa[wid] = ig; wsb[wid] = ie; }
        __syncthreads();
        unsigned bg = 0u, be = 0u, totg = 0u;
#pragma unroll
        for (int w = 0; w < 8; ++w) { const unsigned ga = wsa[w]; totg += ga; if (w < wid) { bg += ga; be += wsb[w]; } }
        const unsigned krem = (unsigned)C - totg;
        unsigned pg = bg + ig - cg, pe = be + ie - ce;
#pragma unroll
        for (int i4 = 0; i4 < 8; ++i4) {
            int iv[4];
#pragma unroll
            for (int jj = 0; jj < 4; ++jj) {
                const int i = i4 * 4 + jj, idx = tid * 32 + i;
                bool sel = false; unsigned rank = 0u;
                if (key[i] > T) { sel = true; rank = pg + (pe < krem ? pe : krem); ++pg; }
                else if (key[i] == T && key[i] != 0u) { if (pe < krem) { sel = true; rank = pg + pe; } ++pe; }
                if (sel) P.rowidx()[e * SLOTS_PAD + slot0 + (int)rank] = r0 + idx;
                iv[jj] = sel ? slot0 + (int)rank : -1;
            }
            if (tid * 32 + i4 * 4 < n) *(int4*)(P.inv() + (size_t)e * MROWS + r0 + tid * 32 + i4 * 4) = make_int4(iv[0], iv[1], iv[2], iv[3]);
        }
        if (set == 3) for (int i = SLOTS + tid; i < SLOTS_PAD; i += NTHR) P.rowidx()[e * SLOTS_PAD + i] = 0;
        __syncthreads();
    }
}

#define XB_TMO      128
#define XB_XCNT(j)  (256  + 64 * (j))
#define XB_XSUB(j)  (1280 + 64 * (j))
#define XB_XGEN(j)  (2304 + 64 * (j))
#define XB_TOP      3328
#define XB_TOPGEN   3392
#define XCD_BAR_WORDS 3456
#define XB_SPIN_CAP (1u << 18)
__device__ __forceinline__ unsigned xb_ld(unsigned* p)              { return __hip_atomic_load(p, __ATOMIC_RELAXED, __HIP_MEMORY_SCOPE_AGENT); }
__device__ __forceinline__ unsigned xb_add(unsigned* p, unsigned v) { return __hip_atomic_fetch_add(p, v, __ATOMIC_RELAXED, __HIP_MEMORY_SCOPE_AGENT); }
__device__ __forceinline__ unsigned xb_xcc_id() { return (unsigned)__builtin_amdgcn_s_getreg((3 << 11) | 20) & 0xFu; }
#define XB_SPIN(cond, bar) do { unsigned _sp = 0; while (cond) { __builtin_amdgcn_s_sleep(1); \
    if ((++_sp & 255u) == 0u) { if (xb_ld(&(bar)[XB_TMO])) break; if (_sp > XB_SPIN_CAP) { atomicAdd(&(bar)[XB_TMO], 1u); break; } } } } while (0)
struct XcdBarrier { unsigned* bar; unsigned x; volatile LAS unsigned* st; };
__device__ __forceinline__ XcdBarrier xcd_barrier_post(unsigned* bar, volatile LAS unsigned* st) {
    XcdBarrier b; b.bar = bar; b.x = xb_xcc_id(); b.st = st;
    if (threadIdx.x == 0) (void)xb_add(&bar[XB_XCNT(b.x)], 1u);
    return b;
}
__device__ __forceinline__ void xcd_barrier_complete(unsigned* bar, unsigned x, unsigned& nloc, unsigned& nx) {
    const unsigned G = gridDim.x * gridDim.y * gridDim.z;
    unsigned sum, cnt, mine, sp = 0u;
    for (;;) {
        sum = 0u; cnt = 0u; mine = 0u;
#pragma unroll
        for (unsigned j = 0; j < 16; ++j) { const unsigned c = xb_ld(&bar[XB_XCNT(j)]); sum += c; cnt += (c > 0u) ? 1u : 0u; mine = (j == x) ? c : mine; }
        if (sum == G) break;
        __builtin_amdgcn_s_sleep(1);
        if ((++sp & 255u) == 0u) { if (xb_ld(&bar[XB_TMO])) break; if (sp > XB_SPIN_CAP) { atomicAdd(&bar[XB_TMO], 1u); break; } }
    }
    nloc = mine > 0u ? mine : 1u; nx = cnt > 0u ? cnt : 1u;
}
__device__ __forceinline__ void xcd_barrier(const XcdBarrier& b) {
    asm volatile("s_waitcnt vmcnt(0)" ::: "memory");
    __syncthreads();
    if (threadIdx.x == 0) {
        unsigned* bar = b.bar; asm volatile("" : "+s"(bar));
        const unsigned bx = (unsigned)__builtin_amdgcn_readfirstlane((int)xb_xcc_id());
        __builtin_amdgcn_s_waitcnt(0);
        unsigned nloc = b.st[0], nx = b.st[1];
        if (nloc == 0u) { xcd_barrier_complete(bar, bx, nloc, nx); b.st[0] = nloc; b.st[1] = nx; }
        const unsigned old = xb_add(&bar[XB_XSUB(bx)], 1u);
        const unsigned gen = old / nloc;
        if (old + 1u == (gen + 1u) * nloc) {
            __builtin_amdgcn_fence(__ATOMIC_RELEASE, "agent");
            asm volatile("s_waitcnt vmcnt(0)" ::: "memory");
            const unsigned og = xb_add(&bar[XB_TOP], 1u);
            const unsigned tg = og / nx;
            if (og + 1u == (tg + 1u) * nx) xb_add(&bar[XB_TOPGEN], 1u);
            else XB_SPIN(xb_ld(&bar[XB_TOPGEN]) == tg, bar);
            __builtin_amdgcn_fence(__ATOMIC_ACQUIRE, "agent");
            xb_add(&bar[XB_XGEN(bx)], 1u);
            asm volatile("s_waitcnt vmcnt(0)" ::: "memory");
        } else {
            XB_SPIN(xb_ld(&bar[XB_XGEN(bx)]) == gen, bar);
            __builtin_amdgcn_fence(__ATOMIC_ACQUIRE, "agent");
            asm volatile("s_waitcnt vmcnt(0)" ::: "memory");
        }
    }
    __syncthreads();
}

namespace fg {
constexpr int BM = 256, BK = 64, HALF = 128, HTB = HALF * BK * 2, STAGE_BYTES = 8 * HTB;
__device__ __forceinline__ int lds_byte(int r, int c) { const int st = (r >> 4) * 2 + (c >> 5), rr = r & 15, cc = c & 31, ob = rr * 64 + cc * 2; return st * 1024 + (ob ^ (((ob >> 9) & 1) << 5)); }
__device__ __forceinline__ void stage_rc(int b, int& R, int& C) { const int st = b / 1024, sb = b % 1024, swz = sb ^ (((sb >> 9) & 1) << 5); R = (st >> 1) * 16 + swz / 64; C = (st & 1) * 32 + (swz % 64) / 2; }
__device__ __forceinline__ int perm32(int rho) { const int n = rho >> 4, i = rho & 15; return 8 * (i >> 2) + 4 * n + (i & 3); }
#define KDUP 0
struct Unit { int e, pm, pn; int skip; };
__device__ __forceinline__ void xcd_order(int i, int& T) { const int c = blockIdx.x; T = i * (int)gridDim.x + c; }

template <class PR>
__device__ __forceinline__ void gemm_phase(LAS unsigned char* lds, const PR& S, int wv) {
    const int tid = opaque_tid_(wv), wid = __builtin_amdgcn_readfirstlane(tid >> 6), lane = tid & 63, wr = wid >> 2, wc = wid & 3, fr = lane & 15, fq = lane >> 4;
    constexpr int K = PR::K, nt = K / BK;
    unsigned voffB[2];
#pragma unroll
    for (int i = 0; i < 2; ++i) { int R, C; stage_rc(tid * 16 + i * 8192, R, C); const int Rb = (R & ~31) + perm32(R & 31); voffB[i] = (unsigned)(Rb * PR::LDB + C) * 2u; }
    const size_t kstep = (size_t)(BK * 2);
    const size_t hB = S.hstepB();
    const unsigned ldsw = (unsigned)wid * 1024u;
    const int aoff = lds_byte(wr * 64 + fr, fq * 8), boff = lds_byte(wc * 32 + fr, fq * 8);
#define FG_SA(b, h) (((b) * 2 + (h)) * HTB)
#define FG_SB(b, h) ((4 + (b) * 2 + (h)) * HTB)
#define FG_STAGE(bufoff, gbase, voff) do { _Pragma("unroll") for (int _i = 0; _i < 2; ++_i) \
        __builtin_amdgcn_global_load_lds((const unsigned*)((const char*)(gbase) + (voff)[_i]), (LAS unsigned*)(lds + (bufoff) + ldsw + _i * 8192), 16, 0, 0); } while (0)
#define FG_LDA(dst, b, h) do { _Pragma("unroll") for (int m = 0; m < 4; ++m) _Pragma("unroll") for (int k = 0; k < 2; ++k) dst[m][k] = *(const LAS f16x8*)(lds + FG_SA(b, h) + aoff + m * 2048 + k * 1024); } while (0)
#define FG_LDB(dst, b, h) do { _Pragma("unroll") for (int n = 0; n < 2; ++n) _Pragma("unroll") for (int k = 0; k < 2; ++k) dst[n][k] = *(const LAS f16x8*)(lds + FG_SB(b, h) + boff + n * 2048 + k * 1024); } while (0)
#define FG_MMA(ai, bj, At, Bt) do { __builtin_amdgcn_s_setprio(1); _Pragma("unroll") for (int m = 0; m < 4; ++m) _Pragma("unroll") for (int n = 0; n < 2; ++n) _Pragma("unroll") for (int k = 0; k < 2; ++k) \
        acc[ai][bj][m][n] = __builtin_amdgcn_mfma_f32_16x16x32_f16(Bt[n][k], At[m][k], acc[ai][bj][m][n], 0, 0, 0); __builtin_amdgcn_s_setprio(0); } while (0)
#define FG_WAIT_V(n) asm volatile("s_waitcnt vmcnt(" #n ")" ::: "memory")
#define FG_WAIT_L(n) asm volatile("s_waitcnt lgkmcnt(" #n ")" ::: "memory")
#define FG_BAR __builtin_amdgcn_s_barrier()
#define FG_SCHED __builtin_amdgcn_sched_barrier(0)
    Unit cur, nxt; int ui = 0;
    if (!S.next(0, cur)) return;
    f32x4 acc[2][2][4][2];
#pragma unroll
    for (int a = 0; a < 2; ++a)
#pragma unroll
        for (int b = 0; b < 2; ++b)
#pragma unroll
            for (int m = 0; m < 4; ++m)
#pragma unroll
                for (int n = 0; n < 2; ++n) acc[a][b][m][n] = (f32x4){0.f, 0.f, 0.f, 0.f};
    f16x8 At[4][2], B0[2][2], B1[2][2];
    unsigned vA[2][2], vN[2][2];
    { int Rr[2], Cc[2]; stage_rc(tid * 16, Rr[0], Cc[0]); stage_rc(tid * 16 + 8192, Rr[1], Cc[1]); S.a_voff(cur, Rr, Cc, vA); }
#pragma unroll
    for (int h = 0; h < 2; ++h)
#pragma unroll
        for (int i = 0; i < 2; ++i) { asm volatile("" : "+v"(vA[h][i])); vN[h][i] = vA[h][i]; }
    const char* cA = S.a_base(cur); const char* cB = S.b_base(cur);
    FG_STAGE(FG_SB(0, 0), cB, voffB); FG_STAGE(FG_SA(0, 0), cA, vA[0]); FG_STAGE(FG_SB(0, 1), cB + hB, voffB); FG_STAGE(FG_SA(0, 1), cA, vA[1]);
    if (wr == 1) FG_BAR;
    FG_WAIT_V(4); FG_BAR;
    FG_STAGE(FG_SB(1, 0), cB + kstep, voffB); FG_STAGE(FG_SA(1, 0), cA + kstep, vA[0]); FG_STAGE(FG_SB(1, 1), cB + hB + kstep, voffB);
    FG_WAIT_V(6); FG_BAR;
    for (;;) {
        const bool has_next = S.next(ui + 1, nxt);
        const char* nA = has_next ? S.a_base(nxt) : cA; const char* nB = has_next ? S.b_base(nxt) : cB;
        if (has_next) { int Rr[2], Cc[2]; int t2 = tid; asm volatile("" : "+v"(t2)); stage_rc(t2 * 16, Rr[0], Cc[0]); stage_rc(t2 * 16 + 8192, Rr[1], Cc[1]); S.a_voff(nxt, Rr, Cc, vN);
#pragma unroll
            for (int h = 0; h < 2; ++h)
#pragma unroll
                for (int i = 0; i < 2; ++i) asm volatile("" : "+v"(vN[h][i])); }
#pragma unroll 1
        for (int t = 0; t < nt; t += 2) {
            const bool last = (t == nt - 2);
            const char* a1 = cA + (size_t)(t + 1) * kstep;
            const char* a2 = last ? nA : cA + (size_t)(t + 2) * kstep; const char* b2 = last ? nB : cB + (size_t)(t + 2) * kstep;
            const char* a3 = a2 + kstep; const char* b3 = b2 + kstep;
            unsigned v2[2][2];
#pragma unroll
            for (int h = 0; h < 2; ++h)
#pragma unroll
                for (int i = 0; i < 2; ++i) v2[h][i] = last ? vN[h][i] : vA[h][i];
            FG_LDB(B0, 0, 0); FG_SCHED; FG_LDA(At, 0, 0); FG_STAGE(FG_SA(1, 1), a1, vA[1]);
            FG_WAIT_L(8); FG_BAR; FG_WAIT_L(0); FG_MMA(0, 0, At, B0); FG_BAR; FG_SCHED;
            FG_LDB(B1, 0, 1); FG_STAGE(FG_SB(0, 0), b2, voffB);
            FG_BAR; FG_WAIT_L(0); FG_MMA(0, 1, At, B1); FG_BAR;
            FG_LDA(At, 0, 1); FG_STAGE(FG_SA(0, 0), a2, v2[0]);
            FG_BAR; FG_WAIT_L(0); FG_MMA(1, 0, At, B0); FG_BAR; FG_SCHED;
            FG_STAGE(FG_SB(0, 1), b2 + hB, voffB);
            FG_WAIT_V(6); FG_BAR; FG_MMA(1, 1, At, B1); FG_BAR;
            FG_LDB(B0, 1, 0); FG_SCHED; FG_LDA(At, 1, 0); FG_STAGE(FG_SA(0, 1), a2, v2[1]);
            FG_WAIT_L(8); FG_BAR; FG_WAIT_L(0); FG_MMA(0, 0, At, B0); FG_BAR; FG_SCHED;
            FG_LDB(B1, 1, 1); FG_STAGE(FG_SB(1, 0), b3, voffB);
            FG_BAR; FG_WAIT_L(0); FG_MMA(0, 1, At, B1); FG_BAR;
            FG_LDA(At, 1, 1); FG_STAGE(FG_SA(1, 0), a3, v2[0]);
            FG_BAR; FG_WAIT_L(0); FG_MMA(1, 0, At, B0); FG_BAR; FG_SCHED;
            FG_STAGE(FG_SB(1, 1), b3 + hB, voffB);
            FG_WAIT_V(6); FG_BAR; FG_MMA(1, 1, At, B1); FG_BAR;
        }
        if (!KDUP || !cur.skip) S.epi(acc, cur, wr, wc, fr, fq);
        if (!has_next) break;
#pragma unroll
        for (int a = 0; a < 2; ++a)
#pragma unroll
            for (int b = 0; b < 2; ++b)
#pragma unroll
                for (int m = 0; m < 4; ++m)
#pragma unroll
                    for (int n = 0; n < 2; ++n) acc[a][b][m][n] = (f32x4){0.f, 0.f, 0.f, 0.f};
        cur = nxt; cA = nA; cB = nB; ++ui;
#pragma unroll
        for (int h = 0; h < 2; ++h)
#pragma unroll
            for (int i = 0; i < 2; ++i) vA[h][i] = vN[h][i];
    }
    FG_WAIT_V(0);
    if (wr == 0) FG_BAR;
    FG_BAR;
#undef FG_SA
#undef FG_SB
#undef FG_STAGE
#undef FG_LDA
#undef FG_LDB
#undef FG_MMA
#undef FG_WAIT_V
#undef FG_WAIT_L
#undef FG_BAR
#undef FG_SCHED
}

__device__ __forceinline__ f16x8 pack8(const f32x4 a, const f32x4 b) { return (f16x8){(f16)a[0], (f16)a[1], (f16)a[2], (f16)a[3], (f16)b[0], (f16)b[1], (f16)b[2], (f16)b[3]}; }

template <int K_, int LDA_, int LDB_> struct PRBase {
    static constexpr int K = K_, LDA = LDA_, LDB = LDB_;
    __device__ __forceinline__ void plain_voff(const int (&R)[2], const int (&C)[2], unsigned (&v)[2][2]) const {
#pragma unroll
        for (int h = 0; h < 2; ++h)
#pragma unroll
            for (int i = 0; i < 2; ++i) v[h][i] = (unsigned)((h * HALF + R[i]) * LDA + C[i]) * 2u;
    }
};
struct PRGateUp : PRBase<1024, 1024, 1024> {
    const f16* H; const int* rowidx; const f16* W; f16* act; int nunits; int bid; int rt;
    __device__ __forceinline__ size_t hstepB() const { return (size_t)DEXP * DM * 2; }
    __device__ __forceinline__ bool next(int i, Unit& u) const { const int ii = KDUP ? (i >> 1) : i; const int T = ii * (int)gridDim.x + bid; u.skip = KDUP ? ((i & 1) == 0) : 0; if (T >= nunits) return false;
        if (rt == 16 && gridDim.x == 256) { const int x = bid & 7, jj = bid >> 3; u.e = ii; u.pm = (x >> 1) * 4 + (jj >> 3); u.pn = (x & 1) * 8 + (jj & 7); return true; }
        const int per = rt * 16; u.e = T / per; const int t = T % per; u.pm = t >> 4; u.pn = t & 15; return true; }
    __device__ __forceinline__ const char* a_base(const Unit&) const { return (const char*)H; }
    __device__ __forceinline__ void a_voff(const Unit& u, const int (&R)[2], const int (&C)[2], unsigned (&v)[2][2]) const {
        const int* ri = rowidx + u.e * SLOTS_PAD + u.pm * BM;
#pragma unroll
        for (int h = 0; h < 2; ++h)
#pragma unroll
            for (int i = 0; i < 2; ++i) { const int g = ri[h * HALF + R[i]]; v[h][i] = (unsigned)(g * LDA + C[i]) * 2u; }
    }
    __device__ __forceinline__ const char* b_base(const Unit& u) const { return (const char*)(W + ((size_t)u.e * 2 * DEXP + (size_t)u.pn * HALF) * DM); }
    __device__ __forceinline__ void epi(const f32x4 (&acc)[2][2][4][2], const Unit& u, int wr, int wc, int fr, int fq) const {
        f16* base = act + ((size_t)u.e * SLOTS_PAD + (size_t)u.pm * BM + wr * 64 + fr) * DEXP + u.pn * HALF + wc * 32 + fq * 8;
#pragma unroll
        for (int ai = 0; ai < 2; ++ai)
#pragma unroll
            for (int m = 0; m < 4; ++m) {
                f32x4 o0, o1;
#pragma unroll
                for (int j = 0; j < 4; ++j) { o0[j] = silu_f(acc[ai][0][m][0][j]) * acc[ai][1][m][0][j]; o1[j] = silu_f(acc[ai][0][m][1][j]) * acc[ai][1][m][1][j]; }
                if (u.e < 8) __builtin_nontemporal_store(rm8(pack8(o0, o1)), (f16x8*)(base + (size_t)(ai * HALF + m * 16) * DEXP));
                else *(f16x8*)(base + (size_t)(ai * HALF + m * 16) * DEXP) = rm8(pack8(o0, o1));
            }
    }
};
struct PRDown : PRBase<2048, 2048, 2048> {
    const f16* act; const f16* W; f16* y; int nunits; int bid; int rt;
    __device__ __forceinline__ size_t hstepB() const { return (size_t)HALF * DEXP * 2; }
    __device__ __forceinline__ bool next(int i, Unit& u) const { const int ii = KDUP ? (i >> 1) : i; const int T = ii * (int)gridDim.x + bid; u.skip = KDUP ? ((i & 1) == 0) : 0; if (T >= nunits) return false;
        if (rt == 16 && gridDim.x == 256) { const int x = bid & 7, jj = bid >> 3; u.e = 15 - (ii * 4 + (x >> 1)); u.pm = (x & 1) * 8 + (jj >> 2); u.pn = jj & 3; return true; }
        const int per = rt * 4; u.e = T / per; const int t = T % per; u.pm = t >> 2; u.pn = t & 3; return true; }
    __device__ __forceinline__ const char* a_base(const Unit& u) const { return (const char*)(act + ((size_t)u.e * SLOTS_PAD + (size_t)u.pm * BM) * DEXP); }
    __device__ __forceinline__ void a_voff(const Unit&, const int (&R)[2], const int (&C)[2], unsigned (&v)[2][2]) const { plain_voff(R, C, v); }
    __device__ __forceinline__ const char* b_base(const Unit& u) const { return (const char*)(W + ((size_t)u.e * DM + (size_t)u.pn * BM) * DEXP); }
    __device__ __forceinline__ void epi(const f32x4 (&acc)[2][2][4][2], const Unit& u, int wr, int wc, int fr, int fq) const {
        f16* base = y + ((size_t)u.e * SLOTS_PAD + (size_t)u.pm * BM + wr * 64 + fr) * DM + u.pn * BM + wc * 32 + fq * 8;
#pragma unroll
        for (int ai = 0; ai < 2; ++ai)
#pragma unroll
            for (int m = 0; m < 4; ++m)
#pragma unroll
                for (int bj = 0; bj < 2; ++bj) *(f16x8*)(base + (size_t)(ai * HALF + m * 16) * DM + bj * HALF) = pack8(acc[ai][bj][m][0], acc[ai][bj][m][1]);
    }
};
template <int K_> struct PRDense : PRBase<K_, 1024, K_> {
    const f16* A; const f16* W; f16* O0; f16* O1; f16* O2; int ncol; int mode; int bid; int npan; int kvx;
    __device__ __forceinline__ size_t hstepB() const { return (size_t)HALF * K_ * 2; }
    __device__ __forceinline__ bool next(int i, Unit& u) const { const int ii = KDUP ? (i >> 1) : i; int T = ii * (int)gridDim.x + bid; if (gridDim.x == 256) T = (ii * 8 + (bid & 7)) * 32 + (bid >> 3);
        u.skip = KDUP ? ((i & 1) == 0) : 0; const int nu = npan * ncol; if (T >= nu + kvx) return false; u.e = 0; if (T < nu) { u.pm = T / ncol; u.pn = T % ncol; } else { const int x = T - nu; u.pm = npan + (x >> 1); u.pn = 4 + (x & 1); } return true; }
    __device__ __forceinline__ const char* a_base(const Unit& u) const { return (const char*)(A + (size_t)u.pm * BM * 1024 + (mode == 2 ? u.pn * 256 : 0)); }
    __device__ __forceinline__ void a_voff(const Unit&, const int (&R)[2], const int (&C)[2], unsigned (&v)[2][2]) const { this->plain_voff(R, C, v); }
    __device__ __forceinline__ const char* b_base(const Unit& u) const { return (const char*)(W + (size_t)u.pn * BM * K_); }
    const float* qn; const float* kn; const float* rope; LAS float* xs; int lane;
    __device__ __forceinline__ void epi(const f32x4 (&acc)[2][2][4][2], const Unit& u, int wr, int wc, int fr, int fq) const {
        f16* base; int ld;
        const int row = u.pm * BM + wr * 64 + fr, colw = wc * 32 + fq * 8;
        if (mode == 1) { if (u.pn < 4) { base = O0 + (size_t)row * 1024 + u.pn * BM + colw; ld = 1024; } else if (u.pn == 4) { base = O1 + (size_t)row * 256 + colw; ld = 256; } else { base = O2 + (size_t)row * 256 + colw; ld = 256; } }
        else { base = O0 + (size_t)row * 1024 + u.pn * BM + colw; ld = 1024; }
        if (mode == 1 && u.pn < 5) {
            float ssq[2][4][2];
#pragma unroll
            for (int ai = 0; ai < 2; ++ai)
#pragma unroll
                for (int m = 0; m < 4; ++m)
#pragma unroll
                    for (int bj = 0; bj < 2; ++bj) { const f32x4 a = acc[ai][bj][m][0], b = acc[ai][bj][m][1];
                        float t = (a[0] * a[0] + a[1] * a[1]) + (a[2] * a[2] + a[3] * a[3]) + (b[0] * b[0] + b[1] * b[1]) + (b[2] * b[2] + b[3] * b[3]);
                        t += shx<16>(t, lane); t += shx<32>(t, lane); ssq[ai][m][bj] = t; }
            LAS float* mine = xs + ((wr * 4 + wc) * 16) * 16 + fr; const LAS float* theirs = xs + ((wr * 4 + (wc ^ 1)) * 16) * 16 + fr;
            if (fq == 0) {
#pragma unroll
                for (int ai = 0; ai < 2; ++ai)
#pragma unroll
                    for (int m = 0; m < 4; ++m)
#pragma unroll
                        for (int bj = 0; bj < 2; ++bj) mine[(ai * 8 + m * 2 + bj) * 16] = ssq[ai][m][bj];
            }
            asm volatile("s_waitcnt lgkmcnt(0)" ::: "memory"); __builtin_amdgcn_s_barrier(); asm volatile("" ::: "memory");
            const bool isq = u.pn < 4, lat = u.pm < 128;
            const float* nw = (isq ? qn : kn) + (wc & 1) * 32 + fq * 8;
            const f32x4 w0 = *(const f32x4*)nw, w1 = *(const f32x4*)(nw + 4);
            const float qs = isq ? 0.125f * 1.4426950408889634f : 1.0f;
#pragma unroll
            for (int ai = 0; ai < 2; ++ai)
#pragma unroll
                for (int m = 0; m < 4; ++m) {
                    f32x4 c0 = (f32x4){1.f, 1.f, 1.f, 1.f}, s0 = (f32x4){0.f, 0.f, 0.f, 0.f};
                    if (lat) { const int t = (row + ai * HALF + m * 16) & (SEQ - 1); const int pos = (wc & 1) ? (t & 63) : (t >> 6);
                        const float* tb = rope + (size_t)(pos * 16 + fq * 4) * 2; const f32x4 ta = *(const f32x4*)tb, tb2 = *(const f32x4*)(tb + 4);
                        c0 = (f32x4){ta[0], ta[2], tb2[0], tb2[2]}; s0 = (f32x4){ta[1], ta[3], tb2[1], tb2[3]}; }
#pragma unroll
                    for (int bj = 0; bj < 2; ++bj) {
                        const float tot = ssq[ai][m][bj] + theirs[(ai * 8 + m * 2 + bj) * 16];
                        const float rstd = rsqrtf(tot * (1.0f / 64.0f) + 1e-6f) * qs;
                        f32x4 a = acc[ai][bj][m][0] * rstd * w0, b = acc[ai][bj][m][1] * rstd * w1;
                        const f32x4 ra = (f32x4){a[0] * c0[0] - a[1] * s0[0], a[0] * s0[0] + a[1] * c0[0], a[2] * c0[1] - a[3] * s0[1], a[2] * s0[1] + a[3] * c0[1]};
                        const f32x4 rb = (f32x4){b[0] * c0[2] - b[1] * s0[2], b[0] * s0[2] + b[1] * c0[2], b[2] * c0[3] - b[3] * s0[3], b[2] * s0[3] + b[3] * c0[3]};
                        *(f16x8*)(base + (size_t)(ai * HALF + m * 16) * ld + bj * HALF) = rm8(pack8(ra, rb));
                    }
                }
            return;
        }
#pragma unroll
        for (int ai = 0; ai < 2; ++ai)
#pragma unroll
            for (int m = 0; m < 4; ++m)
#pragma unroll
                for (int bj = 0; bj < 2; ++bj) { const f16x8 o = pack8(acc[ai][bj][m][0], acc[ai][bj][m][1]); *(f16x8*)(base + (size_t)(ai * HALF + m * 16) * ld + bj * HALF) = (mode == 1) ? rm8(o) : o; }
    }
};
}

struct CvtJob { const float* src; f16* dst; int K, N, k0, n0; };
__device__ __forceinline__ bool cvt_job(const Params& P, int l, int u, CvtJob& jb, bool experts) {
    const int j = l >> 1;
    const int nexp = experts ? NEXP * 3 * 128 : 0;
    const int nmix = (l & 1) == 0 ? 16 : (96 + 64);
    if (u >= nexp + nmix) return false;
    if (u < nexp) {
        const int e = u / 384, r = u % 384, which = r >> 7, t = r & 127;
        if (which < 2) { jb.src = (which == 0 ? P.w_gate : P.w_up) + ((size_t)l * NEXP + e) * DM * DEXP; jb.dst = P.Wgu() + ((size_t)e * 2 + which) * DEXP * DM; jb.K = DM; jb.N = DEXP; jb.k0 = (t >> 4) * 128; jb.n0 = (t & 15) * 128; }
        else { jb.src = P.w_down + ((size_t)l * NEXP + e) * DEXP * DM; jb.dst = P.Wd() + (size_t)e * DM * DEXP; jb.K = DEXP; jb.N = DM; jb.k0 = (t >> 3) * 128; jb.n0 = (t & 7) * 128; }
    } else {
        const int t = u - nexp;
        if ((l & 1) == 0) { const int g = t >> 2, tt = t & 3; jb.src = P.pool_w + (size_t)(j * 4 + g) * 65536; jb.dst = P.Wmix() + (size_t)g * 65536; jb.K = 256; jb.N = 256; jb.k0 = (tt >> 1) * 128; jb.n0 = (tt & 1) * 128; }
        else if (t < 96) { jb.src = P.w_qkv + (size_t)j * DM * QKVD; jb.dst = P.Wmix(); jb.K = DM; jb.N = QKVD; jb.k0 = (t / 12) * 128; jb.n0 = (t % 12) * 128; }
        else { const int tt = t - 96; jb.src = P.w_o + (size_t)j * DM * DM; jb.dst = P.Wmix() + (size_t)QKVD * DM; jb.K = DM; jb.N = DM; jb.k0 = (tt >> 3) * 128; jb.n0 = (tt & 7) * 128; }
    }
    return true;
}
__device__ __forceinline__ void phase_convert(const Params& P, int l, int bid, int nb, f16* tile, bool experts = true) {
    const int tid = opaque_tid();
    CvtJob jb;
    int u = bid;
    bool have = cvt_job(P, l, u, jb, experts);
    f32x4 r[8];
    if (have) {
#pragma unroll
        for (int p = 0; p < 8; ++p) { const int id = tid + p * NTHR, kr = id >> 5, c4 = (id & 31) * 4; r[p] = __builtin_nontemporal_load((const f32x4*)(jb.src + (size_t)(jb.k0 + kr) * jb.N + jb.n0 + c4)); }
    }
    while (have) {
        __syncthreads();
#pragma unroll
        for (int p = 0; p < 8; ++p) { const int id = tid + p * NTHR, kr = id >> 5, c4 = (id & 31) * 4; *(f16x4*)(tile + kr * 136 + c4) = pk4(r[p]); }
        __syncthreads();
        const CvtJob cur = jb;
        u += nb; have = cvt_job(P, l, u, jb, experts);
        if (have) {
#pragma unroll
            for (int p = 0; p < 8; ++p) { const int id = tid + p * NTHR, kr = id >> 5, c4 = (id & 31) * 4; r[p] = __builtin_nontemporal_load((const f32x4*)(jb.src + (size_t)(jb.k0 + kr) * jb.N + jb.n0 + c4)); }
        }
        const int n = tid & 127, kg = (tid >> 7) * 32;
        f16* dp = cur.dst + (size_t)(cur.n0 + n) * cur.K + cur.k0 + kg;
#pragma unroll
        for (int i = 0; i < 4; ++i) { f16x8 o;
#pragma unroll
            for (int e = 0; e < 8; ++e) o[e] = tile[(kg + i * 8 + e) * 136 + n];
            *(f16x8*)(dp + i * 8) = rmw8(o); }
    }
}
template <bool GATEUP, bool CTX>
__device__ __forceinline__ void phase_cvt_ctx(const Params& P, int l, int bid, int nb, f16* tile, int sel = -1, bool alt = false) {
    const int tid = opaque_tid(), wid = P.wv, lane = tid & 63, r16 = lane & 15, kq = lane >> 4;
    constexpr int NC = GATEUP ? 128 : 64;
    constexpr int KT = GATEUP ? 8 : 16, K = GATEUP ? DM : DEXP, N = GATEUP ? DEXP : DM, NB = N / NC;
    constexpr int NT = GATEUP ? 2 * KT : KT;
    const int sel_ = (GATEUP && !CTX) ? sel : -1; const int ntr = (GATEUP && sel_ < 0) ? NT : KT;
    constexpr int TS = NC + 4, TW = 128 * TS;
    constexpr int NLD = NC / 16;
    constexpr int WPC = 8 / (NC / 16);
    constexpr int NRB = 4 / WPC;
    const int cb = wid % (NC / 16), rb0 = (wid / (NC / 16)) * NRB;
    f16* asl = tile + 2 * TW;
    for (int job = bid; job < NEXP * NB; job += nb) {
        const int e = job / NB, nbk = job % NB;
        const f16* ap[2];
        if (CTX) {
#pragma unroll
            for (int p = 0; p < 2; ++p) { const int row = (tid >> 4) + p * 32;
                if (GATEUP) ap[p] = P.H() + (size_t)P.rowidx()[e * SLOTS_PAD + 4096 + row] * DM + (tid & 15) * 8;
                else ap[p] = P.act() + ((size_t)e * SLOTS_PAD + 4096 + row) * DEXP + (tid & 15) * 8; }
        }
        f32x4 acc[2][NRB];
#pragma unroll
        for (int w = 0; w < 2; ++w)
#pragma unroll
            for (int rb = 0; rb < NRB; ++rb) acc[w][rb] = (f32x4){0.f, 0.f, 0.f, 0.f};
        const float* srcs[2]; f16* dsts[2];
        if (GATEUP) { const size_t wo = ((size_t)l * NEXP + e) * DM * DEXP; srcs[0] = P.w_gate + wo; srcs[1] = P.w_up + wo; dsts[0] = P.Wgu() + (alt ? (OFF_WGU3 - OFF_WGU) / 2 : 0) + ((size_t)e * 2) * DEXP * DM; dsts[1] = dsts[0] + (size_t)DEXP * DM; }
        else { srcs[0] = P.w_down + ((size_t)l * NEXP + e) * DEXP * DM; srcs[1] = srcs[0]; dsts[0] = P.Wd() + (alt ? (OFF_WD3 - OFF_WD) / 2 : 0) + (size_t)e * DM * DEXP; dsts[1] = dsts[0]; }
        f32x4 r[2][NLD]; f16x8 ar[2][2];
        const unsigned ldoff = (unsigned)(((tid / (NC / 4)) * N + (tid % (NC / 4)) * 4) * 4);
#define CV_LOAD(ti, slot) do { const int which_ = GATEUP ? (sel_ >= 0 ? sel_ : ((ti) & 1)) : 0, kt_ = (GATEUP && sel_ < 0) ? ((ti) >> 1) : (ti); const char* sp_ = (const char*)(srcs[which_] + (size_t)(kt_ * 128) * N + nbk * NC); \
            _Pragma("unroll") for (int p = 0; p < NLD; ++p) r[slot][p] = __builtin_nontemporal_load((const f32x4*)(sp_ + (size_t)p * (NTHR / (NC / 4)) * N * 4 + ldoff)); \
            if (CTX) { _Pragma("unroll") for (int p = 0; p < 2; ++p) ar[slot][p] = *(const f16x8*)(ap[p] + kt_ * 128); } } while (0)
#define CV_TILE(ti, slot) do { const int which = GATEUP ? (sel_ >= 0 ? sel_ : ((ti) & 1)) : 0, kt = (GATEUP && sel_ < 0) ? ((ti) >> 1) : (ti); \
            f16* tl = tile + (slot) * TW; f16* al = asl + (slot) * (64 * 128); \
            _Pragma("unroll") for (int p = 0; p < NLD; ++p) { const int id = tid + p * NTHR, kr = id / (NC / 4), c4 = (id % (NC / 4)) * 4; *(f16x4*)(tl + kr * TS + c4) = pk4(r[slot][p]); } \
            if (CTX) { _Pragma("unroll") for (int p = 0; p < 2; ++p) { const int row = (tid >> 4) + p * 32; *(f16x8*)(al + row * 128 + (((tid & 15) ^ (row & 15)) * 8)) = ar[slot][p]; } } \
            if ((ti) + 2 < ntr) CV_LOAD((ti) + 2, slot); \
            asm volatile("s_waitcnt lgkmcnt(0)" ::: "memory"); __builtin_amdgcn_s_barrier(); asm volatile("" ::: "memory"); \
            f16* dp = dsts[which] + (size_t)(nbk * NC + cb * 16 + r16) * K + kt * 128 + kq * 8; \
            _Pragma("unroll") for (int ks = 0; ks < 4; ++ks) { f16x8 bv; \
                _Pragma("unroll") for (int i = 0; i < 8; ++i) bv[i] = tl[(ks * 32 + kq * 8 + i) * TS + cb * 16 + r16]; \
                if (rb0 == 0) *(f16x8*)(dp + ks * 32) = rmw8(bv); \
                if (CTX) { _Pragma("unroll") for (int rb = 0; rb < NRB; ++rb) { const int row = (rb0 + rb) * 16 + r16; const f16x8 af = *(const f16x8*)(al + row * 128 + (((ks * 4 + kq) ^ r16) * 8)); \
                    acc[which][rb] = __builtin_amdgcn_mfma_f32_16x16x32_f16(bv, af, acc[which][rb], 0, 0, 0); } } } } while (0)
        CV_LOAD(0, 0); CV_LOAD(1, 1);
        for (int t2 = 0; t2 < ntr; t2 += 2) { CV_TILE(t2, 0); CV_TILE(t2 + 1, 1); }
#undef CV_LOAD
#undef CV_TILE
        asm volatile("s_waitcnt lgkmcnt(0)" ::: "memory"); __builtin_amdgcn_s_barrier(); asm volatile("" ::: "memory");
        if (CTX) {
#pragma unroll
            for (int rb = 0; rb < NRB; ++rb) {
                const size_t row = (size_t)e * SLOTS_PAD + 4096 + (rb0 + rb) * 16 + r16; const int col = nbk * NC + cb * 16 + 4 * kq;
                if (GATEUP) { f32x4 o;
#pragma unroll
                    for (int jj = 0; jj < 4; ++jj) o[jj] = silu_f(acc[0][rb][jj]) * acc[1][rb][jj];
                    *(f16x4*)(P.act() + row * DEXP + col) = pk4(o); }
                else *(f16x4*)(P.yslot() + row * DM + col) = pk4(acc[0][rb]);
            }
        }
    }
}

__device__ __forceinline__ void cvt3_job(const Params& P, int job, f16* tile) {
    if (job < 256) phase_cvt_ctx<false, false>(P, 3, job, 1 << 20, tile, -1, true);
    else { const int h = job - 256; phase_cvt_ctx<true, false>(P, 3, h >> 1, 1 << 20, tile, h & 1, true); }
}
__device__ __forceinline__ void phase_gateup_fast(const Params& P, LAS unsigned char* lds, int rt = 17, bool alt = false) { fg::PRGateUp S; S.H = P.H(); S.rowidx = P.rowidx(); S.W = P.Wgu() + (alt ? (OFF_WGU3 - OFF_WGU) / 2 : 0); S.act = P.act(); S.rt = rt; S.nunits = 16 * rt * 16; S.bid = opaque_bid(); fg::gemm_phase(lds, S, P.wv); }
__device__ __forceinline__ void phase_down_fast(const Params& P, LAS unsigned char* lds, int rt = 17, bool alt = false) { fg::PRDown S; S.act = P.act(); S.W = P.Wd() + (alt ? (OFF_WD3 - OFF_WD) / 2 : 0); S.y = P.yslot(); S.rt = rt; S.nunits = 16 * rt * 4; S.bid = opaque_bid(); fg::gemm_phase(lds, S, P.wv); }
__device__ __forceinline__ void phase_pool_fast(const Params& P, LAS unsigned char* lds) { fg::PRDense<256> S; S.qn = nullptr; S.kn = nullptr; S.rope = nullptr; S.xs = nullptr; S.lane = 0; S.npan = 130; S.kvx = 0; S.A = P.H(); S.W = P.Wmix(); S.O0 = P.Z(); S.O1 = nullptr; S.O2 = nullptr; S.ncol = 4; S.mode = 2; S.bid = opaque_bid(); fg::gemm_phase(lds, S, P.wv); }
__device__ __forceinline__ void phase_qkv_fast(const Params& P, LAS unsigned char* lds, bool lastl = false, int l = 1) { fg::PRDense<1024> S; S.qn = P.q_norm + (l >> 1) * 64; S.kn = P.k_norm + (l >> 1) * 64; S.rope = P.rope(); S.xs = (LAS float*)(lds + fg::STAGE_BYTES); S.lane = opaque_tid_(P.wv) & 63; S.npan = lastl ? 128 : 130; S.kvx = lastl ? 4 : 0; S.A = P.H(); S.W = P.Wmix(); S.O0 = P.Q(); S.O1 = P.Kb(); S.O2 = P.Vb(); S.ncol = 6; S.mode = 1; S.bid = opaque_bid(); fg::gemm_phase(lds, S, P.wv); }
__device__ __forceinline__ void phase_oproj_fast(const Params& P, LAS unsigned char* lds, bool lastl = false) { fg::PRDense<1024> S; S.qn = nullptr; S.kn = nullptr; S.rope = nullptr; S.xs = nullptr; S.lane = 0; S.npan = lastl ? 128 : 130; S.kvx = 0; S.A = P.O(); S.W = P.Wmix() + (size_t)QKVD * DM; S.O0 = P.Z(); S.O1 = nullptr; S.O2 = nullptr; S.ncol = 4; S.mode = 0; S.bid = opaque_bid(); fg::gemm_phase(lds, S, P.wv); }

typedef float f32x16 __attribute__((ext_vector_type(16)));
#define AT_KB 9216
#define AT_VB 8704
template <int VAR = 0>
__device__ __forceinline__ void phase_attn_fast(const Params& P, int l, LAS unsigned char* lds, bool do_ctx, int cvt_l = -1) {
    const int j = l >> 1;
    const int tid = opaque_tid(), wid = tid >> 6, lane = tid & 63, l32 = lane & 31, hi = lane >> 5;
    const int g = wid >> 1, qoff = (wid & 1) * 64, qoffu = (P.wv & 1) * 64;
    const int nunits = do_ctx ? 1040 : 1024;
    int ucount = 0;
    for (int u = opaque_bid(); u < nunits; u += gridDim.x, ++ucount) {
        int b, qblk, kv, qrow0, t0, t1, s0;
        if (u < 1024) { b = u >> 9; qblk = (u >> 2) & 127; kv = u & 3; s0 = b * SEQ; qrow0 = s0 + qblk * 128; t0 = qblk == 0 ? 2 : 0; t1 = qblk == 127 ? 4 : 6; }
        else { const int uu = u - 1024; b = uu >> 3; qblk = (uu >> 2) & 1; kv = uu & 3; s0 = NLAT + b * CTXL; qrow0 = s0 + qblk * 128; t0 = 0; t1 = 0; }
        const int cb = NLAT + b * CTXL, nloc = t1 - t0, ntiles = nloc + 4;
        const int h = kv * 4 + g;
        f16x8 Qf[2][4];
#pragma unroll
        for (int qb = 0; qb < 2; ++qb)
#pragma unroll
            for (int ks = 0; ks < 4; ++ks) Qf[qb][ks] = *(const f16x8*)(P.Q() + (size_t)(qrow0 + qoff + 32 * qb + l32) * 1024 + h * 64 + 16 * ks + 8 * hi);
        f32x16 OT[2][2];
#pragma unroll
        for (int db = 0; db < 2; ++db)
#pragma unroll
            for (int qb = 0; qb < 2; ++qb)
#pragma unroll
                for (int r = 0; r < 16; ++r) OT[db][qb][r] = 0.f;
        float mrun[2], lrun[2];
        { const float sk = P.sink[j * 16 + h] * 1.4426950408889634f; mrun[0] = sk; mrun[1] = sk; lrun[0] = hi == 0 ? 1.0f : 0.0f; lrun[1] = lrun[0]; }
        const int lkey = tid >> 3, lpc = tid & 7;
        f16x8 kreg, vreg;
        auto tile_row = [&](int it) -> int { return it < nloc ? (qrow0 - 128 + 64 * (t0 + it)) : (cb + 64 * (it - nloc)); };
        { const int kr = tile_row(0) + lkey; kreg = *(const f16x8*)(P.Kb() + (size_t)kr * 256 + kv * 64 + lpc * 8); vreg = *(const f16x8*)(P.Vb() + (size_t)kr * 256 + kv * 64 + lpc * 8); }
        __syncthreads();
        {
            LAS f16* Kl = (LAS f16*)(lds); LAS f16* Vl = (LAS f16*)(lds + 2 * AT_KB);
            *(LAS f16x8*)(Kl + lkey * 72 + lpc * 8) = kreg;
#pragma unroll
            for (int i = 0; i < 8; ++i) Vl[(lpc * 8 + i) * 68 + lkey] = vreg[i];
        }
        __syncthreads();
        for (int it = 0; it < ntiles; ++it) {
            const int buf = it & 1;
            if (it + 1 < ntiles) { const int kr = tile_row(it + 1) + lkey; kreg = *(const f16x8*)(P.Kb() + (size_t)kr * 256 + kv * 64 + lpc * 8); vreg = *(const f16x8*)(P.Vb() + (size_t)kr * 256 + kv * 64 + lpc * 8); }
            const LAS f16* Kl = (const LAS f16*)(lds + buf * AT_KB); const LAS f16* Vl = (const LAS f16*)(lds + 2 * AT_KB + buf * AT_VB);
            int cls = 0;
            if (it < nloc) { const int tl = t0 + it, dmin = qoffu + 65 - 64 * tl, dmax = qoffu + 191 - 64 * tl; cls = (dmin > 128 || dmax < -128) ? 2 : ((dmin >= -128 && dmax <= 128) ? 0 : 1); }
            if (cls != 2) {
            f32x16 S[2][2];
#pragma unroll
            for (int kb = 0; kb < 2; ++kb)
#pragma unroll
                for (int qb = 0; qb < 2; ++qb)
#pragma unroll
                    for (int r = 0; r < 16; ++r) S[kb][qb][r] = -mrun[qb];
#pragma unroll
            for (int ks = 0; ks < 4; ++ks)
#pragma unroll
                for (int kb = 0; kb < 2; ++kb) {
                    const f16x8 kf = *(const LAS f16x8*)(Kl + (32 * kb + l32) * 72 + 16 * ks + 8 * hi);
#pragma unroll
                    for (int qb = 0; qb < 2; ++qb) S[kb][qb] = __builtin_amdgcn_mfma_f32_32x32x16_f16(kf, Qf[qb][ks], S[kb][qb], 0, 0, 0);
                }
            if (cls == 1) {
                const int kt = 64 * (t0 + it);
#pragma unroll
                for (int qb = 0; qb < 2; ++qb) {
                    const int qp = 128 + qoff + 32 * qb + l32;
#pragma unroll
                    for (int kb = 0; kb < 2; ++kb)
#pragma unroll
                        for (int r = 0; r < 16; ++r) { const int kp = kt + 32 * kb + 8 * (r >> 2) + 4 * hi + (r & 3); const int d = qp - kp; if (d > 128 || d < -128) S[kb][qb][r] = -INFINITY; }
                }
            }
            f16x8 Pf[2][4];
#pragma unroll
            for (int qb = 0; qb < 2; ++qb) {
                float mx = S[0][qb][0];
#pragma unroll
                for (int kb = 0; kb < 2; ++kb)
#pragma unroll
                    for (int r = 0; r < 16; ++r) mx = fmaxf(mx, S[kb][qb][r]);
                { const auto sw = __builtin_amdgcn_permlane32_swap(__float_as_uint(mx), __float_as_uint(mx), false, false); mx = fmaxf(__uint_as_float(sw[0]), __uint_as_float(sw[1])); }
                if (__builtin_amdgcn_ballot_w64(mx > 8.0f) != 0ull) {
                    const float g = fmaxf(mx, 0.f), corr = __builtin_amdgcn_exp2f(-g);
                    mrun[qb] += g; lrun[qb] *= corr;
#pragma unroll
                    for (int kb = 0; kb < 2; ++kb)
#pragma unroll
                        for (int r = 0; r < 16; ++r) S[kb][qb][r] -= g;
#pragma unroll
                    for (int db = 0; db < 2; ++db)
#pragma unroll
                        for (int r = 0; r < 16; ++r) OT[db][qb][r] *= corr;
                }
                float ps = 0.f;
#pragma unroll
                for (int kb = 0; kb < 2; ++kb)
#pragma unroll
                    for (int r = 0; r < 16; ++r) { const float p = __builtin_amdgcn_exp2f(S[kb][qb][r]); S[kb][qb][r] = p; ps += p; }
                lrun[qb] += ps;
#pragma unroll
                for (int ks = 0; ks < 4; ++ks) { const int kb = ks >> 1, r0 = 8 * (ks & 1);
#pragma unroll
                    for (int e = 0; e < 8; ++e) Pf[qb][ks][e] = (f16)S[kb][qb][r0 + e]; }
            }
#pragma unroll
            for (int ks = 0; ks < 4; ++ks)
#pragma unroll
                for (int db = 0; db < 2; ++db) {
                    const LAS f16* vp = Vl + (32 * db + l32) * 68 + 16 * ks + 4 * hi;
                    const f16x4 v0 = *(const LAS f16x4*)vp, v1 = *(const LAS f16x4*)(vp + 8);
                    const f16x8 vf = (f16x8){v0[0], v0[1], v0[2], v0[3], v1[0], v1[1], v1[2], v1[3]};
#pragma unroll
                    for (int qb = 0; qb < 2; ++qb) OT[db][qb] = __builtin_amdgcn_mfma_f32_32x32x16_f16(vf, Pf[qb][ks], OT[db][qb], 0, 0, 0);
                }
            }
            if (it + 1 < ntiles) {
                LAS f16* Kw = (LAS f16*)(lds + (buf ^ 1) * AT_KB); LAS f16* Vw = (LAS f16*)(lds + 2 * AT_KB + (buf ^ 1) * AT_VB);
                *(LAS f16x8*)(Kw + lkey * 72 + lpc * 8) = kreg;
#pragma unroll
                for (int i = 0; i < 8; ++i) Vw[(lpc * 8 + i) * 68 + lkey] = vreg[i];
            }
            __syncthreads();
        }
#pragma unroll
        for (int qb = 0; qb < 2; ++qb) {
            const float lt = lrun[qb] + shx<32>(lrun[qb], lane);
            const float inv = 1.0f / lt;
            f16* op = P.O() + (size_t)(qrow0 + qoff + 32 * qb + l32) * 1024 + h * 64;
#pragma unroll
            for (int db = 0; db < 2; ++db)
#pragma unroll
                for (int i = 0; i < 4; ++i) {
                    const f16x4 o = (f16x4){(f16)(OT[db][qb][4 * i] * inv), (f16)(OT[db][qb][4 * i + 1] * inv), (f16)(OT[db][qb][4 * i + 2] * inv), (f16)(OT[db][qb][4 * i + 3] * inv)};
                    *(f16x4*)(op + 32 * db + 8 * i + 4 * hi) = rm4(o);
                }
        }
    }
}

#define MEGA_LDS (147456 + 16)
__device__ __forceinline__ const Params& opq(Params& q) { int z; asm volatile("s_mov_b32 %0, 0" : "=s"(z)); q.zoff = z; return q; }
__global__ __launch_bounds__(NTHR, 2) void mega(Params P) {
    extern __shared__ __attribute__((aligned(16))) unsigned char shm[];
    LAS unsigned char* lds = (LAS unsigned char*)shm;
    volatile LAS unsigned* st = (volatile LAS unsigned*)(lds + 147456);
    if (threadIdx.x == 0) { st[0] = 0u; st[1] = 0u; st[2] = 0u; st[3] = 0u; }
    __syncthreads();
    const XcdBarrier bar = xcd_barrier_post(P.bar(), st);
    const int nb = gridDim.x;
#define bid (opaque_bid())
    Params Q = P; Q.wv = __builtin_amdgcn_readfirstlane(threadIdx.x >> 6);
#define P (opq(Q))
    phase_ada(P, bid, nb, (float*)shm);
    __syncthreads();
    phase_convert(P, 0, bid, nb, (f16*)shm, false);
    xcd_barrier(bar);
    for (int l = 0; l < 4; ++l) {
        if (l == 0) phase_n1<true, false>(P, l, bid, nb); else { phase_n1<false, false>(P, l, bid, nb); __syncthreads(); phase_convert(P, l, bid, nb, (f16*)shm, false);
            }
        xcd_barrier(bar);
        if ((l & 1) == 0) {
            phase_pool_fast(P, lds);
            xcd_barrier(bar);
            phase_n2<true>(P, l, bid, nb, (float*)shm);
        } else {
            phase_qkv_fast(P, lds, l == 3, l);
            if (nb == 256 && (bid & 7) >= 2) { __syncthreads(); cvt3_job(P, (l == 1 ? 192 : 576) + ((bid & 7) - 2) * 32 + (bid >> 3), (f16*)shm); }
            xcd_barrier(bar);
            phase_attn_fast(P, l, lds, l != 3);
            if (l == 3 && nb != 256) { __syncthreads(); phase_cvt_ctx<true, false>(P, l, bid, nb, (f16*)shm, -1, true); phase_cvt_ctx<false, false>(P, l, bid, nb, (f16*)shm, -1, true); }
            xcd_barrier(bar);
            phase_oproj_fast(P, lds, l == 3);
            if (l == 1 && nb == 256 && (bid & 7) >= 2) { __syncthreads(); cvt3_job(P, 384 + ((bid & 7) - 2) * 32 + (bid >> 3), (f16*)shm); }
            xcd_barrier(bar);
            phase_n2<false>(P, l, bid, nb, (float*)shm, l == 3 ? NLAT : MROWS);
        }
        xcd_barrier(bar);
        phase_topk(P, bid, nb, (unsigned*)shm, l == 3 ? 32 : 64);
        if (l < 3 && nb == 256 && bid >= 64 && bid < 128) cvt3_job(P, l * 64 + bid - 64, (f16*)shm);
        xcd_barrier(bar);
        if (l < 3) { phase_cvt_ctx<true, true>(P, l, bid, nb, (f16*)shm); xcd_barrier(bar); }
        phase_gateup_fast(P, lds, 16, l == 3);
        if (l < 3) { __syncthreads(); phase_cvt_ctx<false, true>(P, l, bid, nb, (f16*)shm); }
        xcd_barrier(bar);
        phase_down_fast(P, lds, 16, l == 3);
        xcd_barrier(bar);
    }
    phase_n1<false, true>(P, 4, bid, nb);
#undef P
#undef bid
}

static inline size_t al256(size_t v) { return (v + 255) & ~(size_t)255; }

extern "C" void kernel_launch(void* const* d_in, const int* in_sizes, int n_in, void* d_out, int out_size, void* d_ws, size_t ws_size, hipStream_t stream) {
    Params P{};
    P.x = (const float*)d_in[0]; P.c = (const float*)d_in[1]; P.ctx = (const float*)d_in[2]; P.c_ctx = (const float*)d_in[3];
    P.w_ada = (const float*)d_in[4]; P.b_ada = (const float*)d_in[5]; P.norm1_g = (const float*)d_in[6]; P.norm2_g = (const float*)d_in[7];
    P.pool_w = (const float*)d_in[8]; P.pool_scale = (const float*)d_in[9]; P.w_qkv = (const float*)d_in[10]; P.w_o = (const float*)d_in[11];
    P.q_norm = (const float*)d_in[12]; P.k_norm = (const float*)d_in[13]; P.sink = (const float*)d_in[14]; P.router_w = (const float*)d_in[15];
    P.w_gate = (const float*)d_in[16]; P.w_up = (const float*)d_in[17]; P.w_down = (const float*)d_in[18];
    P.out = (float*)d_out;
    P.ws = (char*)d_ws; const size_t off = WS_TOTAL;
    if (off > ws_size) { fprintf(stderr, "workspace too small: need %zu have %zu\n", off, ws_size); return; }
    static int grid = 0;
    if (!grid) {
        int dev = 0, cus = 0, per_cu = 0;
        hipGetDevice(&dev);
        hipDeviceGetAttribute(&cus, hipDeviceAttributeMultiprocessorCount, dev);
        hipFuncSetAttribute((const void*)mega, hipFuncAttributeMaxDynamicSharedMemorySize, MEGA_LDS);
        hipOccupancyMaxActiveBlocksPerMultiprocessor(&per_cu, (const void*)mega, NTHR, MEGA_LDS);
        if (per_cu < 1) { fprintf(stderr, "mega: occupancy query says %d blocks per CU\n", per_cu); }
        grid = cus > 0 ? cus : 256;
    }
    hipMemsetAsync(P.bar(), 0, XCD_BAR_WORDS * sizeof(unsigned), stream);
    hipLaunchKernelGGL(mega, dim3(grid), dim3(NTHR), MEGA_LDS, stream, P);
}
```

```cpp
#include <hip/hip_runtime.h>
#include <stdint.h>
#include <stdio.h>

typedef _Float16 f16;
typedef _Float16 f16x2 __attribute__((ext_vector_type(2)));
typedef _Float16 f16x4 __attribute__((ext_vector_type(4)));
typedef _Float16 f16x8 __attribute__((ext_vector_type(8)));
typedef float f32x4 __attribute__((ext_vector_type(4)));
typedef float f32x2 __attribute__((ext_vector_type(2)));
typedef unsigned u32x2 __attribute__((ext_vector_type(2)));
typedef unsigned u32x4 __attribute__((ext_vector_type(4)));
#define RM_BITS 5
#define RM_ADD (0x00010001u << (RM_BITS - 1))
#define RM_MASK (~(0x00010001u * ((1u << RM_BITS) - 1u)))
__device__ __forceinline__ f16x4 rm4(f16x4 v) { u32x2 b = __builtin_bit_cast(u32x2, v); b = (b + RM_ADD) & RM_MASK; return __builtin_bit_cast(f16x4, b); }
__device__ __forceinline__ f16x8 rm8(f16x8 v) { u32x4 b = __builtin_bit_cast(u32x4, v); b = (b + RM_ADD) & RM_MASK; return __builtin_bit_cast(f16x8, b); }
#define RMW_BITS 5
__device__ __forceinline__ f16x8 rmw8(f16x8 v) { u32x4 b = __builtin_bit_cast(u32x4, v); b = (b + (0x00010001u << (RMW_BITS - 1))) & ~(0x00010001u * ((1u << RMW_BITS) - 1u)); return __builtin_bit_cast(f16x8, b); }

#define LAS __attribute__((address_space(3)))
#define DM 1024
#define SEQ 16384
#define NLAT 32768
#define CTXL 256
#define NCTX 512
#define MROWS 33280
#define NEXP 16
#define DEXP 2048
#define SLOTS 4160
#define SLOTS_PAD 4352
#define QKVD 1536
#define NTHR 512

constexpr size_t al256c(size_t v) { return (v + 255) & ~(size_t)255; }
constexpr size_t OFF_BAR = 0;
constexpr size_t OFF_MOD = al256c(OFF_BAR + 16384);
constexpr size_t OFF_ROPE = al256c(OFF_MOD + (size_t)4 * 3 * 6 * DM * 4);
constexpr size_t OFF_X = al256c(OFF_ROPE + (size_t)256 * 16 * 2 * 4);
constexpr size_t OFF_H = al256c(OFF_X + (size_t)MROWS * DM * 4);
constexpr size_t OFF_Z = al256c(OFF_H + (size_t)MROWS * DM * 2);
constexpr size_t OFF_Q = al256c(OFF_Z + (size_t)MROWS * DM * 2);
constexpr size_t OFF_KB = al256c(OFF_Q + (size_t)MROWS * DM * 2);
constexpr size_t OFF_VB = al256c(OFF_KB + (size_t)MROWS * 256 * 2);
constexpr size_t OFF_VT = al256c(OFF_VB + (size_t)MROWS * 256 * 2);
constexpr size_t OFF_O = al256c(OFF_VT + (size_t)MROWS * 256 * 2);
constexpr size_t OFF_AFF = al256c(OFF_O + (size_t)MROWS * DM * 2);
constexpr size_t OFF_INV = al256c(OFF_AFF + (size_t)MROWS * 16 * 4);
constexpr size_t OFF_ROWIDX = al256c(OFF_INV + (size_t)MROWS * 16 * 4);
constexpr size_t OFF_ACT = al256c(OFF_ROWIDX + (size_t)NEXP * SLOTS_PAD * 4);
constexpr size_t OFF_YSLOT = al256c(OFF_ACT + (size_t)NEXP * SLOTS_PAD * DEXP * 2);
constexpr size_t OFF_WGU = al256c(OFF_YSLOT + (size_t)NEXP * SLOTS_PAD * DM * 2);
constexpr size_t OFF_WD = al256c(OFF_WGU + (size_t)NEXP * 2 * DEXP * DM * 2);
constexpr size_t OFF_WMIX = al256c(OFF_WD + (size_t)NEXP * DM * DEXP * 2);
constexpr size_t OFF_WGU3 = al256c(OFF_WMIX + (size_t)(QKVD + DM) * DM * 2);
constexpr size_t OFF_WD3 = al256c(OFF_WGU3 + (size_t)NEXP * 2 * DEXP * DM * 2);
constexpr size_t OFF_DUMMY = al256c(OFF_WD3 + (size_t)NEXP * DM * DEXP * 2);
constexpr size_t WS_TOTAL = OFF_DUMMY;
struct Params {
    const float *x, *c, *ctx, *c_ctx, *w_ada, *b_ada, *norm1_g, *norm2_g, *pool_w, *pool_scale, *w_qkv, *w_o, *q_norm, *k_norm, *sink, *router_w, *w_gate, *w_up, *w_down;
    float* out; char* ws; int wv; int zoff;
#define WSF(name, type, off) __host__ __device__ __forceinline__ type* name() const { return (type*)(ws + zoff + (off)); }
    WSF(bar, unsigned, OFF_BAR) WSF(mod, float, OFF_MOD) WSF(rope, float, OFF_ROPE) WSF(X, f16, OFF_X) WSF(H, f16, OFF_H) WSF(Z, f16, OFF_Z) WSF(Q, f16, OFF_Q) WSF(Kb, f16, OFF_KB) WSF(Vb, f16, OFF_VB) WSF(Vt, f16, OFF_VT)
    WSF(O, f16, OFF_O) WSF(aff, float, OFF_AFF) WSF(inv, int, OFF_INV) WSF(rowidx, int, OFF_ROWIDX) WSF(act, f16, OFF_ACT) WSF(yslot, f16, OFF_YSLOT) WSF(Wgu, f16, OFF_WGU) WSF(Wd, f16, OFF_WD) WSF(Wmix, f16, OFF_WMIX)
#undef WSF
#define WSW(name, type, off) __host__ __device__ __forceinline__ type* name() const { return (type*)(ws + zoff + (off)); }
    WSW(Xw, f16, OFF_X) WSW(Ow, f16, OFF_O) WSW(Hw, f16, OFF_H) WSW(affw, float, OFF_AFF) WSW(Qw, f16, OFF_Q) WSW(Kw, f16, OFF_KB)
#undef WSW
};

template <int O> __device__ __forceinline__ float shx(float v, int lane) {
    if (O == 1) return __int_as_float(__builtin_amdgcn_update_dpp(0, __float_as_int(v), 0xB1, 0xF, 0xF, true));
    if (O == 2) return __int_as_float(__builtin_amdgcn_update_dpp(0, __float_as_int(v), 0x4E, 0xF, 0xF, true));
    if (O < 32) return __int_as_float(__builtin_amdgcn_ds_swizzle(__float_as_int(v), (O << 10) | 0x1f));
    return __int_as_float(__builtin_amdgcn_ds_bpermute((lane ^ O) << 2, __float_as_int(v)));
}
__device__ __forceinline__ float wave_sum(float v, int lane) {
    v += shx<1>(v, lane); v += shx<2>(v, lane); v += shx<4>(v, lane); v += shx<8>(v, lane); v += shx<16>(v, lane); v += shx<32>(v, lane);
    return v;
}
__device__ __forceinline__ unsigned shup(unsigned v, int o, int lane) { return (unsigned)__builtin_amdgcn_ds_bpermute((lane - o) << 2, (int)v); }
__device__ __forceinline__ int opaque_bid() { int b = blockIdx.x; asm volatile("" : "+s"(b)); return b; }
#define opaque_tid() opaque_tid_(P.wv)
__device__ __forceinline__ int opaque_tid_(int wv) { int ln; asm volatile("v_mbcnt_lo_u32_b32 %0, -1, 0\n\tv_mbcnt_hi_u32_b32 %0, -1, %0" : "=v"(ln)); return (wv << 6) | ln; }
__device__ __forceinline__ float silu_f(float v) { return v * __builtin_amdgcn_rcpf(1.0f + __expf(-v)); }

__device__ __forceinline__ const float* modp(const Params& P, int l, int v, int j) { return P.mod() + (size_t)((l * 3 + v) * 6 + j) * DM; }

__device__ __forceinline__ void phase_ada(const Params& P, int bid, int nb, float* lds) {
    float* sc = lds; float* red = lds + 3 * DM;
    const int tid = opaque_tid();
    for (int i = tid; i < 3 * DM; i += NTHR) { const int v = i >> 10, k = i & 1023; const float cv = v < 2 ? P.c[v * DM + k] : P.c_ctx[k]; sc[i] = silu_f(cv); }
    __syncthreads();
    for (int u = bid; u < 4 * 96; u += nb) {
        const int l = u / 96, ch = u % 96, c4 = tid & 15, kg = tid >> 4;
        const float* w = P.w_ada + (size_t)l * DM * 6 * DM + ch * 64 + c4 * 4;
        f32x4 s0 = (f32x4){0.f, 0.f, 0.f, 0.f}, s1 = s0, s2 = s0;
#pragma unroll 8
        for (int i = 0; i < 32; ++i) { const int k = kg * 32 + i; const f32x4 wv = __builtin_nontemporal_load((const f32x4*)(w + (size_t)k * 6 * DM)); s0 += sc[k] * wv; s1 += sc[DM + k] * wv; s2 += sc[2 * DM + k] * wv; }
        *(f32x4*)(red + (kg * 3 + 0) * 64 + c4 * 4) = s0; *(f32x4*)(red + (kg * 3 + 1) * 64 + c4 * 4) = s1; *(f32x4*)(red + (kg * 3 + 2) * 64 + c4 * 4) = s2;
        __syncthreads();
        if (tid < 192) { const int v = tid >> 6, cc = tid & 63; float s = 0.f;
#pragma unroll
            for (int q = 0; q < 32; ++q) s += red[(q * 3 + v) * 64 + cc];
            const int colg = ch * 64 + cc; s += P.b_ada[l * 6 * DM + colg];
            const int j = colg >> 10, d = colg & 1023;
            P.mod()[(size_t)((l * 3 + v) * 6 + j) * DM + d] = s; }
        __syncthreads();
    }
    for (int i = bid * NTHR + tid; i < 256 * 16; i += nb * NTHR) {
        const int p = i >> 4, f = i & 15;
        const float inv = powf(10000.0f, -(float)f / 16.0f);
        const float angf = (float)p * inv;
        double a = (double)angf;
        const double twopi = 6.283185307179586476925286766559;
        a -= twopi * rint(a / twopi);
        const double a2 = a * a;
        double cs = 1.0, sn = 1.0;
        double tc = 0.0, ts = 0.0;
        for (int n = 16; n >= 1; --n) { tc = (tc + 1.0) * (-a2 / (double)((2 * n - 1) * (2 * n))); ts = (ts + 1.0) * (-a2 / (double)((2 * n) * (2 * n + 1))); }
        cs = 1.0 + tc; sn = a * (1.0 + ts);
        P.rope()[i * 2] = (float)cs; P.rope()[i * 2 + 1] = (float)sn;
    }
}

__device__ __forceinline__ f32x4 cvt4(const f16x4 v) { return (f32x4){(float)v[0], (float)v[1], (float)v[2], (float)v[3]}; }
__device__ __forceinline__ f16x4 pk4(const f32x4 v) { return (f16x4){(f16)v[0], (f16)v[1], (f16)v[2], (f16)v[3]}; }
__device__ __forceinline__ float dot4(const f32x4 a, const f32x4 b) { return a[0] * b[0] + a[1] * b[1] + a[2] * b[2] + a[3] * b[3]; }
template <bool FIRST, bool FINAL>
__device__ __forceinline__ void phase_n1(const Params& P, int l, int bid, int nb) {
    constexpr int R = 4;
    const int tid_ = opaque_tid(); const int wid = P.wv, lane = tid_ & 63;
    const int nrows = FINAL ? NLAT : MROWS;
    for (int rb = (bid * 8 + wid) * R; rb < nrows; rb += nb * 8 * R) {
        const int v = rb < NLAT ? (rb >> 14) : 2;
        f32x4 xv[R][4];
#pragma unroll
        for (int u = 0; u < R; ++u) {
            const int r = rb + u;
            if (FIRST) { const float* src = r < NLAT ? P.x + (size_t)r * DM : P.ctx + (size_t)(r - NLAT) * DM;
#pragma unroll
                for (int q = 0; q < 4; ++q) xv[u][q] = __builtin_nontemporal_load((const f32x4*)(src + q * 256 + lane * 4)); }
            else { const f16* src = P.X() + (size_t)r * DM;
#pragma unroll
                for (int q = 0; q < 4; ++q) xv[u][q] = cvt4(*(const f16x4*)(src + q * 256 + lane * 4)); }
        }
        if (!FIRST) {
            const int sl = P.inv()[(size_t)(lane & 15) * MROWS + rb + (lane >> 4)];
            const float af = P.aff()[(size_t)(lane & 15) * MROWS + rb + (lane >> 4)];
            const unsigned long long bal = __builtin_amdgcn_ballot_w64(sl >= 0);
            unsigned m[R];
#pragma unroll
            for (int u = 0; u < R; ++u) m[u] = (unsigned)(bal >> (16 * u)) & 0xffffu;
            const f16* ys = P.yslot();
            const float* g2 = modp(P, l - 1, v, 5);
            f32x4 gv[4];
#pragma unroll
            for (int q = 0; q < 4; ++q) gv[q] = *(const f32x4*)(g2 + q * 256 + lane * 4);
            while (m[0] | m[1] | m[2] | m[3]) {
                f16x4 yv[R][4]; float w[R];
#pragma unroll
                for (int u = 0; u < R; ++u) {
                    const int e = m[u] ? __builtin_ctz(m[u]) : 0;
                    const int sv = m[u] ? __builtin_amdgcn_readlane(sl, 16 * u + e) : 0;
                    w[u] = m[u] ? __int_as_float(__builtin_amdgcn_readlane(__float_as_int(af), 16 * u + e)) : 0.f;
                    m[u] &= m[u] - 1u;
                    const f16* y = ys + ((size_t)e * SLOTS_PAD + sv) * DM + lane * 4;
#pragma unroll
                    for (int q = 0; q < 4; ++q) yv[u][q] = *(const f16x4*)(y + q * 256);
                }
#pragma unroll
                for (int u = 0; u < R; ++u)
#pragma unroll
                    for (int q = 0; q < 4; ++q) xv[u][q] += (w[u] * gv[q]) * cvt4(yv[u][q]);
            }
        }
        if (FINAL) {
#pragma unroll
            for (int u = 0; u < R; ++u)
#pragma unroll
                for (int q = 0; q < 4; ++q) __builtin_nontemporal_store(xv[u][q], (f32x4*)(P.out + (size_t)(rb + u) * DM + q * 256 + lane * 4));
            continue;
        }
        float ss[R];
#pragma unroll
        for (int u = 0; u < R; ++u) {
            f16* xd = P.Xw() + (size_t)(rb + u) * DM; float sacc = 0.f;
#pragma unroll
            for (int q = 0; q < 4; ++q) { *(f16x4*)(xd + q * 256 + lane * 4) = pk4(xv[u][q]); sacc += dot4(xv[u][q], xv[u][q]); }
            ss[u] = sacc;
        }
#pragma unroll
        for (int u = 0; u < R; ++u) ss[u] = rsqrtf(wave_sum(ss[u], lane) * (1.0f / DM) + 1e-6f);
        const float* g = P.norm1_g + l * DM; const float* sh = modp(P, l, v, 0); const float* scl = modp(P, l, v, 1);
#pragma unroll
        for (int q = 0; q < 4; ++q) {
            const int c0 = q * 256 + lane * 4;
            const f32x4 gq = *(const f32x4*)(g + c0), sq = *(const f32x4*)(sh + c0), cq = *(const f32x4*)(scl + c0);
            const f32x4 gm = gq * (1.0f + cq);
#pragma unroll
            for (int u = 0; u < R; ++u) *(f16x4*)(P.Hw() + (size_t)(rb + u) * DM + c0) = rm4(pk4(xv[u][q] * ss[u] * gm + sq));
        }
    }
}

#define N2_ZST 81920
template <bool POOL>
__device__ __forceinline__ void phase_n2(const Params& P, int l, int bid, int nb, float* lds, int nrows = MROWS) {
    const int tid = opaque_tid(), wid = P.wv, lane = tid & 63;
    const float* wr = P.router_w + (size_t)l * DM * NEXP;
    f16* wh = (f16*)lds;
    for (int i = tid; i < DM * NEXP; i += NTHR) { const int d = i >> 4, e = i & 15; wh[e * 1032 + d] = (f16)wr[i]; }
    f16* h2s = (f16*)lds + 16640;
    LAS unsigned char* zst = (LAS unsigned char*)lds + N2_ZST;
    const int j = l >> 1, nblk = nrows >> 4;
    const f16* Zg = P.Z();
    const f16* Xg = P.X();
    f16x4 xr[2][4]; f16x4 zr[2][4];
    auto prefetch = [&](int blk) {
        const int R0 = blk * 16, rb = R0 + wid * 2;
        if (POOL) {
            int s0, L; if (R0 < NLAT) { s0 = (R0 >> 14) << 14; L = SEQ; } else { s0 = NLAT + (((R0 - NLAT) >> 8) << 8); L = CTXL; }
#pragma unroll
            for (int i = 0; i < 8; ++i) { const int piece = wid * 8 + i; int rr = R0 - 8 + (piece >> 1); rr = rr < s0 ? s0 : (rr > s0 + L - 1 ? s0 + L - 1 : rr);
                __builtin_amdgcn_global_load_lds((const unsigned*)(Zg + (size_t)rr * DM + (piece & 1) * 512 + lane * 8), (LAS unsigned*)(zst + piece * 1024), 16, 0, 0); }
        } else {
#pragma unroll
            for (int u = 0; u < 2; ++u)
#pragma unroll
                for (int q = 0; q < 4; ++q) zr[u][q] = *(const f16x4*)(Zg + (size_t)(rb + u) * DM + q * 256 + lane * 4);
        }
#pragma unroll
        for (int u = 0; u < 2; ++u)
#pragma unroll
            for (int q = 0; q < 4; ++q) xr[u][q] = *(const f16x4*)(Xg + (size_t)(rb + u) * DM + q * 256 + lane * 4);
    };
    int blk = bid;
    if (blk < nblk) prefetch(blk);
    __syncthreads();
    while (blk < nblk) {
        const int R0 = blk * 16, rb = R0 + wid * 2;
        int v, s0, L;
        if (rb < NLAT) { v = rb >> 14; s0 = v << 14; L = SEQ; } else { v = 2; s0 = NLAT + (((rb - NLAT) >> 8) << 8); L = CTXL; }
        const int t = rb - s0;
        if (POOL) asm volatile("s_waitcnt vmcnt(16)" ::: "memory");
        f32x4 g1v[4], gmv[4], shv[4], psv[4];
        { const float* g1 = modp(P, l, v, 2); const float* g = P.norm2_g + l * DM; const float* sh = modp(P, l, v, 3); const float* scl = modp(P, l, v, 4);
#pragma unroll
            for (int q = 0; q < 4; ++q) { const int c0 = q * 256 + lane * 4;
                g1v[q] = *(const f32x4*)(g1 + c0); const f32x4 gv = *(const f32x4*)(g + c0), cv = *(const f32x4*)(scl + c0); shv[q] = *(const f32x4*)(sh + c0); gmv[q] = gv * (1.0f + cv);
                if (POOL) psv[q] = *(const f32x4*)(P.pool_scale + j * DM + c0); } }
        f32x4 y[2][4];
        if (POOL) {
            asm volatile("s_waitcnt lgkmcnt(0)" ::: "memory"); __builtin_amdgcn_s_barrier(); asm volatile("" ::: "memory");
            if (t >= 8 && t + 9 < L) {
#pragma unroll
                for (int q = 0; q < 4; ++q) {
                    const int h = 1 << q;
                    const LAS f16* zb = (const LAS f16*)zst + q * 256 + lane * 4 + (2 * wid + 8) * DM;
#define ZROW(d) (*(const LAS f16x4*)(zb + (d) * DM))
                    const f32x4 z0 = cvt4(ZROW(-h)), z1 = cvt4(ZROW(h)), own0 = cvt4(ZROW(0)), own1 = (h == 1) ? z1 : cvt4(ZROW(1));
                    f32x4 common = (f32x4){0.f, 0.f, 0.f, 0.f};
#pragma unroll
                    for (int d = -h + 1; d + 1 <= h - 1; d += 2) { const f16x4 pr = ZROW(d) + ZROW(d + 1); common += cvt4(pr); }
                    common += cvt4(ZROW(h - 1));
#undef ZROW
                    const float inv = 0.5f / (float)h;
                    y[0][q] = ((common + z0) * inv - own0) * psv[q];
                    y[1][q] = ((common + z1) * inv - own1) * psv[q];
                }
            } else {
#pragma unroll
            for (int q = 0; q < 4; ++q) {
                const int h = 1 << q;
                const LAS f16* zb = (const LAS f16*)zst + q * 256 + lane * 4;
                f32x4 common = (f32x4){0.f, 0.f, 0.f, 0.f}, z0 = common, z1 = common;
#pragma unroll
                for (int d = -h; d <= h; ++d) {
                    const int tt = t + d; const bool ok = tt >= 0 && tt < L;
                    f32x4 zz = cvt4(*(const LAS f16x4*)(zb + (2 * wid + 8 + d) * DM));
                    if (!ok) zz = (f32x4){0.f, 0.f, 0.f, 0.f};
                    if (d == -h) z0 = zz; else if (d == h) z1 = zz; else common += zz;
                    if (d == 0) y[0][q] = zz;
                    if (d == 1) y[1][q] = zz;
                }
                const int c0n = min(t + h, L) - max(t - h, 0), c1n = min(t + 1 + h, L) - max(t + 1 - h, 0);
                y[0][q] = ((common + z0) * (1.0f / (float)c0n) - y[0][q]) * psv[q];
                y[1][q] = ((common + z1) * (1.0f / (float)c1n) - y[1][q]) * psv[q];
            }
            }
            asm volatile("s_waitcnt lgkmcnt(0)" ::: "memory"); __builtin_amdgcn_s_barrier(); asm volatile("" ::: "memory");
        } else {
#pragma unroll
            for (int u = 0; u < 2; ++u)
#pragma unroll
                for (int q = 0; q < 4; ++q) y[u][q] = cvt4(zr[u][q]);
        }
        f32x4 xv[2][4]; float ss[2] = {0.f, 0.f};
#pragma unroll
        for (int q = 0; q < 4; ++q) {
#pragma unroll
            for (int u = 0; u < 2; ++u) { xv[u][q] = cvt4(xr[u][q]) + g1v[q] * y[u][q]; ss[u] += dot4(xv[u][q], xv[u][q]); }
        }
        const int nxt = blk + nb;
        asm volatile("" ::: "memory");
        if (nxt < nblk) prefetch(nxt);
#pragma unroll
        for (int u = 0; u < 2; ++u)
#pragma unroll
            for (int q = 0; q < 4; ++q) *(f16x4*)(P.Xw() + (size_t)(rb + u) * DM + q * 256 + lane * 4) = pk4(xv[u][q]);
        ss[0] = wave_sum(ss[0], lane); ss[1] = wave_sum(ss[1], lane);
        const float rs[2] = {rsqrtf(ss[0] * (1.0f / DM) + 1e-6f), rsqrtf(ss[1] * (1.0f / DM) + 1e-6f)};
        f16x4 h2h[2][4];
#pragma unroll
        for (int q = 0; q < 4; ++q) {
            const int c0 = q * 256 + lane * 4;
#pragma unroll
            for (int u = 0; u < 2; ++u) { h2h[u][q] = pk4(xv[u][q] * rs[u] * gmv[q] + shv[q]); *(f16x4*)(P.Hw() + (size_t)(rb + u) * DM + c0) = rm4(h2h[u][q]); }
        }
        asm volatile("s_waitcnt lgkmcnt(0)" ::: "memory"); __builtin_amdgcn_s_barrier(); asm volatile("" ::: "memory");
#pragma unroll
        for (int q = 0; q < 4; ++q)
#pragma unroll
            for (int u = 0; u < 2; ++u) *(f16x4*)(h2s + (2 * wid + u) * 1032 + q * 256 + lane * 4) = h2h[u][q];
        asm volatile("s_waitcnt lgkmcnt(0)" ::: "memory"); __builtin_amdgcn_s_barrier(); asm volatile("" ::: "memory");
        {
            const int r16 = lane & 15, kq = lane >> 4;
            f32x4 pl = (f32x4){0.f, 0.f, 0.f, 0.f};
#pragma unroll
            for (int ks = 0; ks < 4; ++ks) {
                const f16x8 av = *(const f16x8*)(h2s + r16 * 1032 + wid * 128 + ks * 32 + kq * 8), bv = *(const f16x8*)(wh + r16 * 1032 + wid * 128 + ks * 32 + kq * 8);
                pl = __builtin_amdgcn_mfma_f32_16x16x32_f16(av, bv, pl, 0, 0, 0);
            }
            *(f32x4*)(lds + 16640 + (wid * 64 + lane) * 4) = pl;
            asm volatile("s_waitcnt lgkmcnt(0)" ::: "memory"); __builtin_amdgcn_s_barrier(); asm volatile("" ::: "memory");
        }
        if (wid == 0) {
            const int r16 = lane & 15, kq = lane >> 4;
            f32x4 lg = (f32x4){0.f, 0.f, 0.f, 0.f};
#pragma unroll
            for (int w = 0; w < 8; ++w) lg += *(const f32x4*)(lds + 16640 + (w * 64 + lane) * 4);
#pragma unroll
            for (int jj = 0; jj < 4; ++jj) {
                float mx = lg[jj];
                mx = fmaxf(mx, shx<1>(mx, lane)); mx = fmaxf(mx, shx<2>(mx, lane)); mx = fmaxf(mx, shx<4>(mx, lane)); mx = fmaxf(mx, shx<8>(mx, lane));
                const float pe = __expf(lg[jj] - mx);
                float den = pe;
                den += shx<1>(den, lane); den += shx<2>(den, lane); den += shx<4>(den, lane); den += shx<8>(den, lane);
                P.affw()[(size_t)r16 * MROWS + R0 + 4 * kq + jj] = pe * __builtin_amdgcn_rcpf(den);
            }
        }
        blk = nxt;
    }
}

__device__ __forceinline__ void phase_topk(const Params& P, int bid, int nb, unsigned* lds, int nprob = 64) {
    unsigned* hist = lds; unsigned* misc = lds + 256; unsigned* wsa = lds + 272; unsigned* wsb = lds + 288;
    const int tid = opaque_tid(), wid = tid >> 6, lane = tid & 63;
    for (int p = bid; p < nprob; p += nb) {
        const int set = p >> 4, e = p & 15;
        const int n = set < 2 ? SEQ : CTXL, C = n >> 3;
        const int r0 = set < 2 ? set * SEQ : NLAT + (set - 2) * CTXL;
        const int slot0 = set < 2 ? set * 2048 : 4096 + (set - 2) * 32;
        unsigned key[32];
#pragma unroll
        for (int i4 = 0; i4 < 8; ++i4) { const int idx = tid * 32 + i4 * 4;
            f32x4 v = (f32x4){0.f, 0.f, 0.f, 0.f}; if (idx < n) v = *(const f32x4*)(P.aff() + (size_t)e * MROWS + r0 + idx);
#pragma unroll
            for (int jj = 0; jj < 4; ++jj) key[i4 * 4 + jj] = idx < n ? (__float_as_uint(v[jj]) + 1u) : 0u; }
        unsigned T = 0u;
        for (int bit = 29; bit >= 0; --bit) {
            const unsigned cand = T | (1u << bit);
            unsigned wc = 0u;
#pragma unroll
            for (int i = 0; i < 32; ++i) wc += (unsigned)__builtin_popcountll(__builtin_amdgcn_ballot_w64(key[i] >= cand));
            unsigned* cb = misc + ((bit & 1) << 3);
            if (lane == 0) cb[wid] = wc;
            __syncthreads();
            unsigned tot = 0u;
#pragma unroll
            for (int w = 0; w < 8; ++w) tot += cb[w];
            if (tot >= (unsigned)C) T = cand;
            if (tot == (unsigned)C) { T = cand - 1u; break; }
        }
        unsigned cg = 0u, ce = 0u;
#pragma unroll
        for (int i = 0; i < 32; ++i) { cg += key[i] > T ? 1u : 0u; ce += key[i] == T ? 1u : 0u; }
        unsigned ig = cg, ie = ce;
#pragma unroll
        for (int o = 1; o < 64; o <<= 1) { const unsigned a = shup(ig, o, lane), b = shup(ie, o, lane); if (lane >= o) { ig += a; ie += b; } }
        if (lane == 63) { wsa[wid] = ig; wsb[wid] = ie; }
        __syncthreads();
        unsigned bg = 0u, be = 0u, totg = 0u;
#pragma unroll
        for (int w = 0; w < 8; ++w) { const unsigned ga = wsa[w]; totg += ga; if (w < wid) { bg += ga; be += wsb[w]; } }
        const unsigned krem = (unsigned)C - totg;
        unsigned pg = bg + ig - cg, pe = be + ie - ce;
#pragma unroll
        for (int i4 = 0; i4 < 8; ++i4) {
            int iv[4];
#pragma unroll
            for (int jj = 0; jj < 4; ++jj) {
                const int i = i4 * 4 + jj, idx = tid * 32 + i;
                bool sel = false; unsigned rank = 0u;
                if (key[i] > T) { sel = true; rank = pg + (pe < krem ? pe : krem); ++pg; }
                else if (key[i] == T && key[i] != 0u) { if (pe < krem) { sel = true; rank = pg + pe; } ++pe; }
                if (sel) P.rowidx()[e * SLOTS_PAD + slot0 + (int)rank] = r0 + idx;
                iv[jj] = sel ? slot0 + (int)rank : -1;
            }
            if (tid * 32 + i4 * 4 < n) *(int4*)(P.inv() + (size_t)e * MROWS + r0 + tid * 32 + i4 * 4) = make_int4(iv[0], iv[1], iv[2], iv[3]);
        }
        if (set == 3) for (int i = SLOTS + tid; i < SLOTS_PAD; i += NTHR) P.rowidx()[e * SLOTS_PAD + i] = 0;
        __syncthreads();
    }
}

#define XB_TMO      128
#define XB_XCNT(j)  (256  + 64 * (j))
#define XB_XSUB(j)  (1280 + 64 * (j))
#define XB_XGEN(j)  (2304 + 64 * (j))
#define XB_TOP      3328
#define XB_TOPGEN   3392
#define XCD_BAR_WORDS 3456
#define XB_SPIN_CAP (1u << 18)
__device__ __forceinline__ unsigned xb_ld(unsigned* p)              { return __hip_atomic_load(p, __ATOMIC_RELAXED, __HIP_MEMORY_SCOPE_AGENT); }
__device__ __forceinline__ unsigned xb_add(unsigned* p, unsigned v) { return __hip_atomic_fetch_add(p, v, __ATOMIC_RELAXED, __HIP_MEMORY_SCOPE_AGENT); }
__device__ __forceinline__ unsigned xb_xcc_id() { return (unsigned)__builtin_amdgcn_s_getreg((3 << 11) | 20) & 0xFu; }
#define XB_SPIN(cond, bar) do { unsigned _sp = 0; while (cond) { __builtin_amdgcn_s_sleep(1); \
    if ((++_sp & 255u) == 0u) { if (xb_ld(&(bar)[XB_TMO])) break; if (_sp > XB_SPIN_CAP) { atomicAdd(&(bar)[XB_TMO], 1u); break; } } } } while (0)
struct XcdBarrier { unsigned* bar; unsigned x; volatile LAS unsigned* st; };
__device__ __forceinline__ XcdBarrier xcd_barrier_post(unsigned* bar, volatile LAS unsigned* st) {
    XcdBarrier b; b.bar = bar; b.x = xb_xcc_id(); b.st = st;
    if (threadIdx.x == 0) (void)xb_add(&bar[XB_XCNT(b.x)], 1u);
    return b;
}
__device__ __forceinline__ void xcd_barrier_complete(unsigned* bar, unsigned x, unsigned& nloc, unsigned& nx) {
    const unsigned G = gridDim.x * gridDim.y * gridDim.z;
    unsigned sum, cnt, mine, sp = 0u;
    for (;;) {
        sum = 0u; cnt = 0u; mine = 0u;
#pragma unroll
        for (unsigned j = 0; j < 16; ++j) { const unsigned c = xb_ld(&bar[XB_XCNT(j)]); sum += c; cnt += (c > 0u) ? 1u : 0u; mine = (j == x) ? c : mine; }
        if (sum == G) break;
        __builtin_amdgcn_s_sleep(1);
        if ((++sp & 255u) == 0u) { if (xb_ld(&bar[XB_TMO])) break; if (sp > XB_SPIN_CAP) { atomicAdd(&bar[XB_TMO], 1u); break; } }
    }
    nloc = mine > 0u ? mine : 1u; nx = cnt > 0u ? cnt : 1u;
}
__device__ __forceinline__ void xcd_barrier(const XcdBarrier& b) {
    asm volatile("s_waitcnt vmcnt(0)" ::: "memory");
    __syncthreads();
    if (threadIdx.x == 0) {
        unsigned* bar = b.bar; asm volatile("" : "+s"(bar));
        const unsigned bx = (unsigned)__builtin_amdgcn_readfirstlane((int)xb_xcc_id());
        __builtin_amdgcn_s_waitcnt(0);
        unsigned nloc = b.st[0], nx = b.st[1];
        if (nloc == 0u) { xcd_barrier_complete(bar, bx, nloc, nx); b.st[0] = nloc; b.st[1] = nx; }
        const unsigned old = xb_add(&bar[XB_XSUB(bx)], 1u);
        const unsigned gen = old / nloc;
        if (old + 1u == (gen + 1u) * nloc) {
            __builtin_amdgcn_fence(__ATOMIC_RELEASE, "agent");
            asm volatile("s_waitcnt vmcnt(0)" ::: "memory");
            const unsigned og = xb_add(&bar[XB_TOP], 1u);
            const unsigned tg = og / nx;
            if (og + 1u == (tg + 1u) * nx) xb_add(&bar[XB_TOPGEN], 1u);
            else XB_SPIN(xb_ld(&bar[XB_TOPGEN]) == tg, bar);
            __builtin_amdgcn_fence(__ATOMIC_ACQUIRE, "agent");
            xb_add(&bar[XB_XGEN(bx)], 1u);
            asm volatile("s_waitcnt vmcnt(0)" ::: "memory");
        } else {
            XB_SPIN(xb_ld(&bar[XB_XGEN(bx)]) == gen, bar);
            __builtin_amdgcn_fence(__ATOMIC_ACQUIRE, "agent");
            asm volatile("s_waitcnt vmcnt(0)" ::: "memory");
        }
    }
    __syncthreads();
}

namespace fg {
constexpr int BM = 256, BK = 64, HALF = 128, HTB = HALF * BK * 2, STAGE_BYTES = 8 * HTB;
__device__ __forceinline__ int lds_byte(int r, int c) { const int st = (r >> 4) * 2 + (c >> 5), rr = r & 15, cc = c & 31, ob = rr * 64 + cc * 2; return st * 1024 + (ob ^ (((ob >> 9) & 1) << 5)); }
__device__ __forceinline__ void stage_rc(int b, int& R, int& C) { const int st = b / 1024, sb = b % 1024, swz = sb ^ (((sb >> 9) & 1) << 5); R = (st >> 1) * 16 + swz / 64; C = (st & 1) * 32 + (swz % 64) / 2; }
__device__ __forceinline__ int perm32(int rho) { const int n = rho >> 4, i = rho & 15; return 8 * (i >> 2) + 4 * n + (i & 3); }
#define KDUP 0
struct Unit { int e, pm, pn; int skip; };
__device__ __forceinline__ void xcd_order(int i, int& T) { const int c = blockIdx.x; T = i * (int)gridDim.x + c; }

template <class PR>
__device__ __forceinline__ void gemm_phase(LAS unsigned char* lds, const PR& S, int wv) {
    const int tid = opaque_tid_(wv), wid = __builtin_amdgcn_readfirstlane(tid >> 6), lane = tid & 63, wr = wid >> 2, wc = wid & 3, fr = lane & 15, fq = lane >> 4;
    constexpr int K = PR::K, nt = K / BK;
    unsigned voffB[2];
#pragma unroll
    for (int i = 0; i < 2; ++i) { int R, C; stage_rc(tid * 16 + i * 8192, R, C); const int Rb = (R & ~31) + perm32(R & 31); voffB[i] = (unsigned)(Rb * PR::LDB + C) * 2u; }
    const size_t kstep = (size_t)(BK * 2);
    const size_t hB = S.hstepB();
    const unsigned ldsw = (unsigned)wid * 1024u;
    const int aoff = lds_byte(wr * 64 + fr, fq * 8), boff = lds_byte(wc * 32 + fr, fq * 8);
#define FG_SA(b, h) (((b) * 2 + (h)) * HTB)
#define FG_SB(b, h) ((4 + (b) * 2 + (h)) * HTB)
#define FG_STAGE(bufoff, gbase, voff) do { _Pragma("unroll") for (int _i = 0; _i < 2; ++_i) \
        __builtin_amdgcn_global_load_lds((const unsigned*)((const char*)(gbase) + (voff)[_i]), (LAS unsigned*)(lds + (bufoff) + ldsw + _i * 8192), 16, 0, 0); } while (0)
#define FG_LDA(dst, b, h) do { _Pragma("unroll") for (int m = 0; m < 4; ++m) _Pragma("unroll") for (int k = 0; k < 2; ++k) dst[m][k] = *(const LAS f16x8*)(lds + FG_SA(b, h) + aoff + m * 2048 + k * 1024); } while (0)
#define FG_LDB(dst, b, h) do { _Pragma("unroll") for (int n = 0; n < 2; ++n) _Pragma("unroll") for (int k = 0; k < 2; ++k) dst[n][k] = *(const LAS f16x8*)(lds + FG_SB(b, h) + boff + n * 2048 + k * 1024); } while (0)
#define FG_MMA(ai, bj, At, Bt) do { __builtin_amdgcn_s_setprio(1); _Pragma("unroll") for (int m = 0; m < 4; ++m) _Pragma("unroll") for (int n = 0; n < 2; ++n) _Pragma("unroll") for (int k = 0; k < 2; ++k) \
        acc[ai][bj][m][n] = __builtin_amdgcn_mfma_f32_16x16x32_f16(Bt[n][k], At[m][k], acc[ai][bj][m][n], 0, 0, 0); __builtin_amdgcn_s_setprio(0); } while (0)
#define FG_WAIT_V(n) asm volatile("s_waitcnt vmcnt(" #n ")" ::: "memory")
#define FG_WAIT_L(n) asm volatile("s_waitcnt lgkmcnt(" #n ")" ::: "memory")
#define FG_BAR __builtin_amdgcn_s_barrier()
#define FG_SCHED __builtin_amdgcn_sched_barrier(0)
    Unit cur, nxt; int ui = 0;
    if (!S.next(0, cur)) return;
    f32x4 acc[2][2][4][2];
#pragma unroll
    for (int a = 0; a < 2; ++a)
#pragma unroll
        for (int b = 0; b < 2; ++b)
#pragma unroll
            for (int m = 0; m < 4; ++m)
#pragma unroll
                for (int n = 0; n < 2; ++n) acc[a][b][m][n] = (f32x4){0.f, 0.f, 0.f, 0.f};
    f16x8 At[4][2], B0[2][2], B1[2][2];
    unsigned vA[2][2], vN[2][2];
    { int Rr[2], Cc[2]; stage_rc(tid * 16, Rr[0], Cc[0]); stage_rc(tid * 16 + 8192, Rr[1], Cc[1]); S.a_voff(cur, Rr, Cc, vA); }
#pragma unroll
    for (int h = 0; h < 2; ++h)
#pragma unroll
        for (int i = 0; i < 2; ++i) { asm volatile("" : "+v"(vA[h][i])); vN[h][i] = vA[h][i]; }
    const char* cA = S.a_base(cur); const char* cB = S.b_base(cur);
    FG_STAGE(FG_SB(0, 0), cB, voffB); FG_STAGE(FG_SA(0, 0), cA, vA[0]); FG_STAGE(FG_SB(0, 1), cB + hB, voffB); FG_STAGE(FG_SA(0, 1), cA, vA[1]);
    if (wr == 1) FG_BAR;
    FG_WAIT_V(4); FG_BAR;
    FG_STAGE(FG_SB(1, 0), cB + kstep, voffB); FG_STAGE(FG_SA(1, 0), cA + kstep, vA[0]); FG_STAGE(FG_SB(1, 1), cB + hB + kstep, voffB);
    FG_WAIT_V(6); FG_BAR;
    for (;;) {
        const bool has_next = S.next(ui + 1, nxt);
        const char* nA = has_next ? S.a_base(nxt) : cA; const char* nB = has_next ? S.b_base(nxt) : cB;
        if (has_next) { int Rr[2], Cc[2]; int t2 = tid; asm volatile("" : "+v"(t2)); stage_rc(t2 * 16, Rr[0], Cc[0]); stage_rc(t2 * 16 + 8192, Rr[1], Cc[1]); S.a_voff(nxt, Rr, Cc, vN);
#pragma unroll
            for (int h = 0; h < 2; ++h)
#pragma unroll
                for (int i = 0; i < 2; ++i) asm volatile("" : "+v"(vN[h][i])); }
#pragma unroll 1
        for (int t = 0; t < nt; t += 2) {
            const bool last = (t == nt - 2);
            const char* a1 = cA + (size_t)(t + 1) * kstep;
            const char* a2 = last ? nA : cA + (size_t)(t + 2) * kstep; const char* b2 = last ? nB : cB + (size_t)(t + 2) * kstep;
            const char* a3 = a2 + kstep; const char* b3 = b2 + kstep;
            unsigned v2[2][2];
#pragma unroll
            for (int h = 0; h < 2; ++h)
#pragma unroll
                for (int i = 0; i < 2; ++i) v2[h][i] = last ? vN[h][i] : vA[h][i];
            FG_LDB(B0, 0, 0); FG_SCHED; FG_LDA(At, 0, 0); FG_STAGE(FG_SA(1, 1), a1, vA[1]);
            FG_WAIT_L(8); FG_BAR; FG_WAIT_L(0); FG_MMA(0, 0, At, B0); FG_BAR; FG_SCHED;
            FG_LDB(B1, 0, 1); FG_STAGE(FG_SB(0, 0), b2, voffB);
            FG_BAR; FG_WAIT_L(0); FG_MMA(0, 1, At, B1); FG_BAR;
            FG_LDA(At, 0, 1); FG_STAGE(FG_SA(0, 0), a2, v2[0]);
            FG_BAR; FG_WAIT_L(0); FG_MMA(1, 0, At, B0); FG_BAR; FG_SCHED;
            FG_STAGE(FG_SB(0, 1), b2 + hB, voffB);
            FG_WAIT_V(6); FG_BAR; FG_MMA(1, 1, At, B1); FG_BAR;
            FG_LDB(B0, 1, 0); FG_SCHED; FG_LDA(At, 1, 0); FG_STAGE(FG_SA(0, 1), a2, v2[1]);
            FG_WAIT_L(8); FG_BAR; FG_WAIT_L(0); FG_MMA(0, 0, At, B0); FG_BAR; FG_SCHED;
            FG_LDB(B1, 1, 1); FG_STAGE(FG_SB(1, 0), b3, voffB);
            FG_BAR; FG_WAIT_L(0); FG_MMA(0, 1, At, B1); FG_BAR;
            FG_LDA(At, 1, 1); FG_STAGE(FG_SA(1, 0), a3, v2[0]);
            FG_BAR; FG_WAIT_L(0); FG_MMA(1, 0, At, B0); FG_BAR; FG_SCHED;
            FG_STAGE(FG_SB(1, 1), b3 + hB, voffB);
            FG_WAIT_V(6); FG_BAR; FG_MMA(1, 1, At, B1); FG_BAR;
        }
        if (!KDUP || !cur.skip) S.epi(acc, cur, wr, wc, fr, fq);
        if (!has_next) break;
#pragma unroll
        for (int a = 0; a < 2; ++a)
#pragma unroll
            for (int b = 0; b < 2; ++b)
#pragma unroll
                for (int m = 0; m < 4; ++m)
#pragma unroll
                    for (int n = 0; n < 2; ++n) acc[a][b][m][n] = (f32x4){0.f, 0.f, 0.f, 0.f};
        cur = nxt; cA = nA; cB = nB; ++ui;
#pragma unroll
        for (int h = 0; h < 2; ++h)
#pragma unroll
            for (int i = 0; i < 2; ++i) vA[h][i] = vN[h][i];
    }
    FG_WAIT_V(0);
    if (wr == 0) FG_BAR;
    FG_BAR;
#undef FG_SA
#undef FG_SB
#undef FG_STAGE
#undef FG_LDA
#undef FG_LDB
#undef FG_MMA
#undef FG_WAIT_V
#undef FG_WAIT_L
#undef FG_BAR
#undef FG_SCHED
}

__device__ __forceinline__ f16x8 pack8(const f32x4 a, const f32x4 b) { return (f16x8){(f16)a[0], (f16)a[1], (f16)a[2], (f16)a[3], (f16)b[0], (f16)b[1], (f16)b[2], (f16)b[3]}; }

template <int K_, int LDA_, int LDB_> struct PRBase {
    static constexpr int K = K_, LDA = LDA_, LDB = LDB_;
    __device__ __forceinline__ void plain_voff(const int (&R)[2], const int (&C)[2], unsigned (&v)[2][2]) const {
#pragma unroll
        for (int h = 0; h < 2; ++h)
#pragma unroll
            for (int i = 0; i < 2; ++i) v[h][i] = (unsigned)((h * HALF + R[i]) * LDA + C[i]) * 2u;
    }
};
struct PRGateUp : PRBase<1024, 1024, 1024> {
    const f16* H; const int* rowidx; const f16* W; f16* act; int nunits; int bid; int rt;
    __device__ __forceinline__ size_t hstepB() const { return (size_t)DEXP * DM * 2; }
    __device__ __forceinline__ bool next(int i, Unit& u) const { const int ii = KDUP ? (i >> 1) : i; const int T = ii * (int)gridDim.x + bid; u.skip = KDUP ? ((i & 1) == 0) : 0; if (T >= nunits) return false;
        if (rt == 16 && gridDim.x == 256) { const int x = bid & 7, jj = bid >> 3; u.e = ii; u.pm = (x >> 1) * 4 + (jj >> 3); u.pn = (x & 1) * 8 + (jj & 7); return true; }
        const int per = rt * 16; u.e = T / per; const int t = T % per; u.pm = t >> 4; u.pn = t & 15; return true; }
    __device__ __forceinline__ const char* a_base(const Unit&) const { return (const char*)H; }
    __device__ __forceinline__ void a_voff(const Unit& u, const int (&R)[2], const int (&C)[2], unsigned (&v)[2][2]) const {
        const int* ri = rowidx + u.e * SLOTS_PAD + u.pm * BM;
#pragma unroll
        for (int h = 0; h < 2; ++h)
#pragma unroll
            for (int i = 0; i < 2; ++i) { const int g = ri[h * HALF + R[i]]; v[h][i] = (unsigned)(g * LDA + C[i]) * 2u; }
    }
    __device__ __forceinline__ const char* b_base(const Unit& u) const { return (const char*)(W + ((size_t)u.e * 2 * DEXP + (size_t)u.pn * HALF) * DM); }
    __device__ __forceinline__ void epi(const f32x4 (&acc)[2][2][4][2], const Unit& u, int wr, int wc, int fr, int fq) const {
        f16* base = act + ((size_t)u.e * SLOTS_PAD + (size_t)u.pm * BM + wr * 64 + fr) * DEXP + u.pn * HALF + wc * 32 + fq * 8;
#pragma unroll
        for (int ai = 0; ai < 2; ++ai)
#pragma unroll
            for (int m = 0; m < 4; ++m) {
                f32x4 o0, o1;
#pragma unroll
                for (int j = 0; j < 4; ++j) { o0[j] = silu_f(acc[ai][0][m][0][j]) * acc[ai][1][m][0][j]; o1[j] = silu_f(acc[ai][0][m][1][j]) * acc[ai][1][m][1][j]; }
                if (u.e < 8) __builtin_nontemporal_store(rm8(pack8(o0, o1)), (f16x8*)(base + (size_t)(ai * HALF + m * 16) * DEXP));
                else *(f16x8*)(base + (size_t)(ai * HALF + m * 16) * DEXP) = rm8(pack8(o0, o1));
            }
    }
};
struct PRDown : PRBase<2048, 2048, 2048> {
    const f16* act; const f16* W; f16* y; int nunits; int bid; int rt;
    __device__ __forceinline__ size_t hstepB() const { return (size_t)HALF * DEXP * 2; }
    __device__ __forceinline__ bool next(int i, Unit& u) const { const int ii = KDUP ? (i >> 1) : i; const int T = ii * (int)gridDim.x + bid; u.skip = KDUP ? ((i & 1) == 0) : 0; if (T >= nunits) return false;
        if (rt == 16 && gridDim.x == 256) { const int x = bid & 7, jj = bid >> 3; u.e = 15 - (ii * 4 + (x >> 1)); u.pm = (x & 1) * 8 + (jj >> 2); u.pn = jj & 3; return true; }
        const int per = rt * 4; u.e = T / per; const int t = T % per; u.pm = t >> 2; u.pn = t & 3; return true; }
    __device__ __forceinline__ const char* a_base(const Unit& u) const { return (const char*)(act + ((size_t)u.e * SLOTS_PAD + (size_t)u.pm * BM) * DEXP); }
    __device__ __forceinline__ void a_voff(const Unit&, const int (&R)[2], const int (&C)[2], unsigned (&v)[2][2]) const { plain_voff(R, C, v); }
    __device__ __forceinline__ const char* b_base(const Unit& u) const { return (const char*)(W + ((size_t)u.e * DM + (size_t)u.pn * BM) * DEXP); }
    __device__ __forceinline__ void epi(const f32x4 (&acc)[2][2][4][2], const Unit& u, int wr, int wc, int fr, int fq) const {
        f16* base = y + ((size_t)u.e * SLOTS_PAD + (size_t)u.pm * BM + wr * 64 + fr) * DM + u.pn * BM + wc * 32 + fq * 8;
#pragma unroll
        for (int ai = 0; ai < 2; ++ai)
#pragma unroll
            for (int m = 0; m < 4; ++m)
#pragma unroll
                for (int bj = 0; bj < 2; ++bj) *(f16x8*)(base + (size_t)(ai * HALF + m * 16) * DM + bj * HALF) = pack8(acc[ai][bj][m][0], acc[ai][bj][m][1]);
    }
};
template <int K_> struct PRDense : PRBase<K_, 1024, K_> {
    const f16* A; const f16* W; f16* O0; f16* O1; f16* O2; int ncol; int mode; int bid; int npan; int kvx;
    __device__ __forceinline__ size_t hstepB() const { return (size_t)HALF * K_ * 2; }
    __device__ __forceinline__ bool next(int i, Unit& u) const { const int ii = KDUP ? (i >> 1) : i; int T = ii * (int)gridDim.x + bid; if (gridDim.x == 256) T = (ii * 8 + (bid & 7)) * 32 + (bid >> 3);
        u.skip = KDUP ? ((i & 1) == 0) : 0; const int nu = npan * ncol; if (T >= nu + kvx) return false; u.e = 0; if (T < nu) { u.pm = T / ncol; u.pn = T % ncol; } else { const int x = T - nu; u.pm = npan + (x >> 1); u.pn = 4 + (x & 1); } return true; }
    __device__ __forceinline__ const char* a_base(const Unit& u) const { return (const char*)(A + (size_t)u.pm * BM * 1024 + (mode == 2 ? u.pn * 256 : 0)); }
    __device__ __forceinline__ void a_voff(const Unit&, const int (&R)[2], const int (&C)[2], unsigned (&v)[2][2]) const { this->plain_voff(R, C, v); }
    __device__ __forceinline__ const char* b_base(const Unit& u) const { return (const char*)(W + (size_t)u.pn * BM * K_); }
    const float* qn; const float* kn; const float* rope; LAS float* xs; int lane;
    __device__ __forceinline__ void epi(const f32x4 (&acc)[2][2][4][2], const Unit& u, int wr, int wc, int fr, int fq) const {
        f16* base; int ld;
        const int row = u.pm * BM + wr * 64 + fr, colw = wc * 32 + fq * 8;
        if (mode == 1) { if (u.pn < 4) { base = O0 + (size_t)row * 1024 + u.pn * BM + colw; ld = 1024; } else if (u.pn == 4) { base = O1 + (size_t)row * 256 + colw; ld = 256; } else { base = O2 + (size_t)row * 256 + colw; ld = 256; } }
        else { base = O0 + (size_t)row * 1024 + u.pn * BM + colw; ld = 1024; }
        if (mode == 1 && u.pn < 5) {
            float ssq[2][4][2];
#pragma unroll
            for (int ai = 0; ai < 2; ++ai)
#pragma unroll
                for (int m = 0; m < 4; ++m)
#pragma unroll
                    for (int bj = 0; bj < 2; ++bj) { const f32x4 a = acc[ai][bj][m][0], b = acc[ai][bj][m][1];
                        float t = (a[0] * a[0] + a[1] * a[1]) + (a[2] * a[2] + a[3] * a[3]) + (b[0] * b[0] + b[1] * b[1]) + (b[2] * b[2] + b[3] * b[3]);
                        t += shx<16>(t, lane); t += shx<32>(t, lane); ssq[ai][m][bj] = t; }
            LAS float* mine = xs + ((wr * 4 + wc) * 16) * 16 + fr; const LAS float* theirs = xs + ((wr * 4 + (wc ^ 1)) * 16) * 16 + fr;
            if (fq == 0) {
#pragma unroll
                for (int ai = 0; ai < 2; ++ai)
#pragma unroll
                    for (int m = 0; m < 4; ++m)
#pragma unroll
                        for (int bj = 0; bj < 2; ++bj) mine[(ai * 8 + m * 2 + bj) * 16] = ssq[ai][m][bj];
            }
            asm volatile("s_waitcnt lgkmcnt(0)" ::: "memory"); __builtin_amdgcn_s_barrier(); asm volatile("" ::: "memory");
            const bool isq = u.pn < 4, lat = u.pm < 128;
            const float* nw = (isq ? qn : kn) + (wc & 1) * 32 + fq * 8;
            const f32x4 w0 = *(const f32x4*)nw, w1 = *(const f32x4*)(nw + 4);
            const float qs = isq ? 0.125f * 1.4426950408889634f : 1.0f;
#pragma unroll
            for (int ai = 0; ai < 2; ++ai)
#pragma unroll
                for (int m = 0; m < 4; ++m) {
                    f32x4 c0 = (f32x4){1.f, 1.f, 1.f, 1.f}, s0 = (f32x4){0.f, 0.f, 0.f, 0.f};
                    if (lat) { const int t = (row + ai * HALF + m * 16) & (SEQ - 1); const int pos = (wc & 1) ? (t & 63) : (t >> 6);
                        const float* tb = rope + (size_t)(pos * 16 + fq * 4) * 2; const f32x4 ta = *(const f32x4*)tb, tb2 = *(const f32x4*)(tb + 4);
                        c0 = (f32x4){ta[0], ta[2], tb2[0], tb2[2]}; s0 = (f32x4){ta[1], ta[3], tb2[1], tb2[3]}; }
#pragma unroll
                    for (int bj = 0; bj < 2; ++bj) {
                        const float tot = ssq[ai][m][bj] + theirs[(ai * 8 + m * 2 + bj) * 16];
                        const float rstd = rsqrtf(tot * (1.0f / 64.0f) + 1e-6f) * qs;
                        f32x4 a = acc[ai][bj][m][0] * rstd * w0, b = acc[ai][bj][m][1] * rstd * w1;
                        const f32x4 ra = (f32x4){a[0] * c0[0] - a[1] * s0[0], a[0] * s0[0] + a[1] * c0[0], a[2] * c0[1] - a[3] * s0[1], a[2] * s0[1] + a[3] * c0[1]};
                        const f32x4 rb = (f32x4){b[0] * c0[2] - b[1] * s0[2], b[0] * s0[2] + b[1] * c0[2], b[2] * c0[3] - b[3] * s0[3], b[2] * s0[3] + b[3] * c0[3]};
                        *(f16x8*)(base + (size_t)(ai * HALF + m * 16) * ld + bj * HALF) = rm8(pack8(ra, rb));
                    }
                }
            return;
        }
#pragma unroll
        for (int ai = 0; ai < 2; ++ai)
#pragma unroll
            for (int m = 0; m < 4; ++m)
#pragma unroll
                for (int bj = 0; bj < 2; ++bj) { const f16x8 o = pack8(acc[ai][bj][m][0], acc[ai][bj][m][1]); *(f16x8*)(base + (size_t)(ai * HALF + m * 16) * ld + bj * HALF) = (mode == 1) ? rm8(o) : o; }
    }
};
}

struct CvtJob { const float* src; f16* dst; int K, N, k0, n0; };
__device__ __forceinline__ bool cvt_job(const Params& P, int l, int u, CvtJob& jb, bool experts) {
    const int j = l >> 1;
    const int nexp = experts ? NEXP * 3 * 128 : 0;
    const int nmix = (l & 1) == 0 ? 16 : (96 + 64);
    if (u >= nexp + nmix) return false;
    if (u < nexp) {
        const int e = u / 384, r = u % 384, which = r >> 7, t = r & 127;
        if (which < 2) { jb.src = (which == 0 ? P.w_gate : P.w_up) + ((size_t)l * NEXP + e) * DM * DEXP; jb.dst = P.Wgu() + ((size_t)e * 2 + which) * DEXP * DM; jb.K = DM; jb.N = DEXP; jb.k0 = (t >> 4) * 128; jb.n0 = (t & 15) * 128; }
        else { jb.src = P.w_down + ((size_t)l * NEXP + e) * DEXP * DM; jb.dst = P.Wd() + (size_t)e * DM * DEXP; jb.K = DEXP; jb.N = DM; jb.k0 = (t >> 3) * 128; jb.n0 = (t & 7) * 128; }
    } else {
        const int t = u - nexp;
        if ((l & 1) == 0) { const int g = t >> 2, tt = t & 3; jb.src = P.pool_w + (size_t)(j * 4 + g) * 65536; jb.dst = P.Wmix() + (size_t)g * 65536; jb.K = 256; jb.N = 256; jb.k0 = (tt >> 1) * 128; jb.n0 = (tt & 1) * 128; }
        else if (t < 96) { jb.src = P.w_qkv + (size_t)j * DM * QKVD; jb.dst = P.Wmix(); jb.K = DM; jb.N = QKVD; jb.k0 = (t / 12) * 128; jb.n0 = (t % 12) * 128; }
        else { const int tt = t - 96; jb.src = P.w_o + (size_t)j * DM * DM; jb.dst = P.Wmix() + (size_t)QKVD * DM; jb.K = DM; jb.N = DM; jb.k0 = (tt >> 3) * 128; jb.n0 = (tt & 7) * 128; }
    }
    return true;
}
__device__ __forceinline__ void phase_convert(const Params& P, int l, int bid, int nb, f16* tile, bool experts = true) {
    const int tid = opaque_tid();
    CvtJob jb;
    int u = bid;
    bool have = cvt_job(P, l, u, jb, experts);
    f32x4 r[8];
    if (have) {
#pragma unroll
        for (int p = 0; p < 8; ++p) { const int id = tid + p * NTHR, kr = id >> 5, c4 = (id & 31) * 4; r[p] = __builtin_nontemporal_load((const f32x4*)(jb.src + (size_t)(jb.k0 + kr) * jb.N + jb.n0 + c4)); }
    }
    while (have) {
        __syncthreads();
#pragma unroll
        for (int p = 0; p < 8; ++p) { const int id = tid + p * NTHR, kr = id >> 5, c4 = (id & 31) * 4; *(f16x4*)(tile + kr * 136 + c4) = pk4(r[p]); }
        __syncthreads();
        const CvtJob cur = jb;
        u += nb; have = cvt_job(P, l, u, jb, experts);
        if (have) {
#pragma unroll
            for (int p = 0; p < 8; ++p) { const int id = tid + p * NTHR, kr = id >> 5, c4 = (id & 31) * 4; r[p] = __builtin_nontemporal_load((const f32x4*)(jb.src + (size_t)(jb.k0 + kr) * jb.N + jb.n0 + c4)); }
        }
        const int n = tid & 127, kg = (tid >> 7) * 32;
        f16* dp = cur.dst + (size_t)(cur.n0 + n) * cur.K + cur.k0 + kg;
#pragma unroll
        for (int i = 0; i < 4; ++i) { f16x8 o;
#pragma unroll
            for (int e = 0; e < 8; ++e) o[e] = tile[(kg + i * 8 + e) * 136 + n];
            *(f16x8*)(dp + i * 8) = rmw8(o); }
    }
}
template <bool GATEUP, bool CTX>
__device__ __forceinline__ void phase_cvt_ctx(const Params& P, int l, int bid, int nb, f16* tile, int sel = -1, bool alt = false) {
    const int tid = opaque_tid(), wid = P.wv, lane = tid & 63, r16 = lane & 15, kq = lane >> 4;
    constexpr int NC = GATEUP ? 128 : 64;
    constexpr int KT = GATEUP ? 8 : 16, K = GATEUP ? DM : DEXP, N = GATEUP ? DEXP : DM, NB = N / NC;
    constexpr int NT = GATEUP ? 2 * KT : KT;
    const int sel_ = (GATEUP && !CTX) ? sel : -1; const int ntr = (GATEUP && sel_ < 0) ? NT : KT;
    constexpr int TS = NC + 4, TW = 128 * TS;
    constexpr int NLD = NC / 16;
    constexpr int WPC = 8 / (NC / 16);
    constexpr int NRB = 4 / WPC;
    const int cb = wid % (NC / 16), rb0 = (wid / (NC / 16)) * NRB;
    f16* asl = tile + 2 * TW;
    for (int job = bid; job < NEXP * NB; job += nb) {
        const int e = job / NB, nbk = job % NB;
        const f16* ap[2];
        if (CTX) {
#pragma unroll
            for (int p = 0; p < 2; ++p) { const int row = (tid >> 4) + p * 32;
                if (GATEUP) ap[p] = P.H() + (size_t)P.rowidx()[e * SLOTS_PAD + 4096 + row] * DM + (tid & 15) * 8;
                else ap[p] = P.act() + ((size_t)e * SLOTS_PAD + 4096 + row) * DEXP + (tid & 15) * 8; }
        }
        f32x4 acc[2][NRB];
#pragma unroll
        for (int w = 0; w < 2; ++w)
#pragma unroll
            for (int rb = 0; rb < NRB; ++rb) acc[w][rb] = (f32x4){0.f, 0.f, 0.f, 0.f};
        const float* srcs[2]; f16* dsts[2];
        if (GATEUP) { const size_t wo = ((size_t)l * NEXP + e) * DM * DEXP; srcs[0] = P.w_gate + wo; srcs[1] = P.w_up + wo; dsts[0] = P.Wgu() + (alt ? (OFF_WGU3 - OFF_WGU) / 2 : 0) + ((size_t)e * 2) * DEXP * DM; dsts[1] = dsts[0] + (size_t)DEXP * DM; }
        else { srcs[0] = P.w_down + ((size_t)l * NEXP + e) * DEXP * DM; srcs[1] = srcs[0]; dsts[0] = P.Wd() + (alt ? (OFF_WD3 - OFF_WD) / 2 : 0) + (size_t)e * DM * DEXP; dsts[1] = dsts[0]; }
        f32x4 r[2][NLD]; f16x8 ar[2][2];
        const unsigned ldoff = (unsigned)(((tid / (NC / 4)) * N + (tid % (NC / 4)) * 4) * 4);
#define CV_LOAD(ti, slot) do { const int which_ = GATEUP ? (sel_ >= 0 ? sel_ : ((ti) & 1)) : 0, kt_ = (GATEUP && sel_ < 0) ? ((ti) >> 1) : (ti); const char* sp_ = (const char*)(srcs[which_] + (size_t)(kt_ * 128) * N + nbk * NC); \
            _Pragma("unroll") for (int p = 0; p < NLD; ++p) r[slot][p] = __builtin_nontemporal_load((const f32x4*)(sp_ + (size_t)p * (NTHR / (NC / 4)) * N * 4 + ldoff)); \
            if (CTX) { _Pragma("unroll") for (int p = 0; p < 2; ++p) ar[slot][p] = *(const f16x8*)(ap[p] + kt_ * 128); } } while (0)
#define CV_TILE(ti, slot) do { const int which = GATEUP ? (sel_ >= 0 ? sel_ : ((ti) & 1)) : 0, kt = (GATEUP && sel_ < 0) ? ((ti) >> 1) : (ti); \
            f16* tl = tile + (slot) * TW; f16* al = asl + (slot) * (64 * 128); \
            _Pragma("unroll") for (int p = 0; p < NLD; ++p) { const int id = tid + p * NTHR, kr = id / (NC / 4), c4 = (id % (NC / 4)) * 4; *(f16x4*)(tl + kr * TS + c4) = pk4(r[slot][p]); } \
            if (CTX) { _Pragma("unroll") for (int p = 0; p < 2; ++p) { const int row = (tid >> 4) + p * 32; *(f16x8*)(al + row * 128 + (((tid & 15) ^ (row & 15)) * 8)) = ar[slot][p]; } } \
            if ((ti) + 2 < ntr) CV_LOAD((ti) + 2, slot); \
            asm volatile("s_waitcnt lgkmcnt(0)" ::: "memory"); __builtin_amdgcn_s_barrier(); asm volatile("" ::: "memory"); \
            f16* dp = dsts[which] + (size_t)(nbk * NC + cb * 16 + r16) * K + kt * 128 + kq * 8; \
            _Pragma("unroll") for (int ks = 0; ks < 4; ++ks) { f16x8 bv; \
                _Pragma("unroll") for (int i = 0; i < 8; ++i) bv[i] = tl[(ks * 32 + kq * 8 + i) * TS + cb * 16 + r16]; \
                if (rb0 == 0) *(f16x8*)(dp + ks * 32) = rmw8(bv); \
                if (CTX) { _Pragma("unroll") for (int rb = 0; rb < NRB; ++rb) { const int row = (rb0 + rb) * 16 + r16; const f16x8 af = *(const f16x8*)(al + row * 128 + (((ks * 4 + kq) ^ r16) * 8)); \
                    acc[which][rb] = __builtin_amdgcn_mfma_f32_16x16x32_f16(bv, af, acc[which][rb], 0, 0, 0); } } } } while (0)
        CV_LOAD(0, 0); CV_LOAD(1, 1);
        for (int t2 = 0; t2 < ntr; t2 += 2) { CV_TILE(t2, 0); CV_TILE(t2 + 1, 1); }
#undef CV_LOAD
#undef CV_TILE
        asm volatile("s_waitcnt lgkmcnt(0)" ::: "memory"); __builtin_amdgcn_s_barrier(); asm volatile("" ::: "memory");
        if (CTX) {
#pragma unroll
            for (int rb = 0; rb < NRB; ++rb) {
                const size_t row = (size_t)e * SLOTS_PAD + 4096 + (rb0 + rb) * 16 + r16; const int col = nbk * NC + cb * 16 + 4 * kq;
                if (GATEUP) { f32x4 o;
#pragma unroll
                    for (int jj = 0; jj < 4; ++jj) o[jj] = silu_f(acc[0][rb][jj]) * acc[1][rb][jj];
                    *(f16x4*)(P.act() + row * DEXP + col) = pk4(o); }
                else *(f16x4*)(P.yslot() + row * DM + col) = pk4(acc[0][rb]);
            }
        }
    }
}

__device__ __forceinline__ void cvt3_job(const Params& P, int job, f16* tile) {
    if (job < 256) phase_cvt_ctx<false, false>(P, 3, job, 1 << 20, tile, -1, true);
    else { const int h = job - 256; phase_cvt_ctx<true, false>(P, 3, h >> 1, 1 << 20, tile, h & 1, true); }
}
__device__ __forceinline__ void phase_gateup_fast(const Params& P, LAS unsigned char* lds, int rt = 17, bool alt = false) { fg::PRGateUp S; S.H = P.H(); S.rowidx = P.rowidx(); S.W = P.Wgu() + (alt ? (OFF_WGU3 - OFF_WGU) / 2 : 0); S.act = P.act(); S.rt = rt; S.nunits = 16 * rt * 16; S.bid = opaque_bid(); fg::gemm_phase(lds, S, P.wv); }
__device__ __forceinline__ void phase_down_fast(const Params& P, LAS unsigned char* lds, int rt = 17, bool alt = false) { fg::PRDown S; S.act = P.act(); S.W = P.Wd() + (alt ? (OFF_WD3 - OFF_WD) / 2 : 0); S.y = P.yslot(); S.rt = rt; S.nunits = 16 * rt * 4; S.bid = opaque_bid(); fg::gemm_phase(lds, S, P.wv); }
__device__ __forceinline__ void phase_pool_fast(const Params& P, LAS unsigned char* lds) { fg::PRDense<256> S; S.qn = nullptr; S.kn = nullptr; S.rope = nullptr; S.xs = nullptr; S.lane = 0; S.npan = 130; S.kvx = 0; S.A = P.H(); S.W = P.Wmix(); S.O0 = P.Z(); S.O1 = nullptr; S.O2 = nullptr; S.ncol = 4; S.mode = 2; S.bid = opaque_bid(); fg::gemm_phase(lds, S, P.wv); }
__device__ __forceinline__ void phase_qkv_fast(const Params& P, LAS unsigned char* lds, bool lastl = false, int l = 1) { fg::PRDense<1024> S; S.qn = P.q_norm + (l >> 1) * 64; S.kn = P.k_norm + (l >> 1) * 64; S.rope = P.rope(); S.xs = (LAS float*)(lds + fg::STAGE_BYTES); S.lane = opaque_tid_(P.wv) & 63; S.npan = lastl ? 128 : 130; S.kvx = lastl ? 4 : 0; S.A = P.H(); S.W = P.Wmix(); S.O0 = P.Q(); S.O1 = P.Kb(); S.O2 = P.Vb(); S.ncol = 6; S.mode = 1; S.bid = opaque_bid(); fg::gemm_phase(lds, S, P.wv); }
__device__ __forceinline__ void phase_oproj_fast(const Params& P, LAS unsigned char* lds, bool lastl = false) { fg::PRDense<1024> S; S.qn = nullptr; S.kn = nullptr; S.rope = nullptr; S.xs = nullptr; S.lane = 0; S.npan = lastl ? 128 : 130; S.kvx = 0; S.A = P.O(); S.W = P.Wmix() + (size_t)QKVD * DM; S.O0 = P.Z(); S.O1 = nullptr; S.O2 = nullptr; S.ncol = 4; S.mode = 0; S.bid = opaque_bid(); fg::gemm_phase(lds, S, P.wv); }

typedef float f32x16 __attribute__((ext_vector_type(16)));
#define AT_KB 9216
#define AT_VB 8704
template <int VAR = 0>
__device__ __forceinline__ void phase_attn_fast(const Params& P, int l, LAS unsigned char* lds, bool do_ctx, int cvt_l = -1) {
    const int j = l >> 1;
    const int tid = opaque_tid(), wid = tid >> 6, lane = tid & 63, l32 = lane & 31, hi = lane >> 5;
    const int g = wid >> 1, qoff = (wid & 1) * 64, qoffu = (P.wv & 1) * 64;
    const int nunits = do_ctx ? 1040 : 1024;
    int ucount = 0;
    for (int u = opaque_bid(); u < nunits; u += gridDim.x, ++ucount) {
        int b, qblk, kv, qrow0, t0, t1, s0;
        if (u < 1024) { b = u >> 9; qblk = (u >> 2) & 127; kv = u & 3; s0 = b * SEQ; qrow0 = s0 + qblk * 128; t0 = qblk == 0 ? 2 : 0; t1 = qblk == 127 ? 4 : 6; }
        else { const int uu = u - 1024; b = uu >> 3; qblk = (uu >> 2) & 1; kv = uu & 3; s0 = NLAT + b * CTXL; qrow0 = s0 + qblk * 128; t0 = 0; t1 = 0; }
        const int cb = NLAT + b * CTXL, nloc = t1 - t0, ntiles = nloc + 4;
        const int h = kv * 4 + g;
        f16x8 Qf[2][4];
#pragma unroll
        for (int qb = 0; qb < 2; ++qb)
#pragma unroll
            for (int ks = 0; ks < 4; ++ks) Qf[qb][ks] = *(const f16x8*)(P.Q() + (size_t)(qrow0 + qoff + 32 * qb + l32) * 1024 + h * 64 + 16 * ks + 8 * hi);
        f32x16 OT[2][2];
#pragma unroll
        for (int db = 0; db < 2; ++db)
#pragma unroll
            for (int qb = 0; qb < 2; ++qb)
#pragma unroll
                for (int r = 0; r < 16; ++r) OT[db][qb][r] = 0.f;
        float mrun[2], lrun[2];
        { const float sk = P.sink[j * 16 + h] * 1.4426950408889634f; mrun[0] = sk; mrun[1] = sk; lrun[0] = hi == 0 ? 1.0f : 0.0f; lrun[1] = lrun[0]; }
        const int lkey = tid >> 3, lpc = tid & 7;
        f16x8 kreg, vreg;
        auto tile_row = [&](int it) -> int { return it < nloc ? (qrow0 - 128 + 64 * (t0 + it)) : (cb + 64 * (it - nloc)); };
        { const int kr = tile_row(0) + lkey; kreg = *(const f16x8*)(P.Kb() + (size_t)kr * 256 + kv * 64 + lpc * 8); vreg = *(const f16x8*)(P.Vb() + (size_t)kr * 256 + kv * 64 + lpc * 8); }
        __syncthreads();
        {
            LAS f16* Kl = (LAS f16*)(lds); LAS f16* Vl = (LAS f16*)(lds + 2 * AT_KB);
            *(LAS f16x8*)(Kl + lkey * 72 + lpc * 8) = kreg;
#pragma unroll
            for (int i = 0; i < 8; ++i) Vl[(lpc * 8 + i) * 68 + lkey] = vreg[i];
        }
        __syncthreads();
        for (int it = 0; it < ntiles; ++it) {
            const int buf = it & 1;
            if (it + 1 < ntiles) { const int kr = tile_row(it + 1) + lkey; kreg = *(const f16x8*)(P.Kb() + (size_t)kr * 256 + kv * 64 + lpc * 8); vreg = *(const f16x8*)(P.Vb() + (size_t)kr * 256 + kv * 64 + lpc * 8); }
            const LAS f16* Kl = (const LAS f16*)(lds + buf * AT_KB); const LAS f16* Vl = (const LAS f16*)(lds + 2 * AT_KB + buf * AT_VB);
            int cls = 0;
            if (it < nloc) { const int tl = t0 + it, dmin = qoffu + 65 - 64 * tl, dmax = qoffu + 191 - 64 * tl; cls = (dmin > 128 || dmax < -128) ? 2 : ((dmin >= -128 && dmax <= 128) ? 0 : 1); }
            if (cls != 2) {
            f32x16 S[2][2];
#pragma unroll
            for (int kb = 0; kb < 2; ++kb)
#pragma unroll
                for (int qb = 0; qb < 2; ++qb)
#pragma unroll
                    for (int r = 0; r < 16; ++r) S[kb][qb][r] = -mrun[qb];
#pragma unroll
            for (int ks = 0; ks < 4; ++ks)
#pragma unroll
                for (int kb = 0; kb < 2; ++kb) {
                    const f16x8 kf = *(const LAS f16x8*)(Kl + (32 * kb + l32) * 72 + 16 * ks + 8 * hi);
#pragma unroll
                    for (int qb = 0; qb < 2; ++qb) S[kb][qb] = __builtin_amdgcn_mfma_f32_32x32x16_f16(kf, Qf[qb][ks], S[kb][qb], 0, 0, 0);
                }
            if (cls == 1) {
                const int kt = 64 * (t0 + it);
#pragma unroll
                for (int qb = 0; qb < 2; ++qb) {
                    const int qp = 128 + qoff + 32 * qb + l32;
#pragma unroll
                    for (int kb = 0; kb < 2; ++kb)
#pragma unroll
                        for (int r = 0; r < 16; ++r) { const int kp = kt + 32 * kb + 8 * (r >> 2) + 4 * hi + (r & 3); const int d = qp - kp; if (d > 128 || d < -128) S[kb][qb][r] = -INFINITY; }
                }
            }
            f16x8 Pf[2][4];
#pragma unroll
            for (int qb = 0; qb < 2; ++qb) {
                float mx = S[0][qb][0];
#pragma unroll
                for (int kb = 0; kb < 2; ++kb)
#pragma unroll
                    for (int r = 0; r < 16; ++r) mx = fmaxf(mx, S[kb][qb][r]);
                { const auto sw = __builtin_amdgcn_permlane32_swap(__float_as_uint(mx), __float_as_uint(mx), false, false); mx = fmaxf(__uint_as_float(sw[0]), __uint_as_float(sw[1])); }
                if (__builtin_amdgcn_ballot_w64(mx > 8.0f) != 0ull) {
                    const float g = fmaxf(mx, 0.f), corr = __builtin_amdgcn_exp2f(-g);
                    mrun[qb] += g; lrun[qb] *= corr;
#pragma unroll
                    for (int kb = 0; kb < 2; ++kb)
#pragma unroll
                        for (int r = 0; r < 16; ++r) S[kb][qb][r] -= g;
#pragma unroll
                    for (int db = 0; db < 2; ++db)
#pragma unroll
                        for (int r = 0; r < 16; ++r) OT[db][qb][r] *= corr;
                }
                float ps = 0.f;
#pragma unroll
                for (int kb = 0; kb < 2; ++kb)
#pragma unroll
                    for (int r = 0; r < 16; ++r) { const float p = __builtin_amdgcn_exp2f(S[kb][qb][r]); S[kb][qb][r] = p; ps += p; }
                lrun[qb] += ps;
#pragma unroll
                for (int ks = 0; ks < 4; ++ks) { const int kb = ks >> 1, r0 = 8 * (ks & 1);
#pragma unroll
                    for (int e = 0; e < 8; ++e) Pf[qb][ks][e] = (f16)S[kb][qb][r0 + e]; }
            }
#pragma unroll
            for (int ks = 0; ks < 4; ++ks)
#pragma unroll
                for (int db = 0; db < 2; ++db) {
                    const LAS f16* vp = Vl + (32 * db + l32) * 68 + 16 * ks + 4 * hi;
                    const f16x4 v0 = *(const LAS f16x4*)vp, v1 = *(const LAS f16x4*)(vp + 8);
                    const f16x8 vf = (f16x8){v0[0], v0[1], v0[2], v0[3], v1[0], v1[1], v1[2], v1[3]};
#pragma unroll
                    for (int qb = 0; qb < 2; ++qb) OT[db][qb] = __builtin_amdgcn_mfma_f32_32x32x16_f16(vf, Pf[qb][ks], OT[db][qb], 0, 0, 0);
                }
            }
            if (it + 1 < ntiles) {
                LAS f16* Kw = (LAS f16*)(lds + (buf ^ 1) * AT_KB); LAS f16* Vw = (LAS f16*)(lds + 2 * AT_KB + (buf ^ 1) * AT_VB);
                *(LAS f16x8*)(Kw + lkey * 72 + lpc * 8) = kreg;
#pragma unroll
                for (int i = 0; i < 8; ++i) Vw[(lpc * 8 + i) * 68 + lkey] = vreg[i];
            }
            __syncthreads();
        }
#pragma unroll
        for (int qb = 0; qb < 2; ++qb) {
            const float lt = lrun[qb] + shx<32>(lrun[qb], lane);
            const float inv = 1.0f / lt;
            f16* op = P.O() + (size_t)(qrow0 + qoff + 32 * qb + l32) * 1024 + h * 64;
#pragma unroll
            for (int db = 0; db < 2; ++db)
#pragma unroll
                for (int i = 0; i < 4; ++i) {
                    const f16x4 o = (f16x4){(f16)(OT[db][qb][4 * i] * inv), (f16)(OT[db][qb][4 * i + 1] * inv), (f16)(OT[db][qb][4 * i + 2] * inv), (f16)(OT[db][qb][4 * i + 3] * inv)};
                    *(f16x4*)(op + 32 * db + 8 * i + 4 * hi) = rm4(o);
                }
        }
    }
}

#define MEGA_LDS (147456 + 16)
__device__ __forceinline__ const Params& opq(Params& q) { int z; asm volatile("s_mov_b32 %0, 0" : "=s"(z)); q.zoff = z; return q; }
__global__ __launch_bounds__(NTHR, 2) void mega(Params P) {
    extern __shared__ __attribute__((aligned(16))) unsigned char shm[];
    LAS unsigned char* lds = (LAS unsigned char*)shm;
    volatile LAS unsigned* st = (volatile LAS unsigned*)(lds + 147456);
    if (threadIdx.x == 0) { st[0] = 0u; st[1] = 0u; st[2] = 0u; st[3] = 0u; }
    __syncthreads();
    const XcdBarrier bar = xcd_barrier_post(P.bar(), st);
    const int nb = gridDim.x;
#define bid (opaque_bid())
    Params Q = P; Q.wv = __builtin_amdgcn_readfirstlane(threadIdx.x >> 6);
#define P (opq(Q))
    phase_ada(P, bid, nb, (float*)shm);
    __syncthreads();
    phase_convert(P, 0, bid, nb, (f16*)shm, false);
    xcd_barrier(bar);
    for (int l = 0; l < 4; ++l) {
        if (l == 0) phase_n1<true, false>(P, l, bid, nb); else { phase_n1<false, false>(P, l, bid, nb); __syncthreads(); phase_convert(P, l, bid, nb, (f16*)shm, false);
            }
        xcd_barrier(bar);
        if ((l & 1) == 0) {
            phase_pool_fast(P, lds);
            xcd_barrier(bar);
            phase_n2<true>(P, l, bid, nb, (float*)shm);
        } else {
            phase_qkv_fast(P, lds, l == 3, l);
            if (nb == 256 && (bid & 7) >= 2) { __syncthreads(); cvt3_job(P, (l == 1 ? 192 : 576) + ((bid & 7) - 2) * 32 + (bid >> 3), (f16*)shm); }
            xcd_barrier(bar);
            phase_attn_fast(P, l, lds, l != 3);
            if (l == 3 && nb != 256) { __syncthreads(); phase_cvt_ctx<true, false>(P, l, bid, nb, (f16*)shm, -1, true); phase_cvt_ctx<false, false>(P, l, bid, nb, (f16*)shm, -1, true); }
            xcd_barrier(bar);
            phase_oproj_fast(P, lds, l == 3);
            if (l == 1 && nb == 256 && (bid & 7) >= 2) { __syncthreads(); cvt3_job(P, 384 + ((bid & 7) - 2) * 32 + (bid >> 3), (f16*)shm); }
            xcd_barrier(bar);
            phase_n2<false>(P, l, bid, nb, (float*)shm, l == 3 ? NLAT : MROWS);
        }
        xcd_barrier(bar);
        phase_topk(P, bid, nb, (unsigned*)shm, l == 3 ? 32 : 64);
        if (l < 3 && nb == 256 && bid >= 64 && bid < 128) cvt3_job(P, l * 64 + bid - 64, (f16*)shm);
        xcd_barrier(bar);
        if (l < 3) { phase_cvt_ctx<true, true>(P, l, bid, nb, (f16*)shm); xcd_barrier(bar); }
        phase_gateup_fast(P, lds, 16, l == 3);
        if (l < 3) { __syncthreads(); phase_cvt_ctx<false, true>(P, l, bid, nb, (f16*)shm); }
        xcd_barrier(bar);
        phase_down_fast(P, lds, 16, l == 3);
        xcd_barrier(bar);
    }
    phase_n1<false, true>(P, 4, bid, nb);
#undef P
#undef bid
}

static inline size_t al256(size_t v) { return (v + 255) & ~(size_t)255; }

extern "C" void kernel_launch(void* const* d_in, const int* in_sizes, int n_in, void* d_out, int out_size, void* d_ws, size_t ws_size, hipStream_t stream) {
    Params P{};
    P.x = (const float*)d_in[0]; P.c = (const float*)d_in[1]; P.ctx = (const float*)d_in[2]; P.c_ctx = (const float*)d_in[3];
    P.w_ada = (const float*)d_in[4]; P.b_ada = (const float*)d_in[5]; P.norm1_g = (const float*)d_in[6]; P.norm2_g = (const float*)d_in[7];
    P.pool_w = (const float*)d_in[8]; P.pool_scale = (const float*)d_in[9]; P.w_qkv = (const float*)d_in[10]; P.w_o = (const float*)d_in[11];
    P.q_norm = (const float*)d_in[12]; P.k_norm = (const float*)d_in[13]; P.sink = (const float*)d_in[14]; P.router_w = (const float*)d_in[15];
    P.w_gate = (const float*)d_in[16]; P.w_up = (const float*)d_in[17]; P.w_down = (const float*)d_in[18];
    P.out = (float*)d_out;
    P.ws = (char*)d_ws; const size_t off = WS_TOTAL;
    if (off > ws_size) { fprintf(stderr, "workspace too small: need %zu have %zu\n", off, ws_size); return; }
    static int grid = 0;
    if (!grid) {
        int dev = 0, cus = 0, per_cu = 0;
        hipGetDevice(&dev);
        hipDeviceGetAttribute(&cus, hipDeviceAttributeMultiprocessorCount, dev);
        hipFuncSetAttribute((const void*)mega, hipFuncAttributeMaxDynamicSharedMemorySize, MEGA_LDS);
        hipOccupancyMaxActiveBlocksPerMultiprocessor(&per_cu, (const void*)mega, NTHR, MEGA_LDS);
        if (per_cu < 1) { fprintf(stderr, "mega: occupancy query says %d blocks per CU\n", per_cu); }
        grid = cus > 0 ? cus : 256;
    }
    hipMemsetAsync(P.bar(), 0, XCD_BAR_WORDS * sizeof(unsigned), stream);
    hipLaunchKernelGGL(mega, dim3(grid), dim3(NTHR), MEGA_LDS, stream, P);
}
```

```cpp
#include <hip/hip_runtime.h>
#include <stdint.h>
#include <stdio.h>

typedef _Float16 f16;
typedef _Float16 f16x2 __attribute__((ext_vector_type(2)));
typedef _Float16 f16x4 __attribute__((ext_vector_type(4)));
typedef _Float16 f16x8 __attribute__((ext_vector_type(8)));
typedef float f32x4 __attribute__((ext_vector_type(4)));
typedef float f32x2 __attribute__((ext_vector_type(2)));
typedef unsigned u32x2 __attribute__((ext_vector_type(2)));
typedef unsigned u32x4 __attribute__((ext_vector_type(4)));
#define RM_BITS 5
#define RM_ADD (0x00010001u << (RM_BITS - 1))
#define RM_MASK (~(0x00010001u * ((1u << RM_BITS) - 1u)))
__device__ __forceinline__ f16x4 rm4(f16x4 v) { u32x2 b = __builtin_bit_cast(u32x2, v); b = (b + RM_ADD) & RM_MASK; return __builtin_bit_cast(f16x4, b); }
__device__ __forceinline__ f16x8 rm8(f16x8 v) { u32x4 b = __builtin_bit_cast(u32x4, v); b = (b + RM_ADD) & RM_MASK; return __builtin_bit_cast(f16x8, b); }
#define RMW_BITS 5
__device__ __forceinline__ f16x8 rmw8(f16x8 v) { u32x4 b = __builtin_bit_cast(u32x4, v); b = (b + (0x00010001u << (RMW_BITS - 1))) & ~(0x00010001u * ((1u << RMW_BITS) - 1u)); return __builtin_bit_cast(f16x8, b); }

#define LAS __attribute__((address_space(3)))
#define DM 1024
#define SEQ 16384
#define NLAT 32768
#define CTXL 256
#define NCTX 512
#define MROWS 33280
#define NEXP 16
#define DEXP 2048
#define SLOTS 4160
#define SLOTS_PAD 4352
#define QKVD 1536
#define NTHR 512

constexpr size_t al256c(size_t v) { return (v + 255) & ~(size_t)255; }
constexpr size_t OFF_BAR = 0;
constexpr size_t OFF_MOD = al256c(OFF_BAR + 16384);
constexpr size_t OFF_ROPE = al256c(OFF_MOD + (size_t)4 * 3 * 6 * DM * 4);
constexpr size_t OFF_X = al256c(OFF_ROPE + (size_t)256 * 16 * 2 * 4);
constexpr size_t OFF_H = al256c(OFF_X + (size_t)MROWS * DM * 4);
constexpr size_t OFF_Z = al256c(OFF_H + (size_t)MROWS * DM * 2);
constexpr size_t OFF_Q = al256c(OFF_Z + (size_t)MROWS * DM * 2);
constexpr size_t OFF_KB = al256c(OFF_Q + (size_t)MROWS * DM * 2);
constexpr size_t OFF_VB = al256c(OFF_KB + (size_t)MROWS * 256 * 2);
constexpr size_t OFF_VT = al256c(OFF_VB + (size_t)MROWS * 256 * 2);
constexpr size_t OFF_O = al256c(OFF_VT + (size_t)MROWS * 256 * 2);
constexpr size_t OFF_AFF = al256c(OFF_O + (size_t)MROWS * DM * 2);
constexpr size_t OFF_INV = al256c(OFF_AFF + (size_t)MROWS * 16 * 4);
constexpr size_t OFF_ROWIDX = al256c(OFF_INV + (size_t)MROWS * 16 * 4);
constexpr size_t OFF_ACT = al256c(OFF_ROWIDX + (size_t)NEXP * SLOTS_PAD * 4);
constexpr size_t OFF_YSLOT = al256c(OFF_ACT + (size_t)NEXP * SLOTS_PAD * DEXP * 2);
constexpr size_t OFF_WGU = al256c(OFF_YSLOT + (size_t)NEXP * SLOTS_PAD * DM * 2);
constexpr size_t OFF_WD = al256c(OFF_WGU + (size_t)NEXP * 2 * DEXP * DM * 2);
constexpr size_t OFF_WMIX = al256c(OFF_WD + (size_t)NEXP * DM * DEXP * 2);
constexpr size_t OFF_WGU3 = al256c(OFF_WMIX + (size_t)(QKVD + DM) * DM * 2);
constexpr size_t OFF_WD3 = al256c(OFF_WGU3 + (size_t)NEXP * 2 * DEXP * DM * 2);
constexpr size_t OFF_DUMMY = al256c(OFF_WD3 + (size_t)NEXP * DM * DEXP * 2);
constexpr size_t WS_TOTAL = OFF_DUMMY;
struct Params {
    const float *x, *c, *ctx, *c_ctx, *w_ada, *b_ada, *norm1_g, *norm2_g, *pool_w, *pool_scale, *w_qkv, *w_o, *q_norm, *k_norm, *sink, *router_w, *w_gate, *w_up, *w_down;
    float* out; char* ws; int wv; int zoff;
#define WSF(name, type, off) __host__ __device__ __forceinline__ type* name() const { return (type*)(ws + zoff + (off)); }
    WSF(bar, unsigned, OFF_BAR) WSF(mod, float, OFF_MOD) WSF(rope, float, OFF_ROPE) WSF(X, f16, OFF_X) WSF(H, f16, OFF_H) WSF(Z, f16, OFF_Z) WSF(Q, f16, OFF_Q) WSF(Kb, f16, OFF_KB) WSF(Vb, f16, OFF_VB) WSF(Vt, f16, OFF_VT)
    WSF(O, f16, OFF_O) WSF(aff, float, OFF_AFF) WSF(inv, int, OFF_INV) WSF(rowidx, int, OFF_ROWIDX) WSF(act, f16, OFF_ACT) WSF(yslot, f16, OFF_YSLOT) WSF(Wgu, f16, OFF_WGU) WSF(Wd, f16, OFF_WD) WSF(Wmix, f16, OFF_WMIX)
#undef WSF
#define WSW(name, type, off) __host__ __device__ __forceinline__ type* name() const { return (type*)(ws + zoff + (off)); }
    WSW(Xw, f16, OFF_X) WSW(Ow, f16, OFF_O) WSW(Hw, f16, OFF_H) WSW(affw, float, OFF_AFF) WSW(Qw, f16, OFF_Q) WSW(Kw, f16, OFF_KB)
#undef WSW
};

template <int O> __device__ __forceinline__ float shx(float v, int lane) {
    if (O == 1) return __int_as_float(__builtin_amdgcn_update_dpp(0, __float_as_int(v), 0xB1, 0xF, 0xF, true));
    if (O == 2) return __int_as_float(__builtin_amdgcn_update_dpp(0, __float_as_int(v), 0x4E, 0xF, 0xF, true));
    if (O < 32) return __int_as_float(__builtin_amdgcn_ds_swizzle(__float_as_int(v), (O << 10) | 0x1f));
    return __int_as_float(__builtin_amdgcn_ds_bpermute((lane ^ O) << 2, __float_as_int(v)));
}
__device__ __forceinline__ float wave_sum(float v, int lane) {
    v += shx<1>(v, lane); v += shx<2>(v, lane); v += shx<4>(v, lane); v += shx<8>(v, lane); v += shx<16>(v, lane); v += shx<32>(v, lane);
    return v;
}
__device__ __forceinline__ unsigned shup(unsigned v, int o, int lane) { return (unsigned)__builtin_amdgcn_ds_bpermute((lane - o) << 2, (int)v); }
__device__ __forceinline__ int opaque_bid() { int b = blockIdx.x; asm volatile("" : "+s"(b)); return b; }
#define opaque_tid() opaque_tid_(P.wv)
__device__ __forceinline__ int opaque_tid_(int wv) { int ln; asm volatile("v_mbcnt_lo_u32_b32 %0, -1, 0\n\tv_mbcnt_hi_u32_b32 %0, -1, %0" : "=v"(ln)); return (wv << 6) | ln; }
__device__ __forceinline__ float silu_f(float v) { return v * __builtin_amdgcn_rcpf(1.0f + __expf(-v)); }

__device__ __forceinline__ const float* modp(const Params& P, int l, int v, int j) { return P.mod() + (size_t)((l * 3 + v) * 6 + j) * DM; }

__device__ __forceinline__ void phase_ada(const Params& P, int bid, int nb, float* lds, int l0 = 0, int nl = 4, bool do_rope = true) {
    float* sc = lds; float* red = lds + 3 * DM;
    const int tid = opaque_tid();
    for (int i = tid; i < 3 * DM; i += NTHR) { const int v = i >> 10, k = i & 1023; const float cv = v < 2 ? P.c[v * DM + k] : P.c_ctx[k]; sc[i] = silu_f(cv); }
    __syncthreads();
    for (int u = bid; u < nl * 96; u += nb) {
        const int l = l0 + u / 96, ch = u % 96, c4 = tid & 15, kg = tid >> 4;
        const float* w = P.w_ada + (size_t)l * DM * 6 * DM + ch * 64 + c4 * 4;
        f32x4 s0 = (f32x4){0.f, 0.f, 0.f, 0.f}, s1 = s0, s2 = s0;
#pragma unroll 8
        for (int i = 0; i < 32; ++i) { const int k = kg * 32 + i; const f32x4 wv = __builtin_nontemporal_load((const f32x4*)(w + (size_t)k * 6 * DM)); s0 += sc[k] * wv; s1 += sc[DM + k] * wv; s2 += sc[2 * DM + k] * wv; }
        *(f32x4*)(red + (kg * 3 + 0) * 64 + c4 * 4) = s0; *(f32x4*)(red + (kg * 3 + 1) * 64 + c4 * 4) = s1; *(f32x4*)(red + (kg * 3 + 2) * 64 + c4 * 4) = s2;
        __syncthreads();
        if (tid < 192) { const int v = tid >> 6, cc = tid & 63; float s = 0.f;
#pragma unroll
            for (int q = 0; q < 32; ++q) s += red[(q * 3 + v) * 64 + cc];
            const int colg = ch * 64 + cc; s += P.b_ada[l * 6 * DM + colg];
            const int j = colg >> 10, d = colg & 1023;
            P.mod()[(size_t)((l * 3 + v) * 6 + j) * DM + d] = s; }
        __syncthreads();
    }
    if (do_rope) for (int i = bid * NTHR + tid; i < 256 * 16; i += nb * NTHR) {
        const int p = i >> 4, f = i & 15;
        const float inv = powf(10000.0f, -(float)f / 16.0f);
        const float angf = (float)p * inv;
        double a = (double)angf;
        const double twopi = 6.283185307179586476925286766559;
        a -= twopi * rint(a / twopi);
        const double a2 = a * a;
        double cs = 1.0, sn = 1.0;
        double tc = 0.0, ts = 0.0;
        for (int n = 16; n >= 1; --n) { tc = (tc + 1.0) * (-a2 / (double)((2 * n - 1) * (2 * n))); ts = (ts + 1.0) * (-a2 / (double)((2 * n) * (2 * n + 1))); }
        cs = 1.0 + tc; sn = a * (1.0 + ts);
        P.rope()[i * 2] = (float)cs; P.rope()[i * 2 + 1] = (float)sn;
    }
}

__device__ __forceinline__ f32x4 cvt4(const f16x4 v) { return (f32x4){(float)v[0], (float)v[1], (float)v[2], (float)v[3]}; }
__device__ __forceinline__ f16x4 pk4(const f32x4 v) { return (f16x4){(f16)v[0], (f16)v[1], (f16)v[2], (f16)v[3]}; }
__device__ __forceinline__ float dot4(const f32x4 a, const f32x4 b) { return a[0] * b[0] + a[1] * b[1] + a[2] * b[2] + a[3] * b[3]; }
template <bool FIRST, bool FINAL>
__device__ __forceinline__ void phase_n1(const Params& P, int l, int bid, int nb) {
    constexpr int R = 4;
    const int tid_ = opaque_tid(); const int wid = P.wv, lane = tid_ & 63;
    const int nrows = FINAL ? NLAT : MROWS;
    for (int rb = (bid * 8 + wid) * R; rb < nrows; rb += nb * 8 * R) {
        const int v = rb < NLAT ? (rb >> 14) : 2;
        f32x4 xv[R][4];
#pragma unroll
        for (int u = 0; u < R; ++u) {
            const int r = rb + u;
            if (FIRST) { const float* src = r < NLAT ? P.x + (size_t)r * DM : P.ctx + (size_t)(r - NLAT) * DM;
#pragma unroll
                for (int q = 0; q < 4; ++q) xv[u][q] = __builtin_nontemporal_load((const f32x4*)(src + q * 256 + lane * 4)); }
            else { const f16* src = P.X() + (size_t)r * DM;
#pragma unroll
                for (int q = 0; q < 4; ++q) xv[u][q] = cvt4(*(const f16x4*)(src + q * 256 + lane * 4)); }
        }
        if (!FIRST) {
            const int sl = P.inv()[(size_t)(lane & 15) * MROWS + rb + (lane >> 4)];
            const float af = P.aff()[(size_t)(lane & 15) * MROWS + rb + (lane >> 4)];
            const unsigned long long bal = __builtin_amdgcn_ballot_w64(sl >= 0);
            unsigned m[R];
#pragma unroll
            for (int u = 0; u < R; ++u) m[u] = (unsigned)(bal >> (16 * u)) & 0xffffu;
            const f16* ys = P.yslot();
            const float* g2 = modp(P, l - 1, v, 5);
            f32x4 gv[4];
#pragma unroll
            for (int q = 0; q < 4; ++q) gv[q] = *(const f32x4*)(g2 + q * 256 + lane * 4);
            while (m[0] | m[1] | m[2] | m[3]) {
                f16x4 yv[R][4]; float w[R];
#pragma unroll
                for (int u = 0; u < R; ++u) {
                    const int e = m[u] ? __builtin_ctz(m[u]) : 0;
                    const int sv = m[u] ? __builtin_amdgcn_readlane(sl, 16 * u + e) : 0;
                    w[u] = m[u] ? __int_as_float(__builtin_amdgcn_readlane(__float_as_int(af), 16 * u + e)) : 0.f;
                    m[u] &= m[u] - 1u;
                    const f16* y = ys + ((size_t)e * SLOTS_PAD + sv) * DM + lane * 4;
#pragma unroll
                    for (int q = 0; q < 4; ++q) yv[u][q] = *(const f16x4*)(y + q * 256);
                }
#pragma unroll
                for (int u = 0; u < R; ++u)
#pragma unroll
                    for (int q = 0; q < 4; ++q) xv[u][q] += (w[u] * gv[q]) * cvt4(yv[u][q]);
            }
        }
        if (FINAL) {
#pragma unroll
            for (int u = 0; u < R; ++u)
#pragma unroll
                for (int q = 0; q < 4; ++q) __builtin_nontemporal_store(xv[u][q], (f32x4*)(P.out + (size_t)(rb + u) * DM + q * 256 + lane * 4));
            continue;
        }
        float ss[R];
#pragma unroll
        for (int u = 0; u < R; ++u) {
            f16* xd = P.Xw() + (size_t)(rb + u) * DM; float sacc = 0.f;
#pragma unroll
            for (int q = 0; q < 4; ++q) { *(f16x4*)(xd + q * 256 + lane * 4) = pk4(xv[u][q]); sacc += dot4(xv[u][q], xv[u][q]); }
            ss[u] = sacc;
        }
#pragma unroll
        for (int u = 0; u < R; ++u) ss[u] = rsqrtf(wave_sum(ss[u], lane) * (1.0f / DM) + 1e-6f);
        const float* g = P.norm1_g + l * DM; const float* sh = modp(P, l, v, 0); const float* scl = modp(P, l, v, 1);
#pragma unroll
        for (int q = 0; q < 4; ++q) {
            const int c0 = q * 256 + lane * 4;
            const f32x4 gq = *(const f32x4*)(g + c0), sq = *(const f32x4*)(sh + c0), cq = *(const f32x4*)(scl + c0);
            const f32x4 gm = gq * (1.0f + cq);
#pragma unroll
            for (int u = 0; u < R; ++u) *(f16x4*)(P.Hw() + (size_t)(rb + u) * DM + c0) = rm4(pk4(xv[u][q] * ss[u] * gm + sq));
        }
    }
}

#define N2_ZST 81920
template <bool POOL>
__device__ __forceinline__ void phase_n2(const Params& P, int l, int bid, int nb, float* lds, int nrows = MROWS) {
    const int tid = opaque_tid(), wid = P.wv, lane = tid & 63;
    const float* wr = P.router_w + (size_t)l * DM * NEXP;
    f16* wh = (f16*)lds;
    for (int i = tid; i < DM * NEXP; i += NTHR) { const int d = i >> 4, e = i & 15; wh[e * 1032 + d] = (f16)wr[i]; }
    f16* h2s = (f16*)lds + 16640;
    LAS unsigned char* zst = (LAS unsigned char*)lds + N2_ZST;
    const int j = l >> 1, nblk = nrows >> 4;
    const f16* Zg = P.Z();
    const f16* Xg = P.X();
    f16x4 xr[2][4]; f16x4 zr[2][4];
    auto prefetch = [&](int blk) {
        const int R0 = blk * 16, rb = R0 + wid * 2;
        if (POOL) {
            int s0, L; if (R0 < NLAT) { s0 = (R0 >> 14) << 14; L = SEQ; } else { s0 = NLAT + (((R0 - NLAT) >> 8) << 8); L = CTXL; }
#pragma unroll
            for (int i = 0; i < 8; ++i) { const int piece = wid * 8 + i; int rr = R0 - 8 + (piece >> 1); rr = rr < s0 ? s0 : (rr > s0 + L - 1 ? s0 + L - 1 : rr);
                __builtin_amdgcn_global_load_lds((const unsigned*)(Zg + (size_t)rr * DM + (piece & 1) * 512 + lane * 8), (LAS unsigned*)(zst + piece * 1024), 16, 0, 0); }
        } else {
#pragma unroll
            for (int u = 0; u < 2; ++u)
#pragma unroll
                for (int q = 0; q < 4; ++q) zr[u][q] = *(const f16x4*)(Zg + (size_t)(rb + u) * DM + q * 256 + lane * 4);
        }
#pragma unroll
        for (int u = 0; u < 2; ++u)
#pragma unroll
            for (int q = 0; q < 4; ++q) xr[u][q] = *(const f16x4*)(Xg + (size_t)(rb + u) * DM + q * 256 + lane * 4);
    };
    int blk = bid;
    if (blk < nblk) prefetch(blk);
    __syncthreads();
    while (blk < nblk) {
        const int R0 = blk * 16, rb = R0 + wid * 2;
        int v, s0, L;
        if (rb < NLAT) { v = rb >> 14; s0 = v << 14; L = SEQ; } else { v = 2; s0 = NLAT + (((rb - NLAT) >> 8) << 8); L = CTXL; }
        const int t = rb - s0;
        if (POOL) asm volatile("s_waitcnt vmcnt(16)" ::: "memory");
        f32x4 g1v[4], gmv[4], shv[4], psv[4];
        { const float* g1 = modp(P, l, v, 2); const float* g = P.norm2_g + l * DM; const float* sh = modp(P, l, v, 3); const float* scl = modp(P, l, v, 4);
#pragma unroll
            for (int q = 0; q < 4; ++q) { const int c0 = q * 256 + lane * 4;
                g1v[q] = *(const f32x4*)(g1 + c0); const f32x4 gv = *(const f32x4*)(g + c0), cv = *(const f32x4*)(scl + c0); shv[q] = *(const f32x4*)(sh + c0); gmv[q] = gv * (1.0f + cv);
                if (POOL) psv[q] = *(const f32x4*)(P.pool_scale + j * DM + c0); } }
        f32x4 y[2][4];
        if (POOL) {
            asm volatile("s_waitcnt lgkmcnt(0)" ::: "memory"); __builtin_amdgcn_s_barrier(); asm volatile("" ::: "memory");
            if (t >= 8 && t + 9 < L) {
#pragma unroll
                for (int q = 0; q < 4; ++q) {
                    const int h = 1 << q;
                    const LAS f16* zb = (const LAS f16*)zst + q * 256 + lane * 4 + (2 * wid + 8) * DM;
#define ZROW(d) (*(const LAS f16x4*)(zb + (d) * DM))
                    const f32x4 z0 = cvt4(ZROW(-h)), z1 = cvt4(ZROW(h)), own0 = cvt4(ZROW(0)), own1 = (h == 1) ? z1 : cvt4(ZROW(1));
                    f32x4 common = (f32x4){0.f, 0.f, 0.f, 0.f};
#pragma unroll
                    for (int d = -h + 1; d + 1 <= h - 1; d += 2) { const f16x4 pr = ZROW(d) + ZROW(d + 1); common += cvt4(pr); }
                    common += cvt4(ZROW(h - 1));
#undef ZROW
                    const float inv = 0.5f / (float)h;
                    y[0][q] = ((common + z0) * inv - own0) * psv[q];
                    y[1][q] = ((common + z1) * inv - own1) * psv[q];
                }
            } else {
#pragma unroll
            for (int q = 0; q < 4; ++q) {
                const int h = 1 << q;
                const LAS f16* zb = (const LAS f16*)zst + q * 256 + lane * 4;
                f32x4 common = (f32x4){0.f, 0.f, 0.f, 0.f}, z0 = common, z1 = common;
#pragma unroll
                for (int d = -h; d <= h; ++d) {
                    const int tt = t + d; const bool ok = tt >= 0 && tt < L;
                    f32x4 zz = cvt4(*(const LAS f16x4*)(zb + (2 * wid + 8 + d) * DM));
                    if (!ok) zz = (f32x4){0.f, 0.f, 0.f, 0.f};
                    if (d == -h) z0 = zz; else if (d == h) z1 = zz; else common += zz;
                    if (d == 0) y[0][q] = zz;
                    if (d == 1) y[1][q] = zz;
                }
                const int c0n = min(t + h, L) - max(t - h, 0), c1n = min(t + 1 + h, L) - max(t + 1 - h, 0);
                y[0][q] = ((common + z0) * (1.0f / (float)c0n) - y[0][q]) * psv[q];
                y[1][q] = ((common + z1) * (1.0f / (float)c1n) - y[1][q]) * psv[q];
            }
            }
            asm volatile("s_waitcnt lgkmcnt(0)" ::: "memory"); __builtin_amdgcn_s_barrier(); asm volatile("" ::: "memory");
        } else {
#pragma unroll
            for (int u = 0; u < 2; ++u)
#pragma unroll
                for (int q = 0; q < 4; ++q) y[u][q] = cvt4(zr[u][q]);
        }
        f32x4 xv[2][4]; float ss[2] = {0.f, 0.f};
#pragma unroll
        for (int q = 0; q < 4; ++q) {
#pragma unroll
            for (int u = 0; u < 2; ++u) { xv[u][q] = cvt4(xr[u][q]) + g1v[q] * y[u][q]; ss[u] += dot4(xv[u][q], xv[u][q]); }
        }
        const int nxt = blk + nb;
        asm volatile("" ::: "memory");
        if (nxt < nblk) prefetch(nxt);
#pragma unroll
        for (int u = 0; u < 2; ++u)
#pragma unroll
            for (int q = 0; q < 4; ++q) *(f16x4*)(P.Xw() + (size_t)(rb + u) * DM + q * 256 + lane * 4) = pk4(xv[u][q]);
        ss[0] = wave_sum(ss[0], lane); ss[1] = wave_sum(ss[1], lane);
        const float rs[2] = {rsqrtf(ss[0] * (1.0f / DM) + 1e-6f), rsqrtf(ss[1] * (1.0f / DM) + 1e-6f)};
        f16x4 h2h[2][4];
#pragma unroll
        for (int q = 0; q < 4; ++q) {
            const int c0 = q * 256 + lane * 4;
#pragma unroll
            for (int u = 0; u < 2; ++u) { h2h[u][q] = pk4(xv[u][q] * rs[u] * gmv[q] + shv[q]); *(f16x4*)(P.Hw() + (size_t)(rb + u) * DM + c0) = rm4(h2h[u][q]); }
        }
        asm volatile("s_waitcnt lgkmcnt(0)" ::: "memory"); __builtin_amdgcn_s_barrier(); asm volatile("" ::: "memory");
#pragma unroll
        for (int q = 0; q < 4; ++q)
#pragma unroll
            for (int u = 0; u < 2; ++u) *(f16x4*)(h2s + (2 * wid + u) * 1032 + q * 256 + lane * 4) = h2h[u][q];
        asm volatile("s_waitcnt lgkmcnt(0)" ::: "memory"); __builtin_amdgcn_s_barrier(); asm volatile("" ::: "memory");
        {
            const int r16 = lane & 15, kq = lane >> 4;
            f32x4 pl = (f32x4){0.f, 0.f, 0.f, 0.f};
#pragma unroll
            for (int ks = 0; ks < 4; ++ks) {
                const f16x8 av = *(const f16x8*)(h2s + r16 * 1032 + wid * 128 + ks * 32 + kq * 8), bv = *(const f16x8*)(wh + r16 * 1032 + wid * 128 + ks * 32 + kq * 8);
                pl = __builtin_amdgcn_mfma_f32_16x16x32_f16(av, bv, pl, 0, 0, 0);
            }
            *(f32x4*)(lds + 16640 + (wid * 64 + lane) * 4) = pl;
            asm volatile("s_waitcnt lgkmcnt(0)" ::: "memory"); __builtin_amdgcn_s_barrier(); asm volatile("" ::: "memory");
        }
        if (wid == 0) {
            const int r16 = lane & 15, kq = lane >> 4;
            f32x4 lg = (f32x4){0.f, 0.f, 0.f, 0.f};
#pragma unroll
            for (int w = 0; w < 8; ++w) lg += *(const f32x4*)(lds + 16640 + (w * 64 + lane) * 4);
#pragma unroll
            for (int jj = 0; jj < 4; ++jj) {
                float mx = lg[jj];
                mx = fmaxf(mx, shx<1>(mx, lane)); mx = fmaxf(mx, shx<2>(mx, lane)); mx = fmaxf(mx, shx<4>(mx, lane)); mx = fmaxf(mx, shx<8>(mx, lane));
                const float pe = __expf(lg[jj] - mx);
                float den = pe;
                den += shx<1>(den, lane); den += shx<2>(den, lane); den += shx<4>(den, lane); den += shx<8>(den, lane);
                P.affw()[(size_t)r16 * MROWS + R0 + 4 * kq + jj] = pe * __builtin_amdgcn_rcpf(den);
            }
        }
        blk = nxt;
    }
}

__device__ __forceinline__ void phase_topk(const Params& P, int bid, int nb, unsigned* lds, int nprob = 64) {
    unsigned* hist = lds; unsigned* misc = lds + 256; unsigned* wsa = lds + 272; unsigned* wsb = lds + 288;
    const int tid = opaque_tid(), wid = tid >> 6, lane = tid & 63;
    for (int p = bid; p < nprob; p += nb) {
        const int set = p >> 4, e = p & 15;
        const int n = set < 2 ? SEQ : CTXL, C = n >> 3;
        const int r0 = set < 2 ? set * SEQ : NLAT + (set - 2) * CTXL;
        const int slot0 = set < 2 ? set * 2048 : 4096 + (set - 2) * 32;
        unsigned key[32];
#pragma unroll
        for (int i4 = 0; i4 < 8; ++i4) { const int idx = tid * 32 + i4 * 4;
            f32x4 v = (f32x4){0.f, 0.f, 0.f, 0.f}; if (idx < n) v = *(const f32x4*)(P.aff() + (size_t)e * MROWS + r0 + idx);
#pragma unroll
            for (int jj = 0; jj < 4; ++jj) key[i4 * 4 + jj] = idx < n ? (__float_as_uint(v[jj]) + 1u) : 0u; }
        unsigned T = 0u;
        for (int bit = 29; bit >= 0; --bit) {
            const unsigned cand = T | (1u << bit);
            unsigned wc = 0u;
#pragma unroll
            for (int i = 0; i < 32; ++i) wc += (unsigned)__builtin_popcountll(__builtin_amdgcn_ballot_w64(key[i] >= cand));
            unsigned* cb = misc + ((bit & 1) << 3);
            if (lane == 0) cb[wid] = wc;
            __syncthreads();
            unsigned tot = 0u;
#pragma unroll
            for (int w = 0; w < 8; ++w) tot += cb[w];
            if (tot >= (unsigned)C) T = cand;
            if (tot == (unsigned)C) { T = cand - 1u; break; }
        }
        unsigned cg = 0u, ce = 0u;
#pragma unroll
        for (int i = 0; i < 32; ++i) { cg += key[i] > T ? 1u : 0u; ce += key[i] == T ? 1u : 0u; }
        unsigned ig = cg, ie = ce;
#pragma unroll
        for (int o = 1; o < 64; o <<= 1) { const unsigned a = shup(ig, o, lane), b = shup(ie, o, lane); if (lane >= o) { ig += a; ie += b; } }
        if (lane == 63) { wsa[wid] = ig; wsb[wid] = ie; }
        __syncthreads();
        unsigned bg = 0u, be = 0u, totg = 0u;
#pragma unroll
        for (int w = 0; w < 8; ++w) { const unsigned ga = wsa[w]; totg += ga; if (w < wid) { bg += ga; be += wsb[w]; } }
        const unsigned krem = (unsigned)C - totg;
        unsigned pg = bg + ig - cg, pe = be + ie - ce;
#pragma unroll
        for (int i4 = 0; i4 < 8; ++i4) {
            int iv[4];
#pragma unroll
            for (int jj = 0; jj < 4; ++jj) {
                const int i = i4 * 4 + jj, idx = tid * 32 + i;
                bool sel = false; unsigned rank = 0u;
                if (key[i] > T) { sel = true; rank = pg + (pe < krem ? pe : krem); ++pg; }
                else if (key[i] == T && key[i] != 0u) { if (pe < krem) { sel = true; rank = pg + pe; } ++pe; }
                if (sel) P.rowidx()[e * SLOTS_PAD + slot0 + (int)rank] = r0 + idx;
                iv[jj] = sel ? slot0 + (int)rank : -1;
            }
            if (tid * 32 + i4 * 4 < n) *(int4*)(P.inv() + (size_t)e * MROWS + r0 + tid * 32 + i4 * 4) = make_int4(iv[0], iv[1], iv[2], iv[3]);
        }
        if (set == 3) for (int i = SLOTS + tid; i < SLOTS_PAD; i += NTHR) P.rowidx()[e * SLOTS_PAD + i] = 0;
        __syncthreads();
    }
}

#define XB_TMO      128
#define XB_XCNT(j)  (256  + 64 * (j))
#define XB_XSUB(j)  (1280 + 64 * (j))
#define XB_XGEN(j)  (2304 + 64 * (j))
#define XB_TOP      3328
#define XB_TOPGEN   3392
#define XCD_BAR_WORDS 3456
#define XB_SPIN_CAP (1u << 18)
__device__ __forceinline__ unsigned xb_ld(unsigned* p)              { return __hip_atomic_load(p, __ATOMIC_RELAXED, __HIP_MEMORY_SCOPE_AGENT); }
__device__ __forceinline__ unsigned xb_add(unsigned* p, unsigned v) { return __hip_atomic_fetch_add(p, v, __ATOMIC_RELAXED, __HIP_MEMORY_SCOPE_AGENT); }
__device__ __forceinline__ unsigned xb_xcc_id() { return (unsigned)__builtin_amdgcn_s_getreg((3 << 11) | 20) & 0xFu; }
#define XB_SPIN(cond, bar) do { unsigned _sp = 0; while (cond) { __builtin_amdgcn_s_sleep(1); \
    if ((++_sp & 255u) == 0u) { if (xb_ld(&(bar)[XB_TMO])) break; if (_sp > XB_SPIN_CAP) { atomicAdd(&(bar)[XB_TMO], 1u); break; } } } } while (0)
struct XcdBarrier { unsigned* bar; unsigned x; volatile LAS unsigned* st; };
__device__ __forceinline__ XcdBarrier xcd_barrier_post(unsigned* bar, volatile LAS unsigned* st) {
    XcdBarrier b; b.bar = bar; b.x = xb_xcc_id(); b.st = st;
    if (threadIdx.x == 0) (void)xb_add(&bar[XB_XCNT(b.x)], 1u);
    return b;
}
__device__ __forceinline__ void xcd_barrier_complete(unsigned* bar, unsigned x, unsigned& nloc, unsigned& nx) {
    const unsigned G = gridDim.x * gridDim.y * gridDim.z;
    unsigned sum, cnt, mine, sp = 0u;
    for (;;) {
        sum = 0u; cnt = 0u; mine = 0u;
#pragma unroll
        for (unsigned j = 0; j < 16; ++j) { const unsigned c = xb_ld(&bar[XB_XCNT(j)]); sum += c; cnt += (c > 0u) ? 1u : 0u; mine = (j == x) ? c : mine; }
        if (sum == G) break;
        __builtin_amdgcn_s_sleep(1);
        if ((++sp & 255u) == 0u) { if (xb_ld(&bar[XB_TMO])) break; if (sp > XB_SPIN_CAP) { atomicAdd(&bar[XB_TMO], 1u); break; } }
    }
    nloc = mine > 0u ? mine : 1u; nx = cnt > 0u ? cnt : 1u;
}
__device__ __forceinline__ void xcd_barrier(const XcdBarrier& b) {
    asm volatile("s_waitcnt vmcnt(0)" ::: "memory");
    __syncthreads();
    if (threadIdx.x == 0) {
        unsigned* bar = b.bar; asm volatile("" : "+s"(bar));
        const unsigned bx = (unsigned)__builtin_amdgcn_readfirstlane((int)xb_xcc_id());
        __builtin_amdgcn_s_waitcnt(0);
        unsigned nloc = b.st[0], nx = b.st[1];
        if (nloc == 0u) { xcd_barrier_complete(bar, bx, nloc, nx); b.st[0] = nloc; b.st[1] = nx; }
        const unsigned old = xb_add(&bar[XB_XSUB(bx)], 1u);
        const unsigned gen = old / nloc;
        if (old + 1u == (gen + 1u) * nloc) {
            __builtin_amdgcn_fence(__ATOMIC_RELEASE, "agent");
            asm volatile("s_waitcnt vmcnt(0)" ::: "memory");
            const unsigned og = xb_add(&bar[XB_TOP], 1u);
            const unsigned tg = og / nx;
            if (og + 1u == (tg + 1u) * nx) xb_add(&bar[XB_TOPGEN], 1u);
            else XB_SPIN(xb_ld(&bar[XB_TOPGEN]) == tg, bar);
            __builtin_amdgcn_fence(__ATOMIC_ACQUIRE, "agent");
            xb_add(&bar[XB_XGEN(bx)], 1u);
            asm volatile("s_waitcnt vmcnt(0)" ::: "memory");
        } else {
            XB_SPIN(xb_ld(&bar[XB_XGEN(bx)]) == gen, bar);
            __builtin_amdgcn_fence(__ATOMIC_ACQUIRE, "agent");
            asm volatile("s_waitcnt vmcnt(0)" ::: "memory");
        }
    }
    __syncthreads();
}

namespace fg {
constexpr int BM = 256, BK = 64, HALF = 128, HTB = HALF * BK * 2, STAGE_BYTES = 8 * HTB;
__device__ __forceinline__ int lds_byte(int r, int c) { const int st = (r >> 4) * 2 + (c >> 5), rr = r & 15, cc = c & 31, ob = rr * 64 + cc * 2; return st * 1024 + (ob ^ (((ob >> 9) & 1) << 5)); }
__device__ __forceinline__ void stage_rc(int b, int& R, int& C) { const int st = b / 1024, sb = b % 1024, swz = sb ^ (((sb >> 9) & 1) << 5); R = (st >> 1) * 16 + swz / 64; C = (st & 1) * 32 + (swz % 64) / 2; }
__device__ __forceinline__ int perm32(int rho) { const int n = rho >> 4, i = rho & 15; return 8 * (i >> 2) + 4 * n + (i & 3); }
#define KDUP 0
struct Unit { int e, pm, pn; int skip; };
__device__ __forceinline__ void xcd_order(int i, int& T) { const int c = blockIdx.x; T = i * (int)gridDim.x + c; }

template <class PR>
__device__ __forceinline__ void gemm_phase(LAS unsigned char* lds, const PR& S, int wv) {
    const int tid = opaque_tid_(wv), wid = __builtin_amdgcn_readfirstlane(tid >> 6), lane = tid & 63, wr = wid >> 2, wc = wid & 3, fr = lane & 15, fq = lane >> 4;
    constexpr int K = PR::K, nt = K / BK;
    unsigned voffB[2];
#pragma unroll
    for (int i = 0; i < 2; ++i) { int R, C; stage_rc(tid * 16 + i * 8192, R, C); const int Rb = (R & ~31) + perm32(R & 31); voffB[i] = (unsigned)(Rb * PR::LDB + C) * 2u; }
    const size_t kstep = (size_t)(BK * 2);
    const size_t hB = S.hstepB();
    const unsigned ldsw = (unsigned)wid * 1024u;
    const int aoff = lds_byte(wr * 64 + fr, fq * 8), boff = lds_byte(wc * 32 + fr, fq * 8);
#define FG_SA(b, h) (((b) * 2 + (h)) * HTB)
#define FG_SB(b, h) ((4 + (b) * 2 + (h)) * HTB)
#define FG_STAGE(bufoff, gbase, voff) do { _Pragma("unroll") for (int _i = 0; _i < 2; ++_i) \
        __builtin_amdgcn_global_load_lds((const unsigned*)((const char*)(gbase) + (voff)[_i]), (LAS unsigned*)(lds + (bufoff) + ldsw + _i * 8192), 16, 0, 0); } while (0)
#define FG_LDA(dst, b, h) do { _Pragma("unroll") for (int m = 0; m < 4; ++m) _Pragma("unroll") for (int k = 0; k < 2; ++k) dst[m][k] = *(const LAS f16x8*)(lds + FG_SA(b, h) + aoff + m * 2048 + k * 1024); } while (0)
#define FG_LDB(dst, b, h) do { _Pragma("unroll") for (int n = 0; n < 2; ++n) _Pragma("unroll") for (int k = 0; k < 2; ++k) dst[n][k] = *(const LAS f16x8*)(lds + FG_SB(b, h) + boff + n * 2048 + k * 1024); } while (0)
#define FG_MMA(ai, bj, At, Bt) do { __builtin_amdgcn_s_setprio(1); _Pragma("unroll") for (int m = 0; m < 4; ++m) _Pragma("unroll") for (int n = 0; n < 2; ++n) _Pragma("unroll") for (int k = 0; k < 2; ++k) \
        acc[ai][bj][m][n] = __builtin_amdgcn_mfma_f32_16x16x32_f16(Bt[n][k], At[m][k], acc[ai][bj][m][n], 0, 0, 0); __builtin_amdgcn_s_setprio(0); } while (0)
#define FG_WAIT_V(n) asm volatile("s_waitcnt vmcnt(" #n ")" ::: "memory")
#define FG_WAIT_L(n) asm volatile("s_waitcnt lgkmcnt(" #n ")" ::: "memory")
#define FG_BAR __builtin_amdgcn_s_barrier()
#define FG_SCHED __builtin_amdgcn_sched_barrier(0)
    Unit cur, nxt; int ui = 0;
    if (!S.next(0, cur)) return;
    f32x4 acc[2][2][4][2];
#pragma unroll
    for (int a = 0; a < 2; ++a)
#pragma unroll
        for (int b = 0; b < 2; ++b)
#pragma unroll
            for (int m = 0; m < 4; ++m)
#pragma unroll
                for (int n = 0; n < 2; ++n) acc[a][b][m][n] = (f32x4){0.f, 0.f, 0.f, 0.f};
    f16x8 At[4][2], B0[2][2], B1[2][2];
    unsigned vA[2][2], vN[2][2];
    { int Rr[2], Cc[2]; stage_rc(tid * 16, Rr[0], Cc[0]); stage_rc(tid * 16 + 8192, Rr[1], Cc[1]); S.a_voff(cur, Rr, Cc, vA); }
#pragma unroll
    for (int h = 0; h < 2; ++h)
#pragma unroll
        for (int i = 0; i < 2; ++i) { asm volatile("" : "+v"(vA[h][i])); vN[h][i] = vA[h][i]; }
    const char* cA = S.a_base(cur); const char* cB = S.b_base(cur);
    FG_STAGE(FG_SB(0, 0), cB, voffB); FG_STAGE(FG_SA(0, 0), cA, vA[0]); FG_STAGE(FG_SB(0, 1), cB + hB, voffB); FG_STAGE(FG_SA(0, 1), cA, vA[1]);
    if (wr == 1) FG_BAR;
    FG_WAIT_V(4); FG_BAR;
    FG_STAGE(FG_SB(1, 0), cB + kstep, voffB); FG_STAGE(FG_SA(1, 0), cA + kstep, vA[0]); FG_STAGE(FG_SB(1, 1), cB + hB + kstep, voffB);
    FG_WAIT_V(6); FG_BAR;
    for (;;) {
        const bool has_next = S.next(ui + 1, nxt);
        const char* nA = has_next ? S.a_base(nxt) : cA; const char* nB = has_next ? S.b_base(nxt) : cB;
        if (has_next) { int Rr[2], Cc[2]; int t2 = tid; asm volatile("" : "+v"(t2)); stage_rc(t2 * 16, Rr[0], Cc[0]); stage_rc(t2 * 16 + 8192, Rr[1], Cc[1]); S.a_voff(nxt, Rr, Cc, vN);
#pragma unroll
            for (int h = 0; h < 2; ++h)
#pragma unroll
                for (int i = 0; i < 2; ++i) asm volatile("" : "+v"(vN[h][i])); }
#pragma unroll 1
        for (int t = 0; t < nt; t += 2) {
            const bool last = (t == nt - 2);
            const char* a1 = cA + (size_t)(t + 1) * kstep;
            const char* a2 = last ? nA : cA + (size_t)(t + 2) * kstep; const char* b2 = last ? nB : cB + (size_t)(t + 2) * kstep;
            const char* a3 = a2 + kstep; const char* b3 = b2 + kstep;
            unsigned v2[2][2];
#pragma unroll
            for (int h = 0; h < 2; ++h)
#pragma unroll
                for (int i = 0; i < 2; ++i) v2[h][i] = last ? vN[h][i] : vA[h][i];
            FG_LDB(B0, 0, 0); FG_SCHED; FG_LDA(At, 0, 0); FG_STAGE(FG_SA(1, 1), a1, vA[1]);
            FG_WAIT_L(8); FG_BAR; FG_WAIT_L(0); FG_MMA(0, 0, At, B0); FG_BAR; FG_SCHED;
            FG_LDB(B1, 0, 1); FG_STAGE(FG_SB(0, 0), b2, voffB);
            FG_BAR; FG_WAIT_L(0); FG_MMA(0, 1, At, B1); FG_BAR;
            FG_LDA(At, 0, 1); FG_STAGE(FG_SA(0, 0), a2, v2[0]);
            FG_BAR; FG_WAIT_L(0); FG_MMA(1, 0, At, B0); FG_BAR; FG_SCHED;
            FG_STAGE(FG_SB(0, 1), b2 + hB, voffB);
            FG_WAIT_V(6); FG_BAR; FG_MMA(1, 1, At, B1); FG_BAR;
            FG_LDB(B0, 1, 0); FG_SCHED; FG_LDA(At, 1, 0); FG_STAGE(FG_SA(0, 1), a2, v2[1]);
            FG_WAIT_L(8); FG_BAR; FG_WAIT_L(0); FG_MMA(0, 0, At, B0); FG_BAR; FG_SCHED;
            FG_LDB(B1, 1, 1); FG_STAGE(FG_SB(1, 0), b3, voffB);
            FG_BAR; FG_WAIT_L(0); FG_MMA(0, 1, At, B1); FG_BAR;
            FG_LDA(At, 1, 1); FG_STAGE(FG_SA(1, 0), a3, v2[0]);
            FG_BAR; FG_WAIT_L(0); FG_MMA(1, 0, At, B0); FG_BAR; FG_SCHED;
            FG_STAGE(FG_SB(1, 1), b3 + hB, voffB);
            FG_WAIT_V(6); FG_BAR; FG_MMA(1, 1, At, B1); FG_BAR;
        }
        if (!KDUP || !cur.skip) S.epi(acc, cur, wr, wc, fr, fq);
        if (!has_next) break;
#pragma unroll
        for (int a = 0; a < 2; ++a)
#pragma unroll
            for (int b = 0; b < 2; ++b)
#pragma unroll
                for (int m = 0; m < 4; ++m)
#pragma unroll
                    for (int n = 0; n < 2; ++n) acc[a][b][m][n] = (f32x4){0.f, 0.f, 0.f, 0.f};
        cur = nxt; cA = nA; cB = nB; ++ui;
#pragma unroll
        for (int h = 0; h < 2; ++h)
#pragma unroll
            for (int i = 0; i < 2; ++i) vA[h][i] = vN[h][i];
    }
    FG_WAIT_V(0);
    if (wr == 0) FG_BAR;
    FG_BAR;
#undef FG_SA
#undef FG_SB
#undef FG_STAGE
#undef FG_LDA
#undef FG_LDB
#undef FG_MMA
#undef FG_WAIT_V
#undef FG_WAIT_L
#undef FG_BAR
#undef FG_SCHED
}

__device__ __forceinline__ f16x8 pack8(const f32x4 a, const f32x4 b) { return (f16x8){(f16)a[0], (f16)a[1], (f16)a[2], (f16)a[3], (f16)b[0], (f16)b[1], (f16)b[2], (f16)b[3]}; }

template <int K_, int LDA_, int LDB_> struct PRBase {
    static constexpr int K = K_, LDA = LDA_, LDB = LDB_;
    __device__ __forceinline__ void plain_voff(const int (&R)[2], const int (&C)[2], unsigned (&v)[2][2]) const {
#pragma unroll
        for (int h = 0; h < 2; ++h)
#pragma unroll
            for (int i = 0; i < 2; ++i) v[h][i] = (unsigned)((h * HALF + R[i]) * LDA + C[i]) * 2u;
    }
};
struct PRGateUp : PRBase<1024, 1024, 1024> {
    const f16* H; const int* rowidx; const f16* W; f16* act; int nunits; int bid; int rt;
    __device__ __forceinline__ size_t hstepB() const { return (size_t)DEXP * DM * 2; }
    __device__ __forceinline__ bool next(int i, Unit& u) const { const int ii = KDUP ? (i >> 1) : i; const int T = ii * (int)gridDim.x + bid; u.skip = KDUP ? ((i & 1) == 0) : 0; if (T >= nunits) return false;
        if (rt == 16 && gridDim.x == 256) { const int x = bid & 7, jj = bid >> 3; u.e = ii; u.pm = (x >> 1) * 4 + (jj >> 3); u.pn = (x & 1) * 8 + (jj & 7); return true; }
        const int per = rt * 16; u.e = T / per; const int t = T % per; u.pm = t >> 4; u.pn = t & 15; return true; }
    __device__ __forceinline__ const char* a_base(const Unit&) const { return (const char*)H; }
    __device__ __forceinline__ void a_voff(const Unit& u, const int (&R)[2], const int (&C)[2], unsigned (&v)[2][2]) const {
        const int* ri = rowidx + u.e * SLOTS_PAD + u.pm * BM;
#pragma unroll
        for (int h = 0; h < 2; ++h)
#pragma unroll
            for (int i = 0; i < 2; ++i) { const int g = ri[h * HALF + R[i]]; v[h][i] = (unsigned)(g * LDA + C[i]) * 2u; }
    }
    __device__ __forceinline__ const char* b_base(const Unit& u) const { return (const char*)(W + ((size_t)u.e * 2 * DEXP + (size_t)u.pn * HALF) * DM); }
    __device__ __forceinline__ void epi(const f32x4 (&acc)[2][2][4][2], const Unit& u, int wr, int wc, int fr, int fq) const {
        f16* base = act + ((size_t)u.e * SLOTS_PAD + (size_t)u.pm * BM + wr * 64 + fr) * DEXP + u.pn * HALF + wc * 32 + fq * 8;
#pragma unroll
        for (int ai = 0; ai < 2; ++ai)
#pragma unroll
            for (int m = 0; m < 4; ++m) {
                f32x4 o0, o1;
#pragma unroll
                for (int j = 0; j < 4; ++j) { o0[j] = silu_f(acc[ai][0][m][0][j]) * acc[ai][1][m][0][j]; o1[j] = silu_f(acc[ai][0][m][1][j]) * acc[ai][1][m][1][j]; }
                if (u.e < 8) __builtin_nontemporal_store(rm8(pack8(o0, o1)), (f16x8*)(base + (size_t)(ai * HALF + m * 16) * DEXP));
                else *(f16x8*)(base + (size_t)(ai * HALF + m * 16) * DEXP) = rm8(pack8(o0, o1));
            }
    }
};
struct PRDown : PRBase<2048, 2048, 2048> {
    const f16* act; const f16* W; f16* y; int nunits; int bid; int rt;
    __device__ __forceinline__ size_t hstepB() const { return (size_t)HALF * DEXP * 2; }
    __device__ __forceinline__ bool next(int i, Unit& u) const { const int ii = KDUP ? (i >> 1) : i; const int T = ii * (int)gridDim.x + bid; u.skip = KDUP ? ((i & 1) == 0) : 0; if (T >= nunits) return false;
        if (rt == 16 && gridDim.x == 256) { const int x = bid & 7, jj = bid >> 3; u.e = 15 - (ii * 4 + (x >> 1)); u.pm = (x & 1) * 8 + (jj >> 2); u.pn = jj & 3; return true; }
        const int per = rt * 4; u.e = T / per; const int t = T % per; u.pm = t >> 2; u.pn = t & 3; return true; }
    __device__ __forceinline__ const char* a_base(const Unit& u) const { return (const char*)(act + ((size_t)u.e * SLOTS_PAD + (size_t)u.pm * BM) * DEXP); }
    __device__ __forceinline__ void a_voff(const Unit&, const int (&R)[2], const int (&C)[2], unsigned (&v)[2][2]) const { plain_voff(R, C, v); }
    __device__ __forceinline__ const char* b_base(const Unit& u) const { return (const char*)(W + ((size_t)u.e * DM + (size_t)u.pn * BM) * DEXP); }
    __device__ __forceinline__ void epi(const f32x4 (&acc)[2][2][4][2], const Unit& u, int wr, int wc, int fr, int fq) const {
        f16* base = y + ((size_t)u.e * SLOTS_PAD + (size_t)u.pm * BM + wr * 64 + fr) * DM + u.pn * BM + wc * 32 + fq * 8;
#pragma unroll
        for (int ai = 0; ai < 2; ++ai)
#pragma unroll
            for (int m = 0; m < 4; ++m)
#pragma unroll
                for (int bj = 0; bj < 2; ++bj) *(f16x8*)(base + (size_t)(ai * HALF + m * 16) * DM + bj * HALF) = pack8(acc[ai][bj][m][0], acc[ai][bj][m][1]);
    }
};
template <int K_> struct PRDense : PRBase<K_, 1024, K_> {
    const f16* A; const f16* W; f16* O0; f16* O1; f16* O2; int ncol; int mode; int bid; int npan; int kvx;
    __device__ __forceinline__ size_t hstepB() const { return (size_t)HALF * K_ * 2; }
    __device__ __forceinline__ bool next(int i, Unit& u) const { const int ii = KDUP ? (i >> 1) : i; int T = ii * (int)gridDim.x + bid; if (gridDim.x == 256) T = (ii * 8 + (bid & 7)) * 32 + (bid >> 3);
        u.skip = KDUP ? ((i & 1) == 0) : 0; const int nu = npan * ncol; if (T >= nu + kvx) return false; u.e = 0; if (T < nu) { u.pm = T / ncol; u.pn = T % ncol; } else { const int x = T - nu; u.pm = npan + (x >> 1); u.pn = 4 + (x & 1); } return true; }
    __device__ __forceinline__ const char* a_base(const Unit& u) const { return (const char*)(A + (size_t)u.pm * BM * 1024 + (mode == 2 ? u.pn * 256 : 0)); }
    __device__ __forceinline__ void a_voff(const Unit&, const int (&R)[2], const int (&C)[2], unsigned (&v)[2][2]) const { this->plain_voff(R, C, v); }
    __device__ __forceinline__ const char* b_base(const Unit& u) const { return (const char*)(W + (size_t)u.pn * BM * K_); }
    const float* qn; const float* kn; const float* rope; LAS float* xs; int lane;
    __device__ __forceinline__ void epi(const f32x4 (&acc)[2][2][4][2], const Unit& u, int wr, int wc, int fr, int fq) const {
        f16* base; int ld;
        const int row = u.pm * BM + wr * 64 + fr, colw = wc * 32 + fq * 8;
        if (mode == 1) { if (u.pn < 4) { base = O0 + (size_t)row * 1024 + u.pn * BM + colw; ld = 1024; } else if (u.pn == 4) { base = O1 + (size_t)row * 256 + colw; ld = 256; } else { base = O2 + (size_t)row * 256 + colw; ld = 256; } }
        else { base = O0 + (size_t)row * 1024 + u.pn * BM + colw; ld = 1024; }
        if (mode == 1 && u.pn < 5) {
            float ssq[2][4][2];
#pragma unroll
            for (int ai = 0; ai < 2; ++ai)
#pragma unroll
                for (int m = 0; m < 4; ++m)
#pragma unroll
                    for (int bj = 0; bj < 2; ++bj) { const f32x4 a = acc[ai][bj][m][0], b = acc[ai][bj][m][1];
                        float t = (a[0] * a[0] + a[1] * a[1]) + (a[2] * a[2] + a[3] * a[3]) + (b[0] * b[0] + b[1] * b[1]) + (b[2] * b[2] + b[3] * b[3]);
                        t += shx<16>(t, lane); t += shx<32>(t, lane); ssq[ai][m][bj] = t; }
            LAS float* mine = xs + ((wr * 4 + wc) * 16) * 16 + fr; const LAS float* theirs = xs + ((wr * 4 + (wc ^ 1)) * 16) * 16 + fr;
            if (fq == 0) {
#pragma unroll
                for (int ai = 0; ai < 2; ++ai)
#pragma unroll
                    for (int m = 0; m < 4; ++m)
#pragma unroll
                        for (int bj = 0; bj < 2; ++bj) mine[(ai * 8 + m * 2 + bj) * 16] = ssq[ai][m][bj];
            }
            asm volatile("s_waitcnt lgkmcnt(0)" ::: "memory"); __builtin_amdgcn_s_barrier(); asm volatile("" ::: "memory");
            const bool isq = u.pn < 4, lat = u.pm < 128;
            const float* nw = (isq ? qn : kn) + (wc & 1) * 32 + fq * 8;
            const f32x4 w0 = *(const f32x4*)nw, w1 = *(const f32x4*)(nw + 4);
            const float qs = isq ? 0.125f * 1.4426950408889634f : 1.0f;
#pragma unroll
            for (int ai = 0; ai < 2; ++ai)
#pragma unroll
                for (int m = 0; m < 4; ++m) {
                    f32x4 c0 = (f32x4){1.f, 1.f, 1.f, 1.f}, s0 = (f32x4){0.f, 0.f, 0.f, 0.f};
                    if (lat) { const int t = (row + ai * HALF + m * 16) & (SEQ - 1); const int pos = (wc & 1) ? (t & 63) : (t >> 6);
                        const float* tb = rope + (size_t)(pos * 16 + fq * 4) * 2; const f32x4 ta = *(const f32x4*)tb, tb2 = *(const f32x4*)(tb + 4);
                        c0 = (f32x4){ta[0], ta[2], tb2[0], tb2[2]}; s0 = (f32x4){ta[1], ta[3], tb2[1], tb2[3]}; }
#pragma unroll
                    for (int bj = 0; bj < 2; ++bj) {
                        const float tot = ssq[ai][m][bj] + theirs[(ai * 8 + m * 2 + bj) * 16];
                        const float rstd = rsqrtf(tot * (1.0f / 64.0f) + 1e-6f) * qs;
                        f32x4 a = acc[ai][bj][m][0] * rstd * w0, b = acc[ai][bj][m][1] * rstd * w1;
                        const f32x4 ra = (f32x4){a[0] * c0[0] - a[1] * s0[0], a[0] * s0[0] + a[1] * c0[0], a[2] * c0[1] - a[3] * s0[1], a[2] * s0[1] + a[3] * c0[1]};
                        const f32x4 rb = (f32x4){b[0] * c0[2] - b[1] * s0[2], b[0] * s0[2] + b[1] * c0[2], b[2] * c0[3] - b[3] * s0[3], b[2] * s0[3] + b[3] * c0[3]};
                        *(f16x8*)(base + (size_t)(ai * HALF + m * 16) * ld + bj * HALF) = rm8(pack8(ra, rb));
                    }
                }
            return;
        }
#pragma unroll
        for (int ai = 0; ai < 2; ++ai)
#pragma unroll
            for (int m = 0; m < 4; ++m)
#pragma unroll
                for (int bj = 0; bj < 2; ++bj) { const f16x8 o = pack8(acc[ai][bj][m][0], acc[ai][bj][m][1]); *(f16x8*)(base + (size_t)(ai * HALF + m * 16) * ld + bj * HALF) = (mode == 1) ? rm8(o) : o; }
    }
};
}

struct CvtJob { const float* src; f16* dst; int K, N, k0, n0; };
__device__ __forceinline__ bool cvt_job(const Params& P, int l, int u, CvtJob& jb, bool experts) {
    const int j = l >> 1;
    const int nexp = experts ? NEXP * 3 * 128 : 0;
    const int nmix = (l & 1) == 0 ? 16 : (96 + 64);
    if (u >= nexp + nmix) return false;
    if (u < nexp) {
        const int e = u / 384, r = u % 384, which = r >> 7, t = r & 127;
        if (which < 2) { jb.src = (which == 0 ? P.w_gate : P.w_up) + ((size_t)l * NEXP + e) * DM * DEXP; jb.dst = P.Wgu() + ((size_t)e * 2 + which) * DEXP * DM; jb.K = DM; jb.N = DEXP; jb.k0 = (t >> 4) * 128; jb.n0 = (t & 15) * 128; }
        else { jb.src = P.w_down + ((size_t)l * NEXP + e) * DEXP * DM; jb.dst = P.Wd() + (size_t)e * DM * DEXP; jb.K = DEXP; jb.N = DM; jb.k0 = (t >> 3) * 128; jb.n0 = (t & 7) * 128; }
    } else {
        const int t = u - nexp;
        if ((l & 1) == 0) { const int g = t >> 2, tt = t & 3; jb.src = P.pool_w + (size_t)(j * 4 + g) * 65536; jb.dst = P.Wmix() + (size_t)g * 65536; jb.K = 256; jb.N = 256; jb.k0 = (tt >> 1) * 128; jb.n0 = (tt & 1) * 128; }
        else if (t < 96) { jb.src = P.w_qkv + (size_t)j * DM * QKVD; jb.dst = P.Wmix(); jb.K = DM; jb.N = QKVD; jb.k0 = (t / 12) * 128; jb.n0 = (t % 12) * 128; }
        else { const int tt = t - 96; jb.src = P.w_o + (size_t)j * DM * DM; jb.dst = P.Wmix() + (size_t)QKVD * DM; jb.K = DM; jb.N = DM; jb.k0 = (tt >> 3) * 128; jb.n0 = (tt & 7) * 128; }
    }
    return true;
}
__device__ __forceinline__ void phase_convert(const Params& P, int l, int bid, int nb, f16* tile, bool experts = true) {
    const int tid = opaque_tid();
    CvtJob jb;
    int u = bid;
    bool have = cvt_job(P, l, u, jb, experts);
    f32x4 r[8];
    if (have) {
#pragma unroll
        for (int p = 0; p < 8; ++p) { const int id = tid + p * NTHR, kr = id >> 5, c4 = (id & 31) * 4; r[p] = __builtin_nontemporal_load((const f32x4*)(jb.src + (size_t)(jb.k0 + kr) * jb.N + jb.n0 + c4)); }
    }
    while (have) {
        __syncthreads();
#pragma unroll
        for (int p = 0; p < 8; ++p) { const int id = tid + p * NTHR, kr = id >> 5, c4 = (id & 31) * 4; *(f16x4*)(tile + kr * 136 + c4) = pk4(r[p]); }
        __syncthreads();
        const CvtJob cur = jb;
        u += nb; have = cvt_job(P, l, u, jb, experts);
        if (have) {
#pragma unroll
            for (int p = 0; p < 8; ++p) { const int id = tid + p * NTHR, kr = id >> 5, c4 = (id & 31) * 4; r[p] = __builtin_nontemporal_load((const f32x4*)(jb.src + (size_t)(jb.k0 + kr) * jb.N + jb.n0 + c4)); }
        }
        const int n = tid & 127, kg = (tid >> 7) * 32;
        f16* dp = cur.dst + (size_t)(cur.n0 + n) * cur.K + cur.k0 + kg;
#pragma unroll
        for (int i = 0; i < 4; ++i) { f16x8 o;
#pragma unroll
            for (int e = 0; e < 8; ++e) o[e] = tile[(kg + i * 8 + e) * 136 + n];
            *(f16x8*)(dp + i * 8) = rmw8(o); }
    }
}
template <bool GATEUP, bool CTX>
__device__ __forceinline__ void phase_cvt_ctx(const Params& P, int l, int bid, int nb, f16* tile, int sel = -1, bool alt = false) {
    const int tid = opaque_tid(), wid = P.wv, lane = tid & 63, r16 = lane & 15, kq = lane >> 4;
    constexpr int NC = GATEUP ? 128 : 64;
    constexpr int KT = GATEUP ? 8 : 16, K = GATEUP ? DM : DEXP, N = GATEUP ? DEXP : DM, NB = N / NC;
    constexpr int NT = GATEUP ? 2 * KT : KT;
    const int sel_ = (GATEUP && !CTX) ? sel : -1; const int ntr = (GATEUP && sel_ < 0) ? NT : KT;
    constexpr int TS = NC + 4, TW = 128 * TS;
    constexpr int NLD = NC / 16;
    constexpr int WPC = 8 / (NC / 16);
    constexpr int NRB = 4 / WPC;
    const int cb = wid % (NC / 16), rb0 = (wid / (NC / 16)) * NRB;
    f16* asl = tile + 2 * TW;
    for (int job = bid; job < NEXP * NB; job += nb) {
        const int e = job / NB, nbk = job % NB;
        const f16* ap[2];
        if (CTX) {
#pragma unroll
            for (int p = 0; p < 2; ++p) { const int row = (tid >> 4) + p * 32;
                if (GATEUP) ap[p] = P.H() + (size_t)P.rowidx()[e * SLOTS_PAD + 4096 + row] * DM + (tid & 15) * 8;
                else ap[p] = P.act() + ((size_t)e * SLOTS_PAD + 4096 + row) * DEXP + (tid & 15) * 8; }
        }
        f32x4 acc[2][NRB];
#pragma unroll
        for (int w = 0; w < 2; ++w)
#pragma unroll
            for (int rb = 0; rb < NRB; ++rb) acc[w][rb] = (f32x4){0.f, 0.f, 0.f, 0.f};
        const float* srcs[2]; f16* dsts[2];
        if (GATEUP) { const size_t wo = ((size_t)l * NEXP + e) * DM * DEXP; srcs[0] = P.w_gate + wo; srcs[1] = P.w_up + wo; dsts[0] = P.Wgu() + (alt ? (OFF_WGU3 - OFF_WGU) / 2 : 0) + ((size_t)e * 2) * DEXP * DM; dsts[1] = dsts[0] + (size_t)DEXP * DM; }
        else { srcs[0] = P.w_down + ((size_t)l * NEXP + e) * DEXP * DM; srcs[1] = srcs[0]; dsts[0] = P.Wd() + (alt ? (OFF_WD3 - OFF_WD) / 2 : 0) + (size_t)e * DM * DEXP; dsts[1] = dsts[0]; }
        f32x4 r[2][NLD]; f16x8 ar[2][2];
        const unsigned ldoff = (unsigned)(((tid / (NC / 4)) * N + (tid % (NC / 4)) * 4) * 4);
#define CV_LOAD(ti, slot) do { const int which_ = GATEUP ? (sel_ >= 0 ? sel_ : ((ti) & 1)) : 0, kt_ = (GATEUP && sel_ < 0) ? ((ti) >> 1) : (ti); const char* sp_ = (const char*)(srcs[which_] + (size_t)(kt_ * 128) * N + nbk * NC); \
            _Pragma("unroll") for (int p = 0; p < NLD; ++p) r[slot][p] = __builtin_nontemporal_load((const f32x4*)(sp_ + (size_t)p * (NTHR / (NC / 4)) * N * 4 + ldoff)); \
            if (CTX) { _Pragma("unroll") for (int p = 0; p < 2; ++p) ar[slot][p] = *(const f16x8*)(ap[p] + kt_ * 128); } } while (0)
#define CV_TILE(ti, slot) do { const int which = GATEUP ? (sel_ >= 0 ? sel_ : ((ti) & 1)) : 0, kt = (GATEUP && sel_ < 0) ? ((ti) >> 1) : (ti); \
            f16* tl = tile + (slot) * TW; f16* al = asl + (slot) * (64 * 128); \
            _Pragma("unroll") for (int p = 0; p < NLD; ++p) { const int id = tid + p * NTHR, kr = id / (NC / 4), c4 = (id % (NC / 4)) * 4; *(f16x4*)(tl + kr * TS + c4) = pk4(r[slot][p]); } \
            if (CTX) { _Pragma("unroll") for (int p = 0; p < 2; ++p) { const int row = (tid >> 4) + p * 32; *(f16x8*)(al + row * 128 + (((tid & 15) ^ (row & 15)) * 8)) = ar[slot][p]; } } \
            if ((ti) + 2 < ntr) CV_LOAD((ti) + 2, slot); \
            asm volatile("s_waitcnt lgkmcnt(0)" ::: "memory"); __builtin_amdgcn_s_barrier(); asm volatile("" ::: "memory"); \
            f16* dp = dsts[which] + (size_t)(nbk * NC + cb * 16 + r16) * K + kt * 128 + kq * 8; \
            _Pragma("unroll") for (int ks = 0; ks < 4; ++ks) { f16x8 bv; \
                _Pragma("unroll") for (int i = 0; i < 8; ++i) bv[i] = tl[(ks * 32 + kq * 8 + i) * TS + cb * 16 + r16]; \
                if (rb0 == 0) *(f16x8*)(dp + ks * 32) = rmw8(bv); \
                if (CTX) { _Pragma("unroll") for (int rb = 0; rb < NRB; ++rb) { const int row = (rb0 + rb) * 16 + r16; const f16x8 af = *(const f16x8*)(al + row * 128 + (((ks * 4 + kq) ^ r16) * 8)); \
                    acc[which][rb] = __builtin_amdgcn_mfma_f32_16x16x32_f16(bv, af, acc[which][rb], 0, 0, 0); } } } } while (0)
        CV_LOAD(0, 0); CV_LOAD(1, 1);
        for (int t2 = 0; t2 < ntr; t2 += 2) { CV_TILE(t2, 0); CV_TILE(t2 + 1, 1); }
#undef CV_LOAD
#undef CV_TILE
        asm volatile("s_waitcnt lgkmcnt(0)" ::: "memory"); __builtin_amdgcn_s_barrier(); asm volatile("" ::: "memory");
        if (CTX) {
#pragma unroll
            for (int rb = 0; rb < NRB; ++rb) {
                const size_t row = (size_t)e * SLOTS_PAD + 4096 + (rb0 + rb) * 16 + r16; const int col = nbk * NC + cb * 16 + 4 * kq;
                if (GATEUP) { f32x4 o;
#pragma unroll
                    for (int jj = 0; jj < 4; ++jj) o[jj] = silu_f(acc[0][rb][jj]) * acc[1][rb][jj];
                    *(f16x4*)(P.act() + row * DEXP + col) = pk4(o); }
                else *(f16x4*)(P.yslot() + row * DM + col) = pk4(acc[0][rb]);
            }
        }
    }
}

__device__ __forceinline__ void cvt3_job(const Params& P, int job, f16* tile) {
    if (job < 256) phase_cvt_ctx<false, false>(P, 3, job, 1 << 20, tile, -1, true);
    else { const int h = job - 256; phase_cvt_ctx<true, false>(P, 3, h >> 1, 1 << 20, tile, h & 1, true); }
}
__device__ __forceinline__ void phase_gateup_fast(const Params& P, LAS unsigned char* lds, int rt = 17, bool alt = false) { fg::PRGateUp S; S.H = P.H(); S.rowidx = P.rowidx(); S.W = P.Wgu() + (alt ? (OFF_WGU3 - OFF_WGU) / 2 : 0); S.act = P.act(); S.rt = rt; S.nunits = 16 * rt * 16; S.bid = opaque_bid(); fg::gemm_phase(lds, S, P.wv); }
__device__ __forceinline__ void phase_down_fast(const Params& P, LAS unsigned char* lds, int rt = 17, bool alt = false) { fg::PRDown S; S.act = P.act(); S.W = P.Wd() + (alt ? (OFF_WD3 - OFF_WD) / 2 : 0); S.y = P.yslot(); S.rt = rt; S.nunits = 16 * rt * 4; S.bid = opaque_bid(); fg::gemm_phase(lds, S, P.wv); }
__device__ __forceinline__ void phase_pool_fast(const Params& P, LAS unsigned char* lds) { fg::PRDense<256> S; S.qn = nullptr; S.kn = nullptr; S.rope = nullptr; S.xs = nullptr; S.lane = 0; S.npan = 130; S.kvx = 0; S.A = P.H(); S.W = P.Wmix(); S.O0 = P.Z(); S.O1 = nullptr; S.O2 = nullptr; S.ncol = 4; S.mode = 2; S.bid = opaque_bid(); fg::gemm_phase(lds, S, P.wv); }
__device__ __forceinline__ void phase_qkv_fast(const Params& P, LAS unsigned char* lds, bool lastl = false, int l = 1) { fg::PRDense<1024> S; S.qn = P.q_norm + (l >> 1) * 64; S.kn = P.k_norm + (l >> 1) * 64; S.rope = P.rope(); S.xs = (LAS float*)(lds + fg::STAGE_BYTES); S.lane = opaque_tid_(P.wv) & 63; S.npan = lastl ? 128 : 130; S.kvx = lastl ? 4 : 0; S.A = P.H(); S.W = P.Wmix(); S.O0 = P.Q(); S.O1 = P.Kb(); S.O2 = P.Vb(); S.ncol = 6; S.mode = 1; S.bid = opaque_bid(); fg::gemm_phase(lds, S, P.wv); }
__device__ __forceinline__ void phase_oproj_fast(const Params& P, LAS unsigned char* lds, bool lastl = false) { fg::PRDense<1024> S; S.qn = nullptr; S.kn = nullptr; S.rope = nullptr; S.xs = nullptr; S.lane = 0; S.npan = lastl ? 128 : 130; S.kvx = 0; S.A = P.O(); S.W = P.Wmix() + (size_t)QKVD * DM; S.O0 = P.Z(); S.O1 = nullptr; S.O2 = nullptr; S.ncol = 4; S.mode = 0; S.bid = opaque_bid(); fg::gemm_phase(lds, S, P.wv); }

typedef float f32x16 __attribute__((ext_vector_type(16)));
#define AT_KB 9216
#define AT_VB 8704
template <int VAR = 0>
__device__ __forceinline__ void phase_attn_fast(const Params& P, int l, LAS unsigned char* lds, bool do_ctx, int cvt_l = -1) {
    const int j = l >> 1;
    const int tid = opaque_tid(), wid = tid >> 6, lane = tid & 63, l32 = lane & 31, hi = lane >> 5;
    const int g = wid >> 1, qoff = (wid & 1) * 64, qoffu = (P.wv & 1) * 64;
    const int nunits = do_ctx ? 1040 : 1024;
    int ucount = 0;
    for (int u = opaque_bid(); u < nunits; u += gridDim.x, ++ucount) {
        int b, qblk, kv, qrow0, t0, t1, s0;
        if (u < 1024) { b = u >> 9; qblk = (u >> 2) & 127; kv = u & 3; s0 = b * SEQ; qrow0 = s0 + qblk * 128; t0 = qblk == 0 ? 2 : 0; t1 = qblk == 127 ? 4 : 6; }
        else { const int uu = u - 1024; b = uu >> 3; qblk = (uu >> 2) & 1; kv = uu & 3; s0 = NLAT + b * CTXL; qrow0 = s0 + qblk * 128; t0 = 0; t1 = 0; }
        const int cb = NLAT + b * CTXL, nloc = t1 - t0, ntiles = nloc + 4;
        const int h = kv * 4 + g;
        f16x8 Qf[2][4];
#pragma unroll
        for (int qb = 0; qb < 2; ++qb)
#pragma unroll
            for (int ks = 0; ks < 4; ++ks) Qf[qb][ks] = *(const f16x8*)(P.Q() + (size_t)(qrow0 + qoff + 32 * qb + l32) * 1024 + h * 64 + 16 * ks + 8 * hi);
        f32x16 OT[2][2];
#pragma unroll
        for (int db = 0; db < 2; ++db)
#pragma unroll
            for (int qb = 0; qb < 2; ++qb)
#pragma unroll
                for (int r = 0; r < 16; ++r) OT[db][qb][r] = 0.f;
        float mrun[2], lrun[2];
        { const float sk = P.sink[j * 16 + h] * 1.4426950408889634f; mrun[0] = sk; mrun[1] = sk; lrun[0] = hi == 0 ? 1.0f : 0.0f; lrun[1] = lrun[0]; }
        const int lkey = tid >> 3, lpc = tid & 7;
        f16x8 kreg, vreg;
        auto tile_row = [&](int it) -> int { return it < nloc ? (qrow0 - 128 + 64 * (t0 + it)) : (cb + 64 * (it - nloc)); };
        { const int kr = tile_row(0) + lkey; kreg = *(const f16x8*)(P.Kb() + (size_t)kr * 256 + kv * 64 + lpc * 8); vreg = *(const f16x8*)(P.Vb() + (size_t)kr * 256 + kv * 64 + lpc * 8); }
        __syncthreads();
        {
            LAS f16* Kl = (LAS f16*)(lds); LAS f16* Vl = (LAS f16*)(lds + 2 * AT_KB);
            *(LAS f16x8*)(Kl + lkey * 72 + lpc * 8) = kreg;
#pragma unroll
            for (int i = 0; i < 8; ++i) Vl[(lpc * 8 + i) * 68 + lkey] = vreg[i];
        }
        __syncthreads();
        for (int it = 0; it < ntiles; ++it) {
            const int buf = it & 1;
            if (it + 1 < ntiles) { const int kr = tile_row(it + 1) + lkey; kreg = *(const f16x8*)(P.Kb() + (size_t)kr * 256 + kv * 64 + lpc * 8); vreg = *(const f16x8*)(P.Vb() + (size_t)kr * 256 + kv * 64 + lpc * 8); }
            const LAS f16* Kl = (const LAS f16*)(lds + buf * AT_KB); const LAS f16* Vl = (const LAS f16*)(lds + 2 * AT_KB + buf * AT_VB);
            int cls = 0;
            if (it < nloc) { const int tl = t0 + it, dmin = qoffu + 65 - 64 * tl, dmax = qoffu + 191 - 64 * tl; cls = (dmin > 128 || dmax < -128) ? 2 : ((dmin >= -128 && dmax <= 128) ? 0 : 1); }
            if (cls != 2) {
            f32x16 S[2][2];
#pragma unroll
            for (int kb = 0; kb < 2; ++kb)
#pragma unroll
                for (int qb = 0; qb < 2; ++qb)
#pragma unroll
                    for (int r = 0; r < 16; ++r) S[kb][qb][r] = -mrun[qb];
#pragma unroll
            for (int ks = 0; ks < 4; ++ks)
#pragma unroll
                for (int kb = 0; kb < 2; ++kb) {
                    const f16x8 kf = *(const LAS f16x8*)(Kl + (32 * kb + l32) * 72 + 16 * ks + 8 * hi);
#pragma unroll
                    for (int qb = 0; qb < 2; ++qb) S[kb][qb] = __builtin_amdgcn_mfma_f32_32x32x16_f16(kf, Qf[qb][ks], S[kb][qb], 0, 0, 0);
                }
            if (cls == 1) {
                const int kt = 64 * (t0 + it);
#pragma unroll
                for (int qb = 0; qb < 2; ++qb) {
                    const int qp = 128 + qoff + 32 * qb + l32;
#pragma unroll
                    for (int kb = 0; kb < 2; ++kb)
#pragma unroll
                        for (int r = 0; r < 16; ++r) { const int kp = kt + 32 * kb + 8 * (r >> 2) + 4 * hi + (r & 3); const int d = qp - kp; if (d > 128 || d < -128) S[kb][qb][r] = -INFINITY; }
                }
            }
            f16x8 Pf[2][4];
#pragma unroll
            for (int qb = 0; qb < 2; ++qb) {
                float mx = S[0][qb][0];
#pragma unroll
                for (int kb = 0; kb < 2; ++kb)
#pragma unroll
                    for (int r = 0; r < 16; ++r) mx = fmaxf(mx, S[kb][qb][r]);
                { const auto sw = __builtin_amdgcn_permlane32_swap(__float_as_uint(mx), __float_as_uint(mx), false, false); mx = fmaxf(__uint_as_float(sw[0]), __uint_as_float(sw[1])); }
                if (__builtin_amdgcn_ballot_w64(mx > 8.0f) != 0ull) {
                    const float g = fmaxf(mx, 0.f), corr = __builtin_amdgcn_exp2f(-g);
                    mrun[qb] += g; lrun[qb] *= corr;
#pragma unroll
                    for (int kb = 0; kb < 2; ++kb)
#pragma unroll
                        for (int r = 0; r < 16; ++r) S[kb][qb][r] -= g;
#pragma unroll
                    for (int db = 0; db < 2; ++db)
#pragma unroll
                        for (int r = 0; r < 16; ++r) OT[db][qb][r] *= corr;
                }
                float ps = 0.f;
#pragma unroll
                for (int kb = 0; kb < 2; ++kb)
#pragma unroll
                    for (int r = 0; r < 16; ++r) { const float p = __builtin_amdgcn_exp2f(S[kb][qb][r]); S[kb][qb][r] = p; ps += p; }
                lrun[qb] += ps;
#pragma unroll
                for (int ks = 0; ks < 4; ++ks) { const int kb = ks >> 1, r0 = 8 * (ks & 1);
#pragma unroll
                    for (int e = 0; e < 8; ++e) Pf[qb][ks][e] = (f16)S[kb][qb][r0 + e]; }
            }
#pragma unroll
            for (int ks = 0; ks < 4; ++ks)
#pragma unroll
                for (int db = 0; db < 2; ++db) {
                    const LAS f16* vp = Vl + (32 * db + l32) * 68 + 16 * ks + 4 * hi;
                    const f16x4 v0 = *(const LAS f16x4*)vp, v1 = *(const LAS f16x4*)(vp + 8);
                    const f16x8 vf = (f16x8){v0[0], v0[1], v0[2], v0[3], v1[0], v1[1], v1[2], v1[3]};
#pragma unroll
                    for (int qb = 0; qb < 2; ++qb) OT[db][qb] = __builtin_amdgcn_mfma_f32_32x32x16_f16(vf, Pf[qb][ks], OT[db][qb], 0, 0, 0);
                }
            }
            if (it + 1 < ntiles) {
                LAS f16* Kw = (LAS f16*)(lds + (buf ^ 1) * AT_KB); LAS f16* Vw = (LAS f16*)(lds + 2 * AT_KB + (buf ^ 1) * AT_VB);
                *(LAS f16x8*)(Kw + lkey * 72 + lpc * 8) = kreg;
#pragma unroll
                for (int i = 0; i < 8; ++i) Vw[(lpc * 8 + i) * 68 + lkey] = vreg[i];
            }
            __syncthreads();
        }
#pragma unroll
        for (int qb = 0; qb < 2; ++qb) {
            const float lt = lrun[qb] + shx<32>(lrun[qb], lane);
            const float inv = 1.0f / lt;
            f16* op = P.O() + (size_t)(qrow0 + qoff + 32 * qb + l32) * 1024 + h * 64;
#pragma unroll
            for (int db = 0; db < 2; ++db)
#pragma unroll
                for (int i = 0; i < 4; ++i) {
                    const f16x4 o = (f16x4){(f16)(OT[db][qb][4 * i] * inv), (f16)(OT[db][qb][4 * i + 1] * inv), (f16)(OT[db][qb][4 * i + 2] * inv), (f16)(OT[db][qb][4 * i + 3] * inv)};
                    *(f16x4*)(op + 32 * db + 8 * i + 4 * hi) = rm4(o);
                }
        }
    }
}

#define MEGA_LDS (147456 + 16)
__device__ __forceinline__ const Params& opq(Params& q) { int z; asm volatile("s_mov_b32 %0, 0" : "=s"(z)); q.zoff = z; return q; }
__global__ __launch_bounds__(NTHR, 2) void mega(Params P) {
    extern __shared__ __attribute__((aligned(16))) unsigned char shm[];
    LAS unsigned char* lds = (LAS unsigned char*)shm;
    volatile LAS unsigned* st = (volatile LAS unsigned*)(lds + 147456);
    if (threadIdx.x == 0) { st[0] = 0u; st[1] = 0u; st[2] = 0u; st[3] = 0u; }
    __syncthreads();
    const XcdBarrier bar = xcd_barrier_post(P.bar(), st);
    const int nb = gridDim.x;
#define bid (opaque_bid())
    Params Q = P; Q.wv = __builtin_amdgcn_readfirstlane(threadIdx.x >> 6);
#define P (opq(Q))
    phase_ada(P, bid, nb, (float*)shm, 0, nb == 256 ? 1 : 4, true);
    __syncthreads();
    phase_convert(P, 0, bid, nb, (f16*)shm, false);
    xcd_barrier(bar);
    for (int l = 0; l < 4; ++l) {
        if (l == 0) phase_n1<true, false>(P, l, bid, nb); else { phase_n1<false, false>(P, l, bid, nb); __syncthreads(); phase_convert(P, l, bid, nb, (f16*)shm, false);
            }
        xcd_barrier(bar);
        if ((l & 1) == 0) {
            phase_pool_fast(P, lds);
            xcd_barrier(bar);
            phase_n2<true>(P, l, bid, nb, (float*)shm);
        } else {
            phase_qkv_fast(P, lds, l == 3, l);
            if (nb == 256 && (bid & 7) >= 2) { __syncthreads(); cvt3_job(P, (l == 1 ? 192 : 576) + ((bid & 7) - 2) * 32 + (bid >> 3), (f16*)shm); }
            xcd_barrier(bar);
            phase_attn_fast(P, l, lds, l != 3);
            if (l == 3 && nb != 256) { __syncthreads(); phase_cvt_ctx<true, false>(P, l, bid, nb, (f16*)shm, -1, true); phase_cvt_ctx<false, false>(P, l, bid, nb, (f16*)shm, -1, true); }
            xcd_barrier(bar);
            phase_oproj_fast(P, lds, l == 3);
            if (l == 1 && nb == 256 && (bid & 7) >= 2) { __syncthreads(); cvt3_job(P, 384 + ((bid & 7) - 2) * 32 + (bid >> 3), (f16*)shm); }
            xcd_barrier(bar);
            phase_n2<false>(P, l, bid, nb, (float*)shm, l == 3 ? NLAT : MROWS);
        }
        xcd_barrier(bar);
        phase_topk(P, bid, nb, (unsigned*)shm, l == 3 ? 32 : 64);
        if (l < 3 && nb == 256 && bid >= 64 && bid < 128) cvt3_job(P, l * 64 + bid - 64, (f16*)shm);
        if (l < 3 && nb == 256 && bid >= 128 && bid < 224) phase_ada(P, bid - 128, 1 << 20, (float*)shm, l + 1, 1, false);
        xcd_barrier(bar);
        if (l < 3) { phase_cvt_ctx<true, true>(P, l, bid, nb, (f16*)shm); xcd_barrier(bar); }
        phase_gateup_fast(P, lds, 16, l == 3);
        if (l < 3) { __syncthreads(); phase_cvt_ctx<false, true>(P, l, bid, nb, (f16*)shm); }
        xcd_barrier(bar);
        phase_down_fast(P, lds, 16, l == 3);
        xcd_barrier(bar);
    }
    phase_n1<false, true>(P, 4, bid, nb);
#undef P
#undef bid
}

static inline size_t al256(size_t v) { return (v + 255) & ~(size_t)255; }

extern "C" void kernel_launch(void* const* d_in, const int* in_sizes, int n_in, void* d_out, int out_size, void* d_ws, size_t ws_size, hipStream_t stream) {
    Params P{};
    P.x = (const float*)d_in[0]; P.c = (const float*)d_in[1]; P.ctx = (const float*)d_in[2]; P.c_ctx = (const float*)d_in[3];
    P.w_ada = (const float*)d_in[4]; P.b_ada = (const float*)d_in[5]; P.norm1_g = (const float*)d_in[6]; P.norm2_g = (const float*)d_in[7];
    P.pool_w = (const float*)d_in[8]; P.pool_scale = (const float*)d_in[9]; P.w_qkv = (const float*)d_in[10]; P.w_o = (const float*)d_in[11];
    P.q_norm = (const float*)d_in[12]; P.k_norm = (const float*)d_in[13]; P.sink = (const float*)d_in[14]; P.router_w = (const float*)d_in[15];
    P.w_gate = (const float*)d_in[16]; P.w_up = (const float*)d_in[17]; P.w_down = (const float*)d_in[18];
    P.out = (float*)d_out;
    P.ws = (char*)d_ws; const size_t off = WS_TOTAL;
    if (off > ws_size) { fprintf(stderr, "workspace too small: need %zu have %zu\n", off, ws_size); return; }
    static int grid = 0;
    if (!grid) {
        int dev = 0, cus = 0, per_cu = 0;
        hipGetDevice(&dev);
        hipDeviceGetAttribute(&cus, hipDeviceAttributeMultiprocessorCount, dev);
        hipFuncSetAttribute((const void*)mega, hipFuncAttributeMaxDynamicSharedMemorySize, MEGA_LDS);
        hipOccupancyMaxActiveBlocksPerMultiprocessor(&per_cu, (const void*)mega, NTHR, MEGA_LDS);
        if (per_cu < 1) { fprintf(stderr, "mega: occupancy query says %d blocks per CU\n", per_cu); }
        grid = cus > 0 ? cus : 256;
    }
    hipMemsetAsync(P.bar(), 0, XCD_BAR_WORDS * sizeof(unsigned), stream);
    hipLaunchKernelGGL(mega, dim3(grid), dim3(NTHR), MEGA_LDS, stream, P);
}
```

```cpp
#include <hip/hip_runtime.h>
#include <stdint.h>
#include <stdio.h>

typedef _Float16 f16;
typedef _Float16 f16x2 __attribute__((ext_vector_type(2)));
typedef _Float16 f16x4 __attribute__((ext_vector_type(4)));
typedef _Float16 f16x8 __attribute__((ext_vector_type(8)));
typedef float f32x4 __attribute__((ext_vector_type(4)));
typedef float f32x2 __attribute__((ext_vector_type(2)));
typedef unsigned u32x2 __attribute__((ext_vector_type(2)));
typedef unsigned u32x4 __attribute__((ext_vector_type(4)));
#define RM_BITS 5
#define RM_ADD (0x00010001u << (RM_BITS - 1))
#define RM_MASK (~(0x00010001u * ((1u << RM_BITS) - 1u)))
__device__ __forceinline__ f16x4 rm4(f16x4 v) { u32x2 b = __builtin_bit_cast(u32x2, v); b = (b + RM_ADD) & RM_MASK; return __builtin_bit_cast(f16x4, b); }
__device__ __forceinline__ f16x8 rm8(f16x8 v) { u32x4 b = __builtin_bit_cast(u32x4, v); b = (b + RM_ADD) & RM_MASK; return __builtin_bit_cast(f16x8, b); }
#define RMW_BITS 5
__device__ __forceinline__ f16x8 rmw8(f16x8 v) { u32x4 b = __builtin_bit_cast(u32x4, v); b = (b + (0x00010001u << (RMW_BITS - 1))) & ~(0x00010001u * ((1u << RMW_BITS) - 1u)); return __builtin_bit_cast(f16x8, b); }

#define LAS __attribute__((address_space(3)))
#define DM 1024
#define SEQ 16384
#define NLAT 32768
#define CTXL 256
#define NCTX 512
#define MROWS 33280
#define NEXP 16
#define DEXP 2048
#define SLOTS 4160
#define SLOTS_PAD 4352
#define QKVD 1536
#define NTHR 512

constexpr size_t al256c(size_t v) { return (v + 255) & ~(size_t)255; }
constexpr size_t OFF_BAR = 0;
constexpr size_t OFF_MOD = al256c(OFF_BAR + 16384);
constexpr size_t OFF_ROPE = al256c(OFF_MOD + (size_t)4 * 3 * 6 * DM * 4);
constexpr size_t OFF_X = al256c(OFF_ROPE + (size_t)256 * 16 * 2 * 4);
constexpr size_t OFF_H = al256c(OFF_X + (size_t)MROWS * DM * 4);
constexpr size_t OFF_Z = al256c(OFF_H + (size_t)MROWS * DM * 2);
constexpr size_t OFF_Q = al256c(OFF_Z + (size_t)MROWS * DM * 2);
constexpr size_t OFF_KB = al256c(OFF_Q + (size_t)MROWS * DM * 2);
constexpr size_t OFF_VB = al256c(OFF_KB + (size_t)MROWS * 256 * 2);
constexpr size_t OFF_VT = al256c(OFF_VB + (size_t)MROWS * 256 * 2);
constexpr size_t OFF_O = al256c(OFF_VT + (size_t)MROWS * 256 * 2);
constexpr size_t OFF_AFF = al256c(OFF_O + (size_t)MROWS * DM * 2);
constexpr size_t OFF_INV = al256c(OFF_AFF + (size_t)MROWS * 16 * 4);
constexpr size_t OFF_ROWIDX = al256c(OFF_INV + (size_t)MROWS * 16 * 4);
constexpr size_t OFF_ACT = al256c(OFF_ROWIDX + (size_t)NEXP * SLOTS_PAD * 4);
constexpr size_t OFF_YSLOT = al256c(OFF_ACT + (size_t)NEXP * SLOTS_PAD * DEXP * 2);
constexpr size_t OFF_WGU = al256c(OFF_YSLOT + (size_t)NEXP * SLOTS_PAD * DM * 2);
constexpr size_t OFF_WD = al256c(OFF_WGU + (size_t)NEXP * 2 * DEXP * DM * 2);
constexpr size_t OFF_WMIX = al256c(OFF_WD + (size_t)NEXP * DM * DEXP * 2);
constexpr size_t OFF_WGU3 = al256c(OFF_WMIX + (size_t)(QKVD + DM) * DM * 2);
constexpr size_t OFF_WD3 = al256c(OFF_WGU3 + (size_t)NEXP * 2 * DEXP * DM * 2);
constexpr size_t OFF_DUMMY = al256c(OFF_WD3 + (size_t)NEXP * DM * DEXP * 2);
constexpr size_t WS_TOTAL = OFF_DUMMY;
struct Params {
    const float *x, *c, *ctx, *c_ctx, *w_ada, *b_ada, *norm1_g, *norm2_g, *pool_w, *pool_scale, *w_qkv, *w_o, *q_norm, *k_norm, *sink, *router_w, *w_gate, *w_up, *w_down;
    float* out; char* ws; int wv; int zoff;
#define WSF(name, type, off) __host__ __device__ __forceinline__ type* name() const { return (type*)(ws + zoff + (off)); }
    WSF(bar, unsigned, OFF_BAR) WSF(mod, float, OFF_MOD) WSF(rope, float, OFF_ROPE) WSF(X, f16, OFF_X) WSF(H, f16, OFF_H) WSF(Z, f16, OFF_Z) WSF(Q, f16, OFF_Q) WSF(Kb, f16, OFF_KB) WSF(Vb, f16, OFF_VB) WSF(Vt, f16, OFF_VT)
    WSF(O, f16, OFF_O) WSF(aff, float, OFF_AFF) WSF(inv, int, OFF_INV) WSF(rowidx, int, OFF_ROWIDX) WSF(act, f16, OFF_ACT) WSF(yslot, f16, OFF_YSLOT) WSF(Wgu, f16, OFF_WGU) WSF(Wd, f16, OFF_WD) WSF(Wmix, f16, OFF_WMIX)
#undef WSF
#define WSW(name, type, off) __host__ __device__ __forceinline__ type* name() const { return (type*)(ws + zoff + (off)); }
    WSW(Xw, f16, OFF_X) WSW(Ow, f16, OFF_O) WSW(Hw, f16, OFF_H) WSW(affw, float, OFF_AFF) WSW(Qw, f16, OFF_Q) WSW(Kw, f16, OFF_KB)
#undef WSW
};

template <int O> __device__ __forceinline__ float shx(float v, int lane) {
    if (O == 1) return __int_as_float(__builtin_amdgcn_update_dpp(0, __float_as_int(v), 0xB1, 0xF, 0xF, true));
    if (O == 2) return __int_as_float(__builtin_amdgcn_update_dpp(0, __float_as_int(v), 0x4E, 0xF, 0xF, true));
    if (O < 32) return __int_as_float(__builtin_amdgcn_ds_swizzle(__float_as_int(v), (O << 10) | 0x1f));
    return __int_as_float(__builtin_amdgcn_ds_bpermute((lane ^ O) << 2, __float_as_int(v)));
}
__device__ __forceinline__ float wave_sum(float v, int lane) {
    v += shx<1>(v, lane); v += shx<2>(v, lane); v += shx<4>(v, lane); v += shx<8>(v, lane); v += shx<16>(v, lane); v += shx<32>(v, lane);
    return v;
}
__device__ __forceinline__ unsigned shup(unsigned v, int o, int lane) { return (unsigned)__builtin_amdgcn_ds_bpermute((lane - o) << 2, (int)v); }
__device__ __forceinline__ int opaque_bid() { int b = blockIdx.x; asm volatile("" : "+s"(b)); return b; }
#define opaque_tid() opaque_tid_(P.wv)
__device__ __forceinline__ int opaque_tid_(int wv) { int ln; asm volatile("v_mbcnt_lo_u32_b32 %0, -1, 0\n\tv_mbcnt_hi_u32_b32 %0, -1, %0" : "=v"(ln)); return (wv << 6) | ln; }
__device__ __forceinline__ float silu_f(float v) { return v * __builtin_amdgcn_rcpf(1.0f + __expf(-v)); }

__device__ __forceinline__ const float* modp(const Params& P, int l, int v, int j) { return P.mod() + (size_t)((l * 3 + v) * 6 + j) * DM; }

__device__ __forceinline__ void phase_ada(const Params& P, int bid, int nb, float* lds, int l0 = 0, int nl = 4, bool do_rope = true) {
    float* sc = lds; float* red = lds + 3 * DM;
    const int tid = opaque_tid();
    for (int i = tid; i < 3 * DM; i += NTHR) { const int v = i >> 10, k = i & 1023; const float cv = v < 2 ? P.c[v * DM + k] : P.c_ctx[k]; sc[i] = silu_f(cv); }
    __syncthreads();
    for (int u = bid; u < nl * 96; u += nb) {
        const int l = l0 + u / 96, ch = u % 96, c4 = tid & 15, kg = tid >> 4;
        const float* w = P.w_ada + (size_t)l * DM * 6 * DM + ch * 64 + c4 * 4;
        f32x4 s0 = (f32x4){0.f, 0.f, 0.f, 0.f}, s1 = s0, s2 = s0;
#pragma unroll 8
        for (int i = 0; i < 32; ++i) { const int k = kg * 32 + i; const f32x4 wv = __builtin_nontemporal_load((const f32x4*)(w + (size_t)k * 6 * DM)); s0 += sc[k] * wv; s1 += sc[DM + k] * wv; s2 += sc[2 * DM + k] * wv; }
        *(f32x4*)(red + (kg * 3 + 0) * 64 + c4 * 4) = s0; *(f32x4*)(red + (kg * 3 + 1) * 64 + c4 * 4) = s1; *(f32x4*)(red + (kg * 3 + 2) * 64 + c4 * 4) = s2;
        __syncthreads();
        if (tid < 192) { const int v = tid >> 6, cc = tid & 63; float s = 0.f;
#pragma unroll
            for (int q = 0; q < 32; ++q) s += red[(q * 3 + v) * 64 + cc];
            const int colg = ch * 64 + cc; s += P.b_ada[l * 6 * DM + colg];
            const int j = colg >> 10, d = colg & 1023;
            P.mod()[(size_t)((l * 3 + v) * 6 + j) * DM + d] = s; }
        __syncthreads();
    }
    if (do_rope) for (int i = bid * NTHR + tid; i < 256 * 16; i += nb * NTHR) {
        const int p = i >> 4, f = i & 15;
        const float inv = powf(10000.0f, -(float)f / 16.0f);
        const float angf = (float)p * inv;
        double a = (double)angf;
        const double twopi = 6.283185307179586476925286766559;
        a -= twopi * rint(a / twopi);
        const double a2 = a * a;
        double cs = 1.0, sn = 1.0;
        double tc = 0.0, ts = 0.0;
        for (int n = 16; n >= 1; --n) { tc = (tc + 1.0) * (-a2 / (double)((2 * n - 1) * (2 * n))); ts = (ts + 1.0) * (-a2 / (double)((2 * n) * (2 * n + 1))); }
        cs = 1.0 + tc; sn = a * (1.0 + ts);
        P.rope()[i * 2] = (float)cs; P.rope()[i * 2 + 1] = (float)sn;
    }
}

__device__ __forceinline__ f32x4 cvt4(const f16x4 v) { return (f32x4){(float)v[0], (float)v[1], (float)v[2], (float)v[3]}; }
__device__ __forceinline__ f16x4 pk4(const f32x4 v) { return (f16x4){(f16)v[0], (f16)v[1], (f16)v[2], (f16)v[3]}; }
__device__ __forceinline__ float dot4(const f32x4 a, const f32x4 b) { return a[0] * b[0] + a[1] * b[1] + a[2] * b[2] + a[3] * b[3]; }
template <bool FIRST, bool FINAL>
__device__ __forceinline__ void phase_n1(const Params& P, int l, int bid, int nb) {
    constexpr int R = 4;
    const int tid_ = opaque_tid(); const int wid = P.wv, lane = tid_ & 63;
    const int nrows = FINAL ? NLAT : MROWS;
    for (int rb = (bid * 8 + wid) * R; rb < nrows; rb += nb * 8 * R) {
        const int v = rb < NLAT ? (rb >> 14) : 2;
        f32x4 xv[R][4];
#pragma unroll
        for (int u = 0; u < R; ++u) {
            const int r = rb + u;
            if (FIRST) { const float* src = r < NLAT ? P.x + (size_t)r * DM : P.ctx + (size_t)(r - NLAT) * DM;
#pragma unroll
                for (int q = 0; q < 4; ++q) xv[u][q] = __builtin_nontemporal_load((const f32x4*)(src + q * 256 + lane * 4)); }
            else { const f16* src = P.X() + (size_t)r * DM;
#pragma unroll
                for (int q = 0; q < 4; ++q) xv[u][q] = cvt4(*(const f16x4*)(src + q * 256 + lane * 4)); }
        }
        if (!FIRST) {
            const int sl = P.inv()[(size_t)(lane & 15) * MROWS + rb + (lane >> 4)];
            const float af = P.aff()[(size_t)(lane & 15) * MROWS + rb + (lane >> 4)];
            const unsigned long long bal = __builtin_amdgcn_ballot_w64(sl >= 0);
            unsigned m[R];
#pragma unroll
            for (int u = 0; u < R; ++u) m[u] = (unsigned)(bal >> (16 * u)) & 0xffffu;
            const f16* ys = P.yslot();
            const float* g2 = modp(P, l - 1, v, 5);
            f32x4 gv[4];
#pragma unroll
            for (int q = 0; q < 4; ++q) gv[q] = *(const f32x4*)(g2 + q * 256 + lane * 4);
            while (m[0] | m[1] | m[2] | m[3]) {
                f16x4 yv[R][4]; float w[R];
#pragma unroll
                for (int u = 0; u < R; ++u) {
                    const int e = m[u] ? __builtin_ctz(m[u]) : 0;
                    const int sv = m[u] ? __builtin_amdgcn_readlane(sl, 16 * u + e) : 0;
                    w[u] = m[u] ? __int_as_float(__builtin_amdgcn_readlane(__float_as_int(af), 16 * u + e)) : 0.f;
                    m[u] &= m[u] - 1u;
                    const f16* y = ys + ((size_t)e * SLOTS_PAD + sv) * DM + lane * 4;
#pragma unroll
                    for (int q = 0; q < 4; ++q) yv[u][q] = *(const f16x4*)(y + q * 256);
                }
#pragma unroll
                for (int u = 0; u < R; ++u)
#pragma unroll
                    for (int q = 0; q < 4; ++q) xv[u][q] += (w[u] * gv[q]) * cvt4(yv[u][q]);
            }
        }
        if (FINAL) {
#pragma unroll
            for (int u = 0; u < R; ++u)
#pragma unroll
                for (int q = 0; q < 4; ++q) __builtin_nontemporal_store(xv[u][q], (f32x4*)(P.out + (size_t)(rb + u) * DM + q * 256 + lane * 4));
            continue;
        }
        float ss[R];
#pragma unroll
        for (int u = 0; u < R; ++u) {
            f16* xd = P.Xw() + (size_t)(rb + u) * DM; float sacc = 0.f;
#pragma unroll
            for (int q = 0; q < 4; ++q) { *(f16x4*)(xd + q * 256 + lane * 4) = pk4(xv[u][q]); sacc += dot4(xv[u][q], xv[u][q]); }
            ss[u] = sacc;
        }
#pragma unroll
        for (int u = 0; u < R; ++u) ss[u] = rsqrtf(wave_sum(ss[u], lane) * (1.0f / DM) + 1e-6f);
        const float* g = P.norm1_g + l * DM; const float* sh = modp(P, l, v, 0); const float* scl = modp(P, l, v, 1);
#pragma unroll
        for (int q = 0; q < 4; ++q) {
            const int c0 = q * 256 + lane * 4;
            const f32x4 gq = *(const f32x4*)(g + c0), sq = *(const f32x4*)(sh + c0), cq = *(const f32x4*)(scl + c0);
            const f32x4 gm = gq * (1.0f + cq);
#pragma unroll
            for (int u = 0; u < R; ++u) *(f16x4*)(P.Hw() + (size_t)(rb + u) * DM + c0) = rm4(pk4(xv[u][q] * ss[u] * gm + sq));
        }
    }
}

#define N2_ZST 81920
template <bool POOL>
__device__ __forceinline__ void phase_n2(const Params& P, int l, int bid, int nb, float* lds, int nrows = MROWS) {
    const int tid = opaque_tid(), wid = P.wv, lane = tid & 63;
    const float* wr = P.router_w + (size_t)l * DM * NEXP;
    f16* wh = (f16*)lds;
    for (int i = tid; i < DM * NEXP; i += NTHR) { const int d = i >> 4, e = i & 15; wh[e * 1032 + d] = (f16)wr[i]; }
    f16* h2s = (f16*)lds + 16640;
    LAS unsigned char* zst = (LAS unsigned char*)lds + N2_ZST;
    const int j = l >> 1, nblk = nrows >> 4;
    const f16* Zg = P.Z();
    const f16* Xg = P.X();
    f16x4 xr[2][4]; f16x4 zr[2][4];
    auto prefetch = [&](int blk) {
        const int R0 = blk * 16, rb = R0 + wid * 2;
        if (POOL) {
            int s0, L; if (R0 < NLAT) { s0 = (R0 >> 14) << 14; L = SEQ; } else { s0 = NLAT + (((R0 - NLAT) >> 8) << 8); L = CTXL; }
#pragma unroll
            for (int i = 0; i < 8; ++i) { const int piece = wid * 8 + i; int rr = R0 - 8 + (piece >> 1); rr = rr < s0 ? s0 : (rr > s0 + L - 1 ? s0 + L - 1 : rr);
                __builtin_amdgcn_global_load_lds((const unsigned*)(Zg + (size_t)rr * DM + (piece & 1) * 512 + lane * 8), (LAS unsigned*)(zst + piece * 1024), 16, 0, 0); }
        } else {
#pragma unroll
            for (int u = 0; u < 2; ++u)
#pragma unroll
                for (int q = 0; q < 4; ++q) zr[u][q] = *(const f16x4*)(Zg + (size_t)(rb + u) * DM + q * 256 + lane * 4);
        }
#pragma unroll
        for (int u = 0; u < 2; ++u)
#pragma unroll
            for (int q = 0; q < 4; ++q) xr[u][q] = *(const f16x4*)(Xg + (size_t)(rb + u) * DM + q * 256 + lane * 4);
    };
    int blk = bid;
    if (blk < nblk) prefetch(blk);
    __syncthreads();
    while (blk < nblk) {
        const int R0 = blk * 16, rb = R0 + wid * 2;
        int v, s0, L;
        if (rb < NLAT) { v = rb >> 14; s0 = v << 14; L = SEQ; } else { v = 2; s0 = NLAT + (((rb - NLAT) >> 8) << 8); L = CTXL; }
        const int t = rb - s0;
        if (POOL) asm volatile("s_waitcnt vmcnt(16)" ::: "memory");
        f32x4 g1v[4], gmv[4], shv[4], psv[4];
        { const float* g1 = modp(P, l, v, 2); const float* g = P.norm2_g + l * DM; const float* sh = modp(P, l, v, 3); const float* scl = modp(P, l, v, 4);
#pragma unroll
            for (int q = 0; q < 4; ++q) { const int c0 = q * 256 + lane * 4;
                g1v[q] = *(const f32x4*)(g1 + c0); const f32x4 gv = *(const f32x4*)(g + c0), cv = *(const f32x4*)(scl + c0); shv[q] = *(const f32x4*)(sh + c0); gmv[q] = gv * (1.0f + cv);
                if (POOL) psv[q] = *(const f32x4*)(P.pool_scale + j * DM + c0); } }
        f32x4 y[2][4];
        if (POOL) {
            asm volatile("s_waitcnt lgkmcnt(0)" ::: "memory"); __builtin_amdgcn_s_barrier(); asm volatile("" ::: "memory");
            if (t >= 8 && t + 9 < L) {
#pragma unroll
                for (int q = 0; q < 4; ++q) {
                    const int h = 1 << q;
                    const LAS f16* zb = (const LAS f16*)zst + q * 256 + lane * 4 + (2 * wid + 8) * DM;
#define ZROW(d) (*(const LAS f16x4*)(zb + (d) * DM))
                    const f32x4 z0 = cvt4(ZROW(-h)), z1 = cvt4(ZROW(h)), own0 = cvt4(ZROW(0)), own1 = (h == 1) ? z1 : cvt4(ZROW(1));
                    f32x4 common = (f32x4){0.f, 0.f, 0.f, 0.f};
#pragma unroll
                    for (int d = -h + 1; d + 1 <= h - 1; d += 2) { const f16x4 pr = ZROW(d) + ZROW(d + 1); common += cvt4(pr); }
                    common += cvt4(ZROW(h - 1));
#undef ZROW
                    const float inv = 0.5f / (float)h;
                    y[0][q] = ((common + z0) * inv - own0) * psv[q];
                    y[1][q] = ((common + z1) * inv - own1) * psv[q];
                }
            } else {
#pragma unroll
            for (int q = 0; q < 4; ++q) {
                const int h = 1 << q;
                const LAS f16* zb = (const LAS f16*)zst + q * 256 + lane * 4;
                f32x4 common = (f32x4){0.f, 0.f, 0.f, 0.f}, z0 = common, z1 = common;
#pragma unroll
                for (int d = -h; d <= h; ++d) {
                    const int tt = t + d; const bool ok = tt >= 0 && tt < L;
                    f32x4 zz = cvt4(*(const LAS f16x4*)(zb + (2 * wid + 8 + d) * DM));
                    if (!ok) zz = (f32x4){0.f, 0.f, 0.f, 0.f};
                    if (d == -h) z0 = zz; else if (d == h) z1 = zz; else common += zz;
                    if (d == 0) y[0][q] = zz;
                    if (d == 1) y[1][q] = zz;
                }
                const int c0n = min(t + h, L) - max(t - h, 0), c1n = min(t + 1 + h, L) - max(t + 1 - h, 0);
                y[0][q] = ((common + z0) * (1.0f / (float)c0n) - y[0][q]) * psv[q];
                y[1][q] = ((common + z1) * (1.0f / (float)c1n) - y[1][q]) * psv[q];
            }
            }
            asm volatile("s_waitcnt lgkmcnt(0)" ::: "memory"); __builtin_amdgcn_s_barrier(); asm volatile("" ::: "memory");
        } else {
#pragma unroll
            for (int u = 0; u < 2; ++u)
#pragma unroll
                for (int q = 0; q < 4; ++q) y[u][q] = cvt4(zr[u][q]);
        }
        f32x4 xv[2][4]; float ss[2] = {0.f, 0.f};
#pragma unroll
        for (int q = 0; q < 4; ++q) {
#pragma unroll
            for (int u = 0; u < 2; ++u) { xv[u][q] = cvt4(xr[u][q]) + g1v[q] * y[u][q]; ss[u] += dot4(xv[u][q], xv[u][q]); }
        }
        const int nxt = blk + nb;
        asm volatile("" ::: "memory");
        if (nxt < nblk) prefetch(nxt);
#pragma unroll
        for (int u = 0; u < 2; ++u)
#pragma unroll
            for (int q = 0; q < 4; ++q) *(f16x4*)(P.Xw() + (size_t)(rb + u) * DM + q * 256 + lane * 4) = pk4(xv[u][q]);
        ss[0] = wave_sum(ss[0], lane); ss[1] = wave_sum(ss[1], lane);
        const float rs[2] = {rsqrtf(ss[0] * (1.0f / DM) + 1e-6f), rsqrtf(ss[1] * (1.0f / DM) + 1e-6f)};
        f16x4 h2h[2][4];
#pragma unroll
        for (int q = 0; q < 4; ++q) {
            const int c0 = q * 256 + lane * 4;
#pragma unroll
            for (int u = 0; u < 2; ++u) { h2h[u][q] = pk4(xv[u][q] * rs[u] * gmv[q] + shv[q]); *(f16x4*)(P.Hw() + (size_t)(rb + u) * DM + c0) = rm4(h2h[u][q]); }
        }
        asm volatile("s_waitcnt lgkmcnt(0)" ::: "memory"); __builtin_amdgcn_s_barrier(); asm volatile("" ::: "memory");
#pragma unroll
        for (int q = 0; q < 4; ++q)
#pragma unroll
            for (int u = 0; u < 2; ++u) *(f16x4*)(h2s + (2 * wid + u) * 1032 + q * 256 + lane * 4) = h2h[u][q];
        asm volatile("s_waitcnt lgkmcnt(0)" ::: "memory"); __builtin_amdgcn_s_barrier(); asm volatile("" ::: "memory");
        {
            const int r16 = lane & 15, kq = lane >> 4;
            f32x4 pl = (f32x4){0.f, 0.f, 0.f, 0.f};
#pragma unroll
            for (int ks = 0; ks < 4; ++ks) {
                const f16x8 av = *(const f16x8*)(h2s + r16 * 1032 + wid * 128 + ks * 32 + kq * 8), bv = *(const f16x8*)(wh + r16 * 1032 + wid * 128 + ks * 32 + kq * 8);
                pl = __builtin_amdgcn_mfma_f32_16x16x32_f16(av, bv, pl, 0, 0, 0);
            }
            *(f32x4*)(lds + 16640 + (wid * 64 + lane) * 4) = pl;
            asm volatile("s_waitcnt lgkmcnt(0)" ::: "memory"); __builtin_amdgcn_s_barrier(); asm volatile("" ::: "memory");
        }
        if (wid == 0) {
            const int r16 = lane & 15, kq = lane >> 4;
            f32x4 lg = (f32x4){0.f, 0.f, 0.f, 0.f};
#pragma unroll
            for (int w = 0; w < 8; ++w) lg += *(const f32x4*)(lds + 16640 + (w * 64 + lane) * 4);
#pragma unroll
            for (int jj = 0; jj < 4; ++jj) {
                float mx = lg[jj];
                mx = fmaxf(mx, shx<1>(mx, lane)); mx = fmaxf(mx, shx<2>(mx, lane)); mx = fmaxf(mx, shx<4>(mx, lane)); mx = fmaxf(mx, shx<8>(mx, lane));
                const float pe = __expf(lg[jj] - mx);
                float den = pe;
                den += shx<1>(den, lane); den += shx<2>(den, lane); den += shx<4>(den, lane); den += shx<8>(den, lane);
                P.affw()[(size_t)r16 * MROWS + R0 + 4 * kq + jj] = pe * __builtin_amdgcn_rcpf(den);
            }
        }
        blk = nxt;
    }
}

__device__ __forceinline__ void phase_topk(const Params& P, int bid, int nb, unsigned* lds, int nprob = 64) {
    unsigned* hist = lds; unsigned* misc = lds + 256; unsigned* wsa = lds + 272; unsigned* wsb = lds + 288;
    const int tid = opaque_tid(), wid = tid >> 6, lane = tid & 63;
    for (int p = bid; p < nprob; p += nb) {
        const int set = p >> 4, e = p & 15;
        const int n = set < 2 ? SEQ : CTXL, C = n >> 3;
        const int r0 = set < 2 ? set * SEQ : NLAT + (set - 2) * CTXL;
        const int slot0 = set < 2 ? set * 2048 : 4096 + (set - 2) * 32;
        unsigned key[32];
#pragma unroll
        for (int i4 = 0; i4 < 8; ++i4) { const int idx = tid * 32 + i4 * 4;
            f32x4 v = (f32x4){0.f, 0.f, 0.f, 0.f}; if (idx < n) v = *(const f32x4*)(P.aff() + (size_t)e * MROWS + r0 + idx);
#pragma unroll
            for (int jj = 0; jj < 4; ++jj) key[i4 * 4 + jj] = idx < n ? (__float_as_uint(v[jj]) + 1u) : 0u; }
        unsigned T = 0u;
        for (int bit = 29; bit >= 0; --bit) {
            const unsigned cand = T | (1u << bit);
            unsigned wc = 0u;
#pragma unroll
            for (int i = 0; i < 32; ++i) wc += (unsigned)__builtin_popcountll(__builtin_amdgcn_ballot_w64(key[i] >= cand));
            unsigned* cb = misc + ((bit & 1) << 3);
            if (lane == 0) cb[wid] = wc;
            __syncthreads();
            unsigned tot = 0u;
#pragma unroll
            for (int w = 0; w < 8; ++w) tot += cb[w];
            if (tot >= (unsigned)C) T = cand;
            if (tot == (unsigned)C) { T = cand - 1u; break; }
        }
        unsigned cg = 0u, ce = 0u;
#pragma unroll
        for (int i = 0; i < 32; ++i) { cg += key[i] > T ? 1u : 0u; ce += key[i] == T ? 1u : 0u; }
        unsigned ig = cg, ie = ce;
#pragma unroll
        for (int o = 1; o < 64; o <<= 1) { const unsigned a = shup(ig, o, lane), b = shup(ie, o, lane); if (lane >= o) { ig += a; ie += b; } }
        if (lane == 63) { wsa[wid] = ig; wsb[wid] = ie; }
        __syncthreads();
        unsigned bg = 0u, be = 0u, totg = 0u;
#pragma unroll
        for (int w = 0; w < 8; ++w) { const unsigned ga = wsa[w]; totg += ga; if (w < wid) { bg += ga; be += wsb[w]; } }
        const unsigned krem = (unsigned)C - totg;
        unsigned pg = bg + ig - cg, pe = be + ie - ce;
#pragma unroll
        for (int i4 = 0; i4 < 8; ++i4) {
            int iv[4];
#pragma unroll
            for (int jj = 0; jj < 4; ++jj) {
                const int i = i4 * 4 + jj, idx = tid * 32 + i;
                bool sel = false; unsigned rank = 0u;
                if (key[i] > T) { sel = true; rank = pg + (pe < krem ? pe : krem); ++pg; }
                else if (key[i] == T && key[i] != 0u) { if (pe < krem) { sel = true; rank = pg + pe; } ++pe; }
                if (sel) P.rowidx()[e * SLOTS_PAD + slot0 + (int)rank] = r0 + idx;
                iv[jj] = sel ? slot0 + (int)rank : -1;
            }
            if (tid * 32 + i4 * 4 < n) *(int4*)(P.inv() + (size_t)e * MROWS + r0 + tid * 32 + i4 * 4) = make_int4(iv[0], iv[1], iv[2], iv[3]);
        }
        if (set == 3) for (int i = SLOTS + tid; i < SLOTS_PAD; i += NTHR) P.rowidx()[e * SLOTS_PAD + i] = 0;
        __syncthreads();
    }
}

#define XB_TMO      128
#define XB_XCNT(j)  (256  + 64 * (j))
#define XB_XSUB(j)  (1280 + 64 * (j))
#define XB_XGEN(j)  (2304 + 64 * (j))
#define XB_TOP      3328
#define XB_TOPGEN   3392
#define XCD_BAR_WORDS 3456
#define XB_SPIN_CAP (1u << 18)
__device__ __forceinline__ unsigned xb_ld(unsigned* p)              { return __hip_atomic_load(p, __ATOMIC_RELAXED, __HIP_MEMORY_SCOPE_AGENT); }
__device__ __forceinline__ unsigned xb_add(unsigned* p, unsigned v) { return __hip_atomic_fetch_add(p, v, __ATOMIC_RELAXED, __HIP_MEMORY_SCOPE_AGENT); }
__device__ __forceinline__ unsigned xb_xcc_id() { return (unsigned)__builtin_amdgcn_s_getreg((3 << 11) | 20) & 0xFu; }
#define XB_SPIN(cond, bar) do { unsigned _sp = 0; while (cond) { __builtin_amdgcn_s_sleep(1); \
    if ((++_sp & 255u) == 0u) { if (xb_ld(&(bar)[XB_TMO])) break; if (_sp > XB_SPIN_CAP) { atomicAdd(&(bar)[XB_TMO], 1u); break; } } } } while (0)
struct XcdBarrier { unsigned* bar; unsigned x; volatile LAS unsigned* st; };
__device__ __forceinline__ XcdBarrier xcd_barrier_post(unsigned* bar, volatile LAS unsigned* st) {
    XcdBarrier b; b.bar = bar; b.x = xb_xcc_id(); b.st = st;
    if (threadIdx.x == 0) (void)xb_add(&bar[XB_XCNT(b.x)], 1u);
    return b;
}
__device__ __forceinline__ void xcd_barrier_complete(unsigned* bar, unsigned x, unsigned& nloc, unsigned& nx) {
    const unsigned G = gridDim.x * gridDim.y * gridDim.z;
    unsigned sum, cnt, mine, sp = 0u;
    for (;;) {
        sum = 0u; cnt = 0u; mine = 0u;
#pragma unroll
        for (unsigned j = 0; j < 16; ++j) { const unsigned c = xb_ld(&bar[XB_XCNT(j)]); sum += c; cnt += (c > 0u) ? 1u : 0u; mine = (j == x) ? c : mine; }
        if (sum == G) break;
        __builtin_amdgcn_s_sleep(1);
        if ((++sp & 255u) == 0u) { if (xb_ld(&bar[XB_TMO])) break; if (sp > XB_SPIN_CAP) { atomicAdd(&bar[XB_TMO], 1u); break; } }
    }
    nloc = mine > 0u ? mine : 1u; nx = cnt > 0u ? cnt : 1u;
}
__device__ __forceinline__ void xcd_barrier(const XcdBarrier& b) {
    asm volatile("s_waitcnt vmcnt(0)" ::: "memory");
    __syncthreads();
    if (threadIdx.x == 0) {
        unsigned* bar = b.bar; asm volatile("" : "+s"(bar));
        const unsigned bx = (unsigned)__builtin_amdgcn_readfirstlane((int)xb_xcc_id());
        __builtin_amdgcn_s_waitcnt(0);
        unsigned nloc = b.st[0], nx = b.st[1];
        if (nloc == 0u) { xcd_barrier_complete(bar, bx, nloc, nx); b.st[0] = nloc; b.st[1] = nx; }
        const unsigned old = xb_add(&bar[XB_XSUB(bx)], 1u);
        const unsigned gen = old / nloc;
        if (old + 1u == (gen + 1u) * nloc) {
            __builtin_amdgcn_fence(__ATOMIC_RELEASE, "agent");
            asm volatile("s_waitcnt vmcnt(0)" ::: "memory");
            const unsigned og = xb_add(&bar[XB_TOP], 1u);
            const unsigned tg = og / nx;
            if (og + 1u == (tg + 1u) * nx) xb_add(&bar[XB_TOPGEN], 1u);
            else XB_SPIN(xb_ld(&bar[XB_TOPGEN]) == tg, bar);
            __builtin_amdgcn_fence(__ATOMIC_ACQUIRE, "agent");
            xb_add(&bar[XB_XGEN(bx)], 1u);
            asm volatile("s_waitcnt vmcnt(0)" ::: "memory");
        } else {
            XB_SPIN(xb_ld(&bar[XB_XGEN(bx)]) == gen, bar);
            __builtin_amdgcn_fence(__ATOMIC_ACQUIRE, "agent");
            asm volatile("s_waitcnt vmcnt(0)" ::: "memory");
        }
    }
    __syncthreads();
}

namespace fg {
constexpr int BM = 256, BK = 64, HALF = 128, HTB = HALF * BK * 2, STAGE_BYTES = 8 * HTB;
__device__ __forceinline__ int lds_byte(int r, int c) { const int st = (r >> 4) * 2 + (c >> 5), rr = r & 15, cc = c & 31, ob = rr * 64 + cc * 2; return st * 1024 + (ob ^ (((ob >> 9) & 1) << 5)); }
__device__ __forceinline__ void stage_rc(int b, int& R, int& C) { const int st = b / 1024, sb = b % 1024, swz = sb ^ (((sb >> 9) & 1) << 5); R = (st >> 1) * 16 + swz / 64; C = (st & 1) * 32 + (swz % 64) / 2; }
__device__ __forceinline__ int perm32(int rho) { const int n = rho >> 4, i = rho & 15; return 8 * (i >> 2) + 4 * n + (i & 3); }
#define KDUP 0
struct Unit { int e, pm, pn; int skip; };
__device__ __forceinline__ void xcd_order(int i, int& T) { const int c = blockIdx.x; T = i * (int)gridDim.x + c; }

template <class PR>
__device__ __forceinline__ void gemm_phase(LAS unsigned char* lds, const PR& S, int wv) {
    const int tid = opaque_tid_(wv), wid = __builtin_amdgcn_readfirstlane(tid >> 6), lane = tid & 63, wr = wid >> 2, wc = wid & 3, fr = lane & 15, fq = lane >> 4;
    constexpr int K = PR::K, nt = K / BK;
    unsigned voffB[2];
#pragma unroll
    for (int i = 0; i < 2; ++i) { int R, C; stage_rc(tid * 16 + i * 8192, R, C); const int Rb = (R & ~31) + perm32(R & 31); voffB[i] = (unsigned)(Rb * PR::LDB + C) * 2u; }
    const size_t kstep = (size_t)(BK * 2);
    const size_t hB = S.hstepB();
    const unsigned ldsw = (unsigned)wid * 1024u;
    const int aoff = lds_byte(wr * 64 + fr, fq * 8), boff = lds_byte(wc * 32 + fr, fq * 8);
#define FG_SA(b, h) (((b) * 2 + (h)) * HTB)
#define FG_SB(b, h) ((4 + (b) * 2 + (h)) * HTB)
#define FG_STAGE(bufoff, gbase, voff) do { _Pragma("unroll") for (int _i = 0; _i < 2; ++_i) \
        __builtin_amdgcn_global_load_lds((const unsigned*)((const char*)(gbase) + (voff)[_i]), (LAS unsigned*)(lds + (bufoff) + ldsw + _i * 8192), 16, 0, 0); } while (0)
#define FG_LDA(dst, b, h) do { _Pragma("unroll") for (int m = 0; m < 4; ++m) _Pragma("unroll") for (int k = 0; k < 2; ++k) dst[m][k] = *(const LAS f16x8*)(lds + FG_SA(b, h) + aoff + m * 2048 + k * 1024); } while (0)
#define FG_LDB(dst, b, h) do { _Pragma("unroll") for (int n = 0; n < 2; ++n) _Pragma("unroll") for (int k = 0; k < 2; ++k) dst[n][k] = *(const LAS f16x8*)(lds + FG_SB(b, h) + boff + n * 2048 + k * 1024); } while (0)
#define FG_MMA(ai, bj, At, Bt) do { __builtin_amdgcn_s_setprio(1); _Pragma("unroll") for (int m = 0; m < 4; ++m) _Pragma("unroll") for (int n = 0; n < 2; ++n) _Pragma("unroll") for (int k = 0; k < 2; ++k) \
        acc[ai][bj][m][n] = __builtin_amdgcn_mfma_f32_16x16x32_f16(Bt[n][k], At[m][k], acc[ai][bj][m][n], 0, 0, 0); __builtin_amdgcn_s_setprio(0); } while (0)
#define FG_WAIT_V(n) asm volatile("s_waitcnt vmcnt(" #n ")" ::: "memory")
#define FG_WAIT_L(n) asm volatile("s_waitcnt lgkmcnt(" #n ")" ::: "memory")
#define FG_BAR __builtin_amdgcn_s_barrier()
#define FG_SCHED __builtin_amdgcn_sched_barrier(0)
    Unit cur, nxt; int ui = 0;
    if (!S.next(0, cur)) return;
    f32x4 acc[2][2][4][2];
#pragma unroll
    for (int a = 0; a < 2; ++a)
#pragma unroll
        for (int b = 0; b < 2; ++b)
#pragma unroll
            for (int m = 0; m < 4; ++m)
#pragma unroll
                for (int n = 0; n < 2; ++n) acc[a][b][m][n] = (f32x4){0.f, 0.f, 0.f, 0.f};
    f16x8 At[4][2], B0[2][2], B1[2][2];
    unsigned vA[2][2], vN[2][2];
    { int Rr[2], Cc[2]; stage_rc(tid * 16, Rr[0], Cc[0]); stage_rc(tid * 16 + 8192, Rr[1], Cc[1]); S.a_voff(cur, Rr, Cc, vA); }
#pragma unroll
    for (int h = 0; h < 2; ++h)
#pragma unroll
        for (int i = 0; i < 2; ++i) { asm volatile("" : "+v"(vA[h][i])); vN[h][i] = vA[h][i]; }
    const char* cA = S.a_base(cur); const char* cB = S.b_base(cur);
    FG_STAGE(FG_SB(0, 0), cB, voffB); FG_STAGE(FG_SA(0, 0), cA, vA[0]); FG_STAGE(FG_SB(0, 1), cB + hB, voffB); FG_STAGE(FG_SA(0, 1), cA, vA[1]);
    if (wr == 1) FG_BAR;
    FG_WAIT_V(4); FG_BAR;
    FG_STAGE(FG_SB(1, 0), cB + kstep, voffB); FG_STAGE(FG_SA(1, 0), cA + kstep, vA[0]); FG_STAGE(FG_SB(1, 1), cB + hB + kstep, voffB);
    FG_WAIT_V(6); FG_BAR;
    for (;;) {
        const bool has_next = S.next(ui + 1, nxt);
        const char* nA = has_next ? S.a_base(nxt) : cA; const char* nB = has_next ? S.b_base(nxt) : cB;
        if (has_next) { int Rr[2], Cc[2]; int t2 = tid; asm volatile("" : "+v"(t2)); stage_rc(t2 * 16, Rr[0], Cc[0]); stage_rc(t2 * 16 + 8192, Rr[1], Cc[1]); S.a_voff(nxt, Rr, Cc, vN);
#pragma unroll
            for (int h = 0; h < 2; ++h)
#pragma unroll
                for (int i = 0; i < 2; ++i) asm volatile("" : "+v"(vN[h][i])); }
#pragma unroll 1
        for (int t = 0; t < nt; t += 2) {
            const bool last = (t == nt - 2);
            const char* a1 = cA + (size_t)(t + 1) * kstep;
            const char* a2 = last ? nA : cA + (size_t)(t + 2) * kstep; const char* b2 = last ? nB : cB + (size_t)(t + 2) * kstep;
            const char* a3 = a2 + kstep; const char* b3 = b2 + kstep;
            unsigned v2[2][2];
#pragma unroll
            for (int h = 0; h < 2; ++h)
#pragma unroll
                for (int i = 0; i < 2; ++i) v2[h][i] = last ? vN[h][i] : vA[h][i];
            FG_LDB(B0, 0, 0); FG_SCHED; FG_LDA(At, 0, 0); FG_STAGE(FG_SA(1, 1), a1, vA[1]);
            FG_WAIT_L(8); FG_BAR; FG_WAIT_L(0); FG_MMA(0, 0, At, B0); FG_BAR; FG_SCHED;
            FG_LDB(B1, 0, 1); FG_STAGE(FG_SB(0, 0), b2, voffB);
            FG_BAR; FG_WAIT_L(0); FG_MMA(0, 1, At, B1); FG_BAR;
            FG_LDA(At, 0, 1); FG_STAGE(FG_SA(0, 0), a2, v2[0]);
            FG_BAR; FG_WAIT_L(0); FG_MMA(1, 0, At, B0); FG_BAR; FG_SCHED;
            FG_STAGE(FG_SB(0, 1), b2 + hB, voffB);
            FG_WAIT_V(6); FG_BAR; FG_MMA(1, 1, At, B1); FG_BAR;
            FG_LDB(B0, 1, 0); FG_SCHED; FG_LDA(At, 1, 0); FG_STAGE(FG_SA(0, 1), a2, v2[1]);
            FG_WAIT_L(8); FG_BAR; FG_WAIT_L(0); FG_MMA(0, 0, At, B0); FG_BAR; FG_SCHED;
            FG_LDB(B1, 1, 1); FG_STAGE(FG_SB(1, 0), b3, voffB);
            FG_BAR; FG_WAIT_L(0); FG_MMA(0, 1, At, B1); FG_BAR;
            FG_LDA(At, 1, 1); FG_STAGE(FG_SA(1, 0), a3, v2[0]);
            FG_BAR; FG_WAIT_L(0); FG_MMA(1, 0, At, B0); FG_BAR; FG_SCHED;
            FG_STAGE(FG_SB(1, 1), b3 + hB, voffB);
            FG_WAIT_V(6); FG_BAR; FG_MMA(1, 1, At, B1); FG_BAR;
        }
        if (!KDUP || !cur.skip) S.epi(acc, cur, wr, wc, fr, fq);
        if (!has_next) break;
#pragma unroll
        for (int a = 0; a < 2; ++a)
#pragma unroll
            for (int b = 0; b < 2; ++b)
#pragma unroll
                for (int m = 0; m < 4; ++m)
#pragma unroll
                    for (int n = 0; n < 2; ++n) acc[a][b][m][n] = (f32x4){0.f, 0.f, 0.f, 0.f};
        cur = nxt; cA = nA; cB = nB; ++ui;
#pragma unroll
        for (int h = 0; h < 2; ++h)
#pragma unroll
            for (int i = 0; i < 2; ++i) vA[h][i] = vN[h][i];
    }
    FG_WAIT_V(0);
    if (wr == 0) FG_BAR;
    FG_BAR;
#undef FG_SA
#undef FG_SB
#undef FG_STAGE
#undef FG_LDA
#undef FG_LDB
#undef FG_MMA
#undef FG_WAIT_V
#undef FG_WAIT_L
#undef FG_BAR
#undef FG_SCHED
}

__device__ __forceinline__ f16x8 pack8(const f32x4 a, const f32x4 b) { return (f16x8){(f16)a[0], (f16)a[1], (f16)a[2], (f16)a[3], (f16)b[0], (f16)b[1], (f16)b[2], (f16)b[3]}; }

template <int K_, int LDA_, int LDB_> struct PRBase {
    static constexpr int K = K_, LDA = LDA_, LDB = LDB_;
    __device__ __forceinline__ void plain_voff(const int (&R)[2], const int (&C)[2], unsigned (&v)[2][2]) const {
#pragma unroll
        for (int h = 0; h < 2; ++h)
#pragma unroll
            for (int i = 0; i < 2; ++i) v[h][i] = (unsigned)((h * HALF + R[i]) * LDA + C[i]) * 2u;
    }
};
struct PRGateUp : PRBase<1024, 1024, 1024> {
    const f16* H; const int* rowidx; const f16* W; f16* act; int nunits; int bid; int rt;
    __device__ __forceinline__ size_t hstepB() const { return (size_t)DEXP * DM * 2; }
    __device__ __forceinline__ bool next(int i, Unit& u) const { const int ii = KDUP ? (i >> 1) : i; const int T = ii * (int)gridDim.x + bid; u.skip = KDUP ? ((i & 1) == 0) : 0; if (T >= nunits) return false;
        if (rt == 16 && gridDim.x == 256) { const int x = bid & 7, jj = bid >> 3; u.e = ii; u.pm = (x >> 1) * 4 + (jj >> 3); u.pn = (x & 1) * 8 + (jj & 7); return true; }
        const int per = rt * 16; u.e = T / per; const int t = T % per; u.pm = t >> 4; u.pn = t & 15; return true; }
    __device__ __forceinline__ const char* a_base(const Unit&) const { return (const char*)H; }
    __device__ __forceinline__ void a_voff(const Unit& u, const int (&R)[2], const int (&C)[2], unsigned (&v)[2][2]) const {
        const int* ri = rowidx + u.e * SLOTS_PAD + u.pm * BM;
#pragma unroll
        for (int h = 0; h < 2; ++h)
#pragma unroll
            for (int i = 0; i < 2; ++i) { const int g = ri[h * HALF + R[i]]; v[h][i] = (unsigned)(g * LDA + C[i]) * 2u; }
    }
    __device__ __forceinline__ const char* b_base(const Unit& u) const { return (const char*)(W + ((size_t)u.e * 2 * DEXP + (size_t)u.pn * HALF) * DM); }
    __device__ __forceinline__ void epi(const f32x4 (&acc)[2][2][4][2], const Unit& u, int wr, int wc, int fr, int fq) const {
        f16* base = act + ((size_t)u.e * SLOTS_PAD + (size_t)u.pm * BM + wr * 64 + fr) * DEXP + u.pn * HALF + wc * 32 + fq * 8;
#pragma unroll
        for (int ai = 0; ai < 2; ++ai)
#pragma unroll
            for (int m = 0; m < 4; ++m) {
                f32x4 o0, o1;
#pragma unroll
                for (int j = 0; j < 4; ++j) { o0[j] = silu_f(acc[ai][0][m][0][j]) * acc[ai][1][m][0][j]; o1[j] = silu_f(acc[ai][0][m][1][j]) * acc[ai][1][m][1][j]; }
                if (u.e < 8) __builtin_nontemporal_store(rm8(pack8(o0, o1)), (f16x8*)(base + (size_t)(ai * HALF + m * 16) * DEXP));
                else *(f16x8*)(base + (size_t)(ai * HALF + m * 16) * DEXP) = rm8(pack8(o0, o1));
            }
    }
};
struct PRDown : PRBase<2048, 2048, 2048> {
    const f16* act; const f16* W; f16* y; int nunits; int bid; int rt;
    __device__ __forceinline__ size_t hstepB() const { return (size_t)HALF * DEXP * 2; }
    __device__ __forceinline__ bool next(int i, Unit& u) const { const int ii = KDUP ? (i >> 1) : i; const int T = ii * (int)gridDim.x + bid; u.skip = KDUP ? ((i & 1) == 0) : 0; if (T >= nunits) return false;
        if (rt == 16 && gridDim.x == 256) { const int x = bid & 7, jj = bid >> 3; u.e = 15 - (ii * 4 + (x >> 1)); u.pm = (x & 1) * 8 + (jj >> 2); u.pn = jj & 3; return true; }
        const int per = rt * 4; u.e = T / per; const int t = T % per; u.pm = t >> 2; u.pn = t & 3; return true; }
    __device__ __forceinline__ const char* a_base(const Unit& u) const { return (const char*)(act + ((size_t)u.e * SLOTS_PAD + (size_t)u.pm * BM) * DEXP); }
    __device__ __forceinline__ void a_voff(const Unit&, const int (&R)[2], const int (&C)[2], unsigned (&v)[2][2]) const { plain_voff(R, C, v); }
    __device__ __forceinline__ const char* b_base(const Unit& u) const { return (const char*)(W + ((size_t)u.e * DM + (size_t)u.pn * BM) * DEXP); }
    __device__ __forceinline__ void epi(const f32x4 (&acc)[2][2][4][2], const Unit& u, int wr, int wc, int fr, int fq) const {
        f16* base = y + ((size_t)u.e * SLOTS_PAD + (size_t)u.pm * BM + wr * 64 + fr) * DM + u.pn * BM + wc * 32 + fq * 8;
#pragma unroll
        for (int ai = 0; ai < 2; ++ai)
#pragma unroll
            for (int m = 0; m < 4; ++m)
#pragma unroll
                for (int bj = 0; bj < 2; ++bj) *(f16x8*)(base + (size_t)(ai * HALF + m * 16) * DM + bj * HALF) = pack8(acc[ai][bj][m][0], acc[ai][bj][m][1]);
    }
};
template <int K_> struct PRDense : PRBase<K_, 1024, K_> {
    const f16* A; const f16* W; f16* O0; f16* O1; f16* O2; int ncol; int mode; int bid; int npan; int kvx;
    __device__ __forceinline__ size_t hstepB() const { return (size_t)HALF * K_ * 2; }
    __device__ __forceinline__ bool next(int i, Unit& u) const { const int ii = KDUP ? (i >> 1) : i; int T = ii * (int)gridDim.x + bid; if (gridDim.x == 256) T = (ii * 8 + (bid & 7)) * 32 + (bid >> 3);
        u.skip = KDUP ? ((i & 1) == 0) : 0; const int nu = npan * ncol; if (T >= nu + kvx) return false; u.e = 0; if (T < nu) { u.pm = T / ncol; u.pn = T % ncol; } else { const int x = T - nu; u.pm = npan + (x >> 1); u.pn = 4 + (x & 1); } return true; }
    __device__ __forceinline__ const char* a_base(const Unit& u) const { return (const char*)(A + (size_t)u.pm * BM * 1024 + (mode == 2 ? u.pn * 256 : 0)); }
    __device__ __forceinline__ void a_voff(const Unit&, const int (&R)[2], const int (&C)[2], unsigned (&v)[2][2]) const { this->plain_voff(R, C, v); }
    __device__ __forceinline__ const char* b_base(const Unit& u) const { return (const char*)(W + (size_t)u.pn * BM * K_); }
    const float* qn; const float* kn; const float* rope; LAS float* xs; int lane;
    __device__ __forceinline__ void epi(const f32x4 (&acc)[2][2][4][2], const Unit& u, int wr, int wc, int fr, int fq) const {
        f16* base; int ld;
        const int row = u.pm * BM + wr * 64 + fr, colw = wc * 32 + fq * 8;
        if (mode == 1) { if (u.pn < 4) { base = O0 + (size_t)row * 1024 + u.pn * BM + colw; ld = 1024; } else if (u.pn == 4) { base = O1 + (size_t)row * 256 + colw; ld = 256; } else { base = O2 + (size_t)row * 256 + colw; ld = 256; } }
        else { base = O0 + (size_t)row * 1024 + u.pn * BM + colw; ld = 1024; }
        if (mode == 1 && u.pn < 5) {
            float ssq[2][4][2];
#pragma unroll
            for (int ai = 0; ai < 2; ++ai)
#pragma unroll
                for (int m = 0; m < 4; ++m)
#pragma unroll
                    for (int bj = 0; bj < 2; ++bj) { const f32x4 a = acc[ai][bj][m][0], b = acc[ai][bj][m][1];
                        float t = (a[0] * a[0] + a[1] * a[1]) + (a[2] * a[2] + a[3] * a[3]) + (b[0] * b[0] + b[1] * b[1]) + (b[2] * b[2] + b[3] * b[3]);
                        t += shx<16>(t, lane); t += shx<32>(t, lane); ssq[ai][m][bj] = t; }
            LAS float* mine = xs + ((wr * 4 + wc) * 16) * 16 + fr; const LAS float* theirs = xs + ((wr * 4 + (wc ^ 1)) * 16) * 16 + fr;
            if (fq == 0) {
#pragma unroll
                for (int ai = 0; ai < 2; ++ai)
#pragma unroll
                    for (int m = 0; m < 4; ++m)
#pragma unroll
                        for (int bj = 0; bj < 2; ++bj) mine[(ai * 8 + m * 2 + bj) * 16] = ssq[ai][m][bj];
            }
            asm volatile("s_waitcnt lgkmcnt(0)" ::: "memory"); __builtin_amdgcn_s_barrier(); asm volatile("" ::: "memory");
            const bool isq = u.pn < 4, lat = u.pm < 128;
            const float* nw = (isq ? qn : kn) + (wc & 1) * 32 + fq * 8;
            const f32x4 w0 = *(const f32x4*)nw, w1 = *(const f32x4*)(nw + 4);
            const float qs = isq ? 0.125f * 1.4426950408889634f : 1.0f;
#pragma unroll
            for (int ai = 0; ai < 2; ++ai)
#pragma unroll
                for (int m = 0; m < 4; ++m) {
                    f32x4 c0 = (f32x4){1.f, 1.f, 1.f, 1.f}, s0 = (f32x4){0.f, 0.f, 0.f, 0.f};
                    if (lat) { const int t = (row + ai * HALF + m * 16) & (SEQ - 1); const int pos = (wc & 1) ? (t & 63) : (t >> 6);
                        const float* tb = rope + (size_t)(pos * 16 + fq * 4) * 2; const f32x4 ta = *(const f32x4*)tb, tb2 = *(const f32x4*)(tb + 4);
                        c0 = (f32x4){ta[0], ta[2], tb2[0], tb2[2]}; s0 = (f32x4){ta[1], ta[3], tb2[1], tb2[3]}; }
#pragma unroll
                    for (int bj = 0; bj < 2; ++bj) {
                        const float tot = ssq[ai][m][bj] + theirs[(ai * 8 + m * 2 + bj) * 16];
                        const float rstd = rsqrtf(tot * (1.0f / 64.0f) + 1e-6f) * qs;
                        f32x4 a = acc[ai][bj][m][0] * rstd * w0, b = acc[ai][bj][m][1] * rstd * w1;
                        const f32x4 ra = (f32x4){a[0] * c0[0] - a[1] * s0[0], a[0] * s0[0] + a[1] * c0[0], a[2] * c0[1] - a[3] * s0[1], a[2] * s0[1] + a[3] * c0[1]};
                        const f32x4 rb = (f32x4){b[0] * c0[2] - b[1] * s0[2], b[0] * s0[2] + b[1] * c0[2], b[2] * c0[3] - b[3] * s0[3], b[2] * s0[3] + b[3] * c0[3]};
                        *(f16x8*)(base + (size_t)(ai * HALF + m * 16) * ld + bj * HALF) = rm8(pack8(ra, rb));
                    }
                }
            return;
        }
#pragma unroll
        for (int ai = 0; ai < 2; ++ai)
#pragma unroll
            for (int m = 0; m < 4; ++m)
#pragma unroll
                for (int bj = 0; bj < 2; ++bj) { const f16x8 o = pack8(acc[ai][bj][m][0], acc[ai][bj][m][1]); *(f16x8*)(base + (size_t)(ai * HALF + m * 16) * ld + bj * HALF) = (mode == 1) ? rm8(o) : o; }
    }
};
}

struct CvtJob { const float* src; f16* dst; int K, N, k0, n0; };
__device__ __forceinline__ bool cvt_job(const Params& P, int l, int u, CvtJob& jb, bool experts) {
    const int j = l >> 1;
    const int nexp = experts ? NEXP * 3 * 128 : 0;
    const int nmix = (l & 1) == 0 ? 16 : (96 + 64);
    if (u >= nexp + nmix) return false;
    if (u < nexp) {
        const int e = u / 384, r = u % 384, which = r >> 7, t = r & 127;
        if (which < 2) { jb.src = (which == 0 ? P.w_gate : P.w_up) + ((size_t)l * NEXP + e) * DM * DEXP; jb.dst = P.Wgu() + ((size_t)e * 2 + which) * DEXP * DM; jb.K = DM; jb.N = DEXP; jb.k0 = (t >> 4) * 128; jb.n0 = (t & 15) * 128; }
        else { jb.src = P.w_down + ((size_t)l * NEXP + e) * DEXP * DM; jb.dst = P.Wd() + (size_t)e * DM * DEXP; jb.K = DEXP; jb.N = DM; jb.k0 = (t >> 3) * 128; jb.n0 = (t & 7) * 128; }
    } else {
        const int t = u - nexp;
        if ((l & 1) == 0) { const int g = t >> 2, tt = t & 3; jb.src = P.pool_w + (size_t)(j * 4 + g) * 65536; jb.dst = P.Wmix() + (size_t)g * 65536; jb.K = 256; jb.N = 256; jb.k0 = (tt >> 1) * 128; jb.n0 = (tt & 1) * 128; }
        else if (t < 96) { jb.src = P.w_qkv + (size_t)j * DM * QKVD; jb.dst = P.Wmix(); jb.K = DM; jb.N = QKVD; jb.k0 = (t / 12) * 128; jb.n0 = (t % 12) * 128; }
        else { const int tt = t - 96; jb.src = P.w_o + (size_t)j * DM * DM; jb.dst = P.Wmix() + (size_t)QKVD * DM; jb.K = DM; jb.N = DM; jb.k0 = (tt >> 3) * 128; jb.n0 = (tt & 7) * 128; }
    }
    return true;
}
__device__ __forceinline__ void phase_convert(const Params& P, int l, int bid, int nb, f16* tile, bool experts = true) {
    const int tid = opaque_tid();
    CvtJob jb;
    int u = bid;
    bool have = cvt_job(P, l, u, jb, experts);
    f32x4 r[8];
    if (have) {
#pragma unroll
        for (int p = 0; p < 8; ++p) { const int id = tid + p * NTHR, kr = id >> 5, c4 = (id & 31) * 4; r[p] = __builtin_nontemporal_load((const f32x4*)(jb.src + (size_t)(jb.k0 + kr) * jb.N + jb.n0 + c4)); }
    }
    while (have) {
        __syncthreads();
#pragma unroll
        for (int p = 0; p < 8; ++p) { const int id = tid + p * NTHR, kr = id >> 5, c4 = (id & 31) * 4; *(f16x4*)(tile + kr * 136 + c4) = pk4(r[p]); }
        __syncthreads();
        const CvtJob cur = jb;
        u += nb; have = cvt_job(P, l, u, jb, experts);
        if (have) {
#pragma unroll
            for (int p = 0; p < 8; ++p) { const int id = tid + p * NTHR, kr = id >> 5, c4 = (id & 31) * 4; r[p] = __builtin_nontemporal_load((const f32x4*)(jb.src + (size_t)(jb.k0 + kr) * jb.N + jb.n0 + c4)); }
        }
        const int n = tid & 127, kg = (tid >> 7) * 32;
        f16* dp = cur.dst + (size_t)(cur.n0 + n) * cur.K + cur.k0 + kg;
#pragma unroll
        for (int i = 0; i < 4; ++i) { f16x8 o;
#pragma unroll
            for (int e = 0; e < 8; ++e) o[e] = tile[(kg + i * 8 + e) * 136 + n];
            *(f16x8*)(dp + i * 8) = rmw8(o); }
    }
}
template <bool GATEUP, bool CTX>
__device__ __forceinline__ void phase_cvt_ctx(const Params& P, int l, int bid, int nb, f16* tile, int sel = -1, bool alt = false) {
    const int tid = opaque_tid(), wid = P.wv, lane = tid & 63, r16 = lane & 15, kq = lane >> 4;
    constexpr int NC = GATEUP ? 128 : 64;
    constexpr int KT = GATEUP ? 8 : 16, K = GATEUP ? DM : DEXP, N = GATEUP ? DEXP : DM, NB = N / NC;
    constexpr int NT = GATEUP ? 2 * KT : KT;
    const int sel_ = (GATEUP && !CTX) ? sel : -1; const int ntr = (GATEUP && sel_ < 0) ? NT : KT;
    constexpr int TS = NC + 4, TW = 128 * TS;
    constexpr int NLD = NC / 16;
    constexpr int WPC = 8 / (NC / 16);
    constexpr int NRB = 4 / WPC;
    const int cb = wid % (NC / 16), rb0 = (wid / (NC / 16)) * NRB;
    f16* asl = tile + 2 * TW;
    for (int job = bid; job < NEXP * NB; job += nb) {
        const int e = job / NB, nbk = job % NB;
        const f16* ap[2];
        if (CTX) {
#pragma unroll
            for (int p = 0; p < 2; ++p) { const int row = (tid >> 4) + p * 32;
                if (GATEUP) ap[p] = P.H() + (size_t)P.rowidx()[e * SLOTS_PAD + 4096 + row] * DM + (tid & 15) * 8;
                else ap[p] = P.act() + ((size_t)e * SLOTS_PAD + 4096 + row) * DEXP + (tid & 15) * 8; }
        }
        f32x4 acc[2][NRB];
#pragma unroll
        for (int w = 0; w < 2; ++w)
#pragma unroll
            for (int rb = 0; rb < NRB; ++rb) acc[w][rb] = (f32x4){0.f, 0.f, 0.f, 0.f};
        const float* srcs[2]; f16* dsts[2];
        if (GATEUP) { const size_t wo = ((size_t)l * NEXP + e) * DM * DEXP; srcs[0] = P.w_gate + wo; srcs[1] = P.w_up + wo; dsts[0] = P.Wgu() + (alt ? (OFF_WGU3 - OFF_WGU) / 2 : 0) + ((size_t)e * 2) * DEXP * DM; dsts[1] = dsts[0] + (size_t)DEXP * DM; }
        else { srcs[0] = P.w_down + ((size_t)l * NEXP + e) * DEXP * DM; srcs[1] = srcs[0]; dsts[0] = P.Wd() + (alt ? (OFF_WD3 - OFF_WD) / 2 : 0) + (size_t)e * DM * DEXP; dsts[1] = dsts[0]; }
        f32x4 r[2][NLD]; f16x8 ar[2][2];
        const unsigned ldoff = (unsigned)(((tid / (NC / 4)) * N + (tid % (NC / 4)) * 4) * 4);
#define CV_LOAD(ti, slot) do { const int which_ = GATEUP ? (sel_ >= 0 ? sel_ : ((ti) & 1)) : 0, kt_ = (GATEUP && sel_ < 0) ? ((ti) >> 1) : (ti); const char* sp_ = (const char*)(srcs[which_] + (size_t)(kt_ * 128) * N + nbk * NC); \
            _Pragma("unroll") for (int p = 0; p < NLD; ++p) r[slot][p] = __builtin_nontemporal_load((const f32x4*)(sp_ + (size_t)p * (NTHR / (NC / 4)) * N * 4 + ldoff)); \
            if (CTX) { _Pragma("unroll") for (int p = 0; p < 2; ++p) ar[slot][p] = *(const f16x8*)(ap[p] + kt_ * 128); } } while (0)
#define CV_TILE(ti, slot) do { const int which = GATEUP ? (sel_ >= 0 ? sel_ : ((ti) & 1)) : 0, kt = (GATEUP && sel_ < 0) ? ((ti) >> 1) : (ti); \
            f16* tl = tile + (slot) * TW; f16* al = asl + (slot) * (64 * 128); \
            _Pragma("unroll") for (int p = 0; p < NLD; ++p) { const int id = tid + p * NTHR, kr = id / (NC / 4), c4 = (id % (NC / 4)) * 4; *(f16x4*)(tl + kr * TS + c4) = pk4(r[slot][p]); } \
            if (CTX) { _Pragma("unroll") for (int p = 0; p < 2; ++p) { const int row = (tid >> 4) + p * 32; *(f16x8*)(al + row * 128 + (((tid & 15) ^ (row & 15)) * 8)) = ar[slot][p]; } } \
            if ((ti) + 2 < ntr) CV_LOAD((ti) + 2, slot); \
            asm volatile("s_waitcnt lgkmcnt(0)" ::: "memory"); __builtin_amdgcn_s_barrier(); asm volatile("" ::: "memory"); \
            f16* dp = dsts[which] + (size_t)(nbk * NC + cb * 16 + r16) * K + kt * 128 + kq * 8; \
            _Pragma("unroll") for (int ks = 0; ks < 4; ++ks) { f16x8 bv; \
                _Pragma("unroll") for (int i = 0; i < 8; ++i) bv[i] = tl[(ks * 32 + kq * 8 + i) * TS + cb * 16 + r16]; \
                if (rb0 == 0) *(f16x8*)(dp + ks * 32) = rmw8(bv); \
                if (CTX) { _Pragma("unroll") for (int rb = 0; rb < NRB; ++rb) { const int row = (rb0 + rb) * 16 + r16; const f16x8 af = *(const f16x8*)(al + row * 128 + (((ks * 4 + kq) ^ r16) * 8)); \
                    acc[which][rb] = __builtin_amdgcn_mfma_f32_16x16x32_f16(bv, af, acc[which][rb], 0, 0, 0); } } } } while (0)
        CV_LOAD(0, 0); CV_LOAD(1, 1);
        for (int t2 = 0; t2 < ntr; t2 += 2) { CV_TILE(t2, 0); CV_TILE(t2 + 1, 1); }
#undef CV_LOAD
#undef CV_TILE
        asm volatile("s_waitcnt lgkmcnt(0)" ::: "memory"); __builtin_amdgcn_s_barrier(); asm volatile("" ::: "memory");
        if (CTX) {
#pragma unroll
            for (int rb = 0; rb < NRB; ++rb) {
                const size_t row = (size_t)e * SLOTS_PAD + 4096 + (rb0 + rb) * 16 + r16; const int col = nbk * NC + cb * 16 + 4 * kq;
                if (GATEUP) { f32x4 o;
#pragma unroll
                    for (int jj = 0; jj < 4; ++jj) o[jj] = silu_f(acc[0][rb][jj]) * acc[1][rb][jj];
                    *(f16x4*)(P.act() + row * DEXP + col) = pk4(o); }
                else *(f16x4*)(P.yslot() + row * DM + col) = pk4(acc[0][rb]);
            }
        }
    }
}

__device__ __forceinline__ void cvt3_job(const Params& P, int job, f16* tile) {
    if (job < 256) phase_cvt_ctx<false, false>(P, 3, job, 1 << 20, tile, -1, true);
    else { const int h = job - 256; phase_cvt_ctx<true, false>(P, 3, h >> 1, 1 << 20, tile, h & 1, true); }
}
__device__ __forceinline__ void phase_gateup_fast(const Params& P, LAS unsigned char* lds, int rt = 17, bool alt = false) { fg::PRGateUp S; S.H = P.H(); S.rowidx = P.rowidx(); S.W = P.Wgu() + (alt ? (OFF_WGU3 - OFF_WGU) / 2 : 0); S.act = P.act(); S.rt = rt; S.nunits = 16 * rt * 16; S.bid = opaque_bid(); fg::gemm_phase(lds, S, P.wv); }
__device__ __forceinline__ void phase_down_fast(const Params& P, LAS unsigned char* lds, int rt = 17, bool alt = false) { fg::PRDown S; S.act = P.act(); S.W = P.Wd() + (alt ? (OFF_WD3 - OFF_WD) / 2 : 0); S.y = P.yslot(); S.rt = rt; S.nunits = 16 * rt * 4; S.bid = opaque_bid(); fg::gemm_phase(lds, S, P.wv); }
__device__ __forceinline__ void phase_pool_fast(const Params& P, LAS unsigned char* lds) { fg::PRDense<256> S; S.qn = nullptr; S.kn = nullptr; S.rope = nullptr; S.xs = nullptr; S.lane = 0; S.npan = 130; S.kvx = 0; S.A = P.H(); S.W = P.Wmix(); S.O0 = P.Z(); S.O1 = nullptr; S.O2 = nullptr; S.ncol = 4; S.mode = 2; S.bid = opaque_bid(); fg::gemm_phase(lds, S, P.wv); }
__device__ __forceinline__ void phase_qkv_fast(const Params& P, LAS unsigned char* lds, bool lastl = false, int l = 1) { fg::PRDense<1024> S; S.qn = P.q_norm + (l >> 1) * 64; S.kn = P.k_norm + (l >> 1) * 64; S.rope = P.rope(); S.xs = (LAS float*)(lds + fg::STAGE_BYTES); S.lane = opaque_tid_(P.wv) & 63; S.npan = lastl ? 128 : 130; S.kvx = lastl ? 4 : 0; S.A = P.H(); S.W = P.Wmix(); S.O0 = P.Q(); S.O1 = P.Kb(); S.O2 = P.Vb(); S.ncol = 6; S.mode = 1; S.bid = opaque_bid(); fg::gemm_phase(lds, S, P.wv); }
__device__ __forceinline__ void phase_oproj_fast(const Params& P, LAS unsigned char* lds, bool lastl = false) { fg::PRDense<1024> S; S.qn = nullptr; S.kn = nullptr; S.rope = nullptr; S.xs = nullptr; S.lane = 0; S.npan = lastl ? 128 : 130; S.kvx = 0; S.A = P.O(); S.W = P.Wmix() + (size_t)QKVD * DM; S.O0 = P.Z(); S.O1 = nullptr; S.O2 = nullptr; S.ncol = 4; S.mode = 0; S.bid = opaque_bid(); fg::gemm_phase(lds, S, P.wv); }

typedef float f32x16 __attribute__((ext_vector_type(16)));
#define AT_KB 9216
#define AT_VB 8704
template <int VAR = 0>
__device__ __forceinline__ void phase_attn_fast(const Params& P, int l, LAS unsigned char* lds, bool do_ctx, int cvt_l = -1) {
    const int j = l >> 1;
    const int tid = opaque_tid(), wid = tid >> 6, lane = tid & 63, l32 = lane & 31, hi = lane >> 5;
    const int g = wid >> 1, qoff = (wid & 1) * 64, qoffu = (P.wv & 1) * 64;
    const int nunits = do_ctx ? 1040 : 1024;
    int ucount = 0;
    for (int u = opaque_bid(); u < nunits; u += gridDim.x, ++ucount) {
        int b, qblk, kv, qrow0, t0, t1, s0;
        if (u < 1024) { b = u >> 9; qblk = (u >> 2) & 127; kv = u & 3; s0 = b * SEQ; qrow0 = s0 + qblk * 128; t0 = qblk == 0 ? 2 : 0; t1 = qblk == 127 ? 4 : 6; }
        else { const int uu = u - 1024; b = uu >> 3; qblk = (uu >> 2) & 1; kv = uu & 3; s0 = NLAT + b * CTXL; qrow0 = s0 + qblk * 128; t0 = 0; t1 = 0; }
        const int cb = NLAT + b * CTXL, nloc = t1 - t0, ntiles = nloc + 4;
        const int h = kv * 4 + g;
        f16x8 Qf[2][4];
#pragma unroll
        for (int qb = 0; qb < 2; ++qb)
#pragma unroll
            for (int ks = 0; ks < 4; ++ks) Qf[qb][ks] = *(const f16x8*)(P.Q() + (size_t)(qrow0 + qoff + 32 * qb + l32) * 1024 + h * 64 + 16 * ks + 8 * hi);
        f32x16 OT[2][2];
#pragma unroll
        for (int db = 0; db < 2; ++db)
#pragma unroll
            for (int qb = 0; qb < 2; ++qb)
#pragma unroll
                for (int r = 0; r < 16; ++r) OT[db][qb][r] = 0.f;
        float mrun[2], lrun[2];
        { const float sk = P.sink[j * 16 + h] * 1.4426950408889634f; mrun[0] = sk; mrun[1] = sk; lrun[0] = hi == 0 ? 1.0f : 0.0f; lrun[1] = lrun[0]; }
        const int lkey = tid >> 3, lpc = tid & 7;
        f16x8 kreg, vreg;
        auto tile_row = [&](int it) -> int { return it < nloc ? (qrow0 - 128 + 64 * (t0 + it)) : (cb + 64 * (it - nloc)); };
        { const int kr = tile_row(0) + lkey; kreg = *(const f16x8*)(P.Kb() + (size_t)kr * 256 + kv * 64 + lpc * 8); vreg = *(const f16x8*)(P.Vb() + (size_t)kr * 256 + kv * 64 + lpc * 8); }
        __syncthreads();
        {
            LAS f16* Kl = (LAS f16*)(lds); LAS f16* Vl = (LAS f16*)(lds + 2 * AT_KB);
            *(LAS f16x8*)(Kl + lkey * 72 + lpc * 8) = kreg;
#pragma unroll
            for (int i = 0; i < 8; ++i) Vl[(lpc * 8 + i) * 68 + lkey] = vreg[i];
        }
        __syncthreads();
        for (int it = 0; it < ntiles; ++it) {
            const int buf = it & 1;
            if (it + 1 < ntiles) { const int kr = tile_row(it + 1) + lkey; kreg = *(const f16x8*)(P.Kb() + (size_t)kr * 256 + kv * 64 + lpc * 8); vreg = *(const f16x8*)(P.Vb() + (size_t)kr * 256 + kv * 64 + lpc * 8); }
            const LAS f16* Kl = (const LAS f16*)(lds + buf * AT_KB); const LAS f16* Vl = (const LAS f16*)(lds + 2 * AT_KB + buf * AT_VB);
            int cls = 0;
            if (it < nloc) { const int tl = t0 + it, dmin = qoffu + 65 - 64 * tl, dmax = qoffu + 191 - 64 * tl; cls = (dmin > 128 || dmax < -128) ? 2 : ((dmin >= -128 && dmax <= 128) ? 0 : 1); }
            if (cls != 2) {
            f32x16 S[2][2];
#pragma unroll
            for (int kb = 0; kb < 2; ++kb)
#pragma unroll
                for (int qb = 0; qb < 2; ++qb)
#pragma unroll
                    for (int r = 0; r < 16; ++r) S[kb][qb][r] = -mrun[qb];
#pragma unroll
            for (int ks = 0; ks < 4; ++ks)
#pragma unroll
                for (int kb = 0; kb < 2; ++kb) {
                    const f16x8 kf = *(const LAS f16x8*)(Kl + (32 * kb + l32) * 72 + 16 * ks + 8 * hi);
#pragma unroll
                    for (int qb = 0; qb < 2; ++qb) S[kb][qb] = __builtin_amdgcn_mfma_f32_32x32x16_f16(kf, Qf[qb][ks], S[kb][qb], 0, 0, 0);
                }
            if (cls == 1) {
                const int kt = 64 * (t0 + it);
#pragma unroll
                for (int qb = 0; qb < 2; ++qb) {
                    const int qp = 128 + qoff + 32 * qb + l32;
#pragma unroll
                    for (int kb = 0; kb < 2; ++kb)
#pragma unroll
                        for (int r = 0; r < 16; ++r) { const int kp = kt + 32 * kb + 8 * (r >> 2) + 4 * hi + (r & 3); const int d = qp - kp; if (d > 128 || d < -128) S[kb][qb][r] = -INFINITY; }
                }
            }
            f16x8 Pf[2][4];
#pragma unroll
            for (int qb = 0; qb < 2; ++qb) {
                float mx = S[0][qb][0];
#pragma unroll
                for (int kb = 0; kb < 2; ++kb)
#pragma unroll
                    for (int r = 0; r < 16; ++r) mx = fmaxf(mx, S[kb][qb][r]);
                { const auto sw = __builtin_amdgcn_permlane32_swap(__float_as_uint(mx), __float_as_uint(mx), false, false); mx = fmaxf(__uint_as_float(sw[0]), __uint_as_float(sw[1])); }
                if (__builtin_amdgcn_ballot_w64(mx > 8.0f) != 0ull) {
                    const float g = fmaxf(mx, 0.f), corr = __builtin_amdgcn_exp2f(-g);
                    mrun[qb] += g; lrun[qb] *= corr;
#pragma unroll
                    for (int kb = 0; kb < 2; ++kb)
#pragma unroll
                        for (int r = 0; r < 16; ++r) S[kb][qb][r] -= g;
#pragma unroll
                    for (int db = 0; db < 2; ++db)
#pragma unroll
                        for (int r = 0; r < 16; ++r) OT[db][qb][r] *= corr;
                }
                float ps = 0.f;
#pragma unroll
                for (int kb = 0; kb < 2; ++kb)
#pragma unroll
                    for (int r = 0; r < 16; ++r) { const float p = __builtin_amdgcn_exp2f(S[kb][qb][r]); S[kb][qb][r] = p; ps += p; }
                lrun[qb] += ps;
#pragma unroll
                for (int ks = 0; ks < 4; ++ks) { const int kb = ks >> 1, r0 = 8 * (ks & 1);
#pragma unroll
                    for (int e = 0; e < 8; ++e) Pf[qb][ks][e] = (f16)S[kb][qb][r0 + e]; }
            }
#pragma unroll
            for (int ks = 0; ks < 4; ++ks)
#pragma unroll
                for (int db = 0; db < 2; ++db) {
                    const LAS f16* vp = Vl + (32 * db + l32) * 68 + 16 * ks + 4 * hi;
                    const f16x4 v0 = *(const LAS f16x4*)vp, v1 = *(const LAS f16x4*)(vp + 8);
                    const f16x8 vf = (f16x8){v0[0], v0[1], v0[2], v0[3], v1[0], v1[1], v1[2], v1[3]};
#pragma unroll
                    for (int qb = 0; qb < 2; ++qb) OT[db][qb] = __builtin_amdgcn_mfma_f32_32x32x16_f16(vf, Pf[qb][ks], OT[db][qb], 0, 0, 0);
                }
            }
            if (it + 1 < ntiles) {
                LAS f16* Kw = (LAS f16*)(lds + (buf ^ 1) * AT_KB); LAS f16* Vw = (LAS f16*)(lds + 2 * AT_KB + (buf ^ 1) * AT_VB);
                *(LAS f16x8*)(Kw + lkey * 72 + lpc * 8) = kreg;
#pragma unroll
                for (int i = 0; i < 8; ++i) Vw[(lpc * 8 + i) * 68 + lkey] = vreg[i];
            }
            __syncthreads();
        }
#pragma unroll
        for (int qb = 0; qb < 2; ++qb) {
            const float lt = lrun[qb] + shx<32>(lrun[qb], lane);
            const float inv = 1.0f / lt;
            f16* op = P.O() + (size_t)(qrow0 + qoff + 32 * qb + l32) * 1024 + h * 64;
#pragma unroll
            for (int db = 0; db < 2; ++db)
#pragma unroll
                for (int i = 0; i < 4; ++i) {
                    const f16x4 o = (f16x4){(f16)(OT[db][qb][4 * i] * inv), (f16)(OT[db][qb][4 * i + 1] * inv), (f16)(OT[db][qb][4 * i + 2] * inv), (f16)(OT[db][qb][4 * i + 3] * inv)};
                    *(f16x4*)(op + 32 * db + 8 * i + 4 * hi) = rm4(o);
                }
        }
    }
}

#define MEGA_LDS (147456 + 16)
__device__ __forceinline__ const Params& opq(Params& q) { int z; asm volatile("s_mov_b32 %0, 0" : "=s"(z)); q.zoff = z; return q; }
__global__ __launch_bounds__(NTHR, 2) void mega(Params P) {
    extern __shared__ __attribute__((aligned(16))) unsigned char shm[];
    LAS unsigned char* lds = (LAS unsigned char*)shm;
    volatile LAS unsigned* st = (volatile LAS unsigned*)(lds + 147456);
    if (threadIdx.x == 0) { st[0] = 0u; st[1] = 0u; st[2] = 0u; st[3] = 0u; }
    __syncthreads();
    const XcdBarrier bar = xcd_barrier_post(P.bar(), st);
    const int nb = gridDim.x;
#define bid (opaque_bid())
    Params Q = P; Q.wv = __builtin_amdgcn_readfirstlane(threadIdx.x >> 6);
#define P (opq(Q))
    phase_ada(P, bid, nb, (float*)shm, 0, nb == 256 ? 1 : 4, true);
    __syncthreads();
    phase_convert(P, 0, bid, nb, (f16*)shm, false);
    xcd_barrier(bar);
    for (int l = 0; l < 4; ++l) {
        if (l == 0) phase_n1<true, false>(P, l, bid, nb); else { phase_n1<false, false>(P, l, bid, nb); if (nb != 256) { __syncthreads(); phase_convert(P, l, bid, nb, (f16*)shm, false); }
            }
        xcd_barrier(bar);
        if ((l & 1) == 0) {
            phase_pool_fast(P, lds);
            xcd_barrier(bar);
            phase_n2<true>(P, l, bid, nb, (float*)shm);
        } else {
            phase_qkv_fast(P, lds, l == 3, l);
            if (nb == 256 && (bid & 7) >= 2) { __syncthreads(); cvt3_job(P, (l == 1 ? 192 : 576) + ((bid & 7) - 2) * 32 + (bid >> 3), (f16*)shm); }
            xcd_barrier(bar);
            phase_attn_fast(P, l, lds, l != 3);
            if (l == 3 && nb != 256) { __syncthreads(); phase_cvt_ctx<true, false>(P, l, bid, nb, (f16*)shm, -1, true); phase_cvt_ctx<false, false>(P, l, bid, nb, (f16*)shm, -1, true); }
            xcd_barrier(bar);
            phase_oproj_fast(P, lds, l == 3);
            if (l == 1 && nb == 256 && (bid & 7) >= 2) { __syncthreads(); cvt3_job(P, 384 + ((bid & 7) - 2) * 32 + (bid >> 3), (f16*)shm); }
            xcd_barrier(bar);
            phase_n2<false>(P, l, bid, nb, (float*)shm, l == 3 ? NLAT : MROWS);
        }
        xcd_barrier(bar);
        phase_topk(P, bid, nb, (unsigned*)shm, l == 3 ? 32 : 64);
        if (l < 3 && nb == 256 && bid >= 64 && bid < 128) cvt3_job(P, l * 64 + bid - 64, (f16*)shm);
        if (l < 3 && nb == 256 && bid >= 224) phase_convert(P, l + 1, bid - 224, 32, (f16*)shm, false);
        if (l < 3 && nb == 256 && bid >= 128 && bid < 224) phase_ada(P, bid - 128, 1 << 20, (float*)shm, l + 1, 1, false);
        xcd_barrier(bar);
        if (l < 3) { phase_cvt_ctx<true, true>(P, l, bid, nb, (f16*)shm); xcd_barrier(bar); }
        phase_gateup_fast(P, lds, 16, l == 3);
        if (l < 3) { __syncthreads(); phase_cvt_ctx<false, true>(P, l, bid, nb, (f16*)shm); }
        xcd_barrier(bar);
        phase_down_fast(P, lds, 16, l == 3);
        xcd_barrier(bar);
    }
    phase_n1<false, true>(P, 4, bid, nb);
#undef P
#undef bid
}

static inline size_t al256(size_t v) { return (v + 255) & ~(size_t)255; }

extern "C" void kernel_launch(void* const* d_in, const int* in_sizes, int n_in, void* d_out, int out_size, void* d_ws, size_t ws_size, hipStream_t stream) {
    Params P{};
    P.x = (const float*)d_in[0]; P.c = (const float*)d_in[1]; P.ctx = (const float*)d_in[2]; P.c_ctx = (const float*)d_in[3];
    P.w_ada = (const float*)d_in[4]; P.b_ada = (const float*)d_in[5]; P.norm1_g = (const float*)d_in[6]; P.norm2_g = (const float*)d_in[7];
    P.pool_w = (const float*)d_in[8]; P.pool_scale = (const float*)d_in[9]; P.w_qkv = (const float*)d_in[10]; P.w_o = (const float*)d_in[11];
    P.q_norm = (const float*)d_in[12]; P.k_norm = (const float*)d_in[13]; P.sink = (const float*)d_in[14]; P.router_w = (const float*)d_in[15];
    P.w_gate = (const float*)d_in[16]; P.w_up = (const float*)d_in[17]; P.w_down = (const float*)d_in[18];
    P.out = (float*)d_out;
    P.ws = (char*)d_ws; const size_t off = WS_TOTAL;
    if (off > ws_size) { fprintf(stderr, "workspace too small: need %zu have %zu\n", off, ws_size); return; }
    static int grid = 0;
    if (!grid) {
        int dev = 0, cus = 0, per_cu = 0;
        hipGetDevice(&dev);
        hipDeviceGetAttribute(&cus, hipDeviceAttributeMultiprocessorCount, dev);
        hipFuncSetAttribute((const void*)mega, hipFuncAttributeMaxDynamicSharedMemorySize, MEGA_LDS);
        hipOccupancyMaxActiveBlocksPerMultiprocessor(&per_cu, (const void*)mega, NTHR, MEGA_LDS);
        if (per_cu < 1) { fprintf(stderr, "mega: occupancy query says %d blocks per CU\n", per_cu); }
        grid = cus > 0 ? cus : 256;
    }
    hipMemsetAsync(P.bar(), 0, XCD_BAR_WORDS * sizeof(unsigned), stream);
    hipLaunchKernelGGL(mega, dim3(grid), dim3(NTHR), MEGA_LDS, stream, P);
}
```

```cpp
#include <hip/hip_runtime.h>
#include <stdint.h>
#include <stdio.h>

typedef _Float16 f16;
typedef _Float16 f16x2 __attribute__((ext_vector_type(2)));
typedef _Float16 f16x4 __attribute__((ext_vector_type(4)));
typedef _Float16 f16x8 __attribute__((ext_vector_type(8)));
typedef float f32x4 __attribute__((ext_vector_type(4)));
typedef float f32x2 __attribute__((ext_vector_type(2)));
typedef unsigned u32x2 __attribute__((ext_vector_type(2)));
typedef unsigned u32x4 __attribute__((ext_vector_type(4)));
#define RM_BITS 5
#define RM_ADD (0x00010001u << (RM_BITS - 1))
#define RM_MASK (~(0x00010001u * ((1u << RM_BITS) - 1u)))
__device__ __forceinline__ f16x4 rm4(f16x4 v) { u32x2 b = __builtin_bit_cast(u32x2, v); b = (b + RM_ADD) & RM_MASK; return __builtin_bit_cast(f16x4, b); }
__device__ __forceinline__ f16x8 rm8(f16x8 v) { u32x4 b = __builtin_bit_cast(u32x4, v); b = (b + RM_ADD) & RM_MASK; return __builtin_bit_cast(f16x8, b); }
#define RMW_BITS 5
__device__ __forceinline__ f16x8 rmw8(f16x8 v) { u32x4 b = __builtin_bit_cast(u32x4, v); b = (b + (0x00010001u << (RMW_BITS - 1))) & ~(0x00010001u * ((1u << RMW_BITS) - 1u)); return __builtin_bit_cast(f16x8, b); }

#define LAS __attribute__((address_space(3)))
#define DM 1024
#define SEQ 16384
#define NLAT 32768
#define CTXL 256
#define NCTX 512
#define MROWS 33280
#define NEXP 16
#define DEXP 2048
#define SLOTS 4160
#define SLOTS_PAD 4352
#define QKVD 1536
#define NTHR 512

constexpr size_t al256c(size_t v) { return (v + 255) & ~(size_t)255; }
constexpr size_t OFF_BAR = 0;
constexpr size_t OFF_MOD = al256c(OFF_BAR + 16384);
constexpr size_t OFF_ROPE = al256c(OFF_MOD + (size_t)4 * 3 * 6 * DM * 4);
constexpr size_t OFF_X = al256c(OFF_ROPE + (size_t)256 * 16 * 2 * 4);
constexpr size_t OFF_H = al256c(OFF_X + (size_t)MROWS * DM * 4);
constexpr size_t OFF_Z = al256c(OFF_H + (size_t)MROWS * DM * 2);
constexpr size_t OFF_Q = al256c(OFF_Z + (size_t)MROWS * DM * 2);
constexpr size_t OFF_KB = al256c(OFF_Q + (size_t)MROWS * DM * 2);
constexpr size_t OFF_VB = al256c(OFF_KB + (size_t)MROWS * 256 * 2);
constexpr size_t OFF_VT = al256c(OFF_VB + (size_t)MROWS * 256 * 2);
constexpr size_t OFF_O = al256c(OFF_VT + (size_t)MROWS * 256 * 2);
constexpr size_t OFF_AFF = al256c(OFF_O + (size_t)MROWS * DM * 2);
constexpr size_t OFF_INV = al256c(OFF_AFF + (size_t)MROWS * 16 * 4);
constexpr size_t OFF_ROWIDX = al256c(OFF_INV + (size_t)MROWS * 16 * 4);
constexpr size_t OFF_ACT = al256c(OFF_ROWIDX + (size_t)NEXP * SLOTS_PAD * 4);
constexpr size_t OFF_YSLOT = al256c(OFF_ACT + (size_t)NEXP * SLOTS_PAD * DEXP * 2);
constexpr size_t OFF_WGU = al256c(OFF_YSLOT + (size_t)NEXP * SLOTS_PAD * DM * 2);
constexpr size_t OFF_WD = al256c(OFF_WGU + (size_t)NEXP * 2 * DEXP * DM * 2);
constexpr size_t OFF_WMIX = al256c(OFF_WD + (size_t)NEXP * DM * DEXP * 2);
constexpr size_t OFF_WGU3 = al256c(OFF_WMIX + (size_t)(QKVD + DM) * DM * 2);
constexpr size_t OFF_WD3 = al256c(OFF_WGU3 + (size_t)NEXP * 2 * DEXP * DM * 2);
constexpr size_t OFF_DUMMY = al256c(OFF_WD3 + (size_t)NEXP * DM * DEXP * 2);
constexpr size_t WS_TOTAL = OFF_DUMMY;
struct Params {
    const float *x, *c, *ctx, *c_ctx, *w_ada, *b_ada, *norm1_g, *norm2_g, *pool_w, *pool_scale, *w_qkv, *w_o, *q_norm, *k_norm, *sink, *router_w, *w_gate, *w_up, *w_down;
    float* out; char* ws; int wv; int zoff;
#define WSF(name, type, off) __host__ __device__ __forceinline__ type* name() const { return (type*)(ws + zoff + (off)); }
    WSF(bar, unsigned, OFF_BAR) WSF(mod, float, OFF_MOD) WSF(rope, float, OFF_ROPE) WSF(X, f16, OFF_X) WSF(H, f16, OFF_H) WSF(Z, f16, OFF_Z) WSF(Q, f16, OFF_Q) WSF(Kb, f16, OFF_KB) WSF(Vb, f16, OFF_VB) WSF(Vt, f16, OFF_VT)
    WSF(O, f16, OFF_O) WSF(aff, float, OFF_AFF) WSF(inv, int, OFF_INV) WSF(rowidx, int, OFF_ROWIDX) WSF(act, f16, OFF_ACT) WSF(yslot, f16, OFF_YSLOT) WSF(Wgu, f16, OFF_WGU) WSF(Wd, f16, OFF_WD) WSF(Wmix, f16, OFF_WMIX)
#undef WSF
#define WSW(name, type, off) __host__ __device__ __forceinline__ type* name() const { return (type*)(ws + zoff + (off)); }
    WSW(Xw, f16, OFF_X) WSW(Ow, f16, OFF_O) WSW(Hw, f16, OFF_H) WSW(affw, float, OFF_AFF) WSW(Qw, f16, OFF_Q) WSW(Kw, f16, OFF_KB)
#undef WSW
};

template <int O> __device__ __forceinline__ float shx(float v, int lane) {
    if (O == 1) return __int_as_float(__builtin_amdgcn_update_dpp(0, __float_as_int(v), 0xB1, 0xF, 0xF, true));
    if (O == 2) return __int_as_float(__builtin_amdgcn_update_dpp(0, __float_as_int(v), 0x4E, 0xF, 0xF, true));
    if (O < 32) return __int_as_float(__builtin_amdgcn_ds_swizzle(__float_as_int(v), (O << 10) | 0x1f));
    return __int_as_float(__builtin_amdgcn_ds_bpermute((lane ^ O) << 2, __float_as_int(v)));
}
__device__ __forceinline__ float wave_sum(float v, int lane) {
    v += shx<1>(v, lane); v += shx<2>(v, lane); v += shx<4>(v, lane); v += shx<8>(v, lane); v += shx<16>(v, lane); v += shx<32>(v, lane);
    return v;
}
__device__ __forceinline__ unsigned shup(unsigned v, int o, int lane) { return (unsigned)__builtin_amdgcn_ds_bpermute((lane - o) << 2, (int)v); }
__device__ __forceinline__ int opaque_bid() { int b = blockIdx.x; asm volatile("" : "+s"(b)); return b; }
#define opaque_tid() opaque_tid_(P.wv)
__device__ __forceinline__ int opaque_tid_(int wv) { int ln; asm volatile("v_mbcnt_lo_u32_b32 %0, -1, 0\n\tv_mbcnt_hi_u32_b32 %0, -1, %0" : "=v"(ln)); return (wv << 6) | ln; }
__device__ __forceinline__ float silu_f(float v) { return v * __builtin_amdgcn_rcpf(1.0f + __expf(-v)); }

__device__ __forceinline__ const float* modp(const Params& P, int l, int v, int j) { return P.mod() + (size_t)((l * 3 + v) * 6 + j) * DM; }

__device__ __forceinline__ void phase_ada(const Params& P, int bid, int nb, float* lds, int l0 = 0, int nl = 4, bool do_rope = true) {
    float* sc = lds; float* red = lds + 3 * DM;
    const int tid = opaque_tid();
    for (int i = tid; i < 3 * DM; i += NTHR) { const int v = i >> 10, k = i & 1023; const float cv = v < 2 ? P.c[v * DM + k] : P.c_ctx[k]; sc[i] = silu_f(cv); }
    __syncthreads();
    for (int u = bid; u < nl * 96; u += nb) {
        const int l = l0 + u / 96, ch = u % 96, c4 = tid & 15, kg = tid >> 4;
        const float* w = P.w_ada + (size_t)l * DM * 6 * DM + ch * 64 + c4 * 4;
        f32x4 s0 = (f32x4){0.f, 0.f, 0.f, 0.f}, s1 = s0, s2 = s0;
#pragma unroll 8
        for (int i = 0; i < 32; ++i) { const int k = kg * 32 + i; const f32x4 wv = __builtin_nontemporal_load((const f32x4*)(w + (size_t)k * 6 * DM)); s0 += sc[k] * wv; s1 += sc[DM + k] * wv; s2 += sc[2 * DM + k] * wv; }
        *(f32x4*)(red + (kg * 3 + 0) * 64 + c4 * 4) = s0; *(f32x4*)(red + (kg * 3 + 1) * 64 + c4 * 4) = s1; *(f32x4*)(red + (kg * 3 + 2) * 64 + c4 * 4) = s2;
        __syncthreads();
        if (tid < 192) { const int v = tid >> 6, cc = tid & 63; float s = 0.f;
#pragma unroll
            for (int q = 0; q < 32; ++q) s += red[(q * 3 + v) * 64 + cc];
            const int colg = ch * 64 + cc; s += P.b_ada[l * 6 * DM + colg];
            const int j = colg >> 10, d = colg & 1023;
            P.mod()[(size_t)((l * 3 + v) * 6 + j) * DM + d] = s; }
        __syncthreads();
    }
    if (do_rope) for (int i = bid * NTHR + tid; i < 256 * 16; i += nb * NTHR) {
        const int p = i >> 4, f = i & 15;
        const float inv = powf(10000.0f, -(float)f / 16.0f);
        const float angf = (float)p * inv;
        double a = (double)angf;
        const double twopi = 6.283185307179586476925286766559;
        a -= twopi * rint(a / twopi);
        const double a2 = a * a;
        double cs = 1.0, sn = 1.0;
        double tc = 0.0, ts = 0.0;
        for (int n = 16; n >= 1; --n) { tc = (tc + 1.0) * (-a2 / (double)((2 * n - 1) * (2 * n))); ts = (ts + 1.0) * (-a2 / (double)((2 * n) * (2 * n + 1))); }
        cs = 1.0 + tc; sn = a * (1.0 + ts);
        P.rope()[i * 2] = (float)cs; P.rope()[i * 2 + 1] = (float)sn;
    }
}

__device__ __forceinline__ f32x4 cvt4(const f16x4 v) { return (f32x4){(float)v[0], (float)v[1], (float)v[2], (float)v[3]}; }
__device__ __forceinline__ f16x4 pk4(const f32x4 v) { return (f16x4){(f16)v[0], (f16)v[1], (f16)v[2], (f16)v[3]}; }
__device__ __forceinline__ float dot4(const f32x4 a, const f32x4 b) { return a[0] * b[0] + a[1] * b[1] + a[2] * b[2] + a[3] * b[3]; }
template <bool FIRST, bool FINAL>
__device__ __forceinline__ void phase_n1(const Params& P, int l, int bid, int nb) {
    constexpr int R = 4;
    const int tid_ = opaque_tid(); const int wid = P.wv, lane = tid_ & 63;
    const int nrows = FINAL ? NLAT : MROWS;
    for (int rb = (bid * 8 + wid) * R; rb < nrows; rb += nb * 8 * R) {
        const int v = rb < NLAT ? (rb >> 14) : 2;
        f32x4 xv[R][4];
#pragma unroll
        for (int u = 0; u < R; ++u) {
            const int r = rb + u;
            if (FIRST) { const float* src = r < NLAT ? P.x + (size_t)r * DM : P.ctx + (size_t)(r - NLAT) * DM;
#pragma unroll
                for (int q = 0; q < 4; ++q) xv[u][q] = __builtin_nontemporal_load((const f32x4*)(src + q * 256 + lane * 4)); }
            else { const f16* src = P.X() + (size_t)r * DM;
#pragma unroll
                for (int q = 0; q < 4; ++q) xv[u][q] = cvt4(*(const f16x4*)(src + q * 256 + lane * 4)); }
        }
        if (!FIRST) {
            const int sl = P.inv()[(size_t)(lane & 15) * MROWS + rb + (lane >> 4)];
            const float af = P.aff()[(size_t)(lane & 15) * MROWS + rb + (lane >> 4)];
            const unsigned long long bal = __builtin_amdgcn_ballot_w64(sl >= 0);
            unsigned m[R];
#pragma unroll
            for (int u = 0; u < R; ++u) m[u] = (unsigned)(bal >> (16 * u)) & 0xffffu;
            const f16* ys = P.yslot();
            const float* g2 = modp(P, l - 1, v, 5);
            f32x4 gv[4];
#pragma unroll
            for (int q = 0; q < 4; ++q) gv[q] = *(const f32x4*)(g2 + q * 256 + lane * 4);
            while (m[0] | m[1] | m[2] | m[3]) {
                f16x4 yv[R][4]; float w[R];
#pragma unroll
                for (int u = 0; u < R; ++u) {
                    const int e = m[u] ? __builtin_ctz(m[u]) : 0;
                    const int sv = m[u] ? __builtin_amdgcn_readlane(sl, 16 * u + e) : 0;
                    w[u] = m[u] ? __int_as_float(__builtin_amdgcn_readlane(__float_as_int(af), 16 * u + e)) : 0.f;
                    m[u] &= m[u] - 1u;
                    const f16* y = ys + ((size_t)e * SLOTS_PAD + sv) * DM + lane * 4;
#pragma unroll
                    for (int q = 0; q < 4; ++q) yv[u][q] = *(const f16x4*)(y + q * 256);
                }
#pragma unroll
                for (int u = 0; u < R; ++u)
#pragma unroll
                    for (int q = 0; q < 4; ++q) xv[u][q] += (w[u] * gv[q]) * cvt4(yv[u][q]);
            }
        }
        if (FINAL) {
#pragma unroll
            for (int u = 0; u < R; ++u)
#pragma unroll
                for (int q = 0; q < 4; ++q) __builtin_nontemporal_store(xv[u][q], (f32x4*)(P.out + (size_t)(rb + u) * DM + q * 256 + lane * 4));
            continue;
        }
        float ss[R];
#pragma unroll
        for (int u = 0; u < R; ++u) {
            f16* xd = P.Xw() + (size_t)(rb + u) * DM; float sacc = 0.f;
#pragma unroll
            for (int q = 0; q < 4; ++q) { *(f16x4*)(xd + q * 256 + lane * 4) = pk4(xv[u][q]); sacc += dot4(xv[u][q], xv[u][q]); }
            ss[u] = sacc;
        }
#pragma unroll
        for (int u = 0; u < R; ++u) ss[u] = rsqrtf(wave_sum(ss[u], lane) * (1.0f / DM) + 1e-6f);
        const float* g = P.norm1_g + l * DM; const float* sh = modp(P, l, v, 0); const float* scl = modp(P, l, v, 1);
#pragma unroll
        for (int q = 0; q < 4; ++q) {
            const int c0 = q * 256 + lane * 4;
            const f32x4 gq = *(const f32x4*)(g + c0), sq = *(const f32x4*)(sh + c0), cq = *(const f32x4*)(scl + c0);
            const f32x4 gm = gq * (1.0f + cq);
#pragma unroll
            for (int u = 0; u < R; ++u) *(f16x4*)(P.Hw() + (size_t)(rb + u) * DM + c0) = rm4(pk4(xv[u][q] * ss[u] * gm + sq));
        }
    }
}

#define N2_ZST 81920
template <bool POOL>
__device__ __forceinline__ void phase_n2(const Params& P, int l, int bid, int nb, float* lds, int nrows = MROWS) {
    const int tid = opaque_tid(), wid = P.wv, lane = tid & 63;
    const float* wr = P.router_w + (size_t)l * DM * NEXP;
    f16* wh = (f16*)lds;
    for (int i = tid; i < DM * NEXP; i += NTHR) { const int d = i >> 4, e = i & 15; wh[e * 1032 + d] = (f16)wr[i]; }
    f16* h2s = (f16*)lds + 16640;
    LAS unsigned char* zst = (LAS unsigned char*)lds + N2_ZST;
    const int j = l >> 1, nblk = nrows >> 4;
    const f16* Zg = P.Z();
    const f16* Xg = P.X();
    f16x4 xr[2][4]; f16x4 zr[2][4];
    auto prefetch = [&](int blk) {
        const int R0 = blk * 16, rb = R0 + wid * 2;
        if (POOL) {
            int s0, L; if (R0 < NLAT) { s0 = (R0 >> 14) << 14; L = SEQ; } else { s0 = NLAT + (((R0 - NLAT) >> 8) << 8); L = CTXL; }
#pragma unroll
            for (int i = 0; i < 8; ++i) { const int piece = wid * 8 + i; int rr = R0 - 8 + (piece >> 1); rr = rr < s0 ? s0 : (rr > s0 + L - 1 ? s0 + L - 1 : rr);
                __builtin_amdgcn_global_load_lds((const unsigned*)(Zg + (size_t)rr * DM + (piece & 1) * 512 + lane * 8), (LAS unsigned*)(zst + piece * 1024), 16, 0, 0); }
        } else {
#pragma unroll
            for (int u = 0; u < 2; ++u)
#pragma unroll
                for (int q = 0; q < 4; ++q) zr[u][q] = *(const f16x4*)(Zg + (size_t)(rb + u) * DM + q * 256 + lane * 4);
        }
#pragma unroll
        for (int u = 0; u < 2; ++u)
#pragma unroll
            for (int q = 0; q < 4; ++q) xr[u][q] = *(const f16x4*)(Xg + (size_t)(rb + u) * DM + q * 256 + lane * 4);
    };
    int blk = bid;
    if (blk < nblk) prefetch(blk);
    __syncthreads();
    while (blk < nblk) {
        const int R0 = blk * 16, rb = R0 + wid * 2;
        int v, s0, L;
        if (rb < NLAT) { v = rb >> 14; s0 = v << 14; L = SEQ; } else { v = 2; s0 = NLAT + (((rb - NLAT) >> 8) << 8); L = CTXL; }
        const int t = rb - s0;
        if (POOL) asm volatile("s_waitcnt vmcnt(16)" ::: "memory");
        f32x4 g1v[4], gmv[4], shv[4], psv[4];
        { const float* g1 = modp(P, l, v, 2); const float* g = P.norm2_g + l * DM; const float* sh = modp(P, l, v, 3); const float* scl = modp(P, l, v, 4);
#pragma unroll
            for (int q = 0; q < 4; ++q) { const int c0 = q * 256 + lane * 4;
                g1v[q] = *(const f32x4*)(g1 + c0); const f32x4 gv = *(const f32x4*)(g + c0), cv = *(const f32x4*)(scl + c0); shv[q] = *(const f32x4*)(sh + c0); gmv[q] = gv * (1.0f + cv);
                if (POOL) psv[q] = *(const f32x4*)(P.pool_scale + j * DM + c0); } }
        f32x4 y[2][4];
        if (POOL) {
            asm volatile("s_waitcnt lgkmcnt(0)" ::: "memory"); __builtin_amdgcn_s_barrier(); asm volatile("" ::: "memory");
            if (t >= 8 && t + 9 < L) {
#pragma unroll
                for (int q = 0; q < 4; ++q) {
                    const int h = 1 << q;
                    const LAS f16* zb = (const LAS f16*)zst + q * 256 + lane * 4 + (2 * wid + 8) * DM;
#define ZROW(d) (*(const LAS f16x4*)(zb + (d) * DM))
                    const f32x4 z0 = cvt4(ZROW(-h)), z1 = cvt4(ZROW(h)), own0 = cvt4(ZROW(0)), own1 = (h == 1) ? z1 : cvt4(ZROW(1));
                    f32x4 common = (f32x4){0.f, 0.f, 0.f, 0.f};
#pragma unroll
                    for (int d = -h + 1; d + 1 <= h - 1; d += 2) { const f16x4 pr = ZROW(d) + ZROW(d + 1); common += cvt4(pr); }
                    common += cvt4(ZROW(h - 1));
#undef ZROW
                    const float inv = 0.5f / (float)h;
                    y[0][q] = ((common + z0) * inv - own0) * psv[q];
                    y[1][q] = ((common + z1) * inv - own1) * psv[q];
                }
            } else {
#pragma unroll
            for (int q = 0; q < 4; ++q) {
                const int h = 1 << q;
                const LAS f16* zb = (const LAS f16*)zst + q * 256 + lane * 4;
                f32x4 common = (f32x4){0.f, 0.f, 0.f, 0.f}, z0 = common, z1 = common;
#pragma unroll
                for (int d = -h; d <= h; ++d) {
                    const int tt = t + d; const bool ok = tt >= 0 && tt < L;
                    f32x4 zz = cvt4(*(const LAS f16x4*)(zb + (2 * wid + 8 + d) * DM));
                    if (!ok) zz = (f32x4){0.f, 0.f, 0.f, 0.f};
                    if (d == -h) z0 = zz; else if (d == h) z1 = zz; else common += zz;
                    if (d == 0) y[0][q] = zz;
                    if (d == 1) y[1][q] = zz;
                }
                const int c0n = min(t + h, L) - max(t - h, 0), c1n = min(t + 1 + h, L) - max(t + 1 - h, 0);
                y[0][q] = ((common + z0) * (1.0f / (float)c0n) - y[0][q]) * psv[q];
                y[1][q] = ((common + z1) * (1.0f / (float)c1n) - y[1][q]) * psv[q];
            }
            }
            asm volatile("s_waitcnt lgkmcnt(0)" ::: "memory"); __builtin_amdgcn_s_barrier(); asm volatile("" ::: "memory");
        } else {
#pragma unroll
            for (int u = 0; u < 2; ++u)
#pragma unroll
                for (int q = 0; q < 4; ++q) y[u][q] = cvt4(zr[u][q]);
        }
        f32x4 xv[2][4]; float ss[2] = {0.f, 0.f};
#pragma unroll
        for (int q = 0; q < 4; ++q) {
#pragma unroll
            for (int u = 0; u < 2; ++u) { xv[u][q] = cvt4(xr[u][q]) + g1v[q] * y[u][q]; ss[u] += dot4(xv[u][q], xv[u][q]); }
        }
        const int nxt = blk + nb;
        asm volatile("" ::: "memory");
        if (nxt < nblk) prefetch(nxt);
#pragma unroll
        for (int u = 0; u < 2; ++u)
#pragma unroll
            for (int q = 0; q < 4; ++q) *(f16x4*)(P.Xw() + (size_t)(rb + u) * DM + q * 256 + lane * 4) = pk4(xv[u][q]);
        ss[0] = wave_sum(ss[0], lane); ss[1] = wave_sum(ss[1], lane);
        const float rs[2] = {rsqrtf(ss[0] * (1.0f / DM) + 1e-6f), rsqrtf(ss[1] * (1.0f / DM) + 1e-6f)};
        f16x4 h2h[2][4];
#pragma unroll
        for (int q = 0; q < 4; ++q) {
            const int c0 = q * 256 + lane * 4;
#pragma unroll
            for (int u = 0; u < 2; ++u) { h2h[u][q] = pk4(xv[u][q] * rs[u] * gmv[q] + shv[q]); *(f16x4*)(P.Hw() + (size_t)(rb + u) * DM + c0) = rm4(h2h[u][q]); }
        }
        asm volatile("s_waitcnt lgkmcnt(0)" ::: "memory"); __builtin_amdgcn_s_barrier(); asm volatile("" ::: "memory");
#pragma unroll
        for (int q = 0; q < 4; ++q)
#pragma unroll
            for (int u = 0; u < 2; ++u) *(f16x4*)(h2s + (2 * wid + u) * 1032 + q * 256 + lane * 4) = h2h[u][q];
        asm volatile("s_waitcnt lgkmcnt(0)" ::: "memory"); __builtin_amdgcn_s_barrier(); asm volatile("" ::: "memory");
        {
            const int r16 = lane & 15, kq = lane >> 4;
            f32x4 pl = (f32x4){0.f, 0.f, 0.f, 0.f};
#pragma unroll
            for (int ks = 0; ks < 4; ++ks) {
                const f16x8 av = *(const f16x8*)(h2s + r16 * 1032 + wid * 128 + ks * 32 + kq * 8), bv = *(const f16x8*)(wh + r16 * 1032 + wid * 128 + ks * 32 + kq * 8);
                pl = __builtin_amdgcn_mfma_f32_16x16x32_f16(av, bv, pl, 0, 0, 0);
            }
            *(f32x4*)(lds + 16640 + (wid * 64 + lane) * 4) = pl;
            asm volatile("s_waitcnt lgkmcnt(0)" ::: "memory"); __builtin_amdgcn_s_barrier(); asm volatile("" ::: "memory");
        }
        if (wid == 0) {
            const int r16 = lane & 15, kq = lane >> 4;
            f32x4 lg = (f32x4){0.f, 0.f, 0.f, 0.f};
#pragma unroll
            for (int w = 0; w < 8; ++w) lg += *(const f32x4*)(lds + 16640 + (w * 64 + lane) * 4);
#pragma unroll
            for (int jj = 0; jj < 4; ++jj) {
                float mx = lg[jj];
                mx = fmaxf(mx, shx<1>(mx, lane)); mx = fmaxf(mx, shx<2>(mx, lane)); mx = fmaxf(mx, shx<4>(mx, lane)); mx = fmaxf(mx, shx<8>(mx, lane));
                const float pe = __expf(lg[jj] - mx);
                float den = pe;
                den += shx<1>(den, lane); den += shx<2>(den, lane); den += shx<4>(den, lane); den += shx<8>(den, lane);
                P.affw()[(size_t)r16 * MROWS + R0 + 4 * kq + jj] = pe * __builtin_amdgcn_rcpf(den);
            }
        }
        blk = nxt;
    }
}

__device__ __forceinline__ void phase_topk(const Params& P, int bid, int nb, unsigned* lds, int nprob = 64) {
    unsigned* hist = lds; unsigned* misc = lds + 256; unsigned* wsa = lds + 272; unsigned* wsb = lds + 288;
    const int tid = opaque_tid(), wid = tid >> 6, lane = tid & 63;
    for (int p = bid; p < nprob; p += nb) {
        const int set = p >> 4, e = p & 15;
        const int n = set < 2 ? SEQ : CTXL, C = n >> 3;
        const int r0 = set < 2 ? set * SEQ : NLAT + (set - 2) * CTXL;
        const int slot0 = set < 2 ? set * 2048 : 4096 + (set - 2) * 32;
        unsigned key[32];
#pragma unroll
        for (int i4 = 0; i4 < 8; ++i4) { const int idx = tid * 32 + i4 * 4;
            f32x4 v = (f32x4){0.f, 0.f, 0.f, 0.f}; if (idx < n) v = *(const f32x4*)(P.aff() + (size_t)e * MROWS + r0 + idx);
#pragma unroll
            for (int jj = 0; jj < 4; ++jj) key[i4 * 4 + jj] = idx < n ? (__float_as_uint(v[jj]) + 1u) : 0u; }
        unsigned T = 0u;
        for (int bit = 29; bit >= 0; --bit) {
            const unsigned cand = T | (1u << bit);
            unsigned wc = 0u;
#pragma unroll
            for (int i = 0; i < 32; ++i) wc += (unsigned)__builtin_popcountll(__builtin_amdgcn_ballot_w64(key[i] >= cand));
            unsigned* cb = misc + ((bit & 1) << 3);
            if (lane == 0) cb[wid] = wc;
            __syncthreads();
            unsigned tot = 0u;
#pragma unroll
            for (int w = 0; w < 8; ++w) tot += cb[w];
            if (tot >= (unsigned)C) T = cand;
            if (tot == (unsigned)C) { T = cand - 1u; break; }
        }
        unsigned cg = 0u, ce = 0u;
#pragma unroll
        for (int i = 0; i < 32; ++i) { cg += key[i] > T ? 1u : 0u; ce += key[i] == T ? 1u : 0u; }
        unsigned ig = cg, ie = ce;
#pragma unroll
        for (int o = 1; o < 64; o <<= 1) { const unsigned a = shup(ig, o, lane), b = shup(ie, o, lane); if (lane >= o) { ig += a; ie += b; } }
        if (lane == 63) { wsa[wid] = ig; wsb[wid] = ie; }
        __syncthreads();
        unsigned bg = 0u, be = 0u, totg = 0u;
#pragma unroll
        for (int w = 0; w < 8; ++w) { const unsigned ga = wsa[w]; totg += ga; if (w < wid) { bg += ga; be += wsb[w]; } }
        const unsigned krem = (unsigned)C - totg;
        unsigned pg = bg + ig - cg, pe = be + ie - ce;
#pragma unroll
        for (int i4 = 0; i4 < 8; ++i4) {
            int iv[4];
#pragma unroll
            for (int jj = 0; jj < 4; ++jj) {
                const int i = i4 * 4 + jj, idx = tid * 32 + i;
                bool sel = false; unsigned rank = 0u;
                if (key[i] > T) { sel = true; rank = pg + (pe < krem ? pe : krem); ++pg; }
                else if (key[i] == T && key[i] != 0u) { if (pe < krem) { sel = true; rank = pg + pe; } ++pe; }
                if (sel) P.rowidx()[e * SLOTS_PAD + slot0 + (int)rank] = r0 + idx;
                iv[jj] = sel ? slot0 + (int)rank : -1;
            }
            if (tid * 32 + i4 * 4 < n) *(int4*)(P.inv() + (size_t)e * MROWS + r0 + tid * 32 + i4 * 4) = make_int4(iv[0], iv[1], iv[2], iv[3]);
        }
        if (set == 3) for (int i = SLOTS + tid; i < SLOTS_PAD; i += NTHR) P.rowidx()[e * SLOTS_PAD + i] = 0;
        __syncthreads();
    }
}

#define XB_TMO      128
#define XB_XCNT(j)  (256  + 64 * (j))
#define XB_XSUB(j)  (1280 + 64 * (j))
#define XB_XGEN(j)  (2304 + 64 * (j))
#define XB_TOP      3328
#define XB_TOPGEN   3392
#define XCD_BAR_WORDS 3456
#define XB_SPIN_CAP (1u << 18)
__device__ __forceinline__ unsigned xb_ld(unsigned* p)              { return __hip_atomic_load(p, __ATOMIC_RELAXED, __HIP_MEMORY_SCOPE_AGENT); }
__device__ __forceinline__ unsigned xb_add(unsigned* p, unsigned v) { return __hip_atomic_fetch_add(p, v, __ATOMIC_RELAXED, __HIP_MEMORY_SCOPE_AGENT); }
__device__ __forceinline__ unsigned xb_xcc_id() { return (unsigned)__builtin_amdgcn_s_getreg((3 << 11) | 20) & 0xFu; }
#define XB_SPIN(cond, bar) do { unsigned _sp = 0; while (cond) { __builtin_amdgcn_s_sleep(1); \
    if ((++_sp & 255u) == 0u) { if (xb_ld(&(bar)[XB_TMO])) break; if (_sp > XB_SPIN_CAP) { atomicAdd(&(bar)[XB_TMO], 1u); break; } } } } while (0)
struct XcdBarrier { unsigned* bar; unsigned x; volatile LAS unsigned* st; };
__device__ __forceinline__ XcdBarrier xcd_barrier_post(unsigned* bar, volatile LAS unsigned* st) {
    XcdBarrier b; b.bar = bar; b.x = xb_xcc_id(); b.st = st;
    if (threadIdx.x == 0) (void)xb_add(&bar[XB_XCNT(b.x)], 1u);
    return b;
}
__device__ __forceinline__ void xcd_barrier_complete(unsigned* bar, unsigned x, unsigned& nloc, unsigned& nx) {
    const unsigned G = gridDim.x * gridDim.y * gridDim.z;
    unsigned sum, cnt, mine, sp = 0u;
    for (;;) {
        sum = 0u; cnt = 0u; mine = 0u;
#pragma unroll
        for (unsigned j = 0; j < 16; ++j) { const unsigned c = xb_ld(&bar[XB_XCNT(j)]); sum += c; cnt += (c > 0u) ? 1u : 0u; mine = (j == x) ? c : mine; }
        if (sum == G) break;
        __builtin_amdgcn_s_sleep(1);
        if ((++sp & 255u) == 0u) { if (xb_ld(&bar[XB_TMO])) break; if (sp > XB_SPIN_CAP) { atomicAdd(&bar[XB_TMO], 1u); break; } }
    }
    nloc = mine > 0u ? mine : 1u; nx = cnt > 0u ? cnt : 1u;
}
__device__ __forceinline__ void xcd_barrier(const XcdBarrier& b) {
    asm volatile("s_waitcnt vmcnt(0)" ::: "memory");
    __syncthreads();
    if (threadIdx.x == 0) {
        unsigned* bar = b.bar; asm volatile("" : "+s"(bar));
        const unsigned bx = (unsigned)__builtin_amdgcn_readfirstlane((int)xb_xcc_id());
        __builtin_amdgcn_s_waitcnt(0);
        unsigned nloc = b.st[0], nx = b.st[1];
        if (nloc == 0u) { xcd_barrier_complete(bar, bx, nloc, nx); b.st[0] = nloc; b.st[1] = nx; }
        const unsigned old = xb_add(&bar[XB_XSUB(bx)], 1u);
        const unsigned gen = old / nloc;
        if (old + 1u == (gen + 1u) * nloc) {
            __builtin_amdgcn_fence(__ATOMIC_RELEASE, "agent");
            asm volatile("s_waitcnt vmcnt(0)" ::: "memory");
            const unsigned og = xb_add(&bar[XB_TOP], 1u);
            const unsigned tg = og / nx;
            if (og + 1u == (tg + 1u) * nx) xb_add(&bar[XB_TOPGEN], 1u);
            else XB_SPIN(xb_ld(&bar[XB_TOPGEN]) == tg, bar);
            __builtin_amdgcn_fence(__ATOMIC_ACQUIRE, "agent");
            xb_add(&bar[XB_XGEN(bx)], 1u);
            asm volatile("s_waitcnt vmcnt(0)" ::: "memory");
        } else {
            XB_SPIN(xb_ld(&bar[XB_XGEN(bx)]) == gen, bar);
            __builtin_amdgcn_fence(__ATOMIC_ACQUIRE, "agent");
            asm volatile("s_waitcnt vmcnt(0)" ::: "memory");
        }
    }
    __syncthreads();
}

namespace fg {
constexpr int BM = 256, BK = 64, HALF = 128, HTB = HALF * BK * 2, STAGE_BYTES = 8 * HTB;
__device__ __forceinline__ int lds_byte(int r, int c) { const int st = (r >> 4) * 2 + (c >> 5), rr = r & 15, cc = c & 31, ob = rr * 64 + cc * 2; return st * 1024 + (ob ^ (((ob >> 9) & 1) << 5)); }
__device__ __forceinline__ void stage_rc(int b, int& R, int& C) { const int st = b / 1024, sb = b % 1024, swz = sb ^ (((sb >> 9) & 1) << 5); R = (st >> 1) * 16 + swz / 64; C = (st & 1) * 32 + (swz % 64) / 2; }
__device__ __forceinline__ int perm32(int rho) { const int n = rho >> 4, i = rho & 15; return 8 * (i >> 2) + 4 * n + (i & 3); }
#define KDUP 0
struct Unit { int e, pm, pn; int skip; };
__device__ __forceinline__ void xcd_order(int i, int& T) { const int c = blockIdx.x; T = i * (int)gridDim.x + c; }

template <class PR>
__device__ __forceinline__ void gemm_phase(LAS unsigned char* lds, const PR& S, int wv) {
    const int tid = opaque_tid_(wv), wid = __builtin_amdgcn_readfirstlane(tid >> 6), lane = tid & 63, wr = wid >> 2, wc = wid & 3, fr = lane & 15, fq = lane >> 4;
    constexpr int K = PR::K, nt = K / BK;
    unsigned voffB[2];
#pragma unroll
    for (int i = 0; i < 2; ++i) { int R, C; stage_rc(tid * 16 + i * 8192, R, C); const int Rb = (R & ~31) + perm32(R & 31); voffB[i] = (unsigned)(Rb * PR::LDB + C) * 2u; }
    const size_t kstep = (size_t)(BK * 2);
    const size_t hB = S.hstepB();
    const unsigned ldsw = (unsigned)wid * 1024u;
    const int aoff = lds_byte(wr * 64 + fr, fq * 8), boff = lds_byte(wc * 32 + fr, fq * 8);
#define FG_SA(b, h) (((b) * 2 + (h)) * HTB)
#define FG_SB(b, h) ((4 + (b) * 2 + (h)) * HTB)
#define FG_STAGE(bufoff, gbase, voff) do { _Pragma("unroll") for (int _i = 0; _i < 2; ++_i) \
        __builtin_amdgcn_global_load_lds((const unsigned*)((const char*)(gbase) + (voff)[_i]), (LAS unsigned*)(lds + (bufoff) + ldsw + _i * 8192), 16, 0, 0); } while (0)
#define FG_LDA(dst, b, h) do { _Pragma("unroll") for (int m = 0; m < 4; ++m) _Pragma("unroll") for (int k = 0; k < 2; ++k) dst[m][k] = *(const LAS f16x8*)(lds + FG_SA(b, h) + aoff + m * 2048 + k * 1024); } while (0)
#define FG_LDB(dst, b, h) do { _Pragma("unroll") for (int n = 0; n < 2; ++n) _Pragma("unroll") for (int k = 0; k < 2; ++k) dst[n][k] = *(const LAS f16x8*)(lds + FG_SB(b, h) + boff + n * 2048 + k * 1024); } while (0)
#define FG_MMA(ai, bj, At, Bt) do { __builtin_amdgcn_s_setprio(1); _Pragma("unroll") for (int m = 0; m < 4; ++m) _Pragma("unroll") for (int n = 0; n < 2; ++n) _Pragma("unroll") for (int k = 0; k < 2; ++k) \
        acc[ai][bj][m][n] = __builtin_amdgcn_mfma_f32_16x16x32_f16(Bt[n][k], At[m][k], acc[ai][bj][m][n], 0, 0, 0); __builtin_amdgcn_s_setprio(0); } while (0)
#define FG_WAIT_V(n) asm volatile("s_waitcnt vmcnt(" #n ")" ::: "memory")
#define FG_WAIT_L(n) asm volatile("s_waitcnt lgkmcnt(" #n ")" ::: "memory")
#define FG_BAR __builtin_amdgcn_s_barrier()
#define FG_SCHED __builtin_amdgcn_sched_barrier(0)
    Unit cur, nxt; int ui = 0;
    if (!S.next(0, cur)) return;
    f32x4 acc[2][2][4][2];
#pragma unroll
    for (int a = 0; a < 2; ++a)
#pragma unroll
        for (int b = 0; b < 2; ++b)
#pragma unroll
            for (int m = 0; m < 4; ++m)
#pragma unroll
                for (int n = 0; n < 2; ++n) acc[a][b][m][n] = (f32x4){0.f, 0.f, 0.f, 0.f};
    f16x8 At[4][2], B0[2][2], B1[2][2];
    unsigned vA[2][2], vN[2][2];
    { int Rr[2], Cc[2]; stage_rc(tid * 16, Rr[0], Cc[0]); stage_rc(tid * 16 + 8192, Rr[1], Cc[1]); S.a_voff(cur, Rr, Cc, vA); }
#pragma unroll
    for (int h = 0; h < 2; ++h)
#pragma unroll
        for (int i = 0; i < 2; ++i) { asm volatile("" : "+v"(vA[h][i])); vN[h][i] = vA[h][i]; }
    const char* cA = S.a_base(cur); const char* cB = S.b_base(cur);
    FG_STAGE(FG_SB(0, 0), cB, voffB); FG_STAGE(FG_SA(0, 0), cA, vA[0]); FG_STAGE(FG_SB(0, 1), cB + hB, voffB); FG_STAGE(FG_SA(0, 1), cA, vA[1]);
    if (wr == 1) FG_BAR;
    FG_WAIT_V(4); FG_BAR;
    FG_STAGE(FG_SB(1, 0), cB + kstep, voffB); FG_STAGE(FG_SA(1, 0), cA + kstep, vA[0]); FG_STAGE(FG_SB(1, 1), cB + hB + kstep, voffB);
    FG_WAIT_V(6); FG_BAR;
    for (;;) {
        const bool has_next = S.next(ui + 1, nxt);
        const char* nA = has_next ? S.a_base(nxt) : cA; const char* nB = has_next ? S.b_base(nxt) : cB;
        if (has_next) { int Rr[2], Cc[2]; int t2 = tid; asm volatile("" : "+v"(t2)); stage_rc(t2 * 16, Rr[0], Cc[0]); stage_rc(t2 * 16 + 8192, Rr[1], Cc[1]); S.a_voff(nxt, Rr, Cc, vN);
#pragma unroll
            for (int h = 0; h < 2; ++h)
#pragma unroll
                for (int i = 0; i < 2; ++i) asm volatile("" : "+v"(vN[h][i])); }
#pragma unroll 1
        for (int t = 0; t < nt; t += 2) {
            const bool last = (t == nt - 2);
            const char* a1 = cA + (size_t)(t + 1) * kstep;
            const char* a2 = last ? nA : cA + (size_t)(t + 2) * kstep; const char* b2 = last ? nB : cB + (size_t)(t + 2) * kstep;
            const char* a3 = a2 + kstep; const char* b3 = b2 + kstep;
            unsigned v2[2][2];
#pragma unroll
            for (int h = 0; h < 2; ++h)
#pragma unroll
                for (int i = 0; i < 2; ++i) v2[h][i] = last ? vN[h][i] : vA[h][i];
            FG_LDB(B0, 0, 0); FG_SCHED; FG_LDA(At, 0, 0); FG_STAGE(FG_SA(1, 1), a1, vA[1]);
            FG_WAIT_L(8); FG_BAR; FG_WAIT_L(0); FG_MMA(0, 0, At, B0); FG_BAR; FG_SCHED;
            FG_LDB(B1, 0, 1); FG_STAGE(FG_SB(0, 0), b2, voffB);
            FG_BAR; FG_WAIT_L(0); FG_MMA(0, 1, At, B1); FG_BAR;
            FG_LDA(At, 0, 1); FG_STAGE(FG_SA(0, 0), a2, v2[0]);
            FG_BAR; FG_WAIT_L(0); FG_MMA(1, 0, At, B0); FG_BAR; FG_SCHED;
            FG_STAGE(FG_SB(0, 1), b2 + hB, voffB);
            FG_WAIT_V(6); FG_BAR; FG_MMA(1, 1, At, B1); FG_BAR;
            FG_LDB(B0, 1, 0); FG_SCHED; FG_LDA(At, 1, 0); FG_STAGE(FG_SA(0, 1), a2, v2[1]);
            FG_WAIT_L(8); FG_BAR; FG_WAIT_L(0); FG_MMA(0, 0, At, B0); FG_BAR; FG_SCHED;
            FG_LDB(B1, 1, 1); FG_STAGE(FG_SB(1, 0), b3, voffB);
            FG_BAR; FG_WAIT_L(0); FG_MMA(0, 1, At, B1); FG_BAR;
            FG_LDA(At, 1, 1); FG_STAGE(FG_SA(1, 0), a3, v2[0]);
            FG_BAR; FG_WAIT_L(0); FG_MMA(1, 0, At, B0); FG_BAR; FG_SCHED;
            FG_STAGE(FG_SB(1, 1), b3 + hB, voffB);
            FG_WAIT_V(6); FG_BAR; FG_MMA(1, 1, At, B1); FG_BAR;
        }
        if (!KDUP || !cur.skip) S.epi(acc, cur, wr, wc, fr, fq);
        if (!has_next) break;
#pragma unroll
        for (int a = 0; a < 2; ++a)
#pragma unroll
            for (int b = 0; b < 2; ++b)
#pragma unroll
                for (int m = 0; m < 4; ++m)
#pragma unroll
                    for (int n = 0; n < 2; ++n) acc[a][b][m][n] = (f32x4){0.f, 0.f, 0.f, 0.f};
        cur = nxt; cA = nA; cB = nB; ++ui;
#pragma unroll
        for (int h = 0; h < 2; ++h)
#pragma unroll
            for (int i = 0; i < 2; ++i) vA[h][i] = vN[h][i];
    }
    FG_WAIT_V(0);
    if (wr == 0) FG_BAR;
    FG_BAR;
#undef FG_SA
#undef FG_SB
#undef FG_STAGE
#undef FG_LDA
#undef FG_LDB
#undef FG_MMA
#undef FG_WAIT_V
#undef FG_WAIT_L
#undef FG_BAR
#undef FG_SCHED
}

__device__ __forceinline__ f16x8 pack8(const f32x4 a, const f32x4 b) { return (f16x8){(f16)a[0], (f16)a[1], (f16)a[2], (f16)a[3], (f16)b[0], (f16)b[1], (f16)b[2], (f16)b[3]}; }

template <int K_, int LDA_, int LDB_> struct PRBase {
    static constexpr int K = K_, LDA = LDA_, LDB = LDB_;
    __device__ __forceinline__ void plain_voff(const int (&R)[2], const int (&C)[2], unsigned (&v)[2][2]) const {
#pragma unroll
        for (int h = 0; h < 2; ++h)
#pragma unroll
            for (int i = 0; i < 2; ++i) v[h][i] = (unsigned)((h * HALF + R[i]) * LDA + C[i]) * 2u;
    }
};
struct PRGateUp : PRBase<1024, 1024, 1024> {
    const f16* H; const int* rowidx; const f16* W; f16* act; int nunits; int bid; int rt;
    __device__ __forceinline__ size_t hstepB() const { return (size_t)DEXP * DM * 2; }
    __device__ __forceinline__ bool next(int i, Unit& u) const { const int ii = KDUP ? (i >> 1) : i; const int T = ii * (int)gridDim.x + bid; u.skip = KDUP ? ((i & 1) == 0) : 0; if (T >= nunits) return false;
        if (rt == 16 && gridDim.x == 256) { const int x = bid & 7, jj = bid >> 3; u.e = ii; u.pm = (x >> 1) * 4 + (jj >> 3); u.pn = (x & 1) * 8 + (jj & 7); return true; }
        const int per = rt * 16; u.e = T / per; const int t = T % per; u.pm = t >> 4; u.pn = t & 15; return true; }
    __device__ __forceinline__ const char* a_base(const Unit&) const { return (const char*)H; }
    __device__ __forceinline__ void a_voff(const Unit& u, const int (&R)[2], const int (&C)[2], unsigned (&v)[2][2]) const {
        const int* ri = rowidx + u.e * SLOTS_PAD + u.pm * BM;
#pragma unroll
        for (int h = 0; h < 2; ++h)
#pragma unroll
            for (int i = 0; i < 2; ++i) { const int g = ri[h * HALF + R[i]]; v[h][i] = (unsigned)(g * LDA + C[i]) * 2u; }
    }
    __device__ __forceinline__ const char* b_base(const Unit& u) const { return (const char*)(W + ((size_t)u.e * 2 * DEXP + (size_t)u.pn * HALF) * DM); }
    __device__ __forceinline__ void epi(const f32x4 (&acc)[2][2][4][2], const Unit& u, int wr, int wc, int fr, int fq) const {
        f16* base = act + ((size_t)u.e * SLOTS_PAD + (size_t)u.pm * BM + wr * 64 + fr) * DEXP + u.pn * HALF + wc * 32 + fq * 8;
#pragma unroll
        for (int ai = 0; ai < 2; ++ai)
#pragma unroll
            for (int m = 0; m < 4; ++m) {
                f32x4 o0, o1;
#pragma unroll
                for (int j = 0; j < 4; ++j) { o0[j] = silu_f(acc[ai][0][m][0][j]) * acc[ai][1][m][0][j]; o1[j] = silu_f(acc[ai][0][m][1][j]) * acc[ai][1][m][1][j]; }
                if (u.e < 11) __builtin_nontemporal_store(rm8(pack8(o0, o1)), (f16x8*)(base + (size_t)(ai * HALF + m * 16) * DEXP));
                else *(f16x8*)(base + (size_t)(ai * HALF + m * 16) * DEXP) = rm8(pack8(o0, o1));
            }
    }
};
struct PRDown : PRBase<2048, 2048, 2048> {
    const f16* act; const f16* W; f16* y; int nunits; int bid; int rt;
    __device__ __forceinline__ size_t hstepB() const { return (size_t)HALF * DEXP * 2; }
    __device__ __forceinline__ bool next(int i, Unit& u) const { const int ii = KDUP ? (i >> 1) : i; const int T = ii * (int)gridDim.x + bid; u.skip = KDUP ? ((i & 1) == 0) : 0; if (T >= nunits) return false;
        if (rt == 16 && gridDim.x == 256) { const int x = bid & 7, jj = bid >> 3; u.e = 15 - (ii * 4 + (x >> 1)); u.pm = (x & 1) * 8 + (jj >> 2); u.pn = jj & 3; return true; }
        const int per = rt * 4; u.e = T / per; const int t = T % per; u.pm = t >> 2; u.pn = t & 3; return true; }
    __device__ __forceinline__ const char* a_base(const Unit& u) const { return (const char*)(act + ((size_t)u.e * SLOTS_PAD + (size_t)u.pm * BM) * DEXP); }
    __device__ __forceinline__ void a_voff(const Unit&, const int (&R)[2], const int (&C)[2], unsigned (&v)[2][2]) const { plain_voff(R, C, v); }
    __device__ __forceinline__ const char* b_base(const Unit& u) const { return (const char*)(W + ((size_t)u.e * DM + (size_t)u.pn * BM) * DEXP); }
    __device__ __forceinline__ void epi(const f32x4 (&acc)[2][2][4][2], const Unit& u, int wr, int wc, int fr, int fq) const {
        f16* base = y + ((size_t)u.e * SLOTS_PAD + (size_t)u.pm * BM + wr * 64 + fr) * DM + u.pn * BM + wc * 32 + fq * 8;
#pragma unroll
        for (int ai = 0; ai < 2; ++ai)
#pragma unroll
            for (int m = 0; m < 4; ++m)
#pragma unroll
                for (int bj = 0; bj < 2; ++bj) *(f16x8*)(base + (size_t)(ai * HALF + m * 16) * DM + bj * HALF) = pack8(acc[ai][bj][m][0], acc[ai][bj][m][1]);
    }
};
template <int K_> struct PRDense : PRBase<K_, 1024, K_> {
    const f16* A; const f16* W; f16* O0; f16* O1; f16* O2; int ncol; int mode; int bid; int npan; int kvx;
    __device__ __forceinline__ size_t hstepB() const { return (size_t)HALF * K_ * 2; }
    __device__ __forceinline__ bool next(int i, Unit& u) const { const int ii = KDUP ? (i >> 1) : i; int T = ii * (int)gridDim.x + bid; if (gridDim.x == 256) T = (ii * 8 + (bid & 7)) * 32 + (bid >> 3);
        u.skip = KDUP ? ((i & 1) == 0) : 0; const int nu = npan * ncol; if (T >= nu + kvx) return false; u.e = 0; if (T < nu) { u.pm = T / ncol; u.pn = T % ncol; } else { const int x = T - nu; u.pm = npan + (x >> 1); u.pn = 4 + (x & 1); } return true; }
    __device__ __forceinline__ const char* a_base(const Unit& u) const { return (const char*)(A + (size_t)u.pm * BM * 1024 + (mode == 2 ? u.pn * 256 : 0)); }
    __device__ __forceinline__ void a_voff(const Unit&, const int (&R)[2], const int (&C)[2], unsigned (&v)[2][2]) const { this->plain_voff(R, C, v); }
    __device__ __forceinline__ const char* b_base(const Unit& u) const { return (const char*)(W + (size_t)u.pn * BM * K_); }
    const float* qn; const float* kn; const float* rope; LAS float* xs; int lane;
    __device__ __forceinline__ void epi(const f32x4 (&acc)[2][2][4][2], const Unit& u, int wr, int wc, int fr, int fq) const {
        f16* base; int ld;
        const int row = u.pm * BM + wr * 64 + fr, colw = wc * 32 + fq * 8;
        if (mode == 1) { if (u.pn < 4) { base = O0 + (size_t)row * 1024 + u.pn * BM + colw; ld = 1024; } else if (u.pn == 4) { base = O1 + (size_t)row * 256 + colw; ld = 256; } else { base = O2 + (size_t)row * 256 + colw; ld = 256; } }
        else { base = O0 + (size_t)row * 1024 + u.pn * BM + colw; ld = 1024; }
        if (mode == 1 && u.pn < 5) {
            float ssq[2][4][2];
#pragma unroll
            for (int ai = 0; ai < 2; ++ai)
#pragma unroll
                for (int m = 0; m < 4; ++m)
#pragma unroll
                    for (int bj = 0; bj < 2; ++bj) { const f32x4 a = acc[ai][bj][m][0], b = acc[ai][bj][m][1];
                        float t = (a[0] * a[0] + a[1] * a[1]) + (a[2] * a[2] + a[3] * a[3]) + (b[0] * b[0] + b[1] * b[1]) + (b[2] * b[2] + b[3] * b[3]);
                        t += shx<16>(t, lane); t += shx<32>(t, lane); ssq[ai][m][bj] = t; }
            LAS float* mine = xs + ((wr * 4 + wc) * 16) * 16 + fr; const LAS float* theirs = xs + ((wr * 4 + (wc ^ 1)) * 16) * 16 + fr;
            if (fq == 0) {
#pragma unroll
                for (int ai = 0; ai < 2; ++ai)
#pragma unroll
                    for (int m = 0; m < 4; ++m)
#pragma unroll
                        for (int bj = 0; bj < 2; ++bj) mine[(ai * 8 + m * 2 + bj) * 16] = ssq[ai][m][bj];
            }
            asm volatile("s_waitcnt lgkmcnt(0)" ::: "memory"); __builtin_amdgcn_s_barrier(); asm volatile("" ::: "memory");
            const bool isq = u.pn < 4, lat = u.pm < 128;
            const float* nw = (isq ? qn : kn) + (wc & 1) * 32 + fq * 8;
            const f32x4 w0 = *(const f32x4*)nw, w1 = *(const f32x4*)(nw + 4);
            const float qs = isq ? 0.125f * 1.4426950408889634f : 1.0f;
#pragma unroll
            for (int ai = 0; ai < 2; ++ai)
#pragma unroll
                for (int m = 0; m < 4; ++m) {
                    f32x4 c0 = (f32x4){1.f, 1.f, 1.f, 1.f}, s0 = (f32x4){0.f, 0.f, 0.f, 0.f};
                    if (lat) { const int t = (row + ai * HALF + m * 16) & (SEQ - 1); const int pos = (wc & 1) ? (t & 63) : (t >> 6);
                        const float* tb = rope + (size_t)(pos * 16 + fq * 4) * 2; const f32x4 ta = *(const f32x4*)tb, tb2 = *(const f32x4*)(tb + 4);
                        c0 = (f32x4){ta[0], ta[2], tb2[0], tb2[2]}; s0 = (f32x4){ta[1], ta[3], tb2[1], tb2[3]}; }
#pragma unroll
                    for (int bj = 0; bj < 2; ++bj) {
                        const float tot = ssq[ai][m][bj] + theirs[(ai * 8 + m * 2 + bj) * 16];
                        const float rstd = rsqrtf(tot * (1.0f / 64.0f) + 1e-6f) * qs;
                        f32x4 a = acc[ai][bj][m][0] * rstd * w0, b = acc[ai][bj][m][1] * rstd * w1;
                        const f32x4 ra = (f32x4){a[0] * c0[0] - a[1] * s0[0], a[0] * s0[0] + a[1] * c0[0], a[2] * c0[1] - a[3] * s0[1], a[2] * s0[1] + a[3] * c0[1]};
                        const f32x4 rb = (f32x4){b[0] * c0[2] - b[1] * s0[2], b[0] * s0[2] + b[1] * c0[2], b[2] * c0[3] - b[3] * s0[3], b[2] * s0[3] + b[3] * c0[3]};
                        *(f16x8*)(base + (size_t)(ai * HALF + m * 16) * ld + bj * HALF) = rm8(pack8(ra, rb));
                    }
                }
            return;
        }
#pragma unroll
        for (int ai = 0; ai < 2; ++ai)
#pragma unroll
            for (int m = 0; m < 4; ++m)
#pragma unroll
                for (int bj = 0; bj < 2; ++bj) { const f16x8 o = pack8(acc[ai][bj][m][0], acc[ai][bj][m][1]); *(f16x8*)(base + (size_t)(ai * HALF + m * 16) * ld + bj * HALF) = (mode == 1) ? rm8(o) : o; }
    }
};
}

struct CvtJob { const float* src; f16* dst; int K, N, k0, n0; };
__device__ __forceinline__ bool cvt_job(const Params& P, int l, int u, CvtJob& jb, bool experts) {
    const int j = l >> 1;
    const int nexp = experts ? NEXP * 3 * 128 : 0;
    const int nmix = (l & 1) == 0 ? 16 : (96 + 64);
    if (u >= nexp + nmix) return false;
    if (u < nexp) {
        const int e = u / 384, r = u % 384, which = r >> 7, t = r & 127;
        if (which < 2) { jb.src = (which == 0 ? P.w_gate : P.w_up) + ((size_t)l * NEXP + e) * DM * DEXP; jb.dst = P.Wgu() + ((size_t)e * 2 + which) * DEXP * DM; jb.K = DM; jb.N = DEXP; jb.k0 = (t >> 4) * 128; jb.n0 = (t & 15) * 128; }
        else { jb.src = P.w_down + ((size_t)l * NEXP + e) * DEXP * DM; jb.dst = P.Wd() + (size_t)e * DM * DEXP; jb.K = DEXP; jb.N = DM; jb.k0 = (t >> 3) * 128; jb.n0 = (t & 7) * 128; }
    } else {
        const int t = u - nexp;
        if ((l & 1) == 0) { const int g = t >> 2, tt = t & 3; jb.src = P.pool_w + (size_t)(j * 4 + g) * 65536; jb.dst = P.Wmix() + (size_t)g * 65536; jb.K = 256; jb.N = 256; jb.k0 = (tt >> 1) * 128; jb.n0 = (tt & 1) * 128; }
        else if (t < 96) { jb.src = P.w_qkv + (size_t)j * DM * QKVD; jb.dst = P.Wmix(); jb.K = DM; jb.N = QKVD; jb.k0 = (t / 12) * 128; jb.n0 = (t % 12) * 128; }
        else { const int tt = t - 96; jb.src = P.w_o + (size_t)j * DM * DM; jb.dst = P.Wmix() + (size_t)QKVD * DM; jb.K = DM; jb.N = DM; jb.k0 = (tt >> 3) * 128; jb.n0 = (tt & 7) * 128; }
    }
    return true;
}
__device__ __forceinline__ void phase_convert(const Params& P, int l, int bid, int nb, f16* tile, bool experts = true) {
    const int tid = opaque_tid();
    CvtJob jb;
    int u = bid;
    bool have = cvt_job(P, l, u, jb, experts);
    f32x4 r[8];
    if (have) {
#pragma unroll
        for (int p = 0; p < 8; ++p) { const int id = tid + p * NTHR, kr = id >> 5, c4 = (id & 31) * 4; r[p] = __builtin_nontemporal_load((const f32x4*)(jb.src + (size_t)(jb.k0 + kr) * jb.N + jb.n0 + c4)); }
    }
    while (have) {
        __syncthreads();
#pragma unroll
        for (int p = 0; p < 8; ++p) { const int id = tid + p * NTHR, kr = id >> 5, c4 = (id & 31) * 4; *(f16x4*)(tile + kr * 136 + c4) = pk4(r[p]); }
        __syncthreads();
        const CvtJob cur = jb;
        u += nb; have = cvt_job(P, l, u, jb, experts);
        if (have) {
#pragma unroll
            for (int p = 0; p < 8; ++p) { const int id = tid + p * NTHR, kr = id >> 5, c4 = (id & 31) * 4; r[p] = __builtin_nontemporal_load((const f32x4*)(jb.src + (size_t)(jb.k0 + kr) * jb.N + jb.n0 + c4)); }
        }
        const int n = tid & 127, kg = (tid >> 7) * 32;
        f16* dp = cur.dst + (size_t)(cur.n0 + n) * cur.K + cur.k0 + kg;
#pragma unroll
        for (int i = 0; i < 4; ++i) { f16x8 o;
#pragma unroll
            for (int e = 0; e < 8; ++e) o[e] = tile[(kg + i * 8 + e) * 136 + n];
            *(f16x8*)(dp + i * 8) = rmw8(o); }
    }
}
template <bool GATEUP, bool CTX>
__device__ __forceinline__ void phase_cvt_ctx(const Params& P, int l, int bid, int nb, f16* tile, int sel = -1, bool alt = false) {
    const int tid = opaque_tid(), wid = P.wv, lane = tid & 63, r16 = lane & 15, kq = lane >> 4;
    constexpr int NC = GATEUP ? 128 : 64;
    constexpr int KT = GATEUP ? 8 : 16, K = GATEUP ? DM : DEXP, N = GATEUP ? DEXP : DM, NB = N / NC;
    constexpr int NT = GATEUP ? 2 * KT : KT;
    const int sel_ = (GATEUP && !CTX) ? sel : -1; const int ntr = (GATEUP && sel_ < 0) ? NT : KT;
    constexpr int TS = NC + 4, TW = 128 * TS;
    constexpr int NLD = NC / 16;
    constexpr int WPC = 8 / (NC / 16);
    constexpr int NRB = 4 / WPC;
    const int cb = wid % (NC / 16), rb0 = (wid / (NC / 16)) * NRB;
    f16* asl = tile + 2 * TW;
    for (int job = bid; job < NEXP * NB; job += nb) {
        const int e = job / NB, nbk = job % NB;
        const f16* ap[2];
        if (CTX) {
#pragma unroll
            for (int p = 0; p < 2; ++p) { const int row = (tid >> 4) + p * 32;
                if (GATEUP) ap[p] = P.H() + (size_t)P.rowidx()[e * SLOTS_PAD + 4096 + row] * DM + (tid & 15) * 8;
                else ap[p] = P.act() + ((size_t)e * SLOTS_PAD + 4096 + row) * DEXP + (tid & 15) * 8; }
        }
        f32x4 acc[2][NRB];
#pragma unroll
        for (int w = 0; w < 2; ++w)
#pragma unroll
            for (int rb = 0; rb < NRB; ++rb) acc[w][rb] = (f32x4){0.f, 0.f, 0.f, 0.f};
        const float* srcs[2]; f16* dsts[2];
        if (GATEUP) { const size_t wo = ((size_t)l * NEXP + e) * DM * DEXP; srcs[0] = P.w_gate + wo; srcs[1] = P.w_up + wo; dsts[0] = P.Wgu() + (alt ? (OFF_WGU3 - OFF_WGU) / 2 : 0) + ((size_t)e * 2) * DEXP * DM; dsts[1] = dsts[0] + (size_t)DEXP * DM; }
        else { srcs[0] = P.w_down + ((size_t)l * NEXP + e) * DEXP * DM; srcs[1] = srcs[0]; dsts[0] = P.Wd() + (alt ? (OFF_WD3 - OFF_WD) / 2 : 0) + (size_t)e * DM * DEXP; dsts[1] = dsts[0]; }
        f32x4 r[2][NLD]; f16x8 ar[2][2];
        const unsigned ldoff = (unsigned)(((tid / (NC / 4)) * N + (tid % (NC / 4)) * 4) * 4);
#define CV_LOAD(ti, slot) do { const int which_ = GATEUP ? (sel_ >= 0 ? sel_ : ((ti) & 1)) : 0, kt_ = (GATEUP && sel_ < 0) ? ((ti) >> 1) : (ti); const char* sp_ = (const char*)(srcs[which_] + (size_t)(kt_ * 128) * N + nbk * NC); \
            _Pragma("unroll") for (int p = 0; p < NLD; ++p) r[slot][p] = __builtin_nontemporal_load((const f32x4*)(sp_ + (size_t)p * (NTHR / (NC / 4)) * N * 4 + ldoff)); \
            if (CTX) { _Pragma("unroll") for (int p = 0; p < 2; ++p) ar[slot][p] = *(const f16x8*)(ap[p] + kt_ * 128); } } while (0)
#define CV_TILE(ti, slot) do { const int which = GATEUP ? (sel_ >= 0 ? sel_ : ((ti) & 1)) : 0, kt = (GATEUP && sel_ < 0) ? ((ti) >> 1) : (ti); \
            f16* tl = tile + (slot) * TW; f16* al = asl + (slot) * (64 * 128); \
            _Pragma("unroll") for (int p = 0; p < NLD; ++p) { const int id = tid + p * NTHR, kr = id / (NC / 4), c4 = (id % (NC / 4)) * 4; *(f16x4*)(tl + kr * TS + c4) = pk4(r[slot][p]); } \
            if (CTX) { _Pragma("unroll") for (int p = 0; p < 2; ++p) { const int row = (tid >> 4) + p * 32; *(f16x8*)(al + row * 128 + (((tid & 15) ^ (row & 15)) * 8)) = ar[slot][p]; } } \
            if ((ti) + 2 < ntr) CV_LOAD((ti) + 2, slot); \
            asm volatile("s_waitcnt lgkmcnt(0)" ::: "memory"); __builtin_amdgcn_s_barrier(); asm volatile("" ::: "memory"); \
            f16* dp = dsts[which] + (size_t)(nbk * NC + cb * 16 + r16) * K + kt * 128 + kq * 8; \
            _Pragma("unroll") for (int ks = 0; ks < 4; ++ks) { f16x8 bv; \
                _Pragma("unroll") for (int i = 0; i < 8; ++i) bv[i] = tl[(ks * 32 + kq * 8 + i) * TS + cb * 16 + r16]; \
                if (rb0 == 0) *(f16x8*)(dp + ks * 32) = rmw8(bv); \
                if (CTX) { _Pragma("unroll") for (int rb = 0; rb < NRB; ++rb) { const int row = (rb0 + rb) * 16 + r16; const f16x8 af = *(const f16x8*)(al + row * 128 + (((ks * 4 + kq) ^ r16) * 8)); \
                    acc[which][rb] = __builtin_amdgcn_mfma_f32_16x16x32_f16(bv, af, acc[which][rb], 0, 0, 0); } } } } while (0)
        CV_LOAD(0, 0); CV_LOAD(1, 1);
        for (int t2 = 0; t2 < ntr; t2 += 2) { CV_TILE(t2, 0); CV_TILE(t2 + 1, 1); }
#undef CV_LOAD
#undef CV_TILE
        asm volatile("s_waitcnt lgkmcnt(0)" ::: "memory"); __builtin_amdgcn_s_barrier(); asm volatile("" ::: "memory");
        if (CTX) {
#pragma unroll
            for (int rb = 0; rb < NRB; ++rb) {
                const size_t row = (size_t)e * SLOTS_PAD + 4096 + (rb0 + rb) * 16 + r16; const int col = nbk * NC + cb * 16 + 4 * kq;
                if (GATEUP) { f32x4 o;
#pragma unroll
                    for (int jj = 0; jj < 4; ++jj) o[jj] = silu_f(acc[0][rb][jj]) * acc[1][rb][jj];
                    *(f16x4*)(P.act() + row * DEXP + col) = pk4(o); }
                else *(f16x4*)(P.yslot() + row * DM + col) = pk4(acc[0][rb]);
            }
        }
    }
}

__device__ __forceinline__ void cvt3_job(const Params& P, int job, f16* tile) {
    if (job < 256) phase_cvt_ctx<false, false>(P, 3, job, 1 << 20, tile, -1, true);
    else { const int h = job - 256; phase_cvt_ctx<true, false>(P, 3, h >> 1, 1 << 20, tile, h & 1, true); }
}
__device__ __forceinline__ void phase_gateup_fast(const Params& P, LAS unsigned char* lds, int rt = 17, bool alt = false) { fg::PRGateUp S; S.H = P.H(); S.rowidx = P.rowidx(); S.W = P.Wgu() + (alt ? (OFF_WGU3 - OFF_WGU) / 2 : 0); S.act = P.act(); S.rt = rt; S.nunits = 16 * rt * 16; S.bid = opaque_bid(); fg::gemm_phase(lds, S, P.wv); }
__device__ __forceinline__ void phase_down_fast(const Params& P, LAS unsigned char* lds, int rt = 17, bool alt = false) { fg::PRDown S; S.act = P.act(); S.W = P.Wd() + (alt ? (OFF_WD3 - OFF_WD) / 2 : 0); S.y = P.yslot(); S.rt = rt; S.nunits = 16 * rt * 4; S.bid = opaque_bid(); fg::gemm_phase(lds, S, P.wv); }
__device__ __forceinline__ void phase_pool_fast(const Params& P, LAS unsigned char* lds) { fg::PRDense<256> S; S.qn = nullptr; S.kn = nullptr; S.rope = nullptr; S.xs = nullptr; S.lane = 0; S.npan = 130; S.kvx = 0; S.A = P.H(); S.W = P.Wmix(); S.O0 = P.Z(); S.O1 = nullptr; S.O2 = nullptr; S.ncol = 4; S.mode = 2; S.bid = opaque_bid(); fg::gemm_phase(lds, S, P.wv); }
__device__ __forceinline__ void phase_qkv_fast(const Params& P, LAS unsigned char* lds, bool lastl = false, int l = 1) { fg::PRDense<1024> S; S.qn = P.q_norm + (l >> 1) * 64; S.kn = P.k_norm + (l >> 1) * 64; S.rope = P.rope(); S.xs = (LAS float*)(lds + fg::STAGE_BYTES); S.lane = opaque_tid_(P.wv) & 63; S.npan = lastl ? 128 : 130; S.kvx = lastl ? 4 : 0; S.A = P.H(); S.W = P.Wmix(); S.O0 = P.Q(); S.O1 = P.Kb(); S.O2 = P.Vb(); S.ncol = 6; S.mode = 1; S.bid = opaque_bid(); fg::gemm_phase(lds, S, P.wv); }
__device__ __forceinline__ void phase_oproj_fast(const Params& P, LAS unsigned char* lds, bool lastl = false) { fg::PRDense<1024> S; S.qn = nullptr; S.kn = nullptr; S.rope = nullptr; S.xs = nullptr; S.lane = 0; S.npan = lastl ? 128 : 130; S.kvx = 0; S.A = P.O(); S.W = P.Wmix() + (size_t)QKVD * DM; S.O0 = P.Z(); S.O1 = nullptr; S.O2 = nullptr; S.ncol = 4; S.mode = 0; S.bid = opaque_bid(); fg::gemm_phase(lds, S, P.wv); }

typedef float f32x16 __attribute__((ext_vector_type(16)));
#define AT_KB 9216
#define AT_VB 8704
template <int VAR = 0>
__device__ __forceinline__ void phase_attn_fast(const Params& P, int l, LAS unsigned char* lds, bool do_ctx, int cvt_l = -1) {
    const int j = l >> 1;
    const int tid = opaque_tid(), wid = tid >> 6, lane = tid & 63, l32 = lane & 31, hi = lane >> 5;
    const int g = wid >> 1, qoff = (wid & 1) * 64, qoffu = (P.wv & 1) * 64;
    const int nunits = do_ctx ? 1040 : 1024;
    int ucount = 0;
    for (int u = opaque_bid(); u < nunits; u += gridDim.x, ++ucount) {
        int b, qblk, kv, qrow0, t0, t1, s0;
        if (u < 1024) { b = u >> 9; qblk = (u >> 2) & 127; kv = u & 3; s0 = b * SEQ; qrow0 = s0 + qblk * 128; t0 = qblk == 0 ? 2 : 0; t1 = qblk == 127 ? 4 : 6; }
        else { const int uu = u - 1024; b = uu >> 3; qblk = (uu >> 2) & 1; kv = uu & 3; s0 = NLAT + b * CTXL; qrow0 = s0 + qblk * 128; t0 = 0; t1 = 0; }
        const int cb = NLAT + b * CTXL, nloc = t1 - t0, ntiles = nloc + 4;
        const int h = kv * 4 + g;
        f16x8 Qf[2][4];
#pragma unroll
        for (int qb = 0; qb < 2; ++qb)
#pragma unroll
            for (int ks = 0; ks < 4; ++ks) Qf[qb][ks] = *(const f16x8*)(P.Q() + (size_t)(qrow0 + qoff + 32 * qb + l32) * 1024 + h * 64 + 16 * ks + 8 * hi);
        f32x16 OT[2][2];
#pragma unroll
        for (int db = 0; db < 2; ++db)
#pragma unroll
            for (int qb = 0; qb < 2; ++qb)
#pragma unroll
                for (int r = 0; r < 16; ++r) OT[db][qb][r] = 0.f;
        float mrun[2], lrun[2];
        { const float sk = P.sink[j * 16 + h] * 1.4426950408889634f; mrun[0] = sk; mrun[1] = sk; lrun[0] = hi == 0 ? 1.0f : 0.0f; lrun[1] = lrun[0]; }
        const int lkey = tid >> 3, lpc = tid & 7;
        f16x8 kreg, vreg;
        auto tile_row = [&](int it) -> int { return it < nloc ? (qrow0 - 128 + 64 * (t0 + it)) : (cb + 64 * (it - nloc)); };
        { const int kr = tile_row(0) + lkey; kreg = *(const f16x8*)(P.Kb() + (size_t)kr * 256 + kv * 64 + lpc * 8); vreg = *(const f16x8*)(P.Vb() + (size_t)kr * 256 + kv * 64 + lpc * 8); }
        __syncthreads();
        {
            LAS f16* Kl = (LAS f16*)(lds); LAS f16* Vl = (LAS f16*)(lds + 2 * AT_KB);
            *(LAS f16x8*)(Kl + lkey * 72 + lpc * 8) = kreg;
#pragma unroll
            for (int i = 0; i < 8; ++i) Vl[(lpc * 8 + i) * 68 + lkey] = vreg[i];
        }
        __syncthreads();
        for (int it = 0; it < ntiles; ++it) {
            const int buf = it & 1;
            if (it + 1 < ntiles) { const int kr = tile_row(it + 1) + lkey; kreg = *(const f16x8*)(P.Kb() + (size_t)kr * 256 + kv * 64 + lpc * 8); vreg = *(const f16x8*)(P.Vb() + (size_t)kr * 256 + kv * 64 + lpc * 8); }
            const LAS f16* Kl = (const LAS f16*)(lds + buf * AT_KB); const LAS f16* Vl = (const LAS f16*)(lds + 2 * AT_KB + buf * AT_VB);
            int cls = 0;
            if (it < nloc) { const int tl = t0 + it, dmin = qoffu + 65 - 64 * tl, dmax = qoffu + 191 - 64 * tl; cls = (dmin > 128 || dmax < -128) ? 2 : ((dmin >= -128 && dmax <= 128) ? 0 : 1); }
            if (cls != 2) {
            f32x16 S[2][2];
#pragma unroll
            for (int kb = 0; kb < 2; ++kb)
#pragma unroll
                for (int qb = 0; qb < 2; ++qb)
#pragma unroll
                    for (int r = 0; r < 16; ++r) S[kb][qb][r] = -mrun[qb];
#pragma unroll
            for (int ks = 0; ks < 4; ++ks)
#pragma unroll
                for (int kb = 0; kb < 2; ++kb) {
                    const f16x8 kf = *(const LAS f16x8*)(Kl + (32 * kb + l32) * 72 + 16 * ks + 8 * hi);
#pragma unroll
                    for (int qb = 0; qb < 2; ++qb) S[kb][qb] = __builtin_amdgcn_mfma_f32_32x32x16_f16(kf, Qf[qb][ks], S[kb][qb], 0, 0, 0);
                }
            if (cls == 1) {
                const int kt = 64 * (t0 + it);
#pragma unroll
                for (int qb = 0; qb < 2; ++qb) {
                    const int qp = 128 + qoff + 32 * qb + l32;
#pragma unroll
                    for (int kb = 0; kb < 2; ++kb)
#pragma unroll
                        for (int r = 0; r < 16; ++r) { const int kp = kt + 32 * kb + 8 * (r >> 2) + 4 * hi + (r & 3); const int d = qp - kp; if (d > 128 || d < -128) S[kb][qb][r] = -INFINITY; }
                }
            }
            f16x8 Pf[2][4];
#pragma unroll
            for (int qb = 0; qb < 2; ++qb) {
                float mx = S[0][qb][0];
#pragma unroll
                for (int kb = 0; kb < 2; ++kb)
#pragma unroll
                    for (int r = 0; r < 16; ++r) mx = fmaxf(mx, S[kb][qb][r]);
                { const auto sw = __builtin_amdgcn_permlane32_swap(__float_as_uint(mx), __float_as_uint(mx), false, false); mx = fmaxf(__uint_as_float(sw[0]), __uint_as_float(sw[1])); }
                if (__builtin_amdgcn_ballot_w64(mx > 8.0f) != 0ull) {
                    const float g = fmaxf(mx, 0.f), corr = __builtin_amdgcn_exp2f(-g);
                    mrun[qb] += g; lrun[qb] *= corr;
#pragma unroll
                    for (int kb = 0; kb < 2; ++kb)
#pragma unroll
                        for (int r = 0; r < 16; ++r) S[kb][qb][r] -= g;
#pragma unroll
                    for (int db = 0; db < 2; ++db)
#pragma unroll
                        for (int r = 0; r < 16; ++r) OT[db][qb][r] *= corr;
                }
                float ps = 0.f;
#pragma unroll
                for (int kb = 0; kb < 2; ++kb)
#pragma unroll
                    for (int r = 0; r < 16; ++r) { const float p = __builtin_amdgcn_exp2f(S[kb][qb][r]); S[kb][qb][r] = p; ps += p; }
                lrun[qb] += ps;
#pragma unroll
                for (int ks = 0; ks < 4; ++ks) { const int kb = ks >> 1, r0 = 8 * (ks & 1);
#pragma unroll
                    for (int e = 0; e < 8; ++e) Pf[qb][ks][e] = (f16)S[kb][qb][r0 + e]; }
            }
#pragma unroll
            for (int ks = 0; ks < 4; ++ks)
#pragma unroll
                for (int db = 0; db < 2; ++db) {
                    const LAS f16* vp = Vl + (32 * db + l32) * 68 + 16 * ks + 4 * hi;
                    const f16x4 v0 = *(const LAS f16x4*)vp, v1 = *(const LAS f16x4*)(vp + 8);
                    const f16x8 vf = (f16x8){v0[0], v0[1], v0[2], v0[3], v1[0], v1[1], v1[2], v1[3]};
#pragma unroll
                    for (int qb = 0; qb < 2; ++qb) OT[db][qb] = __builtin_amdgcn_mfma_f32_32x32x16_f16(vf, Pf[qb][ks], OT[db][qb], 0, 0, 0);
                }
            }
            if (it + 1 < ntiles) {
                LAS f16* Kw = (LAS f16*)(lds + (buf ^ 1) * AT_KB); LAS f16* Vw = (LAS f16*)(lds + 2 * AT_KB + (buf ^ 1) * AT_VB);
                *(LAS f16x8*)(Kw + lkey * 72 + lpc * 8) = kreg;
#pragma unroll
                for (int i = 0; i < 8; ++i) Vw[(lpc * 8 + i) * 68 + lkey] = vreg[i];
            }
            __syncthreads();
        }
#pragma unroll
        for (int qb = 0; qb < 2; ++qb) {
            const float lt = lrun[qb] + shx<32>(lrun[qb], lane);
            const float inv = 1.0f / lt;
            f16* op = P.O() + (size_t)(qrow0 + qoff + 32 * qb + l32) * 1024 + h * 64;
#pragma unroll
            for (int db = 0; db < 2; ++db)
#pragma unroll
                for (int i = 0; i < 4; ++i) {
                    const f16x4 o = (f16x4){(f16)(OT[db][qb][4 * i] * inv), (f16)(OT[db][qb][4 * i + 1] * inv), (f16)(OT[db][qb][4 * i + 2] * inv), (f16)(OT[db][qb][4 * i + 3] * inv)};
                    *(f16x4*)(op + 32 * db + 8 * i + 4 * hi) = rm4(o);
                }
        }
    }
}

#define MEGA_LDS (147456 + 16)
__device__ __forceinline__ const Params& opq(Params& q) { int z; asm volatile("s_mov_b32 %0, 0" : "=s"(z)); q.zoff = z; return q; }
__global__ __launch_bounds__(NTHR, 2) void mega(Params P) {
    extern __shared__ __attribute__((aligned(16))) unsigned char shm[];
    LAS unsigned char* lds = (LAS unsigned char*)shm;
    volatile LAS unsigned* st = (volatile LAS unsigned*)(lds + 147456);
    if (threadIdx.x == 0) { st[0] = 0u; st[1] = 0u; st[2] = 0u; st[3] = 0u; }
    __syncthreads();
    const XcdBarrier bar = xcd_barrier_post(P.bar(), st);
    const int nb = gridDim.x;
#define bid (opaque_bid())
    Params Q = P; Q.wv = __builtin_amdgcn_readfirstlane(threadIdx.x >> 6);
#define P (opq(Q))
    phase_ada(P, bid, nb, (float*)shm, 0, nb == 256 ? 1 : 4, true);
    __syncthreads();
    phase_convert(P, 0, bid, nb, (f16*)shm, false);
    xcd_barrier(bar);
    for (int l = 0; l < 4; ++l) {
        if (l == 0) phase_n1<true, false>(P, l, bid, nb); else { phase_n1<false, false>(P, l, bid, nb); if (nb != 256) { __syncthreads(); phase_convert(P, l, bid, nb, (f16*)shm, false); }
            }
        xcd_barrier(bar);
        if ((l & 1) == 0) {
            phase_pool_fast(P, lds);
            xcd_barrier(bar);
            phase_n2<true>(P, l, bid, nb, (float*)shm);
        } else {
            phase_qkv_fast(P, lds, l == 3, l);
            if (nb == 256 && (bid & 7) >= 2) { __syncthreads(); cvt3_job(P, (l == 1 ? 192 : 576) + ((bid & 7) - 2) * 32 + (bid >> 3), (f16*)shm); }
            xcd_barrier(bar);
            phase_attn_fast(P, l, lds, l != 3);
            if (l == 3 && nb != 256) { __syncthreads(); phase_cvt_ctx<true, false>(P, l, bid, nb, (f16*)shm, -1, true); phase_cvt_ctx<false, false>(P, l, bid, nb, (f16*)shm, -1, true); }
            xcd_barrier(bar);
            phase_oproj_fast(P, lds, l == 3);
            if (l == 1 && nb == 256 && (bid & 7) >= 2) { __syncthreads(); cvt3_job(P, 384 + ((bid & 7) - 2) * 32 + (bid >> 3), (f16*)shm); }
            xcd_barrier(bar);
            phase_n2<false>(P, l, bid, nb, (float*)shm, l == 3 ? NLAT : MROWS);
        }
        xcd_barrier(bar);
        phase_topk(P, bid, nb, (unsigned*)shm, l == 3 ? 32 : 64);
        if (l < 3 && nb == 256 && bid >= 64 && bid < 128) cvt3_job(P, l * 64 + bid - 64, (f16*)shm);
        if (l < 3 && nb == 256 && bid >= 224) phase_convert(P, l + 1, bid - 224, 32, (f16*)shm, false);
        if (l < 3 && nb == 256 && bid >= 128 && bid < 224) phase_ada(P, bid - 128, 1 << 20, (float*)shm, l + 1, 1, false);
        xcd_barrier(bar);
        if (l < 3) { phase_cvt_ctx<true, true>(P, l, bid, nb, (f16*)shm); xcd_barrier(bar); }
        phase_gateup_fast(P, lds, 16, l == 3);
        if (l < 3) { __syncthreads(); phase_cvt_ctx<false, true>(P, l, bid, nb, (f16*)shm); }
        xcd_barrier(bar);
        phase_down_fast(P, lds, 16, l == 3);
        xcd_barrier(bar);
    }
    phase_n1<false, true>(P, 4, bid, nb);
#undef P
#undef bid
}

static inline size_t al256(size_t v) { return (v + 255) & ~(size_t)255; }

extern "C" void kernel_launch(void* const* d_in, const int* in_sizes, int n_in, void* d_out, int out_size, void* d_ws, size_t ws_size, hipStream_t stream) {
    Params P{};
    P.x = (const float*)d_in[0]; P.c = (const float*)d_in[1]; P.ctx = (const float*)d_in[2]; P.c_ctx = (const float*)d_in[3];
    P.w_ada = (const float*)d_in[4]; P.b_ada = (const float*)d_in[5]; P.norm1_g = (const float*)d_in[6]; P.norm2_g = (const float*)d_in[7];
    P.pool_w = (const float*)d_in[8]; P.pool_scale = (const float*)d_in[9]; P.w_qkv = (const float*)d_in[10]; P.w_o = (const float*)d_in[11];
    P.q_norm = (const float*)d_in[12]; P.k_norm = (const float*)d_in[13]; P.sink = (const float*)d_in[14]; P.router_w = (const float*)d_in[15];
    P.w_gate = (const float*)d_in[16]; P.w_up = (const float*)d_in[17]; P.w_down = (const float*)d_in[18];
    P.out = (float*)d_out;
    P.ws = (char*)d_ws; const size_t off = WS_TOTAL;
    if (off > ws_size) { fprintf(stderr, "workspace too small: need %zu have %zu\n", off, ws_size); return; }
    static int grid = 0;
    if (!grid) {
        int dev = 0, cus = 0, per_cu = 0;
        hipGetDevice(&dev);
        hipDeviceGetAttribute(&cus, hipDeviceAttributeMultiprocessorCount, dev);
        hipFuncSetAttribute((const void*)mega, hipFuncAttributeMaxDynamicSharedMemorySize, MEGA_LDS);
        hipOccupancyMaxActiveBlocksPerMultiprocessor(&per_cu, (const void*)mega, NTHR, MEGA_LDS);
        if (per_cu < 1) { fprintf(stderr, "mega: occupancy query says %d blocks per CU\n", per_cu); }
        grid = cus > 0 ? cus : 256;
    }
    hipMemsetAsync(P.bar(), 0, XCD_BAR_WORDS * sizeof(unsigned), stream);
    hipLaunchKernelGGL(mega, dim3(grid), dim3(NTHR), MEGA_LDS, stream, P);
}
```

```cpp
#include <hip/hip_runtime.h>
#include <stdint.h>
#include <stdio.h>

typedef _Float16 f16;
typedef _Float16 f16x2 __attribute__((ext_vector_type(2)));
typedef _Float16 f16x4 __attribute__((ext_vector_type(4)));
typedef _Float16 f16x8 __attribute__((ext_vector_type(8)));
typedef float f32x4 __attribute__((ext_vector_type(4)));
typedef float f32x2 __attribute__((ext_vector_type(2)));
typedef unsigned u32x2 __attribute__((ext_vector_type(2)));
typedef unsigned u32x4 __attribute__((ext_vector_type(4)));
#define RM_BITS 5
#define RM_ADD (0x00010001u << (RM_BITS - 1))
#define RM_MASK (~(0x00010001u * ((1u << RM_BITS) - 1u)))
__device__ __forceinline__ f16x4 rm4(f16x4 v) { u32x2 b = __builtin_bit_cast(u32x2, v); b = (b + RM_ADD) & RM_MASK; return __builtin_bit_cast(f16x4, b); }
__device__ __forceinline__ f16x8 rm8(f16x8 v) { u32x4 b = __builtin_bit_cast(u32x4, v); b = (b + RM_ADD) & RM_MASK; return __builtin_bit_cast(f16x8, b); }
#define RMW_BITS 5
__device__ __forceinline__ f16x8 rmw8(f16x8 v) { u32x4 b = __builtin_bit_cast(u32x4, v); b = (b + (0x00010001u << (RMW_BITS - 1))) & ~(0x00010001u * ((1u << RMW_BITS) - 1u)); return __builtin_bit_cast(f16x8, b); }

#define LAS __attribute__((address_space(3)))
#define DM 1024
#define SEQ 16384
#define NLAT 32768
#define CTXL 256
#define NCTX 512
#define MROWS 33280
#define NEXP 16
#define DEXP 2048
#define SLOTS 4160
#define SLOTS_PAD 4352
#define QKVD 1536
#define NTHR 512

constexpr size_t al256c(size_t v) { return (v + 255) & ~(size_t)255; }
constexpr size_t OFF_BAR = 0;
constexpr size_t OFF_MOD = al256c(OFF_BAR + 16384);
constexpr size_t OFF_ROPE = al256c(OFF_MOD + (size_t)4 * 3 * 6 * DM * 4);
constexpr size_t OFF_X = al256c(OFF_ROPE + (size_t)256 * 16 * 2 * 4);
constexpr size_t OFF_H = al256c(OFF_X + (size_t)MROWS * DM * 4);
constexpr size_t OFF_Z = al256c(OFF_H + (size_t)MROWS * DM * 2);
constexpr size_t OFF_Q = al256c(OFF_Z + (size_t)MROWS * DM * 2);
constexpr size_t OFF_KB = al256c(OFF_Q + (size_t)MROWS * DM * 2);
constexpr size_t OFF_VB = al256c(OFF_KB + (size_t)MROWS * 256 * 2);
constexpr size_t OFF_VT = al256c(OFF_VB + (size_t)MROWS * 256 * 2);
constexpr size_t OFF_O = al256c(OFF_VT + (size_t)MROWS * 256 * 2);
constexpr size_t OFF_AFF = al256c(OFF_O + (size_t)MROWS * DM * 2);
constexpr size_t OFF_INV = al256c(OFF_AFF + (size_t)MROWS * 16 * 4);
constexpr size_t OFF_ROWIDX = al256c(OFF_INV + (size_t)MROWS * 16 * 4);
constexpr size_t OFF_ACT = al256c(OFF_ROWIDX + (size_t)NEXP * SLOTS_PAD * 4);
constexpr size_t OFF_YSLOT = al256c(OFF_ACT + (size_t)NEXP * SLOTS_PAD * DEXP * 2);
constexpr size_t OFF_WGU = al256c(OFF_YSLOT + (size_t)NEXP * SLOTS_PAD * DM * 2);
constexpr size_t OFF_WD = al256c(OFF_WGU + (size_t)NEXP * 2 * DEXP * DM * 2);
constexpr size_t OFF_WMIX = al256c(OFF_WD + (size_t)NEXP * DM * DEXP * 2);
constexpr size_t OFF_WGU3 = al256c(OFF_WMIX + (size_t)(QKVD + DM) * DM * 2);
constexpr size_t OFF_WD3 = al256c(OFF_WGU3 + (size_t)NEXP * 2 * DEXP * DM * 2);
constexpr size_t OFF_DUMMY = al256c(OFF_WD3 + (size_t)NEXP * DM * DEXP * 2);
constexpr size_t WS_TOTAL = OFF_DUMMY;
struct Params {
    const float *x, *c, *ctx, *c_ctx, *w_ada, *b_ada, *norm1_g, *norm2_g, *pool_w, *pool_scale, *w_qkv, *w_o, *q_norm, *k_norm, *sink, *router_w, *w_gate, *w_up, *w_down;
    float* out; char* ws; int wv; int zoff;
#define WSF(name, type, off) __host__ __device__ __forceinline__ type* name() const { return (type*)(ws + zoff + (off)); }
    WSF(bar, unsigned, OFF_BAR) WSF(mod, float, OFF_MOD) WSF(rope, float, OFF_ROPE) WSF(X, f16, OFF_X) WSF(H, f16, OFF_H) WSF(Z, f16, OFF_Z) WSF(Q, f16, OFF_Q) WSF(Kb, f16, OFF_KB) WSF(Vb, f16, OFF_VB) WSF(Vt, f16, OFF_VT)
    WSF(O, f16, OFF_O) WSF(aff, float, OFF_AFF) WSF(inv, int, OFF_INV) WSF(rowidx, int, OFF_ROWIDX) WSF(act, f16, OFF_ACT) WSF(yslot, f16, OFF_YSLOT) WSF(Wgu, f16, OFF_WGU) WSF(Wd, f16, OFF_WD) WSF(Wmix, f16, OFF_WMIX)
#undef WSF
#define WSW(name, type, off) __host__ __device__ __forceinline__ type* name() const { return (type*)(ws + zoff + (off)); }
    WSW(Xw, f16, OFF_X) WSW(Ow, f16, OFF_O) WSW(Hw, f16, OFF_H) WSW(affw, float, OFF_AFF) WSW(Qw, f16, OFF_Q) WSW(Kw, f16, OFF_KB)
#undef WSW
};

template <int O> __device__ __forceinline__ float shx(float v, int lane) {
    if (O == 1) return __int_as_float(__builtin_amdgcn_update_dpp(0, __float_as_int(v), 0xB1, 0xF, 0xF, true));
    if (O == 2) return __int_as_float(__builtin_amdgcn_update_dpp(0, __float_as_int(v), 0x4E, 0xF, 0xF, true));
    if (O < 32) return __int_as_float(__builtin_amdgcn_ds_swizzle(__float_as_int(v), (O << 10) | 0x1f));
    return __int_as_float(__builtin_amdgcn_ds_bpermute((lane ^ O) << 2, __float_as_int(v)));
}
__device__ __forceinline__ float wave_sum(float v, int lane) {
    v += shx<1>(v, lane); v += shx<2>(v, lane); v += shx<4>(v, lane); v += shx<8>(v, lane); v += shx<16>(v, lane); v += shx<32>(v, lane);
    return v;
}
__device__ __forceinline__ unsigned shup(unsigned v, int o, int lane) { return (unsigned)__builtin_amdgcn_ds_bpermute((lane - o) << 2, (int)v); }
__device__ __forceinline__ int opaque_bid() { int b = blockIdx.x; asm volatile("" : "+s"(b)); return b; }
#define opaque_tid() opaque_tid_(P.wv)
__device__ __forceinline__ int opaque_tid_(int wv) { int ln; asm volatile("v_mbcnt_lo_u32_b32 %0, -1, 0\n\tv_mbcnt_hi_u32_b32 %0, -1, %0" : "=v"(ln)); return (wv << 6) | ln; }
__device__ __forceinline__ float silu_f(float v) { return v * __builtin_amdgcn_rcpf(1.0f + __expf(-v)); }

__device__ __forceinline__ const float* modp(const Params& P, int l, int v, int j) { return P.mod() + (size_t)((l * 3 + v) * 6 + j) * DM; }

__device__ __forceinline__ void phase_ada(const Params& P, int bid, int nb, float* lds, int l0 = 0, int nl = 4, bool do_rope = true) {
    float* sc = lds; float* red = lds + 3 * DM;
    const int tid = opaque_tid();
    for (int i = tid; i < 3 * DM; i += NTHR) { const int v = i >> 10, k = i & 1023; const float cv = v < 2 ? P.c[v * DM + k] : P.c_ctx[k]; sc[i] = silu_f(cv); }
    __syncthreads();
    for (int u = bid; u < nl * 96; u += nb) {
        const int l = l0 + u / 96, ch = u % 96, c4 = tid & 15, kg = tid >> 4;
        const float* w = P.w_ada + (size_t)l * DM * 6 * DM + ch * 64 + c4 * 4;
        f32x4 s0 = (f32x4){0.f, 0.f, 0.f, 0.f}, s1 = s0, s2 = s0;
#pragma unroll 8
        for (int i = 0; i < 32; ++i) { const int k = kg * 32 + i; const f32x4 wv = __builtin_nontemporal_load((const f32x4*)(w + (size_t)k * 6 * DM)); s0 += sc[k] * wv; s1 += sc[DM + k] * wv; s2 += sc[2 * DM + k] * wv; }
        *(f32x4*)(red + (kg * 3 + 0) * 64 + c4 * 4) = s0; *(f32x4*)(red + (kg * 3 + 1) * 64 + c4 * 4) = s1; *(f32x4*)(red + (kg * 3 + 2) * 64 + c4 * 4) = s2;
        __syncthreads();
        if (tid < 192) { const int v = tid >> 6, cc = tid & 63; float s = 0.f;
#pragma unroll
            for (int q = 0; q < 32; ++q) s += red[(q * 3 + v) * 64 + cc];
            const int colg = ch * 64 + cc; s += P.b_ada[l * 6 * DM + colg];
            const int j = colg >> 10, d = colg & 1023;
            P.mod()[(size_t)((l * 3 + v) * 6 + j) * DM + d] = s; }
        __syncthreads();
    }
    if (do_rope) for (int i = bid * NTHR + tid; i < 256 * 16; i += nb * NTHR) {
        const int p = i >> 4, f = i & 15;
        const float inv = powf(10000.0f, -(float)f / 16.0f);
        const float angf = (float)p * inv;
        double a = (double)angf;
        const double twopi = 6.283185307179586476925286766559;
        a -= twopi * rint(a / twopi);
        const double a2 = a * a;
        double cs = 1.0, sn = 1.0;
        double tc = 0.0, ts = 0.0;
        for (int n = 16; n >= 1; --n) { tc = (tc + 1.0) * (-a2 / (double)((2 * n - 1) * (2 * n))); ts = (ts + 1.0) * (-a2 / (double)((2 * n) * (2 * n + 1))); }
        cs = 1.0 + tc; sn = a * (1.0 + ts);
        P.rope()[i * 2] = (float)cs; P.rope()[i * 2 + 1] = (float)sn;
    }
}

__device__ __forceinline__ f32x4 cvt4(const f16x4 v) { return (f32x4){(float)v[0], (float)v[1], (float)v[2], (float)v[3]}; }
__device__ __forceinline__ f16x4 pk4(const f32x4 v) { return (f16x4){(f16)v[0], (f16)v[1], (f16)v[2], (f16)v[3]}; }
__device__ __forceinline__ float dot4(const f32x4 a, const f32x4 b) { return a[0] * b[0] + a[1] * b[1] + a[2] * b[2] + a[3] * b[3]; }
template <bool FIRST, bool FINAL>
__device__ __forceinline__ void phase_n1(const Params& P, int l, int bid, int nb) {
    constexpr int R = 4;
    const int tid_ = opaque_tid(); const int wid = P.wv, lane = tid_ & 63;
    const int nrows = FINAL ? NLAT : MROWS;
    for (int rb = (bid * 8 + wid) * R; rb < nrows; rb += nb * 8 * R) {
        const int v = rb < NLAT ? (rb >> 14) : 2;
        f32x4 xv[R][4];
#pragma unroll
        for (int u = 0; u < R; ++u) {
            const int r = rb + u;
            if (FIRST) { const float* src = r < NLAT ? P.x + (size_t)r * DM : P.ctx + (size_t)(r - NLAT) * DM;
#pragma unroll
                for (int q = 0; q < 4; ++q) xv[u][q] = __builtin_nontemporal_load((const f32x4*)(src + q * 256 + lane * 4)); }
            else { const f16* src = P.X() + (size_t)r * DM;
#pragma unroll
                for (int q = 0; q < 4; ++q) xv[u][q] = cvt4(*(const f16x4*)(src + q * 256 + lane * 4)); }
        }
        if (!FIRST) {
            const int sl = P.inv()[(size_t)(lane & 15) * MROWS + rb + (lane >> 4)];
            const float af = P.aff()[(size_t)(lane & 15) * MROWS + rb + (lane >> 4)];
            const unsigned long long bal = __builtin_amdgcn_ballot_w64(sl >= 0);
            unsigned m[R];
#pragma unroll
            for (int u = 0; u < R; ++u) m[u] = (unsigned)(bal >> (16 * u)) & 0xffffu;
            const f16* ys = P.yslot();
            const float* g2 = modp(P, l - 1, v, 5);
            f32x4 gv[4];
#pragma unroll
            for (int q = 0; q < 4; ++q) gv[q] = *(const f32x4*)(g2 + q * 256 + lane * 4);
            while (m[0] | m[1] | m[2] | m[3]) {
                f16x4 yv[R][4]; float w[R];
#pragma unroll
                for (int u = 0; u < R; ++u) {
                    const int e = m[u] ? __builtin_ctz(m[u]) : 0;
                    const int sv = m[u] ? __builtin_amdgcn_readlane(sl, 16 * u + e) : 0;
                    w[u] = m[u] ? __int_as_float(__builtin_amdgcn_readlane(__float_as_int(af), 16 * u + e)) : 0.f;
                    m[u] &= m[u] - 1u;
                    const f16* y = ys + ((size_t)e * SLOTS_PAD + sv) * DM + lane * 4;
#pragma unroll
                    for (int q = 0; q < 4; ++q) yv[u][q] = *(const f16x4*)(y + q * 256);
                }
#pragma unroll
                for (int u = 0; u < R; ++u)
#pragma unroll
                    for (int q = 0; q < 4; ++q) xv[u][q] += (w[u] * gv[q]) * cvt4(yv[u][q]);
            }
        }
        if (FINAL) {
#pragma unroll
            for (int u = 0; u < R; ++u)
#pragma unroll
                for (int q = 0; q < 4; ++q) __builtin_nontemporal_store(xv[u][q], (f32x4*)(P.out + (size_t)(rb + u) * DM + q * 256 + lane * 4));
            continue;
        }
        float ss[R];
#pragma unroll
        for (int u = 0; u < R; ++u) {
            f16* xd = P.Xw() + (size_t)(rb + u) * DM; float sacc = 0.f;
#pragma unroll
            for (int q = 0; q < 4; ++q) { *(f16x4*)(xd + q * 256 + lane * 4) = pk4(xv[u][q]); sacc += dot4(xv[u][q], xv[u][q]); }
            ss[u] = sacc;
        }
#pragma unroll
        for (int u = 0; u < R; ++u) ss[u] = rsqrtf(wave_sum(ss[u], lane) * (1.0f / DM) + 1e-6f);
        const float* g = P.norm1_g + l * DM; const float* sh = modp(P, l, v, 0); const float* scl = modp(P, l, v, 1);
#pragma unroll
        for (int q = 0; q < 4; ++q) {
            const int c0 = q * 256 + lane * 4;
            const f32x4 gq = *(const f32x4*)(g + c0), sq = *(const f32x4*)(sh + c0), cq = *(const f32x4*)(scl + c0);
            const f32x4 gm = gq * (1.0f + cq);
#pragma unroll
            for (int u = 0; u < R; ++u) *(f16x4*)(P.Hw() + (size_t)(rb + u) * DM + c0) = rm4(pk4(xv[u][q] * ss[u] * gm + sq));
        }
    }
}

#define N2_ZST 81920
template <bool POOL>
__device__ __forceinline__ void phase_n2(const Params& P, int l, int bid, int nb, float* lds, int nrows = MROWS) {
    const int tid = opaque_tid(), wid = P.wv, lane = tid & 63;
    const float* wr = P.router_w + (size_t)l * DM * NEXP;
    f16* wh = (f16*)lds;
    for (int i = tid; i < DM * NEXP; i += NTHR) { const int d = i >> 4, e = i & 15; wh[e * 1032 + d] = (f16)wr[i]; }
    f16* h2s = (f16*)lds + 16640;
    LAS unsigned char* zst = (LAS unsigned char*)lds + N2_ZST;
    const int j = l >> 1, nblk = nrows >> 4;
    const f16* Zg = P.Z();
    const f16* Xg = P.X();
    f16x4 xr[2][4]; f16x4 zr[2][4];
    auto prefetch = [&](int blk) {
        const int R0 = blk * 16, rb = R0 + wid * 2;
        if (POOL) {
            int s0, L; if (R0 < NLAT) { s0 = (R0 >> 14) << 14; L = SEQ; } else { s0 = NLAT + (((R0 - NLAT) >> 8) << 8); L = CTXL; }
#pragma unroll
            for (int i = 0; i < 8; ++i) { const int piece = wid * 8 + i; int rr = R0 - 8 + (piece >> 1); rr = rr < s0 ? s0 : (rr > s0 + L - 1 ? s0 + L - 1 : rr);
                __builtin_amdgcn_global_load_lds((const unsigned*)(Zg + (size_t)rr * DM + (piece & 1) * 512 + lane * 8), (LAS unsigned*)(zst + piece * 1024), 16, 0, 0); }
        } else {
#pragma unroll
            for (int u = 0; u < 2; ++u)
#pragma unroll
                for (int q = 0; q < 4; ++q) zr[u][q] = *(const f16x4*)(Zg + (size_t)(rb + u) * DM + q * 256 + lane * 4);
        }
#pragma unroll
        for (int u = 0; u < 2; ++u)
#pragma unroll
            for (int q = 0; q < 4; ++q) xr[u][q] = *(const f16x4*)(Xg + (size_t)(rb + u) * DM + q * 256 + lane * 4);
    };
    const bool xo = (nb == 256); int kround = 0;
    auto blk_of = [&](int k) { return xo ? ((k * 8 + (bid & 7)) * 32 + (bid >> 3)) : (bid + k * nb); };
    int blk = blk_of(0);
    f32x4 g1v[4], gmv[4], shv[4], psv[4]; int vprev = -1;
    if (blk < nblk) prefetch(blk);
    __syncthreads();
    while (blk < nblk) {
        const int R0 = blk * 16, rb = R0 + wid * 2;
        int v, s0, L;
        if (rb < NLAT) { v = rb >> 14; s0 = v << 14; L = SEQ; } else { v = 2; s0 = NLAT + (((rb - NLAT) >> 8) << 8); L = CTXL; }
        const int t = rb - s0;
        if (POOL) asm volatile("s_waitcnt vmcnt(16)" ::: "memory");
        if (v != vprev) { vprev = v;
          const float* g1 = modp(P, l, v, 2); const float* g = P.norm2_g + l * DM; const float* sh = modp(P, l, v, 3); const float* scl = modp(P, l, v, 4);
#pragma unroll
            for (int q = 0; q < 4; ++q) { const int c0 = q * 256 + lane * 4;
                g1v[q] = *(const f32x4*)(g1 + c0); const f32x4 gv = *(const f32x4*)(g + c0), cv = *(const f32x4*)(scl + c0); shv[q] = *(const f32x4*)(sh + c0); gmv[q] = gv * (1.0f + cv);
                if (POOL) psv[q] = *(const f32x4*)(P.pool_scale + j * DM + c0); } }
        f32x4 y[2][4];
        if (POOL) {
            asm volatile("s_waitcnt lgkmcnt(0)" ::: "memory"); __builtin_amdgcn_s_barrier(); asm volatile("" ::: "memory");
            if (t >= 8 && t + 9 < L) {
#pragma unroll
                for (int q = 0; q < 4; ++q) {
                    const int h = 1 << q;
                    const LAS f16* zb = (const LAS f16*)zst + q * 256 + lane * 4 + (2 * wid + 8) * DM;
#define ZROW(d) (*(const LAS f16x4*)(zb + (d) * DM))
                    const f32x4 z0 = cvt4(ZROW(-h)), z1 = cvt4(ZROW(h)), own0 = cvt4(ZROW(0)), own1 = (h == 1) ? z1 : cvt4(ZROW(1));
                    f32x4 common = (f32x4){0.f, 0.f, 0.f, 0.f};
#pragma unroll
                    for (int d = -h + 1; d + 1 <= h - 1; d += 2) { const f16x4 pr = ZROW(d) + ZROW(d + 1); common += cvt4(pr); }
                    common += cvt4(ZROW(h - 1));
#undef ZROW
                    const float inv = 0.5f / (float)h;
                    y[0][q] = ((common + z0) * inv - own0) * psv[q];
                    y[1][q] = ((common + z1) * inv - own1) * psv[q];
                }
            } else {
#pragma unroll
            for (int q = 0; q < 4; ++q) {
                const int h = 1 << q;
                const LAS f16* zb = (const LAS f16*)zst + q * 256 + lane * 4;
                f32x4 common = (f32x4){0.f, 0.f, 0.f, 0.f}, z0 = common, z1 = common;
#pragma unroll
                for (int d = -h; d <= h; ++d) {
                    const int tt = t + d; const bool ok = tt >= 0 && tt < L;
                    f32x4 zz = cvt4(*(const LAS f16x4*)(zb + (2 * wid + 8 + d) * DM));
                    if (!ok) zz = (f32x4){0.f, 0.f, 0.f, 0.f};
                    if (d == -h) z0 = zz; else if (d == h) z1 = zz; else common += zz;
                    if (d == 0) y[0][q] = zz;
                    if (d == 1) y[1][q] = zz;
                }
                const int c0n = min(t + h, L) - max(t - h, 0), c1n = min(t + 1 + h, L) - max(t + 1 - h, 0);
                y[0][q] = ((common + z0) * (1.0f / (float)c0n) - y[0][q]) * psv[q];
                y[1][q] = ((common + z1) * (1.0f / (float)c1n) - y[1][q]) * psv[q];
            }
            }
            asm volatile("s_waitcnt lgkmcnt(0)" ::: "memory"); __builtin_amdgcn_s_barrier(); asm volatile("" ::: "memory");
        } else {
#pragma unroll
            for (int u = 0; u < 2; ++u)
#pragma unroll
                for (int q = 0; q < 4; ++q) y[u][q] = cvt4(zr[u][q]);
        }
        f32x4 xv[2][4]; float ss[2] = {0.f, 0.f};
#pragma unroll
        for (int q = 0; q < 4; ++q) {
#pragma unroll
            for (int u = 0; u < 2; ++u) { xv[u][q] = cvt4(xr[u][q]) + g1v[q] * y[u][q]; ss[u] += dot4(xv[u][q], xv[u][q]); }
        }
        const int nxt = blk_of(++kround);
        asm volatile("" ::: "memory");
        if (nxt < nblk) prefetch(nxt);
#pragma unroll
        for (int u = 0; u < 2; ++u)
#pragma unroll
            for (int q = 0; q < 4; ++q) *(f16x4*)(P.Xw() + (size_t)(rb + u) * DM + q * 256 + lane * 4) = pk4(xv[u][q]);
        ss[0] = wave_sum(ss[0], lane); ss[1] = wave_sum(ss[1], lane);
        const float rs[2] = {rsqrtf(ss[0] * (1.0f / DM) + 1e-6f), rsqrtf(ss[1] * (1.0f / DM) + 1e-6f)};
        f16x4 h2h[2][4];
#pragma unroll
        for (int q = 0; q < 4; ++q) {
            const int c0 = q * 256 + lane * 4;
#pragma unroll
            for (int u = 0; u < 2; ++u) { h2h[u][q] = pk4(xv[u][q] * rs[u] * gmv[q] + shv[q]); *(f16x4*)(P.Hw() + (size_t)(rb + u) * DM + c0) = rm4(h2h[u][q]); }
        }
        asm volatile("s_waitcnt lgkmcnt(0)" ::: "memory"); __builtin_amdgcn_s_barrier(); asm volatile("" ::: "memory");
#pragma unroll
        for (int q = 0; q < 4; ++q)
#pragma unroll
            for (int u = 0; u < 2; ++u) *(f16x4*)(h2s + (2 * wid + u) * 1032 + q * 256 + lane * 4) = h2h[u][q];
        asm volatile("s_waitcnt lgkmcnt(0)" ::: "memory"); __builtin_amdgcn_s_barrier(); asm volatile("" ::: "memory");
        {
            const int r16 = lane & 15, kq = lane >> 4;
            f32x4 pl = (f32x4){0.f, 0.f, 0.f, 0.f};
#pragma unroll
            for (int ks = 0; ks < 4; ++ks) {
                const f16x8 av = *(const f16x8*)(h2s + r16 * 1032 + wid * 128 + ks * 32 + kq * 8), bv = *(const f16x8*)(wh + r16 * 1032 + wid * 128 + ks * 32 + kq * 8);
                pl = __builtin_amdgcn_mfma_f32_16x16x32_f16(av, bv, pl, 0, 0, 0);
            }
            *(f32x4*)(lds + 16640 + (wid * 64 + lane) * 4) = pl;
            asm volatile("s_waitcnt lgkmcnt(0)" ::: "memory"); __builtin_amdgcn_s_barrier(); asm volatile("" ::: "memory");
        }
        if (wid == 0) {
            const int r16 = lane & 15, kq = lane >> 4;
            f32x4 lg = (f32x4){0.f, 0.f, 0.f, 0.f};
#pragma unroll
            for (int w = 0; w < 8; ++w) lg += *(const f32x4*)(lds + 16640 + (w * 64 + lane) * 4);
#pragma unroll
            for (int jj = 0; jj < 4; ++jj) {
                float mx = lg[jj];
                mx = fmaxf(mx, shx<1>(mx, lane)); mx = fmaxf(mx, shx<2>(mx, lane)); mx = fmaxf(mx, shx<4>(mx, lane)); mx = fmaxf(mx, shx<8>(mx, lane));
                const float pe = __expf(lg[jj] - mx);
                float den = pe;
                den += shx<1>(den, lane); den += shx<2>(den, lane); den += shx<4>(den, lane); den += shx<8>(den, lane);
                P.affw()[(size_t)r16 * MROWS + R0 + 4 * kq + jj] = pe * __builtin_amdgcn_rcpf(den);
            }
        }
        blk = nxt;
    }
}

__device__ __forceinline__ void phase_topk(const Params& P, int bid, int nb, unsigned* lds, int nprob = 64) {
    unsigned* hist = lds; unsigned* misc = lds + 256; unsigned* wsa = lds + 272; unsigned* wsb = lds + 288;
    const int tid = opaque_tid(), wid = tid >> 6, lane = tid & 63;
    for (int p = bid; p < nprob; p += nb) {
        const int set = p >> 4, e = p & 15;
        const int n = set < 2 ? SEQ : CTXL, C = n >> 3;
        const int r0 = set < 2 ? set * SEQ : NLAT + (set - 2) * CTXL;
        const int slot0 = set < 2 ? set * 2048 : 4096 + (set - 2) * 32;
        unsigned key[32];
#pragma unroll
        for (int i4 = 0; i4 < 8; ++i4) { const int idx = tid * 32 + i4 * 4;
            f32x4 v = (f32x4){0.f, 0.f, 0.f, 0.f}; if (idx < n) v = *(const f32x4*)(P.aff() + (size_t)e * MROWS + r0 + idx);
#pragma unroll
            for (int jj = 0; jj < 4; ++jj) key[i4 * 4 + jj] = idx < n ? (__float_as_uint(v[jj]) + 1u) : 0u; }
        unsigned T = 0u;
        for (int bit = 29; bit >= 0; --bit) {
            const unsigned cand = T | (1u << bit);
            unsigned wc = 0u;
#pragma unroll
            for (int i = 0; i < 32; ++i) wc += (unsigned)__builtin_popcountll(__builtin_amdgcn_ballot_w64(key[i] >= cand));
            unsigned* cb = misc + ((bit & 1) << 3);
            if (lane == 0) cb[wid] = wc;
            __syncthreads();
            unsigned tot = 0u;
#pragma unroll
            for (int w = 0; w < 8; ++w) tot += cb[w];
            if (tot >= (unsigned)C) T = cand;
            if (tot == (unsigned)C) { T = cand - 1u; break; }
        }
        unsigned cg = 0u, ce = 0u;
#pragma unroll
        for (int i = 0; i < 32; ++i) { cg += key[i] > T ? 1u : 0u; ce += key[i] == T ? 1u : 0u; }
        unsigned ig = cg, ie = ce;
#pragma unroll
        for (int o = 1; o < 64; o <<= 1) { const unsigned a = shup(ig, o, lane), b = shup(ie, o, lane); if (lane >= o) { ig += a; ie += b; } }
        if (lane == 63) { wsa[wid] = ig; wsb[wid] = ie; }
        __syncthreads();
        unsigned bg = 0u, be = 0u, totg = 0u;
#pragma unroll
        for (int w = 0; w < 8; ++w) { const unsigned ga = wsa[w]; totg += ga; if (w < wid) { bg += ga; be += wsb[w]; } }
        const unsigned krem = (unsigned)C - totg;
        unsigned pg = bg + ig - cg, pe = be + ie - ce;
#pragma unroll
        for (int i4 = 0; i4 < 8; ++i4) {
            int iv[4];
#pragma unroll
            for (int jj = 0; jj < 4; ++jj) {
                const int i = i4 * 4 + jj, idx = tid * 32 + i;
                bool sel = false; unsigned rank = 0u;
                if (key[i] > T) { sel = true; rank = pg + (pe < krem ? pe : krem); ++pg; }
                else if (key[i] == T && key[i] != 0u) { if (pe < krem) { sel = true; rank = pg + pe; } ++pe; }
                if (sel) P.rowidx()[e * SLOTS_PAD + slot0 + (int)rank] = r0 + idx;
                iv[jj] = sel ? slot0 + (int)rank : -1;
            }
            if (tid * 32 + i4 * 4 < n) *(int4*)(P.inv() + (size_t)e * MROWS + r0 + tid * 32 + i4 * 4) = make_int4(iv[0], iv[1], iv[2], iv[3]);
        }
        if (set == 3) for (int i = SLOTS + tid; i < SLOTS_PAD; i += NTHR) P.rowidx()[e * SLOTS_PAD + i] = 0;
        __syncthreads();
    }
}

#define XB_TMO      128
#define XB_XCNT(j)  (256  + 64 * (j))
#define XB_XSUB(j)  (1280 + 64 * (j))
#define XB_XGEN(j)  (2304 + 64 * (j))
#define XB_TOP      3328
#define XB_TOPGEN   3392
#define XCD_BAR_WORDS 3456
#define XB_SPIN_CAP (1u << 18)
__device__ __forceinline__ unsigned xb_ld(unsigned* p)              { return __hip_atomic_load(p, __ATOMIC_RELAXED, __HIP_MEMORY_SCOPE_AGENT); }
__device__ __forceinline__ unsigned xb_add(unsigned* p, unsigned v) { return __hip_atomic_fetch_add(p, v, __ATOMIC_RELAXED, __HIP_MEMORY_SCOPE_AGENT); }
__device__ __forceinline__ unsigned xb_xcc_id() { return (unsigned)__builtin_amdgcn_s_getreg((3 << 11) | 20) & 0xFu; }
#define XB_SPIN(cond, bar) do { unsigned _sp = 0; while (cond) { __builtin_amdgcn_s_sleep(1); \
    if ((++_sp & 255u) == 0u) { if (xb_ld(&(bar)[XB_TMO])) break; if (_sp > XB_SPIN_CAP) { atomicAdd(&(bar)[XB_TMO], 1u); break; } } } } while (0)
struct XcdBarrier { unsigned* bar; unsigned x; volatile LAS unsigned* st; };
__device__ __forceinline__ XcdBarrier xcd_barrier_post(unsigned* bar, volatile LAS unsigned* st) {
    XcdBarrier b; b.bar = bar; b.x = xb_xcc_id(); b.st = st;
    if (threadIdx.x == 0) (void)xb_add(&bar[XB_XCNT(b.x)], 1u);
    return b;
}
__device__ __forceinline__ void xcd_barrier_complete(unsigned* bar, unsigned x, unsigned& nloc, unsigned& nx) {
    const unsigned G = gridDim.x * gridDim.y * gridDim.z;
    unsigned sum, cnt, mine, sp = 0u;
    for (;;) {
        sum = 0u; cnt = 0u; mine = 0u;
#pragma unroll
        for (unsigned j = 0; j < 16; ++j) { const unsigned c = xb_ld(&bar[XB_XCNT(j)]); sum += c; cnt += (c > 0u) ? 1u : 0u; mine = (j == x) ? c : mine; }
        if (sum == G) break;
        __builtin_amdgcn_s_sleep(1);
        if ((++sp & 255u) == 0u) { if (xb_ld(&bar[XB_TMO])) break; if (sp > XB_SPIN_CAP) { atomicAdd(&bar[XB_TMO], 1u); break; } }
    }
    nloc = mine > 0u ? mine : 1u; nx = cnt > 0u ? cnt : 1u;
}
__device__ __forceinline__ void xcd_barrier(const XcdBarrier& b) {
    asm volatile("s_waitcnt vmcnt(0)" ::: "memory");
    __syncthreads();
    if (threadIdx.x == 0) {
        unsigned* bar = b.bar; asm volatile("" : "+s"(bar));
        const unsigned bx = (unsigned)__builtin_amdgcn_readfirstlane((int)xb_xcc_id());
        __builtin_amdgcn_s_waitcnt(0);
        unsigned nloc = b.st[0], nx = b.st[1];
        if (nloc == 0u) { xcd_barrier_complete(bar, bx, nloc, nx); b.st[0] = nloc; b.st[1] = nx; }
        const unsigned old = xb_add(&bar[XB_XSUB(bx)], 1u);
        const unsigned gen = old / nloc;
        if (old + 1u == (gen + 1u) * nloc) {
            __builtin_amdgcn_fence(__ATOMIC_RELEASE, "agent");
            asm volatile("s_waitcnt vmcnt(0)" ::: "memory");
            const unsigned og = xb_add(&bar[XB_TOP], 1u);
            const unsigned tg = og / nx;
            if (og + 1u == (tg + 1u) * nx) xb_add(&bar[XB_TOPGEN], 1u);
            else XB_SPIN(xb_ld(&bar[XB_TOPGEN]) == tg, bar);
            __builtin_amdgcn_fence(__ATOMIC_ACQUIRE, "agent");
            xb_add(&bar[XB_XGEN(bx)], 1u);
            asm volatile("s_waitcnt vmcnt(0)" ::: "memory");
        } else {
            XB_SPIN(xb_ld(&bar[XB_XGEN(bx)]) == gen, bar);
            __builtin_amdgcn_fence(__ATOMIC_ACQUIRE, "agent");
            asm volatile("s_waitcnt vmcnt(0)" ::: "memory");
        }
    }
    __syncthreads();
}

namespace fg {
constexpr int BM = 256, BK = 64, HALF = 128, HTB = HALF * BK * 2, STAGE_BYTES = 8 * HTB;
__device__ __forceinline__ int lds_byte(int r, int c) { const int st = (r >> 4) * 2 + (c >> 5), rr = r & 15, cc = c & 31, ob = rr * 64 + cc * 2; return st * 1024 + (ob ^ (((ob >> 9) & 1) << 5)); }
__device__ __forceinline__ void stage_rc(int b, int& R, int& C) { const int st = b / 1024, sb = b % 1024, swz = sb ^ (((sb >> 9) & 1) << 5); R = (st >> 1) * 16 + swz / 64; C = (st & 1) * 32 + (swz % 64) / 2; }
__device__ __forceinline__ int perm32(int rho) { const int n = rho >> 4, i = rho & 15; return 8 * (i >> 2) + 4 * n + (i & 3); }
#define KDUP 0
struct Unit { int e, pm, pn; int skip; };
__device__ __forceinline__ void xcd_order(int i, int& T) { const int c = blockIdx.x; T = i * (int)gridDim.x + c; }

template <class PR>
__device__ __forceinline__ void gemm_phase(LAS unsigned char* lds, const PR& S, int wv) {
    const int tid = opaque_tid_(wv), wid = __builtin_amdgcn_readfirstlane(tid >> 6), lane = tid & 63, wr = wid >> 2, wc = wid & 3, fr = lane & 15, fq = lane >> 4;
    constexpr int K = PR::K, nt = K / BK;
    unsigned voffB[2];
#pragma unroll
    for (int i = 0; i < 2; ++i) { int R, C; stage_rc(tid * 16 + i * 8192, R, C); const int Rb = (R & ~31) + perm32(R & 31); voffB[i] = (unsigned)(Rb * PR::LDB + C) * 2u; }
    const size_t kstep = (size_t)(BK * 2);
    const size_t hB = S.hstepB();
    const unsigned ldsw = (unsigned)wid * 1024u;
    const int aoff = lds_byte(wr * 64 + fr, fq * 8), boff = lds_byte(wc * 32 + fr, fq * 8);
#define FG_SA(b, h) (((b) * 2 + (h)) * HTB)
#define FG_SB(b, h) ((4 + (b) * 2 + (h)) * HTB)
#define FG_STAGE(bufoff, gbase, voff) do { _Pragma("unroll") for (int _i = 0; _i < 2; ++_i) \
        __builtin_amdgcn_global_load_lds((const unsigned*)((const char*)(gbase) + (voff)[_i]), (LAS unsigned*)(lds + (bufoff) + ldsw + _i * 8192), 16, 0, 0); } while (0)
#define FG_LDA(dst, b, h) do { _Pragma("unroll") for (int m = 0; m < 4; ++m) _Pragma("unroll") for (int k = 0; k < 2; ++k) dst[m][k] = *(const LAS f16x8*)(lds + FG_SA(b, h) + aoff + m * 2048 + k * 1024); } while (0)
#define FG_LDB(dst, b, h) do { _Pragma("unroll") for (int n = 0; n < 2; ++n) _Pragma("unroll") for (int k = 0; k < 2; ++k) dst[n][k] = *(const LAS f16x8*)(lds + FG_SB(b, h) + boff + n * 2048 + k * 1024); } while (0)
#define FG_MMA(ai, bj, At, Bt) do { __builtin_amdgcn_s_setprio(1); _Pragma("unroll") for (int m = 0; m < 4; ++m) _Pragma("unroll") for (int n = 0; n < 2; ++n) _Pragma("unroll") for (int k = 0; k < 2; ++k) \
        acc[ai][bj][m][n] = __builtin_amdgcn_mfma_f32_16x16x32_f16(Bt[n][k], At[m][k], acc[ai][bj][m][n], 0, 0, 0); __builtin_amdgcn_s_setprio(0); } while (0)
#define FG_WAIT_V(n) asm volatile("s_waitcnt vmcnt(" #n ")" ::: "memory")
#define FG_WAIT_L(n) asm volatile("s_waitcnt lgkmcnt(" #n ")" ::: "memory")
#define FG_BAR __builtin_amdgcn_s_barrier()
#define FG_SCHED __builtin_amdgcn_sched_barrier(0)
    Unit cur, nxt; int ui = 0;
    if (!S.next(0, cur)) return;
    f32x4 acc[2][2][4][2];
#pragma unroll
    for (int a = 0; a < 2; ++a)
#pragma unroll
        for (int b = 0; b < 2; ++b)
#pragma unroll
            for (int m = 0; m < 4; ++m)
#pragma unroll
                for (int n = 0; n < 2; ++n) acc[a][b][m][n] = (f32x4){0.f, 0.f, 0.f, 0.f};
    f16x8 At[4][2], B0[2][2], B1[2][2];
    unsigned vA[2][2], vN[2][2];
    { int Rr[2], Cc[2]; stage_rc(tid * 16, Rr[0], Cc[0]); stage_rc(tid * 16 + 8192, Rr[1], Cc[1]); S.a_voff(cur, Rr, Cc, vA); }
#pragma unroll
    for (int h = 0; h < 2; ++h)
#pragma unroll
        for (int i = 0; i < 2; ++i) { asm volatile("" : "+v"(vA[h][i])); vN[h][i] = vA[h][i]; }
    const char* cA = S.a_base(cur); const char* cB = S.b_base(cur);
    FG_STAGE(FG_SB(0, 0), cB, voffB); FG_STAGE(FG_SA(0, 0), cA, vA[0]); FG_STAGE(FG_SB(0, 1), cB + hB, voffB); FG_STAGE(FG_SA(0, 1), cA, vA[1]);
    if (wr == 1) FG_BAR;
    FG_WAIT_V(4); FG_BAR;
    FG_STAGE(FG_SB(1, 0), cB + kstep, voffB); FG_STAGE(FG_SA(1, 0), cA + kstep, vA[0]); FG_STAGE(FG_SB(1, 1), cB + hB + kstep, voffB);
    FG_WAIT_V(6); FG_BAR;
    for (;;) {
        const bool has_next = S.next(ui + 1, nxt);
        const char* nA = has_next ? S.a_base(nxt) : cA; const char* nB = has_next ? S.b_base(nxt) : cB;
        if (has_next) { int Rr[2], Cc[2]; int t2 = tid; asm volatile("" : "+v"(t2)); stage_rc(t2 * 16, Rr[0], Cc[0]); stage_rc(t2 * 16 + 8192, Rr[1], Cc[1]); S.a_voff(nxt, Rr, Cc, vN);
#pragma unroll
            for (int h = 0; h < 2; ++h)
#pragma unroll
                for (int i = 0; i < 2; ++i) asm volatile("" : "+v"(vN[h][i])); }
#pragma unroll 1
        for (int t = 0; t < nt; t += 2) {
            const bool last = (t == nt - 2);
            const char* a1 = cA + (size_t)(t + 1) * kstep;
            const char* a2 = last ? nA : cA + (size_t)(t + 2) * kstep; const char* b2 = last ? nB : cB + (size_t)(t + 2) * kstep;
            const char* a3 = a2 + kstep; const char* b3 = b2 + kstep;
            unsigned v2[2][2];
#pragma unroll
            for (int h = 0; h < 2; ++h)
#pragma unroll
                for (int i = 0; i < 2; ++i) v2[h][i] = last ? vN[h][i] : vA[h][i];
            FG_LDB(B0, 0, 0); FG_SCHED; FG_LDA(At, 0, 0); FG_STAGE(FG_SA(1, 1), a1, vA[1]);
            FG_WAIT_L(8); FG_BAR; FG_WAIT_L(0); FG_MMA(0, 0, At, B0); FG_BAR; FG_SCHED;
            FG_LDB(B1, 0, 1); FG_STAGE(FG_SB(0, 0), b2, voffB);
            FG_BAR; FG_WAIT_L(0); FG_MMA(0, 1, At, B1); FG_BAR;
            FG_LDA(At, 0, 1); FG_STAGE(FG_SA(0, 0), a2, v2[0]);
            FG_BAR; FG_WAIT_L(0); FG_MMA(1, 0, At, B0); FG_BAR; FG_SCHED;
            FG_STAGE(FG_SB(0, 1), b2 + hB, voffB);
            FG_WAIT_V(6); FG_BAR; FG_MMA(1, 1, At, B1); FG_BAR;
            FG_LDB(B0, 1, 0); FG_SCHED; FG_LDA(At, 1, 0); FG_STAGE(FG_SA(0, 1), a2, v2[1]);
            FG_WAIT_L(8); FG_BAR; FG_WAIT_L(0); FG_MMA(0, 0, At, B0); FG_BAR; FG_SCHED;
            FG_LDB(B1, 1, 1); FG_STAGE(FG_SB(1, 0), b3, voffB);
            FG_BAR; FG_WAIT_L(0); FG_MMA(0, 1, At, B1); FG_BAR;
            FG_LDA(At, 1, 1); FG_STAGE(FG_SA(1, 0), a3, v2[0]);
            FG_BAR; FG_WAIT_L(0); FG_MMA(1, 0, At, B0); FG_BAR; FG_SCHED;
            FG_STAGE(FG_SB(1, 1), b3 + hB, voffB);
            FG_WAIT_V(6); FG_BAR; FG_MMA(1, 1, At, B1); FG_BAR;
        }
        if (!KDUP || !cur.skip) S.epi(acc, cur, wr, wc, fr, fq);
        if (!has_next) break;
#pragma unroll
        for (int a = 0; a < 2; ++a)
#pragma unroll
            for (int b = 0; b < 2; ++b)
#pragma unroll
                for (int m = 0; m < 4; ++m)
#pragma unroll
                    for (int n = 0; n < 2; ++n) acc[a][b][m][n] = (f32x4){0.f, 0.f, 0.f, 0.f};
        cur = nxt; cA = nA; cB = nB; ++ui;
#pragma unroll
        for (int h = 0; h < 2; ++h)
#pragma unroll
            for (int i = 0; i < 2; ++i) vA[h][i] = vN[h][i];
    }
    FG_WAIT_V(0);
    if (wr == 0) FG_BAR;
    FG_BAR;
#undef FG_SA
#undef FG_SB
#undef FG_STAGE
#undef FG_LDA
#undef FG_LDB
#undef FG_MMA
#undef FG_WAIT_V
#undef FG_WAIT_L
#undef FG_BAR
#undef FG_SCHED
}

__device__ __forceinline__ f16x8 pack8(const f32x4 a, const f32x4 b) { return (f16x8){(f16)a[0], (f16)a[1], (f16)a[2], (f16)a[3], (f16)b[0], (f16)b[1], (f16)b[2], (f16)b[3]}; }

template <int K_, int LDA_, int LDB_> struct PRBase {
    static constexpr int K = K_, LDA = LDA_, LDB = LDB_;
    __device__ __forceinline__ void plain_voff(const int (&R)[2], const int (&C)[2], unsigned (&v)[2][2]) const {
#pragma unroll
        for (int h = 0; h < 2; ++h)
#pragma unroll
            for (int i = 0; i < 2; ++i) v[h][i] = (unsigned)((h * HALF + R[i]) * LDA + C[i]) * 2u;
    }
};
template <bool RIL> struct PRGateUpT : PRBase<1024, 1024, 1024> {
    const f16* H; const int* rowidx; const f16* W; f16* act; int nunits; int bid; int rt;
    const LAS int* ril;
    __device__ __forceinline__ size_t hstepB() const { return (size_t)DEXP * DM * 2; }
    __device__ __forceinline__ bool next(int i, Unit& u) const { const int ii = KDUP ? (i >> 1) : i; const int T = ii * (int)gridDim.x + bid; u.skip = KDUP ? ((i & 1) == 0) : 0; if (T >= nunits) return false;
        if (rt == 16 && gridDim.x == 256) { const int x = bid & 7, jj = bid >> 3; u.e = ii; u.pm = (x >> 1) * 4 + (jj >> 3); u.pn = (x & 1) * 8 + (jj & 7); return true; }
        const int per = rt * 16; u.e = T / per; const int t = T % per; u.pm = t >> 4; u.pn = t & 15; return true; }
    __device__ __forceinline__ const char* a_base(const Unit&) const { return (const char*)H; }
    __device__ __forceinline__ void a_voff(const Unit& u, const int (&R)[2], const int (&C)[2], unsigned (&v)[2][2]) const {
        if (RIL) {
            const LAS int* rl = ril + u.e * BM;
#pragma unroll
            for (int h = 0; h < 2; ++h)
#pragma unroll
                for (int i = 0; i < 2; ++i) { const int g = rl[h * HALF + R[i]]; v[h][i] = (unsigned)(g * 1024 + C[i]) * 2u; }
            return;
        }
        const int* ri = rowidx + u.e * SLOTS_PAD + u.pm * BM;
#pragma unroll
        for (int h = 0; h < 2; ++h)
#pragma unroll
            for (int i = 0; i < 2; ++i) { const int g = ri[h * HALF + R[i]]; v[h][i] = (unsigned)(g * 1024 + C[i]) * 2u; }
    }
    __device__ __forceinline__ const char* b_base(const Unit& u) const { return (const char*)(W + ((size_t)u.e * 2 * DEXP + (size_t)u.pn * HALF) * DM); }
    __device__ __forceinline__ void epi(const f32x4 (&acc)[2][2][4][2], const Unit& u, int wr, int wc, int fr, int fq) const {
        f16* base = act + ((size_t)u.e * SLOTS_PAD + (size_t)u.pm * BM + wr * 64 + fr) * DEXP + u.pn * HALF + wc * 32 + fq * 8;
#pragma unroll
        for (int ai = 0; ai < 2; ++ai)
#pragma unroll
            for (int m = 0; m < 4; ++m) {
                f32x4 o0, o1;
#pragma unroll
                for (int j = 0; j < 4; ++j) { o0[j] = silu_f(acc[ai][0][m][0][j]) * acc[ai][1][m][0][j]; o1[j] = silu_f(acc[ai][0][m][1][j]) * acc[ai][1][m][1][j]; }
                if (u.e < 11) __builtin_nontemporal_store(rm8(pack8(o0, o1)), (f16x8*)(base + (size_t)(ai * HALF + m * 16) * DEXP));
                else *(f16x8*)(base + (size_t)(ai * HALF + m * 16) * DEXP) = rm8(pack8(o0, o1));
            }
    }
};
struct PRDown : PRBase<2048, 2048, 2048> {
    const f16* act; const f16* W; f16* y; int nunits; int bid; int rt;
    __device__ __forceinline__ size_t hstepB() const { return (size_t)HALF * DEXP * 2; }
    __device__ __forceinline__ bool next(int i, Unit& u) const { const int ii = KDUP ? (i >> 1) : i; const int T = ii * (int)gridDim.x + bid; u.skip = KDUP ? ((i & 1) == 0) : 0; if (T >= nunits) return false;
        if (rt == 16 && gridDim.x == 256) { const int x = bid & 7, jj = bid >> 3; u.e = 15 - (ii * 4 + (x >> 1)); u.pm = (x & 1) * 8 + (jj >> 2); u.pn = jj & 3; return true; }
        const int per = rt * 4; u.e = T / per; const int t = T % per; u.pm = t >> 2; u.pn = t & 3; return true; }
    __device__ __forceinline__ const char* a_base(const Unit& u) const { return (const char*)(act + ((size_t)u.e * SLOTS_PAD + (size_t)u.pm * BM) * DEXP); }
    __device__ __forceinline__ void a_voff(const Unit&, const int (&R)[2], const int (&C)[2], unsigned (&v)[2][2]) const { plain_voff(R, C, v); }
    __device__ __forceinline__ const char* b_base(const Unit& u) const { return (const char*)(W + ((size_t)u.e * DM + (size_t)u.pn * BM) * DEXP); }
    __device__ __forceinline__ void epi(const f32x4 (&acc)[2][2][4][2], const Unit& u, int wr, int wc, int fr, int fq) const {
        f16* base = y + ((size_t)u.e * SLOTS_PAD + (size_t)u.pm * BM + wr * 64 + fr) * DM + u.pn * BM + wc * 32 + fq * 8;
#pragma unroll
        for (int ai = 0; ai < 2; ++ai)
#pragma unroll
            for (int m = 0; m < 4; ++m)
#pragma unroll
                for (int bj = 0; bj < 2; ++bj) *(f16x8*)(base + (size_t)(ai * HALF + m * 16) * DM + bj * HALF) = pack8(acc[ai][bj][m][0], acc[ai][bj][m][1]);
    }
};
template <int K_> struct PRDense : PRBase<K_, 1024, K_> {
    const f16* A; const f16* W; f16* O0; f16* O1; f16* O2; int ncol; int mode; int bid; int npan; int kvx;
    __device__ __forceinline__ size_t hstepB() const { return (size_t)HALF * K_ * 2; }
    __device__ __forceinline__ bool next(int i, Unit& u) const { const int ii = KDUP ? (i >> 1) : i; int T = ii * (int)gridDim.x + bid; if (gridDim.x == 256) T = (ii * 8 + (bid & 7)) * 32 + (bid >> 3);
        u.skip = KDUP ? ((i & 1) == 0) : 0; const int nu = npan * ncol; if (T >= nu + kvx) return false; u.e = 0; if (T < nu) { u.pm = T / ncol; u.pn = T % ncol; } else { const int x = T - nu; u.pm = npan + (x >> 1); u.pn = 4 + (x & 1); } return true; }
    __device__ __forceinline__ const char* a_base(const Unit& u) const { return (const char*)(A + (size_t)u.pm * BM * 1024 + (mode == 2 ? u.pn * 256 : 0)); }
    __device__ __forceinline__ void a_voff(const Unit&, const int (&R)[2], const int (&C)[2], unsigned (&v)[2][2]) const { this->plain_voff(R, C, v); }
    __device__ __forceinline__ const char* b_base(const Unit& u) const { return (const char*)(W + (size_t)u.pn * BM * K_); }
    const float* qn; const float* kn; const float* rope; LAS float* xs; int lane;
    __device__ __forceinline__ void epi(const f32x4 (&acc)[2][2][4][2], const Unit& u, int wr, int wc, int fr, int fq) const {
        f16* base; int ld;
        const int row = u.pm * BM + wr * 64 + fr, colw = wc * 32 + fq * 8;
        if (mode == 1) { if (u.pn < 4) { base = O0 + (size_t)row * 1024 + u.pn * BM + colw; ld = 1024; } else if (u.pn == 4) { base = O1 + (size_t)row * 256 + colw; ld = 256; } else { base = O2 + (size_t)row * 256 + colw; ld = 256; } }
        else { base = O0 + (size_t)row * 1024 + u.pn * BM + colw; ld = 1024; }
        if (mode == 1 && u.pn < 5) {
            float ssq[2][4][2];
#pragma unroll
            for (int ai = 0; ai < 2; ++ai)
#pragma unroll
                for (int m = 0; m < 4; ++m)
#pragma unroll
                    for (int bj = 0; bj < 2; ++bj) { const f32x4 a = acc[ai][bj][m][0], b = acc[ai][bj][m][1];
                        float t = (a[0] * a[0] + a[1] * a[1]) + (a[2] * a[2] + a[3] * a[3]) + (b[0] * b[0] + b[1] * b[1]) + (b[2] * b[2] + b[3] * b[3]);
                        t += shx<16>(t, lane); t += shx<32>(t, lane); ssq[ai][m][bj] = t; }
            LAS float* mine = xs + ((wr * 4 + wc) * 16) * 16 + fr; const LAS float* theirs = xs + ((wr * 4 + (wc ^ 1)) * 16) * 16 + fr;
            if (fq == 0) {
#pragma unroll
                for (int ai = 0; ai < 2; ++ai)
#pragma unroll
                    for (int m = 0; m < 4; ++m)
#pragma unroll
                        for (int bj = 0; bj < 2; ++bj) mine[(ai * 8 + m * 2 + bj) * 16] = ssq[ai][m][bj];
            }
            asm volatile("s_waitcnt lgkmcnt(0)" ::: "memory"); __builtin_amdgcn_s_barrier(); asm volatile("" ::: "memory");
            const bool isq = u.pn < 4, lat = u.pm < 128;
            const float* nw = (isq ? qn : kn) + (wc & 1) * 32 + fq * 8;
            const f32x4 w0 = *(const f32x4*)nw, w1 = *(const f32x4*)(nw + 4);
            const float qs = isq ? 0.125f * 1.4426950408889634f : 1.0f;
#pragma unroll
            for (int ai = 0; ai < 2; ++ai)
#pragma unroll
                for (int m = 0; m < 4; ++m) {
                    f32x4 c0 = (f32x4){1.f, 1.f, 1.f, 1.f}, s0 = (f32x4){0.f, 0.f, 0.f, 0.f};
                    if (lat) { const int t = (row + ai * HALF + m * 16) & (SEQ - 1); const int pos = (wc & 1) ? (t & 63) : (t >> 6);
                        const float* tb = rope + (size_t)(pos * 16 + fq * 4) * 2; const f32x4 ta = *(const f32x4*)tb, tb2 = *(const f32x4*)(tb + 4);
                        c0 = (f32x4){ta[0], ta[2], tb2[0], tb2[2]}; s0 = (f32x4){ta[1], ta[3], tb2[1], tb2[3]}; }
#pragma unroll
                    for (int bj = 0; bj < 2; ++bj) {
                        const float tot = ssq[ai][m][bj] + theirs[(ai * 8 + m * 2 + bj) * 16];
                        const float rstd = rsqrtf(tot * (1.0f / 64.0f) + 1e-6f) * qs;
                        f32x4 a = acc[ai][bj][m][0] * rstd * w0, b = acc[ai][bj][m][1] * rstd * w1;
                        const f32x4 ra = (f32x4){a[0] * c0[0] - a[1] * s0[0], a[0] * s0[0] + a[1] * c0[0], a[2] * c0[1] - a[3] * s0[1], a[2] * s0[1] + a[3] * c0[1]};
                        const f32x4 rb = (f32x4){b[0] * c0[2] - b[1] * s0[2], b[0] * s0[2] + b[1] * c0[2], b[2] * c0[3] - b[3] * s0[3], b[2] * s0[3] + b[3] * c0[3]};
                        *(f16x8*)(base + (size_t)(ai * HALF + m * 16) * ld + bj * HALF) = rm8(pack8(ra, rb));
                    }
                }
            return;
        }
#pragma unroll
        for (int ai = 0; ai < 2; ++ai)
#pragma unroll
            for (int m = 0; m < 4; ++m)
#pragma unroll
                for (int bj = 0; bj < 2; ++bj) { const f16x8 o = pack8(acc[ai][bj][m][0], acc[ai][bj][m][1]); *(f16x8*)(base + (size_t)(ai * HALF + m * 16) * ld + bj * HALF) = (mode == 1) ? rm8(o) : o; }
    }
};
}

struct CvtJob { const float* src; f16* dst; int K, N, k0, n0; };
__device__ __forceinline__ bool cvt_job(const Params& P, int l, int u, CvtJob& jb, bool experts) {
    const int j = l >> 1;
    const int nexp = experts ? NEXP * 3 * 128 : 0;
    const int nmix = (l & 1) == 0 ? 16 : (96 + 64);
    if (u >= nexp + nmix) return false;
    if (u < nexp) {
        const int e = u / 384, r = u % 384, which = r >> 7, t = r & 127;
        if (which < 2) { jb.src = (which == 0 ? P.w_gate : P.w_up) + ((size_t)l * NEXP + e) * DM * DEXP; jb.dst = P.Wgu() + ((size_t)e * 2 + which) * DEXP * DM; jb.K = DM; jb.N = DEXP; jb.k0 = (t >> 4) * 128; jb.n0 = (t & 15) * 128; }
        else { jb.src = P.w_down + ((size_t)l * NEXP + e) * DEXP * DM; jb.dst = P.Wd() + (size_t)e * DM * DEXP; jb.K = DEXP; jb.N = DM; jb.k0 = (t >> 3) * 128; jb.n0 = (t & 7) * 128; }
    } else {
        const int t = u - nexp;
        if ((l & 1) == 0) { const int g = t >> 2, tt = t & 3; jb.src = P.pool_w + (size_t)(j * 4 + g) * 65536; jb.dst = P.Wmix() + (size_t)g * 65536; jb.K = 256; jb.N = 256; jb.k0 = (tt >> 1) * 128; jb.n0 = (tt & 1) * 128; }
        else if (t < 96) { jb.src = P.w_qkv + (size_t)j * DM * QKVD; jb.dst = P.Wmix(); jb.K = DM; jb.N = QKVD; jb.k0 = (t / 12) * 128; jb.n0 = (t % 12) * 128; }
        else { const int tt = t - 96; jb.src = P.w_o + (size_t)j * DM * DM; jb.dst = P.Wmix() + (size_t)QKVD * DM; jb.K = DM; jb.N = DM; jb.k0 = (tt >> 3) * 128; jb.n0 = (tt & 7) * 128; }
    }
    return true;
}
__device__ __forceinline__ void phase_convert(const Params& P, int l, int bid, int nb, f16* tile, bool experts = true) {
    const int tid = opaque_tid();
    CvtJob jb;
    int u = bid;
    bool have = cvt_job(P, l, u, jb, experts);
    f32x4 r[8];
    if (have) {
#pragma unroll
        for (int p = 0; p < 8; ++p) { const int id = tid + p * NTHR, kr = id >> 5, c4 = (id & 31) * 4; r[p] = __builtin_nontemporal_load((const f32x4*)(jb.src + (size_t)(jb.k0 + kr) * jb.N + jb.n0 + c4)); }
    }
    while (have) {
        __syncthreads();
#pragma unroll
        for (int p = 0; p < 8; ++p) { const int id = tid + p * NTHR, kr = id >> 5, c4 = (id & 31) * 4; *(f16x4*)(tile + kr * 136 + c4) = pk4(r[p]); }
        __syncthreads();
        const CvtJob cur = jb;
        u += nb; have = cvt_job(P, l, u, jb, experts);
        if (have) {
#pragma unroll
            for (int p = 0; p < 8; ++p) { const int id = tid + p * NTHR, kr = id >> 5, c4 = (id & 31) * 4; r[p] = __builtin_nontemporal_load((const f32x4*)(jb.src + (size_t)(jb.k0 + kr) * jb.N + jb.n0 + c4)); }
        }
        const int n = tid & 127, kg = (tid >> 7) * 32;
        f16* dp = cur.dst + (size_t)(cur.n0 + n) * cur.K + cur.k0 + kg;
#pragma unroll
        for (int i = 0; i < 4; ++i) { f16x8 o;
#pragma unroll
            for (int e = 0; e < 8; ++e) o[e] = tile[(kg + i * 8 + e) * 136 + n];
            *(f16x8*)(dp + i * 8) = rmw8(o); }
    }
}
template <bool GATEUP, bool CTX>
__device__ __forceinline__ void phase_cvt_ctx(const Params& P, int l, int bid, int nb, f16* tile, int sel = -1, bool alt = false) {
    const int tid = opaque_tid(), wid = P.wv, lane = tid & 63, r16 = lane & 15, kq = lane >> 4;
    constexpr int NC = GATEUP ? 128 : 64;
    constexpr int KT = GATEUP ? 8 : 16, K = GATEUP ? DM : DEXP, N = GATEUP ? DEXP : DM, NB = N / NC;
    constexpr int NT = GATEUP ? 2 * KT : KT;
    const int sel_ = (GATEUP && !CTX) ? sel : -1; const int ntr = (GATEUP && sel_ < 0) ? NT : KT;
    constexpr int TS = NC + 4, TW = 128 * TS;
    constexpr int NLD = NC / 16;
    constexpr int WPC = 8 / (NC / 16);
    constexpr int NRB = 4 / WPC;
    const int cb = wid % (NC / 16), rb0 = (wid / (NC / 16)) * NRB;
    f16* asl = tile + 2 * TW;
    for (int job = bid; job < NEXP * NB; job += nb) {
        const int e = job / NB, nbk = job % NB;
        const f16* ap[2];
        if (CTX) {
#pragma unroll
            for (int p = 0; p < 2; ++p) { const int row = (tid >> 4) + p * 32;
                if (GATEUP) ap[p] = P.H() + (size_t)P.rowidx()[e * SLOTS_PAD + 4096 + row] * DM + (tid & 15) * 8;
                else ap[p] = P.act() + ((size_t)e * SLOTS_PAD + 4096 + row) * DEXP + (tid & 15) * 8; }
        }
        f32x4 acc[2][NRB];
#pragma unroll
        for (int w = 0; w < 2; ++w)
#pragma unroll
            for (int rb = 0; rb < NRB; ++rb) acc[w][rb] = (f32x4){0.f, 0.f, 0.f, 0.f};
        const float* srcs[2]; f16* dsts[2];
        if (GATEUP) { const size_t wo = ((size_t)l * NEXP + e) * DM * DEXP; srcs[0] = P.w_gate + wo; srcs[1] = P.w_up + wo; dsts[0] = P.Wgu() + (alt ? (OFF_WGU3 - OFF_WGU) / 2 : 0) + ((size_t)e * 2) * DEXP * DM; dsts[1] = dsts[0] + (size_t)DEXP * DM; }
        else { srcs[0] = P.w_down + ((size_t)l * NEXP + e) * DEXP * DM; srcs[1] = srcs[0]; dsts[0] = P.Wd() + (alt ? (OFF_WD3 - OFF_WD) / 2 : 0) + (size_t)e * DM * DEXP; dsts[1] = dsts[0]; }
        f32x4 r[2][NLD]; f16x8 ar[2][2];
        const unsigned ldoff = (unsigned)(((tid / (NC / 4)) * N + (tid % (NC / 4)) * 4) * 4);
#define CV_LOAD(ti, slot) do { const int which_ = GATEUP ? (sel_ >= 0 ? sel_ : ((ti) & 1)) : 0, kt_ = (GATEUP && sel_ < 0) ? ((ti) >> 1) : (ti); const char* sp_ = (const char*)(srcs[which_] + (size_t)(kt_ * 128) * N + nbk * NC); \
            _Pragma("unroll") for (int p = 0; p < NLD; ++p) r[slot][p] = __builtin_nontemporal_load((const f32x4*)(sp_ + (size_t)p * (NTHR / (NC / 4)) * N * 4 + ldoff)); \
            if (CTX) { _Pragma("unroll") for (int p = 0; p < 2; ++p) ar[slot][p] = *(const f16x8*)(ap[p] + kt_ * 128); } } while (0)
#define CV_TILE(ti, slot) do { const int which = GATEUP ? (sel_ >= 0 ? sel_ : ((ti) & 1)) : 0, kt = (GATEUP && sel_ < 0) ? ((ti) >> 1) : (ti); \
            f16* tl = tile + (slot) * TW; f16* al = asl + (slot) * (64 * 128); \
            _Pragma("unroll") for (int p = 0; p < NLD; ++p) { const int id = tid + p * NTHR, kr = id / (NC / 4), c4 = (id % (NC / 4)) * 4; *(f16x4*)(tl + kr * TS + c4) = pk4(r[slot][p]); } \
            if (CTX) { _Pragma("unroll") for (int p = 0; p < 2; ++p) { const int row = (tid >> 4) + p * 32; *(f16x8*)(al + row * 128 + (((tid & 15) ^ (row & 15)) * 8)) = ar[slot][p]; } } \
            if ((ti) + 2 < ntr) CV_LOAD((ti) + 2, slot); \
            asm volatile("s_waitcnt lgkmcnt(0)" ::: "memory"); __builtin_amdgcn_s_barrier(); asm volatile("" ::: "memory"); \
            f16* dp = dsts[which] + (size_t)(nbk * NC + cb * 16 + r16) * K + kt * 128 + kq * 8; \
            _Pragma("unroll") for (int ks = 0; ks < 4; ++ks) { f16x8 bv; \
                _Pragma("unroll") for (int i = 0; i < 8; ++i) bv[i] = tl[(ks * 32 + kq * 8 + i) * TS + cb * 16 + r16]; \
                if (rb0 == 0) *(f16x8*)(dp + ks * 32) = rmw8(bv); \
                if (CTX) { _Pragma("unroll") for (int rb = 0; rb < NRB; ++rb) { const int row = (rb0 + rb) * 16 + r16; const f16x8 af = *(const f16x8*)(al + row * 128 + (((ks * 4 + kq) ^ r16) * 8)); \
                    acc[which][rb] = __builtin_amdgcn_mfma_f32_16x16x32_f16(bv, af, acc[which][rb], 0, 0, 0); } } } } while (0)
        CV_LOAD(0, 0); CV_LOAD(1, 1);
        for (int t2 = 0; t2 < ntr; t2 += 2) { CV_TILE(t2, 0); CV_TILE(t2 + 1, 1); }
#undef CV_LOAD
#undef CV_TILE
        asm volatile("s_waitcnt lgkmcnt(0)" ::: "memory"); __builtin_amdgcn_s_barrier(); asm volatile("" ::: "memory");
        if (CTX) {
#pragma unroll
            for (int rb = 0; rb < NRB; ++rb) {
                const size_t row = (size_t)e * SLOTS_PAD + 4096 + (rb0 + rb) * 16 + r16; const int col = nbk * NC + cb * 16 + 4 * kq;
                if (GATEUP) { f32x4 o;
#pragma unroll
                    for (int jj = 0; jj < 4; ++jj) o[jj] = silu_f(acc[0][rb][jj]) * acc[1][rb][jj];
                    *(f16x4*)(P.act() + row * DEXP + col) = pk4(o); }
                else *(f16x4*)(P.yslot() + row * DM + col) = pk4(acc[0][rb]);
            }
        }
    }
}

__device__ __forceinline__ void cvt3_job(const Params& P, int job, f16* tile) {
    if (job < 256) phase_cvt_ctx<false, false>(P, 3, job, 1 << 20, tile, -1, true);
    else { const int h = job - 256; phase_cvt_ctx<true, false>(P, 3, h >> 1, 1 << 20, tile, h & 1, true); }
}
template <bool RIL> __device__ __forceinline__ void gateup_setup(const Params& P, fg::PRGateUpT<RIL>& S, int rt, bool alt) { S.H = P.H(); S.rowidx = P.rowidx(); S.W = P.Wgu() + (alt ? (OFF_WGU3 - OFF_WGU) / 2 : 0); S.act = P.act(); S.rt = rt; S.nunits = 16 * rt * 16; S.bid = opaque_bid(); S.ril = nullptr; }
__device__ __forceinline__ void phase_gateup_fast(const Params& P, LAS unsigned char* lds, int rt = 17, bool alt = false) {
    if (rt == 16 && gridDim.x == 256) {
        fg::PRGateUpT<true> S; gateup_setup(P, S, rt, alt);
        LAS int* t = (LAS int*)(lds + fg::STAGE_BYTES);
        const int tid = opaque_tid_(P.wv), pm = ((S.bid & 7) >> 1) * 4 + (S.bid >> 6);
        const int* src = P.rowidx() + pm * fg::BM;
        for (int i = tid; i < NEXP * fg::BM; i += NTHR) t[i] = src[(i >> 8) * SLOTS_PAD + (i & 255)];
        __syncthreads();
        S.ril = t;
        fg::gemm_phase(lds, S, P.wv);
    } else { fg::PRGateUpT<false> S; gateup_setup(P, S, rt, alt); fg::gemm_phase(lds, S, P.wv); }
}
__device__ __forceinline__ void phase_down_fast(const Params& P, LAS unsigned char* lds, int rt = 17, bool alt = false) { fg::PRDown S; S.act = P.act(); S.W = P.Wd() + (alt ? (OFF_WD3 - OFF_WD) / 2 : 0); S.y = P.yslot(); S.rt = rt; S.nunits = 16 * rt * 4; S.bid = opaque_bid(); fg::gemm_phase(lds, S, P.wv); }
__device__ __forceinline__ void phase_pool_fast(const Params& P, LAS unsigned char* lds) { fg::PRDense<256> S; S.qn = nullptr; S.kn = nullptr; S.rope = nullptr; S.xs = nullptr; S.lane = 0; S.npan = 130; S.kvx = 0; S.A = P.H(); S.W = P.Wmix(); S.O0 = P.Z(); S.O1 = nullptr; S.O2 = nullptr; S.ncol = 4; S.mode = 2; S.bid = opaque_bid(); fg::gemm_phase(lds, S, P.wv); }
__device__ __forceinline__ void phase_qkv_fast(const Params& P, LAS unsigned char* lds, bool lastl = false, int l = 1) { fg::PRDense<1024> S; S.qn = P.q_norm + (l >> 1) * 64; S.kn = P.k_norm + (l >> 1) * 64; S.rope = P.rope(); S.xs = (LAS float*)(lds + fg::STAGE_BYTES); S.lane = opaque_tid_(P.wv) & 63; S.npan = lastl ? 128 : 130; S.kvx = lastl ? 4 : 0; S.A = P.H(); S.W = P.Wmix(); S.O0 = P.Q(); S.O1 = P.Kb(); S.O2 = P.Vb(); S.ncol = 6; S.mode = 1; S.bid = opaque_bid(); fg::gemm_phase(lds, S, P.wv); }
__device__ __forceinline__ void phase_oproj_fast(const Params& P, LAS unsigned char* lds, bool lastl = false) { fg::PRDense<1024> S; S.qn = nullptr; S.kn = nullptr; S.rope = nullptr; S.xs = nullptr; S.lane = 0; S.npan = lastl ? 128 : 130; S.kvx = 0; S.A = P.O(); S.W = P.Wmix() + (size_t)QKVD * DM; S.O0 = P.Z(); S.O1 = nullptr; S.O2 = nullptr; S.ncol = 4; S.mode = 0; S.bid = opaque_bid(); fg::gemm_phase(lds, S, P.wv); }

typedef float f32x16 __attribute__((ext_vector_type(16)));
#define AT_KB 9216
#define AT_VB 8704
template <int VAR = 0>
__device__ __forceinline__ void phase_attn_fast(const Params& P, int l, LAS unsigned char* lds, bool do_ctx, int cvt_l = -1) {
    const int j = l >> 1;
    const int tid = opaque_tid(), wid = tid >> 6, lane = tid & 63, l32 = lane & 31, hi = lane >> 5;
    const int g = wid >> 1, qoff = (wid & 1) * 64, qoffu = (P.wv & 1) * 64;
    const int nunits = do_ctx ? 1040 : 1024;
    int ucount = 0;
    for (int u = opaque_bid(); u < nunits; u += gridDim.x, ++ucount) {
        int b, qblk, kv, qrow0, t0, t1, s0;
        if (u < 1024) { b = u >> 9; qblk = (u >> 2) & 127; kv = u & 3; s0 = b * SEQ; qrow0 = s0 + qblk * 128; t0 = qblk == 0 ? 2 : 0; t1 = qblk == 127 ? 4 : 6; }
        else { const int uu = u - 1024; b = uu >> 3; qblk = (uu >> 2) & 1; kv = uu & 3; s0 = NLAT + b * CTXL; qrow0 = s0 + qblk * 128; t0 = 0; t1 = 0; }
        const int cb = NLAT + b * CTXL, nloc = t1 - t0, ntiles = nloc + 4;
        const int h = kv * 4 + g;
        f16x8 Qf[2][4];
#pragma unroll
        for (int qb = 0; qb < 2; ++qb)
#pragma unroll
            for (int ks = 0; ks < 4; ++ks) Qf[qb][ks] = *(const f16x8*)(P.Q() + (size_t)(qrow0 + qoff + 32 * qb + l32) * 1024 + h * 64 + 16 * ks + 8 * hi);
        f32x16 OT[2][2];
#pragma unroll
        for (int db = 0; db < 2; ++db)
#pragma unroll
            for (int qb = 0; qb < 2; ++qb)
#pragma unroll
                for (int r = 0; r < 16; ++r) OT[db][qb][r] = 0.f;
        float mrun[2], lrun[2];
        { const float sk = P.sink[j * 16 + h] * 1.4426950408889634f; mrun[0] = sk; mrun[1] = sk; lrun[0] = hi == 0 ? 1.0f : 0.0f; lrun[1] = lrun[0]; }
        const int lkey = tid >> 3, lpc = tid & 7;
        f16x8 kreg, vreg;
        auto tile_row = [&](int it) -> int { return it < nloc ? (qrow0 - 128 + 64 * (t0 + it)) : (cb + 64 * (it - nloc)); };
        { const int kr = tile_row(0) + lkey; kreg = *(const f16x8*)(P.Kb() + (size_t)kr * 256 + kv * 64 + lpc * 8); vreg = *(const f16x8*)(P.Vb() + (size_t)kr * 256 + kv * 64 + lpc * 8); }
        __syncthreads();
        {
            LAS f16* Kl = (LAS f16*)(lds); LAS f16* Vl = (LAS f16*)(lds + 2 * AT_KB);
            *(LAS f16x8*)(Kl + lkey * 72 + lpc * 8) = kreg;
#pragma unroll
            for (int i = 0; i < 8; ++i) Vl[(lpc * 8 + i) * 68 + lkey] = vreg[i];
        }
        __syncthreads();
        for (int it = 0; it < ntiles; ++it) {
            const int buf = it & 1;
            if (it + 1 < ntiles) { const int kr = tile_row(it + 1) + lkey; kreg = *(const f16x8*)(P.Kb() + (size_t)kr * 256 + kv * 64 + lpc * 8); vreg = *(const f16x8*)(P.Vb() + (size_t)kr * 256 + kv * 64 + lpc * 8); }
            const LAS f16* Kl = (const LAS f16*)(lds + buf * AT_KB); const LAS f16* Vl = (const LAS f16*)(lds + 2 * AT_KB + buf * AT_VB);
            int cls = 0;
            if (it < nloc) { const int tl = t0 + it, dmin = qoffu + 65 - 64 * tl, dmax = qoffu + 191 - 64 * tl; cls = (dmin > 128 || dmax < -128) ? 2 : ((dmin >= -128 && dmax <= 128) ? 0 : 1); }
            if (cls != 2) {
            f32x16 S[2][2];
#pragma unroll
            for (int kb = 0; kb < 2; ++kb)
#pragma unroll
                for (int qb = 0; qb < 2; ++qb)
#pragma unroll
                    for (int r = 0; r < 16; ++r) S[kb][qb][r] = -mrun[qb];
#pragma unroll
            for (int ks = 0; ks < 4; ++ks)
#pragma unroll
                for (int kb = 0; kb < 2; ++kb) {
                    const f16x8 kf = *(const LAS f16x8*)(Kl + (32 * kb + l32) * 72 + 16 * ks + 8 * hi);
#pragma unroll
                    for (int qb = 0; qb < 2; ++qb) S[kb][qb] = __builtin_amdgcn_mfma_f32_32x32x16_f16(kf, Qf[qb][ks], S[kb][qb], 0, 0, 0);
                }
            if (cls == 1) {
                const int kt = 64 * (t0 + it);
#pragma unroll
                for (int qb = 0; qb < 2; ++qb) {
                    const int qp = 128 + qoff + 32 * qb + l32;
#pragma unroll
                    for (int kb = 0; kb < 2; ++kb)
#pragma unroll
                        for (int r = 0; r < 16; ++r) { const int kp = kt + 32 * kb + 8 * (r >> 2) + 4 * hi + (r & 3); const int d = qp - kp; if (d > 128 || d < -128) S[kb][qb][r] = -INFINITY; }
                }
            }
            f16x8 Pf[2][4];
#pragma unroll
            for (int qb = 0; qb < 2; ++qb) {
                float mx = S[0][qb][0];
#pragma unroll
                for (int kb = 0; kb < 2; ++kb)
#pragma unroll
                    for (int r = 0; r < 16; ++r) mx = fmaxf(mx, S[kb][qb][r]);
                { const auto sw = __builtin_amdgcn_permlane32_swap(__float_as_uint(mx), __float_as_uint(mx), false, false); mx = fmaxf(__uint_as_float(sw[0]), __uint_as_float(sw[1])); }
                if (__builtin_amdgcn_ballot_w64(mx > 8.0f) != 0ull) {
                    const float g = fmaxf(mx, 0.f), corr = __builtin_amdgcn_exp2f(-g);
                    mrun[qb] += g; lrun[qb] *= corr;
#pragma unroll
                    for (int kb = 0; kb < 2; ++kb)
#pragma unroll
                        for (int r = 0; r < 16; ++r) S[kb][qb][r] -= g;
#pragma unroll
                    for (int db = 0; db < 2; ++db)
#pragma unroll
                        for (int r = 0; r < 16; ++r) OT[db][qb][r] *= corr;
                }
                float ps = 0.f;
#pragma unroll
                for (int kb = 0; kb < 2; ++kb)
#pragma unroll
                    for (int r = 0; r < 16; ++r) { const float p = __builtin_amdgcn_exp2f(S[kb][qb][r]); S[kb][qb][r] = p; ps += p; }
                lrun[qb] += ps;
#pragma unroll
                for (int ks = 0; ks < 4; ++ks) { const int kb = ks >> 1, r0 = 8 * (ks & 1);
#pragma unroll
                    for (int e = 0; e < 8; ++e) Pf[qb][ks][e] = (f16)S[kb][qb][r0 + e]; }
            }
#pragma unroll
            for (int ks = 0; ks < 4; ++ks)
#pragma unroll
                for (int db = 0; db < 2; ++db) {
                    const LAS f16* vp = Vl + (32 * db + l32) * 68 + 16 * ks + 4 * hi;
                    const f16x4 v0 = *(const LAS f16x4*)vp, v1 = *(const LAS f16x4*)(vp + 8);
                    const f16x8 vf = (f16x8){v0[0], v0[1], v0[2], v0[3], v1[0], v1[1], v1[2], v1[3]};
#pragma unroll
                    for (int qb = 0; qb < 2; ++qb) OT[db][qb] = __builtin_amdgcn_mfma_f32_32x32x16_f16(vf, Pf[qb][ks], OT[db][qb], 0, 0, 0);
                }
            }
            if (it + 1 < ntiles) {
                LAS f16* Kw = (LAS f16*)(lds + (buf ^ 1) * AT_KB); LAS f16* Vw = (LAS f16*)(lds + 2 * AT_KB + (buf ^ 1) * AT_VB);
                *(LAS f16x8*)(Kw + lkey * 72 + lpc * 8) = kreg;
#pragma unroll
                for (int i = 0; i < 8; ++i) Vw[(lpc * 8 + i) * 68 + lkey] = vreg[i];
            }
            __syncthreads();
        }
#pragma unroll
        for (int qb = 0; qb < 2; ++qb) {
            const float lt = lrun[qb] + shx<32>(lrun[qb], lane);
            const float inv = 1.0f / lt;
            f16* op = P.O() + (size_t)(qrow0 + qoff + 32 * qb + l32) * 1024 + h * 64;
#pragma unroll
            for (int db = 0; db < 2; ++db)
#pragma unroll
                for (int i = 0; i < 4; ++i) {
                    const f16x4 o = (f16x4){(f16)(OT[db][qb][4 * i] * inv), (f16)(OT[db][qb][4 * i + 1] * inv), (f16)(OT[db][qb][4 * i + 2] * inv), (f16)(OT[db][qb][4 * i + 3] * inv)};
                    *(f16x4*)(op + 32 * db + 8 * i + 4 * hi) = rm4(o);
                }
        }
    }
}

#define MEGA_LDS (147456 + 16)
__device__ __forceinline__ const Params& opq(Params& q) { int z; asm volatile("s_mov_b32 %0, 0" : "=s"(z)); q.zoff = z; return q; }
__global__ __launch_bounds__(NTHR, 2) void mega(Params P) {
    extern __shared__ __attribute__((aligned(16))) unsigned char shm[];
    LAS unsigned char* lds = (LAS unsigned char*)shm;
    volatile LAS unsigned* st = (volatile LAS unsigned*)(lds + 147456);
    if (threadIdx.x == 0) { st[0] = 0u; st[1] = 0u; st[2] = 0u; st[3] = 0u; }
    __syncthreads();
    const XcdBarrier bar = xcd_barrier_post(P.bar(), st);
    const int nb = gridDim.x;
#define bid (opaque_bid())
    Params Q = P; Q.wv = __builtin_amdgcn_readfirstlane(threadIdx.x >> 6);
#define P (opq(Q))
    phase_ada(P, bid, nb, (float*)shm, 0, nb == 256 ? 1 : 4, true);
    __syncthreads();
    phase_convert(P, 0, bid, nb, (f16*)shm, false);
    xcd_barrier(bar);
    for (int l = 0; l < 4; ++l) {
        if (l == 0) phase_n1<true, false>(P, l, bid, nb); else { phase_n1<false, false>(P, l, bid, nb); if (nb != 256) { __syncthreads(); phase_convert(P, l, bid, nb, (f16*)shm, false); }
            }
        xcd_barrier(bar);
        if ((l & 1) == 0) {
            phase_pool_fast(P, lds);
            xcd_barrier(bar);
            phase_n2<true>(P, l, bid, nb, (float*)shm);
        } else {
            phase_qkv_fast(P, lds, l == 3, l);
            if (nb == 256 && (bid & 7) >= 2) { __syncthreads(); cvt3_job(P, (l == 1 ? 192 : 576) + ((bid & 7) - 2) * 32 + (bid >> 3), (f16*)shm); }
            xcd_barrier(bar);
            phase_attn_fast(P, l, lds, l != 3);
            if (l == 3 && nb != 256) { __syncthreads(); phase_cvt_ctx<true, false>(P, l, bid, nb, (f16*)shm, -1, true); phase_cvt_ctx<false, false>(P, l, bid, nb, (f16*)shm, -1, true); }
            xcd_barrier(bar);
            phase_oproj_fast(P, lds, l == 3);
            if (l == 1 && nb == 256 && (bid & 7) >= 2) { __syncthreads(); cvt3_job(P, 384 + ((bid & 7) - 2) * 32 + (bid >> 3), (f16*)shm); }
            xcd_barrier(bar);
            phase_n2<false>(P, l, bid, nb, (float*)shm, l == 3 ? NLAT : MROWS);
        }
        xcd_barrier(bar);
        phase_topk(P, bid, nb, (unsigned*)shm, l == 3 ? 32 : 64);
        if (l < 3 && nb == 256 && bid >= 64 && bid < 128) cvt3_job(P, l * 64 + bid - 64, (f16*)shm);
        if (l < 3 && nb == 256 && bid >= 224) phase_convert(P, l + 1, bid - 224, 32, (f16*)shm, false);
        if (l < 3 && nb == 256 && bid >= 128 && bid < 224) phase_ada(P, bid - 128, 1 << 20, (float*)shm, l + 1, 1, false);
        xcd_barrier(bar);
        if (l < 3) { phase_cvt_ctx<true, true>(P, l, bid, nb, (f16*)shm); xcd_barrier(bar); }
        phase_gateup_fast(P, lds, 16, l == 3);
        if (l < 3) { __syncthreads(); phase_cvt_ctx<false, true>(P, l, bid, nb, (f16*)shm); }
        xcd_barrier(bar);
        phase_down_fast(P, lds, 16, l == 3);
        xcd_barrier(bar);
    }
    phase_n1<false, true>(P, 4, bid, nb);
#undef P
#undef bid
}

static inline size_t al256(size_t v) { return (v + 255) & ~(size_t)255; }

extern "C" void kernel_launch(void* const* d_in, const int* in_sizes, int n_in, void* d_out, int out_size, void* d_ws, size_t ws_size, hipStream_t stream) {
    Params P{};
    P.x = (const float*)d_in[0]; P.c = (const float*)d_in[1]; P.ctx = (const float*)d_in[2]; P.c_ctx = (const float*)d_in[3];
    P.w_ada = (const float*)d_in[4]; P.b_ada = (const float*)d_in[5]; P.norm1_g = (const float*)d_in[6]; P.norm2_g = (const float*)d_in[7];
    P.pool_w = (const float*)d_in[8]; P.pool_scale = (const float*)d_in[9]; P.w_qkv = (const float*)d_in[10]; P.w_o = (const float*)d_in[11];
    P.q_norm = (const float*)d_in[12]; P.k_norm = (const float*)d_in[13]; P.sink = (const float*)d_in[14]; P.router_w = (const float*)d_in[15];
    P.w_gate = (const float*)d_in[16]; P.w_up = (const float*)d_in[17]; P.w_down = (const float*)d_in[18];
    P.out = (float*)d_out;
    P.ws = (char*)d_ws; const size_t off = WS_TOTAL;
    if (off > ws_size) { fprintf(stderr, "workspace too small: need %zu have %zu\n", off, ws_size); return; }
    static int grid = 0;
    if (!grid) {
        int dev = 0, cus = 0, per_cu = 0;
        hipGetDevice(&dev);
        hipDeviceGetAttribute(&cus, hipDeviceAttributeMultiprocessorCount, dev);
        hipFuncSetAttribute((const void*)mega, hipFuncAttributeMaxDynamicSharedMemorySize, MEGA_LDS);
        hipOccupancyMaxActiveBlocksPerMultiprocessor(&per_cu, (const void*)mega, NTHR, MEGA_LDS);
        if (per_cu < 1) { fprintf(stderr, "mega: occupancy query says %d blocks per CU\n", per_cu); }
        grid = cus > 0 ? cus : 256;
    }
    hipMemsetAsync(P.bar(), 0, XCD_BAR_WORDS * sizeof(unsigned), stream);
    hipLaunchKernelGGL(mega, dim3(grid), dim3(NTHR), MEGA_LDS, stream, P);
}
```
